# Optimizing an MI355X kernel written in HIP

```python
import jax
import jax.numpy as jnp
from jax import lax
import numpy as np

D_MODEL = 1024
BATCH = 4
SEQ = 8192
DEPTH = 4

N_MEM = 256
X_HEADS = 4
X_HEAD_DIM = 128
X_WIDTH = X_HEADS * X_HEAD_DIM
MLA_HEADS = 12
QK_NOPE = 128
QK_ROPE = 64
V_HEAD = 128
Q_LORA = 384
KV_LORA = 256
ROPE_THETA = 10000.0
MIX_WIDTH = MLA_HEADS * V_HEAD
INNER = MIX_WIDTH + X_WIDTH
RWKV_HEAD = 64
RWKV_HEADS = MIX_WIDTH // RWKV_HEAD
DECAY_LORA = 64
ICLR_LORA = 64
GN_EPS = 64e-5
NORM_EPS = 1e-6
Q_BLOCK = 128
N_MIXERS = 2
N_MLA = (DEPTH + 1) // 2
N_RWKV = DEPTH // 2
MLA_IN = Q_LORA + KV_LORA + QK_ROPE + X_WIDTH + INNER
RWKV_SHIFT = 3 * MIX_WIDTH + DECAY_LORA + ICLR_LORA
RWKV_IN = RWKV_SHIFT + X_WIDTH + INNER

kernel_name = 'hybrid_mla_rwkv7_memxattn_gated'


def split_cols(u, sizes):
    out, start = [], 0
    for n in sizes:
        out.append(u[..., start:start + n])
        start += n
    return out


def rmsnorm(x, g):
    xf = x.astype(jnp.float32)
    y = xf * lax.rsqrt(jnp.mean(xf * xf, axis=-1, keepdims=True) + NORM_EPS)
    return (y * g.astype(jnp.float32)).astype(x.dtype)


def rope_tables(positions):
    inv_freq = ROPE_THETA ** (-jnp.arange(0, QK_ROPE, 2, dtype=jnp.float32) / QK_ROPE)
    ang = positions.astype(jnp.float32)[..., None] * inv_freq
    return jnp.cos(ang), jnp.sin(ang)


def apply_rope(x, cos, sin):
    cos = cos.astype(x.dtype)
    sin = sin.astype(x.dtype)
    x1, x2 = x[..., 0::2], x[..., 1::2]
    return jnp.stack([x1 * cos - x2 * sin, x1 * sin + x2 * cos], axis=-1).reshape(x.shape)


def causal_block_attention(q_nope, q_rope, k_nope, k_rope, v):
    B, S, H, _ = q_nope.shape
    n_blocks = S // Q_BLOCK
    scale = (QK_NOPE + QK_ROPE) ** -0.5
    key_idx = jnp.arange(S)

    def to_blocks(t):
        return jnp.moveaxis(t.reshape(B, n_blocks, Q_BLOCK, *t.shape[2:]), 1, 0)

    def one_block(args):
        qn, qr, blk = args
        s = (jnp.einsum('bqhd,bkhd->bhqk', qn, k_nope)
             + jnp.einsum('bqhr,bkr->bhqk', qr, k_rope)).astype(jnp.float32) * scale
        q_idx = blk * Q_BLOCK + jnp.arange(Q_BLOCK)
        s = jnp.where(key_idx[None, :] <= q_idx[:, None], s, -jnp.inf)
        p = jax.nn.softmax(s, axis=-1).astype(v.dtype)
        return jnp.einsum('bhqk,bkhd->bqhd', p, v)

    out = lax.map(one_block, (to_blocks(q_nope), to_blocks(q_rope), jnp.arange(n_blocks)))
    return jnp.moveaxis(out, 0, 1).reshape(B, S, H * V_HEAD)


def mla_mixer(c_q, c_kv, k_rope_raw, cos, sin, q_norm_g, kv_norm_g, w_uq, w_ukv):
    B, S, _ = c_q.shape
    q = (rmsnorm(c_q, q_norm_g) @ w_uq).reshape(B, S, MLA_HEADS, QK_NOPE + QK_ROPE)
    q_nope = q[..., :QK_NOPE]
    q_rope = apply_rope(q[..., QK_NOPE:], cos[:, :, None, :], sin[:, :, None, :])
    kv = (rmsnorm(c_kv, kv_norm_g) @ w_ukv).reshape(B, S, MLA_HEADS, QK_NOPE + V_HEAD)
    k_nope, v = kv[..., :QK_NOPE], kv[..., QK_NOPE:]
    k_rope = apply_rope(k_rope_raw, cos, sin)
    return causal_block_attention(q_nope, q_rope, k_nope, k_rope, v)


def rwkv7_scan(r, w, k, v, kk, a):
    B, S, H, N = r.shape

    def step(state, inp):
        r_t, w_t, k_t, v_t, kk_t, a_t = inp
        sa = jnp.einsum('bhvk,bhk->bhv', state, -kk_t)
        state = (state * w_t[:, :, None, :]
                 + sa[..., None] * (kk_t * a_t)[:, :, None, :]
                 + v_t[..., None] * k_t[:, :, None, :])
        return state, jnp.einsum('bhvk,bhk->bhv', state, r_t)

    xs = tuple(jnp.moveaxis(t, 1, 0) for t in (r, w, k, v, kk, a))
    _, y = lax.scan(step, jnp.zeros((B, H, N, N), jnp.float32), xs)
    return jnp.moveaxis(y, 0, 1)


def rwkv7_mixer(u_shift, mu, w0, w2, a0, a2, k_k, k_a, r_k, gn_w, gn_b):
    B, S, _ = u_shift.shape
    f32 = jnp.float32
    u = u_shift.astype(f32)
    u_prev = jnp.pad(u[:, :-1], ((0, 0), (1, 0), (0, 0)))
    u = u + (u_prev - u) * mu.astype(f32)
    r, k, v, wd, ad = split_cols(u, (MIX_WIDTH, MIX_WIDTH, MIX_WIDTH, DECAY_LORA, ICLR_LORA))
    w = -jax.nn.softplus(-(w0.astype(f32) + jnp.tanh(wd) @ w2.astype(f32))) - 0.5
    decay = jnp.exp(-jnp.exp(w))
    a = jax.nn.sigmoid(a0.astype(f32) + ad @ a2.astype(f32))

    def heads(t):
        return t.reshape(B, S, RWKV_HEADS, RWKV_HEAD)

    kk = heads(k * k_k.astype(f32))
    kk = kk / jnp.maximum(jnp.linalg.norm(kk, axis=-1, keepdims=True), 1e-12)
    k = k * (1.0 + (a - 1.0) * k_a.astype(f32))
    r, decay, k, v, a = heads(r), heads(decay), heads(k), heads(v), heads(a)
    y = rwkv7_scan(r, decay, k, v, kk, a)
    mean = jnp.mean(y, axis=-1, keepdims=True)
    var = jnp.mean(jnp.square(y - mean), axis=-1, keepdims=True)
    y = (y - mean) * lax.rsqrt(var + GN_EPS)
    y = y * gn_w.astype(f32).reshape(RWKV_HEADS, RWKV_HEAD) + gn_b.astype(f32).reshape(RWKV_HEADS, RWKV_HEAD)
    bonus = jnp.sum(r * k * r_k.astype(f32).reshape(RWKV_HEADS, RWKV_HEAD), axis=-1, keepdims=True) * v
    return (y + bonus).reshape(B, S, MIX_WIDTH).astype(u_shift.dtype)


def memory_attention(q, mem_k, mem_v):
    B, S = q.shape[:2]
    s = jnp.einsum('bshd,bmhd->bhsm', q, mem_k).astype(jnp.float32) * X_HEAD_DIM ** -0.5
    p = jax.nn.softmax(s, axis=-1).astype(mem_v.dtype)
    return jnp.einsum('bhsm,bmhd->bshd', p, mem_v).reshape(B, S, X_WIDTH)


def setup_inputs(seed: int = 0) -> dict:
    key = jax.random.key(seed)
    ks = iter(jax.random.split(key, 32))

    def nrm(shape, scale):
        return scale * jax.random.normal(next(ks), shape, jnp.float32)

    def gain(shape):
        return 1.0 + nrm(shape, 0.02)

    def unif(shape, lo, hi):
        return jax.random.uniform(next(ks), shape, jnp.float32, lo, hi)

    x = nrm((BATCH, SEQ, D_MODEL), 1.0)
    mem = nrm((BATCH, N_MEM, D_MODEL), 1.0)
    offset = jax.random.randint(next(ks), (BATCH, 1), 0, 4096, dtype=jnp.int32)
    positions = (offset + jnp.arange(SEQ, dtype=jnp.int32)[None, :]).astype(jnp.int32)
    return {
        'x': x,
        'mem': mem,
        'positions': positions,
        'norm_g': gain((DEPTH, D_MODEL)),
        'mem_norm_g': gain((DEPTH, D_MODEL)),
        'w_mem_kv': nrm((DEPTH, D_MODEL, 2 * X_WIDTH), D_MODEL ** -0.5),
        'w_in_mla': nrm((N_MLA, D_MODEL, MLA_IN), D_MODEL ** -0.5),
        'mla_q_norm_g': gain((N_MLA, Q_LORA)),
        'mla_kv_norm_g': gain((N_MLA, KV_LORA)),
        'mla_w_uq': nrm((N_MLA, Q_LORA, MLA_HEADS * (QK_NOPE + QK_ROPE)), Q_LORA ** -0.5),
        'mla_w_ukv': nrm((N_MLA, KV_LORA, MLA_HEADS * (QK_NOPE + V_HEAD)), KV_LORA ** -0.5),
        'w_in_rwkv': nrm((N_RWKV, D_MODEL, RWKV_IN), D_MODEL ** -0.5),
        'rwkv_mu': unif((N_RWKV, RWKV_SHIFT), 0.0, 1.0),
        'rwkv_w0': unif((N_RWKV, MIX_WIDTH), -6.0, -1.0),
        'rwkv_w2': nrm((N_RWKV, DECAY_LORA, MIX_WIDTH), 0.1 * DECAY_LORA ** -0.5),
        'rwkv_a0': nrm((N_RWKV, MIX_WIDTH), 0.1),
        'rwkv_a2': nrm((N_RWKV, ICLR_LORA, MIX_WIDTH), 0.1 * ICLR_LORA ** -0.5),
        'rwkv_k_k': 0.85 + nrm((N_RWKV, MIX_WIDTH), 0.02),
        'rwkv_k_a': gain((N_RWKV, MIX_WIDTH)),
        'rwkv_r_k': nrm((N_RWKV, MIX_WIDTH), 0.1),
        'rwkv_gn_w': gain((N_RWKV, MIX_WIDTH)),
        'rwkv_gn_b': nrm((N_RWKV, MIX_WIDTH), 0.02),
        'w_out': nrm((DEPTH, INNER, D_MODEL), INNER ** -0.5),
        'final_g': gain((D_MODEL,)),
    }


def reference(x, mem, positions, norm_g, mem_norm_g, w_mem_kv, w_in_mla, mla_q_norm_g,
              mla_kv_norm_g, mla_w_uq, mla_w_ukv, w_in_rwkv, rwkv_mu, rwkv_w0, rwkv_w2,
              rwkv_a0, rwkv_a2, rwkv_k_k, rwkv_k_a, rwkv_r_k, rwkv_gn_w, rwkv_gn_b,
              w_out, final_g):
    B, S, _ = x.shape
    M = mem.shape[1]
    cos, sin = rope_tables(positions)
    for i in range(DEPTH):
        h = rmsnorm(x, norm_g[i])
        m = rmsnorm(mem, mem_norm_g[i])
        mem_k, mem_v = split_cols(m @ w_mem_kv[i], (X_WIDTH, X_WIDTH))
        mem_k = mem_k.reshape(B, M, X_HEADS, X_HEAD_DIM)
        mem_v = mem_v.reshape(B, M, X_HEADS, X_HEAD_DIM)
        j = i // N_MIXERS
        if i % N_MIXERS == 0:
            u = h @ w_in_mla[j]
            c_q, c_kv, k_rope_raw, q_mem, gate = split_cols(
                u, (Q_LORA, KV_LORA, QK_ROPE, X_WIDTH, INNER))
            mix = mla_mixer(c_q, c_kv, k_rope_raw, cos, sin, mla_q_norm_g[j],
                            mla_kv_norm_g[j], mla_w_uq[j], mla_w_ukv[j])
        else:
            u = h @ w_in_rwkv[j]
            u_shift, q_mem, gate = split_cols(u, (RWKV_SHIFT, X_WIDTH, INNER))
            mix = rwkv7_mixer(u_shift, rwkv_mu[j], rwkv_w0[j], rwkv_w2[j], rwkv_a0[j],
                              rwkv_a2[j], rwkv_k_k[j], rwkv_k_a[j], rwkv_r_k[j],
                              rwkv_gn_w[j], rwkv_gn_b[j])
        mem_out = memory_attention(q_mem.reshape(B, S, X_HEADS, X_HEAD_DIM), mem_k, mem_v)
        y = jnp.concatenate([mix, mem_out], axis=-1) * jax.nn.silu(gate)
        x = x + y @ w_out[i]
    return rmsnorm(x, final_g)
```

```cpp
#include <hip/hip_runtime.h>
#include <hip/hip_cooperative_groups.h>
#include <cstdio>
#include <cstring>
namespace cg = cooperative_groups;

#ifndef MULTI_LAUNCH
#define MULTI_LAUNCH 0
#endif

#define DI __device__ __forceinline__
typedef unsigned short u16;
typedef __attribute__((ext_vector_type(8))) short bf16x8;
typedef __attribute__((ext_vector_type(16))) float f32x16;
typedef __attribute__((ext_vector_type(2))) __bf16 bf2_t;
typedef __attribute__((ext_vector_type(2))) float f2_t;
typedef __attribute__((ext_vector_type(4))) unsigned u32x4;
typedef __attribute__((ext_vector_type(2))) unsigned u32x2;
#define MFMA32(a, b, c) __builtin_amdgcn_mfma_f32_32x32x16_bf16((a), (b), (c), 0, 0, 0)

constexpr int SEQ = 8192, TC = 16384;
constexpr int LDU_M = 3264, LDU_R = 7296;
constexpr int M_CQ = 0, M_CKV = 384, M_KR = 640, M_QM = 704, M_GATE = 1216;
constexpr int R_R = 0, R_K = 1536, R_V = 3072, R_WD = 4608, R_AD = 4672, R_QM = 4736, R_GATE = 5248;
constexpr int SHIFTW = 4736;

constexpr size_t OFF_WT_MEMKV = 0;
constexpr size_t OFF_WT_INMLA = OFF_WT_MEMKV + 4ull * 1024 * 1024 * 2;
constexpr size_t OFF_WT_UQ    = OFF_WT_INMLA + 2ull * 3328 * 1024 * 2;
constexpr size_t OFF_WT_UKV   = OFF_WT_UQ + 2ull * 2304 * 384 * 2;
constexpr size_t OFF_WT_INRW  = OFF_WT_UKV + 2ull * 3072 * 256 * 2;
constexpr size_t OFF_WT_OUT   = OFF_WT_INRW + 2ull * 7296 * 1024 * 2;
constexpr size_t OFF_MEMH     = OFF_WT_OUT + 4ull * 1024 * 2048 * 2;
constexpr size_t OFF_MEMK     = OFF_MEMH + 4ull * 1024 * 1024 * 2;
constexpr size_t OFF_MEMVT    = OFF_MEMK + 4ull * 4 * 4 * 256 * 128 * 2;
constexpr size_t OFF_COS      = OFF_MEMVT + 4ull * 4 * 4 * 256 * 128 * 2;
constexpr size_t OFF_SIN      = OFF_COS + 32768ull * 32 * 4;
constexpr size_t OFF_CNT      = OFF_SIN + 32768ull * 32 * 4;
constexpr size_t OFF_STATE    = OFF_CNT + 256;
constexpr size_t OFF_BND      = OFF_STATE + 96ull * 4096 * 4;
constexpr size_t OFF_H        = OFF_BND + 4ull * 4736 * 2 + 128;
constexpr size_t OFF_R        = OFF_H + 16384ull * 1024 * 2;
constexpr size_t OFF_U        = OFF_R;
constexpr size_t OFF_Q        = OFF_R + 16384ull * 3264 * 2;
constexpr size_t OFF_K        = OFF_Q + 2ull * 12 * 8192 * 192 * 2;
constexpr size_t OFF_VT       = OFF_K + 2ull * 12 * 8192 * 192 * 2;
constexpr size_t OFF_YR       = OFF_R + 16384ull * 7296 * 2;
constexpr size_t OFF_BV       = OFF_YR + 16384ull * 1536 * 2;
constexpr size_t OFF_ST       = OFF_BV + 16384ull * 1536 * 2;
constexpr size_t OFF_BS       = OFF_ST + 16384ull * 24 * 4 * 4;
constexpr size_t WS_NEED      = OFF_BS + 16384ull * 24 * 4;

constexpr int SMEM_BYTES = 79616;

struct Params {
  const float *x, *mem; const int* pos;
  const float *norm_g, *mem_norm_g, *w_mem_kv, *w_in_mla, *q_norm_g, *kv_norm_g, *w_uq, *w_ukv, *w_in_rwkv;
  const float *mu, *w0, *w2, *a0, *a2, *k_k, *k_a, *r_k, *gn_w, *gn_b, *w_out, *final_g;
  float* out; char* ws;
};

DI float bf2f(unsigned v) { return __uint_as_float(v << 16); }
DI unsigned pack2(float a, float b) { f2_t v = {a, b}; bf2_t r = __builtin_convertvector(v, bf2_t); return __builtin_bit_cast(unsigned, r); }
DI u16 f2bf(float a) { return (u16)(pack2(a, 0.f) & 0xffffu); }
DI float ex2(float x) { return __builtin_amdgcn_exp2f(x); }
DI float fexp(float x) { return __builtin_amdgcn_exp2f(x * 1.4426950408889634f); }
DI float frcp(float x) { return __builtin_amdgcn_rcpf(x); }
DI float silu(float g) { return g * frcp(1.f + fexp(-g)); }
DI float wave_sum(float v) { for (int o = 32; o > 0; o >>= 1) v += __shfl_xor(v, o); return v; }
DI int crow(int reg, int h) { return (reg & 3) + 8 * (reg >> 2) + 4 * h; }
DI float dppf(float x, const int ctrl_sel) {
  int xi;
  if (ctrl_sel == 0) xi = __builtin_amdgcn_update_dpp(0, __float_as_int(x), 0xB1, 0xf, 0xf, true);
  else if (ctrl_sel == 1) xi = __builtin_amdgcn_update_dpp(0, __float_as_int(x), 0x4E, 0xf, 0xf, true);
  else xi = __builtin_amdgcn_update_dpp(0, __float_as_int(x), 0x141, 0xf, 0xf, true);
  return __int_as_float(xi);
}
DI float red4(float x) { x += dppf(x, 0); x += dppf(x, 1); return x; }
DI float red8(float x) { x += dppf(x, 0); x += dppf(x, 1); x += dppf(x, 2); return x; }
DI int gtok(bool rw, int c, int lr) { return rw ? ((lr >> 12) * 8192 + c * 4096 + (lr & 4095)) : (c * 16384 + lr); }
DI void unpack8(const uint4& v, float* f) {
  f[0] = bf2f(v.x & 0xffffu); f[1] = bf2f(v.x >> 16); f[2] = bf2f(v.y & 0xffffu); f[3] = bf2f(v.y >> 16);
  f[4] = bf2f(v.z & 0xffffu); f[5] = bf2f(v.z >> 16); f[6] = bf2f(v.w & 0xffffu); f[7] = bf2f(v.w >> 16);
}
DI uint4 pack8(const float* f) { uint4 v; v.x = pack2(f[0], f[1]); v.y = pack2(f[2], f[3]); v.z = pack2(f[4], f[5]); v.w = pack2(f[6], f[7]); return v; }

DI void transpose_tile(const float* __restrict__ src, u16* __restrict__ dst, int K, int N, int tk, int tn, float* tile) {
  const int tid = threadIdx.x;
  __syncthreads();
#pragma unroll
  for (int i = 0; i < 4; ++i) {
    int kr = (tid >> 4) + 16 * i, nc = (tid & 15) * 4;
    float4 v = *(const float4*)(src + (size_t)(tk * 64 + kr) * N + tn * 64 + nc);
    tile[kr * 65 + nc] = v.x; tile[kr * 65 + nc + 1] = v.y; tile[kr * 65 + nc + 2] = v.z; tile[kr * 65 + nc + 3] = v.w;
  }
  __syncthreads();
#pragma unroll
  for (int i = 0; i < 2; ++i) {
    int n = (tid >> 3) + 32 * i, kc = (tid & 7) * 8;
    float f[8];
#pragma unroll
    for (int e = 0; e < 8; ++e) f[e] = tile[(kc + e) * 65 + n];
    *(uint4*)(dst + (size_t)(tn * 64 + n) * K + tk * 64 + kc) = pack8(f);
  }
}

DI void rms_row_bf16(const float* __restrict__ src, const float* __restrict__ g, u16* __restrict__ dst, int lane) {
  float4 v[4]; float ss = 0.f;
#pragma unroll
  for (int i = 0; i < 4; ++i) { v[i] = *(const float4*)(src + i * 256 + lane * 4); ss += v[i].x * v[i].x + v[i].y * v[i].y + v[i].z * v[i].z + v[i].w * v[i].w; }
  ss = wave_sum(ss);
  float rs = rsqrtf(ss * (1.f / 1024.f) + 1e-6f);
#pragma unroll
  for (int i = 0; i < 4; ++i) {
    float4 gg = *(const float4*)(g + i * 256 + lane * 4);
    uint2 o; o.x = pack2(v[i].x * rs * gg.x, v[i].y * rs * gg.y); o.y = pack2(v[i].z * rs * gg.z, v[i].w * rs * gg.w);
    *(uint2*)(dst + i * 256 + lane * 4) = o;
  }
}

DI void phase_prep(const Params& p, char* smem) {
  const int tid = threadIdx.x, G = gridDim.x, bid = blockIdx.x;
  char* ws = p.ws;
  if (bid == 0 && tid < 64) ((int*)(ws + OFF_CNT))[tid] = 0;
  float* tile = (float*)smem;
  for (int g0 = bid; g0 < 9168; g0 += G) {
    int g = g0;
    const float* src = nullptr; u16* dst = nullptr; int K = 0, N = 0; size_t dstr = 0;
    if (g < 1024) { src = p.w_mem_kv; dst = (u16*)(ws + OFF_WT_MEMKV); K = 1024; N = 1024; dstr = 1024ull * 1024; }
    else if ((g -= 1024) < 1632) { src = p.w_in_mla; dst = (u16*)(ws + OFF_WT_INMLA); K = 1024; N = 3264; dstr = 3328ull * 1024; }
    else if ((g -= 1632) < 432) { src = p.w_uq; dst = (u16*)(ws + OFF_WT_UQ); K = 384; N = 2304; dstr = 2304ull * 384; }
    else if ((g -= 432) < 384) { src = p.w_ukv; dst = (u16*)(ws + OFF_WT_UKV); K = 256; N = 3072; dstr = 3072ull * 256; }
    else if ((g -= 384) < 3648) { src = p.w_in_rwkv; dst = (u16*)(ws + OFF_WT_INRW); K = 1024; N = 7296; dstr = 7296ull * 1024; }
    else { g -= 3648; src = p.w_out; dst = (u16*)(ws + OFF_WT_OUT); K = 2048; N = 1024; dstr = 1024ull * 2048; }
    int ntn = N >> 6, per = (K >> 6) * ntn;
    int m = g / per, t = g - m * per;
    int tk = t / ntn, tn = t - tk * ntn;
    transpose_tile(src + (size_t)m * K * N, dst + (size_t)m * dstr, K, N, tk, tn, tile);
  }
  for (int i = bid * 256 + tid; i < 2 * 64 * 1024 / 8; i += G * 256) {
    int m = i / (64 * 1024 / 8), r = i - m * (64 * 1024 / 8);
    uint4 z; z.x = z.y = z.z = z.w = 0u;
    *(uint4*)((u16*)(ws + OFF_WT_INMLA) + (size_t)m * 3328 * 1024 + 3264ull * 1024 + (size_t)r * 8) = z;
  }
  float* cs = (float*)(ws + OFF_COS); float* sn = (float*)(ws + OFF_SIN);
  for (int i = bid * 256 + tid; i < 32768 * 32; i += G * 256) {
    int tk = i >> 5, pi = i & 31;
    float inv_freq = (float)exp2(-(double)(2 * pi) / 64.0 * 13.287712379549449);
    float ang = (float)p.pos[tk] * inv_freq;
    double rev = (double)ang * 0.15915494309189535;
    float fr = (float)(rev - rint(rev));
    cs[i] = __builtin_amdgcn_cosf(fr); sn[i] = __builtin_amdgcn_sinf(fr);
  }
  const int w = tid >> 6, lane = tid & 63;
  for (int row = bid * 4 + w; row < 4096; row += G * 4) {
    int L = row >> 10, m = row & 1023;
    rms_row_bf16(p.mem + (size_t)m * 1024, p.mem_norm_g + L * 1024, (u16*)(ws + OFF_MEMH) + (size_t)row * 1024, lane);
  }
}

DI void phase_norm(const Params& p, int L, int c) {
  const int tid = threadIdx.x, w = tid >> 6, lane = tid & 63;
  const bool rw = L & 1;
  const float* xs = (L == 0) ? p.x : p.out;
  u16* H = (u16*)(p.ws + OFF_H);
  for (int lr = blockIdx.x * 4 + w; lr < TC; lr += gridDim.x * 4) {
    int gt = gtok(rw, c, lr);
    rms_row_bf16(xs + (size_t)gt * 1024, p.norm_g + L * 1024, H + (size_t)lr * 1024, lane);
  }
}

DI void phase_final_norm(const Params& p) {
  const int tid = threadIdx.x, w = tid >> 6, lane = tid & 63;
  for (int row = blockIdx.x * 4 + w; row < 32768; row += gridDim.x * 4) {
    float* xr = p.out + (size_t)row * 1024;
    float4 v[4]; float ss = 0.f;
#pragma unroll
    for (int i = 0; i < 4; ++i) { v[i] = *(const float4*)(xr + i * 256 + lane * 4); ss += v[i].x * v[i].x + v[i].y * v[i].y + v[i].z * v[i].z + v[i].w * v[i].w; }
    ss = wave_sum(ss);
    float rs = rsqrtf(ss * (1.f / 1024.f) + 1e-6f);
#pragma unroll
    for (int i = 0; i < 4; ++i) {
      float4 gg = *(const float4*)(p.final_g + i * 256 + lane * 4);
      float4 o; o.x = v[i].x * rs * gg.x; o.y = v[i].y * rs * gg.y; o.z = v[i].z * rs * gg.z; o.w = v[i].w * rs * gg.w;
      *(float4*)(xr + i * 256 + lane * 4) = o;
    }
  }
}

template <class Epi>
DI void gemm_phase(const u16* __restrict__ A, size_t strideAz, int lda, const u16* __restrict__ Bt, size_t strideBz, int ldb,
                   int Z, int Mt, int Nt, int K, char* smem, const Epi& epi) {
  const int tid = threadIdx.x, w = tid >> 6, lane = tid & 63, r = lane & 31, h = lane >> 5;
  const int wm = w >> 1, wn = w & 1;
  u16* As = (u16*)smem;
  u16* Bs = As + 2 * 128 * 72;
  const int G = gridDim.x, per = Mt * Nt, total = Z * per;
  const int lrow = tid >> 3, lcc = (tid & 7) * 8;
  for (int base = 0; base < total; base += G) {
    const int t = blockIdx.x;
    const int q = base + (((G & 7) == 0) ? ((t & 7) * (G >> 3) + (t >> 3)) : t);
    if (q >= total) continue;
    const int z = q / per, qq = q - z * per;
    const int grp = qq / (8 * Nt), within = qq - grp * 8 * Nt;
    const int mt = grp * 8 + (within & 7), nt = within >> 3;
    const u16* Ag = A + z * strideAz + (size_t)(mt * 128 + lrow) * lda + lcc;
    const u16* Bg = Bt + z * strideBz + (size_t)(nt * 128 + lrow) * ldb + lcc;
    uint4 ra[4], rb[4];
    f32x16 acc[2][2];
#pragma unroll
    for (int i = 0; i < 2; ++i)
#pragma unroll
      for (int j = 0; j < 2; ++j)
#pragma unroll
        for (int e = 0; e < 16; ++e) acc[i][j][e] = 0.f;
    __syncthreads();
#pragma unroll
    for (int i = 0; i < 4; ++i) { ra[i] = *(const uint4*)(Ag + (size_t)(32 * i) * lda); rb[i] = *(const uint4*)(Bg + (size_t)(32 * i) * ldb); }
#pragma unroll
    for (int i = 0; i < 4; ++i) { *(uint4*)(As + (lrow + 32 * i) * 72 + lcc) = ra[i]; *(uint4*)(Bs + (lrow + 32 * i) * 72 + lcc) = rb[i]; }
    __syncthreads();
    const int nk = K >> 6;
    for (int kt = 0; kt < nk; ++kt) {
      const int buf = kt & 1;
      if (kt + 1 < nk) {
#pragma unroll
        for (int i = 0; i < 4; ++i) { ra[i] = *(const uint4*)(Ag + (size_t)(32 * i) * lda + (kt + 1) * 64); rb[i] = *(const uint4*)(Bg + (size_t)(32 * i) * ldb + (kt + 1) * 64); }
      }
      const u16* as = As + buf * 128 * 72 + (64 * wm + r) * 72 + 8 * h;
      const u16* bs = Bs + buf * 128 * 72 + (64 * wn + r) * 72 + 8 * h;
#pragma unroll
      for (int ks = 0; ks < 4; ++ks) {
        bf16x8 a0 = *(const bf16x8*)(as + 16 * ks), a1 = *(const bf16x8*)(as + 32 * 72 + 16 * ks);
        bf16x8 b0 = *(const bf16x8*)(bs + 16 * ks), b1 = *(const bf16x8*)(bs + 32 * 72 + 16 * ks);
        acc[0][0] = MFMA32(a0, b0, acc[0][0]); acc[0][1] = MFMA32(a0, b1, acc[0][1]);
        acc[1][0] = MFMA32(a1, b0, acc[1][0]); acc[1][1] = MFMA32(a1, b1, acc[1][1]);
      }
      if (kt + 1 < nk) {
        u16* ad = As + (buf ^ 1) * 128 * 72; u16* bd = Bs + (buf ^ 1) * 128 * 72;
#pragma unroll
        for (int i = 0; i < 4; ++i) { *(uint4*)(ad + (lrow + 32 * i) * 72 + lcc) = ra[i]; *(uint4*)(bd + (lrow + 32 * i) * 72 + lcc) = rb[i]; }
      }
      __syncthreads();
    }
#pragma unroll
    for (int i = 0; i < 2; ++i)
#pragma unroll
      for (int j = 0; j < 2; ++j) epi(z, mt * 128 + 64 * wm + 32 * i, nt * 128 + 64 * wn + 32 * j + r, h, acc[i][j]);
  }
}

struct EpiStoreBf16 {
  u16* C; int ldc; int ncols;
  DI void operator()(int z, int rowbase, int col, int h, const f32x16& a) const {
    if (col >= ncols) return;
#pragma unroll
    for (int e = 0; e < 16; ++e) C[(size_t)(rowbase + crow(e, h)) * ldc + col] = f2bf(a[e]);
  }
};
struct EpiResid {
  const float* xin; float* xout; bool rw; int c;
  DI void operator()(int z, int rowbase, int col, int h, const f32x16& a) const {
#pragma unroll
    for (int e = 0; e < 16; ++e) {
      int gt = gtok(rw, c, rowbase + crow(e, h));
      size_t o = (size_t)gt * 1024 + col;
      xout[o] = xin[o] + a[e];
    }
  }
};
struct EpiUQ {
  u16* Q; const float* cs; const float* sn; int c;
  DI void operator()(int z, int rowbase, int col, int h, const f32x16& a) const {
    const int head = col / 192, d = col - head * 192;
    const bool rope = d >= 128;
#pragma unroll
    for (int e = 0; e < 16; ++e) {
      int lr = rowbase + crow(e, h); int lb = lr >> 13, s = lr & 8191;
      float v = a[e];
      if (rope) {
        float o = __shfl_xor(v, 1);
        int ti = (c * 16384 + lr) * 32 + ((d - 128) >> 1);
        float cc = cs[ti], ss = sn[ti];
        v = (d & 1) ? (o * ss + v * cc) : (v * cc - o * ss);
      }
      Q[((size_t)(lb * 12 + head) * 8192 + s) * 192 + d] = f2bf(v);
    }
  }
};
struct EpiUKV {
  u16* Kb; u16* Vt;
  DI void operator()(int z, int rowbase, int col, int h, const f32x16& a) const {
    const int head = col >> 8, d = col & 255;
    if (d < 128) {
#pragma unroll
      for (int e = 0; e < 16; ++e) {
        int lr = rowbase + crow(e, h); int lb = lr >> 13, s = lr & 8191;
        Kb[((size_t)(lb * 12 + head) * 8192 + s) * 192 + d] = f2bf(a[e]);
      }
    } else {
#pragma unroll
      for (int g = 0; g < 4; ++g) {
        int lr = rowbase + 8 * g + 4 * h; int lb = lr >> 13, s = lr & 8191;
        uint2 pk; pk.x = pack2(a[4 * g], a[4 * g + 1]); pk.y = pack2(a[4 * g + 2], a[4 * g + 3]);
        *(uint2*)(Vt + ((size_t)(lb * 12 + head) * 128 + (d - 128)) * 8192 + s) = pk;
      }
    }
  }
};
struct EpiMemKV {
  u16* MK; u16* MVt;
  DI void operator()(int z, int rowbase, int col, int h, const f32x16& a) const {
    if (col < 512) {
      const int xh = col >> 7, d = col & 127;
#pragma unroll
      for (int e = 0; e < 16; ++e) {
        int m = rowbase + crow(e, h); int b = m >> 8, mi = m & 255;
        MK[((size_t)((z * 4 + b) * 4 + xh) * 256 + mi) * 128 + d] = f2bf(a[e]);
      }
    } else {
      const int n = col - 512, xh = n >> 7, d = n & 127;
#pragma unroll
      for (int g = 0; g < 4; ++g) {
        int m = rowbase + 8 * g + 4 * h; int b = m >> 8, mi = m & 255;
        uint2 pk; pk.x = pack2(a[4 * g], a[4 * g + 1]); pk.y = pack2(a[4 * g + 2], a[4 * g + 3]);
        *(uint2*)(MVt + ((size_t)((z * 4 + b) * 4 + xh) * 128 + d) * 256 + mi) = pk;
      }
    }
  }
};

DI void phase_kvprep(const Params& p, int L, int c) {
  const int tid = threadIdx.x, w = tid >> 6, lane = tid & 63;
  const int j = L >> 1;
  u16* U = (u16*)(p.ws + OFF_U); u16* Kb = (u16*)(p.ws + OFF_K);
  const float* cs = (const float*)(p.ws + OFF_COS); const float* sn = (const float*)(p.ws + OFF_SIN);
  for (int lr = blockIdx.x * 4 + w; lr < TC; lr += gridDim.x * 4) {
    u16* row = U + (size_t)lr * LDU_M;
    float fq[8], fk[8]; float sq = 0.f, sk = 0.f;
    if (lane < 48) { uint4 v = *(const uint4*)(row + M_CQ + lane * 8); unpack8(v, fq);
#pragma unroll
      for (int e = 0; e < 8; ++e) sq += fq[e] * fq[e]; }
    if (lane < 32) { uint4 v = *(const uint4*)(row + M_CKV + lane * 8); unpack8(v, fk);
#pragma unroll
      for (int e = 0; e < 8; ++e) sk += fk[e] * fk[e]; }
    sq = wave_sum(sq); sk = wave_sum(sk);
    float rq = rsqrtf(sq * (1.f / 384.f) + 1e-6f), rk = rsqrtf(sk * (1.f / 256.f) + 1e-6f);
    if (lane < 48) {
      const float* g = p.q_norm_g + j * 384 + lane * 8;
#pragma unroll
      for (int e = 0; e < 8; ++e) fq[e] = fq[e] * rq * g[e];
      *(uint4*)(row + M_CQ + lane * 8) = pack8(fq);
    }
    if (lane < 32) {
      const float* g = p.kv_norm_g + j * 256 + lane * 8;
#pragma unroll
      for (int e = 0; e < 8; ++e) fk[e] = fk[e] * rk * g[e];
      *(uint4*)(row + M_CKV + lane * 8) = pack8(fk);
    }
    if (lane < 8) {
      float f[8], o[8]; uint4 v = *(const uint4*)(row + M_KR + lane * 8); unpack8(v, f);
      int gt = c * 16384 + lr;
#pragma unroll
      for (int i = 0; i < 4; ++i) {
        float cc = cs[gt * 32 + lane * 4 + i], ss = sn[gt * 32 + lane * 4 + i];
        o[2 * i] = f[2 * i] * cc - f[2 * i + 1] * ss; o[2 * i + 1] = f[2 * i] * ss + f[2 * i + 1] * cc;
      }
      uint4 pk = pack8(o);
      int lb = lr >> 13, s = lr & 8191;
#pragma unroll
      for (int hd = 0; hd < 12; ++hd) *(uint4*)(Kb + ((size_t)(lb * 12 + hd) * 8192 + s) * 192 + 128 + lane * 8) = pk;
    }
  }
}

template <int DQK>
DI void attn_item(const u16* __restrict__ Qp, int ldq, const u16* __restrict__ Kp, const u16* __restrict__ Vtp, int ldv,
                  int nkt, int q0, bool causal, float c, u16* Yp, int ldy, char* smem) {
  constexpr int KLD = DQK + 8;
  constexpr int NKC = DQK * 64 / 8 / 256;
  constexpr int NKS = DQK / 16;
  constexpr int CPR = DQK / 8;
  u16* Ks = (u16*)smem;
  u16* Vs = Ks + 64 * KLD;
  const int tid = threadIdx.x, w = tid >> 6, lane = tid & 63, r = lane & 31, h = lane >> 5;
  bf16x8 qf[NKS];
  {
    const u16* qrow = Qp + (size_t)(32 * w + r) * ldq + 8 * h;
#pragma unroll
    for (int ks = 0; ks < NKS; ++ks) qf[ks] = *(const bf16x8*)(qrow + 16 * ks);
  }
  f32x16 o[4];
#pragma unroll
  for (int dt = 0; dt < 4; ++dt)
#pragma unroll
    for (int e = 0; e < 16; ++e) o[dt][e] = 0.f;
  float m = -INFINITY, l = 0.f;
  u32x4 kst[NKC], vst[4];
  const int vd = tid >> 3, vc8 = tid & 7;
  {
#pragma unroll
    for (int i = 0; i < NKC; ++i) kst[i] = *(const u32x4*)(Kp + (size_t)(tid + 256 * i) * 8);
#pragma unroll
    for (int i = 0; i < 4; ++i) vst[i] = *(const u32x4*)(Vtp + (size_t)(vd + 32 * i) * ldv + vc8 * 8);
  }
  const int qmin = q0 + 32 * w;
  for (int kt = 0; kt < nkt; ++kt) {
    __syncthreads();
#pragma unroll
    for (int i = 0; i < NKC; ++i) { int id = tid + 256 * i; int row = id / CPR, cc = id - row * CPR; *(u32x4*)(Ks + row * KLD + cc * 8) = kst[i]; }
#pragma unroll
    for (int i = 0; i < 4; ++i) {
      u16* dst = Vs + (vd + 32 * i) * 72 + 16 * (vc8 >> 1) + 4 * (vc8 & 1);
      u32x2 lo = {vst[i].x, vst[i].y}, hi = {vst[i].z, vst[i].w};
      *(u32x2*)dst = lo; *(u32x2*)(dst + 8) = hi;
    }
    __syncthreads();
    if (kt + 1 < nkt) {
      const u16* kg = Kp + (size_t)(kt + 1) * 64 * DQK;
#pragma unroll
      for (int i = 0; i < NKC; ++i) kst[i] = *(const u32x4*)(kg + (size_t)(tid + 256 * i) * 8);
#pragma unroll
      for (int i = 0; i < 4; ++i) vst[i] = *(const u32x4*)(Vtp + (size_t)(vd + 32 * i) * ldv + (kt + 1) * 64 + vc8 * 8);
    }
    if (causal && kt * 64 > qmin + 31) continue;
    f32x16 s0, s1;
#pragma unroll
    for (int e = 0; e < 16; ++e) { s0[e] = 0.f; s1[e] = 0.f; }
    {
      const u16* k0 = Ks + r * KLD + 8 * h;
#pragma unroll
      for (int ks = 0; ks < NKS; ++ks) {
        bf16x8 a0 = *(const bf16x8*)(k0 + 16 * ks), a1 = *(const bf16x8*)(k0 + 32 * KLD + 16 * ks);
        s0 = MFMA32(a0, qf[ks], s0); s1 = MFMA32(a1, qf[ks], s1);
        if ((ks & 1) == 1) __builtin_amdgcn_sched_barrier(0);
      }
    }
    if (causal && kt * 64 + 63 > qmin) {
      const int qi = qmin + r;
#pragma unroll
      for (int e = 0; e < 16; ++e) {
        int key = kt * 64 + crow(e, h);
        if (key > qi) s0[e] = -INFINITY;
        if (key + 32 > qi) s1[e] = -INFINITY;
      }
    }
    float mx = fmaxf(s0[0], s1[0]);
#pragma unroll
    for (int e = 1; e < 16; ++e) mx = fmaxf(mx, fmaxf(s0[e], s1[e]));
    mx = fmaxf(mx, __shfl_xor(mx, 32));
    const float mn = fmaxf(m, mx);
    const float alpha = ex2((m - mn) * c);
    const float mc = mn * c;
    m = mn;
    l *= alpha;
#pragma unroll
    for (int dt = 0; dt < 4; ++dt)
#pragma unroll
      for (int e = 0; e < 16; ++e) o[dt][e] *= alpha;
    float ps = 0.f;
#pragma unroll
    for (int e = 0; e < 16; ++e) { s0[e] = ex2(fmaf(s0[e], c, -mc)); s1[e] = ex2(fmaf(s1[e], c, -mc)); ps += s0[e] + s1[e]; }
    l += ps;
    bf16x8 pf[4];
    {
      u32x4 t;
      t.x = pack2(s0[0], s0[1]); t.y = pack2(s0[2], s0[3]); t.z = pack2(s0[4], s0[5]); t.w = pack2(s0[6], s0[7]); pf[0] = __builtin_bit_cast(bf16x8, t);
      t.x = pack2(s0[8], s0[9]); t.y = pack2(s0[10], s0[11]); t.z = pack2(s0[12], s0[13]); t.w = pack2(s0[14], s0[15]); pf[1] = __builtin_bit_cast(bf16x8, t);
      t.x = pack2(s1[0], s1[1]); t.y = pack2(s1[2], s1[3]); t.z = pack2(s1[4], s1[5]); t.w = pack2(s1[6], s1[7]); pf[2] = __builtin_bit_cast(bf16x8, t);
      t.x = pack2(s1[8], s1[9]); t.y = pack2(s1[10], s1[11]); t.z = pack2(s1[12], s1[13]); t.w = pack2(s1[14], s1[15]); pf[3] = __builtin_bit_cast(bf16x8, t);
    }
    {
      const u16* v0 = Vs + r * 72 + 8 * h;
#pragma unroll
      for (int kk = 0; kk < 4; ++kk)
#pragma unroll
        for (int dt = 0; dt < 4; ++dt) {
          bf16x8 a = *(const bf16x8*)(v0 + (32 * dt) * 72 + 16 * kk);
          o[dt] = MFMA32(a, pf[kk], o[dt]);
          if (dt == 3) __builtin_amdgcn_sched_barrier(0);
        }
    }
  }
  const float lt = l + __shfl_xor(l, 32);
  const float inv = 1.f / lt;
  u16* yrow = Yp + (size_t)(32 * w + r) * ldy;
#pragma unroll
  for (int dt = 0; dt < 4; ++dt)
#pragma unroll
    for (int g = 0; g < 4; ++g) {
      const int d = 32 * dt + 8 * g + 4 * h;
      uint2 gv = *(const uint2*)(yrow + d);
      float g0 = bf2f(gv.x & 0xffffu), g1 = bf2f(gv.x >> 16), g2 = bf2f(gv.y & 0xffffu), g3 = bf2f(gv.y >> 16);
      uint2 ov;
      ov.x = pack2(o[dt][4 * g] * inv * silu(g0), o[dt][4 * g + 1] * inv * silu(g1));
      ov.y = pack2(o[dt][4 * g + 2] * inv * silu(g2), o[dt][4 * g + 3] * inv * silu(g3));
      *(uint2*)(yrow + d) = ov;
    }
}

DI void memattn_item(const Params& p, int L, int c, int item, char* smem) {
  const bool rw = L & 1;
  const int ldu = rw ? LDU_R : LDU_M, oq = rw ? R_QM : M_QM, og = rw ? R_GATE : M_GATE;
  const int tile = item >> 2, xh = item & 3;
  const int b = gtok(rw, c, tile * 128) >> 13;
  u16* U = (u16*)(p.ws + OFF_U);
  const u16* MK = (const u16*)(p.ws + OFF_MEMK) + (size_t)((L * 4 + b) * 4 + xh) * 256 * 128;
  const u16* MV = (const u16*)(p.ws + OFF_MEMVT) + (size_t)((L * 4 + b) * 4 + xh) * 128 * 256;
  attn_item<128>(U + (size_t)tile * 128 * ldu + oq + xh * 128, ldu, MK, MV, 256, 4, 0, false,
                 0.08838834764831845f * 1.4426950408889634f, U + (size_t)tile * 128 * ldu + og + 1536 + xh * 128, ldu, smem);
}

DI void phase_attn(const Params& p, int L, int c, char* smem, int* s_item) {
  int* cnt = (int*)(p.ws + OFF_CNT) + (L * 2 + c);
  u16* U = (u16*)(p.ws + OFF_U);
  const u16* Q = (const u16*)(p.ws + OFF_Q); const u16* Kb = (const u16*)(p.ws + OFF_K); const u16* Vt = (const u16*)(p.ws + OFF_VT);
  for (;;) {
    __syncthreads();
    if (threadIdx.x == 0) *s_item = atomicAdd(cnt, 1);
    __syncthreads();
    const int item = *s_item;
    if (item >= 1536 + 512) break;
    if (item < 1536) {
      const int qt = 63 - item / 24, bh = item % 24;
      const int lb = bh / 12, head = bh - lb * 12;
      const int q0 = qt * 128;
      attn_item<192>(Q + ((size_t)(lb * 12 + head) * 8192 + q0) * 192, 192, Kb + (size_t)(lb * 12 + head) * 8192 * 192,
                     Vt + (size_t)(lb * 12 + head) * 128 * 8192, 8192, 2 * (qt + 1), q0, true,
                     0.07216878364870323f * 1.4426950408889634f,
                     U + (size_t)(lb * 8192 + q0) * LDU_M + M_GATE + head * 128, LDU_M, smem);
    } else {
      memattn_item(p, L, c, item - 1536, smem);
    }
  }
}

DI void scan_item(const Params& p, int L, int c, int item, char* smem) {
  const int tid = threadIdx.x, w = tid >> 6, lane = tid & 63, r = lane & 31, h = lane >> 5;
  const int j = L >> 1;
  const int b = item / 48, rem = item - b * 48, head = rem >> 1, half = rem & 1;
  float* PA  = (float*)smem;
  float* LO  = PA;
  float* Vst = PA + 32 * 5 * 64;
  float* Yst = Vst + 32 * 32;
  float* PRM = Yst + 32 * 32;
  float* BON = PRM + 10 * 64;
  u16* A1  = (u16*)(BON + 32);
  u16* W2t = A1 + 2 * 32 * 72;
  const u16* U = (const u16*)(p.ws + OFF_U);
  const u16* BND = (const u16*)(p.ws + OFF_BND);
  u16* YR = (u16*)(p.ws + OFF_YR); u16* BV = (u16*)(p.ws + OFF_BV);
  float* ST = (float*)(p.ws + OFF_ST); float* BS = (float*)(p.ws + OFF_BS);
  float* STATE = (float*)(p.ws + OFF_STATE);
  __syncthreads();
  if (tid < 64) {
    const float* mu = p.mu + j * SHIFTW;
    const int hc = head * 64 + tid;
    PRM[0 * 64 + tid] = mu[R_R + hc]; PRM[1 * 64 + tid] = mu[R_K + hc]; PRM[2 * 64 + tid] = mu[R_WD + tid]; PRM[3 * 64 + tid] = mu[R_AD + tid];
    PRM[4 * 64 + tid] = p.w0[j * 1536 + hc]; PRM[5 * 64 + tid] = p.a0[j * 1536 + hc]; PRM[6 * 64 + tid] = p.k_k[j * 1536 + hc];
    PRM[7 * 64 + tid] = p.k_a[j * 1536 + hc]; PRM[8 * 64 + tid] = p.r_k[j * 1536 + hc];
    PRM[9 * 64 + tid] = (tid < 32) ? mu[R_V + head * 64 + 32 * half + tid] : 0.f;
  }
  for (int e = tid; e < 8192; e += 256) {
    int arr = e >> 12, jj = (e >> 6) & 63, cc = e & 63;
    const float* src = (arr ? p.a2 : p.w2) + (size_t)j * 64 * 1536;
    W2t[(arr * 64 + cc) * 72 + jj] = f2bf(src[jj * 1536 + head * 64 + cc]);
  }
  const int rowl = lane >> 3, ks = lane & 7, row32 = 8 * w + rowl;
  float S[8];
  {
    float* sp = STATE + ((size_t)((b * 24 + head) * 64 + 32 * half + row32)) * 64 + 8 * ks;
#pragma unroll
    for (int i = 0; i < 8; ++i) S[i] = (c == 0) ? 0.f : sp[i];
  }
  const int tt = tid >> 3, cs = tid & 7;
  uint4 Rr_c, Rr_p, Rk_c, Rk_p, Rw_c, Rw_p, Ra_c, Ra_p, Rv_c, Rv_p;
  const uint4 zero4 = {0u, 0u, 0u, 0u};
  auto load_raw = [&](int tc) {
    const int lr = b * 4096 + tc * 32 + tt;
    const int s = c * 4096 + tc * 32 + tt;
    const u16* cur = U + (size_t)lr * LDU_R;
    const u16* prv = (s == 4096 && c == 1) ? (BND + (size_t)b * SHIFTW) : (cur - LDU_R);
    const bool hp = (s != 0);
    Rr_c = *(const uint4*)(cur + R_R + head * 64 + cs * 8);  Rr_p = hp ? *(const uint4*)(prv + R_R + head * 64 + cs * 8) : zero4;
    Rk_c = *(const uint4*)(cur + R_K + head * 64 + cs * 8);  Rk_p = hp ? *(const uint4*)(prv + R_K + head * 64 + cs * 8) : zero4;
    Rw_c = *(const uint4*)(cur + R_WD + cs * 8);             Rw_p = hp ? *(const uint4*)(prv + R_WD + cs * 8) : zero4;
    Ra_c = *(const uint4*)(cur + R_AD + cs * 8);             Ra_p = hp ? *(const uint4*)(prv + R_AD + cs * 8) : zero4;
    const int vo = R_V + head * 64 + 32 * half + (cs & 3) * 8;
    Rv_c = *(const uint4*)(cur + vo);                        Rv_p = hp ? *(const uint4*)(prv + vo) : zero4;
  };
  load_raw(0);
  __syncthreads();
  for (int tc = 0; tc < 128; ++tc) {
    const int lr = b * 4096 + tc * 32 + tt;
    float rm[8], km[8];
    {
      float cu[8], pv[8], t8[8];
      unpack8(Rr_c, cu); unpack8(Rr_p, pv);
#pragma unroll
      for (int e = 0; e < 8; ++e) rm[e] = cu[e] + (pv[e] - cu[e]) * PRM[0 * 64 + cs * 8 + e];
      unpack8(Rk_c, cu); unpack8(Rk_p, pv);
#pragma unroll
      for (int e = 0; e < 8; ++e) km[e] = cu[e] + (pv[e] - cu[e]) * PRM[1 * 64 + cs * 8 + e];
      unpack8(Rw_c, cu); unpack8(Rw_p, pv);
#pragma unroll
      for (int e = 0; e < 8; ++e) {
        float xw = cu[e] + (pv[e] - cu[e]) * PRM[2 * 64 + cs * 8 + e];
        float ee = ex2(xw * 2.8853900817779268f);
        t8[e] = 1.f - 2.f * frcp(ee + 1.f);
      }
      *(uint4*)(A1 + (0 * 32 + tt) * 72 + cs * 8) = pack8(t8);
      unpack8(Ra_c, cu); unpack8(Ra_p, pv);
#pragma unroll
      for (int e = 0; e < 8; ++e) t8[e] = cu[e] + (pv[e] - cu[e]) * PRM[3 * 64 + cs * 8 + e];
      *(uint4*)(A1 + (1 * 32 + tt) * 72 + cs * 8) = pack8(t8);
      unpack8(Rv_c, cu); unpack8(Rv_p, pv);
      if (cs < 4) {
#pragma unroll
        for (int e = 0; e < 8; ++e) Vst[tt * 32 + cs * 8 + e] = cu[e] + (pv[e] - cu[e]) * PRM[9 * 64 + cs * 8 + e];
      }
    }
    __syncthreads();
    {
      const int arr = w >> 1, nt = w & 1;
      f32x16 acc;
#pragma unroll
      for (int e = 0; e < 16; ++e) acc[e] = 0.f;
#pragma unroll
      for (int k4 = 0; k4 < 4; ++k4) {
        bf16x8 a = *(const bf16x8*)(A1 + (arr * 32 + r) * 72 + 16 * k4 + 8 * h);
        bf16x8 bw = *(const bf16x8*)(W2t + (arr * 64 + 32 * nt + r) * 72 + 16 * k4 + 8 * h);
        acc = MFMA32(a, bw, acc);
      }
#pragma unroll
      for (int e = 0; e < 16; ++e) LO[(arr * 32 + crow(e, h)) * 64 + 32 * nt + r] = acc[e];
    }
    __syncthreads();
    float lw[8], la[8];
    {
      float4 t0 = *(const float4*)(LO + (0 * 32 + tt) * 64 + cs * 8), t1 = *(const float4*)(LO + (0 * 32 + tt) * 64 + cs * 8 + 4);
      lw[0] = t0.x; lw[1] = t0.y; lw[2] = t0.z; lw[3] = t0.w; lw[4] = t1.x; lw[5] = t1.y; lw[6] = t1.z; lw[7] = t1.w;
      t0 = *(const float4*)(LO + (1 * 32 + tt) * 64 + cs * 8); t1 = *(const float4*)(LO + (1 * 32 + tt) * 64 + cs * 8 + 4);
      la[0] = t0.x; la[1] = t0.y; la[2] = t0.z; la[3] = t0.w; la[4] = t1.x; la[5] = t1.y; la[6] = t1.z; la[7] = t1.w;
    }
    __syncthreads();
    {
      float dec[8], kk[8], av[8], kp[8];
      float ssq = 0.f, bon = 0.f;
#pragma unroll
      for (int e = 0; e < 8; ++e) {
        const int ch = cs * 8 + e;
        float xx = -(lw[e] + PRM[4 * 64 + ch]);
        float sp = fmaxf(xx, 0.f) + __logf(1.f + fexp(-fabsf(xx)));
        float wv = -sp - 0.5f;
        dec[e] = fexp(-fexp(wv));
        float a = frcp(1.f + fexp(-(la[e] + PRM[5 * 64 + ch])));
        av[e] = a;
        kk[e] = km[e] * PRM[6 * 64 + ch];
        ssq += kk[e] * kk[e];
        kp[e] = km[e] * (1.f + (a - 1.f) * PRM[7 * 64 + ch]);
        bon += rm[e] * kp[e] * PRM[8 * 64 + ch];
      }
      ssq = red8(ssq); bon = red8(bon);
      const float inv = 1.f / fmaxf(sqrtf(ssq), 1e-12f);
      float nk[8], bb[8];
#pragma unroll
      for (int e = 0; e < 8; ++e) { float kn = kk[e] * inv; nk[e] = -kn; bb[e] = kn * av[e]; }
      float* pa = PA + tt * 320 + cs * 8;
      *(float4*)(pa) = make_float4(dec[0], dec[1], dec[2], dec[3]); *(float4*)(pa + 4) = make_float4(dec[4], dec[5], dec[6], dec[7]);
      *(float4*)(pa + 64) = make_float4(nk[0], nk[1], nk[2], nk[3]); *(float4*)(pa + 68) = make_float4(nk[4], nk[5], nk[6], nk[7]);
      *(float4*)(pa + 128) = make_float4(bb[0], bb[1], bb[2], bb[3]); *(float4*)(pa + 132) = make_float4(bb[4], bb[5], bb[6], bb[7]);
      *(float4*)(pa + 192) = make_float4(kp[0], kp[1], kp[2], kp[3]); *(float4*)(pa + 196) = make_float4(kp[4], kp[5], kp[6], kp[7]);
      *(float4*)(pa + 256) = make_float4(rm[0], rm[1], rm[2], rm[3]); *(float4*)(pa + 260) = make_float4(rm[4], rm[5], rm[6], rm[7]);
      if (cs == 0) BON[tt] = bon;
    }
    __syncthreads();
    if (tc + 1 < 128) load_raw(tc + 1);
#pragma unroll 2
    for (int t = 0; t < 32; ++t) {
      const float* pa = PA + t * 320 + ks * 8;
      const float4 d0 = *(const float4*)(pa), d1 = *(const float4*)(pa + 4);
      const float4 n0 = *(const float4*)(pa + 64), n1 = *(const float4*)(pa + 68);
      const float4 b0 = *(const float4*)(pa + 128), b1 = *(const float4*)(pa + 132);
      const float4 k0 = *(const float4*)(pa + 192), k1 = *(const float4*)(pa + 196);
      const float4 r0 = *(const float4*)(pa + 256), r1 = *(const float4*)(pa + 260);
      const float vv = Vst[t * 32 + row32];
      float sa = (S[0] * n0.x + S[1] * n0.y) + (S[2] * n0.z + S[3] * n0.w) + ((S[4] * n1.x + S[5] * n1.y) + (S[6] * n1.z + S[7] * n1.w));
      sa = red8(sa);
      S[0] = fmaf(sa, b0.x, fmaf(S[0], d0.x, vv * k0.x)); S[1] = fmaf(sa, b0.y, fmaf(S[1], d0.y, vv * k0.y));
      S[2] = fmaf(sa, b0.z, fmaf(S[2], d0.z, vv * k0.z)); S[3] = fmaf(sa, b0.w, fmaf(S[3], d0.w, vv * k0.w));
      S[4] = fmaf(sa, b1.x, fmaf(S[4], d1.x, vv * k1.x)); S[5] = fmaf(sa, b1.y, fmaf(S[5], d1.y, vv * k1.y));
      S[6] = fmaf(sa, b1.z, fmaf(S[6], d1.z, vv * k1.z)); S[7] = fmaf(sa, b1.w, fmaf(S[7], d1.w, vv * k1.w));
      float y = (S[0] * r0.x + S[1] * r0.y) + (S[2] * r0.z + S[3] * r0.w) + ((S[4] * r1.x + S[5] * r1.y) + (S[6] * r1.z + S[7] * r1.w));
      y = red8(y);
      if (ks == 0) Yst[t * 32 + row32] = y;
    }
    __syncthreads();
    {
      const int c4 = cs & 3;
      float y8[8], v8[8];
      float4 t0 = *(const float4*)(Yst + tt * 32 + c4 * 8), t1 = *(const float4*)(Yst + tt * 32 + c4 * 8 + 4);
      y8[0] = t0.x; y8[1] = t0.y; y8[2] = t0.z; y8[3] = t0.w; y8[4] = t1.x; y8[5] = t1.y; y8[6] = t1.z; y8[7] = t1.w;
      float sm = 0.f, sq = 0.f;
#pragma unroll
      for (int e = 0; e < 8; ++e) { sm += y8[e]; sq += y8[e] * y8[e]; }
      sm = red4(sm); sq = red4(sq);
      const float bon = BON[tt];
      t0 = *(const float4*)(Vst + tt * 32 + c4 * 8); t1 = *(const float4*)(Vst + tt * 32 + c4 * 8 + 4);
      v8[0] = t0.x * bon; v8[1] = t0.y * bon; v8[2] = t0.z * bon; v8[3] = t0.w * bon; v8[4] = t1.x * bon; v8[5] = t1.y * bon; v8[6] = t1.z * bon; v8[7] = t1.w * bon;
      if (cs < 4) {
        const size_t o = (size_t)lr * 1536 + head * 64 + 32 * half + cs * 8;
        *(uint4*)(YR + o) = pack8(y8);
        *(uint4*)(BV + o) = pack8(v8);
        if (cs == 0) {
          float* stp = ST + ((size_t)(lr * 24 + head) * 2 + half) * 2;
          stp[0] = sm; stp[1] = sq;
        }
      }
    }
  }
  if (c == 0) {
    float* sp = STATE + ((size_t)((b * 24 + head) * 64 + 32 * half + row32)) * 64 + 8 * ks;
#pragma unroll
    for (int i = 0; i < 8; ++i) sp[i] = S[i];
  }
}

DI void phase_scan(const Params& p, int L, int c, char* smem, int* s_item) {
  for (int item = blockIdx.x; item < 192; item += gridDim.x) scan_item(p, L, c, item, smem);
  int* cnt = (int*)(p.ws + OFF_CNT) + (L * 2 + c);
  for (;;) {
    __syncthreads();
    if (threadIdx.x == 0) *s_item = atomicAdd(cnt, 1);
    __syncthreads();
    const int item = *s_item;
    if (item >= 512) break;
    memattn_item(p, L, c, item, smem);
  }
}

DI void phase_finalize(const Params& p, int L, int c) {
  const int j = L >> 1;
  u16* U = (u16*)(p.ws + OFF_U);
  const u16* YR = (const u16*)(p.ws + OFF_YR); const u16* BV = (const u16*)(p.ws + OFF_BV);
  const float* ST = (const float*)(p.ws + OFF_ST);
  const int G = gridDim.x;
  for (int idx = blockIdx.x * 256 + threadIdx.x; idx < TC * 192; idx += G * 256) {
    const int lr = idx / 192, c8 = idx - lr * 192, ch0 = c8 * 8, head = ch0 >> 6;
    const float4 st = *(const float4*)(ST + (size_t)(lr * 24 + head) * 4);
    const float mean = (st.x + st.z) * (1.f / 64.f);
    const float var = (st.y + st.w) * (1.f / 64.f) - mean * mean;
    const float rstd = rsqrtf(fmaxf(var, 0.f) + 64e-5f);
    float y[8], bv[8], g[8], o[8];
    unpack8(*(const uint4*)(YR + (size_t)lr * 1536 + ch0), y);
    unpack8(*(const uint4*)(BV + (size_t)lr * 1536 + ch0), bv);
    u16* gp = U + (size_t)lr * LDU_R + R_GATE + ch0;
    unpack8(*(const uint4*)gp, g);
    const float* gw = p.gn_w + j * 1536 + ch0; const float* gb = p.gn_b + j * 1536 + ch0;
#pragma unroll
    for (int e = 0; e < 8; ++e) o[e] = ((y[e] - mean) * rstd * gw[e] + gb[e] + bv[e]) * silu(g[e]);
    *(uint4*)gp = pack8(o);
  }
  if (c == 0) {
    u16* BND = (u16*)(p.ws + OFF_BND);
    for (int idx = blockIdx.x * 256 + threadIdx.x; idx < 4 * (SHIFTW / 8); idx += G * 256) {
      const int b = idx / (SHIFTW / 8), cc = idx - b * (SHIFTW / 8);
      *(uint4*)(BND + (size_t)b * SHIFTW + cc * 8) = *(const uint4*)(U + (size_t)(b * 4096 + 4095) * LDU_R + cc * 8);
    }
  }
}

enum { PH_PREP = 0, PH_NORM, PH_GEMM_IN, PH_KVPREP, PH_GEMM_UP, PH_ATTN, PH_SCAN, PH_FINALIZE, PH_GEMM_OUT, PH_FINAL };
constexpr int NSTEPS = 46;

DI void decode_step(int step, int& ph, int& L, int& c) {
  if (step == 0) { ph = PH_PREP; L = 0; c = 0; return; }
  if (step == NSTEPS - 1) { ph = PH_FINAL; L = 0; c = 0; return; }
  int s = step - 1;
  int pr = s / 22, rem = s - pr * 22;
  if (rem < 12) {
    L = 2 * pr; c = rem / 6; int k = rem - c * 6;
    ph = (k == 0) ? PH_NORM : (k == 1) ? PH_GEMM_IN : (k == 2) ? PH_KVPREP : (k == 3) ? PH_GEMM_UP : (k == 4) ? PH_ATTN : PH_GEMM_OUT;
  } else {
    rem -= 12; L = 2 * pr + 1; c = rem / 5; int k = rem - c * 5;
    ph = (k == 0) ? PH_NORM : (k == 1) ? PH_GEMM_IN : (k == 2) ? PH_SCAN : (k == 3) ? PH_FINALIZE : PH_GEMM_OUT;
  }
}

DI void run_step(const Params& p, int step, char* smem, int* s_item) {
  int ph, L, c;
  decode_step(step, ph, L, c);
  char* ws = p.ws;
  const bool rw = L & 1;
  const int j = L >> 1;
  switch (ph) {
    case PH_PREP: phase_prep(p, smem); break;
    case PH_NORM:
      phase_norm(p, L, c);
      if (L == 0 && c == 0) {
        EpiMemKV epi{(u16*)(ws + OFF_MEMK), (u16*)(ws + OFF_MEMVT)};
        gemm_phase((const u16*)(ws + OFF_MEMH), 1024ull * 1024, 1024, (const u16*)(ws + OFF_WT_MEMKV), 1024ull * 1024, 1024, 4, 8, 8, 1024, smem, epi);
      }
      break;
    case PH_GEMM_IN:
      if (!rw) {
        EpiStoreBf16 epi{(u16*)(ws + OFF_U), LDU_M, LDU_M};
        gemm_phase((const u16*)(ws + OFF_H), 0, 1024, (const u16*)(ws + OFF_WT_INMLA) + (size_t)j * 3328 * 1024, 0, 1024, 1, 128, 26, 1024, smem, epi);
      } else {
        EpiStoreBf16 epi{(u16*)(ws + OFF_U), LDU_R, LDU_R};
        gemm_phase((const u16*)(ws + OFF_H), 0, 1024, (const u16*)(ws + OFF_WT_INRW) + (size_t)j * 7296 * 1024, 0, 1024, 1, 128, 57, 1024, smem, epi);
      }
      break;
    case PH_KVPREP: phase_kvprep(p, L, c); break;
    case PH_GEMM_UP: {
      EpiUQ e1{(u16*)(ws + OFF_Q), (const float*)(ws + OFF_COS), (const float*)(ws + OFF_SIN), c};
      gemm_phase((const u16*)(ws + OFF_U) + M_CQ, 0, LDU_M, (const u16*)(ws + OFF_WT_UQ) + (size_t)j * 2304 * 384, 0, 384, 1, 128, 18, 384, smem, e1);
      EpiUKV e2{(u16*)(ws + OFF_K), (u16*)(ws + OFF_VT)};
      gemm_phase((const u16*)(ws + OFF_U) + M_CKV, 0, LDU_M, (const u16*)(ws + OFF_WT_UKV) + (size_t)j * 3072 * 256, 0, 256, 1, 128, 24, 256, smem, e2);
    } break;
    case PH_ATTN: phase_attn(p, L, c, smem, s_item); break;
    case PH_SCAN: phase_scan(p, L, c, smem, s_item); break;
    case PH_FINALIZE: phase_finalize(p, L, c); break;
    case PH_GEMM_OUT: {
      EpiResid epi{(L == 0) ? p.x : (const float*)p.out, p.out, rw, c};
      gemm_phase((const u16*)(ws + OFF_U) + (rw ? R_GATE : M_GATE), 0, rw ? LDU_R : LDU_M, (const u16*)(ws + OFF_WT_OUT) + (size_t)L * 1024 * 2048, 0, 2048,
                 1, 128, 8, 2048, smem, epi);
    } break;
    case PH_FINAL: phase_final_norm(p); break;
  }
}

__global__ void __launch_bounds__(256, 1) hybrid_megakernel(Params p, int s_lo, int s_hi, int coop) {
  __shared__ __attribute__((aligned(16))) char smem[SMEM_BYTES];
  __shared__ int s_item;
  for (int st = s_lo; st < s_hi; ++st) {
    run_step(p, st, smem, &s_item);
    if (coop && st + 1 < s_hi) cg::this_grid().sync();
  }
}

extern "C" void kernel_launch(void* const* d_in, const int* in_sizes, int n_in, void* d_out, int out_size, void* d_ws, size_t ws_size,
                              hipStream_t stream) {
  if (ws_size < WS_NEED) { fprintf(stderr, "workspace too small: %zu < %zu\n", ws_size, (size_t)WS_NEED); return; }
  Params p;
  memset(&p, 0, sizeof(p));
  p.x = (const float*)d_in[0]; p.mem = (const float*)d_in[1]; p.pos = (const int*)d_in[2];
  p.norm_g = (const float*)d_in[3]; p.mem_norm_g = (const float*)d_in[4]; p.w_mem_kv = (const float*)d_in[5];
  p.w_in_mla = (const float*)d_in[6]; p.q_norm_g = (const float*)d_in[7]; p.kv_norm_g = (const float*)d_in[8];
  p.w_uq = (const float*)d_in[9]; p.w_ukv = (const float*)d_in[10]; p.w_in_rwkv = (const float*)d_in[11];
  p.mu = (const float*)d_in[12]; p.w0 = (const float*)d_in[13]; p.w2 = (const float*)d_in[14]; p.a0 = (const float*)d_in[15];
  p.a2 = (const float*)d_in[16]; p.k_k = (const float*)d_in[17]; p.k_a = (const float*)d_in[18]; p.r_k = (const float*)d_in[19];
  p.gn_w = (const float*)d_in[20]; p.gn_b = (const float*)d_in[21]; p.w_out = (const float*)d_in[22]; p.final_g = (const float*)d_in[23];
  p.out = (float*)d_out; p.ws = (char*)d_ws;
  static int grid_blocks = 0;
  if (!grid_blocks) {
    int dev = 0, cus = 0, per_cu = 0;
    hipGetDevice(&dev);
    hipDeviceGetAttribute(&cus, hipDeviceAttributeMultiprocessorCount, dev);
    hipOccupancyMaxActiveBlocksPerMultiprocessor(&per_cu, hybrid_megakernel, 256, 0);
    if (per_cu > 2) per_cu = 2;
    if (per_cu < 1) per_cu = 1;
    grid_blocks = cus * per_cu;
  }
#if MULTI_LAUNCH
  for (int s = 0; s < NSTEPS; ++s) hipLaunchKernelGGL(hybrid_megakernel, dim3(grid_blocks), dim3(256), 0, stream, p, s, s + 1, 0);
#else
  int s_lo = 0, s_hi = NSTEPS, coop = 1;
  void* args[] = {&p, &s_lo, &s_hi, &coop};
  hipError_t e = hipLaunchCooperativeKernel((void*)hybrid_megakernel, dim3(grid_blocks), dim3(256), args, 0, stream);
  if (e != hipSuccess) fprintf(stderr, "cooperative launch failed: %s (grid %d)\n", hipGetErrorString(e), grid_blocks);
#endif
}
```

```cpp
#include <hip/hip_runtime.h>
#include <hip/hip_cooperative_groups.h>
#include <cstdio>
#include <cstring>
namespace cg = cooperative_groups;

#define PROBE_MASK 0
#ifndef MULTI_LAUNCH
#define MULTI_LAUNCH 0
#endif

#define DI __device__ __forceinline__
typedef unsigned short u16;
typedef __attribute__((ext_vector_type(8))) short bf16x8;
typedef __attribute__((ext_vector_type(16))) float f32x16;
typedef __attribute__((ext_vector_type(2))) __bf16 bf2_t;
typedef __attribute__((ext_vector_type(2))) float f2_t;
typedef __attribute__((ext_vector_type(4))) unsigned u32x4;
typedef __attribute__((ext_vector_type(2))) unsigned u32x2;
#define MFMA32(a, b, c) __builtin_amdgcn_mfma_f32_32x32x16_bf16((a), (b), (c), 0, 0, 0)

constexpr int SEQ = 8192, TC = 16384;
constexpr int LDU_M = 3264, LDU_R = 7296;
constexpr int M_CQ = 0, M_CKV = 384, M_KR = 640, M_QM = 704, M_GATE = 1216;
constexpr int R_R = 0, R_K = 1536, R_V = 3072, R_WD = 4608, R_AD = 4672, R_QM = 4736, R_GATE = 5248;
constexpr int SHIFTW = 4736;

constexpr size_t OFF_WT_MEMKV = 0;
constexpr size_t OFF_WT_INMLA = OFF_WT_MEMKV + 4ull * 1024 * 1024 * 2;
constexpr size_t OFF_WT_UQ    = OFF_WT_INMLA + 2ull * 3328 * 1024 * 2;
constexpr size_t OFF_WT_UKV   = OFF_WT_UQ + 2ull * 2304 * 384 * 2;
constexpr size_t OFF_WT_INRW  = OFF_WT_UKV + 2ull * 3072 * 256 * 2;
constexpr size_t OFF_WT_OUT   = OFF_WT_INRW + 2ull * 7296 * 1024 * 2;
constexpr size_t OFF_MEMH     = OFF_WT_OUT + 4ull * 1024 * 2048 * 2;
constexpr size_t OFF_MEMK     = OFF_MEMH + 4ull * 1024 * 1024 * 2;
constexpr size_t OFF_MEMVT    = OFF_MEMK + 4ull * 4 * 4 * 256 * 128 * 2;
constexpr size_t OFF_COS      = OFF_MEMVT + 4ull * 4 * 4 * 256 * 128 * 2;
constexpr size_t OFF_SIN      = OFF_COS + 32768ull * 32 * 4;
constexpr size_t OFF_CNT      = OFF_SIN + 32768ull * 32 * 4;
constexpr size_t OFF_STATE    = OFF_CNT + 256;
constexpr size_t OFF_BND      = OFF_STATE + 96ull * 4096 * 4;
constexpr size_t OFF_H        = OFF_BND + 4ull * 4736 * 2 + 128;
constexpr size_t OFF_R        = OFF_H + 16384ull * 1024 * 2;
constexpr size_t OFF_U        = OFF_R;
constexpr size_t OFF_Q        = OFF_R + 16384ull * 3264 * 2;
constexpr size_t OFF_K        = OFF_Q + 2ull * 12 * 8192 * 192 * 2;
constexpr size_t OFF_VT       = OFF_K + 2ull * 12 * 8192 * 192 * 2;
constexpr size_t OFF_YR       = OFF_R + 16384ull * 7296 * 2;
constexpr size_t OFF_BV       = OFF_YR + 16384ull * 1536 * 2;
constexpr size_t OFF_ST       = OFF_BV + 16384ull * 1536 * 2;
constexpr size_t OFF_BS       = OFF_ST + 16384ull * 24 * 4 * 4;
constexpr size_t WS_NEED      = OFF_BS + 16384ull * 24 * 4;

constexpr int SMEM_BYTES = 110592;

struct Params {
  const float *x, *mem; const int* pos;
  const float *norm_g, *mem_norm_g, *w_mem_kv, *w_in_mla, *q_norm_g, *kv_norm_g, *w_uq, *w_ukv, *w_in_rwkv;
  const float *mu, *w0, *w2, *a0, *a2, *k_k, *k_a, *r_k, *gn_w, *gn_b, *w_out, *final_g;
  float* out; char* ws;
};

DI int otid() { int t = threadIdx.x; asm volatile("" : "+v"(t)); return t; }
DI float bf2f(unsigned v) { return __uint_as_float(v << 16); }
DI unsigned pack2(float a, float b) { f2_t v = {a, b}; bf2_t r = __builtin_convertvector(v, bf2_t); return __builtin_bit_cast(unsigned, r); }
DI u16 f2bf(float a) { return (u16)(pack2(a, 0.f) & 0xffffu); }
DI float ex2(float x) { return __builtin_amdgcn_exp2f(x); }
DI float fexp(float x) { return __builtin_amdgcn_exp2f(x * 1.4426950408889634f); }
DI float frcp(float x) { return __builtin_amdgcn_rcpf(x); }
DI float silu(float g) { return g * frcp(1.f + fexp(-g)); }
DI float wave_sum(float v) { for (int o = 32; o > 0; o >>= 1) v += __shfl_xor(v, o); return v; }
DI int crow(int reg, int h) { return (reg & 3) + 8 * (reg >> 2) + 4 * h; }
DI float dppf(float x, const int ctrl_sel) {
  int xi;
  if (ctrl_sel == 0) xi = __builtin_amdgcn_update_dpp(0, __float_as_int(x), 0xB1, 0xf, 0xf, true);
  else if (ctrl_sel == 1) xi = __builtin_amdgcn_update_dpp(0, __float_as_int(x), 0x4E, 0xf, 0xf, true);
  else xi = __builtin_amdgcn_update_dpp(0, __float_as_int(x), 0x141, 0xf, 0xf, true);
  return __int_as_float(xi);
}
DI float red4(float x) { x += dppf(x, 0); x += dppf(x, 1); return x; }
DI float red8(float x) { x += dppf(x, 0); x += dppf(x, 1); x += dppf(x, 2); return x; }
DI int gtok(bool rw, int c, int lr) { return rw ? ((lr >> 12) * 8192 + c * 4096 + (lr & 4095)) : (c * 16384 + lr); }
DI void unpack8(const uint4& v, float* f) {
  f[0] = bf2f(v.x & 0xffffu); f[1] = bf2f(v.x >> 16); f[2] = bf2f(v.y & 0xffffu); f[3] = bf2f(v.y >> 16);
  f[4] = bf2f(v.z & 0xffffu); f[5] = bf2f(v.z >> 16); f[6] = bf2f(v.w & 0xffffu); f[7] = bf2f(v.w >> 16);
}
DI uint4 pack8(const float* f) { uint4 v; v.x = pack2(f[0], f[1]); v.y = pack2(f[2], f[3]); v.z = pack2(f[4], f[5]); v.w = pack2(f[6], f[7]); return v; }

DI void transpose_tile(const float* __restrict__ src, u16* __restrict__ dst, int K, int N, int tk, int tn, float* tile) {
  const int tid = otid();
  __syncthreads();
#pragma unroll
  for (int i = 0; i < 4; ++i) {
    int kr = (tid >> 4) + 16 * i, nc = (tid & 15) * 4;
    float4 v = *(const float4*)(src + (size_t)(tk * 64 + kr) * N + tn * 64 + nc);
    tile[kr * 65 + nc] = v.x; tile[kr * 65 + nc + 1] = v.y; tile[kr * 65 + nc + 2] = v.z; tile[kr * 65 + nc + 3] = v.w;
  }
  __syncthreads();
#pragma unroll
  for (int i = 0; i < 2; ++i) {
    int n = (tid >> 3) + 32 * i, kc = (tid & 7) * 8;
    float f[8];
#pragma unroll
    for (int e = 0; e < 8; ++e) f[e] = tile[(kc + e) * 65 + n];
    *(uint4*)(dst + (size_t)(tn * 64 + n) * K + tk * 64 + kc) = pack8(f);
  }
}

DI void rms_row_bf16(const float* __restrict__ src, const float* __restrict__ g, u16* __restrict__ dst, int lane) {
  float4 v[4]; float ss = 0.f;
#pragma unroll
  for (int i = 0; i < 4; ++i) { v[i] = *(const float4*)(src + i * 256 + lane * 4); ss += v[i].x * v[i].x + v[i].y * v[i].y + v[i].z * v[i].z + v[i].w * v[i].w; }
  ss = wave_sum(ss);
  float rs = rsqrtf(ss * (1.f / 1024.f) + 1e-6f);
#pragma unroll
  for (int i = 0; i < 4; ++i) {
    float4 gg = *(const float4*)(g + i * 256 + lane * 4);
    uint2 o; o.x = pack2(v[i].x * rs * gg.x, v[i].y * rs * gg.y); o.y = pack2(v[i].z * rs * gg.z, v[i].w * rs * gg.w);
    *(uint2*)(dst + i * 256 + lane * 4) = o;
  }
}

DI void phase_prep(const Params& p, char* smem) {
  const int tid = otid(), G = gridDim.x, bid = blockIdx.x;
  char* ws = p.ws;
  if (bid == 0 && tid < 64) ((int*)(ws + OFF_CNT))[tid] = 0;
  float* tile = (float*)smem;
  for (int g0 = bid; g0 < 9168; g0 += G) {
    int g = g0;
    const float* src = nullptr; u16* dst = nullptr; int K = 0, N = 0; size_t dstr = 0;
    if (g < 1024) { src = p.w_mem_kv; dst = (u16*)(ws + OFF_WT_MEMKV); K = 1024; N = 1024; dstr = 1024ull * 1024; }
    else if ((g -= 1024) < 1632) { src = p.w_in_mla; dst = (u16*)(ws + OFF_WT_INMLA); K = 1024; N = 3264; dstr = 3328ull * 1024; }
    else if ((g -= 1632) < 432) { src = p.w_uq; dst = (u16*)(ws + OFF_WT_UQ); K = 384; N = 2304; dstr = 2304ull * 384; }
    else if ((g -= 432) < 384) { src = p.w_ukv; dst = (u16*)(ws + OFF_WT_UKV); K = 256; N = 3072; dstr = 3072ull * 256; }
    else if ((g -= 384) < 3648) { src = p.w_in_rwkv; dst = (u16*)(ws + OFF_WT_INRW); K = 1024; N = 7296; dstr = 7296ull * 1024; }
    else { g -= 3648; src = p.w_out; dst = (u16*)(ws + OFF_WT_OUT); K = 2048; N = 1024; dstr = 1024ull * 2048; }
    int ntn = N >> 6, per = (K >> 6) * ntn;
    int m = g / per, t = g - m * per;
    int tk = t / ntn, tn = t - tk * ntn;
    transpose_tile(src + (size_t)m * K * N, dst + (size_t)m * dstr, K, N, tk, tn, tile);
  }
  for (int i = bid * 256 + tid; i < 2 * 64 * 1024 / 8; i += G * 256) {
    int m = i / (64 * 1024 / 8), r = i - m * (64 * 1024 / 8);
    uint4 z; z.x = z.y = z.z = z.w = 0u;
    *(uint4*)((u16*)(ws + OFF_WT_INMLA) + (size_t)m * 3328 * 1024 + 3264ull * 1024 + (size_t)r * 8) = z;
  }
  float* cs = (float*)(ws + OFF_COS); float* sn = (float*)(ws + OFF_SIN);
  for (int i = bid * 256 + tid; i < 32768 * 32; i += G * 256) {
    int tk = i >> 5, pi = i & 31;
    float inv_freq = (float)exp2(-(double)(2 * pi) / 64.0 * 13.287712379549449);
    float ang = (float)p.pos[tk] * inv_freq;
    double rev = (double)ang * 0.15915494309189535;
    float fr = (float)(rev - rint(rev));
    cs[i] = __builtin_amdgcn_cosf(fr); sn[i] = __builtin_amdgcn_sinf(fr);
  }
  const int w = tid >> 6, lane = tid & 63;
  for (int row = bid * 4 + w; row < 4096; row += G * 4) {
    int L = row >> 10, m = row & 1023;
    rms_row_bf16(p.mem + (size_t)m * 1024, p.mem_norm_g + L * 1024, (u16*)(ws + OFF_MEMH) + (size_t)row * 1024, lane);
  }
}

DI void phase_norm(const Params& p, int L, int c) {
  const int tid = otid(), w = tid >> 6, lane = tid & 63;
  const bool rw = L & 1;
  const float* xs = (L == 0) ? p.x : p.out;
  u16* H = (u16*)(p.ws + OFF_H);
  for (int lr = blockIdx.x * 4 + w; lr < TC; lr += gridDim.x * 4) {
    int gt = gtok(rw, c, lr);
    rms_row_bf16(xs + (size_t)gt * 1024, p.norm_g + L * 1024, H + (size_t)lr * 1024, lane);
  }
}

DI void phase_final_norm(const Params& p) {
  const int tid = otid(), w = tid >> 6, lane = tid & 63;
  for (int row = blockIdx.x * 4 + w; row < 32768; row += gridDim.x * 4) {
    float* xr = p.out + (size_t)row * 1024;
    float4 v[4]; float ss = 0.f;
#pragma unroll
    for (int i = 0; i < 4; ++i) { v[i] = *(const float4*)(xr + i * 256 + lane * 4); ss += v[i].x * v[i].x + v[i].y * v[i].y + v[i].z * v[i].z + v[i].w * v[i].w; }
    ss = wave_sum(ss);
    float rs = rsqrtf(ss * (1.f / 1024.f) + 1e-6f);
#pragma unroll
    for (int i = 0; i < 4; ++i) {
      float4 gg = *(const float4*)(p.final_g + i * 256 + lane * 4);
      float4 o; o.x = v[i].x * rs * gg.x; o.y = v[i].y * rs * gg.y; o.z = v[i].z * rs * gg.z; o.w = v[i].w * rs * gg.w;
      *(float4*)(xr + i * 256 + lane * 4) = o;
    }
  }
}

template <int TJ, class Epi>
DI void gemm_phase(const u16* __restrict__ A, size_t strideAz, int lda, const u16* __restrict__ Bt, size_t strideBz, int ldb,
                   int Z, int Mt, int Nt, int GM, int K, char* smem, const Epi& epi) {
  constexpr int BN = 64 * TJ;
  constexpr int NB = BN / 32;
  const int tid = otid(), w = tid >> 6, lane = tid & 63, r = lane & 31, h = lane >> 5;
  const int wm = w >> 1, wn = w & 1;
  u16* As = (u16*)smem;
  u16* Bs = As + 2 * 256 * 72;
  const int G = gridDim.x, per = Mt * Nt, total = Z * per;
  const int lrow = tid >> 3, lcc = (tid & 7) * 8;
  for (int base = 0; base < total; base += G) {
    const int t = blockIdx.x;
    const int q = base + (((G & 7) == 0) ? ((t & 7) * (G >> 3) + (t >> 3)) : t);
    if (q >= total) continue;
    const int z = q / per, qq = q - z * per;
    const int grp = qq / (GM * Nt), within = qq - grp * GM * Nt;
    const int mt = grp * GM + (within % GM), nt = within / GM;
    const u16* Ag = A + z * strideAz + (size_t)(mt * 256 + lrow) * lda + lcc;
    const u16* Bg = Bt + z * strideBz + (size_t)(nt * BN + lrow) * ldb + lcc;
    u32x4 ra[8], rb[NB];
    f32x16 acc[4][TJ];
#pragma unroll
    for (int i = 0; i < 4; ++i)
#pragma unroll
      for (int j = 0; j < TJ; ++j)
#pragma unroll
        for (int e = 0; e < 16; ++e) acc[i][j][e] = 0.f;
    __syncthreads();
#pragma unroll
    for (int i = 0; i < 8; ++i) ra[i] = *(const u32x4*)(Ag + (size_t)(32 * i) * lda);
#pragma unroll
    for (int i = 0; i < NB; ++i) rb[i] = *(const u32x4*)(Bg + (size_t)(32 * i) * ldb);
#pragma unroll
    for (int i = 0; i < 8; ++i) *(u32x4*)(As + (lrow + 32 * i) * 72 + lcc) = ra[i];
#pragma unroll
    for (int i = 0; i < NB; ++i) *(u32x4*)(Bs + (lrow + 32 * i) * 72 + lcc) = rb[i];
    __syncthreads();
    const int nk = K >> 6;
    for (int kt = 0; kt < nk; ++kt) {
      const int buf = kt & 1;
      if (kt + 1 < nk) {
#pragma unroll
        for (int i = 0; i < 8; ++i) ra[i] = *(const u32x4*)(Ag + (size_t)(32 * i) * lda + (kt + 1) * 64);
#pragma unroll
        for (int i = 0; i < NB; ++i) rb[i] = *(const u32x4*)(Bg + (size_t)(32 * i) * ldb + (kt + 1) * 64);
      }
      __builtin_amdgcn_sched_barrier(0);
      const u16* as = As + buf * 256 * 72 + (128 * wm + r) * 72 + 8 * h;
      const u16* bs = Bs + buf * BN * 72 + (32 * TJ * wn + r) * 72 + 8 * h;
#pragma unroll
      for (int ks = 0; ks < 4; ++ks) {
        bf16x8 af[4], bfr[TJ];
#pragma unroll
        for (int i = 0; i < 4; ++i) af[i] = *(const bf16x8*)(as + (32 * i) * 72 + 16 * ks);
#pragma unroll
        for (int j = 0; j < TJ; ++j) bfr[j] = *(const bf16x8*)(bs + (32 * j) * 72 + 16 * ks);
#pragma unroll
        for (int i = 0; i < 4; ++i)
#pragma unroll
          for (int j = 0; j < TJ; ++j) acc[i][j] = MFMA32(af[i], bfr[j], acc[i][j]);
      }
      __builtin_amdgcn_sched_barrier(0);
      if (kt + 1 < nk) {
        u16* ad = As + (buf ^ 1) * 256 * 72; u16* bd = Bs + (buf ^ 1) * BN * 72;
#pragma unroll
        for (int i = 0; i < 8; ++i) *(u32x4*)(ad + (lrow + 32 * i) * 72 + lcc) = ra[i];
#pragma unroll
        for (int i = 0; i < NB; ++i) *(u32x4*)(bd + (lrow + 32 * i) * 72 + lcc) = rb[i];
      }
      __syncthreads();
    }
#pragma unroll
    for (int i = 0; i < 4; ++i)
#pragma unroll
      for (int j = 0; j < TJ; ++j) epi(z, mt * 256 + 128 * wm + 32 * i, nt * BN + 32 * TJ * wn + 32 * j + r, h, acc[i][j]);
  }
}

struct EpiStoreBf16 {
  u16* C; int ldc; int ncols; bool dry;
  DI void operator()(int z, int rowbase, int col, int h, const f32x16& a) const {
    if (col >= ncols || dry) return;
#pragma unroll
    for (int e = 0; e < 16; ++e) C[(size_t)(rowbase + crow(e, h)) * ldc + col] = f2bf(a[e]);
  }
};
struct EpiResid {
  const float* xin; float* xout; bool rw; int c; bool dry;
  DI void operator()(int z, int rowbase, int col, int h, const f32x16& a) const {
    if (dry) return;
#pragma unroll
    for (int e = 0; e < 16; ++e) {
      int gt = gtok(rw, c, rowbase + crow(e, h));
      size_t o = (size_t)gt * 1024 + col;
      xout[o] = xin[o] + a[e];
    }
  }
};
struct EpiUQ {
  u16* Q; const float* cs; const float* sn; int c; bool dry;
  DI void operator()(int z, int rowbase, int col, int h, const f32x16& a) const {
    if (dry) return;
    const int head = col / 192, d = col - head * 192;
    const bool rope = d >= 128;
#pragma unroll
    for (int e = 0; e < 16; ++e) {
      int lr = rowbase + crow(e, h); int lb = lr >> 13, s = lr & 8191;
      float v = a[e];
      if (rope) {
        float o = __shfl_xor(v, 1);
        int ti = (c * 16384 + lr) * 32 + ((d - 128) >> 1);
        float cc = cs[ti], ss = sn[ti];
        v = (d & 1) ? (o * ss + v * cc) : (v * cc - o * ss);
      }
      Q[((size_t)(lb * 12 + head) * 8192 + s) * 192 + d] = f2bf(v);
    }
  }
};
struct EpiUKV {
  u16* Kb; u16* Vt; bool dry;
  DI void operator()(int z, int rowbase, int col, int h, const f32x16& a) const {
    if (dry) return;
    const int head = col >> 8, d = col & 255;
    if (d < 128) {
#pragma unroll
      for (int e = 0; e < 16; ++e) {
        int lr = rowbase + crow(e, h); int lb = lr >> 13, s = lr & 8191;
        Kb[((size_t)(lb * 12 + head) * 8192 + s) * 192 + d] = f2bf(a[e]);
      }
    } else {
#pragma unroll
      for (int g = 0; g < 4; ++g) {
        int lr = rowbase + 8 * g + 4 * h; int lb = lr >> 13, s = lr & 8191;
        uint2 pk; pk.x = pack2(a[4 * g], a[4 * g + 1]); pk.y = pack2(a[4 * g + 2], a[4 * g + 3]);
        *(uint2*)(Vt + ((size_t)(lb * 12 + head) * 128 + (d - 128)) * 8192 + s) = pk;
      }
    }
  }
};
struct EpiMemKV {
  u16* MK; u16* MVt;
  DI void operator()(int z, int rowbase, int col, int h, const f32x16& a) const {
    if (col < 512) {
      const int xh = col >> 7, d = col & 127;
#pragma unroll
      for (int e = 0; e < 16; ++e) {
        int m = rowbase + crow(e, h); int b = m >> 8, mi = m & 255;
        MK[((size_t)((z * 4 + b) * 4 + xh) * 256 + mi) * 128 + d] = f2bf(a[e]);
      }
    } else {
      const int n = col - 512, xh = n >> 7, d = n & 127;
#pragma unroll
      for (int g = 0; g < 4; ++g) {
        int m = rowbase + 8 * g + 4 * h; int b = m >> 8, mi = m & 255;
        uint2 pk; pk.x = pack2(a[4 * g], a[4 * g + 1]); pk.y = pack2(a[4 * g + 2], a[4 * g + 3]);
        *(uint2*)(MVt + ((size_t)((z * 4 + b) * 4 + xh) * 128 + d) * 256 + mi) = pk;
      }
    }
  }
};

DI void phase_kvprep(const Params& p, int L, int c) {
  const int tid = otid(), w = tid >> 6, lane = tid & 63;
  const int j = L >> 1;
  u16* U = (u16*)(p.ws + OFF_U); u16* Kb = (u16*)(p.ws + OFF_K);
  const float* cs = (const float*)(p.ws + OFF_COS); const float* sn = (const float*)(p.ws + OFF_SIN);
  for (int lr = blockIdx.x * 4 + w; lr < TC; lr += gridDim.x * 4) {
    u16* row = U + (size_t)lr * LDU_M;
    float fq[8], fk[8]; float sq = 0.f, sk = 0.f;
    if (lane < 48) { uint4 v = *(const uint4*)(row + M_CQ + lane * 8); unpack8(v, fq);
#pragma unroll
      for (int e = 0; e < 8; ++e) sq += fq[e] * fq[e]; }
    if (lane < 32) { uint4 v = *(const uint4*)(row + M_CKV + lane * 8); unpack8(v, fk);
#pragma unroll
      for (int e = 0; e < 8; ++e) sk += fk[e] * fk[e]; }
    sq = wave_sum(sq); sk = wave_sum(sk);
    float rq = rsqrtf(sq * (1.f / 384.f) + 1e-6f), rk = rsqrtf(sk * (1.f / 256.f) + 1e-6f);
    if (lane < 48) {
      const float* g = p.q_norm_g + j * 384 + lane * 8;
#pragma unroll
      for (int e = 0; e < 8; ++e) fq[e] = fq[e] * rq * g[e];
      *(uint4*)(row + M_CQ + lane * 8) = pack8(fq);
    }
    if (lane < 32) {
      const float* g = p.kv_norm_g + j * 256 + lane * 8;
#pragma unroll
      for (int e = 0; e < 8; ++e) fk[e] = fk[e] * rk * g[e];
      *(uint4*)(row + M_CKV + lane * 8) = pack8(fk);
    }
    if (lane < 8) {
      float f[8], o[8]; uint4 v = *(const uint4*)(row + M_KR + lane * 8); unpack8(v, f);
      int gt = c * 16384 + lr;
#pragma unroll
      for (int i = 0; i < 4; ++i) {
        float cc = cs[gt * 32 + lane * 4 + i], ss = sn[gt * 32 + lane * 4 + i];
        o[2 * i] = f[2 * i] * cc - f[2 * i + 1] * ss; o[2 * i + 1] = f[2 * i] * ss + f[2 * i + 1] * cc;
      }
      uint4 pk = pack8(o);
      int lb = lr >> 13, s = lr & 8191;
#pragma unroll
      for (int hd = 0; hd < 12; ++hd) *(uint4*)(Kb + ((size_t)(lb * 12 + hd) * 8192 + s) * 192 + 128 + lane * 8) = pk;
    }
  }
}

template <int DQK>
DI void attn_item(const u16* __restrict__ Qp, int ldq, const u16* __restrict__ Kp, const u16* __restrict__ Vtp, int ldv,
                  int nkt, int q0, bool causal, float c, u16* Yp, int ldy, char* smem, bool dry) {
  constexpr int KLD = DQK + 8;
  constexpr int NKC = DQK * 64 / 8 / 256;
  constexpr int NKS = DQK / 16;
  constexpr int CPR = DQK / 8;
  u16* Ks = (u16*)smem;
  u16* Vs = Ks + 64 * KLD;
  const int tid = otid(), w = tid >> 6, lane = tid & 63, r = lane & 31, h = lane >> 5;
  bf16x8 qf[NKS];
  {
    const u16* qrow = Qp + (size_t)(32 * w + r) * ldq + 8 * h;
#pragma unroll
    for (int ks = 0; ks < NKS; ++ks) qf[ks] = *(const bf16x8*)(qrow + 16 * ks);
  }
  f32x16 o[4];
#pragma unroll
  for (int dt = 0; dt < 4; ++dt)
#pragma unroll
    for (int e = 0; e < 16; ++e) o[dt][e] = 0.f;
  float m = -INFINITY, l = 0.f;
  u32x4 kst[NKC], vst[4];
  const int vd = tid >> 3, vc8 = tid & 7;
  {
#pragma unroll
    for (int i = 0; i < NKC; ++i) kst[i] = *(const u32x4*)(Kp + (size_t)(tid + 256 * i) * 8);
#pragma unroll
    for (int i = 0; i < 4; ++i) vst[i] = *(const u32x4*)(Vtp + (size_t)(vd + 32 * i) * ldv + vc8 * 8);
  }
  const int qmin = q0 + 32 * w;
  for (int kt = 0; kt < nkt; ++kt) {
    __syncthreads();
#pragma unroll
    for (int i = 0; i < NKC; ++i) { int id = tid + 256 * i; int row = id / CPR, cc = id - row * CPR; *(u32x4*)(Ks + row * KLD + cc * 8) = kst[i]; }
#pragma unroll
    for (int i = 0; i < 4; ++i) {
      u16* dst = Vs + (vd + 32 * i) * 72 + 16 * (vc8 >> 1) + 4 * (vc8 & 1);
      u32x2 lo = {vst[i].x, vst[i].y}, hi = {vst[i].z, vst[i].w};
      *(u32x2*)dst = lo; *(u32x2*)(dst + 8) = hi;
    }
    __syncthreads();
    if (kt + 1 < nkt) {
      const u16* kg = Kp + (size_t)(kt + 1) * 64 * DQK;
#pragma unroll
      for (int i = 0; i < NKC; ++i) kst[i] = *(const u32x4*)(kg + (size_t)(tid + 256 * i) * 8);
#pragma unroll
      for (int i = 0; i < 4; ++i) vst[i] = *(const u32x4*)(Vtp + (size_t)(vd + 32 * i) * ldv + (kt + 1) * 64 + vc8 * 8);
    }
    if (causal && kt * 64 > qmin + 31) continue;
    f32x16 s0, s1;
#pragma unroll
    for (int e = 0; e < 16; ++e) { s0[e] = 0.f; s1[e] = 0.f; }
    {
      const u16* k0 = Ks + r * KLD + 8 * h;
#pragma unroll
      for (int ks = 0; ks < NKS; ++ks) {
        bf16x8 a0 = *(const bf16x8*)(k0 + 16 * ks), a1 = *(const bf16x8*)(k0 + 32 * KLD + 16 * ks);
        s0 = MFMA32(a0, qf[ks], s0); s1 = MFMA32(a1, qf[ks], s1);
        if ((ks & 1) == 1) __builtin_amdgcn_sched_barrier(0);
      }
    }
    if (causal && kt * 64 + 63 > qmin) {
      const int qi = qmin + r;
#pragma unroll
      for (int e = 0; e < 16; ++e) {
        int key = kt * 64 + crow(e, h);
        if (key > qi) s0[e] = -INFINITY;
        if (key + 32 > qi) s1[e] = -INFINITY;
      }
    }
    float mx = fmaxf(s0[0], s1[0]);
#pragma unroll
    for (int e = 1; e < 16; ++e) mx = fmaxf(mx, fmaxf(s0[e], s1[e]));
    mx = fmaxf(mx, __shfl_xor(mx, 32));
    const float mn = fmaxf(m, mx);
    const float alpha = ex2((m - mn) * c);
    const float mc = mn * c;
    m = mn;
    l *= alpha;
#pragma unroll
    for (int dt = 0; dt < 4; ++dt)
#pragma unroll
      for (int e = 0; e < 16; ++e) o[dt][e] *= alpha;
    float ps = 0.f;
#pragma unroll
    for (int e = 0; e < 16; ++e) { s0[e] = ex2(fmaf(s0[e], c, -mc)); s1[e] = ex2(fmaf(s1[e], c, -mc)); ps += s0[e] + s1[e]; }
    l += ps;
    bf16x8 pf[4];
    {
      u32x4 t;
      t.x = pack2(s0[0], s0[1]); t.y = pack2(s0[2], s0[3]); t.z = pack2(s0[4], s0[5]); t.w = pack2(s0[6], s0[7]); pf[0] = __builtin_bit_cast(bf16x8, t);
      t.x = pack2(s0[8], s0[9]); t.y = pack2(s0[10], s0[11]); t.z = pack2(s0[12], s0[13]); t.w = pack2(s0[14], s0[15]); pf[1] = __builtin_bit_cast(bf16x8, t);
      t.x = pack2(s1[0], s1[1]); t.y = pack2(s1[2], s1[3]); t.z = pack2(s1[4], s1[5]); t.w = pack2(s1[6], s1[7]); pf[2] = __builtin_bit_cast(bf16x8, t);
      t.x = pack2(s1[8], s1[9]); t.y = pack2(s1[10], s1[11]); t.z = pack2(s1[12], s1[13]); t.w = pack2(s1[14], s1[15]); pf[3] = __builtin_bit_cast(bf16x8, t);
    }
    {
      const u16* v0 = Vs + r * 72 + 8 * h;
#pragma unroll
      for (int kk = 0; kk < 4; ++kk)
#pragma unroll
        for (int dt = 0; dt < 4; ++dt) {
          bf16x8 a = *(const bf16x8*)(v0 + (32 * dt) * 72 + 16 * kk);
          o[dt] = MFMA32(a, pf[kk], o[dt]);
          if (dt == 3) __builtin_amdgcn_sched_barrier(0);
        }
    }
  }
  const float lt = l + __shfl_xor(l, 32);
  const float inv = 1.f / lt;
  if (dry) return;
  u16* yrow = Yp + (size_t)(32 * w + r) * ldy;
#pragma unroll
  for (int dt = 0; dt < 4; ++dt)
#pragma unroll
    for (int g = 0; g < 4; ++g) {
      const int d = 32 * dt + 8 * g + 4 * h;
      uint2 gv = *(const uint2*)(yrow + d);
      float g0 = bf2f(gv.x & 0xffffu), g1 = bf2f(gv.x >> 16), g2 = bf2f(gv.y & 0xffffu), g3 = bf2f(gv.y >> 16);
      uint2 ov;
      ov.x = pack2(o[dt][4 * g] * inv * silu(g0), o[dt][4 * g + 1] * inv * silu(g1));
      ov.y = pack2(o[dt][4 * g + 2] * inv * silu(g2), o[dt][4 * g + 3] * inv * silu(g3));
      *(uint2*)(yrow + d) = ov;
    }
}

DI void memattn_item(const Params& p, int L, int c, int item, char* smem, bool dry) {
  const bool rw = L & 1;
  const int ldu = rw ? LDU_R : LDU_M, oq = rw ? R_QM : M_QM, og = rw ? R_GATE : M_GATE;
  const int tile = item >> 2, xh = item & 3;
  const int b = gtok(rw, c, tile * 128) >> 13;
  u16* U = (u16*)(p.ws + OFF_U);
  const u16* MK = (const u16*)(p.ws + OFF_MEMK) + (size_t)((L * 4 + b) * 4 + xh) * 256 * 128;
  const u16* MV = (const u16*)(p.ws + OFF_MEMVT) + (size_t)((L * 4 + b) * 4 + xh) * 128 * 256;
  attn_item<128>(U + (size_t)tile * 128 * ldu + oq + xh * 128, ldu, MK, MV, 256, 4, 0, false,
                 0.08838834764831845f * 1.4426950408889634f, U + (size_t)tile * 128 * ldu + og + 1536 + xh * 128, ldu, smem, dry);
}

DI void phase_attn(const Params& p, int L, int c, char* smem, int* s_item, bool dry) {
  int* cnt = (int*)(p.ws + OFF_CNT) + (L * 2 + c) + (dry ? 8 : 0);
  u16* U = (u16*)(p.ws + OFF_U);
  const u16* Q = (const u16*)(p.ws + OFF_Q); const u16* Kb = (const u16*)(p.ws + OFF_K); const u16* Vt = (const u16*)(p.ws + OFF_VT);
  for (;;) {
    __syncthreads();
    if (otid() == 0) *s_item = atomicAdd(cnt, 1);
    __syncthreads();
    const int item = *s_item;
    if (item >= 1536 + 512) break;
    if (item < 1536) {
      const int qt = 63 - item / 24, bh = item % 24;
      const int lb = bh / 12, head = bh - lb * 12;
      const int q0 = qt * 128;
      attn_item<192>(Q + ((size_t)(lb * 12 + head) * 8192 + q0) * 192, 192, Kb + (size_t)(lb * 12 + head) * 8192 * 192,
                     Vt + (size_t)(lb * 12 + head) * 128 * 8192, 8192, 2 * (qt + 1), q0, true,
                     0.07216878364870323f * 1.4426950408889634f,
                     U + (size_t)(lb * 8192 + q0) * LDU_M + M_GATE + head * 128, LDU_M, smem, dry);
    } else {
      memattn_item(p, L, c, item - 1536, smem, dry);
    }
  }
}

DI void scan_item(const Params& p, int L, int c, int item, char* smem, bool dry) {
  const int tid = otid(), w = tid >> 6, lane = tid & 63, r = lane & 31, h = lane >> 5;
  const int j = L >> 1;
  const int b = item / 48, rem = item - b * 48, head = rem >> 1, half = rem & 1;
  float* PA  = (float*)smem;
  float* LO  = PA;
  float* Vst = PA + 32 * 5 * 64;
  float* Yst = Vst + 32 * 32;
  float* PRM = Yst + 32 * 32;
  float* BON = PRM + 10 * 64;
  u16* A1  = (u16*)(BON + 32);
  u16* W2t = A1 + 2 * 32 * 72;
  const u16* U = (const u16*)(p.ws + OFF_U);
  const u16* BND = (const u16*)(p.ws + OFF_BND);
  u16* YR = (u16*)(p.ws + OFF_YR); u16* BV = (u16*)(p.ws + OFF_BV);
  float* ST = (float*)(p.ws + OFF_ST); float* BS = (float*)(p.ws + OFF_BS);
  float* STATE = (float*)(p.ws + OFF_STATE);
  __syncthreads();
  if (tid < 64) {
    const float* mu = p.mu + j * SHIFTW;
    const int hc = head * 64 + tid;
    PRM[0 * 64 + tid] = mu[R_R + hc]; PRM[1 * 64 + tid] = mu[R_K + hc]; PRM[2 * 64 + tid] = mu[R_WD + tid]; PRM[3 * 64 + tid] = mu[R_AD + tid];
    PRM[4 * 64 + tid] = p.w0[j * 1536 + hc]; PRM[5 * 64 + tid] = p.a0[j * 1536 + hc]; PRM[6 * 64 + tid] = p.k_k[j * 1536 + hc];
    PRM[7 * 64 + tid] = p.k_a[j * 1536 + hc]; PRM[8 * 64 + tid] = p.r_k[j * 1536 + hc];
    PRM[9 * 64 + tid] = (tid < 32) ? mu[R_V + head * 64 + 32 * half + tid] : 0.f;
  }
  for (int e = tid; e < 8192; e += 256) {
    int arr = e >> 12, jj = (e >> 6) & 63, cc = e & 63;
    const float* src = (arr ? p.a2 : p.w2) + (size_t)j * 64 * 1536;
    W2t[(arr * 64 + cc) * 72 + jj] = f2bf(src[jj * 1536 + head * 64 + cc]);
  }
  const int rowl = lane >> 3, ks = lane & 7, row32 = 8 * w + rowl;
  float S[8];
  {
    float* sp = STATE + ((size_t)((b * 24 + head) * 64 + 32 * half + row32)) * 64 + 8 * ks;
#pragma unroll
    for (int i = 0; i < 8; ++i) S[i] = (c == 0) ? 0.f : sp[i];
  }
  const int tt = tid >> 3, cs = tid & 7;
  uint4 Rr_c, Rr_p, Rk_c, Rk_p, Rw_c, Rw_p, Ra_c, Ra_p, Rv_c, Rv_p;
  const uint4 zero4 = {0u, 0u, 0u, 0u};
  auto load_raw = [&](int tc) {
    const int lr = b * 4096 + tc * 32 + tt;
    const int s = c * 4096 + tc * 32 + tt;
    const u16* cur = U + (size_t)lr * LDU_R;
    const u16* prv = (s == 4096 && c == 1) ? (BND + (size_t)b * SHIFTW) : (cur - LDU_R);
    const bool hp = (s != 0);
    Rr_c = *(const uint4*)(cur + R_R + head * 64 + cs * 8);  Rr_p = hp ? *(const uint4*)(prv + R_R + head * 64 + cs * 8) : zero4;
    Rk_c = *(const uint4*)(cur + R_K + head * 64 + cs * 8);  Rk_p = hp ? *(const uint4*)(prv + R_K + head * 64 + cs * 8) : zero4;
    Rw_c = *(const uint4*)(cur + R_WD + cs * 8);             Rw_p = hp ? *(const uint4*)(prv + R_WD + cs * 8) : zero4;
    Ra_c = *(const uint4*)(cur + R_AD + cs * 8);             Ra_p = hp ? *(const uint4*)(prv + R_AD + cs * 8) : zero4;
    const int vo = R_V + head * 64 + 32 * half + (cs & 3) * 8;
    Rv_c = *(const uint4*)(cur + vo);                        Rv_p = hp ? *(const uint4*)(prv + vo) : zero4;
  };
  load_raw(0);
  __syncthreads();
  for (int tc = 0; tc < 128; ++tc) {
    const int lr = b * 4096 + tc * 32 + tt;
    float rm[8], km[8];
    {
      float cu[8], pv[8], t8[8];
      unpack8(Rr_c, cu); unpack8(Rr_p, pv);
#pragma unroll
      for (int e = 0; e < 8; ++e) rm[e] = cu[e] + (pv[e] - cu[e]) * PRM[0 * 64 + cs * 8 + e];
      unpack8(Rk_c, cu); unpack8(Rk_p, pv);
#pragma unroll
      for (int e = 0; e < 8; ++e) km[e] = cu[e] + (pv[e] - cu[e]) * PRM[1 * 64 + cs * 8 + e];
      unpack8(Rw_c, cu); unpack8(Rw_p, pv);
#pragma unroll
      for (int e = 0; e < 8; ++e) {
        float xw = cu[e] + (pv[e] - cu[e]) * PRM[2 * 64 + cs * 8 + e];
        float ee = ex2(xw * 2.8853900817779268f);
        t8[e] = 1.f - 2.f * frcp(ee + 1.f);
      }
      *(uint4*)(A1 + (0 * 32 + tt) * 72 + cs * 8) = pack8(t8);
      unpack8(Ra_c, cu); unpack8(Ra_p, pv);
#pragma unroll
      for (int e = 0; e < 8; ++e) t8[e] = cu[e] + (pv[e] - cu[e]) * PRM[3 * 64 + cs * 8 + e];
      *(uint4*)(A1 + (1 * 32 + tt) * 72 + cs * 8) = pack8(t8);
      unpack8(Rv_c, cu); unpack8(Rv_p, pv);
      if (cs < 4) {
#pragma unroll
        for (int e = 0; e < 8; ++e) Vst[tt * 32 + cs * 8 + e] = cu[e] + (pv[e] - cu[e]) * PRM[9 * 64 + cs * 8 + e];
      }
    }
    __syncthreads();
    {
      const int arr = w >> 1, nt = w & 1;
      f32x16 acc;
#pragma unroll
      for (int e = 0; e < 16; ++e) acc[e] = 0.f;
#pragma unroll
      for (int k4 = 0; k4 < 4; ++k4) {
        bf16x8 a = *(const bf16x8*)(A1 + (arr * 32 + r) * 72 + 16 * k4 + 8 * h);
        bf16x8 bw = *(const bf16x8*)(W2t + (arr * 64 + 32 * nt + r) * 72 + 16 * k4 + 8 * h);
        acc = MFMA32(a, bw, acc);
      }
#pragma unroll
      for (int e = 0; e < 16; ++e) LO[(arr * 32 + crow(e, h)) * 64 + 32 * nt + r] = acc[e];
    }
    __syncthreads();
    float lw[8], la[8];
    {
      float4 t0 = *(const float4*)(LO + (0 * 32 + tt) * 64 + cs * 8), t1 = *(const float4*)(LO + (0 * 32 + tt) * 64 + cs * 8 + 4);
      lw[0] = t0.x; lw[1] = t0.y; lw[2] = t0.z; lw[3] = t0.w; lw[4] = t1.x; lw[5] = t1.y; lw[6] = t1.z; lw[7] = t1.w;
      t0 = *(const float4*)(LO + (1 * 32 + tt) * 64 + cs * 8); t1 = *(const float4*)(LO + (1 * 32 + tt) * 64 + cs * 8 + 4);
      la[0] = t0.x; la[1] = t0.y; la[2] = t0.z; la[3] = t0.w; la[4] = t1.x; la[5] = t1.y; la[6] = t1.z; la[7] = t1.w;
    }
    __syncthreads();
    {
      float dec[8], kk[8], av[8], kp[8];
      float ssq = 0.f, bon = 0.f;
#pragma unroll
      for (int e = 0; e < 8; ++e) {
        const int ch = cs * 8 + e;
        float xx = -(lw[e] + PRM[4 * 64 + ch]);
        float sp = fmaxf(xx, 0.f) + __logf(1.f + fexp(-fabsf(xx)));
        float wv = -sp - 0.5f;
        dec[e] = fexp(-fexp(wv));
        float a = frcp(1.f + fexp(-(la[e] + PRM[5 * 64 + ch])));
        av[e] = a;
        kk[e] = km[e] * PRM[6 * 64 + ch];
        ssq += kk[e] * kk[e];
        kp[e] = km[e] * (1.f + (a - 1.f) * PRM[7 * 64 + ch]);
        bon += rm[e] * kp[e] * PRM[8 * 64 + ch];
      }
      ssq = red8(ssq); bon = red8(bon);
      const float inv = 1.f / fmaxf(sqrtf(ssq), 1e-12f);
      float nk[8], bb[8];
#pragma unroll
      for (int e = 0; e < 8; ++e) { float kn = kk[e] * inv; nk[e] = -kn; bb[e] = kn * av[e]; }
      float* pa = PA + tt * 320 + cs * 8;
      *(float4*)(pa) = make_float4(dec[0], dec[1], dec[2], dec[3]); *(float4*)(pa + 4) = make_float4(dec[4], dec[5], dec[6], dec[7]);
      *(float4*)(pa + 64) = make_float4(nk[0], nk[1], nk[2], nk[3]); *(float4*)(pa + 68) = make_float4(nk[4], nk[5], nk[6], nk[7]);
      *(float4*)(pa + 128) = make_float4(bb[0], bb[1], bb[2], bb[3]); *(float4*)(pa + 132) = make_float4(bb[4], bb[5], bb[6], bb[7]);
      *(float4*)(pa + 192) = make_float4(kp[0], kp[1], kp[2], kp[3]); *(float4*)(pa + 196) = make_float4(kp[4], kp[5], kp[6], kp[7]);
      *(float4*)(pa + 256) = make_float4(rm[0], rm[1], rm[2], rm[3]); *(float4*)(pa + 260) = make_float4(rm[4], rm[5], rm[6], rm[7]);
      if (cs == 0) BON[tt] = bon;
    }
    __syncthreads();
    if (tc + 1 < 128) load_raw(tc + 1);
#pragma unroll 2
    for (int t = 0; t < 32; ++t) {
      const float* pa = PA + t * 320 + ks * 8;
      const float4 d0 = *(const float4*)(pa), d1 = *(const float4*)(pa + 4);
      const float4 n0 = *(const float4*)(pa + 64), n1 = *(const float4*)(pa + 68);
      const float4 b0 = *(const float4*)(pa + 128), b1 = *(const float4*)(pa + 132);
      const float4 k0 = *(const float4*)(pa + 192), k1 = *(const float4*)(pa + 196);
      const float4 r0 = *(const float4*)(pa + 256), r1 = *(const float4*)(pa + 260);
      const float vv = Vst[t * 32 + row32];
      float sa = (S[0] * n0.x + S[1] * n0.y) + (S[2] * n0.z + S[3] * n0.w) + ((S[4] * n1.x + S[5] * n1.y) + (S[6] * n1.z + S[7] * n1.w));
      sa = red8(sa);
      S[0] = fmaf(sa, b0.x, fmaf(S[0], d0.x, vv * k0.x)); S[1] = fmaf(sa, b0.y, fmaf(S[1], d0.y, vv * k0.y));
      S[2] = fmaf(sa, b0.z, fmaf(S[2], d0.z, vv * k0.z)); S[3] = fmaf(sa, b0.w, fmaf(S[3], d0.w, vv * k0.w));
      S[4] = fmaf(sa, b1.x, fmaf(S[4], d1.x, vv * k1.x)); S[5] = fmaf(sa, b1.y, fmaf(S[5], d1.y, vv * k1.y));
      S[6] = fmaf(sa, b1.z, fmaf(S[6], d1.z, vv * k1.z)); S[7] = fmaf(sa, b1.w, fmaf(S[7], d1.w, vv * k1.w));
      float y = (S[0] * r0.x + S[1] * r0.y) + (S[2] * r0.z + S[3] * r0.w) + ((S[4] * r1.x + S[5] * r1.y) + (S[6] * r1.z + S[7] * r1.w));
      y = red8(y);
      if (ks == 0) Yst[t * 32 + row32] = y;
    }
    __syncthreads();
    {
      const int c4 = cs & 3;
      float y8[8], v8[8];
      float4 t0 = *(const float4*)(Yst + tt * 32 + c4 * 8), t1 = *(const float4*)(Yst + tt * 32 + c4 * 8 + 4);
      y8[0] = t0.x; y8[1] = t0.y; y8[2] = t0.z; y8[3] = t0.w; y8[4] = t1.x; y8[5] = t1.y; y8[6] = t1.z; y8[7] = t1.w;
      float sm = 0.f, sq = 0.f;
#pragma unroll
      for (int e = 0; e < 8; ++e) { sm += y8[e]; sq += y8[e] * y8[e]; }
      sm = red4(sm); sq = red4(sq);
      const float bon = BON[tt];
      t0 = *(const float4*)(Vst + tt * 32 + c4 * 8); t1 = *(const float4*)(Vst + tt * 32 + c4 * 8 + 4);
      v8[0] = t0.x * bon; v8[1] = t0.y * bon; v8[2] = t0.z * bon; v8[3] = t0.w * bon; v8[4] = t1.x * bon; v8[5] = t1.y * bon; v8[6] = t1.z * bon; v8[7] = t1.w * bon;
      if (cs < 4 && !dry) {
        const size_t o = (size_t)lr * 1536 + head * 64 + 32 * half + cs * 8;
        *(uint4*)(YR + o) = pack8(y8);
        *(uint4*)(BV + o) = pack8(v8);
        if (cs == 0) {
          float* stp = ST + ((size_t)(lr * 24 + head) * 2 + half) * 2;
          stp[0] = sm; stp[1] = sq;
        }
      }
    }
  }
  if (c == 0 && !dry) {
    float* sp = STATE + ((size_t)((b * 24 + head) * 64 + 32 * half + row32)) * 64 + 8 * ks;
#pragma unroll
    for (int i = 0; i < 8; ++i) sp[i] = S[i];
  }
}

DI void phase_scan(const Params& p, int L, int c, char* smem, int* s_item, bool dry) {
  for (int item = blockIdx.x; item < 192; item += gridDim.x) scan_item(p, L, c, item, smem, dry);
  int* cnt = (int*)(p.ws + OFF_CNT) + (L * 2 + c) + (dry ? 8 : 0);
  for (;;) {
    __syncthreads();
    if (otid() == 0) *s_item = atomicAdd(cnt, 1);
    __syncthreads();
    const int item = *s_item;
    if (item >= 512) break;
    memattn_item(p, L, c, item, smem, dry);
  }
}

DI void phase_finalize(const Params& p, int L, int c) {
  const int j = L >> 1;
  u16* U = (u16*)(p.ws + OFF_U);
  const u16* YR = (const u16*)(p.ws + OFF_YR); const u16* BV = (const u16*)(p.ws + OFF_BV);
  const float* ST = (const float*)(p.ws + OFF_ST);
  const int G = gridDim.x;
  for (int idx = blockIdx.x * 256 + otid(); idx < TC * 192; idx += G * 256) {
    const int lr = idx / 192, c8 = idx - lr * 192, ch0 = c8 * 8, head = ch0 >> 6;
    const float4 st = *(const float4*)(ST + (size_t)(lr * 24 + head) * 4);
    const float mean = (st.x + st.z) * (1.f / 64.f);
    const float var = (st.y + st.w) * (1.f / 64.f) - mean * mean;
    const float rstd = rsqrtf(fmaxf(var, 0.f) + 64e-5f);
    float y[8], bv[8], g[8], o[8];
    unpack8(*(const uint4*)(YR + (size_t)lr * 1536 + ch0), y);
    unpack8(*(const uint4*)(BV + (size_t)lr * 1536 + ch0), bv);
    u16* gp = U + (size_t)lr * LDU_R + R_GATE + ch0;
    unpack8(*(const uint4*)gp, g);
    const float* gw = p.gn_w + j * 1536 + ch0; const float* gb = p.gn_b + j * 1536 + ch0;
#pragma unroll
    for (int e = 0; e < 8; ++e) o[e] = ((y[e] - mean) * rstd * gw[e] + gb[e] + bv[e]) * silu(g[e]);
    *(uint4*)gp = pack8(o);
  }
  if (c == 0) {
    u16* BND = (u16*)(p.ws + OFF_BND);
    for (int idx = blockIdx.x * 256 + otid(); idx < 4 * (SHIFTW / 8); idx += G * 256) {
      const int b = idx / (SHIFTW / 8), cc = idx - b * (SHIFTW / 8);
      *(uint4*)(BND + (size_t)b * SHIFTW + cc * 8) = *(const uint4*)(U + (size_t)(b * 4096 + 4095) * LDU_R + cc * 8);
    }
  }
}

enum { PH_PREP = 0, PH_NORM, PH_GEMM_IN, PH_KVPREP, PH_GEMM_UP, PH_ATTN, PH_SCAN, PH_FINALIZE, PH_GEMM_OUT, PH_FINAL };
constexpr int NSTEPS = 46;

DI void decode_step(int step, int& ph, int& L, int& c) {
  if (step == 0) { ph = PH_PREP; L = 0; c = 0; return; }
  if (step == NSTEPS - 1) { ph = PH_FINAL; L = 0; c = 0; return; }
  int s = step - 1;
  int pr = s / 22, rem = s - pr * 22;
  if (rem < 12) {
    L = 2 * pr; c = rem / 6; int k = rem - c * 6;
    ph = (k == 0) ? PH_NORM : (k == 1) ? PH_GEMM_IN : (k == 2) ? PH_KVPREP : (k == 3) ? PH_GEMM_UP : (k == 4) ? PH_ATTN : PH_GEMM_OUT;
  } else {
    rem -= 12; L = 2 * pr + 1; c = rem / 5; int k = rem - c * 5;
    ph = (k == 0) ? PH_NORM : (k == 1) ? PH_GEMM_IN : (k == 2) ? PH_SCAN : (k == 3) ? PH_FINALIZE : PH_GEMM_OUT;
  }
}

DI void run_step(const Params& p, int ph, int L, int c, char* smem, int* s_item, bool dry) {
  char* ws = p.ws;
  const bool rw = L & 1;
  const int j = L >> 1;
  switch (ph) {
    case PH_PREP: phase_prep(p, smem); break;
    case PH_NORM:
      phase_norm(p, L, c);
      if (L == 0 && c == 0) {
        EpiMemKV epi{(u16*)(ws + OFF_MEMK), (u16*)(ws + OFF_MEMVT)};
        gemm_phase<2>((const u16*)(ws + OFF_MEMH), 1024ull * 1024, 1024, (const u16*)(ws + OFF_WT_MEMKV), 1024ull * 1024, 1024, 4, 4, 8, 4, 1024, smem, epi);
      }
      break;
    case PH_GEMM_IN:
      if (!rw) {
        EpiStoreBf16 epi{(u16*)(ws + OFF_U), LDU_M, LDU_M, dry};
        gemm_phase<2>((const u16*)(ws + OFF_H), 0, 1024, (const u16*)(ws + OFF_WT_INMLA) + (size_t)j * 3328 * 1024, 0, 1024, 1, 64, 26, 8, 1024, smem, epi);
      } else {
        EpiStoreBf16 epi{(u16*)(ws + OFF_U), LDU_R, LDU_R, dry};
        gemm_phase<2>((const u16*)(ws + OFF_H), 0, 1024, (const u16*)(ws + OFF_WT_INRW) + (size_t)j * 7296 * 1024, 0, 1024, 1, 64, 57, 8, 1024, smem, epi);
      }
      break;
    case PH_KVPREP: phase_kvprep(p, L, c); break;
    case PH_GEMM_UP: {
      EpiUQ e1{(u16*)(ws + OFF_Q), (const float*)(ws + OFF_COS), (const float*)(ws + OFF_SIN), c, dry};
      gemm_phase<2>((const u16*)(ws + OFF_U) + M_CQ, 0, LDU_M, (const u16*)(ws + OFF_WT_UQ) + (size_t)j * 2304 * 384, 0, 384, 1, 64, 18, 8, 384, smem, e1);
      EpiUKV e2{(u16*)(ws + OFF_K), (u16*)(ws + OFF_VT), dry};
      gemm_phase<2>((const u16*)(ws + OFF_U) + M_CKV, 0, LDU_M, (const u16*)(ws + OFF_WT_UKV) + (size_t)j * 3072 * 256, 0, 256, 1, 64, 24, 8, 256, smem, e2);
    } break;
    case PH_ATTN: phase_attn(p, L, c, smem, s_item, dry); break;
    case PH_SCAN: phase_scan(p, L, c, smem, s_item, dry); break;
    case PH_FINALIZE: phase_finalize(p, L, c); break;
    case PH_GEMM_OUT: {
      EpiResid epi{(L == 0) ? p.x : (const float*)p.out, p.out, rw, c, dry};
      gemm_phase<2>((const u16*)(ws + OFF_U) + (rw ? R_GATE : M_GATE), 0, rw ? LDU_R : LDU_M, (const u16*)(ws + OFF_WT_OUT) + (size_t)L * 1024 * 2048, 0, 2048,
                 1, 64, 8, 8, 2048, smem, epi);
    } break;
    case PH_FINAL: phase_final_norm(p); break;
  }
}

__global__ void __launch_bounds__(256, 1) hybrid_megakernel(Params p, int s_lo, int s_hi, int coop, int probe_mask) {
  __shared__ __attribute__((aligned(16))) char smem[SMEM_BYTES];
  __shared__ int s_item;
  for (int st = s_lo; st < s_hi; ++st) {
    int ph, L, c;
    decode_step(st, ph, L, c);
    for (int rep = ((probe_mask >> ph) & 1) ? 0 : 1; rep < 2; ++rep) {
      run_step(p, ph, L, c, smem, &s_item, rep == 0);
      if (coop && (rep == 0 || st + 1 < s_hi)) cg::this_grid().sync();
    }
  }
}

extern "C" void kernel_launch(void* const* d_in, const int* in_sizes, int n_in, void* d_out, int out_size, void* d_ws, size_t ws_size,
                              hipStream_t stream) {
  if (ws_size < WS_NEED) { fprintf(stderr, "workspace too small: %zu < %zu\n", ws_size, (size_t)WS_NEED); return; }
  Params p;
  memset(&p, 0, sizeof(p));
  p.x = (const float*)d_in[0]; p.mem = (const float*)d_in[1]; p.pos = (const int*)d_in[2];
  p.norm_g = (const float*)d_in[3]; p.mem_norm_g = (const float*)d_in[4]; p.w_mem_kv = (const float*)d_in[5];
  p.w_in_mla = (const float*)d_in[6]; p.q_norm_g = (const float*)d_in[7]; p.kv_norm_g = (const float*)d_in[8];
  p.w_uq = (const float*)d_in[9]; p.w_ukv = (const float*)d_in[10]; p.w_in_rwkv = (const float*)d_in[11];
  p.mu = (const float*)d_in[12]; p.w0 = (const float*)d_in[13]; p.w2 = (const float*)d_in[14]; p.a0 = (const float*)d_in[15];
  p.a2 = (const float*)d_in[16]; p.k_k = (const float*)d_in[17]; p.k_a = (const float*)d_in[18]; p.r_k = (const float*)d_in[19];
  p.gn_w = (const float*)d_in[20]; p.gn_b = (const float*)d_in[21]; p.w_out = (const float*)d_in[22]; p.final_g = (const float*)d_in[23];
  p.out = (float*)d_out; p.ws = (char*)d_ws;
  static int grid_blocks = 0;
  if (!grid_blocks) {
    int dev = 0, cus = 0, per_cu = 0;
    hipGetDevice(&dev);
    hipDeviceGetAttribute(&cus, hipDeviceAttributeMultiprocessorCount, dev);
    hipOccupancyMaxActiveBlocksPerMultiprocessor(&per_cu, hybrid_megakernel, 256, 0);
    if (per_cu > 2) per_cu = 2;
    if (per_cu < 1) per_cu = 1;
    grid_blocks = cus * per_cu;
  }
#if MULTI_LAUNCH
  for (int s = 0; s < NSTEPS; ++s) hipLaunchKernelGGL(hybrid_megakernel, dim3(grid_blocks), dim3(256), 0, stream, p, s, s + 1, 0, 0);
#else
  int s_lo = 0, s_hi = NSTEPS, coop = 1, probe_mask = PROBE_MASK;
  void* args[] = {&p, &s_lo, &s_hi, &coop, &probe_mask};
  hipError_t e = hipLaunchCooperativeKernel((void*)hybrid_megakernel, dim3(grid_blocks), dim3(256), args, 0, stream);
  if (e != hipSuccess) fprintf(stderr, "cooperative launch failed: %s (grid %d)\n", hipGetErrorString(e), grid_blocks);
#endif
}
```

```cpp
#include <hip/hip_runtime.h>
#include <hip/hip_cooperative_groups.h>
#include <cstdio>
#include <cstring>
namespace cg = cooperative_groups;

#define PROBE_MASK 0
#ifndef MULTI_LAUNCH
#define MULTI_LAUNCH 0
#endif

#define DI __device__ __forceinline__
typedef unsigned short u16;
typedef __attribute__((ext_vector_type(8))) short bf16x8;
typedef __attribute__((ext_vector_type(16))) float f32x16;
typedef __attribute__((ext_vector_type(2))) __bf16 bf2_t;
typedef __attribute__((ext_vector_type(2))) float f2_t;
typedef __attribute__((ext_vector_type(4))) unsigned u32x4;
typedef __attribute__((ext_vector_type(2))) unsigned u32x2;
#define MFMA32(a, b, c) __builtin_amdgcn_mfma_f32_32x32x16_bf16((a), (b), (c), 0, 0, 0)

constexpr int SEQ = 8192, TC = 16384;
constexpr int LDU_M = 3264, LDU_R = 7296;
constexpr int M_CQ = 0, M_CKV = 384, M_KR = 640, M_QM = 704, M_GATE = 1216;
constexpr int R_R = 0, R_K = 1536, R_V = 3072, R_WD = 4608, R_AD = 4672, R_QM = 4736, R_GATE = 5248;
constexpr int SHIFTW = 4736;

constexpr size_t OFF_WT_MEMKV = 0;
constexpr size_t OFF_WT_INMLA = OFF_WT_MEMKV + 4ull * 1024 * 1024 * 2;
constexpr size_t OFF_WT_UQ    = OFF_WT_INMLA + 2ull * 3328 * 1024 * 2;
constexpr size_t OFF_WT_UKV   = OFF_WT_UQ + 2ull * 2304 * 384 * 2;
constexpr size_t OFF_WT_INRW  = OFF_WT_UKV + 2ull * 3072 * 256 * 2;
constexpr size_t OFF_WT_OUT   = OFF_WT_INRW + 2ull * 7296 * 1024 * 2;
constexpr size_t OFF_MEMH     = OFF_WT_OUT + 4ull * 1024 * 2048 * 2;
constexpr size_t OFF_MEMK     = OFF_MEMH + 4ull * 1024 * 1024 * 2;
constexpr size_t OFF_MEMVT    = OFF_MEMK + 4ull * 4 * 4 * 256 * 128 * 2;
constexpr size_t OFF_COS      = OFF_MEMVT + 4ull * 4 * 4 * 256 * 128 * 2;
constexpr size_t OFF_SIN      = OFF_COS + 32768ull * 32 * 4;
constexpr size_t OFF_CNT      = OFF_SIN + 32768ull * 32 * 4;
constexpr size_t OFF_STATE    = OFF_CNT + 256;
constexpr size_t OFF_BND      = OFF_STATE + 96ull * 4096 * 4;
constexpr size_t OFF_H        = OFF_BND + 4ull * 4736 * 2 + 128;
constexpr size_t OFF_R        = OFF_H + 16384ull * 1024 * 2;
constexpr size_t OFF_U        = OFF_R;
constexpr size_t OFF_Q        = OFF_R + 16384ull * 3264 * 2;
constexpr size_t OFF_K        = OFF_Q + 2ull * 12 * 8192 * 192 * 2;
constexpr size_t OFF_VT       = OFF_K + 2ull * 12 * 8192 * 192 * 2;
constexpr size_t OFF_YR       = OFF_R + 16384ull * 7296 * 2;
constexpr size_t OFF_BV       = OFF_YR + 16384ull * 1536 * 2;
constexpr size_t OFF_ST       = OFF_BV + 16384ull * 1536 * 2;
constexpr size_t OFF_BS       = OFF_ST + 16384ull * 24 * 4 * 4;
constexpr size_t WS_NEED      = OFF_BS + 16384ull * 24 * 4;

constexpr int SMEM_BYTES = 110592;

struct Params {
  const float *x, *mem; const int* pos;
  const float *norm_g, *mem_norm_g, *w_mem_kv, *w_in_mla, *q_norm_g, *kv_norm_g, *w_uq, *w_ukv, *w_in_rwkv;
  const float *mu, *w0, *w2, *a0, *a2, *k_k, *k_a, *r_k, *gn_w, *gn_b, *w_out, *final_g;
  float* out; char* ws;
};

DI int otid() { int t = threadIdx.x; asm volatile("" : "+v"(t)); return t; }
DI float bf2f(unsigned v) { return __uint_as_float(v << 16); }
DI unsigned pack2(float a, float b) { f2_t v = {a, b}; bf2_t r = __builtin_convertvector(v, bf2_t); return __builtin_bit_cast(unsigned, r); }
DI u16 f2bf(float a) { return (u16)(pack2(a, 0.f) & 0xffffu); }
DI float ex2(float x) { return __builtin_amdgcn_exp2f(x); }
DI float fexp(float x) { return __builtin_amdgcn_exp2f(x * 1.4426950408889634f); }
DI float frcp(float x) { return __builtin_amdgcn_rcpf(x); }
DI float silu(float g) { return g * frcp(1.f + fexp(-g)); }
DI float wave_sum(float v) { for (int o = 32; o > 0; o >>= 1) v += __shfl_xor(v, o); return v; }
DI int crow(int reg, int h) { return (reg & 3) + 8 * (reg >> 2) + 4 * h; }
DI float dppf(float x, const int ctrl_sel) {
  int xi;
  if (ctrl_sel == 0) xi = __builtin_amdgcn_update_dpp(0, __float_as_int(x), 0xB1, 0xf, 0xf, true);
  else if (ctrl_sel == 1) xi = __builtin_amdgcn_update_dpp(0, __float_as_int(x), 0x4E, 0xf, 0xf, true);
  else xi = __builtin_amdgcn_update_dpp(0, __float_as_int(x), 0x141, 0xf, 0xf, true);
  return __int_as_float(xi);
}
DI float red4(float x) { x += dppf(x, 0); x += dppf(x, 1); return x; }
DI float red8(float x) { x += dppf(x, 0); x += dppf(x, 1); x += dppf(x, 2); return x; }
DI int gtok(bool rw, int c, int lr) { return rw ? ((lr >> 12) * 8192 + c * 4096 + (lr & 4095)) : (c * 16384 + lr); }
DI void unpack8(const uint4& v, float* f) {
  f[0] = bf2f(v.x & 0xffffu); f[1] = bf2f(v.x >> 16); f[2] = bf2f(v.y & 0xffffu); f[3] = bf2f(v.y >> 16);
  f[4] = bf2f(v.z & 0xffffu); f[5] = bf2f(v.z >> 16); f[6] = bf2f(v.w & 0xffffu); f[7] = bf2f(v.w >> 16);
}
DI uint4 pack8(const float* f) { uint4 v; v.x = pack2(f[0], f[1]); v.y = pack2(f[2], f[3]); v.z = pack2(f[4], f[5]); v.w = pack2(f[6], f[7]); return v; }

DI void transpose_tile(const float* __restrict__ src, u16* __restrict__ dst, int K, int N, int tk, int tn, float* tile) {
  const int tid = otid();
  __syncthreads();
#pragma unroll
  for (int i = 0; i < 4; ++i) {
    int kr = (tid >> 4) + 16 * i, nc = (tid & 15) * 4;
    float4 v = *(const float4*)(src + (size_t)(tk * 64 + kr) * N + tn * 64 + nc);
    tile[kr * 65 + nc] = v.x; tile[kr * 65 + nc + 1] = v.y; tile[kr * 65 + nc + 2] = v.z; tile[kr * 65 + nc + 3] = v.w;
  }
  __syncthreads();
#pragma unroll
  for (int i = 0; i < 2; ++i) {
    int n = (tid >> 3) + 32 * i, kc = (tid & 7) * 8;
    float f[8];
#pragma unroll
    for (int e = 0; e < 8; ++e) f[e] = tile[(kc + e) * 65 + n];
    *(uint4*)(dst + (size_t)(tn * 64 + n) * K + tk * 64 + kc) = pack8(f);
  }
}

DI void rms_row_bf16(const float* __restrict__ src, const float* __restrict__ g, u16* __restrict__ dst, int lane) {
  float4 v[4]; float ss = 0.f;
#pragma unroll
  for (int i = 0; i < 4; ++i) { v[i] = *(const float4*)(src + i * 256 + lane * 4); ss += v[i].x * v[i].x + v[i].y * v[i].y + v[i].z * v[i].z + v[i].w * v[i].w; }
  ss = wave_sum(ss);
  float rs = rsqrtf(ss * (1.f / 1024.f) + 1e-6f);
#pragma unroll
  for (int i = 0; i < 4; ++i) {
    float4 gg = *(const float4*)(g + i * 256 + lane * 4);
    uint2 o; o.x = pack2(v[i].x * rs * gg.x, v[i].y * rs * gg.y); o.y = pack2(v[i].z * rs * gg.z, v[i].w * rs * gg.w);
    *(uint2*)(dst + i * 256 + lane * 4) = o;
  }
}

DI void phase_prep(const Params& p, char* smem) {
  const int tid = otid(), G = gridDim.x, bid = blockIdx.x;
  char* ws = p.ws;
  if (bid == 0 && tid < 64) ((int*)(ws + OFF_CNT))[tid] = 0;
  float* tile = (float*)smem;
  for (int g0 = bid; g0 < 9168; g0 += G) {
    int g = g0;
    const float* src = nullptr; u16* dst = nullptr; int K = 0, N = 0; size_t dstr = 0;
    if (g < 1024) { src = p.w_mem_kv; dst = (u16*)(ws + OFF_WT_MEMKV); K = 1024; N = 1024; dstr = 1024ull * 1024; }
    else if ((g -= 1024) < 1632) { src = p.w_in_mla; dst = (u16*)(ws + OFF_WT_INMLA); K = 1024; N = 3264; dstr = 3328ull * 1024; }
    else if ((g -= 1632) < 432) { src = p.w_uq; dst = (u16*)(ws + OFF_WT_UQ); K = 384; N = 2304; dstr = 2304ull * 384; }
    else if ((g -= 432) < 384) { src = p.w_ukv; dst = (u16*)(ws + OFF_WT_UKV); K = 256; N = 3072; dstr = 3072ull * 256; }
    else if ((g -= 384) < 3648) { src = p.w_in_rwkv; dst = (u16*)(ws + OFF_WT_INRW); K = 1024; N = 7296; dstr = 7296ull * 1024; }
    else { g -= 3648; src = p.w_out; dst = (u16*)(ws + OFF_WT_OUT); K = 2048; N = 1024; dstr = 1024ull * 2048; }
    int ntn = N >> 6, per = (K >> 6) * ntn;
    int m = g / per, t = g - m * per;
    int tk = t / ntn, tn = t - tk * ntn;
    transpose_tile(src + (size_t)m * K * N, dst + (size_t)m * dstr, K, N, tk, tn, tile);
  }
  for (int i = bid * 256 + tid; i < 2 * 64 * 1024 / 8; i += G * 256) {
    int m = i / (64 * 1024 / 8), r = i - m * (64 * 1024 / 8);
    uint4 z; z.x = z.y = z.z = z.w = 0u;
    *(uint4*)((u16*)(ws + OFF_WT_INMLA) + (size_t)m * 3328 * 1024 + 3264ull * 1024 + (size_t)r * 8) = z;
  }
  float* cs = (float*)(ws + OFF_COS); float* sn = (float*)(ws + OFF_SIN);
  for (int i = bid * 256 + tid; i < 32768 * 32; i += G * 256) {
    int tk = i >> 5, pi = i & 31;
    float inv_freq = (float)exp2(-(double)(2 * pi) / 64.0 * 13.287712379549449);
    float ang = (float)p.pos[tk] * inv_freq;
    double rev = (double)ang * 0.15915494309189535;
    float fr = (float)(rev - rint(rev));
    cs[i] = __builtin_amdgcn_cosf(fr); sn[i] = __builtin_amdgcn_sinf(fr);
  }
  const int w = tid >> 6, lane = tid & 63;
  for (int row = bid * 4 + w; row < 4096; row += G * 4) {
    int L = row >> 10, m = row & 1023;
    rms_row_bf16(p.mem + (size_t)m * 1024, p.mem_norm_g + L * 1024, (u16*)(ws + OFF_MEMH) + (size_t)row * 1024, lane);
  }
}

DI void phase_norm(const Params& p, int L, int c) {
  const int tid = otid(), w = tid >> 6, lane = tid & 63;
  const bool rw = L & 1;
  const float* xs = (L == 0) ? p.x : p.out;
  u16* H = (u16*)(p.ws + OFF_H);
  for (int lr = blockIdx.x * 4 + w; lr < TC; lr += gridDim.x * 4) {
    int gt = gtok(rw, c, lr);
    rms_row_bf16(xs + (size_t)gt * 1024, p.norm_g + L * 1024, H + (size_t)lr * 1024, lane);
  }
}

DI void phase_final_norm(const Params& p) {
  const int tid = otid(), w = tid >> 6, lane = tid & 63;
  for (int row = blockIdx.x * 4 + w; row < 32768; row += gridDim.x * 4) {
    float* xr = p.out + (size_t)row * 1024;
    float4 v[4]; float ss = 0.f;
#pragma unroll
    for (int i = 0; i < 4; ++i) { v[i] = *(const float4*)(xr + i * 256 + lane * 4); ss += v[i].x * v[i].x + v[i].y * v[i].y + v[i].z * v[i].z + v[i].w * v[i].w; }
    ss = wave_sum(ss);
    float rs = rsqrtf(ss * (1.f / 1024.f) + 1e-6f);
#pragma unroll
    for (int i = 0; i < 4; ++i) {
      float4 gg = *(const float4*)(p.final_g + i * 256 + lane * 4);
      float4 o; o.x = v[i].x * rs * gg.x; o.y = v[i].y * rs * gg.y; o.z = v[i].z * rs * gg.z; o.w = v[i].w * rs * gg.w;
      *(float4*)(xr + i * 256 + lane * 4) = o;
    }
  }
}

template <int TJ, class Epi>
DI void gemm_phase(const u16* __restrict__ A, size_t strideAz, int lda, const u16* __restrict__ Bt, size_t strideBz, int ldb,
                   int Z, int Mt, int Nt, int GM, int K, char* smem, const Epi& epi) {
  constexpr int BN = 64 * TJ;
  constexpr int NB = BN / 32;
  const int tid = otid(), w = tid >> 6, lane = tid & 63, r = lane & 31, h = lane >> 5;
  const int wm = w >> 1, wn = w & 1;
  u16* As = (u16*)smem;
  u16* Bs = As + 2 * 256 * 72;
  const int G = gridDim.x, per = Mt * Nt, total = Z * per;
  const int lrow = tid >> 3, lcc = (tid & 7) * 8;
  for (int base = 0; base < total; base += G) {
    const int t = blockIdx.x;
    const int q = base + (((G & 7) == 0) ? ((t & 7) * (G >> 3) + (t >> 3)) : t);
    if (q >= total) continue;
    const int z = q / per, qq = q - z * per;
    const int grp = qq / (GM * Nt), within = qq - grp * GM * Nt;
    const int mt = grp * GM + (within % GM), nt = within / GM;
    const u16* Ag = A + z * strideAz + (size_t)(mt * 256 + lrow) * lda + lcc;
    const u16* Bg = Bt + z * strideBz + (size_t)(nt * BN + lrow) * ldb + lcc;
    u32x4 ra[8], rb[NB];
    f32x16 acc[4][TJ];
#pragma unroll
    for (int i = 0; i < 4; ++i)
#pragma unroll
      for (int j = 0; j < TJ; ++j)
#pragma unroll
        for (int e = 0; e < 16; ++e) acc[i][j][e] = 0.f;
    __syncthreads();
#pragma unroll
    for (int i = 0; i < 8; ++i) ra[i] = *(const u32x4*)(Ag + (size_t)(32 * i) * lda);
#pragma unroll
    for (int i = 0; i < NB; ++i) rb[i] = *(const u32x4*)(Bg + (size_t)(32 * i) * ldb);
#pragma unroll
    for (int i = 0; i < 8; ++i) *(u32x4*)(As + (lrow + 32 * i) * 72 + lcc) = ra[i];
#pragma unroll
    for (int i = 0; i < NB; ++i) *(u32x4*)(Bs + (lrow + 32 * i) * 72 + lcc) = rb[i];
    __syncthreads();
    const int nk = K >> 6;
    for (int kt = 0; kt < nk; ++kt) {
      const int buf = kt & 1;
      if (kt + 1 < nk) {
#pragma unroll
        for (int i = 0; i < 8; ++i) ra[i] = *(const u32x4*)(Ag + (size_t)(32 * i) * lda + (kt + 1) * 64);
#pragma unroll
        for (int i = 0; i < NB; ++i) rb[i] = *(const u32x4*)(Bg + (size_t)(32 * i) * ldb + (kt + 1) * 64);
      }
      __builtin_amdgcn_sched_barrier(0);
      const u16* as = As + buf * 256 * 72 + (128 * wm + r) * 72 + 8 * h;
      const u16* bs = Bs + buf * BN * 72 + (32 * TJ * wn + r) * 72 + 8 * h;
#pragma unroll
      for (int ks = 0; ks < 4; ++ks) {
        bf16x8 af[4], bfr[TJ];
#pragma unroll
        for (int i = 0; i < 4; ++i) af[i] = *(const bf16x8*)(as + (32 * i) * 72 + 16 * ks);
#pragma unroll
        for (int j = 0; j < TJ; ++j) bfr[j] = *(const bf16x8*)(bs + (32 * j) * 72 + 16 * ks);
#pragma unroll
        for (int i = 0; i < 4; ++i)
#pragma unroll
          for (int j = 0; j < TJ; ++j) acc[i][j] = MFMA32(af[i], bfr[j], acc[i][j]);
      }
      __builtin_amdgcn_sched_barrier(0);
      if (kt + 1 < nk) {
        u16* ad = As + (buf ^ 1) * 256 * 72; u16* bd = Bs + (buf ^ 1) * BN * 72;
#pragma unroll
        for (int i = 0; i < 8; ++i) *(u32x4*)(ad + (lrow + 32 * i) * 72 + lcc) = ra[i];
#pragma unroll
        for (int i = 0; i < NB; ++i) *(u32x4*)(bd + (lrow + 32 * i) * 72 + lcc) = rb[i];
      }
      __syncthreads();
    }
#pragma unroll
    for (int i = 0; i < 4; ++i)
#pragma unroll
      for (int j = 0; j < TJ; ++j) epi(z, mt * 256 + 128 * wm + 32 * i, nt * BN + 32 * TJ * wn + 32 * j + r, h, acc[i][j]);
  }
}

struct EpiStoreBf16 {
  u16* C; int ldc; int ncols; bool dry;
  DI void operator()(int z, int rowbase, int col, int h, const f32x16& a) const {
    if (col >= ncols || dry) return;
#pragma unroll
    for (int e = 0; e < 16; ++e) C[(size_t)(rowbase + crow(e, h)) * ldc + col] = f2bf(a[e]);
  }
};
struct EpiResid {
  const float* xin; float* xout; bool rw; int c; bool dry;
  DI void operator()(int z, int rowbase, int col, int h, const f32x16& a) const {
    if (dry) return;
#pragma unroll
    for (int e = 0; e < 16; ++e) {
      int gt = gtok(rw, c, rowbase + crow(e, h));
      size_t o = (size_t)gt * 1024 + col;
      xout[o] = xin[o] + a[e];
    }
  }
};
struct EpiUQ {
  u16* Q; const float* cs; const float* sn; int c; bool dry;
  DI void operator()(int z, int rowbase, int col, int h, const f32x16& a) const {
    if (dry) return;
    const int head = col / 192, d = col - head * 192;
    const bool rope = d >= 128;
#pragma unroll
    for (int e = 0; e < 16; ++e) {
      int lr = rowbase + crow(e, h); int lb = lr >> 13, s = lr & 8191;
      float v = a[e];
      if (rope) {
        float o = __shfl_xor(v, 1);
        int ti = (c * 16384 + lr) * 32 + ((d - 128) >> 1);
        float cc = cs[ti], ss = sn[ti];
        v = (d & 1) ? (o * ss + v * cc) : (v * cc - o * ss);
      }
      Q[((size_t)(lb * 12 + head) * 8192 + s) * 192 + d] = f2bf(v);
    }
  }
};
struct EpiUKV {
  u16* Kb; u16* Vt; bool dry;
  DI void operator()(int z, int rowbase, int col, int h, const f32x16& a) const {
    if (dry) return;
    const int head = col >> 8, d = col & 255;
    if (d < 128) {
#pragma unroll
      for (int e = 0; e < 16; ++e) {
        int lr = rowbase + crow(e, h); int lb = lr >> 13, s = lr & 8191;
        Kb[((size_t)(lb * 12 + head) * 8192 + s) * 192 + d] = f2bf(a[e]);
      }
    } else {
#pragma unroll
      for (int g = 0; g < 4; ++g) {
        int lr = rowbase + 8 * g + 4 * h; int lb = lr >> 13, s = lr & 8191;
        uint2 pk; pk.x = pack2(a[4 * g], a[4 * g + 1]); pk.y = pack2(a[4 * g + 2], a[4 * g + 3]);
        *(uint2*)(Vt + ((size_t)(lb * 12 + head) * 128 + (d - 128)) * 8192 + s) = pk;
      }
    }
  }
};
struct EpiMemKV {
  u16* MK; u16* MVt;
  DI void operator()(int z, int rowbase, int col, int h, const f32x16& a) const {
    if (col < 512) {
      const int xh = col >> 7, d = col & 127;
#pragma unroll
      for (int e = 0; e < 16; ++e) {
        int m = rowbase + crow(e, h); int b = m >> 8, mi = m & 255;
        MK[((size_t)((z * 4 + b) * 4 + xh) * 256 + mi) * 128 + d] = f2bf(a[e]);
      }
    } else {
      const int n = col - 512, xh = n >> 7, d = n & 127;
#pragma unroll
      for (int g = 0; g < 4; ++g) {
        int m = rowbase + 8 * g + 4 * h; int b = m >> 8, mi = m & 255;
        uint2 pk; pk.x = pack2(a[4 * g], a[4 * g + 1]); pk.y = pack2(a[4 * g + 2], a[4 * g + 3]);
        *(uint2*)(MVt + ((size_t)((z * 4 + b) * 4 + xh) * 128 + d) * 256 + mi) = pk;
      }
    }
  }
};

DI void phase_kvprep(const Params& p, int L, int c) {
  const int tid = otid(), w = tid >> 6, lane = tid & 63;
  const int j = L >> 1;
  u16* U = (u16*)(p.ws + OFF_U); u16* Kb = (u16*)(p.ws + OFF_K);
  const float* cs = (const float*)(p.ws + OFF_COS); const float* sn = (const float*)(p.ws + OFF_SIN);
  for (int lr = blockIdx.x * 4 + w; lr < TC; lr += gridDim.x * 4) {
    u16* row = U + (size_t)lr * LDU_M;
    float fq[8], fk[8]; float sq = 0.f, sk = 0.f;
    if (lane < 48) { uint4 v = *(const uint4*)(row + M_CQ + lane * 8); unpack8(v, fq);
#pragma unroll
      for (int e = 0; e < 8; ++e) sq += fq[e] * fq[e]; }
    if (lane < 32) { uint4 v = *(const uint4*)(row + M_CKV + lane * 8); unpack8(v, fk);
#pragma unroll
      for (int e = 0; e < 8; ++e) sk += fk[e] * fk[e]; }
    sq = wave_sum(sq); sk = wave_sum(sk);
    float rq = rsqrtf(sq * (1.f / 384.f) + 1e-6f), rk = rsqrtf(sk * (1.f / 256.f) + 1e-6f);
    if (lane < 48) {
      const float* g = p.q_norm_g + j * 384 + lane * 8;
#pragma unroll
      for (int e = 0; e < 8; ++e) fq[e] = fq[e] * rq * g[e];
      *(uint4*)(row + M_CQ + lane * 8) = pack8(fq);
    }
    if (lane < 32) {
      const float* g = p.kv_norm_g + j * 256 + lane * 8;
#pragma unroll
      for (int e = 0; e < 8; ++e) fk[e] = fk[e] * rk * g[e];
      *(uint4*)(row + M_CKV + lane * 8) = pack8(fk);
    }
    if (lane < 8) {
      float f[8], o[8]; uint4 v = *(const uint4*)(row + M_KR + lane * 8); unpack8(v, f);
      int gt = c * 16384 + lr;
#pragma unroll
      for (int i = 0; i < 4; ++i) {
        float cc = cs[gt * 32 + lane * 4 + i], ss = sn[gt * 32 + lane * 4 + i];
        o[2 * i] = f[2 * i] * cc - f[2 * i + 1] * ss; o[2 * i + 1] = f[2 * i] * ss + f[2 * i + 1] * cc;
      }
      uint4 pk = pack8(o);
      int lb = lr >> 13, s = lr & 8191;
#pragma unroll
      for (int hd = 0; hd < 12; ++hd) *(uint4*)(Kb + ((size_t)(lb * 12 + hd) * 8192 + s) * 192 + 128 + lane * 8) = pk;
    }
  }
}

template <int DQK>
DI void attn_item(const u16* __restrict__ Qp, int ldq, const u16* __restrict__ Kp, const u16* __restrict__ Vtp, int ldv,
                  int nkt, int q0, bool causal, float c, u16* Yp, int ldy, char* smem, bool dry) {
  constexpr int KLD = DQK + 8;
  constexpr int NKC = DQK * 64 / 8 / 256;
  constexpr int NKS = DQK / 16;
  constexpr int CPR = DQK / 8;
  u16* Ks = (u16*)smem;
  u16* Vs = Ks + 64 * KLD;
  const int tid = otid(), w = tid >> 6, lane = tid & 63, r = lane & 31, h = lane >> 5;
  bf16x8 qf[NKS];
  {
    const u16* qrow = Qp + (size_t)(32 * w + r) * ldq + 8 * h;
#pragma unroll
    for (int ks = 0; ks < NKS; ++ks) qf[ks] = *(const bf16x8*)(qrow + 16 * ks);
  }
  f32x16 o[4];
#pragma unroll
  for (int dt = 0; dt < 4; ++dt)
#pragma unroll
    for (int e = 0; e < 16; ++e) o[dt][e] = 0.f;
  float m = -INFINITY, l = 0.f;
  u32x4 kst[NKC], vst[4];
  const int vd = tid >> 3, vc8 = tid & 7;
  {
#pragma unroll
    for (int i = 0; i < NKC; ++i) kst[i] = *(const u32x4*)(Kp + (size_t)(tid + 256 * i) * 8);
#pragma unroll
    for (int i = 0; i < 4; ++i) vst[i] = *(const u32x4*)(Vtp + (size_t)(vd + 32 * i) * ldv + vc8 * 8);
  }
  const int qmin = q0 + 32 * w;
  for (int kt = 0; kt < nkt; ++kt) {
    __syncthreads();
#pragma unroll
    for (int i = 0; i < NKC; ++i) { int id = tid + 256 * i; int row = id / CPR, cc = id - row * CPR; *(u32x4*)(Ks + row * KLD + cc * 8) = kst[i]; }
#pragma unroll
    for (int i = 0; i < 4; ++i) {
      u16* dst = Vs + (vd + 32 * i) * 72 + 16 * (vc8 >> 1) + 4 * (vc8 & 1);
      u32x2 lo = {vst[i].x, vst[i].y}, hi = {vst[i].z, vst[i].w};
      *(u32x2*)dst = lo; *(u32x2*)(dst + 8) = hi;
    }
    __syncthreads();
    if (kt + 1 < nkt) {
      const u16* kg = Kp + (size_t)(kt + 1) * 64 * DQK;
#pragma unroll
      for (int i = 0; i < NKC; ++i) kst[i] = *(const u32x4*)(kg + (size_t)(tid + 256 * i) * 8);
#pragma unroll
      for (int i = 0; i < 4; ++i) vst[i] = *(const u32x4*)(Vtp + (size_t)(vd + 32 * i) * ldv + (kt + 1) * 64 + vc8 * 8);
    }
    if (causal && kt * 64 > qmin + 31) continue;
    f32x16 s0, s1;
#pragma unroll
    for (int e = 0; e < 16; ++e) { s0[e] = 0.f; s1[e] = 0.f; }
    {
      const u16* k0 = Ks + r * KLD + 8 * h;
#pragma unroll
      for (int ks = 0; ks < NKS; ++ks) {
        bf16x8 a0 = *(const bf16x8*)(k0 + 16 * ks), a1 = *(const bf16x8*)(k0 + 32 * KLD + 16 * ks);
        s0 = MFMA32(a0, qf[ks], s0); s1 = MFMA32(a1, qf[ks], s1);
      }
    }
    if (causal && kt * 64 + 63 > qmin) {
      const int qi = qmin + r;
#pragma unroll
      for (int e = 0; e < 16; ++e) {
        int key = kt * 64 + crow(e, h);
        if (key > qi) s0[e] = -INFINITY;
        if (key + 32 > qi) s1[e] = -INFINITY;
      }
    }
    float mx = fmaxf(s0[0], s1[0]);
#pragma unroll
    for (int e = 1; e < 16; ++e) mx = fmaxf(mx, fmaxf(s0[e], s1[e]));
    mx = fmaxf(mx, __shfl_xor(mx, 32));
    const float mn = fmaxf(m, mx);
    const float alpha = ex2((m - mn) * c);
    const float mc = mn * c;
    m = mn;
    l *= alpha;
#pragma unroll
    for (int dt = 0; dt < 4; ++dt)
#pragma unroll
      for (int e = 0; e < 16; ++e) o[dt][e] *= alpha;
    float ps = 0.f;
#pragma unroll
    for (int e = 0; e < 16; ++e) { s0[e] = ex2(fmaf(s0[e], c, -mc)); s1[e] = ex2(fmaf(s1[e], c, -mc)); ps += s0[e] + s1[e]; }
    l += ps;
    bf16x8 pf[4];
    {
      u32x4 t;
      t.x = pack2(s0[0], s0[1]); t.y = pack2(s0[2], s0[3]); t.z = pack2(s0[4], s0[5]); t.w = pack2(s0[6], s0[7]); pf[0] = __builtin_bit_cast(bf16x8, t);
      t.x = pack2(s0[8], s0[9]); t.y = pack2(s0[10], s0[11]); t.z = pack2(s0[12], s0[13]); t.w = pack2(s0[14], s0[15]); pf[1] = __builtin_bit_cast(bf16x8, t);
      t.x = pack2(s1[0], s1[1]); t.y = pack2(s1[2], s1[3]); t.z = pack2(s1[4], s1[5]); t.w = pack2(s1[6], s1[7]); pf[2] = __builtin_bit_cast(bf16x8, t);
      t.x = pack2(s1[8], s1[9]); t.y = pack2(s1[10], s1[11]); t.z = pack2(s1[12], s1[13]); t.w = pack2(s1[14], s1[15]); pf[3] = __builtin_bit_cast(bf16x8, t);
    }
    {
      const u16* v0 = Vs + r * 72 + 8 * h;
#pragma unroll
      for (int kk = 0; kk < 4; ++kk)
#pragma unroll
        for (int dt = 0; dt < 4; ++dt) {
          bf16x8 a = *(const bf16x8*)(v0 + (32 * dt) * 72 + 16 * kk);
          o[dt] = MFMA32(a, pf[kk], o[dt]);
        }
    }
  }
  const float lt = l + __shfl_xor(l, 32);
  const float inv = 1.f / lt;
  if (dry) return;
  u16* yrow = Yp + (size_t)(32 * w + r) * ldy;
#pragma unroll
  for (int dt = 0; dt < 4; ++dt)
#pragma unroll
    for (int g = 0; g < 4; ++g) {
      const int d = 32 * dt + 8 * g + 4 * h;
      uint2 gv = *(const uint2*)(yrow + d);
      float g0 = bf2f(gv.x & 0xffffu), g1 = bf2f(gv.x >> 16), g2 = bf2f(gv.y & 0xffffu), g3 = bf2f(gv.y >> 16);
      uint2 ov;
      ov.x = pack2(o[dt][4 * g] * inv * silu(g0), o[dt][4 * g + 1] * inv * silu(g1));
      ov.y = pack2(o[dt][4 * g + 2] * inv * silu(g2), o[dt][4 * g + 3] * inv * silu(g3));
      *(uint2*)(yrow + d) = ov;
    }
}

DI void memattn_item(const Params& p, int L, int c, int item, char* smem, bool dry) {
  const bool rw = L & 1;
  const int ldu = rw ? LDU_R : LDU_M, oq = rw ? R_QM : M_QM, og = rw ? R_GATE : M_GATE;
  const int tile = item >> 2, xh = item & 3;
  const int b = gtok(rw, c, tile * 128) >> 13;
  u16* U = (u16*)(p.ws + OFF_U);
  const u16* MK = (const u16*)(p.ws + OFF_MEMK) + (size_t)((L * 4 + b) * 4 + xh) * 256 * 128;
  const u16* MV = (const u16*)(p.ws + OFF_MEMVT) + (size_t)((L * 4 + b) * 4 + xh) * 128 * 256;
  attn_item<128>(U + (size_t)tile * 128 * ldu + oq + xh * 128, ldu, MK, MV, 256, 4, 0, false,
                 0.08838834764831845f * 1.4426950408889634f, U + (size_t)tile * 128 * ldu + og + 1536 + xh * 128, ldu, smem, dry);
}

DI void phase_attn(const Params& p, int L, int c, char* smem, int* s_item, bool dry) {
  int* cnt = (int*)(p.ws + OFF_CNT) + (L * 2 + c) + (dry ? 8 : 0);
  u16* U = (u16*)(p.ws + OFF_U);
  const u16* Q = (const u16*)(p.ws + OFF_Q); const u16* Kb = (const u16*)(p.ws + OFF_K); const u16* Vt = (const u16*)(p.ws + OFF_VT);
  for (;;) {
    __syncthreads();
    if (otid() == 0) *s_item = atomicAdd(cnt, 1);
    __syncthreads();
    const int item = *s_item;
    if (item >= 1536 + 512) break;
    if (item < 1536) {
      const int qt = 63 - item / 24, bh = item % 24;
      const int lb = bh / 12, head = bh - lb * 12;
      const int q0 = qt * 128;
      attn_item<192>(Q + ((size_t)(lb * 12 + head) * 8192 + q0) * 192, 192, Kb + (size_t)(lb * 12 + head) * 8192 * 192,
                     Vt + (size_t)(lb * 12 + head) * 128 * 8192, 8192, 2 * (qt + 1), q0, true,
                     0.07216878364870323f * 1.4426950408889634f,
                     U + (size_t)(lb * 8192 + q0) * LDU_M + M_GATE + head * 128, LDU_M, smem, dry);
    } else {
      memattn_item(p, L, c, item - 1536, smem, dry);
    }
  }
}

DI void scan_item(const Params& p, int L, int c, int item, char* smem, bool dry) {
  const int tid = otid(), w = tid >> 6, lane = tid & 63, r = lane & 31, h = lane >> 5;
  const int j = L >> 1;
  const int b = item / 48, rem = item - b * 48, head = rem >> 1, half = rem & 1;
  float* PA  = (float*)smem;
  float* LO  = PA;
  float* Vst = PA + 32 * 5 * 64;
  float* Yst = Vst + 32 * 32;
  float* PRM = Yst + 32 * 32;
  float* BON = PRM + 10 * 64;
  u16* A1  = (u16*)(BON + 32);
  u16* W2t = A1 + 2 * 32 * 72;
  const u16* U = (const u16*)(p.ws + OFF_U);
  const u16* BND = (const u16*)(p.ws + OFF_BND);
  u16* YR = (u16*)(p.ws + OFF_YR); u16* BV = (u16*)(p.ws + OFF_BV);
  float* ST = (float*)(p.ws + OFF_ST); float* BS = (float*)(p.ws + OFF_BS);
  float* STATE = (float*)(p.ws + OFF_STATE);
  __syncthreads();
  if (tid < 64) {
    const float* mu = p.mu + j * SHIFTW;
    const int hc = head * 64 + tid;
    PRM[0 * 64 + tid] = mu[R_R + hc]; PRM[1 * 64 + tid] = mu[R_K + hc]; PRM[2 * 64 + tid] = mu[R_WD + tid]; PRM[3 * 64 + tid] = mu[R_AD + tid];
    PRM[4 * 64 + tid] = p.w0[j * 1536 + hc]; PRM[5 * 64 + tid] = p.a0[j * 1536 + hc]; PRM[6 * 64 + tid] = p.k_k[j * 1536 + hc];
    PRM[7 * 64 + tid] = p.k_a[j * 1536 + hc]; PRM[8 * 64 + tid] = p.r_k[j * 1536 + hc];
    PRM[9 * 64 + tid] = (tid < 32) ? mu[R_V + head * 64 + 32 * half + tid] : 0.f;
  }
  for (int e = tid; e < 8192; e += 256) {
    int arr = e >> 12, jj = (e >> 6) & 63, cc = e & 63;
    const float* src = (arr ? p.a2 : p.w2) + (size_t)j * 64 * 1536;
    W2t[(arr * 64 + cc) * 72 + jj] = f2bf(src[jj * 1536 + head * 64 + cc]);
  }
  const int rowl = lane >> 3, ks = lane & 7, row32 = 8 * w + rowl;
  float S[8];
  {
    float* sp = STATE + ((size_t)((b * 24 + head) * 64 + 32 * half + row32)) * 64 + 8 * ks;
#pragma unroll
    for (int i = 0; i < 8; ++i) S[i] = (c == 0) ? 0.f : sp[i];
  }
  const int tt = tid >> 3, cs = tid & 7;
  uint4 Rr_c, Rr_p, Rk_c, Rk_p, Rw_c, Rw_p, Ra_c, Ra_p, Rv_c, Rv_p;
  const uint4 zero4 = {0u, 0u, 0u, 0u};
  auto load_raw = [&](int tc) {
    const int lr = b * 4096 + tc * 32 + tt;
    const int s = c * 4096 + tc * 32 + tt;
    const u16* cur = U + (size_t)lr * LDU_R;
    const u16* prv = (s == 4096 && c == 1) ? (BND + (size_t)b * SHIFTW) : (cur - LDU_R);
    const bool hp = (s != 0);
    Rr_c = *(const uint4*)(cur + R_R + head * 64 + cs * 8);  Rr_p = hp ? *(const uint4*)(prv + R_R + head * 64 + cs * 8) : zero4;
    Rk_c = *(const uint4*)(cur + R_K + head * 64 + cs * 8);  Rk_p = hp ? *(const uint4*)(prv + R_K + head * 64 + cs * 8) : zero4;
    Rw_c = *(const uint4*)(cur + R_WD + cs * 8);             Rw_p = hp ? *(const uint4*)(prv + R_WD + cs * 8) : zero4;
    Ra_c = *(const uint4*)(cur + R_AD + cs * 8);             Ra_p = hp ? *(const uint4*)(prv + R_AD + cs * 8) : zero4;
    const int vo = R_V + head * 64 + 32 * half + (cs & 3) * 8;
    Rv_c = *(const uint4*)(cur + vo);                        Rv_p = hp ? *(const uint4*)(prv + vo) : zero4;
  };
  load_raw(0);
  __syncthreads();
  for (int tc = 0; tc < 128; ++tc) {
    const int lr = b * 4096 + tc * 32 + tt;
    float rm[8], km[8];
    {
      float cu[8], pv[8], t8[8];
      unpack8(Rr_c, cu); unpack8(Rr_p, pv);
#pragma unroll
      for (int e = 0; e < 8; ++e) rm[e] = cu[e] + (pv[e] - cu[e]) * PRM[0 * 64 + cs * 8 + e];
      unpack8(Rk_c, cu); unpack8(Rk_p, pv);
#pragma unroll
      for (int e = 0; e < 8; ++e) km[e] = cu[e] + (pv[e] - cu[e]) * PRM[1 * 64 + cs * 8 + e];
      unpack8(Rw_c, cu); unpack8(Rw_p, pv);
#pragma unroll
      for (int e = 0; e < 8; ++e) {
        float xw = cu[e] + (pv[e] - cu[e]) * PRM[2 * 64 + cs * 8 + e];
        float ee = ex2(xw * 2.8853900817779268f);
        t8[e] = 1.f - 2.f * frcp(ee + 1.f);
      }
      *(uint4*)(A1 + (0 * 32 + tt) * 72 + cs * 8) = pack8(t8);
      unpack8(Ra_c, cu); unpack8(Ra_p, pv);
#pragma unroll
      for (int e = 0; e < 8; ++e) t8[e] = cu[e] + (pv[e] - cu[e]) * PRM[3 * 64 + cs * 8 + e];
      *(uint4*)(A1 + (1 * 32 + tt) * 72 + cs * 8) = pack8(t8);
      unpack8(Rv_c, cu); unpack8(Rv_p, pv);
      if (cs < 4) {
#pragma unroll
        for (int e = 0; e < 8; ++e) Vst[tt * 32 + cs * 8 + e] = cu[e] + (pv[e] - cu[e]) * PRM[9 * 64 + cs * 8 + e];
      }
    }
    __syncthreads();
    {
      const int arr = w >> 1, nt = w & 1;
      f32x16 acc;
#pragma unroll
      for (int e = 0; e < 16; ++e) acc[e] = 0.f;
#pragma unroll
      for (int k4 = 0; k4 < 4; ++k4) {
        bf16x8 a = *(const bf16x8*)(A1 + (arr * 32 + r) * 72 + 16 * k4 + 8 * h);
        bf16x8 bw = *(const bf16x8*)(W2t + (arr * 64 + 32 * nt + r) * 72 + 16 * k4 + 8 * h);
        acc = MFMA32(a, bw, acc);
      }
#pragma unroll
      for (int e = 0; e < 16; ++e) LO[(arr * 32 + crow(e, h)) * 64 + 32 * nt + r] = acc[e];
    }
    __syncthreads();
    float lw[8], la[8];
    {
      float4 t0 = *(const float4*)(LO + (0 * 32 + tt) * 64 + cs * 8), t1 = *(const float4*)(LO + (0 * 32 + tt) * 64 + cs * 8 + 4);
      lw[0] = t0.x; lw[1] = t0.y; lw[2] = t0.z; lw[3] = t0.w; lw[4] = t1.x; lw[5] = t1.y; lw[6] = t1.z; lw[7] = t1.w;
      t0 = *(const float4*)(LO + (1 * 32 + tt) * 64 + cs * 8); t1 = *(const float4*)(LO + (1 * 32 + tt) * 64 + cs * 8 + 4);
      la[0] = t0.x; la[1] = t0.y; la[2] = t0.z; la[3] = t0.w; la[4] = t1.x; la[5] = t1.y; la[6] = t1.z; la[7] = t1.w;
    }
    __syncthreads();
    {
      float dec[8], kk[8], av[8], kp[8];
      float ssq = 0.f, bon = 0.f;
#pragma unroll
      for (int e = 0; e < 8; ++e) {
        const int ch = cs * 8 + e;
        float xx = -(lw[e] + PRM[4 * 64 + ch]);
        float sp = fmaxf(xx, 0.f) + __logf(1.f + fexp(-fabsf(xx)));
        float wv = -sp - 0.5f;
        dec[e] = fexp(-fexp(wv));
        float a = frcp(1.f + fexp(-(la[e] + PRM[5 * 64 + ch])));
        av[e] = a;
        kk[e] = km[e] * PRM[6 * 64 + ch];
        ssq += kk[e] * kk[e];
        kp[e] = km[e] * (1.f + (a - 1.f) * PRM[7 * 64 + ch]);
        bon += rm[e] * kp[e] * PRM[8 * 64 + ch];
      }
      ssq = red8(ssq); bon = red8(bon);
      const float inv = 1.f / fmaxf(sqrtf(ssq), 1e-12f);
      float nk[8], bb[8];
#pragma unroll
      for (int e = 0; e < 8; ++e) { float kn = kk[e] * inv; nk[e] = -kn; bb[e] = kn * av[e]; }
      float* pa = PA + tt * 320 + cs * 8;
      *(float4*)(pa) = make_float4(dec[0], dec[1], dec[2], dec[3]); *(float4*)(pa + 4) = make_float4(dec[4], dec[5], dec[6], dec[7]);
      *(float4*)(pa + 64) = make_float4(nk[0], nk[1], nk[2], nk[3]); *(float4*)(pa + 68) = make_float4(nk[4], nk[5], nk[6], nk[7]);
      *(float4*)(pa + 128) = make_float4(bb[0], bb[1], bb[2], bb[3]); *(float4*)(pa + 132) = make_float4(bb[4], bb[5], bb[6], bb[7]);
      *(float4*)(pa + 192) = make_float4(kp[0], kp[1], kp[2], kp[3]); *(float4*)(pa + 196) = make_float4(kp[4], kp[5], kp[6], kp[7]);
      *(float4*)(pa + 256) = make_float4(rm[0], rm[1], rm[2], rm[3]); *(float4*)(pa + 260) = make_float4(rm[4], rm[5], rm[6], rm[7]);
      if (cs == 0) BON[tt] = bon;
    }
    __syncthreads();
    if (tc + 1 < 128) load_raw(tc + 1);
    {
      const float* pa0 = PA + ks * 8;
      const float* vs0 = Vst + row32;
      float4 d0 = *(const float4*)(pa0), d1 = *(const float4*)(pa0 + 4);
      float4 n0 = *(const float4*)(pa0 + 64), n1 = *(const float4*)(pa0 + 68);
      float4 b0 = *(const float4*)(pa0 + 128), b1 = *(const float4*)(pa0 + 132);
      float4 k0 = *(const float4*)(pa0 + 192), k1 = *(const float4*)(pa0 + 196);
      float4 r0 = *(const float4*)(pa0 + 256), r1 = *(const float4*)(pa0 + 260);
      float vv = vs0[0];
#pragma unroll 2
      for (int t = 0; t < 32; ++t) {
        const float* pa = pa0 + (t + 1) * 320;
        const float4 xd0 = *(const float4*)(pa), xd1 = *(const float4*)(pa + 4);
        const float4 xn0 = *(const float4*)(pa + 64), xn1 = *(const float4*)(pa + 68);
        const float4 xb0 = *(const float4*)(pa + 128), xb1 = *(const float4*)(pa + 132);
        const float4 xk0 = *(const float4*)(pa + 192), xk1 = *(const float4*)(pa + 196);
        const float4 xr0 = *(const float4*)(pa + 256), xr1 = *(const float4*)(pa + 260);
        const float xvv = vs0[(t + 1) * 32];
        __builtin_amdgcn_sched_barrier(0);
        float sa0 = S[0] * n0.x, sa1 = S[1] * n0.y;
        sa0 = fmaf(S[2], n0.z, sa0); sa1 = fmaf(S[3], n0.w, sa1);
        sa0 = fmaf(S[4], n1.x, sa0); sa1 = fmaf(S[5], n1.y, sa1);
        sa0 = fmaf(S[6], n1.z, sa0); sa1 = fmaf(S[7], n1.w, sa1);
        float sa = red8(sa0 + sa1);
        S[0] = fmaf(sa, b0.x, fmaf(S[0], d0.x, vv * k0.x)); S[1] = fmaf(sa, b0.y, fmaf(S[1], d0.y, vv * k0.y));
        S[2] = fmaf(sa, b0.z, fmaf(S[2], d0.z, vv * k0.z)); S[3] = fmaf(sa, b0.w, fmaf(S[3], d0.w, vv * k0.w));
        S[4] = fmaf(sa, b1.x, fmaf(S[4], d1.x, vv * k1.x)); S[5] = fmaf(sa, b1.y, fmaf(S[5], d1.y, vv * k1.y));
        S[6] = fmaf(sa, b1.z, fmaf(S[6], d1.z, vv * k1.z)); S[7] = fmaf(sa, b1.w, fmaf(S[7], d1.w, vv * k1.w));
        float y0 = S[0] * r0.x, y1 = S[1] * r0.y;
        y0 = fmaf(S[2], r0.z, y0); y1 = fmaf(S[3], r0.w, y1);
        y0 = fmaf(S[4], r1.x, y0); y1 = fmaf(S[5], r1.y, y1);
        y0 = fmaf(S[6], r1.z, y0); y1 = fmaf(S[7], r1.w, y1);
        float y = red8(y0 + y1);
        if (ks == 0) Yst[t * 32 + row32] = y;
        __builtin_amdgcn_sched_barrier(0);
        d0 = xd0; d1 = xd1; n0 = xn0; n1 = xn1; b0 = xb0; b1 = xb1; k0 = xk0; k1 = xk1; r0 = xr0; r1 = xr1; vv = xvv;
      }
    }
    __syncthreads();
    {
      const int c4 = cs & 3;
      float y8[8], v8[8];
      float4 t0 = *(const float4*)(Yst + tt * 32 + c4 * 8), t1 = *(const float4*)(Yst + tt * 32 + c4 * 8 + 4);
      y8[0] = t0.x; y8[1] = t0.y; y8[2] = t0.z; y8[3] = t0.w; y8[4] = t1.x; y8[5] = t1.y; y8[6] = t1.z; y8[7] = t1.w;
      float sm = 0.f, sq = 0.f;
#pragma unroll
      for (int e = 0; e < 8; ++e) { sm += y8[e]; sq += y8[e] * y8[e]; }
      sm = red4(sm); sq = red4(sq);
      const float bon = BON[tt];
      t0 = *(const float4*)(Vst + tt * 32 + c4 * 8); t1 = *(const float4*)(Vst + tt * 32 + c4 * 8 + 4);
      v8[0] = t0.x * bon; v8[1] = t0.y * bon; v8[2] = t0.z * bon; v8[3] = t0.w * bon; v8[4] = t1.x * bon; v8[5] = t1.y * bon; v8[6] = t1.z * bon; v8[7] = t1.w * bon;
      if (cs < 4 && !dry) {
        const size_t o = (size_t)lr * 1536 + head * 64 + 32 * half + cs * 8;
        *(uint4*)(YR + o) = pack8(y8);
        *(uint4*)(BV + o) = pack8(v8);
        if (cs == 0) {
          float* stp = ST + ((size_t)(lr * 24 + head) * 2 + half) * 2;
          stp[0] = sm; stp[1] = sq;
        }
      }
    }
  }
  if (c == 0 && !dry) {
    float* sp = STATE + ((size_t)((b * 24 + head) * 64 + 32 * half + row32)) * 64 + 8 * ks;
#pragma unroll
    for (int i = 0; i < 8; ++i) sp[i] = S[i];
  }
}

DI void phase_scan(const Params& p, int L, int c, char* smem, int* s_item, bool dry) {
  for (int item = blockIdx.x; item < 192; item += gridDim.x) scan_item(p, L, c, item, smem, dry);
  int* cnt = (int*)(p.ws + OFF_CNT) + (L * 2 + c) + (dry ? 8 : 0);
  for (;;) {
    __syncthreads();
    if (otid() == 0) *s_item = atomicAdd(cnt, 1);
    __syncthreads();
    const int item = *s_item;
    if (item >= 512) break;
    memattn_item(p, L, c, item, smem, dry);
  }
}

DI void phase_finalize(const Params& p, int L, int c) {
  const int j = L >> 1;
  u16* U = (u16*)(p.ws + OFF_U);
  const u16* YR = (const u16*)(p.ws + OFF_YR); const u16* BV = (const u16*)(p.ws + OFF_BV);
  const float* ST = (const float*)(p.ws + OFF_ST);
  const int G = gridDim.x;
  for (int idx = blockIdx.x * 256 + otid(); idx < TC * 192; idx += G * 256) {
    const int lr = idx / 192, c8 = idx - lr * 192, ch0 = c8 * 8, head = ch0 >> 6;
    const float4 st = *(const float4*)(ST + (size_t)(lr * 24 + head) * 4);
    const float mean = (st.x + st.z) * (1.f / 64.f);
    const float var = (st.y + st.w) * (1.f / 64.f) - mean * mean;
    const float rstd = rsqrtf(fmaxf(var, 0.f) + 64e-5f);
    float y[8], bv[8], g[8], o[8];
    unpack8(*(const uint4*)(YR + (size_t)lr * 1536 + ch0), y);
    unpack8(*(const uint4*)(BV + (size_t)lr * 1536 + ch0), bv);
    u16* gp = U + (size_t)lr * LDU_R + R_GATE + ch0;
    unpack8(*(const uint4*)gp, g);
    const float* gw = p.gn_w + j * 1536 + ch0; const float* gb = p.gn_b + j * 1536 + ch0;
#pragma unroll
    for (int e = 0; e < 8; ++e) o[e] = ((y[e] - mean) * rstd * gw[e] + gb[e] + bv[e]) * silu(g[e]);
    *(uint4*)gp = pack8(o);
  }
  if (c == 0) {
    u16* BND = (u16*)(p.ws + OFF_BND);
    for (int idx = blockIdx.x * 256 + otid(); idx < 4 * (SHIFTW / 8); idx += G * 256) {
      const int b = idx / (SHIFTW / 8), cc = idx - b * (SHIFTW / 8);
      *(uint4*)(BND + (size_t)b * SHIFTW + cc * 8) = *(const uint4*)(U + (size_t)(b * 4096 + 4095) * LDU_R + cc * 8);
    }
  }
}

enum { PH_PREP = 0, PH_NORM, PH_GEMM_IN, PH_KVPREP, PH_GEMM_UP, PH_ATTN, PH_SCAN, PH_FINALIZE, PH_GEMM_OUT, PH_FINAL };
constexpr int NSTEPS = 46;

DI void decode_step(int step, int& ph, int& L, int& c) {
  if (step == 0) { ph = PH_PREP; L = 0; c = 0; return; }
  if (step == NSTEPS - 1) { ph = PH_FINAL; L = 0; c = 0; return; }
  int s = step - 1;
  int pr = s / 22, rem = s - pr * 22;
  if (rem < 12) {
    L = 2 * pr; c = rem / 6; int k = rem - c * 6;
    ph = (k == 0) ? PH_NORM : (k == 1) ? PH_GEMM_IN : (k == 2) ? PH_KVPREP : (k == 3) ? PH_GEMM_UP : (k == 4) ? PH_ATTN : PH_GEMM_OUT;
  } else {
    rem -= 12; L = 2 * pr + 1; c = rem / 5; int k = rem - c * 5;
    ph = (k == 0) ? PH_NORM : (k == 1) ? PH_GEMM_IN : (k == 2) ? PH_SCAN : (k == 3) ? PH_FINALIZE : PH_GEMM_OUT;
  }
}

DI void run_step(const Params& p, int ph, int L, int c, char* smem, int* s_item, bool dry) {
  char* ws = p.ws;
  const bool rw = L & 1;
  const int j = L >> 1;
  switch (ph) {
    case PH_PREP: phase_prep(p, smem); break;
    case PH_NORM:
      phase_norm(p, L, c);
      if (L == 0 && c == 0) {
        EpiMemKV epi{(u16*)(ws + OFF_MEMK), (u16*)(ws + OFF_MEMVT)};
        gemm_phase<2>((const u16*)(ws + OFF_MEMH), 1024ull * 1024, 1024, (const u16*)(ws + OFF_WT_MEMKV), 1024ull * 1024, 1024, 4, 4, 8, 4, 1024, smem, epi);
      }
      break;
    case PH_GEMM_IN:
      if (!rw) {
        EpiStoreBf16 epi{(u16*)(ws + OFF_U), LDU_M, LDU_M, dry};
        gemm_phase<2>((const u16*)(ws + OFF_H), 0, 1024, (const u16*)(ws + OFF_WT_INMLA) + (size_t)j * 3328 * 1024, 0, 1024, 1, 64, 26, 8, 1024, smem, epi);
      } else {
        EpiStoreBf16 epi{(u16*)(ws + OFF_U), LDU_R, LDU_R, dry};
        gemm_phase<2>((const u16*)(ws + OFF_H), 0, 1024, (const u16*)(ws + OFF_WT_INRW) + (size_t)j * 7296 * 1024, 0, 1024, 1, 64, 57, 8, 1024, smem, epi);
      }
      break;
    case PH_KVPREP: phase_kvprep(p, L, c); break;
    case PH_GEMM_UP: {
      EpiUQ e1{(u16*)(ws + OFF_Q), (const float*)(ws + OFF_COS), (const float*)(ws + OFF_SIN), c, dry};
      gemm_phase<2>((const u16*)(ws + OFF_U) + M_CQ, 0, LDU_M, (const u16*)(ws + OFF_WT_UQ) + (size_t)j * 2304 * 384, 0, 384, 1, 64, 18, 8, 384, smem, e1);
      EpiUKV e2{(u16*)(ws + OFF_K), (u16*)(ws + OFF_VT), dry};
      gemm_phase<2>((const u16*)(ws + OFF_U) + M_CKV, 0, LDU_M, (const u16*)(ws + OFF_WT_UKV) + (size_t)j * 3072 * 256, 0, 256, 1, 64, 24, 8, 256, smem, e2);
    } break;
    case PH_ATTN: phase_attn(p, L, c, smem, s_item, dry); break;
    case PH_SCAN: phase_scan(p, L, c, smem, s_item, dry); break;
    case PH_FINALIZE: phase_finalize(p, L, c); break;
    case PH_GEMM_OUT: {
      EpiResid epi{(L == 0) ? p.x : (const float*)p.out, p.out, rw, c, dry};
      gemm_phase<2>((const u16*)(ws + OFF_U) + (rw ? R_GATE : M_GATE), 0, rw ? LDU_R : LDU_M, (const u16*)(ws + OFF_WT_OUT) + (size_t)L * 1024 * 2048, 0, 2048,
                 1, 64, 8, 8, 2048, smem, epi);
    } break;
    case PH_FINAL: phase_final_norm(p); break;
  }
}

__global__ void __launch_bounds__(256, 1) hybrid_megakernel(Params p, int s_lo, int s_hi, int coop, int probe_mask) {
  __shared__ __attribute__((aligned(16))) char smem[SMEM_BYTES];
  __shared__ int s_item;
  for (int st = s_lo; st < s_hi; ++st) {
    int ph, L, c;
    decode_step(st, ph, L, c);
    for (int rep = ((probe_mask >> ph) & 1) ? 0 : 1; rep < 2; ++rep) {
      run_step(p, ph, L, c, smem, &s_item, rep == 0);
      if (coop && (rep == 0 || st + 1 < s_hi)) cg::this_grid().sync();
    }
  }
}

extern "C" void kernel_launch(void* const* d_in, const int* in_sizes, int n_in, void* d_out, int out_size, void* d_ws, size_t ws_size,
                              hipStream_t stream) {
  if (ws_size < WS_NEED) { fprintf(stderr, "workspace too small: %zu < %zu\n", ws_size, (size_t)WS_NEED); return; }
  Params p;
  memset(&p, 0, sizeof(p));
  p.x = (const float*)d_in[0]; p.mem = (const float*)d_in[1]; p.pos = (const int*)d_in[2];
  p.norm_g = (const float*)d_in[3]; p.mem_norm_g = (const float*)d_in[4]; p.w_mem_kv = (const float*)d_in[5];
  p.w_in_mla = (const float*)d_in[6]; p.q_norm_g = (const float*)d_in[7]; p.kv_norm_g = (const float*)d_in[8];
  p.w_uq = (const float*)d_in[9]; p.w_ukv = (const float*)d_in[10]; p.w_in_rwkv = (const float*)d_in[11];
  p.mu = (const float*)d_in[12]; p.w0 = (const float*)d_in[13]; p.w2 = (const float*)d_in[14]; p.a0 = (const float*)d_in[15];
  p.a2 = (const float*)d_in[16]; p.k_k = (const float*)d_in[17]; p.k_a = (const float*)d_in[18]; p.r_k = (const float*)d_in[19];
  p.gn_w = (const float*)d_in[20]; p.gn_b = (const float*)d_in[21]; p.w_out = (const float*)d_in[22]; p.final_g = (const float*)d_in[23];
  p.out = (float*)d_out; p.ws = (char*)d_ws;
  static int grid_blocks = 0;
  if (!grid_blocks) {
    int dev = 0, cus = 0, per_cu = 0;
    hipGetDevice(&dev);
    hipDeviceGetAttribute(&cus, hipDeviceAttributeMultiprocessorCount, dev);
    hipOccupancyMaxActiveBlocksPerMultiprocessor(&per_cu, hybrid_megakernel, 256, 0);
    if (per_cu > 2) per_cu = 2;
    if (per_cu < 1) per_cu = 1;
    grid_blocks = cus * per_cu;
  }
#if MULTI_LAUNCH
  for (int s = 0; s < NSTEPS; ++s) hipLaunchKernelGGL(hybrid_megakernel, dim3(grid_blocks), dim3(256), 0, stream, p, s, s + 1, 0, 0);
#else
  int s_lo = 0, s_hi = NSTEPS, coop = 1, probe_mask = PROBE_MASK;
  void* args[] = {&p, &s_lo, &s_hi, &coop, &probe_mask};
  hipError_t e = hipLaunchCooperativeKernel((void*)hybrid_megakernel, dim3(grid_blocks), dim3(256), args, 0, stream);
  if (e != hipSuccess) fprintf(stderr, "cooperative launch failed: %s (grid %d)\n", hipGetErrorString(e), grid_blocks);
#endif
}
```

```cpp
#include <hip/hip_runtime.h>
#include <hip/hip_cooperative_groups.h>
#include <cstdio>
#include <cstring>
namespace cg = cooperative_groups;

#define PROBE_MASK 0
#ifndef MULTI_LAUNCH
#define MULTI_LAUNCH 0
#endif

#define DI __device__ __forceinline__
typedef unsigned short u16;
typedef __attribute__((ext_vector_type(8))) short bf16x8;
typedef __attribute__((ext_vector_type(16))) float f32x16;
typedef __attribute__((ext_vector_type(2))) __bf16 bf2_t;
typedef __attribute__((ext_vector_type(2))) float f2_t;
typedef __attribute__((ext_vector_type(4))) unsigned u32x4;
typedef __attribute__((ext_vector_type(2))) unsigned u32x2;
#define MFMA32(a, b, c) __builtin_amdgcn_mfma_f32_32x32x16_bf16((a), (b), (c), 0, 0, 0)

constexpr int SEQ = 8192, TC = 16384;
constexpr int LDU_M = 3264, LDU_R = 7296;
constexpr int M_CQ = 0, M_CKV = 384, M_KR = 640, M_QM = 704, M_GATE = 1216;
constexpr int R_R = 0, R_K = 1536, R_V = 3072, R_WD = 4608, R_AD = 4672, R_QM = 4736, R_GATE = 5248;
constexpr int SHIFTW = 4736;

constexpr size_t OFF_WT_MEMKV = 0;
constexpr size_t OFF_WT_INMLA = OFF_WT_MEMKV + 4ull * 1024 * 1024 * 2;
constexpr size_t OFF_WT_UQ    = OFF_WT_INMLA + 2ull * 3328 * 1024 * 2;
constexpr size_t OFF_WT_UKV   = OFF_WT_UQ + 2ull * 2304 * 384 * 2;
constexpr size_t OFF_WT_INRW  = OFF_WT_UKV + 2ull * 3072 * 256 * 2;
constexpr size_t OFF_WT_OUT   = OFF_WT_INRW + 2ull * 7296 * 1024 * 2;
constexpr size_t OFF_MEMH     = OFF_WT_OUT + 4ull * 1024 * 2048 * 2;
constexpr size_t OFF_MEMK     = OFF_MEMH + 4ull * 1024 * 1024 * 2;
constexpr size_t OFF_MEMVT    = OFF_MEMK + 4ull * 4 * 4 * 256 * 128 * 2;
constexpr size_t OFF_COS      = OFF_MEMVT + 4ull * 4 * 4 * 256 * 128 * 2;
constexpr size_t OFF_SIN      = OFF_COS + 32768ull * 32 * 4;
constexpr size_t OFF_CNT      = OFF_SIN + 32768ull * 32 * 4;
constexpr size_t OFF_STATE    = OFF_CNT + 256;
constexpr size_t OFF_BND      = OFF_STATE + 96ull * 4096 * 4;
constexpr size_t OFF_H        = OFF_BND + 4ull * 4736 * 2 + 128;
constexpr size_t OFF_R        = OFF_H + 16384ull * 1024 * 2;
constexpr size_t OFF_U        = OFF_R;
constexpr size_t OFF_Q        = OFF_R + 16384ull * 3264 * 2;
constexpr size_t OFF_K        = OFF_Q + 2ull * 12 * 8192 * 192 * 2;
constexpr size_t OFF_VT       = OFF_K + 2ull * 12 * 8192 * 192 * 2;
constexpr size_t OFF_YR       = OFF_R + 16384ull * 7296 * 2;
constexpr size_t OFF_BV       = OFF_YR + 16384ull * 1536 * 2;
constexpr size_t OFF_ST       = OFF_BV + 16384ull * 1536 * 2;
constexpr size_t OFF_BS       = OFF_ST + 16384ull * 24 * 4 * 4;
constexpr size_t WS_NEED      = OFF_BS + 16384ull * 24 * 4;

constexpr int SMEM_BYTES = 110592;

struct Params {
  const float *x, *mem; const int* pos;
  const float *norm_g, *mem_norm_g, *w_mem_kv, *w_in_mla, *q_norm_g, *kv_norm_g, *w_uq, *w_ukv, *w_in_rwkv;
  const float *mu, *w0, *w2, *a0, *a2, *k_k, *k_a, *r_k, *gn_w, *gn_b, *w_out, *final_g;
  float* out; char* ws;
};

DI int otid() { int t = threadIdx.x; asm volatile("" : "+v"(t)); return t; }
DI float bf2f(unsigned v) { return __uint_as_float(v << 16); }
DI unsigned pack2(float a, float b) { f2_t v = {a, b}; bf2_t r = __builtin_convertvector(v, bf2_t); return __builtin_bit_cast(unsigned, r); }
DI u16 f2bf(float a) { return (u16)(pack2(a, 0.f) & 0xffffu); }
DI float ex2(float x) { return __builtin_amdgcn_exp2f(x); }
DI float fexp(float x) { return __builtin_amdgcn_exp2f(x * 1.4426950408889634f); }
DI float frcp(float x) { return __builtin_amdgcn_rcpf(x); }
DI float silu(float g) { return g * frcp(1.f + fexp(-g)); }
DI float wave_sum(float v) { for (int o = 32; o > 0; o >>= 1) v += __shfl_xor(v, o); return v; }
DI int crow(int reg, int h) { return (reg & 3) + 8 * (reg >> 2) + 4 * h; }
DI float dppf(float x, const int ctrl_sel) {
  int xi;
  if (ctrl_sel == 0) xi = __builtin_amdgcn_update_dpp(0, __float_as_int(x), 0xB1, 0xf, 0xf, true);
  else if (ctrl_sel == 1) xi = __builtin_amdgcn_update_dpp(0, __float_as_int(x), 0x4E, 0xf, 0xf, true);
  else xi = __builtin_amdgcn_update_dpp(0, __float_as_int(x), 0x141, 0xf, 0xf, true);
  return __int_as_float(xi);
}
DI float red4(float x) { x += dppf(x, 0); x += dppf(x, 1); return x; }
DI float red8(float x) { x += dppf(x, 0); x += dppf(x, 1); x += dppf(x, 2); return x; }
DI int gtok(bool rw, int c, int lr) { return rw ? ((lr >> 12) * 8192 + c * 4096 + (lr & 4095)) : (c * 16384 + lr); }
DI void unpack8(const uint4& v, float* f) {
  f[0] = bf2f(v.x & 0xffffu); f[1] = bf2f(v.x >> 16); f[2] = bf2f(v.y & 0xffffu); f[3] = bf2f(v.y >> 16);
  f[4] = bf2f(v.z & 0xffffu); f[5] = bf2f(v.z >> 16); f[6] = bf2f(v.w & 0xffffu); f[7] = bf2f(v.w >> 16);
}
DI uint4 pack8(const float* f) { uint4 v; v.x = pack2(f[0], f[1]); v.y = pack2(f[2], f[3]); v.z = pack2(f[4], f[5]); v.w = pack2(f[6], f[7]); return v; }

DI void transpose_tile(const float* __restrict__ src, u16* __restrict__ dst, int K, int N, int tk, int tn, int drow, float* tile) {
  const int tid = otid();
  __syncthreads();
#pragma unroll
  for (int i = 0; i < 4; ++i) {
    int kr = (tid >> 4) + 16 * i, nc = (tid & 15) * 4;
    float4 v = *(const float4*)(src + (size_t)(tk * 64 + kr) * N + tn * 64 + nc);
    tile[kr * 65 + nc] = v.x; tile[kr * 65 + nc + 1] = v.y; tile[kr * 65 + nc + 2] = v.z; tile[kr * 65 + nc + 3] = v.w;
  }
  __syncthreads();
#pragma unroll
  for (int i = 0; i < 2; ++i) {
    int n = (tid >> 3) + 32 * i, kc = (tid & 7) * 8;
    float f[8];
#pragma unroll
    for (int e = 0; e < 8; ++e) f[e] = tile[(kc + e) * 65 + n];
    *(uint4*)(dst + (size_t)(drow + n) * K + tk * 64 + kc) = pack8(f);
  }
}

DI void rms_row_bf16(const float* __restrict__ src, const float* __restrict__ g, u16* __restrict__ dst, int lane) {
  float4 v[4]; float ss = 0.f;
#pragma unroll
  for (int i = 0; i < 4; ++i) { v[i] = *(const float4*)(src + i * 256 + lane * 4); ss += v[i].x * v[i].x + v[i].y * v[i].y + v[i].z * v[i].z + v[i].w * v[i].w; }
  ss = wave_sum(ss);
  float rs = rsqrtf(ss * (1.f / 1024.f) + 1e-6f);
#pragma unroll
  for (int i = 0; i < 4; ++i) {
    float4 gg = *(const float4*)(g + i * 256 + lane * 4);
    uint2 o; o.x = pack2(v[i].x * rs * gg.x, v[i].y * rs * gg.y); o.y = pack2(v[i].z * rs * gg.z, v[i].w * rs * gg.w);
    *(uint2*)(dst + i * 256 + lane * 4) = o;
  }
}

DI void phase_prep(const Params& p, char* smem) {
  const int tid = otid(), G = gridDim.x, bid = blockIdx.x;
  char* ws = p.ws;
  if (bid == 0 && tid < 64) ((int*)(ws + OFF_CNT))[tid] = 0;
  float* tile = (float*)smem;
  for (int g0 = bid; g0 < 9168; g0 += G) {
    int g = g0;
    const float* src = nullptr; u16* dst = nullptr; int K = 0, N = 0; size_t dstr = 0; bool ukv = false;
    if (g < 1024) { src = p.w_mem_kv; dst = (u16*)(ws + OFF_WT_MEMKV); K = 1024; N = 1024; dstr = 1024ull * 1024; }
    else if ((g -= 1024) < 1632) { src = p.w_in_mla; dst = (u16*)(ws + OFF_WT_INMLA); K = 1024; N = 3264; dstr = 3328ull * 1024; }
    else if ((g -= 1632) < 432) { src = p.w_uq; dst = (u16*)(ws + OFF_WT_UQ); K = 384; N = 2304; dstr = 2304ull * 384; }
    else if ((g -= 432) < 384) { src = p.w_ukv; dst = (u16*)(ws + OFF_WT_UKV); K = 256; N = 3072; dstr = 3072ull * 256; ukv = true; }
    else if ((g -= 384) < 3648) { src = p.w_in_rwkv; dst = (u16*)(ws + OFF_WT_INRW); K = 1024; N = 7296; dstr = 7296ull * 1024; }
    else { g -= 3648; src = p.w_out; dst = (u16*)(ws + OFF_WT_OUT); K = 2048; N = 1024; dstr = 1024ull * 2048; }
    int ntn = N >> 6, per = (K >> 6) * ntn;
    int m = g / per, t = g - m * per;
    int tk = t / ntn, tn = t - tk * ntn;
    int drow = tn * 64;
    if (ukv) { const int hd = drow >> 8, dd = drow & 255; drow = (dd < 128) ? (hd * 128 + dd) : (1536 + hd * 128 + dd - 128); }
    transpose_tile(src + (size_t)m * K * N, dst + (size_t)m * dstr, K, N, tk, tn, drow, tile);
  }
  for (int i = bid * 256 + tid; i < 2 * 64 * 1024 / 8; i += G * 256) {
    int m = i / (64 * 1024 / 8), r = i - m * (64 * 1024 / 8);
    uint4 z; z.x = z.y = z.z = z.w = 0u;
    *(uint4*)((u16*)(ws + OFF_WT_INMLA) + (size_t)m * 3328 * 1024 + 3264ull * 1024 + (size_t)r * 8) = z;
  }
  float* cs = (float*)(ws + OFF_COS); float* sn = (float*)(ws + OFF_SIN);
  for (int i = bid * 256 + tid; i < 32768 * 32; i += G * 256) {
    int tk = i >> 5, pi = i & 31;
    float inv_freq = (float)exp2(-(double)(2 * pi) / 64.0 * 13.287712379549449);
    float ang = (float)p.pos[tk] * inv_freq;
    double rev = (double)ang * 0.15915494309189535;
    float fr = (float)(rev - rint(rev));
    cs[i] = __builtin_amdgcn_cosf(fr); sn[i] = __builtin_amdgcn_sinf(fr);
  }
  const int w = tid >> 6, lane = tid & 63;
  for (int row = bid * 4 + w; row < 4096; row += G * 4) {
    int L = row >> 10, m = row & 1023;
    rms_row_bf16(p.mem + (size_t)m * 1024, p.mem_norm_g + L * 1024, (u16*)(ws + OFF_MEMH) + (size_t)row * 1024, lane);
  }
}

DI void phase_norm(const Params& p, int L, int c) {
  const int tid = otid(), w = tid >> 6, lane = tid & 63;
  const bool rw = L & 1;
  const float* xs = (L == 0) ? p.x : p.out;
  u16* H = (u16*)(p.ws + OFF_H);
  for (int lr = blockIdx.x * 4 + w; lr < TC; lr += gridDim.x * 4) {
    int gt = gtok(rw, c, lr);
    rms_row_bf16(xs + (size_t)gt * 1024, p.norm_g + L * 1024, H + (size_t)lr * 1024, lane);
  }
}

DI void phase_final_norm(const Params& p) {
  const int tid = otid(), w = tid >> 6, lane = tid & 63;
  for (int row = blockIdx.x * 4 + w; row < 32768; row += gridDim.x * 4) {
    float* xr = p.out + (size_t)row * 1024;
    float4 v[4]; float ss = 0.f;
#pragma unroll
    for (int i = 0; i < 4; ++i) { v[i] = *(const float4*)(xr + i * 256 + lane * 4); ss += v[i].x * v[i].x + v[i].y * v[i].y + v[i].z * v[i].z + v[i].w * v[i].w; }
    ss = wave_sum(ss);
    float rs = rsqrtf(ss * (1.f / 1024.f) + 1e-6f);
#pragma unroll
    for (int i = 0; i < 4; ++i) {
      float4 gg = *(const float4*)(p.final_g + i * 256 + lane * 4);
      float4 o; o.x = v[i].x * rs * gg.x; o.y = v[i].y * rs * gg.y; o.z = v[i].z * rs * gg.z; o.w = v[i].w * rs * gg.w;
      *(float4*)(xr + i * 256 + lane * 4) = o;
    }
  }
}

template <int TJ, bool SWAP, class Epi>
DI void gemm_phase(const u16* __restrict__ A, size_t strideAz, int lda, const u16* __restrict__ Bt, size_t strideBz, int ldb,
                   int Z, int Mt, int Nt, int GM, int K, char* smem, const Epi& epi) {
  constexpr int BN = 64 * TJ;
  constexpr int NB = BN / 32;
  const int tid = otid(), w = tid >> 6, lane = tid & 63, r = lane & 31, h = lane >> 5;
  const int wm = w >> 1, wn = w & 1;
  u16* As = (u16*)smem;
  u16* Bs = As + 2 * 256 * 72;
  const int G = gridDim.x, per = Mt * Nt, total = Z * per;
  const int lrow = tid >> 3, lcc = (tid & 7) * 8;
  const int nk = K >> 6;
  for (int base = 0; base < total; base += G) {
    const int t = blockIdx.x;
    const int q = base + (((G & 7) == 0) ? ((t & 7) * (G >> 3) + (t >> 3)) : t);
    if (q >= total) continue;
    const int z = q / per, qq = q - z * per;
    const int grp = qq / (GM * Nt), within = qq - grp * GM * Nt;
    const int mt = grp * GM + (within % GM), nt = within / GM;
    const u16* Ag = A + z * strideAz + (size_t)(mt * 256 + lrow) * lda + lcc;
    const u16* Bg = Bt + z * strideBz + (size_t)(nt * BN + lrow) * ldb + lcc;
    u32x4 ra[2][8], rb[2][NB];
    f32x16 acc[4][TJ];
#pragma unroll
    for (int i = 0; i < 4; ++i)
#pragma unroll
      for (int j = 0; j < TJ; ++j)
#pragma unroll
        for (int e = 0; e < 16; ++e) acc[i][j][e] = 0.f;
    __syncthreads();
#pragma unroll
    for (int u = 0; u < 2; ++u) {
#pragma unroll
      for (int i = 0; i < 8; ++i) ra[u][i] = *(const u32x4*)(Ag + (size_t)(32 * i) * lda + u * 64);
#pragma unroll
      for (int i = 0; i < NB; ++i) rb[u][i] = *(const u32x4*)(Bg + (size_t)(32 * i) * ldb + u * 64);
    }
#pragma unroll
    for (int i = 0; i < 8; ++i) *(u32x4*)(As + (lrow + 32 * i) * 72 + lcc) = ra[0][i];
#pragma unroll
    for (int i = 0; i < NB; ++i) *(u32x4*)(Bs + (lrow + 32 * i) * 72 + lcc) = rb[0][i];
    __syncthreads();
    for (int kt2 = 0; kt2 < nk; kt2 += 2) {
#pragma unroll
      for (int u = 0; u < 2; ++u) {
        const int kt = kt2 + u;
        if (kt + 2 < nk) {
#pragma unroll
          for (int i = 0; i < 8; ++i) ra[u][i] = *(const u32x4*)(Ag + (size_t)(32 * i) * lda + (kt + 2) * 64);
#pragma unroll
          for (int i = 0; i < NB; ++i) rb[u][i] = *(const u32x4*)(Bg + (size_t)(32 * i) * ldb + (kt + 2) * 64);
        }
        __builtin_amdgcn_sched_barrier(0);
        const u16* as = As + u * 256 * 72 + (128 * wm + r) * 72 + 8 * h;
        const u16* bs = Bs + u * BN * 72 + (32 * TJ * wn + r) * 72 + 8 * h;
#pragma unroll
        for (int ks = 0; ks < 4; ++ks) {
          bf16x8 af[4], bfr[TJ];
#pragma unroll
          for (int i = 0; i < 4; ++i) af[i] = *(const bf16x8*)(as + (32 * i) * 72 + 16 * ks);
#pragma unroll
          for (int j = 0; j < TJ; ++j) bfr[j] = *(const bf16x8*)(bs + (32 * j) * 72 + 16 * ks);
#pragma unroll
          for (int i = 0; i < 4; ++i)
#pragma unroll
            for (int j = 0; j < TJ; ++j) acc[i][j] = SWAP ? MFMA32(bfr[j], af[i], acc[i][j]) : MFMA32(af[i], bfr[j], acc[i][j]);
        }
        __builtin_amdgcn_sched_barrier(0);
        if (kt + 1 < nk) {
          u16* ad = As + (u ^ 1) * 256 * 72; u16* bd = Bs + (u ^ 1) * BN * 72;
#pragma unroll
          for (int i = 0; i < 8; ++i) *(u32x4*)(ad + (lrow + 32 * i) * 72 + lcc) = ra[u ^ 1][i];
#pragma unroll
          for (int i = 0; i < NB; ++i) *(u32x4*)(bd + (lrow + 32 * i) * 72 + lcc) = rb[u ^ 1][i];
        }
        __syncthreads();
      }
    }
#pragma unroll
    for (int i = 0; i < 4; ++i)
#pragma unroll
      for (int j = 0; j < TJ; ++j) {
        if (SWAP) epi(z, mt * 256 + 128 * wm + 32 * i + r, nt * BN + 32 * TJ * wn + 32 * j, h, acc[i][j]);
        else epi(z, mt * 256 + 128 * wm + 32 * i, nt * BN + 32 * TJ * wn + 32 * j + r, h, acc[i][j]);
      }
  }
}

struct EpiStoreBf16 {
  u16* C; int ldc; int ncols; bool dry;
  DI void operator()(int z, int row, int colbase, int h, const f32x16& a) const {
    if (dry) return;
#pragma unroll
    for (int g = 0; g < 4; ++g) {
      const int col = colbase + 8 * g + 4 * h;
      if (col < ncols) {
        u32x2 pk = {pack2(a[4 * g], a[4 * g + 1]), pack2(a[4 * g + 2], a[4 * g + 3])};
        *(u32x2*)(C + (size_t)row * ldc + col) = pk;
      }
    }
  }
};
struct EpiResid {
  const float* xin; float* xout; bool rw; int c; bool dry;
  DI void operator()(int z, int row, int colbase, int h, const f32x16& a) const {
    if (dry) return;
    const size_t o = (size_t)gtok(rw, c, row) * 1024 + colbase + 4 * h;
#pragma unroll
    for (int g = 0; g < 4; ++g) {
      float4 v = *(const float4*)(xin + o + 8 * g);
      v.x += a[4 * g]; v.y += a[4 * g + 1]; v.z += a[4 * g + 2]; v.w += a[4 * g + 3];
      *(float4*)(xout + o + 8 * g) = v;
    }
  }
};
struct EpiUQ {
  u16* Q; const float* cs; const float* sn; int c; bool dry;
  DI void operator()(int z, int row, int colbase, int h, const f32x16& a) const {
    if (dry) return;
    const int head = colbase / 192, db = colbase - head * 192;
    const int lb = row >> 13, s = row & 8191;
    u16* qp = Q + ((size_t)(lb * 12 + head) * 8192 + s) * 192 + db + 4 * h;
    const size_t ti = (size_t)(c * 16384 + row) * 32;
#pragma unroll
    for (int g = 0; g < 4; ++g) {
      float v0 = a[4 * g], v1 = a[4 * g + 1], v2 = a[4 * g + 2], v3 = a[4 * g + 3];
      if (db >= 128) {
        const int pi = (db - 128 + 8 * g + 4 * h) >> 1;
        const float2 cc = *(const float2*)(cs + ti + pi), ss = *(const float2*)(sn + ti + pi);
        const float o0 = v0 * cc.x - v1 * ss.x, o1 = v0 * ss.x + v1 * cc.x;
        const float o2 = v2 * cc.y - v3 * ss.y, o3 = v2 * ss.y + v3 * cc.y;
        v0 = o0; v1 = o1; v2 = o2; v3 = o3;
      }
      u32x2 pk = {pack2(v0, v1), pack2(v2, v3)};
      *(u32x2*)(qp + 8 * g) = pk;
    }
  }
};
struct EpiUK {
  u16* Kb; bool dry;
  DI void operator()(int z, int row, int colbase, int h, const f32x16& a) const {
    if (dry) return;
    const int head = colbase >> 7, db = colbase & 127;
    const int lb = row >> 13, s = row & 8191;
    u16* kp = Kb + ((size_t)(lb * 12 + head) * 8192 + s) * 192 + db + 4 * h;
#pragma unroll
    for (int g = 0; g < 4; ++g) {
      u32x2 pk = {pack2(a[4 * g], a[4 * g + 1]), pack2(a[4 * g + 2], a[4 * g + 3])};
      *(u32x2*)(kp + 8 * g) = pk;
    }
  }
};
struct EpiUV {
  u16* Vt; bool dry;
  DI void operator()(int z, int rowbase, int col, int h, const f32x16& a) const {
    if (dry) return;
    const int head = col >> 7, d = col & 127;
#pragma unroll
    for (int g = 0; g < 4; ++g) {
      int lr = rowbase + 8 * g + 4 * h; int lb = lr >> 13, s = lr & 8191;
      u32x2 pk = {pack2(a[4 * g], a[4 * g + 1]), pack2(a[4 * g + 2], a[4 * g + 3])};
      *(u32x2*)(Vt + ((size_t)(lb * 12 + head) * 128 + d) * 8192 + s) = pk;
    }
  }
};
struct EpiMemKV {
  u16* MK; u16* MVt;
  DI void operator()(int z, int rowbase, int col, int h, const f32x16& a) const {
    if (col < 512) {
      const int xh = col >> 7, d = col & 127;
#pragma unroll
      for (int e = 0; e < 16; ++e) {
        int m = rowbase + crow(e, h); int b = m >> 8, mi = m & 255;
        MK[((size_t)((z * 4 + b) * 4 + xh) * 256 + mi) * 128 + d] = f2bf(a[e]);
      }
    } else {
      const int n = col - 512, xh = n >> 7, d = n & 127;
#pragma unroll
      for (int g = 0; g < 4; ++g) {
        int m = rowbase + 8 * g + 4 * h; int b = m >> 8, mi = m & 255;
        uint2 pk; pk.x = pack2(a[4 * g], a[4 * g + 1]); pk.y = pack2(a[4 * g + 2], a[4 * g + 3]);
        *(uint2*)(MVt + ((size_t)((z * 4 + b) * 4 + xh) * 128 + d) * 256 + mi) = pk;
      }
    }
  }
};

DI void phase_kvprep(const Params& p, int L, int c) {
  const int tid = otid(), w = tid >> 6, lane = tid & 63;
  const int j = L >> 1;
  u16* U = (u16*)(p.ws + OFF_U); u16* Kb = (u16*)(p.ws + OFF_K);
  const float* cs = (const float*)(p.ws + OFF_COS); const float* sn = (const float*)(p.ws + OFF_SIN);
  for (int lr = blockIdx.x * 4 + w; lr < TC; lr += gridDim.x * 4) {
    u16* row = U + (size_t)lr * LDU_M;
    float fq[8], fk[8]; float sq = 0.f, sk = 0.f;
    if (lane < 48) { uint4 v = *(const uint4*)(row + M_CQ + lane * 8); unpack8(v, fq);
#pragma unroll
      for (int e = 0; e < 8; ++e) sq += fq[e] * fq[e]; }
    if (lane < 32) { uint4 v = *(const uint4*)(row + M_CKV + lane * 8); unpack8(v, fk);
#pragma unroll
      for (int e = 0; e < 8; ++e) sk += fk[e] * fk[e]; }
    sq = wave_sum(sq); sk = wave_sum(sk);
    float rq = rsqrtf(sq * (1.f / 384.f) + 1e-6f), rk = rsqrtf(sk * (1.f / 256.f) + 1e-6f);
    if (lane < 48) {
      const float* g = p.q_norm_g + j * 384 + lane * 8;
#pragma unroll
      for (int e = 0; e < 8; ++e) fq[e] = fq[e] * rq * g[e];
      *(uint4*)(row + M_CQ + lane * 8) = pack8(fq);
    }
    if (lane < 32) {
      const float* g = p.kv_norm_g + j * 256 + lane * 8;
#pragma unroll
      for (int e = 0; e < 8; ++e) fk[e] = fk[e] * rk * g[e];
      *(uint4*)(row + M_CKV + lane * 8) = pack8(fk);
    }
    if (lane < 8) {
      float f[8], o[8]; uint4 v = *(const uint4*)(row + M_KR + lane * 8); unpack8(v, f);
      int gt = c * 16384 + lr;
#pragma unroll
      for (int i = 0; i < 4; ++i) {
        float cc = cs[gt * 32 + lane * 4 + i], ss = sn[gt * 32 + lane * 4 + i];
        o[2 * i] = f[2 * i] * cc - f[2 * i + 1] * ss; o[2 * i + 1] = f[2 * i] * ss + f[2 * i + 1] * cc;
      }
      uint4 pk = pack8(o);
      int lb = lr >> 13, s = lr & 8191;
#pragma unroll
      for (int hd = 0; hd < 12; ++hd) *(uint4*)(Kb + ((size_t)(lb * 12 + hd) * 8192 + s) * 192 + 128 + lane * 8) = pk;
    }
  }
}

template <int DQK>
DI void attn_item(const u16* __restrict__ Qp, int ldq, const u16* __restrict__ Kp, const u16* __restrict__ Vtp, int ldv,
                  int nkt, int q0, bool causal, float c, u16* Yp, int ldy, char* smem, bool dry) {
  constexpr int KLD = DQK + 8;
  constexpr int NKC = DQK * 64 / 8 / 256;
  constexpr int NKS = DQK / 16;
  constexpr int CPR = DQK / 8;
  u16* Ks = (u16*)smem;
  u16* Vs = Ks + 64 * KLD;
  const int tid = otid(), w = tid >> 6, lane = tid & 63, r = lane & 31, h = lane >> 5;
  bf16x8 qf[NKS];
  {
    const u16* qrow = Qp + (size_t)(32 * w + r) * ldq + 8 * h;
#pragma unroll
    for (int ks = 0; ks < NKS; ++ks) qf[ks] = *(const bf16x8*)(qrow + 16 * ks);
  }
  f32x16 o[4];
#pragma unroll
  for (int dt = 0; dt < 4; ++dt)
#pragma unroll
    for (int e = 0; e < 16; ++e) o[dt][e] = 0.f;
  float m = -INFINITY, l = 0.f;
  u32x4 kst[NKC], vst[4];
  const int vd = tid >> 3, vc8 = tid & 7;
  {
#pragma unroll
    for (int i = 0; i < NKC; ++i) kst[i] = *(const u32x4*)(Kp + (size_t)(tid + 256 * i) * 8);
#pragma unroll
    for (int i = 0; i < 4; ++i) vst[i] = *(const u32x4*)(Vtp + (size_t)(vd + 32 * i) * ldv + vc8 * 8);
  }
  const int qmin = q0 + 32 * w;
  for (int kt = 0; kt < nkt; ++kt) {
    __syncthreads();
#pragma unroll
    for (int i = 0; i < NKC; ++i) { int id = tid + 256 * i; int row = id / CPR, cc = id - row * CPR; *(u32x4*)(Ks + row * KLD + cc * 8) = kst[i]; }
#pragma unroll
    for (int i = 0; i < 4; ++i) {
      u16* dst = Vs + (vd + 32 * i) * 72 + 16 * (vc8 >> 1) + 4 * (vc8 & 1);
      u32x2 lo = {vst[i].x, vst[i].y}, hi = {vst[i].z, vst[i].w};
      *(u32x2*)dst = lo; *(u32x2*)(dst + 8) = hi;
    }
    __syncthreads();
    if (kt + 1 < nkt) {
      const u16* kg = Kp + (size_t)(kt + 1) * 64 * DQK;
#pragma unroll
      for (int i = 0; i < NKC; ++i) kst[i] = *(const u32x4*)(kg + (size_t)(tid + 256 * i) * 8);
#pragma unroll
      for (int i = 0; i < 4; ++i) vst[i] = *(const u32x4*)(Vtp + (size_t)(vd + 32 * i) * ldv + (kt + 1) * 64 + vc8 * 8);
    }
    if (causal && kt * 64 > qmin + 31) continue;
    f32x16 s0, s1;
#pragma unroll
    for (int e = 0; e < 16; ++e) { s0[e] = 0.f; s1[e] = 0.f; }
    {
      const u16* k0 = Ks + r * KLD + 8 * h;
#pragma unroll
      for (int ks = 0; ks < NKS; ++ks) {
        bf16x8 a0 = *(const bf16x8*)(k0 + 16 * ks), a1 = *(const bf16x8*)(k0 + 32 * KLD + 16 * ks);
        s0 = MFMA32(a0, qf[ks], s0); s1 = MFMA32(a1, qf[ks], s1);
      }
    }
    if (causal && kt * 64 + 63 > qmin) {
      const int qi = qmin + r;
#pragma unroll
      for (int e = 0; e < 16; ++e) {
        int key = kt * 64 + crow(e, h);
        if (key > qi) s0[e] = -INFINITY;
        if (key + 32 > qi) s1[e] = -INFINITY;
      }
    }
    float mx = fmaxf(s0[0], s1[0]);
#pragma unroll
    for (int e = 1; e < 16; ++e) mx = fmaxf(mx, fmaxf(s0[e], s1[e]));
    mx = fmaxf(mx, __shfl_xor(mx, 32));
    if (__builtin_amdgcn_ballot_w64((mx - m) * c > 8.f) != 0ull) {
      const float mn = fmaxf(m, mx);
      const float alpha = ex2((m - mn) * c);
      m = mn;
      l *= alpha;
#pragma unroll
      for (int dt = 0; dt < 4; ++dt)
#pragma unroll
        for (int e = 0; e < 16; ++e) o[dt][e] *= alpha;
    }
    const float mc = m * c;
    float ps = 0.f;
#pragma unroll
    for (int e = 0; e < 16; ++e) { s0[e] = ex2(fmaf(s0[e], c, -mc)); s1[e] = ex2(fmaf(s1[e], c, -mc)); ps += s0[e] + s1[e]; }
    l += ps;
    bf16x8 pf[4];
    {
      u32x4 t;
      t.x = pack2(s0[0], s0[1]); t.y = pack2(s0[2], s0[3]); t.z = pack2(s0[4], s0[5]); t.w = pack2(s0[6], s0[7]); pf[0] = __builtin_bit_cast(bf16x8, t);
      t.x = pack2(s0[8], s0[9]); t.y = pack2(s0[10], s0[11]); t.z = pack2(s0[12], s0[13]); t.w = pack2(s0[14], s0[15]); pf[1] = __builtin_bit_cast(bf16x8, t);
      t.x = pack2(s1[0], s1[1]); t.y = pack2(s1[2], s1[3]); t.z = pack2(s1[4], s1[5]); t.w = pack2(s1[6], s1[7]); pf[2] = __builtin_bit_cast(bf16x8, t);
      t.x = pack2(s1[8], s1[9]); t.y = pack2(s1[10], s1[11]); t.z = pack2(s1[12], s1[13]); t.w = pack2(s1[14], s1[15]); pf[3] = __builtin_bit_cast(bf16x8, t);
    }
    {
      const u16* v0 = Vs + r * 72 + 8 * h;
#pragma unroll
      for (int kk = 0; kk < 4; ++kk)
#pragma unroll
        for (int dt = 0; dt < 4; ++dt) {
          bf16x8 a = *(const bf16x8*)(v0 + (32 * dt) * 72 + 16 * kk);
          o[dt] = MFMA32(a, pf[kk], o[dt]);
        }
    }
  }
  const float lt = l + __shfl_xor(l, 32);
  const float inv = 1.f / lt;
  if (dry) return;
  u16* yrow = Yp + (size_t)(32 * w + r) * ldy;
#pragma unroll
  for (int dt = 0; dt < 4; ++dt)
#pragma unroll
    for (int g = 0; g < 4; ++g) {
      const int d = 32 * dt + 8 * g + 4 * h;
      uint2 gv = *(const uint2*)(yrow + d);
      float g0 = bf2f(gv.x & 0xffffu), g1 = bf2f(gv.x >> 16), g2 = bf2f(gv.y & 0xffffu), g3 = bf2f(gv.y >> 16);
      uint2 ov;
      ov.x = pack2(o[dt][4 * g] * inv * silu(g0), o[dt][4 * g + 1] * inv * silu(g1));
      ov.y = pack2(o[dt][4 * g + 2] * inv * silu(g2), o[dt][4 * g + 3] * inv * silu(g3));
      *(uint2*)(yrow + d) = ov;
    }
}

DI void memattn_item(const Params& p, int L, int c, int item, char* smem, bool dry) {
  const bool rw = L & 1;
  const int ldu = rw ? LDU_R : LDU_M, oq = rw ? R_QM : M_QM, og = rw ? R_GATE : M_GATE;
  const int tile = item >> 2, xh = item & 3;
  const int b = gtok(rw, c, tile * 128) >> 13;
  u16* U = (u16*)(p.ws + OFF_U);
  const u16* MK = (const u16*)(p.ws + OFF_MEMK) + (size_t)((L * 4 + b) * 4 + xh) * 256 * 128;
  const u16* MV = (const u16*)(p.ws + OFF_MEMVT) + (size_t)((L * 4 + b) * 4 + xh) * 128 * 256;
  attn_item<128>(U + (size_t)tile * 128 * ldu + oq + xh * 128, ldu, MK, MV, 256, 4, 0, false,
                 0.08838834764831845f * 1.4426950408889634f, U + (size_t)tile * 128 * ldu + og + 1536 + xh * 128, ldu, smem, dry);
}

DI void phase_attn(const Params& p, int L, int c, char* smem, int* s_item, bool dry) {
  int* cnt = (int*)(p.ws + OFF_CNT) + (L * 2 + c) + (dry ? 8 : 0);
  u16* U = (u16*)(p.ws + OFF_U);
  const u16* Q = (const u16*)(p.ws + OFF_Q); const u16* Kb = (const u16*)(p.ws + OFF_K); const u16* Vt = (const u16*)(p.ws + OFF_VT);
  for (;;) {
    __syncthreads();
    if (otid() == 0) *s_item = atomicAdd(cnt, 1);
    __syncthreads();
    const int item = *s_item;
    if (item >= 1536 + 512) break;
    if (item < 1536) {
      const int qt = 63 - item / 24, bh = item % 24;
      const int lb = bh / 12, head = bh - lb * 12;
      const int q0 = qt * 128;
      attn_item<192>(Q + ((size_t)(lb * 12 + head) * 8192 + q0) * 192, 192, Kb + (size_t)(lb * 12 + head) * 8192 * 192,
                     Vt + (size_t)(lb * 12 + head) * 128 * 8192, 8192, 2 * (qt + 1), q0, true,
                     0.07216878364870323f * 1.4426950408889634f,
                     U + (size_t)(lb * 8192 + q0) * LDU_M + M_GATE + head * 128, LDU_M, smem, dry);
    } else {
      memattn_item(p, L, c, item - 1536, smem, dry);
    }
  }
}

DI void scan_item(const Params& p, int L, int c, int item, char* smem, bool dry) {
  const int tid = otid(), w = tid >> 6, lane = tid & 63, r = lane & 31, h = lane >> 5;
  const int j = L >> 1;
  const int b = item / 48, rem = item - b * 48, head = rem >> 1, half = rem & 1;
  float* PA  = (float*)smem;
  float* LO  = PA;
  float* Vst = PA + 32 * 5 * 64;
  float* Yst = Vst + 32 * 32;
  float* PRM = Yst + 32 * 32;
  float* BON = PRM + 10 * 64;
  u16* A1  = (u16*)(BON + 32);
  u16* W2t = A1 + 2 * 32 * 72;
  const u16* U = (const u16*)(p.ws + OFF_U);
  const u16* BND = (const u16*)(p.ws + OFF_BND);
  u16* YR = (u16*)(p.ws + OFF_YR); u16* BV = (u16*)(p.ws + OFF_BV);
  float* ST = (float*)(p.ws + OFF_ST); float* BS = (float*)(p.ws + OFF_BS);
  float* STATE = (float*)(p.ws + OFF_STATE);
  __syncthreads();
  if (tid < 64) {
    const float* mu = p.mu + j * SHIFTW;
    const int hc = head * 64 + tid;
    PRM[0 * 64 + tid] = mu[R_R + hc]; PRM[1 * 64 + tid] = mu[R_K + hc]; PRM[2 * 64 + tid] = mu[R_WD + tid]; PRM[3 * 64 + tid] = mu[R_AD + tid];
    PRM[4 * 64 + tid] = p.w0[j * 1536 + hc]; PRM[5 * 64 + tid] = p.a0[j * 1536 + hc]; PRM[6 * 64 + tid] = p.k_k[j * 1536 + hc];
    PRM[7 * 64 + tid] = p.k_a[j * 1536 + hc]; PRM[8 * 64 + tid] = p.r_k[j * 1536 + hc];
    PRM[9 * 64 + tid] = (tid < 32) ? mu[R_V + head * 64 + 32 * half + tid] : 0.f;
  }
  for (int e = tid; e < 8192; e += 256) {
    int arr = e >> 12, jj = (e >> 6) & 63, cc = e & 63;
    const float* src = (arr ? p.a2 : p.w2) + (size_t)j * 64 * 1536;
    W2t[(arr * 64 + cc) * 72 + jj] = f2bf(src[jj * 1536 + head * 64 + cc]);
  }
  const int rowl = lane >> 3, ks = lane & 7, row32 = 8 * w + rowl;
  float S[8];
  {
    float* sp = STATE + ((size_t)((b * 24 + head) * 64 + 32 * half + row32)) * 64 + 8 * ks;
#pragma unroll
    for (int i = 0; i < 8; ++i) S[i] = (c == 0) ? 0.f : sp[i];
  }
  const int tt = tid >> 3, cs = tid & 7;
  uint4 Rr_c, Rr_p, Rk_c, Rk_p, Rw_c, Rw_p, Ra_c, Ra_p, Rv_c, Rv_p;
  const uint4 zero4 = {0u, 0u, 0u, 0u};
  auto load_raw = [&](int tc) {
    const int lr = b * 4096 + tc * 32 + tt;
    const int s = c * 4096 + tc * 32 + tt;
    const u16* cur = U + (size_t)lr * LDU_R;
    const u16* prv = (s == 4096 && c == 1) ? (BND + (size_t)b * SHIFTW) : (cur - LDU_R);
    const bool hp = (s != 0);
    Rr_c = *(const uint4*)(cur + R_R + head * 64 + cs * 8);  Rr_p = hp ? *(const uint4*)(prv + R_R + head * 64 + cs * 8) : zero4;
    Rk_c = *(const uint4*)(cur + R_K + head * 64 + cs * 8);  Rk_p = hp ? *(const uint4*)(prv + R_K + head * 64 + cs * 8) : zero4;
    Rw_c = *(const uint4*)(cur + R_WD + cs * 8);             Rw_p = hp ? *(const uint4*)(prv + R_WD + cs * 8) : zero4;
    Ra_c = *(const uint4*)(cur + R_AD + cs * 8);             Ra_p = hp ? *(const uint4*)(prv + R_AD + cs * 8) : zero4;
    const int vo = R_V + head * 64 + 32 * half + (cs & 3) * 8;
    Rv_c = *(const uint4*)(cur + vo);                        Rv_p = hp ? *(const uint4*)(prv + vo) : zero4;
  };
  load_raw(0);
  __syncthreads();
  for (int tc = 0; tc < 128; ++tc) {
    const int lr = b * 4096 + tc * 32 + tt;
    float rm[8], km[8];
    {
      float cu[8], pv[8], t8[8];
      unpack8(Rr_c, cu); unpack8(Rr_p, pv);
#pragma unroll
      for (int e = 0; e < 8; ++e) rm[e] = cu[e] + (pv[e] - cu[e]) * PRM[0 * 64 + cs * 8 + e];
      unpack8(Rk_c, cu); unpack8(Rk_p, pv);
#pragma unroll
      for (int e = 0; e < 8; ++e) km[e] = cu[e] + (pv[e] - cu[e]) * PRM[1 * 64 + cs * 8 + e];
      unpack8(Rw_c, cu); unpack8(Rw_p, pv);
#pragma unroll
      for (int e = 0; e < 8; ++e) {
        float xw = cu[e] + (pv[e] - cu[e]) * PRM[2 * 64 + cs * 8 + e];
        float ee = ex2(xw * 2.8853900817779268f);
        t8[e] = 1.f - 2.f * frcp(ee + 1.f);
      }
      *(uint4*)(A1 + (0 * 32 + tt) * 72 + cs * 8) = pack8(t8);
      unpack8(Ra_c, cu); unpack8(Ra_p, pv);
#pragma unroll
      for (int e = 0; e < 8; ++e) t8[e] = cu[e] + (pv[e] - cu[e]) * PRM[3 * 64 + cs * 8 + e];
      *(uint4*)(A1 + (1 * 32 + tt) * 72 + cs * 8) = pack8(t8);
      unpack8(Rv_c, cu); unpack8(Rv_p, pv);
      if (cs < 4) {
#pragma unroll
        for (int e = 0; e < 8; ++e) Vst[tt * 32 + cs * 8 + e] = cu[e] + (pv[e] - cu[e]) * PRM[9 * 64 + cs * 8 + e];
      }
    }
    __syncthreads();
    {
      const int arr = w >> 1, nt = w & 1;
      f32x16 acc;
#pragma unroll
      for (int e = 0; e < 16; ++e) acc[e] = 0.f;
#pragma unroll
      for (int k4 = 0; k4 < 4; ++k4) {
        bf16x8 a = *(const bf16x8*)(A1 + (arr * 32 + r) * 72 + 16 * k4 + 8 * h);
        bf16x8 bw = *(const bf16x8*)(W2t + (arr * 64 + 32 * nt + r) * 72 + 16 * k4 + 8 * h);
        acc = MFMA32(a, bw, acc);
      }
#pragma unroll
      for (int e = 0; e < 16; ++e) LO[(arr * 32 + crow(e, h)) * 64 + 32 * nt + r] = acc[e];
    }
    __syncthreads();
    float lw[8], la[8];
    {
      float4 t0 = *(const float4*)(LO + (0 * 32 + tt) * 64 + cs * 8), t1 = *(const float4*)(LO + (0 * 32 + tt) * 64 + cs * 8 + 4);
      lw[0] = t0.x; lw[1] = t0.y; lw[2] = t0.z; lw[3] = t0.w; lw[4] = t1.x; lw[5] = t1.y; lw[6] = t1.z; lw[7] = t1.w;
      t0 = *(const float4*)(LO + (1 * 32 + tt) * 64 + cs * 8); t1 = *(const float4*)(LO + (1 * 32 + tt) * 64 + cs * 8 + 4);
      la[0] = t0.x; la[1] = t0.y; la[2] = t0.z; la[3] = t0.w; la[4] = t1.x; la[5] = t1.y; la[6] = t1.z; la[7] = t1.w;
    }
    __syncthreads();
    {
      float dec[8], kk[8], av[8], kp[8];
      float ssq = 0.f, bon = 0.f;
#pragma unroll
      for (int e = 0; e < 8; ++e) {
        const int ch = cs * 8 + e;
        float xx = -(lw[e] + PRM[4 * 64 + ch]);
        float sp = fmaxf(xx, 0.f) + __logf(1.f + fexp(-fabsf(xx)));
        float wv = -sp - 0.5f;
        dec[e] = fexp(-fexp(wv));
        float a = frcp(1.f + fexp(-(la[e] + PRM[5 * 64 + ch])));
        av[e] = a;
        kk[e] = km[e] * PRM[6 * 64 + ch];
        ssq += kk[e] * kk[e];
        kp[e] = km[e] * (1.f + (a - 1.f) * PRM[7 * 64 + ch]);
        bon += rm[e] * kp[e] * PRM[8 * 64 + ch];
      }
      ssq = red8(ssq); bon = red8(bon);
      const float inv = 1.f / fmaxf(sqrtf(ssq), 1e-12f);
      float nk[8], bb[8];
#pragma unroll
      for (int e = 0; e < 8; ++e) { float kn = kk[e] * inv; nk[e] = -kn; bb[e] = kn * av[e]; }
      float* pa = PA + tt * 320 + cs * 8;
      *(float4*)(pa) = make_float4(dec[0], dec[1], dec[2], dec[3]); *(float4*)(pa + 4) = make_float4(dec[4], dec[5], dec[6], dec[7]);
      *(float4*)(pa + 64) = make_float4(nk[0], nk[1], nk[2], nk[3]); *(float4*)(pa + 68) = make_float4(nk[4], nk[5], nk[6], nk[7]);
      *(float4*)(pa + 128) = make_float4(bb[0], bb[1], bb[2], bb[3]); *(float4*)(pa + 132) = make_float4(bb[4], bb[5], bb[6], bb[7]);
      *(float4*)(pa + 192) = make_float4(kp[0], kp[1], kp[2], kp[3]); *(float4*)(pa + 196) = make_float4(kp[4], kp[5], kp[6], kp[7]);
      *(float4*)(pa + 256) = make_float4(rm[0], rm[1], rm[2], rm[3]); *(float4*)(pa + 260) = make_float4(rm[4], rm[5], rm[6], rm[7]);
      if (cs == 0) BON[tt] = bon;
    }
    __syncthreads();
    if (tc + 1 < 128) load_raw(tc + 1);
    {
      const float* pa0 = PA + ks * 8;
      const float* vs0 = Vst + row32;
      float4 d0 = *(const float4*)(pa0), d1 = *(const float4*)(pa0 + 4);
      float4 n0 = *(const float4*)(pa0 + 64), n1 = *(const float4*)(pa0 + 68);
      float4 b0 = *(const float4*)(pa0 + 128), b1 = *(const float4*)(pa0 + 132);
      float4 k0 = *(const float4*)(pa0 + 192), k1 = *(const float4*)(pa0 + 196);
      float4 r0 = *(const float4*)(pa0 + 256), r1 = *(const float4*)(pa0 + 260);
      float vv = vs0[0];
#pragma unroll 2
      for (int t = 0; t < 32; ++t) {
        const float* pa = pa0 + (t + 1) * 320;
        const float4 xd0 = *(const float4*)(pa), xd1 = *(const float4*)(pa + 4);
        const float4 xn0 = *(const float4*)(pa + 64), xn1 = *(const float4*)(pa + 68);
        const float4 xb0 = *(const float4*)(pa + 128), xb1 = *(const float4*)(pa + 132);
        const float4 xk0 = *(const float4*)(pa + 192), xk1 = *(const float4*)(pa + 196);
        const float4 xr0 = *(const float4*)(pa + 256), xr1 = *(const float4*)(pa + 260);
        const float xvv = vs0[(t + 1) * 32];
        __builtin_amdgcn_sched_barrier(0);
        float sa0 = S[0] * n0.x, sa1 = S[1] * n0.y;
        sa0 = fmaf(S[2], n0.z, sa0); sa1 = fmaf(S[3], n0.w, sa1);
        sa0 = fmaf(S[4], n1.x, sa0); sa1 = fmaf(S[5], n1.y, sa1);
        sa0 = fmaf(S[6], n1.z, sa0); sa1 = fmaf(S[7], n1.w, sa1);
        float sa = red8(sa0 + sa1);
        S[0] = fmaf(sa, b0.x, fmaf(S[0], d0.x, vv * k0.x)); S[1] = fmaf(sa, b0.y, fmaf(S[1], d0.y, vv * k0.y));
        S[2] = fmaf(sa, b0.z, fmaf(S[2], d0.z, vv * k0.z)); S[3] = fmaf(sa, b0.w, fmaf(S[3], d0.w, vv * k0.w));
        S[4] = fmaf(sa, b1.x, fmaf(S[4], d1.x, vv * k1.x)); S[5] = fmaf(sa, b1.y, fmaf(S[5], d1.y, vv * k1.y));
        S[6] = fmaf(sa, b1.z, fmaf(S[6], d1.z, vv * k1.z)); S[7] = fmaf(sa, b1.w, fmaf(S[7], d1.w, vv * k1.w));
        float y0 = S[0] * r0.x, y1 = S[1] * r0.y;
        y0 = fmaf(S[2], r0.z, y0); y1 = fmaf(S[3], r0.w, y1);
        y0 = fmaf(S[4], r1.x, y0); y1 = fmaf(S[5], r1.y, y1);
        y0 = fmaf(S[6], r1.z, y0); y1 = fmaf(S[7], r1.w, y1);
        float y = red8(y0 + y1);
        if (ks == 0) Yst[t * 32 + row32] = y;
        __builtin_amdgcn_sched_barrier(0);
        d0 = xd0; d1 = xd1; n0 = xn0; n1 = xn1; b0 = xb0; b1 = xb1; k0 = xk0; k1 = xk1; r0 = xr0; r1 = xr1; vv = xvv;
      }
    }
    __syncthreads();
    {
      const int c4 = cs & 3;
      float y8[8], v8[8];
      float4 t0 = *(const float4*)(Yst + tt * 32 + c4 * 8), t1 = *(const float4*)(Yst + tt * 32 + c4 * 8 + 4);
      y8[0] = t0.x; y8[1] = t0.y; y8[2] = t0.z; y8[3] = t0.w; y8[4] = t1.x; y8[5] = t1.y; y8[6] = t1.z; y8[7] = t1.w;
      float sm = 0.f, sq = 0.f;
#pragma unroll
      for (int e = 0; e < 8; ++e) { sm += y8[e]; sq += y8[e] * y8[e]; }
      sm = red4(sm); sq = red4(sq);
      const float bon = BON[tt];
      t0 = *(const float4*)(Vst + tt * 32 + c4 * 8); t1 = *(const float4*)(Vst + tt * 32 + c4 * 8 + 4);
      v8[0] = t0.x * bon; v8[1] = t0.y * bon; v8[2] = t0.z * bon; v8[3] = t0.w * bon; v8[4] = t1.x * bon; v8[5] = t1.y * bon; v8[6] = t1.z * bon; v8[7] = t1.w * bon;
      if (cs < 4 && !dry) {
        const size_t o = (size_t)lr * 1536 + head * 64 + 32 * half + cs * 8;
        *(uint4*)(YR + o) = pack8(y8);
        *(uint4*)(BV + o) = pack8(v8);
        if (cs == 0) {
          float* stp = ST + ((size_t)(lr * 24 + head) * 2 + half) * 2;
          stp[0] = sm; stp[1] = sq;
        }
      }
    }
  }
  if (c == 0 && !dry) {
    float* sp = STATE + ((size_t)((b * 24 + head) * 64 + 32 * half + row32)) * 64 + 8 * ks;
#pragma unroll
    for (int i = 0; i < 8; ++i) sp[i] = S[i];
  }
}

DI void phase_scan(const Params& p, int L, int c, char* smem, int* s_item, bool dry) {
  for (int item = blockIdx.x; item < 192; item += gridDim.x) scan_item(p, L, c, item, smem, dry);
  int* cnt = (int*)(p.ws + OFF_CNT) + (L * 2 + c) + (dry ? 8 : 0);
  for (;;) {
    __syncthreads();
    if (otid() == 0) *s_item = atomicAdd(cnt, 1);
    __syncthreads();
    const int item = *s_item;
    if (item >= 512) break;
    memattn_item(p, L, c, item, smem, dry);
  }
}

DI void phase_finalize(const Params& p, int L, int c) {
  const int j = L >> 1;
  u16* U = (u16*)(p.ws + OFF_U);
  const u16* YR = (const u16*)(p.ws + OFF_YR); const u16* BV = (const u16*)(p.ws + OFF_BV);
  const float* ST = (const float*)(p.ws + OFF_ST);
  const int G = gridDim.x;
  for (int idx = blockIdx.x * 256 + otid(); idx < TC * 192; idx += G * 256) {
    const int lr = idx / 192, c8 = idx - lr * 192, ch0 = c8 * 8, head = ch0 >> 6;
    const float4 st = *(const float4*)(ST + (size_t)(lr * 24 + head) * 4);
    const float mean = (st.x + st.z) * (1.f / 64.f);
    const float var = (st.y + st.w) * (1.f / 64.f) - mean * mean;
    const float rstd = rsqrtf(fmaxf(var, 0.f) + 64e-5f);
    float y[8], bv[8], g[8], o[8];
    unpack8(*(const uint4*)(YR + (size_t)lr * 1536 + ch0), y);
    unpack8(*(const uint4*)(BV + (size_t)lr * 1536 + ch0), bv);
    u16* gp = U + (size_t)lr * LDU_R + R_GATE + ch0;
    unpack8(*(const uint4*)gp, g);
    const float* gw = p.gn_w + j * 1536 + ch0; const float* gb = p.gn_b + j * 1536 + ch0;
#pragma unroll
    for (int e = 0; e < 8; ++e) o[e] = ((y[e] - mean) * rstd * gw[e] + gb[e] + bv[e]) * silu(g[e]);
    *(uint4*)gp = pack8(o);
  }
  if (c == 0) {
    u16* BND = (u16*)(p.ws + OFF_BND);
    for (int idx = blockIdx.x * 256 + otid(); idx < 4 * (SHIFTW / 8); idx += G * 256) {
      const int b = idx / (SHIFTW / 8), cc = idx - b * (SHIFTW / 8);
      *(uint4*)(BND + (size_t)b * SHIFTW + cc * 8) = *(const uint4*)(U + (size_t)(b * 4096 + 4095) * LDU_R + cc * 8);
    }
  }
}

enum { PH_PREP = 0, PH_NORM, PH_GEMM_IN, PH_KVPREP, PH_GEMM_UP, PH_ATTN, PH_SCAN, PH_FINALIZE, PH_GEMM_OUT, PH_FINAL };
constexpr int NSTEPS = 46;

DI void decode_step(int step, int& ph, int& L, int& c) {
  if (step == 0) { ph = PH_PREP; L = 0; c = 0; return; }
  if (step == NSTEPS - 1) { ph = PH_FINAL; L = 0; c = 0; return; }
  int s = step - 1;
  int pr = s / 22, rem = s - pr * 22;
  if (rem < 12) {
    L = 2 * pr; c = rem / 6; int k = rem - c * 6;
    ph = (k == 0) ? PH_NORM : (k == 1) ? PH_GEMM_IN : (k == 2) ? PH_KVPREP : (k == 3) ? PH_GEMM_UP : (k == 4) ? PH_ATTN : PH_GEMM_OUT;
  } else {
    rem -= 12; L = 2 * pr + 1; c = rem / 5; int k = rem - c * 5;
    ph = (k == 0) ? PH_NORM : (k == 1) ? PH_GEMM_IN : (k == 2) ? PH_SCAN : (k == 3) ? PH_FINALIZE : PH_GEMM_OUT;
  }
}

DI void run_step(const Params& p, int ph, int L, int c, char* smem, int* s_item, bool dry) {
  char* ws = p.ws;
  const bool rw = L & 1;
  const int j = L >> 1;
  switch (ph) {
    case PH_PREP: phase_prep(p, smem); break;
    case PH_NORM:
      phase_norm(p, L, c);
      if (L == 0 && c == 0) {
        EpiMemKV epi{(u16*)(ws + OFF_MEMK), (u16*)(ws + OFF_MEMVT)};
        gemm_phase<2, false>((const u16*)(ws + OFF_MEMH), 1024ull * 1024, 1024, (const u16*)(ws + OFF_WT_MEMKV), 1024ull * 1024, 1024, 4, 4, 8, 4, 1024, smem, epi);
      }
      break;
    case PH_GEMM_IN:
      if (!rw) {
        EpiStoreBf16 epi{(u16*)(ws + OFF_U), LDU_M, LDU_M, dry};
        gemm_phase<2, true>((const u16*)(ws + OFF_H), 0, 1024, (const u16*)(ws + OFF_WT_INMLA) + (size_t)j * 3328 * 1024, 0, 1024, 1, 64, 26, 8, 1024, smem, epi);
      } else {
        EpiStoreBf16 epi{(u16*)(ws + OFF_U), LDU_R, LDU_R, dry};
        gemm_phase<2, true>((const u16*)(ws + OFF_H), 0, 1024, (const u16*)(ws + OFF_WT_INRW) + (size_t)j * 7296 * 1024, 0, 1024, 1, 64, 57, 8, 1024, smem, epi);
      }
      break;
    case PH_KVPREP: phase_kvprep(p, L, c); break;
    case PH_GEMM_UP: {
      EpiUQ e1{(u16*)(ws + OFF_Q), (const float*)(ws + OFF_COS), (const float*)(ws + OFF_SIN), c, dry};
      gemm_phase<2, true>((const u16*)(ws + OFF_U) + M_CQ, 0, LDU_M, (const u16*)(ws + OFF_WT_UQ) + (size_t)j * 2304 * 384, 0, 384, 1, 64, 18, 8, 384, smem, e1);
      EpiUK e2{(u16*)(ws + OFF_K), dry};
      gemm_phase<2, true>((const u16*)(ws + OFF_U) + M_CKV, 0, LDU_M, (const u16*)(ws + OFF_WT_UKV) + (size_t)j * 3072 * 256, 0, 256, 1, 64, 12, 8, 256, smem, e2);
      EpiUV e3{(u16*)(ws + OFF_VT), dry};
      gemm_phase<2, false>((const u16*)(ws + OFF_U) + M_CKV, 0, LDU_M, (const u16*)(ws + OFF_WT_UKV) + (size_t)j * 3072 * 256 + 1536ull * 256, 0, 256, 1, 64, 12, 8, 256, smem, e3);
    } break;
    case PH_ATTN: phase_attn(p, L, c, smem, s_item, dry); break;
    case PH_SCAN: phase_scan(p, L, c, smem, s_item, dry); break;
    case PH_FINALIZE: phase_finalize(p, L, c); break;
    case PH_GEMM_OUT: {
      EpiResid epi{(L == 0) ? p.x : (const float*)p.out, p.out, rw, c, dry};
      gemm_phase<2, true>((const u16*)(ws + OFF_U) + (rw ? R_GATE : M_GATE), 0, rw ? LDU_R : LDU_M, (const u16*)(ws + OFF_WT_OUT) + (size_t)L * 1024 * 2048, 0, 2048,
                 1, 64, 8, 8, 2048, smem, epi);
    } break;
    case PH_FINAL: phase_final_norm(p); break;
  }
}

__global__ void __launch_bounds__(256, 1) hybrid_megakernel(Params p, int s_lo, int s_hi, int coop, int probe_mask) {
  __shared__ __attribute__((aligned(16))) char smem[SMEM_BYTES];
  __shared__ int s_item;
  for (int st = s_lo; st < s_hi; ++st) {
    int ph, L, c;
    decode_step(st, ph, L, c);
    for (int rep = ((probe_mask >> ph) & 1) ? 0 : 1; rep < 2; ++rep) {
      run_step(p, ph, L, c, smem, &s_item, rep == 0);
      if (coop && (rep == 0 || st + 1 < s_hi)) cg::this_grid().sync();
    }
  }
}

extern "C" void kernel_launch(void* const* d_in, const int* in_sizes, int n_in, void* d_out, int out_size, void* d_ws, size_t ws_size,
                              hipStream_t stream) {
  if (ws_size < WS_NEED) { fprintf(stderr, "workspace too small: %zu < %zu\n", ws_size, (size_t)WS_NEED); return; }
  Params p;
  memset(&p, 0, sizeof(p));
  p.x = (const float*)d_in[0]; p.mem = (const float*)d_in[1]; p.pos = (const int*)d_in[2];
  p.norm_g = (const float*)d_in[3]; p.mem_norm_g = (const float*)d_in[4]; p.w_mem_kv = (const float*)d_in[5];
  p.w_in_mla = (const float*)d_in[6]; p.q_norm_g = (const float*)d_in[7]; p.kv_norm_g = (const float*)d_in[8];
  p.w_uq = (const float*)d_in[9]; p.w_ukv = (const float*)d_in[10]; p.w_in_rwkv = (const float*)d_in[11];
  p.mu = (const float*)d_in[12]; p.w0 = (const float*)d_in[13]; p.w2 = (const float*)d_in[14]; p.a0 = (const float*)d_in[15];
  p.a2 = (const float*)d_in[16]; p.k_k = (const float*)d_in[17]; p.k_a = (const float*)d_in[18]; p.r_k = (const float*)d_in[19];
  p.gn_w = (const float*)d_in[20]; p.gn_b = (const float*)d_in[21]; p.w_out = (const float*)d_in[22]; p.final_g = (const float*)d_in[23];
  p.out = (float*)d_out; p.ws = (char*)d_ws;
  static int grid_blocks = 0;
  if (!grid_blocks) {
    int dev = 0, cus = 0, per_cu = 0;
    hipGetDevice(&dev);
    hipDeviceGetAttribute(&cus, hipDeviceAttributeMultiprocessorCount, dev);
    hipOccupancyMaxActiveBlocksPerMultiprocessor(&per_cu, hybrid_megakernel, 256, 0);
    if (per_cu > 2) per_cu = 2;
    if (per_cu < 1) per_cu = 1;
    grid_blocks = cus * per_cu;
  }
#if MULTI_LAUNCH
  for (int s = 0; s < NSTEPS; ++s) hipLaunchKernelGGL(hybrid_megakernel, dim3(grid_blocks), dim3(256), 0, stream, p, s, s + 1, 0, 0);
#else
  int s_lo = 0, s_hi = NSTEPS, coop = 1, probe_mask = PROBE_MASK;
  void* args[] = {&p, &s_lo, &s_hi, &coop, &probe_mask};
  hipError_t e = hipLaunchCooperativeKernel((void*)hybrid_megakernel, dim3(grid_blocks), dim3(256), args, 0, stream);
  if (e != hipSuccess) fprintf(stderr, "cooperative launch failed: %s (grid %d)\n", hipGetErrorString(e), grid_blocks);
#endif
}
```

```cpp
#include <hip/hip_runtime.h>
#include <hip/hip_cooperative_groups.h>
#include <cstdio>
#include <cstring>
namespace cg = cooperative_groups;

#define PROBE_MASK 0
#define EXTRA_SYNCS 0
#define HYP1 0
#define HYP2 0
#ifndef MULTI_LAUNCH
#define MULTI_LAUNCH 0
#endif

#define DI __device__ __forceinline__
typedef unsigned short u16;
typedef __attribute__((ext_vector_type(8))) short bf16x8;
typedef __attribute__((ext_vector_type(16))) float f32x16;
typedef __attribute__((ext_vector_type(2))) __bf16 bf2_t;
typedef __attribute__((ext_vector_type(2))) float f2_t;
typedef __attribute__((ext_vector_type(4))) unsigned u32x4;
typedef __attribute__((ext_vector_type(2))) unsigned u32x2;
#define MFMA32(a, b, c) __builtin_amdgcn_mfma_f32_32x32x16_bf16((a), (b), (c), 0, 0, 0)

constexpr int SEQ = 8192, TC = 16384;
constexpr int LDU_M = 3264, LDU_R = 7296;
constexpr int M_CQ = 0, M_CKV = 384, M_KR = 640, M_QM = 704, M_GATE = 1216;
constexpr int R_R = 0, R_K = 1536, R_V = 3072, R_WD = 4608, R_AD = 4672, R_QM = 4736, R_GATE = 5248;
constexpr int SHIFTW = 4736;

constexpr size_t OFF_WT_MEMKV = 0;
constexpr size_t OFF_WT_INMLA = OFF_WT_MEMKV + 4ull * 1024 * 1024 * 2;
constexpr size_t OFF_WT_UQ    = OFF_WT_INMLA + 2ull * 3328 * 1024 * 2;
constexpr size_t OFF_WT_UKV   = OFF_WT_UQ + 2ull * 2304 * 384 * 2;
constexpr size_t OFF_WT_INRW  = OFF_WT_UKV + 2ull * 3072 * 256 * 2;
constexpr size_t OFF_WT_OUT   = OFF_WT_INRW + 2ull * 7296 * 1024 * 2;
constexpr size_t OFF_MEMH     = OFF_WT_OUT + 4ull * 1024 * 2048 * 2;
constexpr size_t OFF_MEMK     = OFF_MEMH + 4ull * 1024 * 1024 * 2;
constexpr size_t OFF_MEMVT    = OFF_MEMK + 4ull * 4 * 4 * 256 * 128 * 2;
constexpr size_t OFF_COS      = OFF_MEMVT + 4ull * 4 * 4 * 256 * 128 * 2;
constexpr size_t OFF_SIN      = OFF_COS + 32768ull * 32 * 4;
constexpr size_t OFF_CNT      = OFF_SIN + 32768ull * 32 * 4;
constexpr size_t OFF_BAR      = OFF_CNT + 256;
constexpr size_t OFF_STATE    = OFF_BAR + 256;
constexpr size_t OFF_BND      = OFF_STATE + 96ull * 4096 * 4;
constexpr size_t OFF_H        = OFF_BND + 4ull * 4736 * 2 + 128;
constexpr size_t OFF_R        = OFF_H + 16384ull * 1024 * 2;
constexpr size_t OFF_U        = OFF_R;
constexpr size_t OFF_Q        = OFF_R + 16384ull * 3264 * 2;
constexpr size_t OFF_K        = OFF_Q + 2ull * 12 * 8192 * 192 * 2;
constexpr size_t OFF_VT       = OFF_K + 2ull * 12 * 8192 * 192 * 2;
constexpr size_t OFF_YR       = OFF_R + 16384ull * 7296 * 2;
constexpr size_t OFF_BV       = OFF_YR + 16384ull * 1536 * 2;
constexpr size_t OFF_ST       = OFF_BV + 16384ull * 1536 * 2;
constexpr size_t OFF_BS       = OFF_ST + 16384ull * 24 * 4 * 4;
constexpr size_t WS_NEED      = OFF_BS + 16384ull * 24 * 4;

constexpr int SMEM_BYTES = 110592;

struct Params {
  const float *x, *mem; const int* pos;
  const float *norm_g, *mem_norm_g, *w_mem_kv, *w_in_mla, *q_norm_g, *kv_norm_g, *w_uq, *w_ukv, *w_in_rwkv;
  const float *mu, *w0, *w2, *a0, *a2, *k_k, *k_a, *r_k, *gn_w, *gn_b, *w_out, *final_g;
  float* out; char* ws;
};

DI int otid() { int t = threadIdx.x; asm volatile("" : "+v"(t)); return t; }
DI float bf2f(unsigned v) { return __uint_as_float(v << 16); }
DI unsigned pack2(float a, float b) { f2_t v = {a, b}; bf2_t r = __builtin_convertvector(v, bf2_t); return __builtin_bit_cast(unsigned, r); }
DI u16 f2bf(float a) { return (u16)(pack2(a, 0.f) & 0xffffu); }
DI float ex2(float x) { return __builtin_amdgcn_exp2f(x); }
DI float fexp(float x) { return __builtin_amdgcn_exp2f(x * 1.4426950408889634f); }
DI float frcp(float x) { return __builtin_amdgcn_rcpf(x); }
DI float silu(float g) { return g * frcp(1.f + fexp(-g)); }
DI float wave_sum(float v) { for (int o = 32; o > 0; o >>= 1) v += __shfl_xor(v, o); return v; }
DI int crow(int reg, int h) { return (reg & 3) + 8 * (reg >> 2) + 4 * h; }
DI float dppf(float x, const int ctrl_sel) {
  int xi;
  if (ctrl_sel == 0) xi = __builtin_amdgcn_update_dpp(0, __float_as_int(x), 0xB1, 0xf, 0xf, true);
  else if (ctrl_sel == 1) xi = __builtin_amdgcn_update_dpp(0, __float_as_int(x), 0x4E, 0xf, 0xf, true);
  else xi = __builtin_amdgcn_update_dpp(0, __float_as_int(x), 0x141, 0xf, 0xf, true);
  return __int_as_float(xi);
}
DI float red4(float x) { x += dppf(x, 0); x += dppf(x, 1); return x; }
DI float red8(float x) { x += dppf(x, 0); x += dppf(x, 1); x += dppf(x, 2); return x; }
DI int gtok(bool rw, int c, int lr) { return rw ? ((lr >> 12) * 8192 + c * 4096 + (lr & 4095)) : (c * 16384 + lr); }
DI void unpack8(const uint4& v, float* f) {
  f[0] = bf2f(v.x & 0xffffu); f[1] = bf2f(v.x >> 16); f[2] = bf2f(v.y & 0xffffu); f[3] = bf2f(v.y >> 16);
  f[4] = bf2f(v.z & 0xffffu); f[5] = bf2f(v.z >> 16); f[6] = bf2f(v.w & 0xffffu); f[7] = bf2f(v.w >> 16);
}
DI uint4 pack8(const float* f) { uint4 v; v.x = pack2(f[0], f[1]); v.y = pack2(f[2], f[3]); v.z = pack2(f[4], f[5]); v.w = pack2(f[6], f[7]); return v; }

DI void transpose_tile(const float* __restrict__ src, u16* __restrict__ dst, int K, int N, int tk, int tn, int drow, float* tile) {
  const int tid = otid();
  __syncthreads();
#pragma unroll
  for (int i = 0; i < 4; ++i) {
    int kr = (tid >> 4) + 16 * i, nc = (tid & 15) * 4;
    float4 v = *(const float4*)(src + (size_t)(tk * 64 + kr) * N + tn * 64 + nc);
    tile[kr * 65 + nc] = v.x; tile[kr * 65 + nc + 1] = v.y; tile[kr * 65 + nc + 2] = v.z; tile[kr * 65 + nc + 3] = v.w;
  }
  __syncthreads();
#pragma unroll
  for (int i = 0; i < 2; ++i) {
    int n = (tid >> 3) + 32 * i, kc = (tid & 7) * 8;
    float f[8];
#pragma unroll
    for (int e = 0; e < 8; ++e) f[e] = tile[(kc + e) * 65 + n];
    *(uint4*)(dst + (size_t)(drow + n) * K + tk * 64 + kc) = pack8(f);
  }
}

DI void rms_row_bf16(const float* __restrict__ src, const float* __restrict__ g, u16* __restrict__ dst, int lane) {
  float4 v[4]; float ss = 0.f;
#pragma unroll
  for (int i = 0; i < 4; ++i) { v[i] = *(const float4*)(src + i * 256 + lane * 4); ss += v[i].x * v[i].x + v[i].y * v[i].y + v[i].z * v[i].z + v[i].w * v[i].w; }
  ss = wave_sum(ss);
  float rs = rsqrtf(ss * (1.f / 1024.f) + 1e-6f);
#pragma unroll
  for (int i = 0; i < 4; ++i) {
    float4 gg = *(const float4*)(g + i * 256 + lane * 4);
    uint2 o; o.x = pack2(v[i].x * rs * gg.x, v[i].y * rs * gg.y); o.y = pack2(v[i].z * rs * gg.z, v[i].w * rs * gg.w);
    *(uint2*)(dst + i * 256 + lane * 4) = o;
  }
}

DI void phase_prep(const Params& p, char* smem) {
  const int tid = otid(), G = gridDim.x, bid = blockIdx.x;
  char* ws = p.ws;
  if (bid == 0 && tid < 64) ((int*)(ws + OFF_CNT))[tid] = 0;
  float* tile = (float*)smem;
  for (int g0 = bid; g0 < 9168; g0 += G) {
    int g = g0;
    const float* src = nullptr; u16* dst = nullptr; int K = 0, N = 0; size_t dstr = 0; bool ukv = false;
    if (g < 1024) { src = p.w_mem_kv; dst = (u16*)(ws + OFF_WT_MEMKV); K = 1024; N = 1024; dstr = 1024ull * 1024; }
    else if ((g -= 1024) < 1632) { src = p.w_in_mla; dst = (u16*)(ws + OFF_WT_INMLA); K = 1024; N = 3264; dstr = 3328ull * 1024; }
    else if ((g -= 1632) < 432) { src = p.w_uq; dst = (u16*)(ws + OFF_WT_UQ); K = 384; N = 2304; dstr = 2304ull * 384; }
    else if ((g -= 432) < 384) { src = p.w_ukv; dst = (u16*)(ws + OFF_WT_UKV); K = 256; N = 3072; dstr = 3072ull * 256; ukv = true; }
    else if ((g -= 384) < 3648) { src = p.w_in_rwkv; dst = (u16*)(ws + OFF_WT_INRW); K = 1024; N = 7296; dstr = 7296ull * 1024; }
    else { g -= 3648; src = p.w_out; dst = (u16*)(ws + OFF_WT_OUT); K = 2048; N = 1024; dstr = 1024ull * 2048; }
    int ntn = N >> 6, per = (K >> 6) * ntn;
    int m = g / per, t = g - m * per;
    int tk = t / ntn, tn = t - tk * ntn;
    int drow = tn * 64;
    if (ukv) { const int hd = drow >> 8, dd = drow & 255; drow = (dd < 128) ? (hd * 128 + dd) : (1536 + hd * 128 + dd - 128); }
    transpose_tile(src + (size_t)m * K * N, dst + (size_t)m * dstr, K, N, tk, tn, drow, tile);
  }
  for (int i = bid * 256 + tid; i < 2 * 64 * 1024 / 8; i += G * 256) {
    int m = i / (64 * 1024 / 8), r = i - m * (64 * 1024 / 8);
    uint4 z; z.x = z.y = z.z = z.w = 0u;
    *(uint4*)((u16*)(ws + OFF_WT_INMLA) + (size_t)m * 3328 * 1024 + 3264ull * 1024 + (size_t)r * 8) = z;
  }
  float* cs = (float*)(ws + OFF_COS); float* sn = (float*)(ws + OFF_SIN);
  for (int i = bid * 256 + tid; i < 32768 * 32; i += G * 256) {
    int tk = i >> 5, pi = i & 31;
    float inv_freq = (float)exp2(-(double)(2 * pi) / 64.0 * 13.287712379549449);
    float ang = (float)p.pos[tk] * inv_freq;
    double rev = (double)ang * 0.15915494309189535;
    float fr = (float)(rev - rint(rev));
    cs[i] = __builtin_amdgcn_cosf(fr); sn[i] = __builtin_amdgcn_sinf(fr);
  }
  const int w = tid >> 6, lane = tid & 63;
  for (int row = bid * 4 + w; row < 4096; row += G * 4) {
    int L = row >> 10, m = row & 1023;
    rms_row_bf16(p.mem + (size_t)m * 1024, p.mem_norm_g + L * 1024, (u16*)(ws + OFF_MEMH) + (size_t)row * 1024, lane);
  }
}

DI void phase_norm(const Params& p, int L, int c) {
  const int tid = otid(), w = tid >> 6, lane = tid & 63;
  const bool rw = L & 1;
  const float* xs = (L == 0) ? p.x : p.out;
  u16* H = (u16*)(p.ws + OFF_H);
  for (int lr = blockIdx.x * 4 + w; lr < TC; lr += gridDim.x * 4) {
    int gt = gtok(rw, c, lr);
    rms_row_bf16(xs + (size_t)gt * 1024, p.norm_g + L * 1024, H + (size_t)lr * 1024, lane);
  }
}

DI void phase_final_norm(const Params& p) {
  const int tid = otid(), w = tid >> 6, lane = tid & 63;
  for (int row = blockIdx.x * 4 + w; row < 32768; row += gridDim.x * 4) {
    float* xr = p.out + (size_t)row * 1024;
    float4 v[4]; float ss = 0.f;
#pragma unroll
    for (int i = 0; i < 4; ++i) { v[i] = *(const float4*)(xr + i * 256 + lane * 4); ss += v[i].x * v[i].x + v[i].y * v[i].y + v[i].z * v[i].z + v[i].w * v[i].w; }
    ss = wave_sum(ss);
    float rs = rsqrtf(ss * (1.f / 1024.f) + 1e-6f);
#pragma unroll
    for (int i = 0; i < 4; ++i) {
      float4 gg = *(const float4*)(p.final_g + i * 256 + lane * 4);
      float4 o; o.x = v[i].x * rs * gg.x; o.y = v[i].y * rs * gg.y; o.z = v[i].z * rs * gg.z; o.w = v[i].w * rs * gg.w;
      *(float4*)(xr + i * 256 + lane * 4) = o;
    }
  }
}

template <int TJ, bool SWAP, class Epi>
DI void gemm_phase(const u16* __restrict__ A, size_t strideAz, int lda, const u16* __restrict__ Bt, size_t strideBz, int ldb,
                   int Z, int Mt, int Nt, int GM, int K, char* smem, const Epi& epi) {
  constexpr int BN = 64 * TJ;
  constexpr int NB = BN / 32;
  const int tid = otid(), w = tid >> 6, lane = tid & 63, r = lane & 31, h = lane >> 5;
  const int wm = w >> 1, wn = w & 1;
  u16* As = (u16*)smem;
  u16* Bs = As + 2 * 256 * 72;
  const int G = gridDim.x, per = Mt * Nt, total = Z * per;
  const int lrow = tid >> 3, lcc = (tid & 7) * 8;
  const int nk = K >> 6;
  for (int base = 0; base < total; base += G) {
    const int t = blockIdx.x;
    const int q = base + (((G & 7) == 0) ? ((t & 7) * (G >> 3) + (t >> 3)) : t);
    if (q >= total) continue;
    const int z = q / per, qq = q - z * per;
    const int grp = qq / (GM * Nt), within = qq - grp * GM * Nt;
    const int mt = grp * GM + (within % GM), nt = within / GM;
    const int mta = (HYP1 && epi.dry) ? 0 : mt, nta = (HYP1 && epi.dry) ? 0 : nt;
    const u16* Ag = A + z * strideAz + (size_t)(mta * 256 + lrow) * lda + lcc;
    const u16* Bg = Bt + z * strideBz + (size_t)(nta * BN + lrow) * ldb + lcc;
    u32x4 ra[8], rb[NB];
    f32x16 acc[4][TJ];
#pragma unroll
    for (int i = 0; i < 4; ++i)
#pragma unroll
      for (int j = 0; j < TJ; ++j)
#pragma unroll
        for (int e = 0; e < 16; ++e) acc[i][j][e] = 0.f;
    __syncthreads();
#pragma unroll
    for (int i = 0; i < 8; ++i) ra[i] = *(const u32x4*)(Ag + (size_t)(32 * i) * lda);
#pragma unroll
    for (int i = 0; i < NB; ++i) rb[i] = *(const u32x4*)(Bg + (size_t)(32 * i) * ldb);
#pragma unroll
    for (int i = 0; i < 8; ++i) *(u32x4*)(As + (lrow + 32 * i) * 72 + lcc) = ra[i];
#pragma unroll
    for (int i = 0; i < NB; ++i) *(u32x4*)(Bs + (lrow + 32 * i) * 72 + lcc) = rb[i];
#pragma unroll
    for (int i = 0; i < 8; ++i) ra[i] = *(const u32x4*)(Ag + (size_t)(32 * i) * lda + 64);
#pragma unroll
    for (int i = 0; i < NB; ++i) rb[i] = *(const u32x4*)(Bg + (size_t)(32 * i) * ldb + 64);
    __syncthreads();
    for (int kt2 = 0; kt2 < nk; kt2 += 2) {
#pragma unroll
      for (int u = 0; u < 2; ++u) {
        const int kt = kt2 + u;
        const u16* as = As + u * 256 * 72 + (128 * wm + r) * 72 + 8 * h;
        const u16* bs = Bs + u * BN * 72 + (32 * TJ * wn + r) * 72 + 8 * h;
        bf16x8 af[2][4], bfr[2][TJ];
#pragma unroll
        for (int i = 0; i < 4; ++i) af[0][i] = *(const bf16x8*)(as + (32 * i) * 72);
#pragma unroll
        for (int j = 0; j < TJ; ++j) bfr[0][j] = *(const bf16x8*)(bs + (32 * j) * 72);
#pragma unroll
        for (int ks = 0; ks < 4; ++ks) {
          if (ks < 3) {
#pragma unroll
            for (int i = 0; i < 4; ++i) af[(ks + 1) & 1][i] = *(const bf16x8*)(as + (32 * i) * 72 + 16 * (ks + 1));
#pragma unroll
            for (int j = 0; j < TJ; ++j) bfr[(ks + 1) & 1][j] = *(const bf16x8*)(bs + (32 * j) * 72 + 16 * (ks + 1));
          }
          __builtin_amdgcn_sched_barrier(0);
#pragma unroll
          for (int i = 0; i < 4; ++i)
#pragma unroll
            for (int j = 0; j < TJ; ++j)
              acc[i][j] = SWAP ? MFMA32(bfr[ks & 1][j], af[ks & 1][i], acc[i][j]) : MFMA32(af[ks & 1][i], bfr[ks & 1][j], acc[i][j]);
          if (ks == 0 && !(HYP2 && epi.dry)) {
            if (kt + 1 < nk) {
              u16* ad = As + (u ^ 1) * 256 * 72; u16* bd = Bs + (u ^ 1) * BN * 72;
#pragma unroll
              for (int i = 0; i < 8; ++i) *(u32x4*)(ad + (lrow + 32 * i) * 72 + lcc) = ra[i];
#pragma unroll
              for (int i = 0; i < NB; ++i) *(u32x4*)(bd + (lrow + 32 * i) * 72 + lcc) = rb[i];
            }
            if (kt + 2 < nk) {
#pragma unroll
              for (int i = 0; i < 8; ++i) ra[i] = *(const u32x4*)(Ag + (size_t)(32 * i) * lda + (kt + 2) * 64);
#pragma unroll
              for (int i = 0; i < NB; ++i) rb[i] = *(const u32x4*)(Bg + (size_t)(32 * i) * ldb + (kt + 2) * 64);
            }
          }
          __builtin_amdgcn_sched_barrier(0);
        }
        __syncthreads();
      }
    }
#pragma unroll
    for (int i = 0; i < 4; ++i)
#pragma unroll
      for (int j = 0; j < TJ; ++j) {
        if (SWAP) epi(z, mt * 256 + 128 * wm + 32 * i + r, nt * BN + 32 * TJ * wn + 32 * j, h, acc[i][j]);
        else epi(z, mt * 256 + 128 * wm + 32 * i, nt * BN + 32 * TJ * wn + 32 * j + r, h, acc[i][j]);
      }
  }
}

struct EpiStoreBf16 {
  u16* C; int ldc; int ncols; bool dry;
  DI void operator()(int z, int row, int colbase, int h, const f32x16& a) const {
    if (dry) return;
#pragma unroll
    for (int g = 0; g < 4; ++g) {
      const int col = colbase + 8 * g + 4 * h;
      if (col < ncols) {
        u32x2 pk = {pack2(a[4 * g], a[4 * g + 1]), pack2(a[4 * g + 2], a[4 * g + 3])};
        *(u32x2*)(C + (size_t)row * ldc + col) = pk;
      }
    }
  }
};
struct EpiResid {
  const float* xin; float* xout; bool rw; int c; bool dry;
  DI void operator()(int z, int row, int colbase, int h, const f32x16& a) const {
    if (dry) return;
    const size_t o = (size_t)gtok(rw, c, row) * 1024 + colbase + 4 * h;
#pragma unroll
    for (int g = 0; g < 4; ++g) {
      float4 v = *(const float4*)(xin + o + 8 * g);
      v.x += a[4 * g]; v.y += a[4 * g + 1]; v.z += a[4 * g + 2]; v.w += a[4 * g + 3];
      *(float4*)(xout + o + 8 * g) = v;
    }
  }
};
struct EpiUQ {
  u16* Q; const float* cs; const float* sn; int c; bool dry;
  DI void operator()(int z, int row, int colbase, int h, const f32x16& a) const {
    if (dry) return;
    const int head = colbase / 192, db = colbase - head * 192;
    const int lb = row >> 13, s = row & 8191;
    u16* qp = Q + ((size_t)(lb * 12 + head) * 8192 + s) * 192 + db + 4 * h;
    const size_t ti = (size_t)(c * 16384 + row) * 32;
#pragma unroll
    for (int g = 0; g < 4; ++g) {
      float v0 = a[4 * g], v1 = a[4 * g + 1], v2 = a[4 * g + 2], v3 = a[4 * g + 3];
      if (db >= 128) {
        const int pi = (db - 128 + 8 * g + 4 * h) >> 1;
        const float2 cc = *(const float2*)(cs + ti + pi), ss = *(const float2*)(sn + ti + pi);
        const float o0 = v0 * cc.x - v1 * ss.x, o1 = v0 * ss.x + v1 * cc.x;
        const float o2 = v2 * cc.y - v3 * ss.y, o3 = v2 * ss.y + v3 * cc.y;
        v0 = o0; v1 = o1; v2 = o2; v3 = o3;
      }
      u32x2 pk = {pack2(v0, v1), pack2(v2, v3)};
      *(u32x2*)(qp + 8 * g) = pk;
    }
  }
};
struct EpiUK {
  u16* Kb; bool dry;
  DI void operator()(int z, int row, int colbase, int h, const f32x16& a) const {
    if (dry) return;
    const int head = colbase >> 7, db = colbase & 127;
    const int lb = row >> 13, s = row & 8191;
    u16* kp = Kb + ((size_t)(lb * 12 + head) * 8192 + s) * 192 + db + 4 * h;
#pragma unroll
    for (int g = 0; g < 4; ++g) {
      u32x2 pk = {pack2(a[4 * g], a[4 * g + 1]), pack2(a[4 * g + 2], a[4 * g + 3])};
      *(u32x2*)(kp + 8 * g) = pk;
    }
  }
};
struct EpiUV {
  u16* Vt; bool dry;
  DI void operator()(int z, int rowbase, int col, int h, const f32x16& a) const {
    if (dry) return;
    const int head = col >> 7, d = col & 127;
#pragma unroll
    for (int g = 0; g < 4; ++g) {
      int lr = rowbase + 8 * g + 4 * h; int lb = lr >> 13, s = lr & 8191;
      u32x2 pk = {pack2(a[4 * g], a[4 * g + 1]), pack2(a[4 * g + 2], a[4 * g + 3])};
      *(u32x2*)(Vt + ((size_t)(lb * 12 + head) * 128 + d) * 8192 + s) = pk;
    }
  }
};
struct EpiMemKV {
  u16* MK; u16* MVt; bool dry;
  DI void operator()(int z, int rowbase, int col, int h, const f32x16& a) const {
    if (col < 512) {
      const int xh = col >> 7, d = col & 127;
#pragma unroll
      for (int e = 0; e < 16; ++e) {
        int m = rowbase + crow(e, h); int b = m >> 8, mi = m & 255;
        MK[((size_t)((z * 4 + b) * 4 + xh) * 256 + mi) * 128 + d] = f2bf(a[e]);
      }
    } else {
      const int n = col - 512, xh = n >> 7, d = n & 127;
#pragma unroll
      for (int g = 0; g < 4; ++g) {
        int m = rowbase + 8 * g + 4 * h; int b = m >> 8, mi = m & 255;
        uint2 pk; pk.x = pack2(a[4 * g], a[4 * g + 1]); pk.y = pack2(a[4 * g + 2], a[4 * g + 3]);
        *(uint2*)(MVt + ((size_t)((z * 4 + b) * 4 + xh) * 128 + d) * 256 + mi) = pk;
      }
    }
  }
};

DI void phase_kvprep(const Params& p, int L, int c) {
  const int tid = otid(), w = tid >> 6, lane = tid & 63;
  const int j = L >> 1;
  u16* U = (u16*)(p.ws + OFF_U); u16* Kb = (u16*)(p.ws + OFF_K);
  const float* cs = (const float*)(p.ws + OFF_COS); const float* sn = (const float*)(p.ws + OFF_SIN);
  for (int lr = blockIdx.x * 4 + w; lr < TC; lr += gridDim.x * 4) {
    u16* row = U + (size_t)lr * LDU_M;
    float fq[8], fk[8]; float sq = 0.f, sk = 0.f;
    if (lane < 48) { uint4 v = *(const uint4*)(row + M_CQ + lane * 8); unpack8(v, fq);
#pragma unroll
      for (int e = 0; e < 8; ++e) sq += fq[e] * fq[e]; }
    if (lane < 32) { uint4 v = *(const uint4*)(row + M_CKV + lane * 8); unpack8(v, fk);
#pragma unroll
      for (int e = 0; e < 8; ++e) sk += fk[e] * fk[e]; }
    sq = wave_sum(sq); sk = wave_sum(sk);
    float rq = rsqrtf(sq * (1.f / 384.f) + 1e-6f), rk = rsqrtf(sk * (1.f / 256.f) + 1e-6f);
    if (lane < 48) {
      const float* g = p.q_norm_g + j * 384 + lane * 8;
#pragma unroll
      for (int e = 0; e < 8; ++e) fq[e] = fq[e] * rq * g[e];
      *(uint4*)(row + M_CQ + lane * 8) = pack8(fq);
    }
    if (lane < 32) {
      const float* g = p.kv_norm_g + j * 256 + lane * 8;
#pragma unroll
      for (int e = 0; e < 8; ++e) fk[e] = fk[e] * rk * g[e];
      *(uint4*)(row + M_CKV + lane * 8) = pack8(fk);
    }
    if (lane < 8) {
      float f[8], o[8]; uint4 v = *(const uint4*)(row + M_KR + lane * 8); unpack8(v, f);
      int gt = c * 16384 + lr;
#pragma unroll
      for (int i = 0; i < 4; ++i) {
        float cc = cs[gt * 32 + lane * 4 + i], ss = sn[gt * 32 + lane * 4 + i];
        o[2 * i] = f[2 * i] * cc - f[2 * i + 1] * ss; o[2 * i + 1] = f[2 * i] * ss + f[2 * i + 1] * cc;
      }
      uint4 pk = pack8(o);
      int lb = lr >> 13, s = lr & 8191;
#pragma unroll
      for (int hd = 0; hd < 12; ++hd) *(uint4*)(Kb + ((size_t)(lb * 12 + hd) * 8192 + s) * 192 + 128 + lane * 8) = pk;
    }
  }
}

template <int DQK>
DI void attn_item(const u16* __restrict__ Qp, int ldq, const u16* __restrict__ Kp, const u16* __restrict__ Vtp, int ldv,
                  int nkt, int q0, bool causal, float c, u16* Yp, int ldy, char* smem, bool dry) {
  constexpr int KLD = DQK + 8;
  constexpr int NKC = DQK * 64 / 8 / 256;
  constexpr int NKS = DQK / 16;
  constexpr int CPR = DQK / 8;
  u16* Ks = (u16*)smem;
  u16* Vs = Ks + 64 * KLD;
  const int tid = otid(), w = tid >> 6, lane = tid & 63, r = lane & 31, h = lane >> 5;
  bf16x8 qf[NKS];
  {
    const u16* qrow = Qp + (size_t)(32 * w + r) * ldq + 8 * h;
#pragma unroll
    for (int ks = 0; ks < NKS; ++ks) qf[ks] = *(const bf16x8*)(qrow + 16 * ks);
  }
  f32x16 o[4];
#pragma unroll
  for (int dt = 0; dt < 4; ++dt)
#pragma unroll
    for (int e = 0; e < 16; ++e) o[dt][e] = 0.f;
  float m = -INFINITY, l = 0.f;
  u32x4 kst[NKC], vst[4];
  const int vd = tid >> 3, vc8 = tid & 7;
  {
#pragma unroll
    for (int i = 0; i < NKC; ++i) kst[i] = *(const u32x4*)(Kp + (size_t)(tid + 256 * i) * 8);
#pragma unroll
    for (int i = 0; i < 4; ++i) vst[i] = *(const u32x4*)(Vtp + (size_t)(vd + 32 * i) * ldv + vc8 * 8);
  }
  const int qmin = q0 + 32 * w;
  for (int kt = 0; kt < nkt; ++kt) {
    __syncthreads();
#pragma unroll
    for (int i = 0; i < NKC; ++i) { int id = tid + 256 * i; int row = id / CPR, cc = id - row * CPR; *(u32x4*)(Ks + row * KLD + cc * 8) = kst[i]; }
#pragma unroll
    for (int i = 0; i < 4; ++i) {
      u16* dst = Vs + (vd + 32 * i) * 72 + 16 * (vc8 >> 1) + 4 * (vc8 & 1);
      u32x2 lo = {vst[i].x, vst[i].y}, hi = {vst[i].z, vst[i].w};
      *(u32x2*)dst = lo; *(u32x2*)(dst + 8) = hi;
    }
    __syncthreads();
    if (kt + 1 < nkt) {
      const u16* kg = Kp + (size_t)(kt + 1) * 64 * DQK;
#pragma unroll
      for (int i = 0; i < NKC; ++i) kst[i] = *(const u32x4*)(kg + (size_t)(tid + 256 * i) * 8);
#pragma unroll
      for (int i = 0; i < 4; ++i) vst[i] = *(const u32x4*)(Vtp + (size_t)(vd + 32 * i) * ldv + (kt + 1) * 64 + vc8 * 8);
    }
    if (causal && kt * 64 > qmin + 31) continue;
    f32x16 s0, s1;
#pragma unroll
    for (int e = 0; e < 16; ++e) { s0[e] = 0.f; s1[e] = 0.f; }
    {
      const u16* k0 = Ks + r * KLD + 8 * h;
#pragma unroll
      for (int ks = 0; ks < NKS; ++ks) {
        bf16x8 a0 = *(const bf16x8*)(k0 + 16 * ks), a1 = *(const bf16x8*)(k0 + 32 * KLD + 16 * ks);
        s0 = MFMA32(a0, qf[ks], s0); s1 = MFMA32(a1, qf[ks], s1);
      }
    }
    if (causal && kt * 64 + 63 > qmin) {
      const int qi = qmin + r;
#pragma unroll
      for (int e = 0; e < 16; ++e) {
        int key = kt * 64 + crow(e, h);
        if (key > qi) s0[e] = -INFINITY;
        if (key + 32 > qi) s1[e] = -INFINITY;
      }
    }
    float mx = fmaxf(s0[0], s1[0]);
#pragma unroll
    for (int e = 1; e < 16; ++e) mx = fmaxf(mx, fmaxf(s0[e], s1[e]));
    mx = fmaxf(mx, __shfl_xor(mx, 32));
    if (__builtin_amdgcn_ballot_w64((mx - m) * c > 8.f) != 0ull) {
      const float mn = fmaxf(m, mx);
      const float alpha = ex2((m - mn) * c);
      m = mn;
      l *= alpha;
#pragma unroll
      for (int dt = 0; dt < 4; ++dt)
#pragma unroll
        for (int e = 0; e < 16; ++e) o[dt][e] *= alpha;
    }
    const float mc = m * c;
    float ps = 0.f;
#pragma unroll
    for (int e = 0; e < 16; ++e) { s0[e] = ex2(fmaf(s0[e], c, -mc)); s1[e] = ex2(fmaf(s1[e], c, -mc)); ps += s0[e] + s1[e]; }
    l += ps;
    bf16x8 pf[4];
    {
      u32x4 t;
      t.x = pack2(s0[0], s0[1]); t.y = pack2(s0[2], s0[3]); t.z = pack2(s0[4], s0[5]); t.w = pack2(s0[6], s0[7]); pf[0] = __builtin_bit_cast(bf16x8, t);
      t.x = pack2(s0[8], s0[9]); t.y = pack2(s0[10], s0[11]); t.z = pack2(s0[12], s0[13]); t.w = pack2(s0[14], s0[15]); pf[1] = __builtin_bit_cast(bf16x8, t);
      t.x = pack2(s1[0], s1[1]); t.y = pack2(s1[2], s1[3]); t.z = pack2(s1[4], s1[5]); t.w = pack2(s1[6], s1[7]); pf[2] = __builtin_bit_cast(bf16x8, t);
      t.x = pack2(s1[8], s1[9]); t.y = pack2(s1[10], s1[11]); t.z = pack2(s1[12], s1[13]); t.w = pack2(s1[14], s1[15]); pf[3] = __builtin_bit_cast(bf16x8, t);
    }
    {
      const u16* v0 = Vs + r * 72 + 8 * h;
#pragma unroll
      for (int kk = 0; kk < 4; ++kk)
#pragma unroll
        for (int dt = 0; dt < 4; ++dt) {
          bf16x8 a = *(const bf16x8*)(v0 + (32 * dt) * 72 + 16 * kk);
          o[dt] = MFMA32(a, pf[kk], o[dt]);
        }
    }
  }
  const float lt = l + __shfl_xor(l, 32);
  const float inv = 1.f / lt;
  if (dry) return;
  u16* yrow = Yp + (size_t)(32 * w + r) * ldy;
#pragma unroll
  for (int dt = 0; dt < 4; ++dt)
#pragma unroll
    for (int g = 0; g < 4; ++g) {
      const int d = 32 * dt + 8 * g + 4 * h;
      uint2 gv = *(const uint2*)(yrow + d);
      float g0 = bf2f(gv.x & 0xffffu), g1 = bf2f(gv.x >> 16), g2 = bf2f(gv.y & 0xffffu), g3 = bf2f(gv.y >> 16);
      uint2 ov;
      ov.x = pack2(o[dt][4 * g] * inv * silu(g0), o[dt][4 * g + 1] * inv * silu(g1));
      ov.y = pack2(o[dt][4 * g + 2] * inv * silu(g2), o[dt][4 * g + 3] * inv * silu(g3));
      *(uint2*)(yrow + d) = ov;
    }
}

DI void memattn_item(const Params& p, int L, int c, int item, char* smem, bool dry) {
  const bool rw = L & 1;
  const int ldu = rw ? LDU_R : LDU_M, oq = rw ? R_QM : M_QM, og = rw ? R_GATE : M_GATE;
  const int tile = item >> 2, xh = item & 3;
  const int b = gtok(rw, c, tile * 128) >> 13;
  u16* U = (u16*)(p.ws + OFF_U);
  const u16* MK = (const u16*)(p.ws + OFF_MEMK) + (size_t)((L * 4 + b) * 4 + xh) * 256 * 128;
  const u16* MV = (const u16*)(p.ws + OFF_MEMVT) + (size_t)((L * 4 + b) * 4 + xh) * 128 * 256;
  attn_item<128>(U + (size_t)tile * 128 * ldu + oq + xh * 128, ldu, MK, MV, 256, 4, 0, false,
                 0.08838834764831845f * 1.4426950408889634f, U + (size_t)tile * 128 * ldu + og + 1536 + xh * 128, ldu, smem, dry);
}

DI void phase_attn(const Params& p, int L, int c, char* smem, int* s_item, bool dry) {
  int* cnt = (int*)(p.ws + OFF_CNT) + (L * 2 + c) + (dry ? 8 : 0);
  u16* U = (u16*)(p.ws + OFF_U);
  const u16* Q = (const u16*)(p.ws + OFF_Q); const u16* Kb = (const u16*)(p.ws + OFF_K); const u16* Vt = (const u16*)(p.ws + OFF_VT);
  for (;;) {
    __syncthreads();
    if (otid() == 0) *s_item = atomicAdd(cnt, 1);
    __syncthreads();
    const int item = *s_item;
    if (item >= 1536 + 512) break;
    if (item < 1536) {
      const int qt = 63 - item / 24, bh = item % 24;
      const int lb = bh / 12, head = bh - lb * 12;
      const int q0 = qt * 128;
      attn_item<192>(Q + ((size_t)(lb * 12 + head) * 8192 + q0) * 192, 192, Kb + (size_t)(lb * 12 + head) * 8192 * 192,
                     Vt + (size_t)(lb * 12 + head) * 128 * 8192, 8192, 2 * (qt + 1), q0, true,
                     0.07216878364870323f * 1.4426950408889634f,
                     U + (size_t)(lb * 8192 + q0) * LDU_M + M_GATE + head * 128, LDU_M, smem, dry);
    } else {
      memattn_item(p, L, c, item - 1536, smem, dry);
    }
  }
}

DI void scan_item(const Params& p, int L, int c, int item, char* smem, bool dry) {
  const int tid = otid(), w = tid >> 6, lane = tid & 63, r = lane & 31, h = lane >> 5;
  const int j = L >> 1;
  const int b = item / 48, rem = item - b * 48, head = rem >> 1, half = rem & 1;
  float* PA  = (float*)smem;
  float* LO  = PA;
  float* Vst = PA + 32 * 5 * 64;
  float* Yst = Vst + 32 * 32;
  float* PRM = Yst + 32 * 32;
  float* BON = PRM + 10 * 64;
  u16* A1  = (u16*)(BON + 32);
  u16* W2t = A1 + 2 * 32 * 72;
  const u16* U = (const u16*)(p.ws + OFF_U);
  const u16* BND = (const u16*)(p.ws + OFF_BND);
  u16* YR = (u16*)(p.ws + OFF_YR); u16* BV = (u16*)(p.ws + OFF_BV);
  float* ST = (float*)(p.ws + OFF_ST); float* BS = (float*)(p.ws + OFF_BS);
  float* STATE = (float*)(p.ws + OFF_STATE);
  __syncthreads();
  if (tid < 64) {
    const float* mu = p.mu + j * SHIFTW;
    const int hc = head * 64 + tid;
    PRM[0 * 64 + tid] = mu[R_R + hc]; PRM[1 * 64 + tid] = mu[R_K + hc]; PRM[2 * 64 + tid] = mu[R_WD + tid]; PRM[3 * 64 + tid] = mu[R_AD + tid];
    PRM[4 * 64 + tid] = p.w0[j * 1536 + hc]; PRM[5 * 64 + tid] = p.a0[j * 1536 + hc]; PRM[6 * 64 + tid] = p.k_k[j * 1536 + hc];
    PRM[7 * 64 + tid] = p.k_a[j * 1536 + hc]; PRM[8 * 64 + tid] = p.r_k[j * 1536 + hc];
    PRM[9 * 64 + tid] = (tid < 32) ? mu[R_V + head * 64 + 32 * half + tid] : 0.f;
  }
  for (int e = tid; e < 8192; e += 256) {
    int arr = e >> 12, jj = (e >> 6) & 63, cc = e & 63;
    const float* src = (arr ? p.a2 : p.w2) + (size_t)j * 64 * 1536;
    W2t[(arr * 64 + cc) * 72 + jj] = f2bf(src[jj * 1536 + head * 64 + cc]);
  }
  const int rowl = lane >> 3, ks = lane & 7, row32 = 8 * w + rowl;
  float S[8];
  {
    float* sp = STATE + ((size_t)((b * 24 + head) * 64 + 32 * half + row32)) * 64 + 8 * ks;
#pragma unroll
    for (int i = 0; i < 8; ++i) S[i] = (c == 0) ? 0.f : sp[i];
  }
  const int tt = tid >> 3, cs = tid & 7;
  uint4 Rr_c, Rr_p, Rk_c, Rk_p, Rw_c, Rw_p, Ra_c, Ra_p, Rv_c, Rv_p;
  const uint4 zero4 = {0u, 0u, 0u, 0u};
  auto load_raw = [&](int tc) {
    const int lr = b * 4096 + tc * 32 + tt;
    const int s = c * 4096 + tc * 32 + tt;
    const u16* cur = U + (size_t)lr * LDU_R;
    const u16* prv = (s == 4096 && c == 1) ? (BND + (size_t)b * SHIFTW) : (cur - LDU_R);
    const bool hp = (s != 0);
    Rr_c = *(const uint4*)(cur + R_R + head * 64 + cs * 8);  Rr_p = hp ? *(const uint4*)(prv + R_R + head * 64 + cs * 8) : zero4;
    Rk_c = *(const uint4*)(cur + R_K + head * 64 + cs * 8);  Rk_p = hp ? *(const uint4*)(prv + R_K + head * 64 + cs * 8) : zero4;
    Rw_c = *(const uint4*)(cur + R_WD + cs * 8);             Rw_p = hp ? *(const uint4*)(prv + R_WD + cs * 8) : zero4;
    Ra_c = *(const uint4*)(cur + R_AD + cs * 8);             Ra_p = hp ? *(const uint4*)(prv + R_AD + cs * 8) : zero4;
    const int vo = R_V + head * 64 + 32 * half + (cs & 3) * 8;
    Rv_c = *(const uint4*)(cur + vo);                        Rv_p = hp ? *(const uint4*)(prv + vo) : zero4;
  };
  load_raw(0);
  __syncthreads();
  for (int tc = 0; tc < 128; ++tc) {
    const int lr = b * 4096 + tc * 32 + tt;
    float rm[8], km[8];
    {
      float cu[8], pv[8], t8[8];
      unpack8(Rr_c, cu); unpack8(Rr_p, pv);
#pragma unroll
      for (int e = 0; e < 8; ++e) rm[e] = cu[e] + (pv[e] - cu[e]) * PRM[0 * 64 + cs * 8 + e];
      unpack8(Rk_c, cu); unpack8(Rk_p, pv);
#pragma unroll
      for (int e = 0; e < 8; ++e) km[e] = cu[e] + (pv[e] - cu[e]) * PRM[1 * 64 + cs * 8 + e];
      unpack8(Rw_c, cu); unpack8(Rw_p, pv);
#pragma unroll
      for (int e = 0; e < 8; ++e) {
        float xw = cu[e] + (pv[e] - cu[e]) * PRM[2 * 64 + cs * 8 + e];
        float ee = ex2(xw * 2.8853900817779268f);
        t8[e] = 1.f - 2.f * frcp(ee + 1.f);
      }
      *(uint4*)(A1 + (0 * 32 + tt) * 72 + cs * 8) = pack8(t8);
      unpack8(Ra_c, cu); unpack8(Ra_p, pv);
#pragma unroll
      for (int e = 0; e < 8; ++e) t8[e] = cu[e] + (pv[e] - cu[e]) * PRM[3 * 64 + cs * 8 + e];
      *(uint4*)(A1 + (1 * 32 + tt) * 72 + cs * 8) = pack8(t8);
      unpack8(Rv_c, cu); unpack8(Rv_p, pv);
      if (cs < 4) {
#pragma unroll
        for (int e = 0; e < 8; ++e) Vst[tt * 32 + cs * 8 + e] = cu[e] + (pv[e] - cu[e]) * PRM[9 * 64 + cs * 8 + e];
      }
    }
    __syncthreads();
    {
      const int arr = w >> 1, nt = w & 1;
      f32x16 acc;
#pragma unroll
      for (int e = 0; e < 16; ++e) acc[e] = 0.f;
#pragma unroll
      for (int k4 = 0; k4 < 4; ++k4) {
        bf16x8 a = *(const bf16x8*)(A1 + (arr * 32 + r) * 72 + 16 * k4 + 8 * h);
        bf16x8 bw = *(const bf16x8*)(W2t + (arr * 64 + 32 * nt + r) * 72 + 16 * k4 + 8 * h);
        acc = MFMA32(a, bw, acc);
      }
#pragma unroll
      for (int e = 0; e < 16; ++e) LO[(arr * 32 + crow(e, h)) * 64 + 32 * nt + r] = acc[e];
    }
    __syncthreads();
    float lw[8], la[8];
    {
      float4 t0 = *(const float4*)(LO + (0 * 32 + tt) * 64 + cs * 8), t1 = *(const float4*)(LO + (0 * 32 + tt) * 64 + cs * 8 + 4);
      lw[0] = t0.x; lw[1] = t0.y; lw[2] = t0.z; lw[3] = t0.w; lw[4] = t1.x; lw[5] = t1.y; lw[6] = t1.z; lw[7] = t1.w;
      t0 = *(const float4*)(LO + (1 * 32 + tt) * 64 + cs * 8); t1 = *(const float4*)(LO + (1 * 32 + tt) * 64 + cs * 8 + 4);
      la[0] = t0.x; la[1] = t0.y; la[2] = t0.z; la[3] = t0.w; la[4] = t1.x; la[5] = t1.y; la[6] = t1.z; la[7] = t1.w;
    }
    __syncthreads();
    {
      float dec[8], kk[8], av[8], kp[8];
      float ssq = 0.f, bon = 0.f;
#pragma unroll
      for (int e = 0; e < 8; ++e) {
        const int ch = cs * 8 + e;
        float xx = -(lw[e] + PRM[4 * 64 + ch]);
        float sp = fmaxf(xx, 0.f) + __logf(1.f + fexp(-fabsf(xx)));
        float wv = -sp - 0.5f;
        dec[e] = fexp(-fexp(wv));
        float a = frcp(1.f + fexp(-(la[e] + PRM[5 * 64 + ch])));
        av[e] = a;
        kk[e] = km[e] * PRM[6 * 64 + ch];
        ssq += kk[e] * kk[e];
        kp[e] = km[e] * (1.f + (a - 1.f) * PRM[7 * 64 + ch]);
        bon += rm[e] * kp[e] * PRM[8 * 64 + ch];
      }
      ssq = red8(ssq); bon = red8(bon);
      const float inv = 1.f / fmaxf(sqrtf(ssq), 1e-12f);
      float nk[8], bb[8];
#pragma unroll
      for (int e = 0; e < 8; ++e) { float kn = kk[e] * inv; nk[e] = -kn; bb[e] = kn * av[e]; }
      float* pa = PA + tt * 320 + cs * 8;
      *(float4*)(pa) = make_float4(dec[0], dec[1], dec[2], dec[3]); *(float4*)(pa + 4) = make_float4(dec[4], dec[5], dec[6], dec[7]);
      *(float4*)(pa + 64) = make_float4(nk[0], nk[1], nk[2], nk[3]); *(float4*)(pa + 68) = make_float4(nk[4], nk[5], nk[6], nk[7]);
      *(float4*)(pa + 128) = make_float4(bb[0], bb[1], bb[2], bb[3]); *(float4*)(pa + 132) = make_float4(bb[4], bb[5], bb[6], bb[7]);
      *(float4*)(pa + 192) = make_float4(kp[0], kp[1], kp[2], kp[3]); *(float4*)(pa + 196) = make_float4(kp[4], kp[5], kp[6], kp[7]);
      *(float4*)(pa + 256) = make_float4(rm[0], rm[1], rm[2], rm[3]); *(float4*)(pa + 260) = make_float4(rm[4], rm[5], rm[6], rm[7]);
      if (cs == 0) BON[tt] = bon;
    }
    __syncthreads();
    if (tc + 1 < 128) load_raw(tc + 1);
    {
      const float* pa0 = PA + ks * 8;
      const float* vs0 = Vst + row32;
      float4 d0 = *(const float4*)(pa0), d1 = *(const float4*)(pa0 + 4);
      float4 n0 = *(const float4*)(pa0 + 64), n1 = *(const float4*)(pa0 + 68);
      float4 b0 = *(const float4*)(pa0 + 128), b1 = *(const float4*)(pa0 + 132);
      float4 k0 = *(const float4*)(pa0 + 192), k1 = *(const float4*)(pa0 + 196);
      float4 r0 = *(const float4*)(pa0 + 256), r1 = *(const float4*)(pa0 + 260);
      float vv = vs0[0];
#pragma unroll 2
      for (int t = 0; t < 32; ++t) {
        const float* pa = pa0 + (t + 1) * 320;
        const float4 xd0 = *(const float4*)(pa), xd1 = *(const float4*)(pa + 4);
        const float4 xn0 = *(const float4*)(pa + 64), xn1 = *(const float4*)(pa + 68);
        const float4 xb0 = *(const float4*)(pa + 128), xb1 = *(const float4*)(pa + 132);
        const float4 xk0 = *(const float4*)(pa + 192), xk1 = *(const float4*)(pa + 196);
        const float4 xr0 = *(const float4*)(pa + 256), xr1 = *(const float4*)(pa + 260);
        const float xvv = vs0[(t + 1) * 32];
        __builtin_amdgcn_sched_barrier(0);
        float sa0 = S[0] * n0.x, sa1 = S[1] * n0.y;
        sa0 = fmaf(S[2], n0.z, sa0); sa1 = fmaf(S[3], n0.w, sa1);
        sa0 = fmaf(S[4], n1.x, sa0); sa1 = fmaf(S[5], n1.y, sa1);
        sa0 = fmaf(S[6], n1.z, sa0); sa1 = fmaf(S[7], n1.w, sa1);
        float sa = red8(sa0 + sa1);
        S[0] = fmaf(sa, b0.x, fmaf(S[0], d0.x, vv * k0.x)); S[1] = fmaf(sa, b0.y, fmaf(S[1], d0.y, vv * k0.y));
        S[2] = fmaf(sa, b0.z, fmaf(S[2], d0.z, vv * k0.z)); S[3] = fmaf(sa, b0.w, fmaf(S[3], d0.w, vv * k0.w));
        S[4] = fmaf(sa, b1.x, fmaf(S[4], d1.x, vv * k1.x)); S[5] = fmaf(sa, b1.y, fmaf(S[5], d1.y, vv * k1.y));
        S[6] = fmaf(sa, b1.z, fmaf(S[6], d1.z, vv * k1.z)); S[7] = fmaf(sa, b1.w, fmaf(S[7], d1.w, vv * k1.w));
        float y0 = S[0] * r0.x, y1 = S[1] * r0.y;
        y0 = fmaf(S[2], r0.z, y0); y1 = fmaf(S[3], r0.w, y1);
        y0 = fmaf(S[4], r1.x, y0); y1 = fmaf(S[5], r1.y, y1);
        y0 = fmaf(S[6], r1.z, y0); y1 = fmaf(S[7], r1.w, y1);
        float y = red8(y0 + y1);
        if (ks == 0) Yst[t * 32 + row32] = y;
        __builtin_amdgcn_sched_barrier(0);
        d0 = xd0; d1 = xd1; n0 = xn0; n1 = xn1; b0 = xb0; b1 = xb1; k0 = xk0; k1 = xk1; r0 = xr0; r1 = xr1; vv = xvv;
      }
    }
    __syncthreads();
    {
      const int c4 = cs & 3;
      float y8[8], v8[8];
      float4 t0 = *(const float4*)(Yst + tt * 32 + c4 * 8), t1 = *(const float4*)(Yst + tt * 32 + c4 * 8 + 4);
      y8[0] = t0.x; y8[1] = t0.y; y8[2] = t0.z; y8[3] = t0.w; y8[4] = t1.x; y8[5] = t1.y; y8[6] = t1.z; y8[7] = t1.w;
      float sm = 0.f, sq = 0.f;
#pragma unroll
      for (int e = 0; e < 8; ++e) { sm += y8[e]; sq += y8[e] * y8[e]; }
      sm = red4(sm); sq = red4(sq);
      const float bon = BON[tt];
      t0 = *(const float4*)(Vst + tt * 32 + c4 * 8); t1 = *(const float4*)(Vst + tt * 32 + c4 * 8 + 4);
      v8[0] = t0.x * bon; v8[1] = t0.y * bon; v8[2] = t0.z * bon; v8[3] = t0.w * bon; v8[4] = t1.x * bon; v8[5] = t1.y * bon; v8[6] = t1.z * bon; v8[7] = t1.w * bon;
      if (cs < 4 && !dry) {
        const size_t o = (size_t)lr * 1536 + head * 64 + 32 * half + cs * 8;
        *(uint4*)(YR + o) = pack8(y8);
        *(uint4*)(BV + o) = pack8(v8);
        if (cs == 0) {
          float* stp = ST + ((size_t)(lr * 24 + head) * 2 + half) * 2;
          stp[0] = sm; stp[1] = sq;
        }
      }
    }
  }
  if (c == 0 && !dry) {
    float* sp = STATE + ((size_t)((b * 24 + head) * 64 + 32 * half + row32)) * 64 + 8 * ks;
#pragma unroll
    for (int i = 0; i < 8; ++i) sp[i] = S[i];
  }
}

DI void phase_scan(const Params& p, int L, int c, char* smem, int* s_item, bool dry) {
  for (int item = blockIdx.x; item < 192; item += gridDim.x) scan_item(p, L, c, item, smem, dry);
  int* cnt = (int*)(p.ws + OFF_CNT) + (L * 2 + c) + (dry ? 8 : 0);
  for (;;) {
    __syncthreads();
    if (otid() == 0) *s_item = atomicAdd(cnt, 1);
    __syncthreads();
    const int item = *s_item;
    if (item >= 512) break;
    memattn_item(p, L, c, item, smem, dry);
  }
}

DI void phase_finalize(const Params& p, int L, int c) {
  const int j = L >> 1;
  u16* U = (u16*)(p.ws + OFF_U);
  const u16* YR = (const u16*)(p.ws + OFF_YR); const u16* BV = (const u16*)(p.ws + OFF_BV);
  const float* ST = (const float*)(p.ws + OFF_ST);
  const int G = gridDim.x;
  for (int idx = blockIdx.x * 256 + otid(); idx < TC * 192; idx += G * 256) {
    const int lr = idx / 192, c8 = idx - lr * 192, ch0 = c8 * 8, head = ch0 >> 6;
    const float4 st = *(const float4*)(ST + (size_t)(lr * 24 + head) * 4);
    const float mean = (st.x + st.z) * (1.f / 64.f);
    const float var = (st.y + st.w) * (1.f / 64.f) - mean * mean;
    const float rstd = rsqrtf(fmaxf(var, 0.f) + 64e-5f);
    float y[8], bv[8], g[8], o[8];
    unpack8(*(const uint4*)(YR + (size_t)lr * 1536 + ch0), y);
    unpack8(*(const uint4*)(BV + (size_t)lr * 1536 + ch0), bv);
    u16* gp = U + (size_t)lr * LDU_R + R_GATE + ch0;
    unpack8(*(const uint4*)gp, g);
    const float* gw = p.gn_w + j * 1536 + ch0; const float* gb = p.gn_b + j * 1536 + ch0;
#pragma unroll
    for (int e = 0; e < 8; ++e) o[e] = ((y[e] - mean) * rstd * gw[e] + gb[e] + bv[e]) * silu(g[e]);
    *(uint4*)gp = pack8(o);
  }
  if (c == 0) {
    u16* BND = (u16*)(p.ws + OFF_BND);
    for (int idx = blockIdx.x * 256 + otid(); idx < 4 * (SHIFTW / 8); idx += G * 256) {
      const int b = idx / (SHIFTW / 8), cc = idx - b * (SHIFTW / 8);
      *(uint4*)(BND + (size_t)b * SHIFTW + cc * 8) = *(const uint4*)(U + (size_t)(b * 4096 + 4095) * LDU_R + cc * 8);
    }
  }
}

enum { PH_PREP = 0, PH_NORM, PH_GEMM_IN, PH_KVPREP, PH_GEMM_UP, PH_ATTN, PH_SCAN, PH_FINALIZE, PH_GEMM_OUT, PH_FINAL };
constexpr int NSTEPS = 46;

DI void decode_step(int step, int& ph, int& L, int& c) {
  if (step == 0) { ph = PH_PREP; L = 0; c = 0; return; }
  if (step == NSTEPS - 1) { ph = PH_FINAL; L = 0; c = 0; return; }
  int s = step - 1;
  int pr = s / 22, rem = s - pr * 22;
  if (rem < 12) {
    L = 2 * pr; c = rem / 6; int k = rem - c * 6;
    ph = (k == 0) ? PH_NORM : (k == 1) ? PH_GEMM_IN : (k == 2) ? PH_KVPREP : (k == 3) ? PH_GEMM_UP : (k == 4) ? PH_ATTN : PH_GEMM_OUT;
  } else {
    rem -= 12; L = 2 * pr + 1; c = rem / 5; int k = rem - c * 5;
    ph = (k == 0) ? PH_NORM : (k == 1) ? PH_GEMM_IN : (k == 2) ? PH_SCAN : (k == 3) ? PH_FINALIZE : PH_GEMM_OUT;
  }
}

DI void run_step(const Params& p, int ph, int L, int c, char* smem, int* s_item, bool dry) {
  char* ws = p.ws;
  const bool rw = L & 1;
  const int j = L >> 1;
  switch (ph) {
    case PH_PREP: phase_prep(p, smem); break;
    case PH_NORM:
      phase_norm(p, L, c);
      if (L == 0 && c == 0) {
        EpiMemKV epi{(u16*)(ws + OFF_MEMK), (u16*)(ws + OFF_MEMVT), false};
        gemm_phase<2, false>((const u16*)(ws + OFF_MEMH), 1024ull * 1024, 1024, (const u16*)(ws + OFF_WT_MEMKV), 1024ull * 1024, 1024, 4, 4, 8, 4, 1024, smem, epi);
      }
      break;
    case PH_GEMM_IN:
      if (!rw) {
        EpiStoreBf16 epi{(u16*)(ws + OFF_U), LDU_M, LDU_M, dry};
        gemm_phase<2, true>((const u16*)(ws + OFF_H), 0, 1024, (const u16*)(ws + OFF_WT_INMLA) + (size_t)j * 3328 * 1024, 0, 1024, 1, 64, 26, 8, 1024, smem, epi);
      } else {
        EpiStoreBf16 epi{(u16*)(ws + OFF_U), LDU_R, LDU_R, dry};
        gemm_phase<2, true>((const u16*)(ws + OFF_H), 0, 1024, (const u16*)(ws + OFF_WT_INRW) + (size_t)j * 7296 * 1024, 0, 1024, 1, 64, 57, 8, 1024, smem, epi);
      }
      break;
    case PH_KVPREP: phase_kvprep(p, L, c); break;
    case PH_GEMM_UP: {
      EpiUQ e1{(u16*)(ws + OFF_Q), (const float*)(ws + OFF_COS), (const float*)(ws + OFF_SIN), c, dry};
      gemm_phase<2, true>((const u16*)(ws + OFF_U) + M_CQ, 0, LDU_M, (const u16*)(ws + OFF_WT_UQ) + (size_t)j * 2304 * 384, 0, 384, 1, 64, 18, 8, 384, smem, e1);
      EpiUK e2{(u16*)(ws + OFF_K), dry};
      gemm_phase<2, true>((const u16*)(ws + OFF_U) + M_CKV, 0, LDU_M, (const u16*)(ws + OFF_WT_UKV) + (size_t)j * 3072 * 256, 0, 256, 1, 64, 12, 8, 256, smem, e2);
      EpiUV e3{(u16*)(ws + OFF_VT), dry};
      gemm_phase<2, false>((const u16*)(ws + OFF_U) + M_CKV, 0, LDU_M, (const u16*)(ws + OFF_WT_UKV) + (size_t)j * 3072 * 256 + 1536ull * 256, 0, 256, 1, 64, 12, 8, 256, smem, e3);
    } break;
    case PH_ATTN: phase_attn(p, L, c, smem, s_item, dry); break;
    case PH_SCAN: phase_scan(p, L, c, smem, s_item, dry); break;
    case PH_FINALIZE: phase_finalize(p, L, c); break;
    case PH_GEMM_OUT: {
      EpiResid epi{(L == 0) ? p.x : (const float*)p.out, p.out, rw, c, dry};
      gemm_phase<2, true>((const u16*)(ws + OFF_U) + (rw ? R_GATE : M_GATE), 0, rw ? LDU_R : LDU_M, (const u16*)(ws + OFF_WT_OUT) + (size_t)L * 1024 * 2048, 0, 2048,
                 1, 64, 8, 8, 2048, smem, epi);
    } break;
    case PH_FINAL: phase_final_norm(p); break;
  }
}

DI void grid_barrier(unsigned* bar, unsigned& epoch) {
  __syncthreads();
  ++epoch;
  if (threadIdx.x == 0) {
    __builtin_amdgcn_fence(__ATOMIC_RELEASE, "agent");
    asm volatile("s_waitcnt vmcnt(0)" ::: "memory");
    const unsigned target = epoch * gridDim.x;
    __hip_atomic_fetch_add(bar, 1u, __ATOMIC_RELAXED, __HIP_MEMORY_SCOPE_AGENT);
    unsigned spins = 0;
    while (__hip_atomic_load(bar, __ATOMIC_RELAXED, __HIP_MEMORY_SCOPE_AGENT) < target) {
      __builtin_amdgcn_s_sleep(2);
      if (++spins > (1u << 22)) break;
    }
    __builtin_amdgcn_fence(__ATOMIC_ACQUIRE, "agent");
    asm volatile("s_waitcnt vmcnt(0)" ::: "memory");
  }
  __syncthreads();
}

__global__ void __launch_bounds__(256, 1) hybrid_megakernel(Params p, int s_lo, int s_hi, int coop, int probe_mask) {
  __shared__ __attribute__((aligned(16))) char smem[SMEM_BYTES];
  __shared__ int s_item;
  unsigned* bar = (unsigned*)(p.ws + OFF_BAR);
  unsigned epoch = 0;
  if (coop == 2) cg::this_grid().sync();
  for (int st = s_lo; st < s_hi; ++st) {
    int ph, L, c;
    decode_step(st, ph, L, c);
    for (int rep = ((probe_mask >> ph) & 1) ? 0 : 1; rep < 2; ++rep) {
      run_step(p, ph, L, c, smem, &s_item, rep == 0);
      if (coop && (rep == 0 || st + 1 < s_hi)) grid_barrier(bar, epoch);
      if (coop) for (int xs = 0; xs < EXTRA_SYNCS; ++xs) grid_barrier(bar, epoch);
    }
  }
}

extern "C" void kernel_launch(void* const* d_in, const int* in_sizes, int n_in, void* d_out, int out_size, void* d_ws, size_t ws_size,
                              hipStream_t stream) {
  if (ws_size < WS_NEED) { fprintf(stderr, "workspace too small: %zu < %zu\n", ws_size, (size_t)WS_NEED); return; }
  Params p;
  memset(&p, 0, sizeof(p));
  p.x = (const float*)d_in[0]; p.mem = (const float*)d_in[1]; p.pos = (const int*)d_in[2];
  p.norm_g = (const float*)d_in[3]; p.mem_norm_g = (const float*)d_in[4]; p.w_mem_kv = (const float*)d_in[5];
  p.w_in_mla = (const float*)d_in[6]; p.q_norm_g = (const float*)d_in[7]; p.kv_norm_g = (const float*)d_in[8];
  p.w_uq = (const float*)d_in[9]; p.w_ukv = (const float*)d_in[10]; p.w_in_rwkv = (const float*)d_in[11];
  p.mu = (const float*)d_in[12]; p.w0 = (const float*)d_in[13]; p.w2 = (const float*)d_in[14]; p.a0 = (const float*)d_in[15];
  p.a2 = (const float*)d_in[16]; p.k_k = (const float*)d_in[17]; p.k_a = (const float*)d_in[18]; p.r_k = (const float*)d_in[19];
  p.gn_w = (const float*)d_in[20]; p.gn_b = (const float*)d_in[21]; p.w_out = (const float*)d_in[22]; p.final_g = (const float*)d_in[23];
  p.out = (float*)d_out; p.ws = (char*)d_ws;
  static int grid_blocks = 0;
  if (!grid_blocks) {
    int dev = 0, cus = 0, per_cu = 0;
    hipGetDevice(&dev);
    hipDeviceGetAttribute(&cus, hipDeviceAttributeMultiprocessorCount, dev);
    hipOccupancyMaxActiveBlocksPerMultiprocessor(&per_cu, hybrid_megakernel, 256, 0);
    if (per_cu > 2) per_cu = 2;
    if (per_cu < 1) per_cu = 1;
    grid_blocks = cus * per_cu;
  }
#if MULTI_LAUNCH
  for (int s = 0; s < NSTEPS; ++s) hipLaunchKernelGGL(hybrid_megakernel, dim3(grid_blocks), dim3(256), 0, stream, p, s, s + 1, 0, 0);
#else
  int s_lo = 0, s_hi = NSTEPS, coop = 1, probe_mask = PROBE_MASK;
  void* args[] = {&p, &s_lo, &s_hi, &coop, &probe_mask};
  hipMemsetAsync((char*)d_ws + OFF_BAR, 0, 256, stream);
  hipError_t e = hipLaunchCooperativeKernel((void*)hybrid_megakernel, dim3(grid_blocks), dim3(256), args, 0, stream);
  if (e != hipSuccess) fprintf(stderr, "cooperative launch failed: %s (grid %d)\n", hipGetErrorString(e), grid_blocks);
#endif
}
```

```cpp
#include <hip/hip_runtime.h>
#include <hip/hip_cooperative_groups.h>
#include <cstdio>
#include <cstring>
namespace cg = cooperative_groups;

#define PROBE_MASK 0
#define EXTRA_SYNCS 0
#define HYP1 0
#define HYP2 0
#define HYP3 0
#define HYP4 0
#define HYP5 0
#ifndef MULTI_LAUNCH
#define MULTI_LAUNCH 0
#endif

#define DI __device__ __forceinline__
typedef unsigned short u16;
typedef __attribute__((ext_vector_type(8))) short bf16x8;
typedef __attribute__((ext_vector_type(16))) float f32x16;
typedef __attribute__((ext_vector_type(2))) __bf16 bf2_t;
typedef __attribute__((ext_vector_type(2))) float f2_t;
typedef __attribute__((ext_vector_type(4))) unsigned u32x4;
typedef __attribute__((ext_vector_type(2))) unsigned u32x2;
#define MFMA32(a, b, c) __builtin_amdgcn_mfma_f32_32x32x16_bf16((a), (b), (c), 0, 0, 0)

constexpr int SEQ = 8192, TC = 16384;
constexpr int LDU_M = 3264, LDU_R = 7296;
constexpr int M_CQ = 0, M_CKV = 384, M_KR = 640, M_QM = 704, M_GATE = 1216;
constexpr int R_R = 0, R_K = 1536, R_V = 3072, R_WD = 4608, R_AD = 4672, R_QM = 4736, R_GATE = 5248;
constexpr int SHIFTW = 4736;

constexpr size_t OFF_WT_MEMKV = 0;
constexpr size_t OFF_WT_INMLA = OFF_WT_MEMKV + 4ull * 1024 * 1024 * 2;
constexpr size_t OFF_WT_UQ    = OFF_WT_INMLA + 2ull * 3328 * 1024 * 2;
constexpr size_t OFF_WT_UKV   = OFF_WT_UQ + 2ull * 2304 * 384 * 2;
constexpr size_t OFF_WT_INRW  = OFF_WT_UKV + 2ull * 3072 * 256 * 2;
constexpr size_t OFF_WT_OUT   = OFF_WT_INRW + 2ull * 7296 * 1024 * 2;
constexpr size_t OFF_MEMH     = OFF_WT_OUT + 4ull * 1024 * 2048 * 2;
constexpr size_t OFF_MEMK     = OFF_MEMH + 4ull * 1024 * 1024 * 2;
constexpr size_t OFF_MEMVT    = OFF_MEMK + 4ull * 4 * 4 * 256 * 128 * 2;
constexpr size_t OFF_COS      = OFF_MEMVT + 4ull * 4 * 4 * 256 * 128 * 2;
constexpr size_t OFF_SIN      = OFF_COS + 32768ull * 32 * 4;
constexpr size_t OFF_CNT      = OFF_SIN + 32768ull * 32 * 4;
constexpr size_t OFF_BAR      = OFF_CNT + 4096;
constexpr size_t OFF_STATE    = OFF_BAR + 256;
constexpr size_t OFF_BND      = OFF_STATE + 96ull * 4096 * 4;
constexpr size_t OFF_H        = OFF_BND + 4ull * 4736 * 2 + 128;
constexpr size_t OFF_R        = OFF_H + 16384ull * 1024 * 2;
constexpr size_t OFF_U        = OFF_R;
constexpr size_t OFF_Q        = OFF_R + 16384ull * 3264 * 2;
constexpr size_t OFF_K        = OFF_Q + 2ull * 12 * 8192 * 192 * 2;
constexpr size_t OFF_VT       = OFF_K + 2ull * 12 * 8192 * 192 * 2;
constexpr size_t OFF_YR       = OFF_R + 16384ull * 7296 * 2;
constexpr size_t OFF_BV       = OFF_YR + 16384ull * 1536 * 2;
constexpr size_t OFF_ST       = OFF_BV + 16384ull * 1536 * 2;
constexpr size_t OFF_BS       = OFF_ST + 16384ull * 24 * 4 * 4;
constexpr size_t WS_NEED      = OFF_BS + 16384ull * 24 * 4;

constexpr int SMEM_BYTES = 110592;

struct Params {
  const float *x, *mem; const int* pos;
  const float *norm_g, *mem_norm_g, *w_mem_kv, *w_in_mla, *q_norm_g, *kv_norm_g, *w_uq, *w_ukv, *w_in_rwkv;
  const float *mu, *w0, *w2, *a0, *a2, *k_k, *k_a, *r_k, *gn_w, *gn_b, *w_out, *final_g;
  float* out; char* ws;
};

DI int otid() { int t = threadIdx.x; asm volatile("" : "+v"(t)); return t; }
DI float bf2f(unsigned v) { return __uint_as_float(v << 16); }
DI unsigned pack2(float a, float b) { f2_t v = {a, b}; bf2_t r = __builtin_convertvector(v, bf2_t); return __builtin_bit_cast(unsigned, r); }
DI u16 f2bf(float a) { return (u16)(pack2(a, 0.f) & 0xffffu); }
DI float ex2(float x) { return __builtin_amdgcn_exp2f(x); }
DI float fexp(float x) { return __builtin_amdgcn_exp2f(x * 1.4426950408889634f); }
DI float frcp(float x) { return __builtin_amdgcn_rcpf(x); }
DI float silu(float g) { return g * frcp(1.f + fexp(-g)); }
DI float wave_sum(float v) { for (int o = 32; o > 0; o >>= 1) v += __shfl_xor(v, o); return v; }
DI int crow(int reg, int h) { return (reg & 3) + 8 * (reg >> 2) + 4 * h; }
DI float dppf(float x, const int ctrl_sel) {
  int xi;
  if (ctrl_sel == 0) xi = __builtin_amdgcn_update_dpp(0, __float_as_int(x), 0xB1, 0xf, 0xf, true);
  else if (ctrl_sel == 1) xi = __builtin_amdgcn_update_dpp(0, __float_as_int(x), 0x4E, 0xf, 0xf, true);
  else xi = __builtin_amdgcn_update_dpp(0, __float_as_int(x), 0x141, 0xf, 0xf, true);
  return __int_as_float(xi);
}
DI float red4(float x) { x += dppf(x, 0); x += dppf(x, 1); return x; }
DI float red8(float x) { x += dppf(x, 0); x += dppf(x, 1); x += dppf(x, 2); return x; }
DI int gtok(bool rw, int c, int lr) { return rw ? ((lr >> 12) * 8192 + c * 4096 + (lr & 4095)) : (c * 16384 + lr); }
DI void unpack8(const uint4& v, float* f) {
  f[0] = bf2f(v.x & 0xffffu); f[1] = bf2f(v.x >> 16); f[2] = bf2f(v.y & 0xffffu); f[3] = bf2f(v.y >> 16);
  f[4] = bf2f(v.z & 0xffffu); f[5] = bf2f(v.z >> 16); f[6] = bf2f(v.w & 0xffffu); f[7] = bf2f(v.w >> 16);
}
DI uint4 pack8(const float* f) { uint4 v; v.x = pack2(f[0], f[1]); v.y = pack2(f[2], f[3]); v.z = pack2(f[4], f[5]); v.w = pack2(f[6], f[7]); return v; }

DI void transpose_tile(const float* __restrict__ src, u16* __restrict__ dst, int K, int N, int tk, int tn, int drow, float* tile) {
  const int tid = otid();
  __syncthreads();
#pragma unroll
  for (int i = 0; i < 4; ++i) {
    int kr = (tid >> 4) + 16 * i, nc = (tid & 15) * 4;
    float4 v = *(const float4*)(src + (size_t)(tk * 64 + kr) * N + tn * 64 + nc);
    tile[kr * 65 + nc] = v.x; tile[kr * 65 + nc + 1] = v.y; tile[kr * 65 + nc + 2] = v.z; tile[kr * 65 + nc + 3] = v.w;
  }
  __syncthreads();
#pragma unroll
  for (int i = 0; i < 2; ++i) {
    int n = (tid >> 3) + 32 * i, kc = (tid & 7) * 8;
    float f[8];
#pragma unroll
    for (int e = 0; e < 8; ++e) f[e] = tile[(kc + e) * 65 + n];
    *(uint4*)(dst + (size_t)(drow + n) * K + tk * 64 + kc) = pack8(f);
  }
}

DI void rms_row_bf16(const float* __restrict__ src, const float* __restrict__ g, u16* __restrict__ dst, int lane) {
  float4 v[4]; float ss = 0.f;
#pragma unroll
  for (int i = 0; i < 4; ++i) { v[i] = *(const float4*)(src + i * 256 + lane * 4); ss += v[i].x * v[i].x + v[i].y * v[i].y + v[i].z * v[i].z + v[i].w * v[i].w; }
  ss = wave_sum(ss);
  float rs = rsqrtf(ss * (1.f / 1024.f) + 1e-6f);
#pragma unroll
  for (int i = 0; i < 4; ++i) {
    float4 gg = *(const float4*)(g + i * 256 + lane * 4);
    uint2 o; o.x = pack2(v[i].x * rs * gg.x, v[i].y * rs * gg.y); o.y = pack2(v[i].z * rs * gg.z, v[i].w * rs * gg.w);
    *(uint2*)(dst + i * 256 + lane * 4) = o;
  }
}

DI void phase_prep(const Params& p, char* smem) {
  const int tid = otid(), G = gridDim.x, bid = blockIdx.x;
  char* ws = p.ws;
  if (bid == 0) for (int i = tid; i < 1024; i += 256) ((int*)(ws + OFF_CNT))[i] = 0;
  float* tile = (float*)smem;
  for (int g0 = bid; g0 < 9168; g0 += G) {
    int g = g0;
    const float* src = nullptr; u16* dst = nullptr; int K = 0, N = 0; size_t dstr = 0; bool ukv = false;
    if (g < 1024) { src = p.w_mem_kv; dst = (u16*)(ws + OFF_WT_MEMKV); K = 1024; N = 1024; dstr = 1024ull * 1024; }
    else if ((g -= 1024) < 1632) { src = p.w_in_mla; dst = (u16*)(ws + OFF_WT_INMLA); K = 1024; N = 3264; dstr = 3328ull * 1024; }
    else if ((g -= 1632) < 432) { src = p.w_uq; dst = (u16*)(ws + OFF_WT_UQ); K = 384; N = 2304; dstr = 2304ull * 384; }
    else if ((g -= 432) < 384) { src = p.w_ukv; dst = (u16*)(ws + OFF_WT_UKV); K = 256; N = 3072; dstr = 3072ull * 256; ukv = true; }
    else if ((g -= 384) < 3648) { src = p.w_in_rwkv; dst = (u16*)(ws + OFF_WT_INRW); K = 1024; N = 7296; dstr = 7296ull * 1024; }
    else { g -= 3648; src = p.w_out; dst = (u16*)(ws + OFF_WT_OUT); K = 2048; N = 1024; dstr = 1024ull * 2048; }
    int ntn = N >> 6, per = (K >> 6) * ntn;
    int m = g / per, t = g - m * per;
    int tk = t / ntn, tn = t - tk * ntn;
    int drow = tn * 64;
    if (ukv) { const int hd = drow >> 8, dd = drow & 255; drow = (dd < 128) ? (hd * 128 + dd) : (1536 + hd * 128 + dd - 128); }
    transpose_tile(src + (size_t)m * K * N, dst + (size_t)m * dstr, K, N, tk, tn, drow, tile);
  }
  for (int i = bid * 256 + tid; i < 2 * 64 * 1024 / 8; i += G * 256) {
    int m = i / (64 * 1024 / 8), r = i - m * (64 * 1024 / 8);
    uint4 z; z.x = z.y = z.z = z.w = 0u;
    *(uint4*)((u16*)(ws + OFF_WT_INMLA) + (size_t)m * 3328 * 1024 + 3264ull * 1024 + (size_t)r * 8) = z;
  }
  float* cs = (float*)(ws + OFF_COS); float* sn = (float*)(ws + OFF_SIN);
  for (int i = bid * 256 + tid; i < 32768 * 32; i += G * 256) {
    int tk = i >> 5, pi = i & 31;
    float inv_freq = (float)exp2(-(double)(2 * pi) / 64.0 * 13.287712379549449);
    float ang = (float)p.pos[tk] * inv_freq;
    double rev = (double)ang * 0.15915494309189535;
    float fr = (float)(rev - rint(rev));
    cs[i] = __builtin_amdgcn_cosf(fr); sn[i] = __builtin_amdgcn_sinf(fr);
  }
  const int w = tid >> 6, lane = tid & 63;
  for (int row = bid * 4 + w; row < 4096; row += G * 4) {
    int L = row >> 10, m = row & 1023;
    rms_row_bf16(p.mem + (size_t)m * 1024, p.mem_norm_g + L * 1024, (u16*)(ws + OFF_MEMH) + (size_t)row * 1024, lane);
  }
}

DI void phase_norm(const Params& p, int L, int c) {
  const int tid = otid(), w = tid >> 6, lane = tid & 63;
  const bool rw = L & 1;
  const float* xs = (L == 0) ? p.x : p.out;
  u16* H = (u16*)(p.ws + OFF_H);
  for (int lr = blockIdx.x * 4 + w; lr < TC; lr += gridDim.x * 4) {
    int gt = gtok(rw, c, lr);
    rms_row_bf16(xs + (size_t)gt * 1024, p.norm_g + L * 1024, H + (size_t)lr * 1024, lane);
  }
}

DI void phase_final_norm(const Params& p, bool dry) {
  const int tid = otid(), w = tid >> 6, lane = tid & 63;
  for (int row = blockIdx.x * 4 + w; row < 32768; row += gridDim.x * 4) {
    float* xr = p.out + (size_t)row * 1024;
    float4 v[4]; float ss = 0.f;
#pragma unroll
    for (int i = 0; i < 4; ++i) { v[i] = *(const float4*)(xr + i * 256 + lane * 4); ss += v[i].x * v[i].x + v[i].y * v[i].y + v[i].z * v[i].z + v[i].w * v[i].w; }
    ss = wave_sum(ss);
    float rs = rsqrtf(ss * (1.f / 1024.f) + 1e-6f);
#pragma unroll
    for (int i = 0; i < 4; ++i) {
      float4 gg = *(const float4*)(p.final_g + i * 256 + lane * 4);
      float4 o; o.x = v[i].x * rs * gg.x; o.y = v[i].y * rs * gg.y; o.z = v[i].z * rs * gg.z; o.w = v[i].w * rs * gg.w;
      if (!dry) *(float4*)(xr + i * 256 + lane * 4) = o;
    }
  }
}

template <int TJ, bool SWAP, class Epi>
DI void gemm_phase(const u16* __restrict__ A, size_t strideAz, int lda, const u16* __restrict__ Bt, size_t strideBz, int ldb,
                   int Z, int Mt, int Nt, int GM, int K, char* smem, const Epi& epi) {
  constexpr int BN = 64 * TJ;
  constexpr int NB = BN / 32;
  const int tid = otid(), w = tid >> 6, lane = tid & 63, r = lane & 31, h = lane >> 5;
  const int wm = w >> 1, wn = w & 1;
  u16* As = (u16*)smem;
  u16* Bs = As + 2 * 256 * 72;
  const int G = gridDim.x, per = Mt * Nt, total = Z * per;
  const int lrow = tid >> 3, lcc = (tid & 7) * 8;
  const int nk = K >> 6;
  for (int base = 0; base < total; base += G) {
    const int t = blockIdx.x;
    const int q = base + (((G & 7) == 0) ? ((t & 7) * (G >> 3) + (t >> 3)) : t);
    if (q >= total) continue;
    const int z = q / per, qq = q - z * per;
    const int grp = qq / (GM * Nt), within = qq - grp * GM * Nt;
    const int mt = grp * GM + (within % GM), nt = within / GM;
    const int mta = (HYP1 && epi.dry) ? 0 : mt, nta = (HYP1 && epi.dry) ? 0 : nt;
    const u16* Ag = A + z * strideAz + (size_t)(mta * 256 + lrow) * lda + lcc;
    const u16* Bg = Bt + z * strideBz + (size_t)(nta * BN + lrow) * ldb + lcc;
    u32x4 ra[8], rb[NB];
    f32x16 acc[4][TJ];
#pragma unroll
    for (int i = 0; i < 4; ++i)
#pragma unroll
      for (int j = 0; j < TJ; ++j)
#pragma unroll
        for (int e = 0; e < 16; ++e) acc[i][j][e] = 0.f;
    __syncthreads();
#pragma unroll
    for (int i = 0; i < 8; ++i) ra[i] = *(const u32x4*)(Ag + (size_t)(32 * i) * lda);
#pragma unroll
    for (int i = 0; i < NB; ++i) rb[i] = *(const u32x4*)(Bg + (size_t)(32 * i) * ldb);
#pragma unroll
    for (int i = 0; i < 8; ++i) *(u32x4*)(As + (lrow + 32 * i) * 72 + lcc) = ra[i];
#pragma unroll
    for (int i = 0; i < NB; ++i) *(u32x4*)(Bs + (lrow + 32 * i) * 72 + lcc) = rb[i];
#pragma unroll
    for (int i = 0; i < 8; ++i) ra[i] = *(const u32x4*)(Ag + (size_t)(32 * i) * lda + 64);
#pragma unroll
    for (int i = 0; i < NB; ++i) rb[i] = *(const u32x4*)(Bg + (size_t)(32 * i) * ldb + 64);
    __syncthreads();
    for (int kt2 = 0; kt2 < nk; kt2 += 2) {
#pragma unroll
      for (int u = 0; u < 2; ++u) {
        const int kt = kt2 + u;
        const u16* as = As + u * 256 * 72 + (128 * wm + r) * 72 + 8 * h;
        const u16* bs = Bs + u * BN * 72 + (32 * TJ * wn + r) * 72 + 8 * h;
        bf16x8 af[2][4], bfr[2][TJ];
#pragma unroll
        for (int i = 0; i < 4; ++i) af[0][i] = *(const bf16x8*)(as + (32 * i) * 72);
#pragma unroll
        for (int j = 0; j < TJ; ++j) bfr[0][j] = *(const bf16x8*)(bs + (32 * j) * 72);
#pragma unroll
        for (int ks = 0; ks < 4; ++ks) {
          if (ks < 3) {
#pragma unroll
            for (int i = 0; i < 4; ++i) af[(ks + 1) & 1][i] = *(const bf16x8*)(as + (32 * i) * 72 + 16 * (ks + 1));
#pragma unroll
            for (int j = 0; j < TJ; ++j) bfr[(ks + 1) & 1][j] = *(const bf16x8*)(bs + (32 * j) * 72 + 16 * (ks + 1));
          }
          __builtin_amdgcn_sched_barrier(0);
#pragma unroll
          for (int i = 0; i < 4; ++i)
#pragma unroll
            for (int j = 0; j < TJ; ++j)
              acc[i][j] = SWAP ? MFMA32(bfr[ks & 1][j], af[ks & 1][i], acc[i][j]) : MFMA32(af[ks & 1][i], bfr[ks & 1][j], acc[i][j]);
          if (ks == 0 && !(HYP2 && epi.dry)) {
            if (kt + 1 < nk) {
              u16* ad = As + (u ^ 1) * 256 * 72; u16* bd = Bs + (u ^ 1) * BN * 72;
#pragma unroll
              for (int i = 0; i < 8; ++i) *(u32x4*)(ad + (lrow + 32 * i) * 72 + lcc) = ra[i];
#pragma unroll
              for (int i = 0; i < NB; ++i) *(u32x4*)(bd + (lrow + 32 * i) * 72 + lcc) = rb[i];
            }
            if (kt + 2 < nk) {
#pragma unroll
              for (int i = 0; i < 8; ++i) ra[i] = *(const u32x4*)(Ag + (size_t)(32 * i) * lda + (kt + 2) * 64);
#pragma unroll
              for (int i = 0; i < NB; ++i) rb[i] = *(const u32x4*)(Bg + (size_t)(32 * i) * ldb + (kt + 2) * 64);
            }
          }
          __builtin_amdgcn_sched_barrier(0);
        }
        __syncthreads();
      }
    }
#pragma unroll
    for (int i = 0; i < 4; ++i)
#pragma unroll
      for (int j = 0; j < TJ; ++j) {
        if (SWAP) epi(z, mt * 256 + 128 * wm + 32 * i + r, nt * BN + 32 * TJ * wn + 32 * j, h, acc[i][j]);
        else epi(z, mt * 256 + 128 * wm + 32 * i, nt * BN + 32 * TJ * wn + 32 * j + r, h, acc[i][j]);
      }
  }
}

struct EpiStoreBf16 {
  u16* C; int ldc; int ncols; bool dry;
  DI void operator()(int z, int row, int colbase, int h, const f32x16& a) const {
    if (dry) return;
#pragma unroll
    for (int g = 0; g < 4; ++g) {
      const int col = colbase + 8 * g + 4 * h;
      if (col < ncols) {
        u32x2 pk = {pack2(a[4 * g], a[4 * g + 1]), pack2(a[4 * g + 2], a[4 * g + 3])};
        *(u32x2*)(C + (size_t)row * ldc + col) = pk;
      }
    }
  }
};
struct EpiResid {
  const float* xin; float* xout; bool rw; int c; bool dry;
  DI void operator()(int z, int row, int colbase, int h, const f32x16& a) const {
    if (dry) return;
    const size_t o = (size_t)gtok(rw, c, row) * 1024 + colbase + 4 * h;
#pragma unroll
    for (int g = 0; g < 4; ++g) {
      float4 v = *(const float4*)(xin + o + 8 * g);
      v.x += a[4 * g]; v.y += a[4 * g + 1]; v.z += a[4 * g + 2]; v.w += a[4 * g + 3];
      *(float4*)(xout + o + 8 * g) = v;
    }
  }
};
struct EpiUQ {
  u16* Q; const float* cs; const float* sn; int c; bool dry;
  DI void operator()(int z, int row, int colbase, int h, const f32x16& a) const {
    if (dry) return;
    const int head = colbase / 192, db = colbase - head * 192;
    const int lb = row >> 13, s = row & 8191;
    u16* qp = Q + ((size_t)(lb * 12 + head) * 8192 + s) * 192 + db + 4 * h;
    const size_t ti = (size_t)(c * 16384 + row) * 32;
#pragma unroll
    for (int g = 0; g < 4; ++g) {
      float v0 = a[4 * g], v1 = a[4 * g + 1], v2 = a[4 * g + 2], v3 = a[4 * g + 3];
      if (db >= 128) {
        const int pi = (db - 128 + 8 * g + 4 * h) >> 1;
        const float2 cc = *(const float2*)(cs + ti + pi), ss = *(const float2*)(sn + ti + pi);
        const float o0 = v0 * cc.x - v1 * ss.x, o1 = v0 * ss.x + v1 * cc.x;
        const float o2 = v2 * cc.y - v3 * ss.y, o3 = v2 * ss.y + v3 * cc.y;
        v0 = o0; v1 = o1; v2 = o2; v3 = o3;
      }
      u32x2 pk = {pack2(v0, v1), pack2(v2, v3)};
      *(u32x2*)(qp + 8 * g) = pk;
    }
  }
};
struct EpiUK {
  u16* Kb; bool dry;
  DI void operator()(int z, int row, int colbase, int h, const f32x16& a) const {
    if (dry) return;
    const int head = colbase >> 7, db = colbase & 127;
    const int lb = row >> 13, s = row & 8191;
    u16* kp = Kb + ((size_t)(lb * 12 + head) * 8192 + s) * 192 + db + 4 * h;
#pragma unroll
    for (int g = 0; g < 4; ++g) {
      u32x2 pk = {pack2(a[4 * g], a[4 * g + 1]), pack2(a[4 * g + 2], a[4 * g + 3])};
      *(u32x2*)(kp + 8 * g) = pk;
    }
  }
};
struct EpiUV {
  u16* Vt; bool dry;
  DI void operator()(int z, int rowbase, int col, int h, const f32x16& a) const {
    if (dry) return;
    const int head = col >> 7, d = col & 127;
#pragma unroll
    for (int g = 0; g < 4; ++g) {
      int lr = rowbase + 8 * g + 4 * h; int lb = lr >> 13, s = lr & 8191;
      u32x2 pk = {pack2(a[4 * g], a[4 * g + 1]), pack2(a[4 * g + 2], a[4 * g + 3])};
      *(u32x2*)(Vt + (((size_t)(lb * 12 + head) * 128 + (s >> 6)) * 128 + d) * 64 + (s & 63)) = pk;
    }
  }
};
struct EpiMemKV {
  u16* MK; u16* MVt; bool dry;
  DI void operator()(int z, int rowbase, int col, int h, const f32x16& a) const {
    if (col < 512) {
      const int xh = col >> 7, d = col & 127;
#pragma unroll
      for (int e = 0; e < 16; ++e) {
        int m = rowbase + crow(e, h); int b = m >> 8, mi = m & 255;
        MK[((size_t)((z * 4 + b) * 4 + xh) * 256 + mi) * 128 + d] = f2bf(a[e]);
      }
    } else {
      const int n = col - 512, xh = n >> 7, d = n & 127;
#pragma unroll
      for (int g = 0; g < 4; ++g) {
        int m = rowbase + 8 * g + 4 * h; int b = m >> 8, mi = m & 255;
        uint2 pk; pk.x = pack2(a[4 * g], a[4 * g + 1]); pk.y = pack2(a[4 * g + 2], a[4 * g + 3]);
        *(uint2*)(MVt + (((size_t)((z * 4 + b) * 4 + xh) * 4 + (mi >> 6)) * 128 + d) * 64 + (mi & 63)) = pk;
      }
    }
  }
};

DI void phase_kvprep(const Params& p, int L, int c, bool dry) {
  const int tid = otid(), w = tid >> 6, lane = tid & 63;
  const int j = L >> 1;
  u16* U = (u16*)(p.ws + OFF_U); u16* Kb = (u16*)(p.ws + OFF_K);
  const float* cs = (const float*)(p.ws + OFF_COS); const float* sn = (const float*)(p.ws + OFF_SIN);
  for (int lr = blockIdx.x * 4 + w; lr < TC; lr += gridDim.x * 4) {
    u16* row = U + (size_t)lr * LDU_M;
    float fq[8], fk[8]; float sq = 0.f, sk = 0.f;
    if (lane < 48) { uint4 v = *(const uint4*)(row + M_CQ + lane * 8); unpack8(v, fq);
#pragma unroll
      for (int e = 0; e < 8; ++e) sq += fq[e] * fq[e]; }
    if (lane < 32) { uint4 v = *(const uint4*)(row + M_CKV + lane * 8); unpack8(v, fk);
#pragma unroll
      for (int e = 0; e < 8; ++e) sk += fk[e] * fk[e]; }
    sq = wave_sum(sq); sk = wave_sum(sk);
    float rq = rsqrtf(sq * (1.f / 384.f) + 1e-6f), rk = rsqrtf(sk * (1.f / 256.f) + 1e-6f);
    if (dry) continue;
    if (lane < 48) {
      const float* g = p.q_norm_g + j * 384 + lane * 8;
#pragma unroll
      for (int e = 0; e < 8; ++e) fq[e] = fq[e] * rq * g[e];
      *(uint4*)(row + M_CQ + lane * 8) = pack8(fq);
    }
    if (lane < 32) {
      const float* g = p.kv_norm_g + j * 256 + lane * 8;
#pragma unroll
      for (int e = 0; e < 8; ++e) fk[e] = fk[e] * rk * g[e];
      *(uint4*)(row + M_CKV + lane * 8) = pack8(fk);
    }
    if (lane < 8) {
      float f[8], o[8]; uint4 v = *(const uint4*)(row + M_KR + lane * 8); unpack8(v, f);
      int gt = c * 16384 + lr;
#pragma unroll
      for (int i = 0; i < 4; ++i) {
        float cc = cs[gt * 32 + lane * 4 + i], ss = sn[gt * 32 + lane * 4 + i];
        o[2 * i] = f[2 * i] * cc - f[2 * i + 1] * ss; o[2 * i + 1] = f[2 * i] * ss + f[2 * i + 1] * cc;
      }
      uint4 pk = pack8(o);
      int lb = lr >> 13, s = lr & 8191;
#pragma unroll
      for (int hd = 0; hd < 12; ++hd) *(uint4*)(Kb + ((size_t)(lb * 12 + hd) * 8192 + s) * 192 + 128 + lane * 8) = pk;
    }
  }
}

template <int DQK>
DI void attn_item(const u16* __restrict__ Qp, int ldq, const u16* __restrict__ Kp, const u16* __restrict__ Vtp, int ldv,
                  int nkt, int q0, bool causal, float c, u16* Yp, int ldy, char* smem, bool dry) {
  constexpr int KLD = DQK + 8;
  constexpr int NKC = DQK * 64 / 8 / 256;
  constexpr int NKS = DQK / 16;
  constexpr int CPR = DQK / 8;
  constexpr int BUFE = 64 * KLD + 128 * 72;
  u16* L0 = (u16*)smem;
  const int tid = otid(), w = tid >> 6, lane = tid & 63, r = lane & 31, h = lane >> 5;
  bf16x8 qf[NKS];
  {
    const u16* qrow = Qp + (size_t)(32 * w + r) * ldq + 8 * h;
#pragma unroll
    for (int ks = 0; ks < NKS; ++ks) qf[ks] = *(const bf16x8*)(qrow + 16 * ks);
  }
  f32x16 o[4];
#pragma unroll
  for (int dt = 0; dt < 4; ++dt)
#pragma unroll
    for (int e = 0; e < 16; ++e) o[dt][e] = 0.f;
  float m = -INFINITY, l = 0.f;
  u32x4 kst[NKC], vst[4];
  const int vd = tid >> 3, vc8 = tid & 7;
  int kso[NKC];
#pragma unroll
  for (int i = 0; i < NKC; ++i) { int id = tid + 256 * i; int row = id / CPR, cc = id - row * CPR; kso[i] = row * KLD + cc * 8; }
  const int vso = 64 * KLD + vd * 72 + 16 * (vc8 >> 1) + 4 * (vc8 & 1);
  __syncthreads();
#pragma unroll
  for (int i = 0; i < NKC; ++i) kst[i] = *(const u32x4*)(Kp + (size_t)(tid + 256 * i) * 8);
#pragma unroll
  for (int i = 0; i < 4; ++i) vst[i] = *(const u32x4*)(Vtp + (size_t)(tid + 256 * i) * 8);
#pragma unroll
  for (int i = 0; i < NKC; ++i) *(u32x4*)(L0 + kso[i]) = kst[i];
#pragma unroll
  for (int i = 0; i < 4; ++i) {
    u16* dst = L0 + vso + (32 * i) * 72;
    u32x2 lo = {vst[i].x, vst[i].y}, hi = {vst[i].z, vst[i].w};
    *(u32x2*)dst = lo; *(u32x2*)(dst + 8) = hi;
  }
  if (nkt > 1) {
    const u16* kg = Kp + (size_t)64 * DQK;
#pragma unroll
    for (int i = 0; i < NKC; ++i) kst[i] = *(const u32x4*)(kg + (size_t)(tid + 256 * i) * 8);
#pragma unroll
    for (int i = 0; i < 4; ++i) vst[i] = *(const u32x4*)(Vtp + 8192 + (size_t)(tid + 256 * i) * 8);
  }
  __syncthreads();
  const int qmin = q0 + 32 * w;
  for (int kt = 0; kt < nkt; ++kt) {
    const u16* Ks = L0 + (kt & 1) * BUFE;
    const u16* Vs = Ks + 64 * KLD;
    u16* Ln = L0 + ((kt + 1) & 1) * BUFE;
    const bool active = !(causal && kt * 64 > qmin + 31);
    f32x16 s0, s1;
#pragma unroll
    for (int e = 0; e < 16; ++e) { s0[e] = 0.f; s1[e] = 0.f; }
    const u16* k0 = Ks + r * KLD + 8 * h;
    bf16x8 ka[2][2];
    if (active) {
      ka[0][0] = *(const bf16x8*)(k0); ka[0][1] = *(const bf16x8*)(k0 + 32 * KLD);
      ka[1][0] = *(const bf16x8*)(k0 + 16); ka[1][1] = *(const bf16x8*)(k0 + 32 * KLD + 16);
      __builtin_amdgcn_sched_barrier(0);
      s0 = MFMA32(ka[0][0], qf[0], s0); s1 = MFMA32(ka[0][1], qf[0], s1);
    }
    if (kt + 1 < nkt) {
#pragma unroll
      for (int i = 0; i < NKC; ++i) *(u32x4*)(Ln + kso[i]) = kst[i];
#pragma unroll
      for (int i = 0; i < 4; ++i) {
        u16* dst = Ln + vso + (32 * i) * 72;
        u32x2 lo = {vst[i].x, vst[i].y}, hi = {vst[i].z, vst[i].w};
        *(u32x2*)dst = lo; *(u32x2*)(dst + 8) = hi;
      }
    }
    if (kt + 2 < nkt) {
      const u16* kg = Kp + (size_t)(kt + 2) * 64 * DQK;
#pragma unroll
      for (int i = 0; i < NKC; ++i) kst[i] = *(const u32x4*)(kg + (size_t)(tid + 256 * i) * 8);
#pragma unroll
      for (int i = 0; i < 4; ++i) vst[i] = *(const u32x4*)(Vtp + (size_t)(kt + 2) * 8192 + (size_t)(tid + 256 * i) * 8);
    }
    if (active) {
      __builtin_amdgcn_sched_barrier(0);
#pragma unroll
      for (int ks = 1; ks < NKS; ++ks) {
        if (ks + 1 < NKS) {
          ka[(ks + 1) & 1][0] = *(const bf16x8*)(k0 + 16 * (ks + 1));
          ka[(ks + 1) & 1][1] = *(const bf16x8*)(k0 + 32 * KLD + 16 * (ks + 1));
        }
        __builtin_amdgcn_sched_barrier(0);
        s0 = MFMA32(ka[ks & 1][0], qf[ks], s0); s1 = MFMA32(ka[ks & 1][1], qf[ks], s1);
        __builtin_amdgcn_sched_barrier(0);
      }
      const u16* v0 = Vs + r * 72 + 8 * h;
      bf16x8 va[2][4];
#pragma unroll
      for (int dt = 0; dt < 4; ++dt) va[0][dt] = *(const bf16x8*)(v0 + (32 * dt) * 72);
      if (causal && kt * 64 + 63 > qmin) {
        const int qi = qmin + r;
#pragma unroll
        for (int e = 0; e < 16; ++e) {
          int key = kt * 64 + crow(e, h);
          if (key > qi) s0[e] = -INFINITY;
          if (key + 32 > qi) s1[e] = -INFINITY;
        }
      }
      float mx = fmaxf(s0[0], s1[0]);
#pragma unroll
      for (int e = 1; e < 16; ++e) mx = fmaxf(mx, fmaxf(s0[e], s1[e]));
      mx = fmaxf(mx, __shfl_xor(mx, 32));
      if (__builtin_amdgcn_ballot_w64((mx - m) * c > 8.f) != 0ull) {
        const float mn = fmaxf(m, mx);
        const float alpha = ex2((m - mn) * c);
        m = mn;
        l *= alpha;
#pragma unroll
        for (int dt = 0; dt < 4; ++dt)
#pragma unroll
          for (int e = 0; e < 16; ++e) o[dt][e] *= alpha;
      }
      const float mc = m * c;
      float ps = 0.f;
#pragma unroll
      for (int e = 0; e < 16; ++e) { s0[e] = ex2(fmaf(s0[e], c, -mc)); s1[e] = ex2(fmaf(s1[e], c, -mc)); ps += s0[e] + s1[e]; }
      l += ps;
      bf16x8 pf[4];
      {
        u32x4 t;
        t.x = pack2(s0[0], s0[1]); t.y = pack2(s0[2], s0[3]); t.z = pack2(s0[4], s0[5]); t.w = pack2(s0[6], s0[7]); pf[0] = __builtin_bit_cast(bf16x8, t);
        t.x = pack2(s0[8], s0[9]); t.y = pack2(s0[10], s0[11]); t.z = pack2(s0[12], s0[13]); t.w = pack2(s0[14], s0[15]); pf[1] = __builtin_bit_cast(bf16x8, t);
        t.x = pack2(s1[0], s1[1]); t.y = pack2(s1[2], s1[3]); t.z = pack2(s1[4], s1[5]); t.w = pack2(s1[6], s1[7]); pf[2] = __builtin_bit_cast(bf16x8, t);
        t.x = pack2(s1[8], s1[9]); t.y = pack2(s1[10], s1[11]); t.z = pack2(s1[12], s1[13]); t.w = pack2(s1[14], s1[15]); pf[3] = __builtin_bit_cast(bf16x8, t);
      }
#pragma unroll
      for (int kk = 0; kk < 4; ++kk) {
        if (kk < 3) {
#pragma unroll
          for (int dt = 0; dt < 4; ++dt) va[(kk + 1) & 1][dt] = *(const bf16x8*)(v0 + (32 * dt) * 72 + 16 * (kk + 1));
        }
        __builtin_amdgcn_sched_barrier(0);
#pragma unroll
        for (int dt = 0; dt < 4; ++dt) o[dt] = MFMA32(va[kk & 1][dt], pf[kk], o[dt]);
        __builtin_amdgcn_sched_barrier(0);
      }
    }
    __syncthreads();
  }
  const float lt = l + __shfl_xor(l, 32);
  const float inv = 1.f / lt;
  if (dry) return;
  u16* yrow = Yp + (size_t)(32 * w + r) * ldy;
#pragma unroll
  for (int dt = 0; dt < 4; ++dt)
#pragma unroll
    for (int g = 0; g < 4; ++g) {
      const int d = 32 * dt + 8 * g + 4 * h;
      uint2 gv = *(const uint2*)(yrow + d);
      float g0 = bf2f(gv.x & 0xffffu), g1 = bf2f(gv.x >> 16), g2 = bf2f(gv.y & 0xffffu), g3 = bf2f(gv.y >> 16);
      uint2 ov;
      ov.x = pack2(o[dt][4 * g] * inv * silu(g0), o[dt][4 * g + 1] * inv * silu(g1));
      ov.y = pack2(o[dt][4 * g + 2] * inv * silu(g2), o[dt][4 * g + 3] * inv * silu(g3));
      *(uint2*)(yrow + d) = ov;
    }
}

DI void memattn_item(const Params& p, int L, int c, int item, char* smem, bool dry) {
  const bool rw = L & 1;
  const int ldu = rw ? LDU_R : LDU_M, oq = rw ? R_QM : M_QM, og = rw ? R_GATE : M_GATE;
  const int tile = item >> 2, xh = item & 3;
  const int b = gtok(rw, c, tile * 128) >> 13;
  u16* U = (u16*)(p.ws + OFF_U);
  const u16* MK = (const u16*)(p.ws + OFF_MEMK) + (size_t)((L * 4 + b) * 4 + xh) * 256 * 128;
  const u16* MV = (const u16*)(p.ws + OFF_MEMVT) + (size_t)((L * 4 + b) * 4 + xh) * 128 * 256;
  attn_item<128>(U + (size_t)tile * 128 * ldu + oq + xh * 128, ldu, MK, MV, 256, 4, 0, false,
                 0.08838834764831845f * 1.4426950408889634f, U + (size_t)tile * 128 * ldu + og + 1536 + xh * 128, ldu, smem, dry);
}

DI void phase_attn(const Params& p, int L, int c, char* smem, int* s_item, bool dry) {
  int* cnt = (int*)(p.ws + OFF_CNT) + 64 + ((L * 2 + c) * 2 + (dry ? 1 : 0)) * 16;
  u16* U = (u16*)(p.ws + OFF_U);
  const u16* Q = (const u16*)(p.ws + OFF_Q); const u16* Kb = (const u16*)(p.ws + OFF_K); const u16* Vt = (const u16*)(p.ws + OFF_VT);
  const int xcc = (int)(__builtin_amdgcn_s_getreg((3 << 11) | 20) & 7u);
  for (int k = 0; k < 8; ++k) {
    const int x = (xcc + k) & 7;
    for (;;) {
      __syncthreads();
      if (otid() == 0) *s_item = atomicAdd(cnt + x, 1);
      __syncthreads();
      const int item = *s_item;
      if (item >= 192) break;
      const int qt = 63 - (item & 63), bh = 3 * x + (item >> 6);
      const int lb = bh / 12, head = bh - lb * 12;
      const int q0 = qt * 128;
      attn_item<192>(Q + ((size_t)(lb * 12 + head) * 8192 + q0) * 192, 192, Kb + (size_t)(lb * 12 + head) * 8192 * 192,
                     Vt + (size_t)(lb * 12 + head) * 128 * 8192, 8192, 2 * (qt + 1), q0, true,
                     0.07216878364870323f * 1.4426950408889634f,
                     U + (size_t)(lb * 8192 + q0) * LDU_M + M_GATE + head * 128, LDU_M, smem, dry);
    }
  }
  for (;;) {
    __syncthreads();
    if (otid() == 0) *s_item = atomicAdd(cnt + 8, 1);
    __syncthreads();
    const int item = *s_item;
    if (item >= 512) break;
    memattn_item(p, L, c, item, smem, dry);
  }
}

DI void scan_item(const Params& p, int L, int c, int item, char* smem, bool dry) {
  const int tid = otid(), w = tid >> 6, lane = tid & 63, r = lane & 31, h = lane >> 5;
  const int j = L >> 1;
  const int b = item / 48, rem = item - b * 48, head = rem >> 1, half = rem & 1;
  float* PA  = (float*)smem;
  float* LO  = PA;
  float* Vst = PA + 32 * 5 * 64;
  float* Yst = Vst + 32 * 32;
  float* PRM = Yst + 32 * 32;
  float* BON = PRM + 10 * 64;
  float* CC  = BON + 32;
  u16* A1  = (u16*)(CC + 80);
  u16* W2t = A1 + 2 * 32 * 72;
  const u16* U = (const u16*)(p.ws + OFF_U);
  const u16* BND = (const u16*)(p.ws + OFF_BND);
  u16* YR = (u16*)(p.ws + OFF_YR); u16* BV = (u16*)(p.ws + OFF_BV);
  float* ST = (float*)(p.ws + OFF_ST); float* BS = (float*)(p.ws + OFF_BS);
  float* STATE = (float*)(p.ws + OFF_STATE);
  __syncthreads();
  if (tid < 64) {
    const float* mu = p.mu + j * SHIFTW;
    const int hc = head * 64 + tid;
    PRM[0 * 64 + tid] = mu[R_R + hc]; PRM[1 * 64 + tid] = mu[R_K + hc]; PRM[2 * 64 + tid] = mu[R_WD + tid]; PRM[3 * 64 + tid] = mu[R_AD + tid];
    PRM[4 * 64 + tid] = p.w0[j * 1536 + hc]; PRM[5 * 64 + tid] = p.a0[j * 1536 + hc]; PRM[6 * 64 + tid] = p.k_k[j * 1536 + hc];
    PRM[7 * 64 + tid] = p.k_a[j * 1536 + hc]; PRM[8 * 64 + tid] = p.r_k[j * 1536 + hc];
    PRM[9 * 64 + tid] = (tid < 32) ? mu[R_V + head * 64 + 32 * half + tid] : 0.f;
  }
  for (int e = tid; e < 8192; e += 256) {
    int arr = e >> 12, jj = (e >> 6) & 63, cc = e & 63;
    const float* src = (arr ? p.a2 : p.w2) + (size_t)j * 64 * 1536;
    W2t[(arr * 64 + cc) * 72 + jj] = f2bf(src[jj * 1536 + head * 64 + cc]);
  }
  const int rowl = lane >> 3, ks = lane & 7, row32 = 8 * w + rowl;
  float S[8];
  {
    float* sp = STATE + ((size_t)((b * 24 + head) * 64 + 32 * half + row32)) * 64 + 8 * ks;
#pragma unroll
    for (int i = 0; i < 8; ++i) S[i] = (c == 0) ? 0.f : sp[i];
  }
  const int tt = tid >> 3, cs = tid & 7;
  uint4 Rr_c, Rr_p, Rk_c, Rk_p, Rw_c, Rw_p, Ra_c, Ra_p, Rv_c, Rv_p;
  const uint4 zero4 = {0u, 0u, 0u, 0u};
  auto load_raw = [&](int tc) {
    const int lr = b * 4096 + tc * 32 + tt;
    const int s = c * 4096 + tc * 32 + tt;
    const u16* cur = U + (size_t)lr * LDU_R;
    const u16* prv = (s == 4096 && c == 1) ? (BND + (size_t)b * SHIFTW) : (cur - LDU_R);
    const bool hp = (s != 0);
    Rr_c = *(const uint4*)(cur + R_R + head * 64 + cs * 8);  Rr_p = hp ? *(const uint4*)(prv + R_R + head * 64 + cs * 8) : zero4;
    Rk_c = *(const uint4*)(cur + R_K + head * 64 + cs * 8);  Rk_p = hp ? *(const uint4*)(prv + R_K + head * 64 + cs * 8) : zero4;
    Rw_c = *(const uint4*)(cur + R_WD + cs * 8);             Rw_p = hp ? *(const uint4*)(prv + R_WD + cs * 8) : zero4;
    Ra_c = *(const uint4*)(cur + R_AD + cs * 8);             Ra_p = hp ? *(const uint4*)(prv + R_AD + cs * 8) : zero4;
    const int vo = R_V + head * 64 + 32 * half + (cs & 3) * 8;
    Rv_c = *(const uint4*)(cur + vo);                        Rv_p = hp ? *(const uint4*)(prv + vo) : zero4;
  };
  load_raw(0);
  __syncthreads();
  for (int tc = 0; tc < 128; ++tc) {
    const int lr = b * 4096 + tc * 32 + tt;
    float rm[8], km[8];
    {
      float cu[8], pv[8], t8[8];
      unpack8(Rr_c, cu); unpack8(Rr_p, pv);
#pragma unroll
      for (int e = 0; e < 8; ++e) rm[e] = cu[e] + (pv[e] - cu[e]) * PRM[0 * 64 + cs * 8 + e];
      unpack8(Rk_c, cu); unpack8(Rk_p, pv);
#pragma unroll
      for (int e = 0; e < 8; ++e) km[e] = cu[e] + (pv[e] - cu[e]) * PRM[1 * 64 + cs * 8 + e];
      unpack8(Rw_c, cu); unpack8(Rw_p, pv);
#pragma unroll
      for (int e = 0; e < 8; ++e) {
        float xw = cu[e] + (pv[e] - cu[e]) * PRM[2 * 64 + cs * 8 + e];
        float ee = ex2(xw * 2.8853900817779268f);
        t8[e] = 1.f - 2.f * frcp(ee + 1.f);
      }
      *(uint4*)(A1 + (0 * 32 + tt) * 72 + cs * 8) = pack8(t8);
      unpack8(Ra_c, cu); unpack8(Ra_p, pv);
#pragma unroll
      for (int e = 0; e < 8; ++e) t8[e] = cu[e] + (pv[e] - cu[e]) * PRM[3 * 64 + cs * 8 + e];
      *(uint4*)(A1 + (1 * 32 + tt) * 72 + cs * 8) = pack8(t8);
      unpack8(Rv_c, cu); unpack8(Rv_p, pv);
      if (cs < 4) {
#pragma unroll
        for (int e = 0; e < 8; ++e) Vst[tt * 32 + cs * 8 + e] = cu[e] + (pv[e] - cu[e]) * PRM[9 * 64 + cs * 8 + e];
      }
    }
    __syncthreads();
    {
      const int arr = w >> 1, nt = w & 1;
      f32x16 acc;
#pragma unroll
      for (int e = 0; e < 16; ++e) acc[e] = 0.f;
#pragma unroll
      for (int k4 = 0; k4 < 4; ++k4) {
        bf16x8 a = *(const bf16x8*)(A1 + (arr * 32 + r) * 72 + 16 * k4 + 8 * h);
        bf16x8 bw = *(const bf16x8*)(W2t + (arr * 64 + 32 * nt + r) * 72 + 16 * k4 + 8 * h);
        acc = MFMA32(a, bw, acc);
      }
#pragma unroll
      for (int e = 0; e < 16; ++e) LO[(arr * 32 + crow(e, h)) * 64 + 32 * nt + r] = acc[e];
    }
    __syncthreads();
    float lw[8], la[8];
    {
      float4 t0 = *(const float4*)(LO + (0 * 32 + tt) * 64 + cs * 8), t1 = *(const float4*)(LO + (0 * 32 + tt) * 64 + cs * 8 + 4);
      lw[0] = t0.x; lw[1] = t0.y; lw[2] = t0.z; lw[3] = t0.w; lw[4] = t1.x; lw[5] = t1.y; lw[6] = t1.z; lw[7] = t1.w;
      t0 = *(const float4*)(LO + (1 * 32 + tt) * 64 + cs * 8); t1 = *(const float4*)(LO + (1 * 32 + tt) * 64 + cs * 8 + 4);
      la[0] = t0.x; la[1] = t0.y; la[2] = t0.z; la[3] = t0.w; la[4] = t1.x; la[5] = t1.y; la[6] = t1.z; la[7] = t1.w;
    }
    __syncthreads();
    {
      float dec[8], kk[8], av[8], kp[8];
      float ssq = 0.f, bon = 0.f;
#pragma unroll
      for (int e = 0; e < 8; ++e) {
        const int ch = cs * 8 + e;
        float xx = -(lw[e] + PRM[4 * 64 + ch]);
        float sp = fmaxf(xx, 0.f) + __logf(1.f + fexp(-fabsf(xx)));
        float wv = -sp - 0.5f;
        dec[e] = fexp(-fexp(wv));
        float a = frcp(1.f + fexp(-(la[e] + PRM[5 * 64 + ch])));
        av[e] = a;
        kk[e] = km[e] * PRM[6 * 64 + ch];
        ssq += kk[e] * kk[e];
        kp[e] = km[e] * (1.f + (a - 1.f) * PRM[7 * 64 + ch]);
        bon += rm[e] * kp[e] * PRM[8 * 64 + ch];
      }
      ssq = red8(ssq); bon = red8(bon);
      const float inv = 1.f / fmaxf(sqrtf(ssq), 1e-12f);
      float nk[8], bb[8], dr[8];
      float c1 = 0.f, c2 = 0.f;
#pragma unroll
      for (int e = 0; e < 8; ++e) {
        float kn = kk[e] * inv; nk[e] = -kn; bb[e] = kn * av[e];
        c1 = fmaf(bb[e], rm[e], c1); c2 = fmaf(kp[e], rm[e], c2); dr[e] = dec[e] * rm[e];
      }
      c1 = red8(c1); c2 = red8(c2);
      float* pa = PA + tt * 320 + cs * 8;
      *(float4*)(pa) = make_float4(dec[0], dec[1], dec[2], dec[3]); *(float4*)(pa + 4) = make_float4(dec[4], dec[5], dec[6], dec[7]);
      *(float4*)(pa + 64) = make_float4(nk[0], nk[1], nk[2], nk[3]); *(float4*)(pa + 68) = make_float4(nk[4], nk[5], nk[6], nk[7]);
      *(float4*)(pa + 128) = make_float4(bb[0], bb[1], bb[2], bb[3]); *(float4*)(pa + 132) = make_float4(bb[4], bb[5], bb[6], bb[7]);
      *(float4*)(pa + 192) = make_float4(kp[0], kp[1], kp[2], kp[3]); *(float4*)(pa + 196) = make_float4(kp[4], kp[5], kp[6], kp[7]);
      *(float4*)(pa + 256) = make_float4(dr[0], dr[1], dr[2], dr[3]); *(float4*)(pa + 260) = make_float4(dr[4], dr[5], dr[6], dr[7]);
      if (cs == 0) { BON[tt] = bon; CC[tt * 2] = c1; CC[tt * 2 + 1] = c2; }
    }
    __syncthreads();
    if (tc + 1 < 128) load_raw(tc + 1);
    {
      typedef float f2v __attribute__((ext_vector_type(2)));
      typedef float f4v __attribute__((ext_vector_type(4)));
      const float* pa0 = PA + ks * 8;
      const float* vs0 = Vst + row32;
      f4v d0 = *(const f4v*)(pa0), d1 = *(const f4v*)(pa0 + 4);
      f4v n0 = *(const f4v*)(pa0 + 64), n1 = *(const f4v*)(pa0 + 68);
      f4v b0 = *(const f4v*)(pa0 + 128), b1 = *(const f4v*)(pa0 + 132);
      f4v k0 = *(const f4v*)(pa0 + 192), k1 = *(const f4v*)(pa0 + 196);
      f4v r0 = *(const f4v*)(pa0 + 256), r1 = *(const f4v*)(pa0 + 260);
      f2v cc = *(const f2v*)(CC);
      float vv = vs0[0];
      f2v S01 = {S[0], S[1]}, S23 = {S[2], S[3]}, S45 = {S[4], S[5]}, S67 = {S[6], S[7]};
#pragma unroll 2
      for (int t = 0; t < ((HYP4 && dry) ? 0 : 32); ++t) {
        const float* pa = pa0 + (t + 1) * 320;
        const f4v xd0 = *(const f4v*)(pa), xd1 = *(const f4v*)(pa + 4);
        const f4v xn0 = *(const f4v*)(pa + 64), xn1 = *(const f4v*)(pa + 68);
        const f4v xb0 = *(const f4v*)(pa + 128), xb1 = *(const f4v*)(pa + 132);
        const f4v xk0 = *(const f4v*)(pa + 192), xk1 = *(const f4v*)(pa + 196);
        const f4v xr0 = *(const f4v*)(pa + 256), xr1 = *(const f4v*)(pa + 260);
        const f2v xcc = *(const f2v*)(CC + (t + 1) * 2);
        const float xvv = vs0[(t + 1) * 32];
        __builtin_amdgcn_sched_barrier(0);
        f2v sa2 = S01 * n0.xy; f2v y2 = S01 * r0.xy;
        sa2 = __builtin_elementwise_fma(S23, n0.zw, sa2); y2 = __builtin_elementwise_fma(S23, r0.zw, y2);
        sa2 = __builtin_elementwise_fma(S45, n1.xy, sa2); y2 = __builtin_elementwise_fma(S45, r1.xy, y2);
        sa2 = __builtin_elementwise_fma(S67, n1.zw, sa2); y2 = __builtin_elementwise_fma(S67, r1.zw, y2);
        float sa = sa2.x + sa2.y, yp = y2.x + y2.y;
        sa += dppf(sa, 0); yp += dppf(yp, 0);
        sa += dppf(sa, 1); yp += dppf(yp, 1);
        sa += dppf(sa, 2); yp += dppf(yp, 2);
        const f2v sav = {sa, sa}, vv2 = {vv, vv};
        S01 = __builtin_elementwise_fma(sav, b0.xy, __builtin_elementwise_fma(S01, d0.xy, vv2 * k0.xy));
        S23 = __builtin_elementwise_fma(sav, b0.zw, __builtin_elementwise_fma(S23, d0.zw, vv2 * k0.zw));
        S45 = __builtin_elementwise_fma(sav, b1.xy, __builtin_elementwise_fma(S45, d1.xy, vv2 * k1.xy));
        S67 = __builtin_elementwise_fma(sav, b1.zw, __builtin_elementwise_fma(S67, d1.zw, vv2 * k1.zw));
        const float y = fmaf(vv, cc.y, fmaf(sa, cc.x, yp));
        if (ks == 0) Yst[t * 32 + row32] = y;
        __builtin_amdgcn_sched_barrier(0);
        d0 = xd0; d1 = xd1; n0 = xn0; n1 = xn1; b0 = xb0; b1 = xb1; k0 = xk0; k1 = xk1; r0 = xr0; r1 = xr1; vv = xvv; cc = xcc;
      }
      S[0] = S01.x; S[1] = S01.y; S[2] = S23.x; S[3] = S23.y; S[4] = S45.x; S[5] = S45.y; S[6] = S67.x; S[7] = S67.y;
    }
    __syncthreads();
    {
      const int c4 = cs & 3;
      float y8[8], v8[8];
      float4 t0 = *(const float4*)(Yst + tt * 32 + c4 * 8), t1 = *(const float4*)(Yst + tt * 32 + c4 * 8 + 4);
      y8[0] = t0.x; y8[1] = t0.y; y8[2] = t0.z; y8[3] = t0.w; y8[4] = t1.x; y8[5] = t1.y; y8[6] = t1.z; y8[7] = t1.w;
      float sm = 0.f, sq = 0.f;
#pragma unroll
      for (int e = 0; e < 8; ++e) { sm += y8[e]; sq += y8[e] * y8[e]; }
      sm = red4(sm); sq = red4(sq);
      const float bon = BON[tt];
      t0 = *(const float4*)(Vst + tt * 32 + c4 * 8); t1 = *(const float4*)(Vst + tt * 32 + c4 * 8 + 4);
      v8[0] = t0.x * bon; v8[1] = t0.y * bon; v8[2] = t0.z * bon; v8[3] = t0.w * bon; v8[4] = t1.x * bon; v8[5] = t1.y * bon; v8[6] = t1.z * bon; v8[7] = t1.w * bon;
      if (cs < 4 && !dry) {
        const size_t o = (size_t)lr * 1536 + head * 64 + 32 * half + cs * 8;
        *(uint4*)(YR + o) = pack8(y8);
        *(uint4*)(BV + o) = pack8(v8);
        if (cs == 0) {
          float* stp = ST + ((size_t)(lr * 24 + head) * 2 + half) * 2;
          stp[0] = sm; stp[1] = sq;
        }
      }
    }
  }
  if (c == 0 && !dry) {
    float* sp = STATE + ((size_t)((b * 24 + head) * 64 + 32 * half + row32)) * 64 + 8 * ks;
#pragma unroll
    for (int i = 0; i < 8; ++i) sp[i] = S[i];
  }
}

DI void phase_scan(const Params& p, int L, int c, char* smem, int* s_item, bool dry) {
  for (int item = blockIdx.x; item < 192; item += gridDim.x) scan_item(p, L, c, item, smem, dry);
  int* cnt = (int*)(p.ws + OFF_CNT) + 64 + ((L * 2 + c) * 2 + (dry ? 1 : 0)) * 16 + 8;
  for (;;) {
    __syncthreads();
    if (otid() == 0) *s_item = atomicAdd(cnt, 1);
    __syncthreads();
    const int item = *s_item;
    if (item >= 512) break;
    memattn_item(p, L, c, item, smem, dry);
  }
}

DI void phase_finalize(const Params& p, int L, int c, bool dry) {
  const int j = L >> 1;
  u16* U = (u16*)(p.ws + OFF_U);
  const u16* YR = (const u16*)(p.ws + OFF_YR); const u16* BV = (const u16*)(p.ws + OFF_BV);
  const float* ST = (const float*)(p.ws + OFF_ST);
  const int G = gridDim.x;
  for (int idx = blockIdx.x * 256 + otid(); idx < TC * 192; idx += G * 256) {
    const int lr = idx / 192, c8 = idx - lr * 192, ch0 = c8 * 8, head = ch0 >> 6;
    const float4 st = *(const float4*)(ST + (size_t)(lr * 24 + head) * 4);
    const float mean = (st.x + st.z) * (1.f / 64.f);
    const float var = (st.y + st.w) * (1.f / 64.f) - mean * mean;
    const float rstd = rsqrtf(fmaxf(var, 0.f) + 64e-5f);
    float y[8], bv[8], g[8], o[8];
    unpack8(*(const uint4*)(YR + (size_t)lr * 1536 + ch0), y);
    unpack8(*(const uint4*)(BV + (size_t)lr * 1536 + ch0), bv);
    u16* gp = U + (size_t)lr * LDU_R + R_GATE + ch0;
    unpack8(*(const uint4*)gp, g);
    const float* gw = p.gn_w + j * 1536 + ch0; const float* gb = p.gn_b + j * 1536 + ch0;
#pragma unroll
    for (int e = 0; e < 8; ++e) o[e] = ((y[e] - mean) * rstd * gw[e] + gb[e] + bv[e]) * silu(g[e]);
    if (!dry) *(uint4*)gp = pack8(o);
  }
  if (c == 0) {
    u16* BND = (u16*)(p.ws + OFF_BND);
    for (int idx = blockIdx.x * 256 + otid(); idx < 4 * (SHIFTW / 8); idx += G * 256) {
      const int b = idx / (SHIFTW / 8), cc = idx - b * (SHIFTW / 8);
      *(uint4*)(BND + (size_t)b * SHIFTW + cc * 8) = *(const uint4*)(U + (size_t)(b * 4096 + 4095) * LDU_R + cc * 8);
    }
  }
}

enum { PH_PREP = 0, PH_NORM, PH_GEMM_IN, PH_KVPREP, PH_GEMM_UP, PH_ATTN, PH_SCAN, PH_FINALIZE, PH_GEMM_OUT, PH_FINAL };
constexpr int NSTEPS = 46;

DI void decode_step(int step, int& ph, int& L, int& c) {
  if (step == 0) { ph = PH_PREP; L = 0; c = 0; return; }
  if (step == NSTEPS - 1) { ph = PH_FINAL; L = 0; c = 0; return; }
  int s = step - 1;
  int pr = s / 22, rem = s - pr * 22;
  if (rem < 12) {
    L = 2 * pr; c = rem / 6; int k = rem - c * 6;
    ph = (k == 0) ? PH_NORM : (k == 1) ? PH_GEMM_IN : (k == 2) ? PH_KVPREP : (k == 3) ? PH_GEMM_UP : (k == 4) ? PH_ATTN : PH_GEMM_OUT;
  } else {
    rem -= 12; L = 2 * pr + 1; c = rem / 5; int k = rem - c * 5;
    ph = (k == 0) ? PH_NORM : (k == 1) ? PH_GEMM_IN : (k == 2) ? PH_SCAN : (k == 3) ? PH_FINALIZE : PH_GEMM_OUT;
  }
}

DI void run_step(const Params& p, int ph, int L, int c, char* smem, int* s_item, bool dry_in) {
  const bool dry = dry_in && !(HYP5 && (ph == PH_GEMM_IN || ph == PH_GEMM_UP));
  char* ws = p.ws;
  const bool rw = L & 1;
  const int j = L >> 1;
  switch (ph) {
    case PH_PREP: phase_prep(p, smem); break;
    case PH_NORM:
      phase_norm(p, L, c);
      if (L == 0 && c == 0) {
        EpiMemKV epi{(u16*)(ws + OFF_MEMK), (u16*)(ws + OFF_MEMVT), false};
        gemm_phase<2, false>((const u16*)(ws + OFF_MEMH), 1024ull * 1024, 1024, (const u16*)(ws + OFF_WT_MEMKV), 1024ull * 1024, 1024, 4, 4, 8, 4, 1024, smem, epi);
      }
      break;
    case PH_GEMM_IN:
      if (!rw) {
        EpiStoreBf16 epi{(u16*)(ws + OFF_U), LDU_M, LDU_M, dry};
        gemm_phase<2, true>((const u16*)(ws + OFF_H), 0, 1024, (const u16*)(ws + OFF_WT_INMLA) + (size_t)j * 3328 * 1024, 0, 1024, 1, 64, 26, 8, 1024, smem, epi);
      } else {
        EpiStoreBf16 epi{(u16*)(ws + OFF_U), LDU_R, LDU_R, dry};
        gemm_phase<2, true>((const u16*)(ws + OFF_H), 0, 1024, (const u16*)(ws + OFF_WT_INRW) + (size_t)j * 7296 * 1024, 0, 1024, 1, 64, 57, 8, 1024, smem, epi);
      }
      break;
    case PH_KVPREP: phase_kvprep(p, L, c, dry); break;
    case PH_GEMM_UP: {
      EpiUQ e1{(u16*)(ws + OFF_Q), (const float*)(ws + OFF_COS), (const float*)(ws + OFF_SIN), c, dry};
      gemm_phase<2, true>((const u16*)(ws + OFF_U) + M_CQ, 0, LDU_M, (const u16*)(ws + OFF_WT_UQ) + (size_t)j * 2304 * 384, 0, 384, 1, 64, 18, 8, 384, smem, e1);
      EpiUK e2{(u16*)(ws + OFF_K), dry};
      gemm_phase<2, true>((const u16*)(ws + OFF_U) + M_CKV, 0, LDU_M, (const u16*)(ws + OFF_WT_UKV) + (size_t)j * 3072 * 256, 0, 256, 1, 64, 12, 8, 256, smem, e2);
      EpiUV e3{(u16*)(ws + OFF_VT), dry};
      gemm_phase<2, false>((const u16*)(ws + OFF_U) + M_CKV, 0, LDU_M, (const u16*)(ws + OFF_WT_UKV) + (size_t)j * 3072 * 256 + 1536ull * 256, 0, 256, 1, 64, 12, 8, 256, smem, e3);
    } break;
    case PH_ATTN: phase_attn(p, L, c, smem, s_item, dry); break;
    case PH_SCAN: phase_scan(p, L, c, smem, s_item, dry); break;
    case PH_FINALIZE: phase_finalize(p, L, c, dry); break;
    case PH_GEMM_OUT: {
      EpiResid epi{(L == 0) ? p.x : (const float*)p.out, p.out, rw, c, dry};
      gemm_phase<2, true>((const u16*)(ws + OFF_U) + (rw ? R_GATE : M_GATE), 0, rw ? LDU_R : LDU_M, (const u16*)(ws + OFF_WT_OUT) + (size_t)L * 1024 * 2048, 0, 2048,
                 1, 64, 8, 8, 2048, smem, epi);
    } break;
    case PH_FINAL: phase_final_norm(p, dry); break;
  }
}

DI void grid_barrier(unsigned* bar, unsigned& epoch) {
  __syncthreads();
  ++epoch;
  if (threadIdx.x == 0) {
    __builtin_amdgcn_fence(__ATOMIC_RELEASE, "agent");
    asm volatile("s_waitcnt vmcnt(0)" ::: "memory");
    const unsigned target = epoch * gridDim.x;
    __hip_atomic_fetch_add(bar, 1u, __ATOMIC_RELAXED, __HIP_MEMORY_SCOPE_AGENT);
    unsigned spins = 0;
    while (__hip_atomic_load(bar, __ATOMIC_RELAXED, __HIP_MEMORY_SCOPE_AGENT) < target) {
      __builtin_amdgcn_s_sleep(2);
      if (++spins > (1u << 22)) break;
    }
    __builtin_amdgcn_fence(__ATOMIC_ACQUIRE, "agent");
    asm volatile("s_waitcnt vmcnt(0)" ::: "memory");
  }
  __syncthreads();
}

__global__ void __launch_bounds__(256, 1) hybrid_megakernel(Params p, int s_lo, int s_hi, int coop, int probe_mask) {
  __shared__ __attribute__((aligned(16))) char smem[SMEM_BYTES];
  __shared__ int s_item;
  unsigned* bar = (unsigned*)(p.ws + OFF_BAR);
  unsigned epoch = 0;
  if (coop == 2) cg::this_grid().sync();
  for (int st = s_lo; st < s_hi; ++st) {
    int ph, L, c;
    decode_step(st, ph, L, c);
    for (int rep = ((probe_mask >> ph) & 1) ? 0 : 1; rep < 2; ++rep) {
      run_step(p, ph, L, c, smem, &s_item, rep == 0);
      if (coop && (rep == 0 || st + 1 < s_hi)) grid_barrier(bar, epoch);
      if (coop) for (int xs = 0; xs < EXTRA_SYNCS; ++xs) grid_barrier(bar, epoch);
    }
  }
}

extern "C" void kernel_launch(void* const* d_in, const int* in_sizes, int n_in, void* d_out, int out_size, void* d_ws, size_t ws_size,
                              hipStream_t stream) {
  if (ws_size < WS_NEED) { fprintf(stderr, "workspace too small: %zu < %zu\n", ws_size, (size_t)WS_NEED); return; }
  Params p;
  memset(&p, 0, sizeof(p));
  p.x = (const float*)d_in[0]; p.mem = (const float*)d_in[1]; p.pos = (const int*)d_in[2];
  p.norm_g = (const float*)d_in[3]; p.mem_norm_g = (const float*)d_in[4]; p.w_mem_kv = (const float*)d_in[5];
  p.w_in_mla = (const float*)d_in[6]; p.q_norm_g = (const float*)d_in[7]; p.kv_norm_g = (const float*)d_in[8];
  p.w_uq = (const float*)d_in[9]; p.w_ukv = (const float*)d_in[10]; p.w_in_rwkv = (const float*)d_in[11];
  p.mu = (const float*)d_in[12]; p.w0 = (const float*)d_in[13]; p.w2 = (const float*)d_in[14]; p.a0 = (const float*)d_in[15];
  p.a2 = (const float*)d_in[16]; p.k_k = (const float*)d_in[17]; p.k_a = (const float*)d_in[18]; p.r_k = (const float*)d_in[19];
  p.gn_w = (const float*)d_in[20]; p.gn_b = (const float*)d_in[21]; p.w_out = (const float*)d_in[22]; p.final_g = (const float*)d_in[23];
  p.out = (float*)d_out; p.ws = (char*)d_ws;
  static int grid_blocks = 0;
  if (!grid_blocks) {
    int dev = 0, cus = 0, per_cu = 0;
    hipGetDevice(&dev);
    hipDeviceGetAttribute(&cus, hipDeviceAttributeMultiprocessorCount, dev);
    hipOccupancyMaxActiveBlocksPerMultiprocessor(&per_cu, hybrid_megakernel, 256, 0);
    if (per_cu > 2) per_cu = 2;
    if (per_cu < 1) per_cu = 1;
    grid_blocks = cus * per_cu;
  }
#if MULTI_LAUNCH
  for (int s = 0; s < NSTEPS; ++s) hipLaunchKernelGGL(hybrid_megakernel, dim3(grid_blocks), dim3(256), 0, stream, p, s, s + 1, 0, 0);
#else
  int s_lo = 0, s_hi = NSTEPS, coop = 1, probe_mask = PROBE_MASK;
  void* args[] = {&p, &s_lo, &s_hi, &coop, &probe_mask};
  hipMemsetAsync((char*)d_ws + OFF_BAR, 0, 256, stream);
  hipError_t e = hipLaunchCooperativeKernel((void*)hybrid_megakernel, dim3(grid_blocks), dim3(256), args, 0, stream);
  if (e != hipSuccess) fprintf(stderr, "cooperative launch failed: %s (grid %d)\n", hipGetErrorString(e), grid_blocks);
#endif
}
```

```cpp
#include <hip/hip_runtime.h>
#include <hip/hip_cooperative_groups.h>
#include <cstdio>
#include <cstring>
namespace cg = cooperative_groups;

#define PROBE_MASK 0
#define EXTRA_SYNCS 0
#define HYP1 0
#define HYP2 0
#define HYP3 0
#define HYP4 0
#define HYP5 0
#ifndef MULTI_LAUNCH
#define MULTI_LAUNCH 0
#endif

#define DI __device__ __forceinline__
typedef unsigned short u16;
typedef __attribute__((ext_vector_type(8))) short bf16x8;
typedef __attribute__((ext_vector_type(16))) float f32x16;
typedef __attribute__((ext_vector_type(2))) __bf16 bf2_t;
typedef __attribute__((ext_vector_type(2))) float f2_t;
typedef __attribute__((ext_vector_type(4))) unsigned u32x4;
typedef __attribute__((ext_vector_type(2))) unsigned u32x2;
#define MFMA32(a, b, c) __builtin_amdgcn_mfma_f32_32x32x16_bf16((a), (b), (c), 0, 0, 0)

constexpr int SEQ = 8192, TC = 16384;
constexpr int LDU_M = 3264, LDU_R = 7296;
constexpr int M_CQ = 0, M_CKV = 384, M_KR = 640, M_QM = 704, M_GATE = 1216;
constexpr int R_R = 0, R_K = 1536, R_V = 3072, R_WD = 4608, R_AD = 4672, R_QM = 4736, R_GATE = 5248;
constexpr int SHIFTW = 4736;

constexpr size_t OFF_WT_MEMKV = 0;
constexpr size_t OFF_WT_INMLA = OFF_WT_MEMKV + 4ull * 1024 * 1024 * 2;
constexpr size_t OFF_WT_UQ    = OFF_WT_INMLA + 2ull * 3328 * 1024 * 2;
constexpr size_t OFF_WT_UKV   = OFF_WT_UQ + 2ull * 2304 * 384 * 2;
constexpr size_t OFF_WT_INRW  = OFF_WT_UKV + 2ull * 3072 * 256 * 2;
constexpr size_t OFF_WT_OUT   = OFF_WT_INRW + 2ull * 7296 * 1024 * 2;
constexpr size_t OFF_MEMH     = OFF_WT_OUT + 4ull * 1024 * 2048 * 2;
constexpr size_t OFF_MEMK     = OFF_MEMH + 4ull * 1024 * 1024 * 2;
constexpr size_t OFF_MEMVT    = OFF_MEMK + 4ull * 4 * 4 * 256 * 128 * 2;
constexpr size_t OFF_COS      = OFF_MEMVT + 4ull * 4 * 4 * 256 * 128 * 2;
constexpr size_t OFF_SIN      = OFF_COS + 32768ull * 32 * 4;
constexpr size_t OFF_CNT      = OFF_SIN + 32768ull * 32 * 4;
constexpr size_t OFF_BAR      = OFF_CNT + 4096;
constexpr size_t OFF_STATE    = OFF_BAR + 256;
constexpr size_t OFF_BND      = OFF_STATE + 96ull * 4096 * 4;
constexpr size_t OFF_H        = OFF_BND + 4ull * 4736 * 2 + 128;
constexpr size_t OFF_R        = OFF_H + 16384ull * 1024 * 2;
constexpr size_t OFF_U        = OFF_R;
constexpr size_t OFF_Q        = OFF_R + 16384ull * 3264 * 2;
constexpr size_t OFF_K        = OFF_Q + 2ull * 12 * 8192 * 192 * 2;
constexpr size_t OFF_VT       = OFF_K + 2ull * 12 * 8192 * 192 * 2;
constexpr size_t OFF_YR       = OFF_R + 16384ull * 7296 * 2;
constexpr size_t OFF_BV       = OFF_YR + 16384ull * 1536 * 2;
constexpr size_t OFF_ST       = OFF_BV + 16384ull * 1536 * 2;
constexpr size_t OFF_BS       = OFF_ST + 16384ull * 24 * 4 * 4;
constexpr size_t WS_NEED      = OFF_BS + 16384ull * 24 * 4;

constexpr int SMEM_BYTES = 110592;

struct Params {
  const float *x, *mem; const int* pos;
  const float *norm_g, *mem_norm_g, *w_mem_kv, *w_in_mla, *q_norm_g, *kv_norm_g, *w_uq, *w_ukv, *w_in_rwkv;
  const float *mu, *w0, *w2, *a0, *a2, *k_k, *k_a, *r_k, *gn_w, *gn_b, *w_out, *final_g;
  float* out; char* ws;
};

DI int otid() { int t = threadIdx.x; asm volatile("" : "+v"(t)); return t; }
DI float bf2f(unsigned v) { return __uint_as_float(v << 16); }
DI unsigned pack2(float a, float b) { f2_t v = {a, b}; bf2_t r = __builtin_convertvector(v, bf2_t); return __builtin_bit_cast(unsigned, r); }
DI u16 f2bf(float a) { return (u16)(pack2(a, 0.f) & 0xffffu); }
DI float ex2(float x) { return __builtin_amdgcn_exp2f(x); }
DI float fexp(float x) { return __builtin_amdgcn_exp2f(x * 1.4426950408889634f); }
DI float frcp(float x) { return __builtin_amdgcn_rcpf(x); }
DI float silu(float g) { return g * frcp(1.f + fexp(-g)); }
DI float wave_sum(float v) { for (int o = 32; o > 0; o >>= 1) v += __shfl_xor(v, o); return v; }
DI int crow(int reg, int h) { return (reg & 3) + 8 * (reg >> 2) + 4 * h; }
DI float dppf(float x, const int ctrl_sel) {
  int xi;
  if (ctrl_sel == 0) xi = __builtin_amdgcn_update_dpp(0, __float_as_int(x), 0xB1, 0xf, 0xf, true);
  else if (ctrl_sel == 1) xi = __builtin_amdgcn_update_dpp(0, __float_as_int(x), 0x4E, 0xf, 0xf, true);
  else xi = __builtin_amdgcn_update_dpp(0, __float_as_int(x), 0x141, 0xf, 0xf, true);
  return __int_as_float(xi);
}
DI float red4(float x) { x += dppf(x, 0); x += dppf(x, 1); return x; }
DI float red8(float x) { x += dppf(x, 0); x += dppf(x, 1); x += dppf(x, 2); return x; }
DI int gtok(bool rw, int c, int lr) { return rw ? ((lr >> 12) * 8192 + c * 4096 + (lr & 4095)) : (c * 16384 + lr); }
DI void unpack8(const uint4& v, float* f) {
  f[0] = bf2f(v.x & 0xffffu); f[1] = bf2f(v.x >> 16); f[2] = bf2f(v.y & 0xffffu); f[3] = bf2f(v.y >> 16);
  f[4] = bf2f(v.z & 0xffffu); f[5] = bf2f(v.z >> 16); f[6] = bf2f(v.w & 0xffffu); f[7] = bf2f(v.w >> 16);
}
DI uint4 pack8(const float* f) { uint4 v; v.x = pack2(f[0], f[1]); v.y = pack2(f[2], f[3]); v.z = pack2(f[4], f[5]); v.w = pack2(f[6], f[7]); return v; }

DI void transpose_tile(const float* __restrict__ src, u16* __restrict__ dst, int K, int N, int tk, int tn, int drow, float* tile) {
  const int tid = otid();
  __syncthreads();
#pragma unroll
  for (int i = 0; i < 4; ++i) {
    int kr = (tid >> 4) + 16 * i, nc = (tid & 15) * 4;
    float4 v = *(const float4*)(src + (size_t)(tk * 64 + kr) * N + tn * 64 + nc);
    tile[kr * 65 + nc] = v.x; tile[kr * 65 + nc + 1] = v.y; tile[kr * 65 + nc + 2] = v.z; tile[kr * 65 + nc + 3] = v.w;
  }
  __syncthreads();
#pragma unroll
  for (int i = 0; i < 2; ++i) {
    int n = (tid >> 3) + 32 * i, kc = (tid & 7) * 8;
    float f[8];
#pragma unroll
    for (int e = 0; e < 8; ++e) f[e] = tile[(kc + e) * 65 + n];
    *(uint4*)(dst + (size_t)(drow + n) * K + tk * 64 + kc) = pack8(f);
  }
}

DI void rms_row_bf16(const float* __restrict__ src, const float* __restrict__ g, u16* __restrict__ dst, int lane) {
  float4 v[4]; float ss = 0.f;
#pragma unroll
  for (int i = 0; i < 4; ++i) { v[i] = *(const float4*)(src + i * 256 + lane * 4); ss += v[i].x * v[i].x + v[i].y * v[i].y + v[i].z * v[i].z + v[i].w * v[i].w; }
  ss = wave_sum(ss);
  float rs = rsqrtf(ss * (1.f / 1024.f) + 1e-6f);
#pragma unroll
  for (int i = 0; i < 4; ++i) {
    float4 gg = *(const float4*)(g + i * 256 + lane * 4);
    uint2 o; o.x = pack2(v[i].x * rs * gg.x, v[i].y * rs * gg.y); o.y = pack2(v[i].z * rs * gg.z, v[i].w * rs * gg.w);
    *(uint2*)(dst + i * 256 + lane * 4) = o;
  }
}

DI void phase_prep(const Params& p, char* smem) {
  const int tid = otid(), G = gridDim.x, bid = blockIdx.x;
  char* ws = p.ws;
  if (bid == 0) for (int i = tid; i < 1024; i += 256) ((int*)(ws + OFF_CNT))[i] = 0;
  float* tile = (float*)smem;
  for (int g0 = bid; g0 < 9168; g0 += G) {
    int g = g0;
    const float* src = nullptr; u16* dst = nullptr; int K = 0, N = 0; size_t dstr = 0; bool ukv = false;
    if (g < 1024) { src = p.w_mem_kv; dst = (u16*)(ws + OFF_WT_MEMKV); K = 1024; N = 1024; dstr = 1024ull * 1024; }
    else if ((g -= 1024) < 1632) { src = p.w_in_mla; dst = (u16*)(ws + OFF_WT_INMLA); K = 1024; N = 3264; dstr = 3328ull * 1024; }
    else if ((g -= 1632) < 432) { src = p.w_uq; dst = (u16*)(ws + OFF_WT_UQ); K = 384; N = 2304; dstr = 2304ull * 384; }
    else if ((g -= 432) < 384) { src = p.w_ukv; dst = (u16*)(ws + OFF_WT_UKV); K = 256; N = 3072; dstr = 3072ull * 256; ukv = true; }
    else if ((g -= 384) < 3648) { src = p.w_in_rwkv; dst = (u16*)(ws + OFF_WT_INRW); K = 1024; N = 7296; dstr = 7296ull * 1024; }
    else { g -= 3648; src = p.w_out; dst = (u16*)(ws + OFF_WT_OUT); K = 2048; N = 1024; dstr = 1024ull * 2048; }
    int ntn = N >> 6, per = (K >> 6) * ntn;
    int m = g / per, t = g - m * per;
    int tk = t / ntn, tn = t - tk * ntn;
    int drow = tn * 64;
    if (ukv) { const int hd = drow >> 8, dd = drow & 255; drow = (dd < 128) ? (hd * 128 + dd) : (1536 + hd * 128 + dd - 128); }
    transpose_tile(src + (size_t)m * K * N, dst + (size_t)m * dstr, K, N, tk, tn, drow, tile);
  }
  for (int i = bid * 256 + tid; i < 2 * 64 * 1024 / 8; i += G * 256) {
    int m = i / (64 * 1024 / 8), r = i - m * (64 * 1024 / 8);
    uint4 z; z.x = z.y = z.z = z.w = 0u;
    *(uint4*)((u16*)(ws + OFF_WT_INMLA) + (size_t)m * 3328 * 1024 + 3264ull * 1024 + (size_t)r * 8) = z;
  }
  float* cs = (float*)(ws + OFF_COS); float* sn = (float*)(ws + OFF_SIN);
  for (int i = bid * 256 + tid; i < 32768 * 32; i += G * 256) {
    int tk = i >> 5, pi = i & 31;
    float inv_freq = (float)exp2(-(double)(2 * pi) / 64.0 * 13.287712379549449);
    float ang = (float)p.pos[tk] * inv_freq;
    double rev = (double)ang * 0.15915494309189535;
    float fr = (float)(rev - rint(rev));
    cs[i] = __builtin_amdgcn_cosf(fr); sn[i] = __builtin_amdgcn_sinf(fr);
  }
  const int w = tid >> 6, lane = tid & 63;
  for (int row = bid * 4 + w; row < 4096; row += G * 4) {
    int L = row >> 10, m = row & 1023;
    rms_row_bf16(p.mem + (size_t)m * 1024, p.mem_norm_g + L * 1024, (u16*)(ws + OFF_MEMH) + (size_t)row * 1024, lane);
  }
}

DI void phase_norm(const Params& p, int L, int c) {
  const int tid = otid(), w = tid >> 6, lane = tid & 63;
  const bool rw = L & 1;
  const float* xs = (L == 0) ? p.x : p.out;
  u16* H = (u16*)(p.ws + OFF_H);
  for (int lr = blockIdx.x * 4 + w; lr < TC; lr += gridDim.x * 4) {
    int gt = gtok(rw, c, lr);
    rms_row_bf16(xs + (size_t)gt * 1024, p.norm_g + L * 1024, H + (size_t)lr * 1024, lane);
  }
}

DI void phase_final_norm(const Params& p, bool dry) {
  const int tid = otid(), w = tid >> 6, lane = tid & 63;
  for (int row = blockIdx.x * 4 + w; row < 32768; row += gridDim.x * 4) {
    float* xr = p.out + (size_t)row * 1024;
    float4 v[4]; float ss = 0.f;
#pragma unroll
    for (int i = 0; i < 4; ++i) { v[i] = *(const float4*)(xr + i * 256 + lane * 4); ss += v[i].x * v[i].x + v[i].y * v[i].y + v[i].z * v[i].z + v[i].w * v[i].w; }
    ss = wave_sum(ss);
    float rs = rsqrtf(ss * (1.f / 1024.f) + 1e-6f);
#pragma unroll
    for (int i = 0; i < 4; ++i) {
      float4 gg = *(const float4*)(p.final_g + i * 256 + lane * 4);
      float4 o; o.x = v[i].x * rs * gg.x; o.y = v[i].y * rs * gg.y; o.z = v[i].z * rs * gg.z; o.w = v[i].w * rs * gg.w;
      if (!dry) *(float4*)(xr + i * 256 + lane * 4) = o;
    }
  }
}

template <int TJ, bool SWAP, class Epi>
DI void gemm_phase(const u16* __restrict__ A, size_t strideAz, int lda, const u16* __restrict__ Bt, size_t strideBz, int ldb,
                   int Z, int Mt, int Nt, int GM, int K, char* smem, const Epi& epi, int vt) {
  constexpr int BN = 64 * TJ;
  constexpr int NB = BN / 32;
  const int tid = otid(), w = tid >> 6, lane = tid & 63, r = lane & 31, h = lane >> 5;
  const int wm = w >> 1, wn = w & 1;
  u16* As = (u16*)smem;
  u16* Bs = As + 2 * 256 * 72;
  const int G = gridDim.x, per = Mt * Nt, total = Z * per;
  const int lrow = tid >> 3, lcc = (tid & 7) * 8;
  const int nk = K >> 6;
  unsigned aoff[8], boff[NB];
#pragma unroll
  for (int i = 0; i < 8; ++i) aoff[i] = (unsigned)((lrow + 32 * i) * lda + lcc);
#pragma unroll
  for (int i = 0; i < NB; ++i) boff[i] = (unsigned)((lrow + 32 * i) * ldb + lcc);
  const int lds_st = lrow * 72 + lcc;
  for (int base = 0; base < total; base += G) {
    const int q = base + vt;
    if (q >= total) continue;
    const int z = q / per, qq = q - z * per;
    const int grp = qq / (GM * Nt), within = qq - grp * GM * Nt;
    const int mt = grp * GM + (within % GM), nt = within / GM;
    const u16* Ag = A + z * strideAz + (size_t)(mt * 256) * lda;
    const u16* Bg = Bt + z * strideBz + (size_t)(nt * BN) * ldb;
    u32x4 ra[8], rb[NB];
    f32x16 acc[4][TJ];
#pragma unroll
    for (int i = 0; i < 4; ++i)
#pragma unroll
      for (int j = 0; j < TJ; ++j)
#pragma unroll
        for (int e = 0; e < 16; ++e) acc[i][j][e] = 0.f;
    __syncthreads();
#pragma unroll
    for (int i = 0; i < 8; ++i) ra[i] = *(const u32x4*)(Ag + aoff[i]);
#pragma unroll
    for (int i = 0; i < NB; ++i) rb[i] = *(const u32x4*)(Bg + boff[i]);
#pragma unroll
    for (int i = 0; i < 8; ++i) *(u32x4*)(As + lds_st + (32 * i) * 72) = ra[i];
#pragma unroll
    for (int i = 0; i < NB; ++i) *(u32x4*)(Bs + lds_st + (32 * i) * 72) = rb[i];
#pragma unroll
    for (int i = 0; i < 8; ++i) ra[i] = *(const u32x4*)(Ag + 64 + aoff[i]);
#pragma unroll
    for (int i = 0; i < NB; ++i) rb[i] = *(const u32x4*)(Bg + 64 + boff[i]);
    __syncthreads();
    for (int kt2 = 0; kt2 < nk; kt2 += 2) {
#pragma unroll
      for (int u = 0; u < 2; ++u) {
        const int kt = kt2 + u;
        const u16* as = As + u * 256 * 72 + (128 * wm + r) * 72 + 8 * h;
        const u16* bs = Bs + u * BN * 72 + (32 * TJ * wn + r) * 72 + 8 * h;
        bf16x8 af[2][4], bfr[2][TJ];
#pragma unroll
        for (int i = 0; i < 4; ++i) af[0][i] = *(const bf16x8*)(as + (32 * i) * 72);
#pragma unroll
        for (int j = 0; j < TJ; ++j) bfr[0][j] = *(const bf16x8*)(bs + (32 * j) * 72);
#pragma unroll
        for (int ks = 0; ks < 4; ++ks) {
          if (ks < 3) {
#pragma unroll
            for (int i = 0; i < 4; ++i) af[(ks + 1) & 1][i] = *(const bf16x8*)(as + (32 * i) * 72 + 16 * (ks + 1));
#pragma unroll
            for (int j = 0; j < TJ; ++j) bfr[(ks + 1) & 1][j] = *(const bf16x8*)(bs + (32 * j) * 72 + 16 * (ks + 1));
          }
          __builtin_amdgcn_sched_barrier(0);
#pragma unroll
          for (int i = 0; i < 4; ++i)
#pragma unroll
            for (int j = 0; j < TJ; ++j)
              acc[i][j] = SWAP ? MFMA32(bfr[ks & 1][j], af[ks & 1][i], acc[i][j]) : MFMA32(af[ks & 1][i], bfr[ks & 1][j], acc[i][j]);
          if (ks == 0 && kt + 1 < nk) {
            u16* ad = As + (u ^ 1) * 256 * 72 + lds_st; u16* bd = Bs + (u ^ 1) * BN * 72 + lds_st;
#pragma unroll
            for (int i = 0; i < 8; ++i) *(u32x4*)(ad + (32 * i) * 72) = ra[i];
#pragma unroll
            for (int i = 0; i < NB; ++i) *(u32x4*)(bd + (32 * i) * 72) = rb[i];
#pragma unroll
            for (int i = 0; i < 6; ++i) { __builtin_amdgcn_sched_group_barrier(0x008, 1, 0); __builtin_amdgcn_sched_group_barrier(0x200, 2, 0); }
          }
          if (ks == 1 && kt + 2 < nk) {
            const u16* ag = Ag + (kt + 2) * 64; const u16* bg = Bg + (kt + 2) * 64;
#pragma unroll
            for (int i = 0; i < 8; ++i) ra[i] = *(const u32x4*)(ag + aoff[i]);
#pragma unroll
            for (int i = 0; i < NB; ++i) rb[i] = *(const u32x4*)(bg + boff[i]);
#pragma unroll
            for (int i = 0; i < 6; ++i) { __builtin_amdgcn_sched_group_barrier(0x008, 1, 0); __builtin_amdgcn_sched_group_barrier(0x020, 2, 0); }
          }
          __builtin_amdgcn_sched_barrier(0);
        }
        __syncthreads();
      }
    }
#pragma unroll
    for (int i = 0; i < 4; ++i)
#pragma unroll
      for (int j = 0; j < TJ; ++j) {
        if (SWAP) epi(z, mt * 256 + 128 * wm + 32 * i + r, nt * BN + 32 * TJ * wn + 32 * j, h, acc[i][j]);
        else epi(z, mt * 256 + 128 * wm + 32 * i, nt * BN + 32 * TJ * wn + 32 * j + r, h, acc[i][j]);
      }
  }
}

struct EpiStoreBf16 {
  u16* C; int ldc; int ncols; bool dry;
  DI void operator()(int z, int row, int colbase, int h, const f32x16& a) const {
    if (dry) return;
#pragma unroll
    for (int g = 0; g < 4; ++g) {
      const int col = colbase + 8 * g + 4 * h;
      if (col < ncols) {
        u32x2 pk = {pack2(a[4 * g], a[4 * g + 1]), pack2(a[4 * g + 2], a[4 * g + 3])};
        *(u32x2*)(C + (size_t)row * ldc + col) = pk;
      }
    }
  }
};
struct EpiResid {
  const float* xin; float* xout; bool rw; int c; bool dry;
  DI void operator()(int z, int row, int colbase, int h, const f32x16& a) const {
    if (dry) return;
    const size_t o = (size_t)gtok(rw, c, row) * 1024 + colbase + 4 * h;
#pragma unroll
    for (int g = 0; g < 4; ++g) {
      float4 v = *(const float4*)(xin + o + 8 * g);
      v.x += a[4 * g]; v.y += a[4 * g + 1]; v.z += a[4 * g + 2]; v.w += a[4 * g + 3];
      *(float4*)(xout + o + 8 * g) = v;
    }
  }
};
struct EpiUQ {
  u16* Q; const float* cs; const float* sn; int c; bool dry;
  DI void operator()(int z, int row, int colbase, int h, const f32x16& a) const {
    if (dry) return;
    const int head = colbase / 192, db = colbase - head * 192;
    const int lb = row >> 13, s = row & 8191;
    u16* qp = Q + ((size_t)(lb * 12 + head) * 8192 + s) * 192 + db + 4 * h;
    const size_t ti = (size_t)(c * 16384 + row) * 32;
#pragma unroll
    for (int g = 0; g < 4; ++g) {
      float v0 = a[4 * g], v1 = a[4 * g + 1], v2 = a[4 * g + 2], v3 = a[4 * g + 3];
      if (db >= 128) {
        const int pi = (db - 128 + 8 * g + 4 * h) >> 1;
        const float2 cc = *(const float2*)(cs + ti + pi), ss = *(const float2*)(sn + ti + pi);
        const float o0 = v0 * cc.x - v1 * ss.x, o1 = v0 * ss.x + v1 * cc.x;
        const float o2 = v2 * cc.y - v3 * ss.y, o3 = v2 * ss.y + v3 * cc.y;
        v0 = o0; v1 = o1; v2 = o2; v3 = o3;
      }
      u32x2 pk = {pack2(v0, v1), pack2(v2, v3)};
      *(u32x2*)(qp + 8 * g) = pk;
    }
  }
};
struct EpiUK {
  u16* Kb; bool dry;
  DI void operator()(int z, int row, int colbase, int h, const f32x16& a) const {
    if (dry) return;
    const int head = colbase >> 7, db = colbase & 127;
    const int lb = row >> 13, s = row & 8191;
    u16* kp = Kb + ((size_t)(lb * 12 + head) * 8192 + s) * 192 + db + 4 * h;
#pragma unroll
    for (int g = 0; g < 4; ++g) {
      u32x2 pk = {pack2(a[4 * g], a[4 * g + 1]), pack2(a[4 * g + 2], a[4 * g + 3])};
      *(u32x2*)(kp + 8 * g) = pk;
    }
  }
};
struct EpiUV {
  u16* Vt; bool dry;
  DI void operator()(int z, int rowbase, int col, int h, const f32x16& a) const {
    if (dry) return;
    const int head = col >> 7, d = col & 127;
#pragma unroll
    for (int g = 0; g < 4; ++g) {
      int lr = rowbase + 8 * g + 4 * h; int lb = lr >> 13, s = lr & 8191;
      u32x2 pk = {pack2(a[4 * g], a[4 * g + 1]), pack2(a[4 * g + 2], a[4 * g + 3])};
      *(u32x2*)(Vt + (((size_t)(lb * 12 + head) * 128 + (s >> 6)) * 128 + d) * 64 + (s & 63)) = pk;
    }
  }
};
struct EpiMemKV {
  u16* MK; u16* MVt; bool dry;
  DI void operator()(int z, int rowbase, int col, int h, const f32x16& a) const {
    if (col < 512) {
      const int xh = col >> 7, d = col & 127;
#pragma unroll
      for (int e = 0; e < 16; ++e) {
        int m = rowbase + crow(e, h); int b = m >> 8, mi = m & 255;
        MK[((size_t)((z * 4 + b) * 4 + xh) * 256 + mi) * 128 + d] = f2bf(a[e]);
      }
    } else {
      const int n = col - 512, xh = n >> 7, d = n & 127;
#pragma unroll
      for (int g = 0; g < 4; ++g) {
        int m = rowbase + 8 * g + 4 * h; int b = m >> 8, mi = m & 255;
        uint2 pk; pk.x = pack2(a[4 * g], a[4 * g + 1]); pk.y = pack2(a[4 * g + 2], a[4 * g + 3]);
        *(uint2*)(MVt + (((size_t)((z * 4 + b) * 4 + xh) * 4 + (mi >> 6)) * 128 + d) * 64 + (mi & 63)) = pk;
      }
    }
  }
};

DI void phase_kvprep(const Params& p, int L, int c, bool dry) {
  const int tid = otid(), w = tid >> 6, lane = tid & 63;
  const int j = L >> 1;
  u16* U = (u16*)(p.ws + OFF_U); u16* Kb = (u16*)(p.ws + OFF_K);
  const float* cs = (const float*)(p.ws + OFF_COS); const float* sn = (const float*)(p.ws + OFF_SIN);
  for (int lr = blockIdx.x * 4 + w; lr < TC; lr += gridDim.x * 4) {
    u16* row = U + (size_t)lr * LDU_M;
    float fq[8], fk[8]; float sq = 0.f, sk = 0.f;
    if (lane < 48) { uint4 v = *(const uint4*)(row + M_CQ + lane * 8); unpack8(v, fq);
#pragma unroll
      for (int e = 0; e < 8; ++e) sq += fq[e] * fq[e]; }
    if (lane < 32) { uint4 v = *(const uint4*)(row + M_CKV + lane * 8); unpack8(v, fk);
#pragma unroll
      for (int e = 0; e < 8; ++e) sk += fk[e] * fk[e]; }
    sq = wave_sum(sq); sk = wave_sum(sk);
    float rq = rsqrtf(sq * (1.f / 384.f) + 1e-6f), rk = rsqrtf(sk * (1.f / 256.f) + 1e-6f);
    if (dry) continue;
    if (lane < 48) {
      const float* g = p.q_norm_g + j * 384 + lane * 8;
#pragma unroll
      for (int e = 0; e < 8; ++e) fq[e] = fq[e] * rq * g[e];
      *(uint4*)(row + M_CQ + lane * 8) = pack8(fq);
    }
    if (lane < 32) {
      const float* g = p.kv_norm_g + j * 256 + lane * 8;
#pragma unroll
      for (int e = 0; e < 8; ++e) fk[e] = fk[e] * rk * g[e];
      *(uint4*)(row + M_CKV + lane * 8) = pack8(fk);
    }
    if (lane < 8) {
      float f[8], o[8]; uint4 v = *(const uint4*)(row + M_KR + lane * 8); unpack8(v, f);
      int gt = c * 16384 + lr;
#pragma unroll
      for (int i = 0; i < 4; ++i) {
        float cc = cs[gt * 32 + lane * 4 + i], ss = sn[gt * 32 + lane * 4 + i];
        o[2 * i] = f[2 * i] * cc - f[2 * i + 1] * ss; o[2 * i + 1] = f[2 * i] * ss + f[2 * i + 1] * cc;
      }
      uint4 pk = pack8(o);
      int lb = lr >> 13, s = lr & 8191;
#pragma unroll
      for (int hd = 0; hd < 12; ++hd) *(uint4*)(Kb + ((size_t)(lb * 12 + hd) * 8192 + s) * 192 + 128 + lane * 8) = pk;
    }
  }
}

template <int DQK>
DI void attn_item(const u16* __restrict__ Qp, int ldq, const u16* __restrict__ Kp, const u16* __restrict__ Vtp, int ldv,
                  int nkt, int q0, bool causal, float c, u16* Yp, int ldy, char* smem, bool dry) {
  constexpr int KLD = DQK + 8;
  constexpr int NKC = DQK * 64 / 8 / 256;
  constexpr int NKS = DQK / 16;
  constexpr int CPR = DQK / 8;
  constexpr int BUFE = 64 * KLD + 128 * 72;
  u16* L0 = (u16*)smem;
  const int tid = otid(), w = tid >> 6, lane = tid & 63, r = lane & 31, h = lane >> 5;
  bf16x8 qf[NKS];
  {
    const u16* qrow = Qp + (size_t)(32 * w + r) * ldq + 8 * h;
#pragma unroll
    for (int ks = 0; ks < NKS; ++ks) qf[ks] = *(const bf16x8*)(qrow + 16 * ks);
  }
  f32x16 o[4];
#pragma unroll
  for (int dt = 0; dt < 4; ++dt)
#pragma unroll
    for (int e = 0; e < 16; ++e) o[dt][e] = 0.f;
  float m = -INFINITY, l = 0.f;
  u32x4 kst[NKC], vst[4];
  const int vd = tid >> 3, vc8 = tid & 7;
  int kso[NKC];
#pragma unroll
  for (int i = 0; i < NKC; ++i) { int id = tid + 256 * i; int row = id / CPR, cc = id - row * CPR; kso[i] = row * KLD + cc * 8; }
  const int vso = 64 * KLD + vd * 72 + 16 * (vc8 >> 1) + 4 * (vc8 & 1);
  __syncthreads();
#pragma unroll
  for (int i = 0; i < NKC; ++i) kst[i] = *(const u32x4*)(Kp + (size_t)(tid + 256 * i) * 8);
#pragma unroll
  for (int i = 0; i < 4; ++i) vst[i] = *(const u32x4*)(Vtp + (size_t)(tid + 256 * i) * 8);
#pragma unroll
  for (int i = 0; i < NKC; ++i) *(u32x4*)(L0 + kso[i]) = kst[i];
#pragma unroll
  for (int i = 0; i < 4; ++i) {
    u16* dst = L0 + vso + (32 * i) * 72;
    u32x2 lo = {vst[i].x, vst[i].y}, hi = {vst[i].z, vst[i].w};
    *(u32x2*)dst = lo; *(u32x2*)(dst + 8) = hi;
  }
  if (nkt > 1) {
    const u16* kg = Kp + (size_t)64 * DQK;
#pragma unroll
    for (int i = 0; i < NKC; ++i) kst[i] = *(const u32x4*)(kg + (size_t)(tid + 256 * i) * 8);
#pragma unroll
    for (int i = 0; i < 4; ++i) vst[i] = *(const u32x4*)(Vtp + 8192 + (size_t)(tid + 256 * i) * 8);
  }
  __syncthreads();
  const int qmin = q0 + 32 * w;
  for (int kt = 0; kt < nkt; ++kt) {
    const u16* Ks = L0 + (kt & 1) * BUFE;
    const u16* Vs = Ks + 64 * KLD;
    u16* Ln = L0 + ((kt + 1) & 1) * BUFE;
    const bool active = !(causal && kt * 64 > qmin + 31);
    f32x16 s0, s1;
#pragma unroll
    for (int e = 0; e < 16; ++e) { s0[e] = 0.f; s1[e] = 0.f; }
    const u16* k0 = Ks + r * KLD + 8 * h;
    bf16x8 ka[2][2];
    if (active) {
      ka[0][0] = *(const bf16x8*)(k0); ka[0][1] = *(const bf16x8*)(k0 + 32 * KLD);
      ka[1][0] = *(const bf16x8*)(k0 + 16); ka[1][1] = *(const bf16x8*)(k0 + 32 * KLD + 16);
      __builtin_amdgcn_sched_barrier(0);
      s0 = MFMA32(ka[0][0], qf[0], s0); s1 = MFMA32(ka[0][1], qf[0], s1);
    }
    if (kt + 1 < nkt) {
#pragma unroll
      for (int i = 0; i < NKC; ++i) *(u32x4*)(Ln + kso[i]) = kst[i];
#pragma unroll
      for (int i = 0; i < 4; ++i) {
        u16* dst = Ln + vso + (32 * i) * 72;
        u32x2 lo = {vst[i].x, vst[i].y}, hi = {vst[i].z, vst[i].w};
        *(u32x2*)dst = lo; *(u32x2*)(dst + 8) = hi;
      }
    }
    if (kt + 2 < nkt) {
      const u16* kg = Kp + (size_t)(kt + 2) * 64 * DQK;
#pragma unroll
      for (int i = 0; i < NKC; ++i) kst[i] = *(const u32x4*)(kg + (size_t)(tid + 256 * i) * 8);
#pragma unroll
      for (int i = 0; i < 4; ++i) vst[i] = *(const u32x4*)(Vtp + (size_t)(kt + 2) * 8192 + (size_t)(tid + 256 * i) * 8);
    }
    if (active) {
      __builtin_amdgcn_sched_barrier(0);
#pragma unroll
      for (int ks = 1; ks < NKS; ++ks) {
        if (ks + 1 < NKS) {
          ka[(ks + 1) & 1][0] = *(const bf16x8*)(k0 + 16 * (ks + 1));
          ka[(ks + 1) & 1][1] = *(const bf16x8*)(k0 + 32 * KLD + 16 * (ks + 1));
        }
        __builtin_amdgcn_sched_barrier(0);
        s0 = MFMA32(ka[ks & 1][0], qf[ks], s0); s1 = MFMA32(ka[ks & 1][1], qf[ks], s1);
        __builtin_amdgcn_sched_barrier(0);
      }
      const u16* v0 = Vs + r * 72 + 8 * h;
      bf16x8 va[2][4];
#pragma unroll
      for (int dt = 0; dt < 4; ++dt) va[0][dt] = *(const bf16x8*)(v0 + (32 * dt) * 72);
      if (causal && kt * 64 + 63 > qmin) {
        const int qi = qmin + r;
#pragma unroll
        for (int e = 0; e < 16; ++e) {
          int key = kt * 64 + crow(e, h);
          if (key > qi) s0[e] = -INFINITY;
          if (key + 32 > qi) s1[e] = -INFINITY;
        }
      }
      float mx = fmaxf(s0[0], s1[0]);
#pragma unroll
      for (int e = 1; e < 16; ++e) mx = fmaxf(mx, fmaxf(s0[e], s1[e]));
      mx = fmaxf(mx, __shfl_xor(mx, 32));
      if (__builtin_amdgcn_ballot_w64((mx - m) * c > 8.f) != 0ull) {
        const float mn = fmaxf(m, mx);
        const float alpha = ex2((m - mn) * c);
        m = mn;
        l *= alpha;
#pragma unroll
        for (int dt = 0; dt < 4; ++dt)
#pragma unroll
          for (int e = 0; e < 16; ++e) o[dt][e] *= alpha;
      }
      const float mc = m * c;
      float ps = 0.f;
#pragma unroll
      for (int e = 0; e < 16; ++e) { s0[e] = ex2(fmaf(s0[e], c, -mc)); s1[e] = ex2(fmaf(s1[e], c, -mc)); ps += s0[e] + s1[e]; }
      l += ps;
      bf16x8 pf[4];
      {
        u32x4 t;
        t.x = pack2(s0[0], s0[1]); t.y = pack2(s0[2], s0[3]); t.z = pack2(s0[4], s0[5]); t.w = pack2(s0[6], s0[7]); pf[0] = __builtin_bit_cast(bf16x8, t);
        t.x = pack2(s0[8], s0[9]); t.y = pack2(s0[10], s0[11]); t.z = pack2(s0[12], s0[13]); t.w = pack2(s0[14], s0[15]); pf[1] = __builtin_bit_cast(bf16x8, t);
        t.x = pack2(s1[0], s1[1]); t.y = pack2(s1[2], s1[3]); t.z = pack2(s1[4], s1[5]); t.w = pack2(s1[6], s1[7]); pf[2] = __builtin_bit_cast(bf16x8, t);
        t.x = pack2(s1[8], s1[9]); t.y = pack2(s1[10], s1[11]); t.z = pack2(s1[12], s1[13]); t.w = pack2(s1[14], s1[15]); pf[3] = __builtin_bit_cast(bf16x8, t);
      }
#pragma unroll
      for (int kk = 0; kk < 4; ++kk) {
        if (kk < 3) {
#pragma unroll
          for (int dt = 0; dt < 4; ++dt) va[(kk + 1) & 1][dt] = *(const bf16x8*)(v0 + (32 * dt) * 72 + 16 * (kk + 1));
        }
        __builtin_amdgcn_sched_barrier(0);
#pragma unroll
        for (int dt = 0; dt < 4; ++dt) o[dt] = MFMA32(va[kk & 1][dt], pf[kk], o[dt]);
        __builtin_amdgcn_sched_barrier(0);
      }
    }
    __syncthreads();
  }
  const float lt = l + __shfl_xor(l, 32);
  const float inv = 1.f / lt;
  if (dry) return;
  u16* yrow = Yp + (size_t)(32 * w + r) * ldy;
#pragma unroll
  for (int dt = 0; dt < 4; ++dt)
#pragma unroll
    for (int g = 0; g < 4; ++g) {
      const int d = 32 * dt + 8 * g + 4 * h;
      uint2 gv = *(const uint2*)(yrow + d);
      float g0 = bf2f(gv.x & 0xffffu), g1 = bf2f(gv.x >> 16), g2 = bf2f(gv.y & 0xffffu), g3 = bf2f(gv.y >> 16);
      uint2 ov;
      ov.x = pack2(o[dt][4 * g] * inv * silu(g0), o[dt][4 * g + 1] * inv * silu(g1));
      ov.y = pack2(o[dt][4 * g + 2] * inv * silu(g2), o[dt][4 * g + 3] * inv * silu(g3));
      *(uint2*)(yrow + d) = ov;
    }
}

DI void memattn_item(const Params& p, int L, int c, int item, char* smem, bool dry) {
  const bool rw = L & 1;
  const int ldu = rw ? LDU_R : LDU_M, oq = rw ? R_QM : M_QM, og = rw ? R_GATE : M_GATE;
  const int tile = item >> 2, xh = item & 3;
  const int b = gtok(rw, c, tile * 128) >> 13;
  u16* U = (u16*)(p.ws + OFF_U);
  const u16* MK = (const u16*)(p.ws + OFF_MEMK) + (size_t)((L * 4 + b) * 4 + xh) * 256 * 128;
  const u16* MV = (const u16*)(p.ws + OFF_MEMVT) + (size_t)((L * 4 + b) * 4 + xh) * 128 * 256;
  attn_item<128>(U + (size_t)tile * 128 * ldu + oq + xh * 128, ldu, MK, MV, 256, 4, 0, false,
                 0.08838834764831845f * 1.4426950408889634f, U + (size_t)tile * 128 * ldu + og + 1536 + xh * 128, ldu, smem, dry);
}

DI void phase_attn(const Params& p, int L, int c, char* smem, int* s_item, bool dry) {
  int* cnt = (int*)(p.ws + OFF_CNT) + 64 + ((L * 2 + c) * 2 + (dry ? 1 : 0)) * 16;
  u16* U = (u16*)(p.ws + OFF_U);
  const u16* Q = (const u16*)(p.ws + OFF_Q); const u16* Kb = (const u16*)(p.ws + OFF_K); const u16* Vt = (const u16*)(p.ws + OFF_VT);
  const int xcc = (int)(__builtin_amdgcn_s_getreg((3 << 11) | 20) & 7u);
  for (int k = 0; k < 8; ++k) {
    const int x = (xcc + k) & 7;
    for (;;) {
      __syncthreads();
      if (otid() == 0) *s_item = atomicAdd(cnt + x, 1);
      __syncthreads();
      const int item = *s_item;
      if (item >= 192) break;
      const int qt = 63 - (item & 63), bh = 3 * x + (item >> 6);
      const int lb = bh / 12, head = bh - lb * 12;
      const int q0 = qt * 128;
      attn_item<192>(Q + ((size_t)(lb * 12 + head) * 8192 + q0) * 192, 192, Kb + (size_t)(lb * 12 + head) * 8192 * 192,
                     Vt + (size_t)(lb * 12 + head) * 128 * 8192, 8192, 2 * (qt + 1), q0, true,
                     0.07216878364870323f * 1.4426950408889634f,
                     U + (size_t)(lb * 8192 + q0) * LDU_M + M_GATE + head * 128, LDU_M, smem, dry);
    }
  }
  for (;;) {
    __syncthreads();
    if (otid() == 0) *s_item = atomicAdd(cnt + 8, 1);
    __syncthreads();
    const int item = *s_item;
    if (item >= 512) break;
    memattn_item(p, L, c, item, smem, dry);
  }
}

DI void scan_item(const Params& p, int L, int c, int item, char* smem, bool dry) {
  const int tid = otid(), w = tid >> 6, lane = tid & 63, r = lane & 31, h = lane >> 5;
  const int j = L >> 1;
  const int b = item / 48, rem = item - b * 48, head = rem >> 1, half = rem & 1;
  float* PA  = (float*)smem;
  float* LO  = PA;
  float* Vst = PA + 32 * 5 * 64;
  float* Yst = Vst + 32 * 32;
  float* PRM = Yst + 32 * 32;
  float* BON = PRM + 10 * 64;
  u16* A1  = (u16*)(BON + 32);
  u16* W2t = A1 + 2 * 32 * 72;
  const u16* U = (const u16*)(p.ws + OFF_U);
  const u16* BND = (const u16*)(p.ws + OFF_BND);
  u16* YR = (u16*)(p.ws + OFF_YR); u16* BV = (u16*)(p.ws + OFF_BV);
  float* ST = (float*)(p.ws + OFF_ST); float* BS = (float*)(p.ws + OFF_BS);
  float* STATE = (float*)(p.ws + OFF_STATE);
  __syncthreads();
  if (tid < 64) {
    const float* mu = p.mu + j * SHIFTW;
    const int hc = head * 64 + tid;
    PRM[0 * 64 + tid] = mu[R_R + hc]; PRM[1 * 64 + tid] = mu[R_K + hc]; PRM[2 * 64 + tid] = mu[R_WD + tid]; PRM[3 * 64 + tid] = mu[R_AD + tid];
    PRM[4 * 64 + tid] = p.w0[j * 1536 + hc]; PRM[5 * 64 + tid] = p.a0[j * 1536 + hc]; PRM[6 * 64 + tid] = p.k_k[j * 1536 + hc];
    PRM[7 * 64 + tid] = p.k_a[j * 1536 + hc]; PRM[8 * 64 + tid] = p.r_k[j * 1536 + hc];
    PRM[9 * 64 + tid] = (tid < 32) ? mu[R_V + head * 64 + 32 * half + tid] : 0.f;
  }
  for (int e = tid; e < 8192; e += 256) {
    int arr = e >> 12, jj = (e >> 6) & 63, cc = e & 63;
    const float* src = (arr ? p.a2 : p.w2) + (size_t)j * 64 * 1536;
    W2t[(arr * 64 + cc) * 72 + jj] = f2bf(src[jj * 1536 + head * 64 + cc]);
  }
  const int rowl = lane >> 3, ks = lane & 7, row32 = 8 * w + rowl;
  float S[8];
  {
    float* sp = STATE + ((size_t)((b * 24 + head) * 64 + 32 * half + row32)) * 64 + 8 * ks;
#pragma unroll
    for (int i = 0; i < 8; ++i) S[i] = (c == 0) ? 0.f : sp[i];
  }
  const int tt = tid >> 3, cs = tid & 7;
  uint4 Rr_c, Rr_p, Rk_c, Rk_p, Rw_c, Rw_p, Ra_c, Ra_p, Rv_c, Rv_p;
  const uint4 zero4 = {0u, 0u, 0u, 0u};
  auto load_raw = [&](int tc) {
    const int lr = b * 4096 + tc * 32 + tt;
    const int s = c * 4096 + tc * 32 + tt;
    const u16* cur = U + (size_t)lr * LDU_R;
    const u16* prv = (s == 4096 && c == 1) ? (BND + (size_t)b * SHIFTW) : (cur - LDU_R);
    const bool hp = (s != 0);
    Rr_c = *(const uint4*)(cur + R_R + head * 64 + cs * 8);  Rr_p = hp ? *(const uint4*)(prv + R_R + head * 64 + cs * 8) : zero4;
    Rk_c = *(const uint4*)(cur + R_K + head * 64 + cs * 8);  Rk_p = hp ? *(const uint4*)(prv + R_K + head * 64 + cs * 8) : zero4;
    Rw_c = *(const uint4*)(cur + R_WD + cs * 8);             Rw_p = hp ? *(const uint4*)(prv + R_WD + cs * 8) : zero4;
    Ra_c = *(const uint4*)(cur + R_AD + cs * 8);             Ra_p = hp ? *(const uint4*)(prv + R_AD + cs * 8) : zero4;
    const int vo = R_V + head * 64 + 32 * half + (cs & 3) * 8;
    Rv_c = *(const uint4*)(cur + vo);                        Rv_p = hp ? *(const uint4*)(prv + vo) : zero4;
  };
  load_raw(0);
  __syncthreads();
  for (int tc = 0; tc < 128; ++tc) {
    const int lr = b * 4096 + tc * 32 + tt;
    float rm[8], km[8];
    {
      float cu[8], pv[8], t8[8];
      unpack8(Rr_c, cu); unpack8(Rr_p, pv);
#pragma unroll
      for (int e = 0; e < 8; ++e) rm[e] = cu[e] + (pv[e] - cu[e]) * PRM[0 * 64 + cs * 8 + e];
      unpack8(Rk_c, cu); unpack8(Rk_p, pv);
#pragma unroll
      for (int e = 0; e < 8; ++e) km[e] = cu[e] + (pv[e] - cu[e]) * PRM[1 * 64 + cs * 8 + e];
      unpack8(Rw_c, cu); unpack8(Rw_p, pv);
#pragma unroll
      for (int e = 0; e < 8; ++e) {
        float xw = cu[e] + (pv[e] - cu[e]) * PRM[2 * 64 + cs * 8 + e];
        float ee = ex2(xw * 2.8853900817779268f);
        t8[e] = 1.f - 2.f * frcp(ee + 1.f);
      }
      *(uint4*)(A1 + (0 * 32 + tt) * 72 + cs * 8) = pack8(t8);
      unpack8(Ra_c, cu); unpack8(Ra_p, pv);
#pragma unroll
      for (int e = 0; e < 8; ++e) t8[e] = cu[e] + (pv[e] - cu[e]) * PRM[3 * 64 + cs * 8 + e];
      *(uint4*)(A1 + (1 * 32 + tt) * 72 + cs * 8) = pack8(t8);
      unpack8(Rv_c, cu); unpack8(Rv_p, pv);
      if (cs < 4) {
#pragma unroll
        for (int e = 0; e < 8; ++e) Vst[tt * 32 + cs * 8 + e] = cu[e] + (pv[e] - cu[e]) * PRM[9 * 64 + cs * 8 + e];
      }
    }
    __syncthreads();
    {
      const int arr = w >> 1, nt = w & 1;
      f32x16 acc;
#pragma unroll
      for (int e = 0; e < 16; ++e) acc[e] = 0.f;
#pragma unroll
      for (int k4 = 0; k4 < 4; ++k4) {
        bf16x8 a = *(const bf16x8*)(A1 + (arr * 32 + r) * 72 + 16 * k4 + 8 * h);
        bf16x8 bw = *(const bf16x8*)(W2t + (arr * 64 + 32 * nt + r) * 72 + 16 * k4 + 8 * h);
        acc = MFMA32(a, bw, acc);
      }
#pragma unroll
      for (int e = 0; e < 16; ++e) LO[(arr * 32 + crow(e, h)) * 64 + 32 * nt + r] = acc[e];
    }
    __syncthreads();
    float lw[8], la[8];
    {
      float4 t0 = *(const float4*)(LO + (0 * 32 + tt) * 64 + cs * 8), t1 = *(const float4*)(LO + (0 * 32 + tt) * 64 + cs * 8 + 4);
      lw[0] = t0.x; lw[1] = t0.y; lw[2] = t0.z; lw[3] = t0.w; lw[4] = t1.x; lw[5] = t1.y; lw[6] = t1.z; lw[7] = t1.w;
      t0 = *(const float4*)(LO + (1 * 32 + tt) * 64 + cs * 8); t1 = *(const float4*)(LO + (1 * 32 + tt) * 64 + cs * 8 + 4);
      la[0] = t0.x; la[1] = t0.y; la[2] = t0.z; la[3] = t0.w; la[4] = t1.x; la[5] = t1.y; la[6] = t1.z; la[7] = t1.w;
    }
    __syncthreads();
    {
      float dec[8], kk[8], av[8], kp[8];
      float ssq = 0.f, bon = 0.f;
#pragma unroll
      for (int e = 0; e < 8; ++e) {
        const int ch = cs * 8 + e;
        float xx = -(lw[e] + PRM[4 * 64 + ch]);
        float sp = fmaxf(xx, 0.f) + __logf(1.f + fexp(-fabsf(xx)));
        float wv = -sp - 0.5f;
        dec[e] = fexp(-fexp(wv));
        float a = frcp(1.f + fexp(-(la[e] + PRM[5 * 64 + ch])));
        av[e] = a;
        kk[e] = km[e] * PRM[6 * 64 + ch];
        ssq += kk[e] * kk[e];
        kp[e] = km[e] * (1.f + (a - 1.f) * PRM[7 * 64 + ch]);
        bon += rm[e] * kp[e] * PRM[8 * 64 + ch];
      }
      ssq = red8(ssq); bon = red8(bon);
      const float inv = 1.f / fmaxf(sqrtf(ssq), 1e-12f);
      float nk[8], bb[8];
#pragma unroll
      for (int e = 0; e < 8; ++e) { float kn = kk[e] * inv; nk[e] = -kn; bb[e] = kn * av[e]; }
      float* pa = PA + tt * 320 + cs * 8;
      *(float4*)(pa) = make_float4(dec[0], dec[1], dec[2], dec[3]); *(float4*)(pa + 4) = make_float4(dec[4], dec[5], dec[6], dec[7]);
      *(float4*)(pa + 64) = make_float4(nk[0], nk[1], nk[2], nk[3]); *(float4*)(pa + 68) = make_float4(nk[4], nk[5], nk[6], nk[7]);
      *(float4*)(pa + 128) = make_float4(bb[0], bb[1], bb[2], bb[3]); *(float4*)(pa + 132) = make_float4(bb[4], bb[5], bb[6], bb[7]);
      *(float4*)(pa + 192) = make_float4(kp[0], kp[1], kp[2], kp[3]); *(float4*)(pa + 196) = make_float4(kp[4], kp[5], kp[6], kp[7]);
      *(float4*)(pa + 256) = make_float4(rm[0], rm[1], rm[2], rm[3]); *(float4*)(pa + 260) = make_float4(rm[4], rm[5], rm[6], rm[7]);
      if (cs == 0) BON[tt] = bon;
    }
    __syncthreads();
    if (tc + 1 < 128) load_raw(tc + 1);
    {
      const float* pa0 = PA + ks * 8;
      const float* vs0 = Vst + row32;
      float4 d0 = *(const float4*)(pa0), d1 = *(const float4*)(pa0 + 4);
      float4 n0 = *(const float4*)(pa0 + 64), n1 = *(const float4*)(pa0 + 68);
      float4 b0 = *(const float4*)(pa0 + 128), b1 = *(const float4*)(pa0 + 132);
      float4 k0 = *(const float4*)(pa0 + 192), k1 = *(const float4*)(pa0 + 196);
      float4 r0 = *(const float4*)(pa0 + 256), r1 = *(const float4*)(pa0 + 260);
      float vv = vs0[0];
#pragma unroll 2
      for (int t = 0; t < 32; ++t) {
        const float* pa = pa0 + (t + 1) * 320;
        const float4 xd0 = *(const float4*)(pa), xd1 = *(const float4*)(pa + 4);
        const float4 xn0 = *(const float4*)(pa + 64), xn1 = *(const float4*)(pa + 68);
        const float4 xb0 = *(const float4*)(pa + 128), xb1 = *(const float4*)(pa + 132);
        const float4 xk0 = *(const float4*)(pa + 192), xk1 = *(const float4*)(pa + 196);
        const float4 xr0 = *(const float4*)(pa + 256), xr1 = *(const float4*)(pa + 260);
        const float xvv = vs0[(t + 1) * 32];
        __builtin_amdgcn_sched_barrier(0);
        float sa0 = S[0] * n0.x, sa1 = S[1] * n0.y;
        sa0 = fmaf(S[2], n0.z, sa0); sa1 = fmaf(S[3], n0.w, sa1);
        sa0 = fmaf(S[4], n1.x, sa0); sa1 = fmaf(S[5], n1.y, sa1);
        sa0 = fmaf(S[6], n1.z, sa0); sa1 = fmaf(S[7], n1.w, sa1);
        float sa = red8(sa0 + sa1);
        S[0] = fmaf(sa, b0.x, fmaf(S[0], d0.x, vv * k0.x)); S[1] = fmaf(sa, b0.y, fmaf(S[1], d0.y, vv * k0.y));
        S[2] = fmaf(sa, b0.z, fmaf(S[2], d0.z, vv * k0.z)); S[3] = fmaf(sa, b0.w, fmaf(S[3], d0.w, vv * k0.w));
        S[4] = fmaf(sa, b1.x, fmaf(S[4], d1.x, vv * k1.x)); S[5] = fmaf(sa, b1.y, fmaf(S[5], d1.y, vv * k1.y));
        S[6] = fmaf(sa, b1.z, fmaf(S[6], d1.z, vv * k1.z)); S[7] = fmaf(sa, b1.w, fmaf(S[7], d1.w, vv * k1.w));
        float y0 = S[0] * r0.x, y1 = S[1] * r0.y;
        y0 = fmaf(S[2], r0.z, y0); y1 = fmaf(S[3], r0.w, y1);
        y0 = fmaf(S[4], r1.x, y0); y1 = fmaf(S[5], r1.y, y1);
        y0 = fmaf(S[6], r1.z, y0); y1 = fmaf(S[7], r1.w, y1);
        float y = red8(y0 + y1);
        if (ks == 0) Yst[t * 32 + row32] = y;
        __builtin_amdgcn_sched_barrier(0);
        d0 = xd0; d1 = xd1; n0 = xn0; n1 = xn1; b0 = xb0; b1 = xb1; k0 = xk0; k1 = xk1; r0 = xr0; r1 = xr1; vv = xvv;
      }
    }
    __syncthreads();
    {
      const int c4 = cs & 3;
      float y8[8], v8[8];
      float4 t0 = *(const float4*)(Yst + tt * 32 + c4 * 8), t1 = *(const float4*)(Yst + tt * 32 + c4 * 8 + 4);
      y8[0] = t0.x; y8[1] = t0.y; y8[2] = t0.z; y8[3] = t0.w; y8[4] = t1.x; y8[5] = t1.y; y8[6] = t1.z; y8[7] = t1.w;
      float sm = 0.f, sq = 0.f;
#pragma unroll
      for (int e = 0; e < 8; ++e) { sm += y8[e]; sq += y8[e] * y8[e]; }
      sm = red4(sm); sq = red4(sq);
      const float bon = BON[tt];
      t0 = *(const float4*)(Vst + tt * 32 + c4 * 8); t1 = *(const float4*)(Vst + tt * 32 + c4 * 8 + 4);
      v8[0] = t0.x * bon; v8[1] = t0.y * bon; v8[2] = t0.z * bon; v8[3] = t0.w * bon; v8[4] = t1.x * bon; v8[5] = t1.y * bon; v8[6] = t1.z * bon; v8[7] = t1.w * bon;
      if (cs < 4 && !dry) {
        const size_t o = (size_t)lr * 1536 + head * 64 + 32 * half + cs * 8;
        *(uint4*)(YR + o) = pack8(y8);
        *(uint4*)(BV + o) = pack8(v8);
        if (cs == 0) {
          float* stp = ST + ((size_t)(lr * 24 + head) * 2 + half) * 2;
          stp[0] = sm; stp[1] = sq;
        }
      }
    }
  }
  if (c == 0 && !dry) {
    float* sp = STATE + ((size_t)((b * 24 + head) * 64 + 32 * half + row32)) * 64 + 8 * ks;
#pragma unroll
    for (int i = 0; i < 8; ++i) sp[i] = S[i];
  }
}

DI void phase_scan(const Params& p, int L, int c, char* smem, int* s_item, bool dry) {
  for (int item = blockIdx.x; item < 192; item += gridDim.x) scan_item(p, L, c, item, smem, dry);
  int* cnt = (int*)(p.ws + OFF_CNT) + 64 + ((L * 2 + c) * 2 + (dry ? 1 : 0)) * 16 + 8;
  for (;;) {
    __syncthreads();
    if (otid() == 0) *s_item = atomicAdd(cnt, 1);
    __syncthreads();
    const int item = *s_item;
    if (item >= 512) break;
    memattn_item(p, L, c, item, smem, dry);
  }
}

DI void phase_finalize(const Params& p, int L, int c, bool dry) {
  const int j = L >> 1;
  u16* U = (u16*)(p.ws + OFF_U);
  const u16* YR = (const u16*)(p.ws + OFF_YR); const u16* BV = (const u16*)(p.ws + OFF_BV);
  const float* ST = (const float*)(p.ws + OFF_ST);
  const int G = gridDim.x;
  for (int idx = blockIdx.x * 256 + otid(); idx < TC * 192; idx += G * 256) {
    const int lr = idx / 192, c8 = idx - lr * 192, ch0 = c8 * 8, head = ch0 >> 6;
    const float4 st = *(const float4*)(ST + (size_t)(lr * 24 + head) * 4);
    const float mean = (st.x + st.z) * (1.f / 64.f);
    const float var = (st.y + st.w) * (1.f / 64.f) - mean * mean;
    const float rstd = rsqrtf(fmaxf(var, 0.f) + 64e-5f);
    float y[8], bv[8], g[8], o[8];
    unpack8(*(const uint4*)(YR + (size_t)lr * 1536 + ch0), y);
    unpack8(*(const uint4*)(BV + (size_t)lr * 1536 + ch0), bv);
    u16* gp = U + (size_t)lr * LDU_R + R_GATE + ch0;
    unpack8(*(const uint4*)gp, g);
    const float* gw = p.gn_w + j * 1536 + ch0; const float* gb = p.gn_b + j * 1536 + ch0;
#pragma unroll
    for (int e = 0; e < 8; ++e) o[e] = ((y[e] - mean) * rstd * gw[e] + gb[e] + bv[e]) * silu(g[e]);
    if (!dry) *(uint4*)gp = pack8(o);
  }
  if (c == 0) {
    u16* BND = (u16*)(p.ws + OFF_BND);
    for (int idx = blockIdx.x * 256 + otid(); idx < 4 * (SHIFTW / 8); idx += G * 256) {
      const int b = idx / (SHIFTW / 8), cc = idx - b * (SHIFTW / 8);
      *(uint4*)(BND + (size_t)b * SHIFTW + cc * 8) = *(const uint4*)(U + (size_t)(b * 4096 + 4095) * LDU_R + cc * 8);
    }
  }
}

enum { PH_PREP = 0, PH_NORM, PH_GEMM_IN, PH_KVPREP, PH_GEMM_UP, PH_ATTN, PH_SCAN, PH_FINALIZE, PH_GEMM_OUT, PH_FINAL };
constexpr int NSTEPS = 46;

DI void decode_step(int step, int& ph, int& L, int& c) {
  if (step == 0) { ph = PH_PREP; L = 0; c = 0; return; }
  if (step == NSTEPS - 1) { ph = PH_FINAL; L = 0; c = 0; return; }
  int s = step - 1;
  int pr = s / 22, rem = s - pr * 22;
  if (rem < 12) {
    L = 2 * pr; c = rem / 6; int k = rem - c * 6;
    ph = (k == 0) ? PH_NORM : (k == 1) ? PH_GEMM_IN : (k == 2) ? PH_KVPREP : (k == 3) ? PH_GEMM_UP : (k == 4) ? PH_ATTN : PH_GEMM_OUT;
  } else {
    rem -= 12; L = 2 * pr + 1; c = rem / 5; int k = rem - c * 5;
    ph = (k == 0) ? PH_NORM : (k == 1) ? PH_GEMM_IN : (k == 2) ? PH_SCAN : (k == 3) ? PH_FINALIZE : PH_GEMM_OUT;
  }
}

DI void run_step(const Params& p, int ph, int L, int c, char* smem, int* s_item, bool dry_in, int vt) {
  const bool dry = dry_in && !(HYP5 && (ph == PH_GEMM_IN || ph == PH_GEMM_UP));
  char* ws = p.ws;
  const bool rw = L & 1;
  const int j = L >> 1;
  switch (ph) {
    case PH_PREP: phase_prep(p, smem); break;
    case PH_NORM:
      phase_norm(p, L, c);
      if (L == 0 && c == 0) {
        EpiMemKV epi{(u16*)(ws + OFF_MEMK), (u16*)(ws + OFF_MEMVT), false};
        gemm_phase<2, false>((const u16*)(ws + OFF_MEMH), 1024ull * 1024, 1024, (const u16*)(ws + OFF_WT_MEMKV), 1024ull * 1024, 1024, 4, 4, 8, 4, 1024, smem, epi, vt);
      }
      break;
    case PH_GEMM_IN:
      if (!rw) {
        EpiStoreBf16 epi{(u16*)(ws + OFF_U), LDU_M, LDU_M, dry};
        gemm_phase<2, true>((const u16*)(ws + OFF_H), 0, 1024, (const u16*)(ws + OFF_WT_INMLA) + (size_t)j * 3328 * 1024, 0, 1024, 1, 64, 26, 4, 1024, smem, epi, vt);
      } else {
        EpiStoreBf16 epi{(u16*)(ws + OFF_U), LDU_R, LDU_R, dry};
        gemm_phase<2, true>((const u16*)(ws + OFF_H), 0, 1024, (const u16*)(ws + OFF_WT_INRW) + (size_t)j * 7296 * 1024, 0, 1024, 1, 64, 57, 4, 1024, smem, epi, vt);
      }
      break;
    case PH_KVPREP: phase_kvprep(p, L, c, dry); break;
    case PH_GEMM_UP: {
      EpiUQ e1{(u16*)(ws + OFF_Q), (const float*)(ws + OFF_COS), (const float*)(ws + OFF_SIN), c, dry};
      gemm_phase<2, true>((const u16*)(ws + OFF_U) + M_CQ, 0, LDU_M, (const u16*)(ws + OFF_WT_UQ) + (size_t)j * 2304 * 384, 0, 384, 1, 64, 18, 4, 384, smem, e1, vt);
      EpiUK e2{(u16*)(ws + OFF_K), dry};
      gemm_phase<2, true>((const u16*)(ws + OFF_U) + M_CKV, 0, LDU_M, (const u16*)(ws + OFF_WT_UKV) + (size_t)j * 3072 * 256, 0, 256, 1, 64, 12, 4, 256, smem, e2, vt);
      EpiUV e3{(u16*)(ws + OFF_VT), dry};
      gemm_phase<2, false>((const u16*)(ws + OFF_U) + M_CKV, 0, LDU_M, (const u16*)(ws + OFF_WT_UKV) + (size_t)j * 3072 * 256 + 1536ull * 256, 0, 256, 1, 64, 12, 4, 256, smem, e3, vt);
    } break;
    case PH_ATTN: phase_attn(p, L, c, smem, s_item, dry); break;
    case PH_SCAN: phase_scan(p, L, c, smem, s_item, dry); break;
    case PH_FINALIZE: phase_finalize(p, L, c, dry); break;
    case PH_GEMM_OUT: {
      EpiResid epi{(L == 0) ? p.x : (const float*)p.out, p.out, rw, c, dry};
      gemm_phase<2, true>((const u16*)(ws + OFF_U) + (rw ? R_GATE : M_GATE), 0, rw ? LDU_R : LDU_M, (const u16*)(ws + OFF_WT_OUT) + (size_t)L * 1024 * 2048, 0, 2048,
                 1, 64, 8, 4, 2048, smem, epi, vt);
    } break;
    case PH_FINAL: phase_final_norm(p, dry); break;
  }
}

DI void grid_barrier(unsigned* bar, unsigned& epoch) {
  __syncthreads();
  ++epoch;
  if (threadIdx.x == 0) {
    __builtin_amdgcn_fence(__ATOMIC_RELEASE, "agent");
    asm volatile("s_waitcnt vmcnt(0)" ::: "memory");
    const unsigned target = epoch * gridDim.x;
    __hip_atomic_fetch_add(bar, 1u, __ATOMIC_RELAXED, __HIP_MEMORY_SCOPE_AGENT);
    unsigned spins = 0;
    while (__hip_atomic_load(bar, __ATOMIC_RELAXED, __HIP_MEMORY_SCOPE_AGENT) < target) {
      __builtin_amdgcn_s_sleep(2);
      if (++spins > (1u << 22)) break;
    }
    __builtin_amdgcn_fence(__ATOMIC_ACQUIRE, "agent");
    asm volatile("s_waitcnt vmcnt(0)" ::: "memory");
  }
  __syncthreads();
}

__global__ void __launch_bounds__(256, 1) hybrid_megakernel(Params p, int s_lo, int s_hi, int coop, int probe_mask) {
  __shared__ __attribute__((aligned(16))) char smem[SMEM_BYTES];
  __shared__ int s_item;
  unsigned* bar = (unsigned*)(p.ws + OFF_BAR);
  unsigned epoch = 0;
  if (coop == 2) cg::this_grid().sync();
  __shared__ int s_vt;
  int myx = 0, myrank = 0;
  if (coop && threadIdx.x == 0) {
    myx = (int)(__builtin_amdgcn_s_getreg((3 << 11) | 20) & 7u);
    myrank = (int)__hip_atomic_fetch_add(bar + 16 + myx, 1u, __ATOMIC_RELAXED, __HIP_MEMORY_SCOPE_AGENT);
  }
  int vt = blockIdx.x;
  {
    const int G = gridDim.x, t = blockIdx.x;
    vt = ((G & 7) == 0) ? ((t & 7) * (G >> 3) + (t >> 3)) : t;
  }
  for (int st = s_lo; st < s_hi; ++st) {
    int ph, L, c;
    decode_step(st, ph, L, c);
    for (int rep = ((probe_mask >> ph) & 1) ? 0 : 1; rep < 2; ++rep) {
      run_step(p, ph, L, c, smem, &s_item, rep == 0, vt);
      if (coop && (rep == 0 || st + 1 < s_hi)) grid_barrier(bar, epoch);
      if (coop) for (int xs = 0; xs < EXTRA_SYNCS; ++xs) grid_barrier(bar, epoch);
    }
    if (coop && st == s_lo) {
      if (threadIdx.x == 0) {
        const int G = gridDim.x;
        bool ok = (G & 7) == 0;
        for (int x = 0; x < 8; ++x) ok = ok && ((int)__hip_atomic_load(bar + 16 + x, __ATOMIC_RELAXED, __HIP_MEMORY_SCOPE_AGENT) == (G >> 3));
        s_vt = ok ? (myx * (G >> 3) + myrank) : vt;
      }
      __syncthreads();
      vt = s_vt;
    }
  }
}

extern "C" void kernel_launch(void* const* d_in, const int* in_sizes, int n_in, void* d_out, int out_size, void* d_ws, size_t ws_size,
                              hipStream_t stream) {
  if (ws_size < WS_NEED) { fprintf(stderr, "workspace too small: %zu < %zu\n", ws_size, (size_t)WS_NEED); return; }
  Params p;
  memset(&p, 0, sizeof(p));
  p.x = (const float*)d_in[0]; p.mem = (const float*)d_in[1]; p.pos = (const int*)d_in[2];
  p.norm_g = (const float*)d_in[3]; p.mem_norm_g = (const float*)d_in[4]; p.w_mem_kv = (const float*)d_in[5];
  p.w_in_mla = (const float*)d_in[6]; p.q_norm_g = (const float*)d_in[7]; p.kv_norm_g = (const float*)d_in[8];
  p.w_uq = (const float*)d_in[9]; p.w_ukv = (const float*)d_in[10]; p.w_in_rwkv = (const float*)d_in[11];
  p.mu = (const float*)d_in[12]; p.w0 = (const float*)d_in[13]; p.w2 = (const float*)d_in[14]; p.a0 = (const float*)d_in[15];
  p.a2 = (const float*)d_in[16]; p.k_k = (const float*)d_in[17]; p.k_a = (const float*)d_in[18]; p.r_k = (const float*)d_in[19];
  p.gn_w = (const float*)d_in[20]; p.gn_b = (const float*)d_in[21]; p.w_out = (const float*)d_in[22]; p.final_g = (const float*)d_in[23];
  p.out = (float*)d_out; p.ws = (char*)d_ws;
  static int grid_blocks = 0;
  if (!grid_blocks) {
    int dev = 0, cus = 0, per_cu = 0;
    hipGetDevice(&dev);
    hipDeviceGetAttribute(&cus, hipDeviceAttributeMultiprocessorCount, dev);
    hipOccupancyMaxActiveBlocksPerMultiprocessor(&per_cu, hybrid_megakernel, 256, 0);
    if (per_cu > 2) per_cu = 2;
    if (per_cu < 1) per_cu = 1;
    grid_blocks = cus * per_cu;
  }
#if MULTI_LAUNCH
  for (int s = 0; s < NSTEPS; ++s) hipLaunchKernelGGL(hybrid_megakernel, dim3(grid_blocks), dim3(256), 0, stream, p, s, s + 1, 0, 0);
#else
  int s_lo = 0, s_hi = NSTEPS, coop = 1, probe_mask = PROBE_MASK;
  void* args[] = {&p, &s_lo, &s_hi, &coop, &probe_mask};
  hipMemsetAsync((char*)d_ws + OFF_BAR, 0, 256, stream);
  hipError_t e = hipLaunchCooperativeKernel((void*)hybrid_megakernel, dim3(grid_blocks), dim3(256), args, 0, stream);
  if (e != hipSuccess) fprintf(stderr, "cooperative launch failed: %s (grid %d)\n", hipGetErrorString(e), grid_blocks);
#endif
}
```

```cpp
#include <hip/hip_runtime.h>
#include <hip/hip_cooperative_groups.h>
#include <cstdio>
#include <cstring>
namespace cg = cooperative_groups;

#define PROBE_MASK 0
#define EXTRA_SYNCS 0
#define HYP1 0
#define HYP2 0
#define HYP3 0
#define HYP4 0
#define HYP5 0
#define HYP6 0
#ifndef MULTI_LAUNCH
#define MULTI_LAUNCH 0
#endif

#define DI __device__ __forceinline__
typedef unsigned short u16;
typedef __attribute__((ext_vector_type(8))) short bf16x8;
typedef __attribute__((ext_vector_type(16))) float f32x16;
typedef __attribute__((ext_vector_type(2))) __bf16 bf2_t;
typedef __attribute__((ext_vector_type(2))) float f2_t;
typedef __attribute__((ext_vector_type(4))) unsigned u32x4;
typedef __attribute__((ext_vector_type(2))) unsigned u32x2;
#define MFMA32(a, b, c) __builtin_amdgcn_mfma_f32_32x32x16_bf16((a), (b), (c), 0, 0, 0)

constexpr int SEQ = 8192, TC = 16384;
constexpr int LDU_M = 3264, LDU_R = 7296;
constexpr int M_CQ = 0, M_CKV = 384, M_KR = 640, M_QM = 704, M_GATE = 1216;
constexpr int R_R = 0, R_K = 1536, R_V = 3072, R_WD = 4608, R_AD = 4672, R_QM = 4736, R_GATE = 5248;
constexpr int SHIFTW = 4736;

constexpr size_t OFF_WT_MEMKV = 0;
constexpr size_t OFF_WT_INMLA = OFF_WT_MEMKV + 4ull * 1024 * 1024 * 2;
constexpr size_t OFF_WT_UQ    = OFF_WT_INMLA + 2ull * 3328 * 1024 * 2;
constexpr size_t OFF_WT_UKV   = OFF_WT_UQ + 2ull * 2304 * 384 * 2;
constexpr size_t OFF_WT_INRW  = OFF_WT_UKV + 2ull * 3072 * 256 * 2;
constexpr size_t OFF_WT_OUT   = OFF_WT_INRW + 2ull * 7296 * 1024 * 2;
constexpr size_t OFF_MEMH     = OFF_WT_OUT + 4ull * 1024 * 2048 * 2;
constexpr size_t OFF_MEMK     = OFF_MEMH + 4ull * 1024 * 1024 * 2;
constexpr size_t OFF_MEMVT    = OFF_MEMK + 4ull * 4 * 4 * 256 * 128 * 2;
constexpr size_t OFF_COS      = OFF_MEMVT + 4ull * 4 * 4 * 256 * 128 * 2;
constexpr size_t OFF_SIN      = OFF_COS + 32768ull * 32 * 4;
constexpr size_t OFF_CNT      = OFF_SIN + 32768ull * 32 * 4;
constexpr size_t OFF_BAR      = OFF_CNT + 4096;
constexpr size_t OFF_STATE    = OFF_BAR + 256;
constexpr size_t OFF_BND      = OFF_STATE + 96ull * 4096 * 4;
constexpr size_t OFF_H        = OFF_BND + 4ull * 4736 * 2 + 128;
constexpr size_t OFF_R        = OFF_H + 16384ull * 1024 * 2;
constexpr size_t OFF_U        = OFF_R;
constexpr size_t OFF_Q        = OFF_R + 16384ull * 3264 * 2;
constexpr size_t OFF_K        = OFF_Q + 2ull * 12 * 8192 * 192 * 2;
constexpr size_t OFF_VT       = OFF_K + 2ull * 12 * 8192 * 192 * 2;
constexpr size_t OFF_YR       = OFF_R + 16384ull * 7296 * 2;
constexpr size_t OFF_BV       = OFF_YR + 16384ull * 1536 * 2;
constexpr size_t OFF_ST       = OFF_BV + 16384ull * 1536 * 2;
constexpr size_t OFF_BS       = OFF_ST + 16384ull * 24 * 4 * 4;
constexpr size_t WS_NEED      = OFF_BS + 16384ull * 24 * 4;

constexpr int SMEM_BYTES = 110592;

struct Params {
  const float *x, *mem; const int* pos;
  const float *norm_g, *mem_norm_g, *w_mem_kv, *w_in_mla, *q_norm_g, *kv_norm_g, *w_uq, *w_ukv, *w_in_rwkv;
  const float *mu, *w0, *w2, *a0, *a2, *k_k, *k_a, *r_k, *gn_w, *gn_b, *w_out, *final_g;
  float* out; char* ws;
};

DI int otid() { int t = threadIdx.x; asm volatile("" : "+v"(t)); return t; }
DI float bf2f(unsigned v) { return __uint_as_float(v << 16); }
DI unsigned pack2(float a, float b) { f2_t v = {a, b}; bf2_t r = __builtin_convertvector(v, bf2_t); return __builtin_bit_cast(unsigned, r); }
DI u16 f2bf(float a) { return (u16)(pack2(a, 0.f) & 0xffffu); }
DI float ex2(float x) { return __builtin_amdgcn_exp2f(x); }
DI float fexp(float x) { return __builtin_amdgcn_exp2f(x * 1.4426950408889634f); }
DI float frcp(float x) { return __builtin_amdgcn_rcpf(x); }
DI float silu(float g) { return g * frcp(1.f + fexp(-g)); }
DI float wave_sum(float v) { for (int o = 32; o > 0; o >>= 1) v += __shfl_xor(v, o); return v; }
DI int crow(int reg, int h) { return (reg & 3) + 8 * (reg >> 2) + 4 * h; }
DI float dppf(float x, const int ctrl_sel) {
  int xi;
  if (ctrl_sel == 0) xi = __builtin_amdgcn_update_dpp(0, __float_as_int(x), 0xB1, 0xf, 0xf, true);
  else if (ctrl_sel == 1) xi = __builtin_amdgcn_update_dpp(0, __float_as_int(x), 0x4E, 0xf, 0xf, true);
  else xi = __builtin_amdgcn_update_dpp(0, __float_as_int(x), 0x141, 0xf, 0xf, true);
  return __int_as_float(xi);
}
DI float red4(float x) { x += dppf(x, 0); x += dppf(x, 1); return x; }
DI float red8(float x) { x += dppf(x, 0); x += dppf(x, 1); x += dppf(x, 2); return x; }
DI int gtok(bool rw, int c, int lr) { return rw ? ((lr >> 12) * 8192 + c * 4096 + (lr & 4095)) : (c * 16384 + lr); }
DI void unpack8(const uint4& v, float* f) {
  f[0] = bf2f(v.x & 0xffffu); f[1] = bf2f(v.x >> 16); f[2] = bf2f(v.y & 0xffffu); f[3] = bf2f(v.y >> 16);
  f[4] = bf2f(v.z & 0xffffu); f[5] = bf2f(v.z >> 16); f[6] = bf2f(v.w & 0xffffu); f[7] = bf2f(v.w >> 16);
}
DI uint4 pack8(const float* f) { uint4 v; v.x = pack2(f[0], f[1]); v.y = pack2(f[2], f[3]); v.z = pack2(f[4], f[5]); v.w = pack2(f[6], f[7]); return v; }

DI void transpose_tile(const float* __restrict__ src, u16* __restrict__ dst, int K, int N, int tk, int tn, int drow, float* tile) {
  const int tid = otid();
  __syncthreads();
#pragma unroll
  for (int i = 0; i < 4; ++i) {
    int kr = (tid >> 4) + 16 * i, nc = (tid & 15) * 4;
    float4 v = *(const float4*)(src + (size_t)(tk * 64 + kr) * N + tn * 64 + nc);
    tile[kr * 65 + nc] = v.x; tile[kr * 65 + nc + 1] = v.y; tile[kr * 65 + nc + 2] = v.z; tile[kr * 65 + nc + 3] = v.w;
  }
  __syncthreads();
#pragma unroll
  for (int i = 0; i < 2; ++i) {
    int n = (tid >> 3) + 32 * i, kc = (tid & 7) * 8;
    float f[8];
#pragma unroll
    for (int e = 0; e < 8; ++e) f[e] = tile[(kc + e) * 65 + n];
    *(uint4*)(dst + (size_t)(drow + n) * K + tk * 64 + kc) = pack8(f);
  }
}

DI void rms_row_bf16(const float* __restrict__ src, const float* __restrict__ g, u16* __restrict__ dst, int lane) {
  float4 v[4]; float ss = 0.f;
#pragma unroll
  for (int i = 0; i < 4; ++i) { v[i] = *(const float4*)(src + i * 256 + lane * 4); ss += v[i].x * v[i].x + v[i].y * v[i].y + v[i].z * v[i].z + v[i].w * v[i].w; }
  ss = wave_sum(ss);
  float rs = rsqrtf(ss * (1.f / 1024.f) + 1e-6f);
#pragma unroll
  for (int i = 0; i < 4; ++i) {
    float4 gg = *(const float4*)(g + i * 256 + lane * 4);
    uint2 o; o.x = pack2(v[i].x * rs * gg.x, v[i].y * rs * gg.y); o.y = pack2(v[i].z * rs * gg.z, v[i].w * rs * gg.w);
    *(uint2*)(dst + i * 256 + lane * 4) = o;
  }
}

DI void phase_prep(const Params& p, char* smem) {
  const int tid = otid(), G = gridDim.x, bid = blockIdx.x;
  char* ws = p.ws;
  if (bid == 0) for (int i = tid; i < 1024; i += 256) ((int*)(ws + OFF_CNT))[i] = 0;
  float* tile = (float*)smem;
  for (int g0 = bid; g0 < 9168; g0 += G) {
    int g = g0;
    const float* src = nullptr; u16* dst = nullptr; int K = 0, N = 0; size_t dstr = 0; bool ukv = false;
    if (g < 1024) { src = p.w_mem_kv; dst = (u16*)(ws + OFF_WT_MEMKV); K = 1024; N = 1024; dstr = 1024ull * 1024; }
    else if ((g -= 1024) < 1632) { src = p.w_in_mla; dst = (u16*)(ws + OFF_WT_INMLA); K = 1024; N = 3264; dstr = 3328ull * 1024; }
    else if ((g -= 1632) < 432) { src = p.w_uq; dst = (u16*)(ws + OFF_WT_UQ); K = 384; N = 2304; dstr = 2304ull * 384; }
    else if ((g -= 432) < 384) { src = p.w_ukv; dst = (u16*)(ws + OFF_WT_UKV); K = 256; N = 3072; dstr = 3072ull * 256; ukv = true; }
    else if ((g -= 384) < 3648) { src = p.w_in_rwkv; dst = (u16*)(ws + OFF_WT_INRW); K = 1024; N = 7296; dstr = 7296ull * 1024; }
    else { g -= 3648; src = p.w_out; dst = (u16*)(ws + OFF_WT_OUT); K = 2048; N = 1024; dstr = 1024ull * 2048; }
    int ntn = N >> 6, per = (K >> 6) * ntn;
    int m = g / per, t = g - m * per;
    int tk = t / ntn, tn = t - tk * ntn;
    int drow = tn * 64;
    if (ukv) { const int hd = drow >> 8, dd = drow & 255; drow = (dd < 128) ? (hd * 128 + dd) : (1536 + hd * 128 + dd - 128); }
    transpose_tile(src + (size_t)m * K * N, dst + (size_t)m * dstr, K, N, tk, tn, drow, tile);
  }
  for (int i = bid * 256 + tid; i < 2 * 64 * 1024 / 8; i += G * 256) {
    int m = i / (64 * 1024 / 8), r = i - m * (64 * 1024 / 8);
    uint4 z; z.x = z.y = z.z = z.w = 0u;
    *(uint4*)((u16*)(ws + OFF_WT_INMLA) + (size_t)m * 3328 * 1024 + 3264ull * 1024 + (size_t)r * 8) = z;
  }
  float* cs = (float*)(ws + OFF_COS); float* sn = (float*)(ws + OFF_SIN);
  for (int i = bid * 256 + tid; i < 32768 * 32; i += G * 256) {
    int tk = i >> 5, pi = i & 31;
    float inv_freq = (float)exp2(-(double)(2 * pi) / 64.0 * 13.287712379549449);
    float ang = (float)p.pos[tk] * inv_freq;
    double rev = (double)ang * 0.15915494309189535;
    float fr = (float)(rev - rint(rev));
    cs[i] = __builtin_amdgcn_cosf(fr); sn[i] = __builtin_amdgcn_sinf(fr);
  }
  const int w = tid >> 6, lane = tid & 63;
  for (int row = bid * 4 + w; row < 4096; row += G * 4) {
    int L = row >> 10, m = row & 1023;
    rms_row_bf16(p.mem + (size_t)m * 1024, p.mem_norm_g + L * 1024, (u16*)(ws + OFF_MEMH) + (size_t)row * 1024, lane);
  }
}

DI void phase_norm(const Params& p, int L, int c) {
  const int tid = otid(), w = tid >> 6, lane = tid & 63;
  const bool rw = L & 1;
  const float* xs = (L == 0) ? p.x : p.out;
  u16* H = (u16*)(p.ws + OFF_H);
  for (int lr = blockIdx.x * 4 + w; lr < TC; lr += gridDim.x * 4) {
    int gt = gtok(rw, c, lr);
    rms_row_bf16(xs + (size_t)gt * 1024, p.norm_g + L * 1024, H + (size_t)lr * 1024, lane);
  }
}

DI void phase_final_norm(const Params& p, bool dry) {
  const int tid = otid(), w = tid >> 6, lane = tid & 63;
  for (int row = blockIdx.x * 4 + w; row < 32768; row += gridDim.x * 4) {
    float* xr = p.out + (size_t)row * 1024;
    float4 v[4]; float ss = 0.f;
#pragma unroll
    for (int i = 0; i < 4; ++i) { v[i] = *(const float4*)(xr + i * 256 + lane * 4); ss += v[i].x * v[i].x + v[i].y * v[i].y + v[i].z * v[i].z + v[i].w * v[i].w; }
    ss = wave_sum(ss);
    float rs = rsqrtf(ss * (1.f / 1024.f) + 1e-6f);
#pragma unroll
    for (int i = 0; i < 4; ++i) {
      float4 gg = *(const float4*)(p.final_g + i * 256 + lane * 4);
      float4 o; o.x = v[i].x * rs * gg.x; o.y = v[i].y * rs * gg.y; o.z = v[i].z * rs * gg.z; o.w = v[i].w * rs * gg.w;
      if (!dry) *(float4*)(xr + i * 256 + lane * 4) = o;
    }
  }
}

template <int TJ, bool SWAP, int NK, class Epi>
DI void gemm_phase(const u16* __restrict__ A, size_t strideAz, int lda, const u16* __restrict__ Bt, size_t strideBz, int ldb,
                   int Z, int Mt, int Nt, int GM, int K, char* smem, const Epi& epi, int vt) {
  constexpr int BN = 64 * TJ;
  constexpr int NB = BN / 32;
  const int tid = otid(), w = tid >> 6, lane = tid & 63, r = lane & 31, h = lane >> 5;
  const int wm = w >> 1, wn = w & 1;
  u16* As = (u16*)smem;
  u16* Bs = As + 2 * 256 * 72;
  const int G = gridDim.x, per = Mt * Nt, total = Z * per;
  const int lrow = tid >> 3, lcc = (tid & 7) * 8;
  unsigned aoff[8], boff[NB];
#pragma unroll
  for (int i = 0; i < 8; ++i) aoff[i] = (unsigned)((lrow + 32 * i) * lda + lcc);
#pragma unroll
  for (int i = 0; i < NB; ++i) boff[i] = (unsigned)((lrow + 32 * i) * ldb + lcc);
  const int lds_st = lrow * 72 + lcc;
  for (int base = 0; base < total; base += G) {
    const int q = base + vt;
    if (q >= total) continue;
    const int z = q / per, qq = q - z * per;
    const int grp = qq / (GM * Nt), within = qq - grp * GM * Nt;
    const int mt = grp * GM + (within % GM), nt = within / GM;
    const u16* Ag = A + z * strideAz + (size_t)(mt * 256) * lda;
    const u16* Bg = Bt + z * strideBz + (size_t)(nt * BN) * ldb;
    u32x4 ra[2][8], rb[2][NB];
    f32x16 acc[4][TJ];
#pragma unroll
    for (int i = 0; i < 4; ++i)
#pragma unroll
      for (int j = 0; j < TJ; ++j)
#pragma unroll
        for (int e = 0; e < 16; ++e) acc[i][j][e] = 0.f;
    __syncthreads();
#pragma unroll
    for (int i = 0; i < 8; ++i) ra[0][i] = *(const u32x4*)(Ag + aoff[i]);
#pragma unroll
    for (int i = 0; i < NB; ++i) rb[0][i] = *(const u32x4*)(Bg + boff[i]);
#pragma unroll
    for (int i = 0; i < 8; ++i) ra[1][i] = *(const u32x4*)(Ag + 64 + aoff[i]);
#pragma unroll
    for (int i = 0; i < NB; ++i) rb[1][i] = *(const u32x4*)(Bg + 64 + boff[i]);
#pragma unroll
    for (int i = 0; i < 8; ++i) *(u32x4*)(As + lds_st + (32 * i) * 72) = ra[0][i];
#pragma unroll
    for (int i = 0; i < NB; ++i) *(u32x4*)(Bs + lds_st + (32 * i) * 72) = rb[0][i];
    __syncthreads();
#pragma unroll
    for (int kt = 0; kt < NK; ++kt) {
      constexpr int dummy = 0; (void)dummy;
      const int u = kt & 1;
      if (kt + 2 < NK) {
        const u16* ag = Ag + (kt + 2) * 64; const u16* bg = Bg + (kt + 2) * 64;
#pragma unroll
        for (int i = 0; i < 8; ++i) ra[u][i] = *(const u32x4*)(ag + aoff[i]);
#pragma unroll
        for (int i = 0; i < NB; ++i) rb[u][i] = *(const u32x4*)(bg + boff[i]);
      }
      const u16* as = As + u * 256 * 72 + (128 * wm + r) * 72 + 8 * h;
      const u16* bs = Bs + u * BN * 72 + (32 * TJ * wn + r) * 72 + 8 * h;
      bf16x8 af[2][4], bfr[2][TJ];
#pragma unroll
      for (int i = 0; i < 4; ++i) af[0][i] = *(const bf16x8*)(as + (32 * i) * 72);
#pragma unroll
      for (int j = 0; j < TJ; ++j) bfr[0][j] = *(const bf16x8*)(bs + (32 * j) * 72);
#pragma unroll
      for (int ks = 0; ks < 4; ++ks) {
        if (ks < 3) {
#pragma unroll
          for (int i = 0; i < 4; ++i) af[(ks + 1) & 1][i] = *(const bf16x8*)(as + (32 * i) * 72 + 16 * (ks + 1));
#pragma unroll
          for (int j = 0; j < TJ; ++j) bfr[(ks + 1) & 1][j] = *(const bf16x8*)(bs + (32 * j) * 72 + 16 * (ks + 1));
        }
        __builtin_amdgcn_sched_barrier(0);
#pragma unroll
        for (int i = 0; i < 4; ++i)
#pragma unroll
          for (int j = 0; j < TJ; ++j)
            acc[i][j] = SWAP ? MFMA32(bfr[ks & 1][j], af[ks & 1][i], acc[i][j]) : MFMA32(af[ks & 1][i], bfr[ks & 1][j], acc[i][j]);
        if (ks == 0 && kt + 1 < NK) {
          u16* ad = As + (u ^ 1) * 256 * 72 + lds_st; u16* bd = Bs + (u ^ 1) * BN * 72 + lds_st;
#pragma unroll
          for (int i = 0; i < 8; ++i) *(u32x4*)(ad + (32 * i) * 72) = ra[u ^ 1][i];
#pragma unroll
          for (int i = 0; i < NB; ++i) *(u32x4*)(bd + (32 * i) * 72) = rb[u ^ 1][i];
#pragma unroll
          for (int i = 0; i < 6; ++i) { __builtin_amdgcn_sched_group_barrier(0x008, 1, 0); __builtin_amdgcn_sched_group_barrier(0x200, 2, 0); }
        }
        __builtin_amdgcn_sched_barrier(0);
      }
      __syncthreads();
    }
#pragma unroll
    for (int i = 0; i < 4; ++i)
#pragma unroll
      for (int j = 0; j < TJ; ++j) {
        if (SWAP) epi(z, mt * 256 + 128 * wm + 32 * i + r, nt * BN + 32 * TJ * wn + 32 * j, h, acc[i][j]);
        else epi(z, mt * 256 + 128 * wm + 32 * i, nt * BN + 32 * TJ * wn + 32 * j + r, h, acc[i][j]);
      }
  }
}

struct EpiStoreBf16 {
  u16* C; int ldc; int ncols; bool dry;
  DI void operator()(int z, int row, int colbase, int h, const f32x16& a) const {
    if (dry) return;
#pragma unroll
    for (int g = 0; g < 4; ++g) {
      const int col = colbase + 8 * g + 4 * h;
      if (col < ncols) {
        u32x2 pk = {pack2(a[4 * g], a[4 * g + 1]), pack2(a[4 * g + 2], a[4 * g + 3])};
        *(u32x2*)(C + (size_t)row * ldc + col) = pk;
      }
    }
  }
};
struct EpiResid {
  const float* xin; float* xout; bool rw; int c; bool dry;
  DI void operator()(int z, int row, int colbase, int h, const f32x16& a) const {
    if (dry) return;
    const size_t o = (size_t)gtok(rw, c, row) * 1024 + colbase + 4 * h;
#pragma unroll
    for (int g = 0; g < 4; ++g) {
      float4 v = *(const float4*)(xin + o + 8 * g);
      v.x += a[4 * g]; v.y += a[4 * g + 1]; v.z += a[4 * g + 2]; v.w += a[4 * g + 3];
      *(float4*)(xout + o + 8 * g) = v;
    }
  }
};
struct EpiUQ {
  u16* Q; const float* cs; const float* sn; int c; bool dry;
  DI void operator()(int z, int row, int colbase, int h, const f32x16& a) const {
    if (dry) return;
    const int head = colbase / 192, db = colbase - head * 192;
    const int lb = row >> 13, s = row & 8191;
    u16* qp = Q + ((size_t)(lb * 12 + head) * 8192 + s) * 192 + db + 4 * h;
    const size_t ti = (size_t)(c * 16384 + row) * 32;
#pragma unroll
    for (int g = 0; g < 4; ++g) {
      float v0 = a[4 * g], v1 = a[4 * g + 1], v2 = a[4 * g + 2], v3 = a[4 * g + 3];
      if (db >= 128) {
        const int pi = (db - 128 + 8 * g + 4 * h) >> 1;
        const float2 cc = *(const float2*)(cs + ti + pi), ss = *(const float2*)(sn + ti + pi);
        const float o0 = v0 * cc.x - v1 * ss.x, o1 = v0 * ss.x + v1 * cc.x;
        const float o2 = v2 * cc.y - v3 * ss.y, o3 = v2 * ss.y + v3 * cc.y;
        v0 = o0; v1 = o1; v2 = o2; v3 = o3;
      }
      u32x2 pk = {pack2(v0, v1), pack2(v2, v3)};
      *(u32x2*)(qp + 8 * g) = pk;
    }
  }
};
struct EpiUK {
  u16* Kb; bool dry;
  DI void operator()(int z, int row, int colbase, int h, const f32x16& a) const {
    if (dry) return;
    const int head = colbase >> 7, db = colbase & 127;
    const int lb = row >> 13, s = row & 8191;
    u16* kp = Kb + ((size_t)(lb * 12 + head) * 8192 + s) * 192 + db + 4 * h;
#pragma unroll
    for (int g = 0; g < 4; ++g) {
      u32x2 pk = {pack2(a[4 * g], a[4 * g + 1]), pack2(a[4 * g + 2], a[4 * g + 3])};
      *(u32x2*)(kp + 8 * g) = pk;
    }
  }
};
struct EpiUV {
  u16* Vt; bool dry;
  DI void operator()(int z, int rowbase, int col, int h, const f32x16& a) const {
    if (dry) return;
    const int head = col >> 7, d = col & 127;
#pragma unroll
    for (int g = 0; g < 4; ++g) {
      int lr = rowbase + 8 * g + 4 * h; int lb = lr >> 13, s = lr & 8191;
      u32x2 pk = {pack2(a[4 * g], a[4 * g + 1]), pack2(a[4 * g + 2], a[4 * g + 3])};
      *(u32x2*)(Vt + (((size_t)(lb * 12 + head) * 128 + (s >> 6)) * 128 + d) * 64 + (s & 63)) = pk;
    }
  }
};
struct EpiMemKV {
  u16* MK; u16* MVt; bool dry;
  DI void operator()(int z, int rowbase, int col, int h, const f32x16& a) const {
    if (col < 512) {
      const int xh = col >> 7, d = col & 127;
#pragma unroll
      for (int e = 0; e < 16; ++e) {
        int m = rowbase + crow(e, h); int b = m >> 8, mi = m & 255;
        MK[((size_t)((z * 4 + b) * 4 + xh) * 256 + mi) * 128 + d] = f2bf(a[e]);
      }
    } else {
      const int n = col - 512, xh = n >> 7, d = n & 127;
#pragma unroll
      for (int g = 0; g < 4; ++g) {
        int m = rowbase + 8 * g + 4 * h; int b = m >> 8, mi = m & 255;
        uint2 pk; pk.x = pack2(a[4 * g], a[4 * g + 1]); pk.y = pack2(a[4 * g + 2], a[4 * g + 3]);
        *(uint2*)(MVt + (((size_t)((z * 4 + b) * 4 + xh) * 4 + (mi >> 6)) * 128 + d) * 64 + (mi & 63)) = pk;
      }
    }
  }
};

DI void phase_kvprep(const Params& p, int L, int c, bool dry) {
  const int tid = otid(), w = tid >> 6, lane = tid & 63;
  const int j = L >> 1;
  u16* U = (u16*)(p.ws + OFF_U); u16* Kb = (u16*)(p.ws + OFF_K);
  const float* cs = (const float*)(p.ws + OFF_COS); const float* sn = (const float*)(p.ws + OFF_SIN);
  for (int lr = blockIdx.x * 4 + w; lr < TC; lr += gridDim.x * 4) {
    u16* row = U + (size_t)lr * LDU_M;
    float fq[8], fk[8]; float sq = 0.f, sk = 0.f;
    if (lane < 48) { uint4 v = *(const uint4*)(row + M_CQ + lane * 8); unpack8(v, fq);
#pragma unroll
      for (int e = 0; e < 8; ++e) sq += fq[e] * fq[e]; }
    if (lane < 32) { uint4 v = *(const uint4*)(row + M_CKV + lane * 8); unpack8(v, fk);
#pragma unroll
      for (int e = 0; e < 8; ++e) sk += fk[e] * fk[e]; }
    sq = wave_sum(sq); sk = wave_sum(sk);
    float rq = rsqrtf(sq * (1.f / 384.f) + 1e-6f), rk = rsqrtf(sk * (1.f / 256.f) + 1e-6f);
    if (dry) continue;
    if (lane < 48) {
      const float* g = p.q_norm_g + j * 384 + lane * 8;
#pragma unroll
      for (int e = 0; e < 8; ++e) fq[e] = fq[e] * rq * g[e];
      *(uint4*)(row + M_CQ + lane * 8) = pack8(fq);
    }
    if (lane < 32) {
      const float* g = p.kv_norm_g + j * 256 + lane * 8;
#pragma unroll
      for (int e = 0; e < 8; ++e) fk[e] = fk[e] * rk * g[e];
      *(uint4*)(row + M_CKV + lane * 8) = pack8(fk);
    }
    if (lane < 8) {
      float f[8], o[8]; uint4 v = *(const uint4*)(row + M_KR + lane * 8); unpack8(v, f);
      int gt = c * 16384 + lr;
#pragma unroll
      for (int i = 0; i < 4; ++i) {
        float cc = cs[gt * 32 + lane * 4 + i], ss = sn[gt * 32 + lane * 4 + i];
        o[2 * i] = f[2 * i] * cc - f[2 * i + 1] * ss; o[2 * i + 1] = f[2 * i] * ss + f[2 * i + 1] * cc;
      }
      uint4 pk = pack8(o);
      int lb = lr >> 13, s = lr & 8191;
#pragma unroll
      for (int hd = 0; hd < 12; ++hd) *(uint4*)(Kb + ((size_t)(lb * 12 + hd) * 8192 + s) * 192 + 128 + lane * 8) = pk;
    }
  }
}

template <int DQK>
DI void attn_item(const u16* __restrict__ Qp, int ldq, const u16* __restrict__ Kp, const u16* __restrict__ Vtp, int ldv,
                  int nkt, int q0, bool causal, float c, u16* Yp, int ldy, char* smem, bool dry) {
  constexpr int KLD = DQK + 8;
  constexpr int NKC = DQK * 64 / 8 / 256;
  constexpr int NKS = DQK / 16;
  constexpr int CPR = DQK / 8;
  constexpr int BUFE = 64 * KLD + 128 * 72;
  u16* L0 = (u16*)smem;
  const int tid = otid(), w = tid >> 6, lane = tid & 63, r = lane & 31, h = lane >> 5;
  bf16x8 qf[NKS];
  {
    const u16* qrow = Qp + (size_t)(32 * w + r) * ldq + 8 * h;
#pragma unroll
    for (int ks = 0; ks < NKS; ++ks) qf[ks] = *(const bf16x8*)(qrow + 16 * ks);
  }
  f32x16 o[4];
#pragma unroll
  for (int dt = 0; dt < 4; ++dt)
#pragma unroll
    for (int e = 0; e < 16; ++e) o[dt][e] = 0.f;
  float m = -INFINITY, l = 0.f;
  u32x4 kst[NKC], vst[4];
  const int vd = tid >> 3, vc8 = tid & 7;
  int kso[NKC];
#pragma unroll
  for (int i = 0; i < NKC; ++i) { int id = tid + 256 * i; int row = id / CPR, cc = id - row * CPR; kso[i] = row * KLD + cc * 8; }
  const int vso = 64 * KLD + vd * 72 + 16 * (vc8 >> 1) + 4 * (vc8 & 1);
  __syncthreads();
#pragma unroll
  for (int i = 0; i < NKC; ++i) kst[i] = *(const u32x4*)(Kp + (size_t)(tid + 256 * i) * 8);
#pragma unroll
  for (int i = 0; i < 4; ++i) vst[i] = *(const u32x4*)(Vtp + (size_t)(tid + 256 * i) * 8);
#pragma unroll
  for (int i = 0; i < NKC; ++i) *(u32x4*)(L0 + kso[i]) = kst[i];
#pragma unroll
  for (int i = 0; i < 4; ++i) {
    u16* dst = L0 + vso + (32 * i) * 72;
    u32x2 lo = {vst[i].x, vst[i].y}, hi = {vst[i].z, vst[i].w};
    *(u32x2*)dst = lo; *(u32x2*)(dst + 8) = hi;
  }
  if (nkt > 1) {
    const u16* kg = Kp + (size_t)64 * DQK;
#pragma unroll
    for (int i = 0; i < NKC; ++i) kst[i] = *(const u32x4*)(kg + (size_t)(tid + 256 * i) * 8);
#pragma unroll
    for (int i = 0; i < 4; ++i) vst[i] = *(const u32x4*)(Vtp + 8192 + (size_t)(tid + 256 * i) * 8);
  }
  __syncthreads();
  const int qmin = q0 + 32 * w;
  for (int kt = 0; kt < nkt; ++kt) {
    const u16* Ks = L0 + (kt & 1) * BUFE;
    const u16* Vs = Ks + 64 * KLD;
    u16* Ln = L0 + ((kt + 1) & 1) * BUFE;
    const bool active = !(causal && kt * 64 > qmin + 31);
    f32x16 s0, s1;
#pragma unroll
    for (int e = 0; e < 16; ++e) { s0[e] = 0.f; s1[e] = 0.f; }
    const u16* k0 = Ks + r * KLD + 8 * h;
    bf16x8 ka[2][2];
    if (active) {
      ka[0][0] = *(const bf16x8*)(k0); ka[0][1] = *(const bf16x8*)(k0 + 32 * KLD);
      ka[1][0] = *(const bf16x8*)(k0 + 16); ka[1][1] = *(const bf16x8*)(k0 + 32 * KLD + 16);
      __builtin_amdgcn_sched_barrier(0);
      s0 = MFMA32(ka[0][0], qf[0], s0); s1 = MFMA32(ka[0][1], qf[0], s1);
    }
    if (kt + 1 < nkt) {
#pragma unroll
      for (int i = 0; i < NKC; ++i) *(u32x4*)(Ln + kso[i]) = kst[i];
#pragma unroll
      for (int i = 0; i < 4; ++i) {
        u16* dst = Ln + vso + (32 * i) * 72;
        u32x2 lo = {vst[i].x, vst[i].y}, hi = {vst[i].z, vst[i].w};
        *(u32x2*)dst = lo; *(u32x2*)(dst + 8) = hi;
      }
    }
    if (kt + 2 < nkt) {
      const u16* kg = Kp + (size_t)(kt + 2) * 64 * DQK;
#pragma unroll
      for (int i = 0; i < NKC; ++i) kst[i] = *(const u32x4*)(kg + (size_t)(tid + 256 * i) * 8);
#pragma unroll
      for (int i = 0; i < 4; ++i) vst[i] = *(const u32x4*)(Vtp + (size_t)(kt + 2) * 8192 + (size_t)(tid + 256 * i) * 8);
    }
    if (active) {
      __builtin_amdgcn_sched_barrier(0);
#pragma unroll
      for (int ks = 1; ks < NKS; ++ks) {
        if (ks + 1 < NKS) {
          ka[(ks + 1) & 1][0] = *(const bf16x8*)(k0 + 16 * (ks + 1));
          ka[(ks + 1) & 1][1] = *(const bf16x8*)(k0 + 32 * KLD + 16 * (ks + 1));
        }
        __builtin_amdgcn_sched_barrier(0);
        s0 = MFMA32(ka[ks & 1][0], qf[ks], s0); s1 = MFMA32(ka[ks & 1][1], qf[ks], s1);
        __builtin_amdgcn_sched_barrier(0);
      }
      const u16* v0 = Vs + r * 72 + 8 * h;
      bf16x8 va[2][4];
#pragma unroll
      for (int dt = 0; dt < 4; ++dt) va[0][dt] = *(const bf16x8*)(v0 + (32 * dt) * 72);
      if (causal && kt * 64 + 63 > qmin) {
        const int qi = qmin + r;
#pragma unroll
        for (int e = 0; e < 16; ++e) {
          int key = kt * 64 + crow(e, h);
          if (key > qi) s0[e] = -INFINITY;
          if (key + 32 > qi) s1[e] = -INFINITY;
        }
      }
      float mx = fmaxf(s0[0], s1[0]);
#pragma unroll
      for (int e = 1; e < 16; ++e) mx = fmaxf(mx, fmaxf(s0[e], s1[e]));
      mx = fmaxf(mx, __shfl_xor(mx, 32));
      if (__builtin_amdgcn_ballot_w64((mx - m) * c > 8.f) != 0ull) {
        const float mn = fmaxf(m, mx);
        const float alpha = ex2((m - mn) * c);
        m = mn;
        l *= alpha;
#pragma unroll
        for (int dt = 0; dt < 4; ++dt)
#pragma unroll
          for (int e = 0; e < 16; ++e) o[dt][e] *= alpha;
      }
      const float mc = m * c;
      float ps = 0.f;
#pragma unroll
      for (int e = 0; e < 16; ++e) { s0[e] = ex2(fmaf(s0[e], c, -mc)); s1[e] = ex2(fmaf(s1[e], c, -mc)); ps += s0[e] + s1[e]; }
      l += ps;
      bf16x8 pf[4];
      {
        u32x4 t;
        t.x = pack2(s0[0], s0[1]); t.y = pack2(s0[2], s0[3]); t.z = pack2(s0[4], s0[5]); t.w = pack2(s0[6], s0[7]); pf[0] = __builtin_bit_cast(bf16x8, t);
        t.x = pack2(s0[8], s0[9]); t.y = pack2(s0[10], s0[11]); t.z = pack2(s0[12], s0[13]); t.w = pack2(s0[14], s0[15]); pf[1] = __builtin_bit_cast(bf16x8, t);
        t.x = pack2(s1[0], s1[1]); t.y = pack2(s1[2], s1[3]); t.z = pack2(s1[4], s1[5]); t.w = pack2(s1[6], s1[7]); pf[2] = __builtin_bit_cast(bf16x8, t);
        t.x = pack2(s1[8], s1[9]); t.y = pack2(s1[10], s1[11]); t.z = pack2(s1[12], s1[13]); t.w = pack2(s1[14], s1[15]); pf[3] = __builtin_bit_cast(bf16x8, t);
      }
#pragma unroll
      for (int kk = 0; kk < 4; ++kk) {
        if (kk < 3) {
#pragma unroll
          for (int dt = 0; dt < 4; ++dt) va[(kk + 1) & 1][dt] = *(const bf16x8*)(v0 + (32 * dt) * 72 + 16 * (kk + 1));
        }
        __builtin_amdgcn_sched_barrier(0);
#pragma unroll
        for (int dt = 0; dt < 4; ++dt) o[dt] = MFMA32(va[kk & 1][dt], pf[kk], o[dt]);
        __builtin_amdgcn_sched_barrier(0);
      }
    }
    __syncthreads();
  }
  const float lt = l + __shfl_xor(l, 32);
  const float inv = 1.f / lt;
  if (dry) return;
  u16* yrow = Yp + (size_t)(32 * w + r) * ldy;
#pragma unroll
  for (int dt = 0; dt < 4; ++dt)
#pragma unroll
    for (int g = 0; g < 4; ++g) {
      const int d = 32 * dt + 8 * g + 4 * h;
      uint2 gv = *(const uint2*)(yrow + d);
      float g0 = bf2f(gv.x & 0xffffu), g1 = bf2f(gv.x >> 16), g2 = bf2f(gv.y & 0xffffu), g3 = bf2f(gv.y >> 16);
      uint2 ov;
      ov.x = pack2(o[dt][4 * g] * inv * silu(g0), o[dt][4 * g + 1] * inv * silu(g1));
      ov.y = pack2(o[dt][4 * g + 2] * inv * silu(g2), o[dt][4 * g + 3] * inv * silu(g3));
      *(uint2*)(yrow + d) = ov;
    }
}

template <int DQK>
DI void attn_item_c(const u16* __restrict__ Qp, int ldq, const u16* __restrict__ Kp, const u16* __restrict__ Vtp, int ldv,
                    int nkt, int q0, float c, u16* Yp, int ldy, char* smem, bool dry) {
  constexpr int KLD = DQK + 8;
  constexpr int NKC = DQK * 64 / 8 / 256;
  constexpr int NKS = DQK / 16;
  constexpr int CPR = DQK / 8;
  constexpr int BUFE = 64 * KLD + 128 * 72;
  u16* L0 = (u16*)smem;
  const int tid = otid(), w = tid >> 6, lane = tid & 63, r = lane & 31, h = lane >> 5;
  bf16x8 qf[NKS];
  {
    const u16* qrow = Qp + (size_t)(32 * w + r) * ldq + 8 * h;
#pragma unroll
    for (int ks = 0; ks < NKS; ++ks) qf[ks] = *(const bf16x8*)(qrow + 16 * ks);
  }
  f32x16 o[4];
#pragma unroll
  for (int dt = 0; dt < 4; ++dt)
#pragma unroll
    for (int e = 0; e < 16; ++e) o[dt][e] = 0.f;
  float m = -INFINITY, l = 0.f;
  u32x4 kstA[NKC], vstA[4], kstB[NKC], vstB[4];
  const int vd = tid >> 3, vc8 = tid & 7;
  int kso[NKC];
#pragma unroll
  for (int i = 0; i < NKC; ++i) { int id = tid + 256 * i; int row = id / CPR, cc = id - row * CPR; kso[i] = row * KLD + cc * 8; }
  const int vso = 64 * KLD + vd * 72 + 16 * (vc8 >> 1) + 4 * (vc8 & 1);
  const int nktp = (nkt + 3) & ~3;
  auto gload = [&](u32x4* ks_, u32x4* vs_, int j) {
    const u16* kg = Kp + (size_t)(j + 1) * 64 * DQK;
#pragma unroll
    for (int i = 0; i < NKC; ++i) ks_[i] = *(const u32x4*)(kg + (size_t)(tid + 256 * i) * 8);
#pragma unroll
    for (int i = 0; i < 4; ++i) vs_[i] = *(const u32x4*)(Vtp + (size_t)j * 8192 + (size_t)(tid + 256 * i) * 8);
  };
  auto lstore = [&](const u32x4* ks_, const u32x4* vs_, u16* Lb) {
#pragma unroll
    for (int i = 0; i < NKC; ++i) *(u32x4*)(Lb + kso[i]) = ks_[i];
#pragma unroll
    for (int i = 0; i < 4; ++i) {
      u16* dst = Lb + vso + (32 * i) * 72;
      u32x2 lo = {vs_[i].x, vs_[i].y}, hi = {vs_[i].z, vs_[i].w};
      *(u32x2*)dst = lo; *(u32x2*)(dst + 8) = hi;
    }
  };
  __syncthreads();
  gload(kstA, vstA, 0);
  gload(kstB, vstB, 1);
  f32x16 sa0, sa1, sb0, sb1;
#pragma unroll
  for (int e = 0; e < 16; ++e) { sa0[e] = 0.f; sa1[e] = 0.f; }
  {
    const u16* kr = Kp + (size_t)r * DQK + 8 * h;
#pragma unroll
    for (int ks = 0; ks < NKS; ++ks) {
      bf16x8 a0 = *(const bf16x8*)(kr + 16 * ks), a1 = *(const bf16x8*)(kr + 32 * DQK + 16 * ks);
      sa0 = MFMA32(a0, qf[ks], sa0); sa1 = MFMA32(a1, qf[ks], sa1);
    }
  }
  lstore(kstA, vstA, L0);
  gload(kstA, vstA, 2);
  __syncthreads();
  const int qmin = q0 + 32 * w;
  const int qi = qmin + r;
  auto body = [&](int kt, u32x4* wk, u32x4* wv, f32x16& s0, f32x16& s1, f32x16& n0, f32x16& n1) {
    const u16* Ks = L0 + (kt & 1) * BUFE;
    const u16* Vs = Ks + 64 * KLD;
    u16* Ln = L0 + ((kt + 1) & 1) * BUFE;
    const bool active = !(kt * 64 > qmin + 31);
    if (kt * 64 + 63 > qmin) {
#pragma unroll
      for (int e = 0; e < 16; ++e) {
        int key = kt * 64 + crow(e, h);
        if (key > qi) s0[e] = -INFINITY;
        if (key + 32 > qi) s1[e] = -INFINITY;
      }
    }
    float mx = fmaxf(s0[0], s1[0]);
#pragma unroll
    for (int e = 1; e < 16; ++e) mx = fmaxf(mx, fmaxf(s0[e], s1[e]));
    mx = fmaxf(mx, __shfl_xor(mx, 32));
    if (__builtin_amdgcn_ballot_w64((mx - m) * c > 8.f) != 0ull) {
      const float mn = fmaxf(m, mx);
      const float alpha = ex2((m - mn) * c);
      m = mn;
      l *= alpha;
#pragma unroll
      for (int dt = 0; dt < 4; ++dt)
#pragma unroll
        for (int e = 0; e < 16; ++e) o[dt][e] *= alpha;
    }
    const float mc = m * c;
#pragma unroll
    for (int e = 0; e < 16; ++e) { n0[e] = 0.f; n1[e] = 0.f; }
    const u16* k0 = Ks + r * KLD + 8 * h;
    bf16x8 ka[2][2];
    ka[0][0] = *(const bf16x8*)(k0); ka[0][1] = *(const bf16x8*)(k0 + 32 * KLD);
    bf16x8 pf[4];
    u32x4 pk[4];
    float ps = 0.f;
#pragma unroll
    for (int ks = 0; ks < NKS; ++ks) {
      if (ks + 1 < NKS) {
        ka[(ks + 1) & 1][0] = *(const bf16x8*)(k0 + 16 * (ks + 1));
        ka[(ks + 1) & 1][1] = *(const bf16x8*)(k0 + 32 * KLD + 16 * (ks + 1));
      }
      __builtin_amdgcn_sched_barrier(0);
      n0 = MFMA32(ka[ks & 1][0], qf[ks], n0); n1 = MFMA32(ka[ks & 1][1], qf[ks], n1);
      if (ks < 8) {
#pragma unroll
        for (int e4 = 0; e4 < 4; ++e4) {
          const int e = (4 * ks + e4) & 15;
          if (ks < 4) { s0[e] = ex2(fmaf(s0[e], c, -mc)); ps += s0[e]; }
          else        { s1[e] = ex2(fmaf(s1[e], c, -mc)); ps += s1[e]; }
        }
      }
      if (ks == 1) {
        lstore(wk, wv, Ln);
        gload(wk, wv, kt + 3);
      }
      if (ks == 4)  { pk[0].x = pack2(s0[0], s0[1]);  pk[0].y = pack2(s0[2], s0[3]);   pk[0].z = pack2(s0[4], s0[5]);   pk[0].w = pack2(s0[6], s0[7]); }
      if (ks == 5)  { pk[1].x = pack2(s0[8], s0[9]);  pk[1].y = pack2(s0[10], s0[11]); pk[1].z = pack2(s0[12], s0[13]); pk[1].w = pack2(s0[14], s0[15]); }
      if (ks == 8)  { pk[2].x = pack2(s1[0], s1[1]);  pk[2].y = pack2(s1[2], s1[3]);   pk[2].z = pack2(s1[4], s1[5]);   pk[2].w = pack2(s1[6], s1[7]); }
      if (ks == 9)  { pk[3].x = pack2(s1[8], s1[9]);  pk[3].y = pack2(s1[10], s1[11]); pk[3].z = pack2(s1[12], s1[13]); pk[3].w = pack2(s1[14], s1[15]); }
      __builtin_amdgcn_sched_barrier(0);
    }
    l += ps;
#pragma unroll
    for (int i = 0; i < 4; ++i) pf[i] = __builtin_bit_cast(bf16x8, pk[i]);
    if (active) {
      const u16* v0 = Vs + r * 72 + 8 * h;
      bf16x8 va[2][4];
#pragma unroll
      for (int dt = 0; dt < 4; ++dt) va[0][dt] = *(const bf16x8*)(v0 + (32 * dt) * 72);
#pragma unroll
      for (int kk = 0; kk < 4; ++kk) {
        if (kk < 3) {
#pragma unroll
          for (int dt = 0; dt < 4; ++dt) va[(kk + 1) & 1][dt] = *(const bf16x8*)(v0 + (32 * dt) * 72 + 16 * (kk + 1));
        }
        __builtin_amdgcn_sched_barrier(0);
#pragma unroll
        for (int dt = 0; dt < 4; ++dt) o[dt] = MFMA32(va[kk & 1][dt], pf[kk], o[dt]);
        __builtin_amdgcn_sched_barrier(0);
      }
    }
    __syncthreads();
  };
  for (int kt4 = 0; kt4 < nktp; kt4 += 4) {
    body(kt4 + 0, kstB, vstB, sa0, sa1, sb0, sb1); body(kt4 + 1, kstA, vstA, sb0, sb1, sa0, sa1);
    body(kt4 + 2, kstB, vstB, sa0, sa1, sb0, sb1); body(kt4 + 3, kstA, vstA, sb0, sb1, sa0, sa1);
  }
  const float lt = l + __shfl_xor(l, 32);
  const float inv = 1.f / lt;
  if (dry) return;
  u16* yrow = Yp + (size_t)(32 * w + r) * ldy;
#pragma unroll
  for (int dt = 0; dt < 4; ++dt)
#pragma unroll
    for (int g = 0; g < 4; ++g) {
      const int d = 32 * dt + 8 * g + 4 * h;
      uint2 gv = *(const uint2*)(yrow + d);
      float g0 = bf2f(gv.x & 0xffffu), g1 = bf2f(gv.x >> 16), g2 = bf2f(gv.y & 0xffffu), g3 = bf2f(gv.y >> 16);
      uint2 ov;
      ov.x = pack2(o[dt][4 * g] * inv * silu(g0), o[dt][4 * g + 1] * inv * silu(g1));
      ov.y = pack2(o[dt][4 * g + 2] * inv * silu(g2), o[dt][4 * g + 3] * inv * silu(g3));
      *(uint2*)(yrow + d) = ov;
    }
}

DI void memattn_item(const Params& p, int L, int c, int item, char* smem, bool dry) {
  const bool rw = L & 1;
  const int ldu = rw ? LDU_R : LDU_M, oq = rw ? R_QM : M_QM, og = rw ? R_GATE : M_GATE;
  const int tile = item >> 2, xh = item & 3;
  const int b = gtok(rw, c, tile * 128) >> 13;
  u16* U = (u16*)(p.ws + OFF_U);
  const u16* MK = (const u16*)(p.ws + OFF_MEMK) + (size_t)((L * 4 + b) * 4 + xh) * 256 * 128;
  const u16* MV = (const u16*)(p.ws + OFF_MEMVT) + (size_t)((L * 4 + b) * 4 + xh) * 128 * 256;
  attn_item<128>(U + (size_t)tile * 128 * ldu + oq + xh * 128, ldu, MK, MV, 256, 4, 0, false,
                 0.08838834764831845f * 1.4426950408889634f, U + (size_t)tile * 128 * ldu + og + 1536 + xh * 128, ldu, smem, dry);
}

DI void phase_attn(const Params& p, int L, int c, char* smem, int* s_item, bool dry) {
  int* cnt = (int*)(p.ws + OFF_CNT) + 64 + ((L * 2 + c) * 2 + (dry ? 1 : 0)) * 16;
  u16* U = (u16*)(p.ws + OFF_U);
  const u16* Q = (const u16*)(p.ws + OFF_Q); const u16* Kb = (const u16*)(p.ws + OFF_K); const u16* Vt = (const u16*)(p.ws + OFF_VT);
  const int xcc = (int)(__builtin_amdgcn_s_getreg((3 << 11) | 20) & 7u);
  for (int k = 0; k < 8; ++k) {
    const int x = (xcc + k) & 7;
    for (;;) {
      __syncthreads();
      if (otid() == 0) *s_item = atomicAdd(cnt + x, 1);
      __syncthreads();
      const int item = *s_item;
      if (item >= 192) break;
      const int qt = 63 - (item & 63), bh = 3 * x + (item >> 6);
      const int lb = bh / 12, head = bh - lb * 12;
      const int q0 = qt * 128;
      attn_item_c<192>(Q + ((size_t)(lb * 12 + head) * 8192 + q0) * 192, 192, Kb + (size_t)(lb * 12 + head) * 8192 * 192,
                     Vt + (size_t)(lb * 12 + head) * 128 * 8192, 8192, 2 * (qt + 1), q0,
                     0.07216878364870323f * 1.4426950408889634f,
                     U + (size_t)(lb * 8192 + q0) * LDU_M + M_GATE + head * 128, LDU_M, smem, dry);
    }
  }
  for (;;) {
    __syncthreads();
    if (otid() == 0) *s_item = atomicAdd(cnt + 8, 1);
    __syncthreads();
    const int item = *s_item;
    if (item >= 512) break;
    memattn_item(p, L, c, item, smem, dry);
  }
}

DI void scan_item(const Params& p, int L, int c, int item, char* smem, bool dry) {
  const int tid = otid(), w = tid >> 6, lane = tid & 63, r = lane & 31, h = lane >> 5;
  const int j = L >> 1;
  const int b = item / 48, rem = item - b * 48, head = rem >> 1, half = rem & 1;
  float* PA  = (float*)smem;
  float* LO  = PA;
  float* Vst = PA + 32 * 5 * 64;
  float* Yst = Vst + 32 * 32;
  float* PRM = Yst + 32 * 32;
  float* BON = PRM + 10 * 64;
  u16* A1  = (u16*)(BON + 32);
  u16* W2t = A1 + 2 * 32 * 72;
  const u16* U = (const u16*)(p.ws + OFF_U);
  const u16* BND = (const u16*)(p.ws + OFF_BND);
  u16* YR = (u16*)(p.ws + OFF_YR); u16* BV = (u16*)(p.ws + OFF_BV);
  float* ST = (float*)(p.ws + OFF_ST); float* BS = (float*)(p.ws + OFF_BS);
  float* STATE = (float*)(p.ws + OFF_STATE);
  __syncthreads();
  if (tid < 64) {
    const float* mu = p.mu + j * SHIFTW;
    const int hc = head * 64 + tid;
    PRM[0 * 64 + tid] = mu[R_R + hc]; PRM[1 * 64 + tid] = mu[R_K + hc]; PRM[2 * 64 + tid] = mu[R_WD + tid]; PRM[3 * 64 + tid] = mu[R_AD + tid];
    PRM[4 * 64 + tid] = p.w0[j * 1536 + hc]; PRM[5 * 64 + tid] = p.a0[j * 1536 + hc]; PRM[6 * 64 + tid] = p.k_k[j * 1536 + hc];
    PRM[7 * 64 + tid] = p.k_a[j * 1536 + hc]; PRM[8 * 64 + tid] = p.r_k[j * 1536 + hc];
    PRM[9 * 64 + tid] = (tid < 32) ? mu[R_V + head * 64 + 32 * half + tid] : 0.f;
  }
  for (int e = tid; e < 8192; e += 256) {
    int arr = e >> 12, jj = (e >> 6) & 63, cc = e & 63;
    const float* src = (arr ? p.a2 : p.w2) + (size_t)j * 64 * 1536;
    W2t[(arr * 64 + cc) * 72 + jj] = f2bf(src[jj * 1536 + head * 64 + cc]);
  }
  const int rowl = lane >> 3, ks = lane & 7, row32 = 8 * w + rowl;
  float S[8];
  {
    float* sp = STATE + ((size_t)((b * 24 + head) * 64 + 32 * half + row32)) * 64 + 8 * ks;
#pragma unroll
    for (int i = 0; i < 8; ++i) S[i] = (c == 0) ? 0.f : sp[i];
  }
  const int tt = tid >> 3, cs = tid & 7;
  uint4 Rr_c, Rr_p, Rk_c, Rk_p, Rw_c, Rw_p, Ra_c, Ra_p, Rv_c, Rv_p;
  const uint4 zero4 = {0u, 0u, 0u, 0u};
  auto load_raw = [&](int tc) {
    const int lr = b * 4096 + tc * 32 + tt;
    const int s = c * 4096 + tc * 32 + tt;
    const u16* cur = U + (size_t)lr * LDU_R;
    const u16* prv = (s == 4096 && c == 1) ? (BND + (size_t)b * SHIFTW) : (cur - LDU_R);
    const bool hp = (s != 0);
    Rr_c = *(const uint4*)(cur + R_R + head * 64 + cs * 8);  Rr_p = hp ? *(const uint4*)(prv + R_R + head * 64 + cs * 8) : zero4;
    Rk_c = *(const uint4*)(cur + R_K + head * 64 + cs * 8);  Rk_p = hp ? *(const uint4*)(prv + R_K + head * 64 + cs * 8) : zero4;
    Rw_c = *(const uint4*)(cur + R_WD + cs * 8);             Rw_p = hp ? *(const uint4*)(prv + R_WD + cs * 8) : zero4;
    Ra_c = *(const uint4*)(cur + R_AD + cs * 8);             Ra_p = hp ? *(const uint4*)(prv + R_AD + cs * 8) : zero4;
    const int vo = R_V + head * 64 + 32 * half + (cs & 3) * 8;
    Rv_c = *(const uint4*)(cur + vo);                        Rv_p = hp ? *(const uint4*)(prv + vo) : zero4;
  };
  load_raw(0);
  __syncthreads();
  for (int tc = 0; tc < 128; ++tc) {
    const int lr = b * 4096 + tc * 32 + tt;
    float rm[8], km[8];
    {
      float cu[8], pv[8], t8[8];
      unpack8(Rr_c, cu); unpack8(Rr_p, pv);
#pragma unroll
      for (int e = 0; e < 8; ++e) rm[e] = cu[e] + (pv[e] - cu[e]) * PRM[0 * 64 + cs * 8 + e];
      unpack8(Rk_c, cu); unpack8(Rk_p, pv);
#pragma unroll
      for (int e = 0; e < 8; ++e) km[e] = cu[e] + (pv[e] - cu[e]) * PRM[1 * 64 + cs * 8 + e];
      unpack8(Rw_c, cu); unpack8(Rw_p, pv);
#pragma unroll
      for (int e = 0; e < 8; ++e) {
        float xw = cu[e] + (pv[e] - cu[e]) * PRM[2 * 64 + cs * 8 + e];
        float ee = ex2(xw * 2.8853900817779268f);
        t8[e] = 1.f - 2.f * frcp(ee + 1.f);
      }
      *(uint4*)(A1 + (0 * 32 + tt) * 72 + cs * 8) = pack8(t8);
      unpack8(Ra_c, cu); unpack8(Ra_p, pv);
#pragma unroll
      for (int e = 0; e < 8; ++e) t8[e] = cu[e] + (pv[e] - cu[e]) * PRM[3 * 64 + cs * 8 + e];
      *(uint4*)(A1 + (1 * 32 + tt) * 72 + cs * 8) = pack8(t8);
      unpack8(Rv_c, cu); unpack8(Rv_p, pv);
      if (cs < 4) {
#pragma unroll
        for (int e = 0; e < 8; ++e) Vst[tt * 32 + cs * 8 + e] = cu[e] + (pv[e] - cu[e]) * PRM[9 * 64 + cs * 8 + e];
      }
    }
    __syncthreads();
    {
      const int arr = w >> 1, nt = w & 1;
      f32x16 acc;
#pragma unroll
      for (int e = 0; e < 16; ++e) acc[e] = 0.f;
#pragma unroll
      for (int k4 = 0; k4 < 4; ++k4) {
        bf16x8 a = *(const bf16x8*)(A1 + (arr * 32 + r) * 72 + 16 * k4 + 8 * h);
        bf16x8 bw = *(const bf16x8*)(W2t + (arr * 64 + 32 * nt + r) * 72 + 16 * k4 + 8 * h);
        acc = MFMA32(a, bw, acc);
      }
#pragma unroll
      for (int e = 0; e < 16; ++e) LO[(arr * 32 + crow(e, h)) * 64 + 32 * nt + r] = acc[e];
    }
    __syncthreads();
    float lw[8], la[8];
    {
      float4 t0 = *(const float4*)(LO + (0 * 32 + tt) * 64 + cs * 8), t1 = *(const float4*)(LO + (0 * 32 + tt) * 64 + cs * 8 + 4);
      lw[0] = t0.x; lw[1] = t0.y; lw[2] = t0.z; lw[3] = t0.w; lw[4] = t1.x; lw[5] = t1.y; lw[6] = t1.z; lw[7] = t1.w;
      t0 = *(const float4*)(LO + (1 * 32 + tt) * 64 + cs * 8); t1 = *(const float4*)(LO + (1 * 32 + tt) * 64 + cs * 8 + 4);
      la[0] = t0.x; la[1] = t0.y; la[2] = t0.z; la[3] = t0.w; la[4] = t1.x; la[5] = t1.y; la[6] = t1.z; la[7] = t1.w;
    }
    __syncthreads();
    {
      float dec[8], kk[8], av[8], kp[8];
      float ssq = 0.f, bon = 0.f;
#pragma unroll
      for (int e = 0; e < 8; ++e) {
        const int ch = cs * 8 + e;
        float xx = -(lw[e] + PRM[4 * 64 + ch]);
        float sp = fmaxf(xx, 0.f) + __logf(1.f + fexp(-fabsf(xx)));
        float wv = -sp - 0.5f;
        dec[e] = fexp(-fexp(wv));
        float a = frcp(1.f + fexp(-(la[e] + PRM[5 * 64 + ch])));
        av[e] = a;
        kk[e] = km[e] * PRM[6 * 64 + ch];
        ssq += kk[e] * kk[e];
        kp[e] = km[e] * (1.f + (a - 1.f) * PRM[7 * 64 + ch]);
        bon += rm[e] * kp[e] * PRM[8 * 64 + ch];
      }
      ssq = red8(ssq); bon = red8(bon);
      const float inv = 1.f / fmaxf(sqrtf(ssq), 1e-12f);
      float nk[8], bb[8];
#pragma unroll
      for (int e = 0; e < 8; ++e) { float kn = kk[e] * inv; nk[e] = -kn; bb[e] = kn * av[e]; }
      float* pa = PA + tt * 320 + cs * 8;
      *(float4*)(pa) = make_float4(dec[0], dec[1], dec[2], dec[3]); *(float4*)(pa + 4) = make_float4(dec[4], dec[5], dec[6], dec[7]);
      *(float4*)(pa + 64) = make_float4(nk[0], nk[1], nk[2], nk[3]); *(float4*)(pa + 68) = make_float4(nk[4], nk[5], nk[6], nk[7]);
      *(float4*)(pa + 128) = make_float4(bb[0], bb[1], bb[2], bb[3]); *(float4*)(pa + 132) = make_float4(bb[4], bb[5], bb[6], bb[7]);
      *(float4*)(pa + 192) = make_float4(kp[0], kp[1], kp[2], kp[3]); *(float4*)(pa + 196) = make_float4(kp[4], kp[5], kp[6], kp[7]);
      *(float4*)(pa + 256) = make_float4(rm[0], rm[1], rm[2], rm[3]); *(float4*)(pa + 260) = make_float4(rm[4], rm[5], rm[6], rm[7]);
      if (cs == 0) BON[tt] = bon;
    }
    __syncthreads();
    if (tc + 1 < 128) load_raw(tc + 1);
    {
      const float* pa0 = PA + ks * 8;
      const float* vs0 = Vst + row32;
      float4 d0 = *(const float4*)(pa0), d1 = *(const float4*)(pa0 + 4);
      float4 n0 = *(const float4*)(pa0 + 64), n1 = *(const float4*)(pa0 + 68);
      float4 b0 = *(const float4*)(pa0 + 128), b1 = *(const float4*)(pa0 + 132);
      float4 k0 = *(const float4*)(pa0 + 192), k1 = *(const float4*)(pa0 + 196);
      float4 r0 = *(const float4*)(pa0 + 256), r1 = *(const float4*)(pa0 + 260);
      float vv = vs0[0];
#pragma unroll 2
      for (int t = 0; t < 32; ++t) {
        const float* pa = pa0 + (t + 1) * 320;
        const float4 xd0 = *(const float4*)(pa), xd1 = *(const float4*)(pa + 4);
        const float4 xn0 = *(const float4*)(pa + 64), xn1 = *(const float4*)(pa + 68);
        const float4 xb0 = *(const float4*)(pa + 128), xb1 = *(const float4*)(pa + 132);
        const float4 xk0 = *(const float4*)(pa + 192), xk1 = *(const float4*)(pa + 196);
        const float4 xr0 = *(const float4*)(pa + 256), xr1 = *(const float4*)(pa + 260);
        const float xvv = vs0[(t + 1) * 32];
        __builtin_amdgcn_sched_barrier(0);
        float sa0 = S[0] * n0.x, sa1 = S[1] * n0.y;
        sa0 = fmaf(S[2], n0.z, sa0); sa1 = fmaf(S[3], n0.w, sa1);
        sa0 = fmaf(S[4], n1.x, sa0); sa1 = fmaf(S[5], n1.y, sa1);
        sa0 = fmaf(S[6], n1.z, sa0); sa1 = fmaf(S[7], n1.w, sa1);
        float sa = red8(sa0 + sa1);
        S[0] = fmaf(sa, b0.x, fmaf(S[0], d0.x, vv * k0.x)); S[1] = fmaf(sa, b0.y, fmaf(S[1], d0.y, vv * k0.y));
        S[2] = fmaf(sa, b0.z, fmaf(S[2], d0.z, vv * k0.z)); S[3] = fmaf(sa, b0.w, fmaf(S[3], d0.w, vv * k0.w));
        S[4] = fmaf(sa, b1.x, fmaf(S[4], d1.x, vv * k1.x)); S[5] = fmaf(sa, b1.y, fmaf(S[5], d1.y, vv * k1.y));
        S[6] = fmaf(sa, b1.z, fmaf(S[6], d1.z, vv * k1.z)); S[7] = fmaf(sa, b1.w, fmaf(S[7], d1.w, vv * k1.w));
        float y0 = S[0] * r0.x, y1 = S[1] * r0.y;
        y0 = fmaf(S[2], r0.z, y0); y1 = fmaf(S[3], r0.w, y1);
        y0 = fmaf(S[4], r1.x, y0); y1 = fmaf(S[5], r1.y, y1);
        y0 = fmaf(S[6], r1.z, y0); y1 = fmaf(S[7], r1.w, y1);
        float y = red8(y0 + y1);
        if (ks == 0) Yst[t * 32 + row32] = y;
        __builtin_amdgcn_sched_barrier(0);
        d0 = xd0; d1 = xd1; n0 = xn0; n1 = xn1; b0 = xb0; b1 = xb1; k0 = xk0; k1 = xk1; r0 = xr0; r1 = xr1; vv = xvv;
      }
    }
    __syncthreads();
    {
      const int c4 = cs & 3;
      float y8[8], v8[8];
      float4 t0 = *(const float4*)(Yst + tt * 32 + c4 * 8), t1 = *(const float4*)(Yst + tt * 32 + c4 * 8 + 4);
      y8[0] = t0.x; y8[1] = t0.y; y8[2] = t0.z; y8[3] = t0.w; y8[4] = t1.x; y8[5] = t1.y; y8[6] = t1.z; y8[7] = t1.w;
      float sm = 0.f, sq = 0.f;
#pragma unroll
      for (int e = 0; e < 8; ++e) { sm += y8[e]; sq += y8[e] * y8[e]; }
      sm = red4(sm); sq = red4(sq);
      const float bon = BON[tt];
      t0 = *(const float4*)(Vst + tt * 32 + c4 * 8); t1 = *(const float4*)(Vst + tt * 32 + c4 * 8 + 4);
      v8[0] = t0.x * bon; v8[1] = t0.y * bon; v8[2] = t0.z * bon; v8[3] = t0.w * bon; v8[4] = t1.x * bon; v8[5] = t1.y * bon; v8[6] = t1.z * bon; v8[7] = t1.w * bon;
      if (cs < 4 && !dry) {
        const size_t o = (size_t)lr * 1536 + head * 64 + 32 * half + cs * 8;
        *(uint4*)(YR + o) = pack8(y8);
        *(uint4*)(BV + o) = pack8(v8);
        if (cs == 0) {
          float* stp = ST + ((size_t)(lr * 24 + head) * 2 + half) * 2;
          stp[0] = sm; stp[1] = sq;
        }
      }
    }
  }
  if (c == 0 && !dry) {
    float* sp = STATE + ((size_t)((b * 24 + head) * 64 + 32 * half + row32)) * 64 + 8 * ks;
#pragma unroll
    for (int i = 0; i < 8; ++i) sp[i] = S[i];
  }
}

DI void phase_scan(const Params& p, int L, int c, char* smem, int* s_item, bool dry) {
  for (int item = blockIdx.x; item < 192; item += gridDim.x) scan_item(p, L, c, item, smem, dry);
  int* cnt = (int*)(p.ws + OFF_CNT) + 64 + ((L * 2 + c) * 2 + (dry ? 1 : 0)) * 16 + 8;
  for (;;) {
    __syncthreads();
    if (otid() == 0) *s_item = atomicAdd(cnt, 1);
    __syncthreads();
    const int item = *s_item;
    if (item >= 512) break;
    memattn_item(p, L, c, item, smem, dry);
  }
}

DI void phase_finalize(const Params& p, int L, int c, bool dry) {
  const int j = L >> 1;
  u16* U = (u16*)(p.ws + OFF_U);
  const u16* YR = (const u16*)(p.ws + OFF_YR); const u16* BV = (const u16*)(p.ws + OFF_BV);
  const float* ST = (const float*)(p.ws + OFF_ST);
  const int G = gridDim.x;
  for (int idx = blockIdx.x * 256 + otid(); idx < TC * 192; idx += G * 256) {
    const int lr = idx / 192, c8 = idx - lr * 192, ch0 = c8 * 8, head = ch0 >> 6;
    const float4 st = *(const float4*)(ST + (size_t)(lr * 24 + head) * 4);
    const float mean = (st.x + st.z) * (1.f / 64.f);
    const float var = (st.y + st.w) * (1.f / 64.f) - mean * mean;
    const float rstd = rsqrtf(fmaxf(var, 0.f) + 64e-5f);
    float y[8], bv[8], g[8], o[8];
    unpack8(*(const uint4*)(YR + (size_t)lr * 1536 + ch0), y);
    unpack8(*(const uint4*)(BV + (size_t)lr * 1536 + ch0), bv);
    u16* gp = U + (size_t)lr * LDU_R + R_GATE + ch0;
    unpack8(*(const uint4*)gp, g);
    const float* gw = p.gn_w + j * 1536 + ch0; const float* gb = p.gn_b + j * 1536 + ch0;
#pragma unroll
    for (int e = 0; e < 8; ++e) o[e] = ((y[e] - mean) * rstd * gw[e] + gb[e] + bv[e]) * silu(g[e]);
    if (!dry) *(uint4*)gp = pack8(o);
  }
  if (c == 0) {
    u16* BND = (u16*)(p.ws + OFF_BND);
    for (int idx = blockIdx.x * 256 + otid(); idx < 4 * (SHIFTW / 8); idx += G * 256) {
      const int b = idx / (SHIFTW / 8), cc = idx - b * (SHIFTW / 8);
      *(uint4*)(BND + (size_t)b * SHIFTW + cc * 8) = *(const uint4*)(U + (size_t)(b * 4096 + 4095) * LDU_R + cc * 8);
    }
  }
}

enum { PH_PREP = 0, PH_NORM, PH_GEMM_IN, PH_KVPREP, PH_GEMM_UP, PH_ATTN, PH_SCAN, PH_FINALIZE, PH_GEMM_OUT, PH_FINAL };
constexpr int NSTEPS = 46;

DI void decode_step(int step, int& ph, int& L, int& c) {
  if (step == 0) { ph = PH_PREP; L = 0; c = 0; return; }
  if (step == NSTEPS - 1) { ph = PH_FINAL; L = 0; c = 0; return; }
  int s = step - 1;
  int pr = s / 22, rem = s - pr * 22;
  if (rem < 12) {
    L = 2 * pr; c = rem / 6; int k = rem - c * 6;
    ph = (k == 0) ? PH_NORM : (k == 1) ? PH_GEMM_IN : (k == 2) ? PH_KVPREP : (k == 3) ? PH_GEMM_UP : (k == 4) ? PH_ATTN : PH_GEMM_OUT;
  } else {
    rem -= 12; L = 2 * pr + 1; c = rem / 5; int k = rem - c * 5;
    ph = (k == 0) ? PH_NORM : (k == 1) ? PH_GEMM_IN : (k == 2) ? PH_SCAN : (k == 3) ? PH_FINALIZE : PH_GEMM_OUT;
  }
}

DI void run_step(const Params& p, int ph, int L, int c, char* smem, int* s_item, bool dry_in, int vt) {
  const bool dry = dry_in && !(HYP5 && (ph == PH_GEMM_IN || ph == PH_GEMM_UP));
  char* ws = p.ws;
  const bool rw = L & 1;
  const int j = L >> 1;
  switch (ph) {
    case PH_PREP: phase_prep(p, smem); break;
    case PH_NORM:
      phase_norm(p, L, c);
      if (L == 0 && c == 0) {
        EpiMemKV epi{(u16*)(ws + OFF_MEMK), (u16*)(ws + OFF_MEMVT), false};
        gemm_phase<2, false, 16>((const u16*)(ws + OFF_MEMH), 1024ull * 1024, 1024, (const u16*)(ws + OFF_WT_MEMKV), 1024ull * 1024, 1024, 4, 4, 8, 4, 1024, smem, epi, vt);
      }
      break;
    case PH_GEMM_IN:
      if (!rw) {
        EpiStoreBf16 epi{(u16*)(ws + OFF_U), LDU_M, LDU_M, dry};
        gemm_phase<2, true, 16>((const u16*)(ws + OFF_H), 0, 1024, (const u16*)(ws + OFF_WT_INMLA) + (size_t)j * 3328 * 1024, 0, 1024, 1, 64, 26, 4, 1024, smem, epi, vt);
      } else {
        EpiStoreBf16 epi{(u16*)(ws + OFF_U), LDU_R, LDU_R, dry};
        gemm_phase<2, true, 16>((const u16*)(ws + OFF_H), 0, 1024, (const u16*)(ws + OFF_WT_INRW) + (size_t)j * 7296 * 1024, 0, 1024, 1, 64, 57, 4, 1024, smem, epi, vt);
      }
      break;
    case PH_KVPREP: phase_kvprep(p, L, c, dry); break;
    case PH_GEMM_UP: {
      EpiUQ e1{(u16*)(ws + OFF_Q), (const float*)(ws + OFF_COS), (const float*)(ws + OFF_SIN), c, dry};
      gemm_phase<2, true, 6>((const u16*)(ws + OFF_U) + M_CQ, 0, LDU_M, (const u16*)(ws + OFF_WT_UQ) + (size_t)j * 2304 * 384, 0, 384, 1, 64, 18, 4, 384, smem, e1, vt);
      EpiUK e2{(u16*)(ws + OFF_K), dry};
      gemm_phase<2, true, 4>((const u16*)(ws + OFF_U) + M_CKV, 0, LDU_M, (const u16*)(ws + OFF_WT_UKV) + (size_t)j * 3072 * 256, 0, 256, 1, 64, 12, 4, 256, smem, e2, vt);
      EpiUV e3{(u16*)(ws + OFF_VT), dry};
      gemm_phase<2, false, 4>((const u16*)(ws + OFF_U) + M_CKV, 0, LDU_M, (const u16*)(ws + OFF_WT_UKV) + (size_t)j * 3072 * 256 + 1536ull * 256, 0, 256, 1, 64, 12, 4, 256, smem, e3, vt);
    } break;
    case PH_ATTN: phase_attn(p, L, c, smem, s_item, dry); break;
    case PH_SCAN: phase_scan(p, L, c, smem, s_item, dry); break;
    case PH_FINALIZE: phase_finalize(p, L, c, dry); break;
    case PH_GEMM_OUT: {
      EpiResid epi{(L == 0) ? p.x : (const float*)p.out, p.out, rw, c, dry};
      gemm_phase<2, true, 32>((const u16*)(ws + OFF_U) + (rw ? R_GATE : M_GATE), 0, rw ? LDU_R : LDU_M, (const u16*)(ws + OFF_WT_OUT) + (size_t)L * 1024 * 2048, 0, 2048,
                 1, 64, 8, 4, 2048, smem, epi, vt);
    } break;
    case PH_FINAL: phase_final_norm(p, dry); break;
  }
}

DI void grid_barrier(unsigned* bar, unsigned& epoch) {
  __syncthreads();
  ++epoch;
  if (threadIdx.x == 0) {
    __builtin_amdgcn_fence(__ATOMIC_RELEASE, "agent");
    asm volatile("s_waitcnt vmcnt(0)" ::: "memory");
    const unsigned target = epoch * gridDim.x;
    __hip_atomic_fetch_add(bar, 1u, __ATOMIC_RELAXED, __HIP_MEMORY_SCOPE_AGENT);
    unsigned spins = 0;
    while (__hip_atomic_load(bar, __ATOMIC_RELAXED, __HIP_MEMORY_SCOPE_AGENT) < target) {
      __builtin_amdgcn_s_sleep(2);
      if (++spins > (1u << 22)) break;
    }
    __builtin_amdgcn_fence(__ATOMIC_ACQUIRE, "agent");
    asm volatile("s_waitcnt vmcnt(0)" ::: "memory");
  }
  __syncthreads();
}

__global__ void __launch_bounds__(256, 1) hybrid_megakernel(Params p, int s_lo, int s_hi, int coop, int probe_mask) {
  __shared__ __attribute__((aligned(16))) char smem[SMEM_BYTES];
  __shared__ int s_item;
  unsigned* bar = (unsigned*)(p.ws + OFF_BAR);
  unsigned epoch = 0;
  if (coop == 2) cg::this_grid().sync();
  __shared__ int s_vt;
  int myx = 0, myrank = 0;
  if (coop && threadIdx.x == 0) {
    myx = (int)(__builtin_amdgcn_s_getreg((3 << 11) | 20) & 7u);
    myrank = (int)__hip_atomic_fetch_add(bar + 16 + myx, 1u, __ATOMIC_RELAXED, __HIP_MEMORY_SCOPE_AGENT);
  }
  int vt = blockIdx.x;
  {
    const int G = gridDim.x, t = blockIdx.x;
    vt = ((G & 7) == 0) ? ((t & 7) * (G >> 3) + (t >> 3)) : t;
  }
  for (int st = s_lo; st < s_hi; ++st) {
    int ph, L, c;
    decode_step(st, ph, L, c);
    for (int rep = ((probe_mask >> ph) & 1) ? 0 : 1; rep < 2; ++rep) {
      run_step(p, ph, L, c, smem, &s_item, rep == 0, vt);
      if (coop && (rep == 0 || st + 1 < s_hi)) grid_barrier(bar, epoch);
      if (coop) for (int xs = 0; xs < EXTRA_SYNCS; ++xs) grid_barrier(bar, epoch);
    }
    if (coop && st == s_lo) {
      if (threadIdx.x == 0) {
        const int G = gridDim.x;
        bool ok = (G & 7) == 0;
        for (int x = 0; x < 8; ++x) ok = ok && ((int)__hip_atomic_load(bar + 16 + x, __ATOMIC_RELAXED, __HIP_MEMORY_SCOPE_AGENT) == (G >> 3));
        s_vt = ok ? (myx * (G >> 3) + myrank) : vt;
      }
      __syncthreads();
      vt = s_vt;
    }
  }
}

extern "C" void kernel_launch(void* const* d_in, const int* in_sizes, int n_in, void* d_out, int out_size, void* d_ws, size_t ws_size,
                              hipStream_t stream) {
  if (ws_size < WS_NEED) { fprintf(stderr, "workspace too small: %zu < %zu\n", ws_size, (size_t)WS_NEED); return; }
  Params p;
  memset(&p, 0, sizeof(p));
  p.x = (const float*)d_in[0]; p.mem = (const float*)d_in[1]; p.pos = (const int*)d_in[2];
  p.norm_g = (const float*)d_in[3]; p.mem_norm_g = (const float*)d_in[4]; p.w_mem_kv = (const float*)d_in[5];
  p.w_in_mla = (const float*)d_in[6]; p.q_norm_g = (const float*)d_in[7]; p.kv_norm_g = (const float*)d_in[8];
  p.w_uq = (const float*)d_in[9]; p.w_ukv = (const float*)d_in[10]; p.w_in_rwkv = (const float*)d_in[11];
  p.mu = (const float*)d_in[12]; p.w0 = (const float*)d_in[13]; p.w2 = (const float*)d_in[14]; p.a0 = (const float*)d_in[15];
  p.a2 = (const float*)d_in[16]; p.k_k = (const float*)d_in[17]; p.k_a = (const float*)d_in[18]; p.r_k = (const float*)d_in[19];
  p.gn_w = (const float*)d_in[20]; p.gn_b = (const float*)d_in[21]; p.w_out = (const float*)d_in[22]; p.final_g = (const float*)d_in[23];
  p.out = (float*)d_out; p.ws = (char*)d_ws;
  static int grid_blocks = 0;
  if (!grid_blocks) {
    int dev = 0, cus = 0, per_cu = 0;
    hipGetDevice(&dev);
    hipDeviceGetAttribute(&cus, hipDeviceAttributeMultiprocessorCount, dev);
    hipOccupancyMaxActiveBlocksPerMultiprocessor(&per_cu, hybrid_megakernel, 256, 0);
    if (per_cu > 2) per_cu = 2;
    if (per_cu < 1) per_cu = 1;
    grid_blocks = cus * per_cu;
  }
#if MULTI_LAUNCH
  for (int s = 0; s < NSTEPS; ++s) hipLaunchKernelGGL(hybrid_megakernel, dim3(grid_blocks), dim3(256), 0, stream, p, s, s + 1, 0, 0);
#else
  int s_lo = 0, s_hi = NSTEPS, coop = 1, probe_mask = PROBE_MASK;
  void* args[] = {&p, &s_lo, &s_hi, &coop, &probe_mask};
  hipMemsetAsync((char*)d_ws + OFF_BAR, 0, 256, stream);
  hipError_t e = hipLaunchCooperativeKernel((void*)hybrid_megakernel, dim3(grid_blocks), dim3(256), args, 0, stream);
  if (e != hipSuccess) fprintf(stderr, "cooperative launch failed: %s (grid %d)\n", hipGetErrorString(e), grid_blocks);
#endif
}
```

```cpp
#include <hip/hip_runtime.h>
#include <hip/hip_cooperative_groups.h>
#include <cstdio>
#include <cstring>
namespace cg = cooperative_groups;

#define PROBE_MASK 0
#define EXTRA_SYNCS 0
#define HYP1 0
#define HYP2 0
#define HYP3 0
#define HYP4 0
#define HYP5 0
#define HYP6 0
#ifndef MULTI_LAUNCH
#define MULTI_LAUNCH 0
#endif

#define DI __device__ __forceinline__
typedef unsigned short u16;
typedef __attribute__((ext_vector_type(8))) short bf16x8;
typedef __attribute__((ext_vector_type(16))) float f32x16;
typedef __attribute__((ext_vector_type(2))) __bf16 bf2_t;
typedef __attribute__((ext_vector_type(2))) float f2_t;
typedef __attribute__((ext_vector_type(4))) unsigned u32x4;
typedef __attribute__((ext_vector_type(2))) unsigned u32x2;
#define MFMA32(a, b, c) __builtin_amdgcn_mfma_f32_32x32x16_bf16((a), (b), (c), 0, 0, 0)

constexpr int SEQ = 8192, TC = 16384;
constexpr int LDU_M = 3264, LDU_R = 7296;
constexpr int M_CQ = 0, M_CKV = 384, M_KR = 640, M_QM = 704, M_GATE = 1216;
constexpr int R_R = 0, R_K = 1536, R_V = 3072, R_WD = 4608, R_AD = 4672, R_QM = 4736, R_GATE = 5248;
constexpr int SHIFTW = 4736;

constexpr size_t OFF_WT_MEMKV = 0;
constexpr size_t OFF_WT_INMLA = OFF_WT_MEMKV + 4ull * 1024 * 1024 * 2;
constexpr size_t OFF_WT_UQ    = OFF_WT_INMLA + 2ull * 3328 * 1024 * 2;
constexpr size_t OFF_WT_UKV   = OFF_WT_UQ + 2ull * 2304 * 384 * 2;
constexpr size_t OFF_WT_INRW  = OFF_WT_UKV + 2ull * 3072 * 256 * 2;
constexpr size_t OFF_WT_OUT   = OFF_WT_INRW + 2ull * 7296 * 1024 * 2;
constexpr size_t OFF_MEMH     = OFF_WT_OUT + 4ull * 1024 * 2048 * 2;
constexpr size_t OFF_MEMK     = OFF_MEMH + 4ull * 1024 * 1024 * 2;
constexpr size_t OFF_MEMVT    = OFF_MEMK + 4ull * 4 * 4 * 256 * 128 * 2;
constexpr size_t OFF_COS      = OFF_MEMVT + 4ull * 4 * 4 * 256 * 128 * 2;
constexpr size_t OFF_SIN      = OFF_COS + 32768ull * 32 * 4;
constexpr size_t OFF_CNT      = OFF_SIN + 32768ull * 32 * 4;
constexpr size_t OFF_BAR      = OFF_CNT + 4096;
constexpr size_t OFF_STATE    = OFF_BAR + 256;
constexpr size_t OFF_BND      = OFF_STATE + 96ull * 4096 * 4;
constexpr size_t OFF_H        = OFF_BND + 4ull * 4736 * 2 + 128;
constexpr size_t OFF_R        = OFF_H + 16384ull * 1024 * 2;
constexpr size_t OFF_U        = OFF_R;
constexpr size_t OFF_Q        = OFF_R + 16384ull * 3264 * 2;
constexpr size_t OFF_K        = OFF_Q + 2ull * 12 * 8192 * 192 * 2;
constexpr size_t OFF_VT       = OFF_K + 2ull * 12 * 8192 * 192 * 2;
constexpr size_t OFF_YR       = OFF_R + 16384ull * 7296 * 2;
constexpr size_t OFF_BV       = OFF_YR + 16384ull * 1536 * 2;
constexpr size_t OFF_ST       = OFF_BV + 16384ull * 1536 * 2;
constexpr size_t OFF_BS       = OFF_ST + 16384ull * 24 * 4 * 4;
constexpr size_t WS_NEED      = OFF_BS + 16384ull * 24 * 4;

constexpr int SMEM_BYTES = 110592;

struct Params {
  const float *x, *mem; const int* pos;
  const float *norm_g, *mem_norm_g, *w_mem_kv, *w_in_mla, *q_norm_g, *kv_norm_g, *w_uq, *w_ukv, *w_in_rwkv;
  const float *mu, *w0, *w2, *a0, *a2, *k_k, *k_a, *r_k, *gn_w, *gn_b, *w_out, *final_g;
  float* out; char* ws;
};

DI int otid() { int t = threadIdx.x; asm volatile("" : "+v"(t)); return t; }
DI float bf2f(unsigned v) { return __uint_as_float(v << 16); }
DI unsigned pack2(float a, float b) { f2_t v = {a, b}; bf2_t r = __builtin_convertvector(v, bf2_t); return __builtin_bit_cast(unsigned, r); }
DI u16 f2bf(float a) { return (u16)(pack2(a, 0.f) & 0xffffu); }
DI float ex2(float x) { return __builtin_amdgcn_exp2f(x); }
DI float fexp(float x) { return __builtin_amdgcn_exp2f(x * 1.4426950408889634f); }
DI float frcp(float x) { return __builtin_amdgcn_rcpf(x); }
DI float silu(float g) { return g * frcp(1.f + fexp(-g)); }
DI float wave_sum(float v) { for (int o = 32; o > 0; o >>= 1) v += __shfl_xor(v, o); return v; }
DI int crow(int reg, int h) { return (reg & 3) + 8 * (reg >> 2) + 4 * h; }
DI float dppf(float x, const int ctrl_sel) {
  int xi;
  if (ctrl_sel == 0) xi = __builtin_amdgcn_update_dpp(0, __float_as_int(x), 0xB1, 0xf, 0xf, true);
  else if (ctrl_sel == 1) xi = __builtin_amdgcn_update_dpp(0, __float_as_int(x), 0x4E, 0xf, 0xf, true);
  else xi = __builtin_amdgcn_update_dpp(0, __float_as_int(x), 0x141, 0xf, 0xf, true);
  return __int_as_float(xi);
}
DI float red4(float x) { x += dppf(x, 0); x += dppf(x, 1); return x; }
DI float red8(float x) { x += dppf(x, 0); x += dppf(x, 1); x += dppf(x, 2); return x; }
DI int gtok(bool rw, int c, int lr) { return rw ? ((lr >> 12) * 8192 + c * 4096 + (lr & 4095)) : (c * 16384 + lr); }
DI void unpack8(const uint4& v, float* f) {
  f[0] = bf2f(v.x & 0xffffu); f[1] = bf2f(v.x >> 16); f[2] = bf2f(v.y & 0xffffu); f[3] = bf2f(v.y >> 16);
  f[4] = bf2f(v.z & 0xffffu); f[5] = bf2f(v.z >> 16); f[6] = bf2f(v.w & 0xffffu); f[7] = bf2f(v.w >> 16);
}
DI uint4 pack8(const float* f) { uint4 v; v.x = pack2(f[0], f[1]); v.y = pack2(f[2], f[3]); v.z = pack2(f[4], f[5]); v.w = pack2(f[6], f[7]); return v; }

DI void transpose_tile(const float* __restrict__ src, u16* __restrict__ dst, int K, int N, int tk, int tn, int drow, float* tile) {
  const int tid = otid();
  __syncthreads();
#pragma unroll
  for (int i = 0; i < 4; ++i) {
    int kr = (tid >> 4) + 16 * i, nc = (tid & 15) * 4;
    float4 v = *(const float4*)(src + (size_t)(tk * 64 + kr) * N + tn * 64 + nc);
    tile[kr * 65 + nc] = v.x; tile[kr * 65 + nc + 1] = v.y; tile[kr * 65 + nc + 2] = v.z; tile[kr * 65 + nc + 3] = v.w;
  }
  __syncthreads();
#pragma unroll
  for (int i = 0; i < 2; ++i) {
    int n = (tid >> 3) + 32 * i, kc = (tid & 7) * 8;
    float f[8];
#pragma unroll
    for (int e = 0; e < 8; ++e) f[e] = tile[(kc + e) * 65 + n];
    *(uint4*)(dst + (size_t)(drow + n) * K + tk * 64 + kc) = pack8(f);
  }
}

DI void rms_row_bf16(const float* __restrict__ src, const float* __restrict__ g, u16* __restrict__ dst, int lane) {
  float4 v[4]; float ss = 0.f;
#pragma unroll
  for (int i = 0; i < 4; ++i) { v[i] = *(const float4*)(src + i * 256 + lane * 4); ss += v[i].x * v[i].x + v[i].y * v[i].y + v[i].z * v[i].z + v[i].w * v[i].w; }
  ss = wave_sum(ss);
  float rs = rsqrtf(ss * (1.f / 1024.f) + 1e-6f);
#pragma unroll
  for (int i = 0; i < 4; ++i) {
    float4 gg = *(const float4*)(g + i * 256 + lane * 4);
    uint2 o; o.x = pack2(v[i].x * rs * gg.x, v[i].y * rs * gg.y); o.y = pack2(v[i].z * rs * gg.z, v[i].w * rs * gg.w);
    *(uint2*)(dst + i * 256 + lane * 4) = o;
  }
}

DI void phase_prep(const Params& p, char* smem) {
  const int tid = otid(), G = gridDim.x, bid = blockIdx.x;
  char* ws = p.ws;
  if (bid == 0) for (int i = tid; i < 1024; i += 256) ((int*)(ws + OFF_CNT))[i] = 0;
  float* tile = (float*)smem;
  for (int g0 = bid; g0 < 9168; g0 += G) {
    int g = g0;
    const float* src = nullptr; u16* dst = nullptr; int K = 0, N = 0; size_t dstr = 0; bool ukv = false;
    if (g < 1024) { src = p.w_mem_kv; dst = (u16*)(ws + OFF_WT_MEMKV); K = 1024; N = 1024; dstr = 1024ull * 1024; }
    else if ((g -= 1024) < 1632) { src = p.w_in_mla; dst = (u16*)(ws + OFF_WT_INMLA); K = 1024; N = 3264; dstr = 3328ull * 1024; }
    else if ((g -= 1632) < 432) { src = p.w_uq; dst = (u16*)(ws + OFF_WT_UQ); K = 384; N = 2304; dstr = 2304ull * 384; }
    else if ((g -= 432) < 384) { src = p.w_ukv; dst = (u16*)(ws + OFF_WT_UKV); K = 256; N = 3072; dstr = 3072ull * 256; ukv = true; }
    else if ((g -= 384) < 3648) { src = p.w_in_rwkv; dst = (u16*)(ws + OFF_WT_INRW); K = 1024; N = 7296; dstr = 7296ull * 1024; }
    else { g -= 3648; src = p.w_out; dst = (u16*)(ws + OFF_WT_OUT); K = 2048; N = 1024; dstr = 1024ull * 2048; }
    int ntn = N >> 6, per = (K >> 6) * ntn;
    int m = g / per, t = g - m * per;
    int tk = t / ntn, tn = t - tk * ntn;
    int drow = tn * 64;
    if (ukv) { const int hd = drow >> 8, dd = drow & 255; drow = (dd < 128) ? (hd * 128 + dd) : (1536 + hd * 128 + dd - 128); }
    transpose_tile(src + (size_t)m * K * N, dst + (size_t)m * dstr, K, N, tk, tn, drow, tile);
  }
  for (int i = bid * 256 + tid; i < 2 * 64 * 1024 / 8; i += G * 256) {
    int m = i / (64 * 1024 / 8), r = i - m * (64 * 1024 / 8);
    uint4 z; z.x = z.y = z.z = z.w = 0u;
    *(uint4*)((u16*)(ws + OFF_WT_INMLA) + (size_t)m * 3328 * 1024 + 3264ull * 1024 + (size_t)r * 8) = z;
  }
  float* cs = (float*)(ws + OFF_COS); float* sn = (float*)(ws + OFF_SIN);
  for (int i = bid * 256 + tid; i < 32768 * 32; i += G * 256) {
    int tk = i >> 5, pi = i & 31;
    float inv_freq = (float)exp2(-(double)(2 * pi) / 64.0 * 13.287712379549449);
    float ang = (float)p.pos[tk] * inv_freq;
    double rev = (double)ang * 0.15915494309189535;
    float fr = (float)(rev - rint(rev));
    cs[i] = __builtin_amdgcn_cosf(fr); sn[i] = __builtin_amdgcn_sinf(fr);
  }
  const int w = tid >> 6, lane = tid & 63;
  for (int row = bid * 4 + w; row < 4096; row += G * 4) {
    int L = row >> 10, m = row & 1023;
    rms_row_bf16(p.mem + (size_t)m * 1024, p.mem_norm_g + L * 1024, (u16*)(ws + OFF_MEMH) + (size_t)row * 1024, lane);
  }
}

DI void phase_norm(const Params& p, int L, int c) {
  const int tid = otid(), w = tid >> 6, lane = tid & 63;
  const bool rw = L & 1;
  const float* xs = (L == 0) ? p.x : p.out;
  u16* H = (u16*)(p.ws + OFF_H);
  for (int lr = blockIdx.x * 4 + w; lr < TC; lr += gridDim.x * 4) {
    int gt = gtok(rw, c, lr);
    rms_row_bf16(xs + (size_t)gt * 1024, p.norm_g + L * 1024, H + (size_t)lr * 1024, lane);
  }
}

DI void phase_final_norm(const Params& p, bool dry) {
  const int tid = otid(), w = tid >> 6, lane = tid & 63;
  for (int row = blockIdx.x * 4 + w; row < 32768; row += gridDim.x * 4) {
    float* xr = p.out + (size_t)row * 1024;
    float4 v[4]; float ss = 0.f;
#pragma unroll
    for (int i = 0; i < 4; ++i) { v[i] = *(const float4*)(xr + i * 256 + lane * 4); ss += v[i].x * v[i].x + v[i].y * v[i].y + v[i].z * v[i].z + v[i].w * v[i].w; }
    ss = wave_sum(ss);
    float rs = rsqrtf(ss * (1.f / 1024.f) + 1e-6f);
#pragma unroll
    for (int i = 0; i < 4; ++i) {
      float4 gg = *(const float4*)(p.final_g + i * 256 + lane * 4);
      float4 o; o.x = v[i].x * rs * gg.x; o.y = v[i].y * rs * gg.y; o.z = v[i].z * rs * gg.z; o.w = v[i].w * rs * gg.w;
      if (!dry) *(float4*)(xr + i * 256 + lane * 4) = o;
    }
  }
}

template <int TJ, bool SWAP, int NK, class Epi>
DI void gemm_phase(const u16* __restrict__ A, size_t strideAz, int lda, const u16* __restrict__ Bt, size_t strideBz, int ldb,
                   int Z, int Mt, int Nt, int GM, int K, char* smem, const Epi& epi, int vt) {
  constexpr int BN = 64 * TJ;
  constexpr int NB = BN / 32;
  const int tid = otid(), w = tid >> 6, lane = tid & 63, r = lane & 31, h = lane >> 5;
  const int wm = w >> 1, wn = w & 1;
  u16* As = (u16*)smem;
  u16* Bs = As + 2 * 256 * 72;
  const int G = gridDim.x, per = Mt * Nt, total = Z * per;
  const int lrow = tid >> 3, lcc = (tid & 7) * 8;
  unsigned aoff[8], boff[NB];
#pragma unroll
  for (int i = 0; i < 8; ++i) aoff[i] = (unsigned)((lrow + 32 * i) * lda + lcc);
#pragma unroll
  for (int i = 0; i < NB; ++i) boff[i] = (unsigned)((lrow + 32 * i) * ldb + lcc);
  const int lds_st = lrow * 72 + lcc;
  for (int base = 0; base < total; base += G) {
    const int q = base + vt;
    if (q >= total) continue;
    const int z = q / per, qq = q - z * per;
    const int grp = qq / (GM * Nt), within = qq - grp * GM * Nt;
    const int mt = grp * GM + (within % GM), nt = within / GM;
    const u16* Ag = A + z * strideAz + (size_t)(mt * 256) * lda;
    const u16* Bg = Bt + z * strideBz + (size_t)(nt * BN) * ldb;
    u32x4 ra[2][8], rb[2][NB];
    f32x16 acc[4][TJ];
#pragma unroll
    for (int i = 0; i < 4; ++i)
#pragma unroll
      for (int j = 0; j < TJ; ++j)
#pragma unroll
        for (int e = 0; e < 16; ++e) acc[i][j][e] = 0.f;
    __syncthreads();
#pragma unroll
    for (int i = 0; i < 8; ++i) ra[0][i] = *(const u32x4*)(Ag + aoff[i]);
#pragma unroll
    for (int i = 0; i < NB; ++i) rb[0][i] = *(const u32x4*)(Bg + boff[i]);
#pragma unroll
    for (int i = 0; i < 8; ++i) ra[1][i] = *(const u32x4*)(Ag + 64 + aoff[i]);
#pragma unroll
    for (int i = 0; i < NB; ++i) rb[1][i] = *(const u32x4*)(Bg + 64 + boff[i]);
#pragma unroll
    for (int i = 0; i < 8; ++i) *(u32x4*)(As + lds_st + (32 * i) * 72) = ra[0][i];
#pragma unroll
    for (int i = 0; i < NB; ++i) *(u32x4*)(Bs + lds_st + (32 * i) * 72) = rb[0][i];
    __syncthreads();
#pragma unroll
    for (int kt = 0; kt < NK; ++kt) {
      constexpr int dummy = 0; (void)dummy;
      const int u = kt & 1;
      if (kt + 2 < NK) {
        const u16* ag = Ag + (kt + 2) * 64; const u16* bg = Bg + (kt + 2) * 64;
#pragma unroll
        for (int i = 0; i < 8; ++i) ra[u][i] = *(const u32x4*)(ag + aoff[i]);
#pragma unroll
        for (int i = 0; i < NB; ++i) rb[u][i] = *(const u32x4*)(bg + boff[i]);
      }
      const u16* as = As + u * 256 * 72 + (128 * wm + r) * 72 + 8 * h;
      const u16* bs = Bs + u * BN * 72 + (32 * TJ * wn + r) * 72 + 8 * h;
      bf16x8 af[2][4], bfr[2][TJ];
#pragma unroll
      for (int i = 0; i < 4; ++i) af[0][i] = *(const bf16x8*)(as + (32 * i) * 72);
#pragma unroll
      for (int j = 0; j < TJ; ++j) bfr[0][j] = *(const bf16x8*)(bs + (32 * j) * 72);
#pragma unroll
      for (int ks = 0; ks < 4; ++ks) {
        if (ks < 3) {
#pragma unroll
          for (int i = 0; i < 4; ++i) af[(ks + 1) & 1][i] = *(const bf16x8*)(as + (32 * i) * 72 + 16 * (ks + 1));
#pragma unroll
          for (int j = 0; j < TJ; ++j) bfr[(ks + 1) & 1][j] = *(const bf16x8*)(bs + (32 * j) * 72 + 16 * (ks + 1));
        }
        __builtin_amdgcn_sched_barrier(0);
#pragma unroll
        for (int i = 0; i < 4; ++i)
#pragma unroll
          for (int j = 0; j < TJ; ++j)
            acc[i][j] = SWAP ? MFMA32(bfr[ks & 1][j], af[ks & 1][i], acc[i][j]) : MFMA32(af[ks & 1][i], bfr[ks & 1][j], acc[i][j]);
        if (ks == 0 && kt + 1 < NK) {
          u16* ad = As + (u ^ 1) * 256 * 72 + lds_st; u16* bd = Bs + (u ^ 1) * BN * 72 + lds_st;
#pragma unroll
          for (int i = 0; i < 8; ++i) *(u32x4*)(ad + (32 * i) * 72) = ra[u ^ 1][i];
#pragma unroll
          for (int i = 0; i < NB; ++i) *(u32x4*)(bd + (32 * i) * 72) = rb[u ^ 1][i];
#pragma unroll
          for (int i = 0; i < 6; ++i) { __builtin_amdgcn_sched_group_barrier(0x008, 1, 0); __builtin_amdgcn_sched_group_barrier(0x200, 2, 0); }
        }
        __builtin_amdgcn_sched_barrier(0);
      }
      __syncthreads();
    }
#pragma unroll
    for (int i = 0; i < 4; ++i)
#pragma unroll
      for (int j = 0; j < TJ; ++j) {
        if (SWAP) epi(z, mt * 256 + 128 * wm + 32 * i + r, nt * BN + 32 * TJ * wn + 32 * j, h, acc[i][j]);
        else epi(z, mt * 256 + 128 * wm + 32 * i, nt * BN + 32 * TJ * wn + 32 * j + r, h, acc[i][j]);
      }
  }
}

struct EpiStoreBf16 {
  u16* C; int ldc; int ncols; bool dry;
  DI void operator()(int z, int row, int colbase, int h, const f32x16& a) const {
    if (dry) return;
#pragma unroll
    for (int g = 0; g < 4; ++g) {
      const int col = colbase + 8 * g + 4 * h;
      if (col < ncols) {
        u32x2 pk = {pack2(a[4 * g], a[4 * g + 1]), pack2(a[4 * g + 2], a[4 * g + 3])};
        *(u32x2*)(C + (size_t)row * ldc + col) = pk;
      }
    }
  }
};
struct EpiResid {
  const float* xin; float* xout; bool rw; int c; bool dry;
  DI void operator()(int z, int row, int colbase, int h, const f32x16& a) const {
    if (dry) return;
    const size_t o = (size_t)gtok(rw, c, row) * 1024 + colbase + 4 * h;
#pragma unroll
    for (int g = 0; g < 4; ++g) {
      float4 v = *(const float4*)(xin + o + 8 * g);
      v.x += a[4 * g]; v.y += a[4 * g + 1]; v.z += a[4 * g + 2]; v.w += a[4 * g + 3];
      *(float4*)(xout + o + 8 * g) = v;
    }
  }
};
struct EpiUQ {
  u16* Q; const float* cs; const float* sn; int c; bool dry;
  DI void operator()(int z, int row, int colbase, int h, const f32x16& a) const {
    if (dry) return;
    const int head = colbase / 192, db = colbase - head * 192;
    const int lb = row >> 13, s = row & 8191;
    u16* qp = Q + ((size_t)(lb * 12 + head) * 8192 + s) * 192 + db + 4 * h;
    const size_t ti = (size_t)(c * 16384 + row) * 32;
#pragma unroll
    for (int g = 0; g < 4; ++g) {
      float v0 = a[4 * g], v1 = a[4 * g + 1], v2 = a[4 * g + 2], v3 = a[4 * g + 3];
      if (db >= 128) {
        const int pi = (db - 128 + 8 * g + 4 * h) >> 1;
        const float2 cc = *(const float2*)(cs + ti + pi), ss = *(const float2*)(sn + ti + pi);
        const float o0 = v0 * cc.x - v1 * ss.x, o1 = v0 * ss.x + v1 * cc.x;
        const float o2 = v2 * cc.y - v3 * ss.y, o3 = v2 * ss.y + v3 * cc.y;
        v0 = o0; v1 = o1; v2 = o2; v3 = o3;
      }
      u32x2 pk = {pack2(v0, v1), pack2(v2, v3)};
      *(u32x2*)(qp + 8 * g) = pk;
    }
  }
};
struct EpiUK {
  u16* Kb; bool dry;
  DI void operator()(int z, int row, int colbase, int h, const f32x16& a) const {
    if (dry) return;
    const int head = colbase >> 7, db = colbase & 127;
    const int lb = row >> 13, s = row & 8191;
    u16* kp = Kb + ((size_t)(lb * 12 + head) * 8192 + s) * 192 + db + 4 * h;
#pragma unroll
    for (int g = 0; g < 4; ++g) {
      u32x2 pk = {pack2(a[4 * g], a[4 * g + 1]), pack2(a[4 * g + 2], a[4 * g + 3])};
      *(u32x2*)(kp + 8 * g) = pk;
    }
  }
};
struct EpiUV {
  u16* Vt; bool dry;
  DI void operator()(int z, int rowbase, int col, int h, const f32x16& a) const {
    if (dry) return;
    const int head = col >> 7, d = col & 127;
#pragma unroll
    for (int g = 0; g < 4; ++g) {
      int lr = rowbase + 8 * g + 4 * h; int lb = lr >> 13, s = lr & 8191;
      u32x2 pk = {pack2(a[4 * g], a[4 * g + 1]), pack2(a[4 * g + 2], a[4 * g + 3])};
      *(u32x2*)(Vt + (((size_t)(lb * 12 + head) * 128 + (s >> 6)) * 128 + d) * 64 + (s & 63)) = pk;
    }
  }
};
struct EpiMemKV {
  u16* MK; u16* MVt; bool dry;
  DI void operator()(int z, int rowbase, int col, int h, const f32x16& a) const {
    if (col < 512) {
      const int xh = col >> 7, d = col & 127;
#pragma unroll
      for (int e = 0; e < 16; ++e) {
        int m = rowbase + crow(e, h); int b = m >> 8, mi = m & 255;
        MK[((size_t)((z * 4 + b) * 4 + xh) * 256 + mi) * 128 + d] = f2bf(a[e]);
      }
    } else {
      const int n = col - 512, xh = n >> 7, d = n & 127;
#pragma unroll
      for (int g = 0; g < 4; ++g) {
        int m = rowbase + 8 * g + 4 * h; int b = m >> 8, mi = m & 255;
        uint2 pk; pk.x = pack2(a[4 * g], a[4 * g + 1]); pk.y = pack2(a[4 * g + 2], a[4 * g + 3]);
        *(uint2*)(MVt + (((size_t)((z * 4 + b) * 4 + xh) * 4 + (mi >> 6)) * 128 + d) * 64 + (mi & 63)) = pk;
      }
    }
  }
};

DI void phase_kvprep(const Params& p, int L, int c, bool dry) {
  const int tid = otid(), w = tid >> 6, lane = tid & 63;
  const int j = L >> 1;
  u16* U = (u16*)(p.ws + OFF_U); u16* Kb = (u16*)(p.ws + OFF_K);
  const float* cs = (const float*)(p.ws + OFF_COS); const float* sn = (const float*)(p.ws + OFF_SIN);
  for (int lr = blockIdx.x * 4 + w; lr < TC; lr += gridDim.x * 4) {
    u16* row = U + (size_t)lr * LDU_M;
    float fq[8], fk[8]; float sq = 0.f, sk = 0.f;
    if (lane < 48) { uint4 v = *(const uint4*)(row + M_CQ + lane * 8); unpack8(v, fq);
#pragma unroll
      for (int e = 0; e < 8; ++e) sq += fq[e] * fq[e]; }
    if (lane < 32) { uint4 v = *(const uint4*)(row + M_CKV + lane * 8); unpack8(v, fk);
#pragma unroll
      for (int e = 0; e < 8; ++e) sk += fk[e] * fk[e]; }
    sq = wave_sum(sq); sk = wave_sum(sk);
    float rq = rsqrtf(sq * (1.f / 384.f) + 1e-6f), rk = rsqrtf(sk * (1.f / 256.f) + 1e-6f);
    if (dry) continue;
    if (lane < 48) {
      const float* g = p.q_norm_g + j * 384 + lane * 8;
#pragma unroll
      for (int e = 0; e < 8; ++e) fq[e] = fq[e] * rq * g[e];
      *(uint4*)(row + M_CQ + lane * 8) = pack8(fq);
    }
    if (lane < 32) {
      const float* g = p.kv_norm_g + j * 256 + lane * 8;
#pragma unroll
      for (int e = 0; e < 8; ++e) fk[e] = fk[e] * rk * g[e];
      *(uint4*)(row + M_CKV + lane * 8) = pack8(fk);
    }
    if (lane < 8) {
      float f[8], o[8]; uint4 v = *(const uint4*)(row + M_KR + lane * 8); unpack8(v, f);
      int gt = c * 16384 + lr;
#pragma unroll
      for (int i = 0; i < 4; ++i) {
        float cc = cs[gt * 32 + lane * 4 + i], ss = sn[gt * 32 + lane * 4 + i];
        o[2 * i] = f[2 * i] * cc - f[2 * i + 1] * ss; o[2 * i + 1] = f[2 * i] * ss + f[2 * i + 1] * cc;
      }
      uint4 pk = pack8(o);
      int lb = lr >> 13, s = lr & 8191;
#pragma unroll
      for (int hd = 0; hd < 12; ++hd) *(uint4*)(Kb + ((size_t)(lb * 12 + hd) * 8192 + s) * 192 + 128 + lane * 8) = pk;
    }
  }
}

template <int DQK>
DI void attn_item(const u16* __restrict__ Qp, int ldq, const u16* __restrict__ Kp, const u16* __restrict__ Vtp, int ldv,
                  int nkt, int q0, bool causal, float c, u16* Yp, int ldy, char* smem, bool dry) {
  constexpr int KLD = DQK + 8;
  constexpr int NKC = DQK * 64 / 8 / 256;
  constexpr int NKS = DQK / 16;
  constexpr int CPR = DQK / 8;
  constexpr int BUFE = 64 * KLD + 128 * 72;
  u16* L0 = (u16*)smem;
  const int tid = otid(), w = tid >> 6, lane = tid & 63, r = lane & 31, h = lane >> 5;
  bf16x8 qf[NKS];
  {
    const u16* qrow = Qp + (size_t)(32 * w + r) * ldq + 8 * h;
#pragma unroll
    for (int ks = 0; ks < NKS; ++ks) qf[ks] = *(const bf16x8*)(qrow + 16 * ks);
  }
  f32x16 o[4];
#pragma unroll
  for (int dt = 0; dt < 4; ++dt)
#pragma unroll
    for (int e = 0; e < 16; ++e) o[dt][e] = 0.f;
  float m = -INFINITY, l = 0.f;
  u32x4 kst[NKC], vst[4];
  const int vd = tid >> 3, vc8 = tid & 7;
  int kso[NKC];
#pragma unroll
  for (int i = 0; i < NKC; ++i) { int id = tid + 256 * i; int row = id / CPR, cc = id - row * CPR; kso[i] = row * KLD + cc * 8; }
  const int vso = 64 * KLD + vd * 72 + 16 * (vc8 >> 1) + 4 * (vc8 & 1);
  __syncthreads();
#pragma unroll
  for (int i = 0; i < NKC; ++i) kst[i] = *(const u32x4*)(Kp + (size_t)(tid + 256 * i) * 8);
#pragma unroll
  for (int i = 0; i < 4; ++i) vst[i] = *(const u32x4*)(Vtp + (size_t)(tid + 256 * i) * 8);
#pragma unroll
  for (int i = 0; i < NKC; ++i) *(u32x4*)(L0 + kso[i]) = kst[i];
#pragma unroll
  for (int i = 0; i < 4; ++i) {
    u16* dst = L0 + vso + (32 * i) * 72;
    u32x2 lo = {vst[i].x, vst[i].y}, hi = {vst[i].z, vst[i].w};
    *(u32x2*)dst = lo; *(u32x2*)(dst + 8) = hi;
  }
  if (nkt > 1) {
    const u16* kg = Kp + (size_t)64 * DQK;
#pragma unroll
    for (int i = 0; i < NKC; ++i) kst[i] = *(const u32x4*)(kg + (size_t)(tid + 256 * i) * 8);
#pragma unroll
    for (int i = 0; i < 4; ++i) vst[i] = *(const u32x4*)(Vtp + 8192 + (size_t)(tid + 256 * i) * 8);
  }
  __syncthreads();
  const int qmin = q0 + 32 * w;
  for (int kt = 0; kt < nkt; ++kt) {
    const u16* Ks = L0 + (kt & 1) * BUFE;
    const u16* Vs = Ks + 64 * KLD;
    u16* Ln = L0 + ((kt + 1) & 1) * BUFE;
    const bool active = !(causal && kt * 64 > qmin + 31);
    f32x16 s0, s1;
#pragma unroll
    for (int e = 0; e < 16; ++e) { s0[e] = 0.f; s1[e] = 0.f; }
    const u16* k0 = Ks + r * KLD + 8 * h;
    bf16x8 ka[2][2];
    if (active) {
      ka[0][0] = *(const bf16x8*)(k0); ka[0][1] = *(const bf16x8*)(k0 + 32 * KLD);
      ka[1][0] = *(const bf16x8*)(k0 + 16); ka[1][1] = *(const bf16x8*)(k0 + 32 * KLD + 16);
      __builtin_amdgcn_sched_barrier(0);
      s0 = MFMA32(ka[0][0], qf[0], s0); s1 = MFMA32(ka[0][1], qf[0], s1);
    }
    if (kt + 1 < nkt) {
#pragma unroll
      for (int i = 0; i < NKC; ++i) *(u32x4*)(Ln + kso[i]) = kst[i];
#pragma unroll
      for (int i = 0; i < 4; ++i) {
        u16* dst = Ln + vso + (32 * i) * 72;
        u32x2 lo = {vst[i].x, vst[i].y}, hi = {vst[i].z, vst[i].w};
        *(u32x2*)dst = lo; *(u32x2*)(dst + 8) = hi;
      }
    }
    if (kt + 2 < nkt) {
      const u16* kg = Kp + (size_t)(kt + 2) * 64 * DQK;
#pragma unroll
      for (int i = 0; i < NKC; ++i) kst[i] = *(const u32x4*)(kg + (size_t)(tid + 256 * i) * 8);
#pragma unroll
      for (int i = 0; i < 4; ++i) vst[i] = *(const u32x4*)(Vtp + (size_t)(kt + 2) * 8192 + (size_t)(tid + 256 * i) * 8);
    }
    if (active) {
      __builtin_amdgcn_sched_barrier(0);
#pragma unroll
      for (int ks = 1; ks < NKS; ++ks) {
        if (ks + 1 < NKS) {
          ka[(ks + 1) & 1][0] = *(const bf16x8*)(k0 + 16 * (ks + 1));
          ka[(ks + 1) & 1][1] = *(const bf16x8*)(k0 + 32 * KLD + 16 * (ks + 1));
        }
        __builtin_amdgcn_sched_barrier(0);
        s0 = MFMA32(ka[ks & 1][0], qf[ks], s0); s1 = MFMA32(ka[ks & 1][1], qf[ks], s1);
        __builtin_amdgcn_sched_barrier(0);
      }
      const u16* v0 = Vs + r * 72 + 8 * h;
      bf16x8 va[2][4];
#pragma unroll
      for (int dt = 0; dt < 4; ++dt) va[0][dt] = *(const bf16x8*)(v0 + (32 * dt) * 72);
      if (causal && kt * 64 + 63 > qmin) {
        const int qi = qmin + r;
#pragma unroll
        for (int e = 0; e < 16; ++e) {
          int key = kt * 64 + crow(e, h);
          if (key > qi) s0[e] = -INFINITY;
          if (key + 32 > qi) s1[e] = -INFINITY;
        }
      }
      float mx = fmaxf(s0[0], s1[0]);
#pragma unroll
      for (int e = 1; e < 16; ++e) mx = fmaxf(mx, fmaxf(s0[e], s1[e]));
      mx = fmaxf(mx, __shfl_xor(mx, 32));
      if (__builtin_amdgcn_ballot_w64((mx - m) * c > 8.f) != 0ull) {
        const float mn = fmaxf(m, mx);
        const float alpha = ex2((m - mn) * c);
        m = mn;
        l *= alpha;
#pragma unroll
        for (int dt = 0; dt < 4; ++dt)
#pragma unroll
          for (int e = 0; e < 16; ++e) o[dt][e] *= alpha;
      }
      const float mc = m * c;
      float ps = 0.f;
#pragma unroll
      for (int e = 0; e < 16; ++e) { s0[e] = ex2(fmaf(s0[e], c, -mc)); s1[e] = ex2(fmaf(s1[e], c, -mc)); ps += s0[e] + s1[e]; }
      l += ps;
      bf16x8 pf[4];
      {
        u32x4 t;
        t.x = pack2(s0[0], s0[1]); t.y = pack2(s0[2], s0[3]); t.z = pack2(s0[4], s0[5]); t.w = pack2(s0[6], s0[7]); pf[0] = __builtin_bit_cast(bf16x8, t);
        t.x = pack2(s0[8], s0[9]); t.y = pack2(s0[10], s0[11]); t.z = pack2(s0[12], s0[13]); t.w = pack2(s0[14], s0[15]); pf[1] = __builtin_bit_cast(bf16x8, t);
        t.x = pack2(s1[0], s1[1]); t.y = pack2(s1[2], s1[3]); t.z = pack2(s1[4], s1[5]); t.w = pack2(s1[6], s1[7]); pf[2] = __builtin_bit_cast(bf16x8, t);
        t.x = pack2(s1[8], s1[9]); t.y = pack2(s1[10], s1[11]); t.z = pack2(s1[12], s1[13]); t.w = pack2(s1[14], s1[15]); pf[3] = __builtin_bit_cast(bf16x8, t);
      }
#pragma unroll
      for (int kk = 0; kk < 4; ++kk) {
        if (kk < 3) {
#pragma unroll
          for (int dt = 0; dt < 4; ++dt) va[(kk + 1) & 1][dt] = *(const bf16x8*)(v0 + (32 * dt) * 72 + 16 * (kk + 1));
        }
        __builtin_amdgcn_sched_barrier(0);
#pragma unroll
        for (int dt = 0; dt < 4; ++dt) o[dt] = MFMA32(va[kk & 1][dt], pf[kk], o[dt]);
        __builtin_amdgcn_sched_barrier(0);
      }
    }
    __syncthreads();
  }
  const float lt = l + __shfl_xor(l, 32);
  const float inv = 1.f / lt;
  if (dry) return;
  u16* yrow = Yp + (size_t)(32 * w + r) * ldy;
#pragma unroll
  for (int dt = 0; dt < 4; ++dt)
#pragma unroll
    for (int g = 0; g < 4; ++g) {
      const int d = 32 * dt + 8 * g + 4 * h;
      uint2 gv = *(const uint2*)(yrow + d);
      float g0 = bf2f(gv.x & 0xffffu), g1 = bf2f(gv.x >> 16), g2 = bf2f(gv.y & 0xffffu), g3 = bf2f(gv.y >> 16);
      uint2 ov;
      ov.x = pack2(o[dt][4 * g] * inv * silu(g0), o[dt][4 * g + 1] * inv * silu(g1));
      ov.y = pack2(o[dt][4 * g + 2] * inv * silu(g2), o[dt][4 * g + 3] * inv * silu(g3));
      *(uint2*)(yrow + d) = ov;
    }
}

template <int DQK>
DI void attn_item_c(const u16* __restrict__ Qp, int ldq, const u16* __restrict__ Kp, const u16* __restrict__ Vtp, int ldv,
                    int nkt, int q0, float c, u16* Yp, int ldy, char* smem, bool dry) {
  constexpr int KLD = DQK + 8;
  constexpr int NKC = DQK * 64 / 8 / 256;
  constexpr int NKS = DQK / 16;
  constexpr int CPR = DQK / 8;
  constexpr int BUFE = 64 * KLD + 128 * 72;
  u16* L0 = (u16*)smem;
  const int tid = otid(), w = tid >> 6, lane = tid & 63, r = lane & 31, h = lane >> 5;
  bf16x8 qf[NKS];
  {
    const u16* qrow = Qp + (size_t)(32 * w + r) * ldq + 8 * h;
#pragma unroll
    for (int ks = 0; ks < NKS; ++ks) qf[ks] = *(const bf16x8*)(qrow + 16 * ks);
  }
  f32x16 o[4];
#pragma unroll
  for (int dt = 0; dt < 4; ++dt)
#pragma unroll
    for (int e = 0; e < 16; ++e) o[dt][e] = 0.f;
  float m = -INFINITY, l = 0.f;
  u32x4 kstA[NKC], vstA[4], kstB[NKC], vstB[4];
  const int vd = tid >> 3, vc8 = tid & 7;
  int kso[NKC];
#pragma unroll
  for (int i = 0; i < NKC; ++i) { int id = tid + 256 * i; int row = id / CPR, cc = id - row * CPR; kso[i] = row * KLD + cc * 8; }
  const int vso = 64 * KLD + vd * 72 + 16 * (vc8 >> 1) + 4 * (vc8 & 1);
  const int nktp = (nkt + 3) & ~3;
  auto gload = [&](u32x4* ks_, u32x4* vs_, int j) {
    const u16* kg = Kp + (size_t)(j + 1) * 64 * DQK;
#pragma unroll
    for (int i = 0; i < NKC; ++i) ks_[i] = *(const u32x4*)(kg + (size_t)(tid + 256 * i) * 8);
#pragma unroll
    for (int i = 0; i < 4; ++i) vs_[i] = *(const u32x4*)(Vtp + (size_t)j * 8192 + (size_t)(tid + 256 * i) * 8);
  };
  auto lstore = [&](const u32x4* ks_, const u32x4* vs_, u16* Lb) {
#pragma unroll
    for (int i = 0; i < NKC; ++i) *(u32x4*)(Lb + kso[i]) = ks_[i];
#pragma unroll
    for (int i = 0; i < 4; ++i) {
      u16* dst = Lb + vso + (32 * i) * 72;
      u32x2 lo = {vs_[i].x, vs_[i].y}, hi = {vs_[i].z, vs_[i].w};
      *(u32x2*)dst = lo; *(u32x2*)(dst + 8) = hi;
    }
  };
  __syncthreads();
  gload(kstA, vstA, 0);
  gload(kstB, vstB, 1);
  f32x16 sa0, sa1, sb0, sb1;
#pragma unroll
  for (int e = 0; e < 16; ++e) { sa0[e] = 0.f; sa1[e] = 0.f; }
  {
    const u16* kr = Kp + (size_t)r * DQK + 8 * h;
#pragma unroll
    for (int ks = 0; ks < NKS; ++ks) {
      bf16x8 a0 = *(const bf16x8*)(kr + 16 * ks), a1 = *(const bf16x8*)(kr + 32 * DQK + 16 * ks);
      sa0 = MFMA32(a0, qf[ks], sa0); sa1 = MFMA32(a1, qf[ks], sa1);
    }
  }
  lstore(kstA, vstA, L0);
  gload(kstA, vstA, 2);
  __syncthreads();
  const int qmin = q0 + 32 * w;
  const int qi = qmin + r;
  auto body = [&](int kt, u32x4* wk, u32x4* wv, f32x16& s0, f32x16& s1, f32x16& n0, f32x16& n1) {
    const u16* Ks = L0 + (kt & 1) * BUFE;
    const u16* Vs = Ks + 64 * KLD;
    u16* Ln = L0 + ((kt + 1) & 1) * BUFE;
    const bool active = !(kt * 64 > qmin + 31);
    if (kt * 64 + 63 > qmin) {
#pragma unroll
      for (int e = 0; e < 16; ++e) {
        int key = kt * 64 + crow(e, h);
        if (key > qi) s0[e] = -INFINITY;
        if (key + 32 > qi) s1[e] = -INFINITY;
      }
    }
    float mx = fmaxf(s0[0], s1[0]);
#pragma unroll
    for (int e = 1; e < 16; ++e) mx = fmaxf(mx, fmaxf(s0[e], s1[e]));
    mx = fmaxf(mx, __shfl_xor(mx, 32));
    if (__builtin_amdgcn_ballot_w64((mx - m) * c > 8.f) != 0ull) {
      const float mn = fmaxf(m, mx);
      const float alpha = ex2((m - mn) * c);
      m = mn;
      l *= alpha;
#pragma unroll
      for (int dt = 0; dt < 4; ++dt)
#pragma unroll
        for (int e = 0; e < 16; ++e) o[dt][e] *= alpha;
    }
    const float mc = m * c;
#pragma unroll
    for (int e = 0; e < 16; ++e) { n0[e] = 0.f; n1[e] = 0.f; }
    const u16* k0 = Ks + r * KLD + 8 * h;
    bf16x8 ka[2][2];
    ka[0][0] = *(const bf16x8*)(k0); ka[0][1] = *(const bf16x8*)(k0 + 32 * KLD);
    bf16x8 pf[4];
    u32x4 pk[4];
    float ps = 0.f;
#pragma unroll
    for (int ks = 0; ks < NKS; ++ks) {
      if (ks + 1 < NKS) {
        ka[(ks + 1) & 1][0] = *(const bf16x8*)(k0 + 16 * (ks + 1));
        ka[(ks + 1) & 1][1] = *(const bf16x8*)(k0 + 32 * KLD + 16 * (ks + 1));
      }
      __builtin_amdgcn_sched_barrier(0);
      n0 = MFMA32(ka[ks & 1][0], qf[ks], n0); n1 = MFMA32(ka[ks & 1][1], qf[ks], n1);
      if (ks < 8) {
#pragma unroll
        for (int e4 = 0; e4 < 4; ++e4) {
          const int e = (4 * ks + e4) & 15;
          if (ks < 4) { s0[e] = ex2(fmaf(s0[e], c, -mc)); ps += s0[e]; }
          else        { s1[e] = ex2(fmaf(s1[e], c, -mc)); ps += s1[e]; }
        }
      }
      if (ks == 1) {
        lstore(wk, wv, Ln);
        gload(wk, wv, kt + 3);
      }
      if (ks == 4)  { pk[0].x = pack2(s0[0], s0[1]);  pk[0].y = pack2(s0[2], s0[3]);   pk[0].z = pack2(s0[4], s0[5]);   pk[0].w = pack2(s0[6], s0[7]); }
      if (ks == 5)  { pk[1].x = pack2(s0[8], s0[9]);  pk[1].y = pack2(s0[10], s0[11]); pk[1].z = pack2(s0[12], s0[13]); pk[1].w = pack2(s0[14], s0[15]); }
      if (ks == 8)  { pk[2].x = pack2(s1[0], s1[1]);  pk[2].y = pack2(s1[2], s1[3]);   pk[2].z = pack2(s1[4], s1[5]);   pk[2].w = pack2(s1[6], s1[7]); }
      if (ks == 9)  { pk[3].x = pack2(s1[8], s1[9]);  pk[3].y = pack2(s1[10], s1[11]); pk[3].z = pack2(s1[12], s1[13]); pk[3].w = pack2(s1[14], s1[15]); }
      __builtin_amdgcn_sched_barrier(0);
    }
    l += ps;
#pragma unroll
    for (int i = 0; i < 4; ++i) pf[i] = __builtin_bit_cast(bf16x8, pk[i]);
    if (active) {
      const u16* v0 = Vs + r * 72 + 8 * h;
      bf16x8 va[2][4];
#pragma unroll
      for (int dt = 0; dt < 4; ++dt) va[0][dt] = *(const bf16x8*)(v0 + (32 * dt) * 72);
#pragma unroll
      for (int kk = 0; kk < 4; ++kk) {
        if (kk < 3) {
#pragma unroll
          for (int dt = 0; dt < 4; ++dt) va[(kk + 1) & 1][dt] = *(const bf16x8*)(v0 + (32 * dt) * 72 + 16 * (kk + 1));
        }
        __builtin_amdgcn_sched_barrier(0);
#pragma unroll
        for (int dt = 0; dt < 4; ++dt) o[dt] = MFMA32(va[kk & 1][dt], pf[kk], o[dt]);
        __builtin_amdgcn_sched_barrier(0);
      }
    }
    __syncthreads();
  };
  for (int kt4 = 0; kt4 < nktp; kt4 += 4) {
    body(kt4 + 0, kstB, vstB, sa0, sa1, sb0, sb1); body(kt4 + 1, kstA, vstA, sb0, sb1, sa0, sa1);
    body(kt4 + 2, kstB, vstB, sa0, sa1, sb0, sb1); body(kt4 + 3, kstA, vstA, sb0, sb1, sa0, sa1);
  }
  const float lt = l + __shfl_xor(l, 32);
  const float inv = 1.f / lt;
  if (dry) return;
  u16* yrow = Yp + (size_t)(32 * w + r) * ldy;
#pragma unroll
  for (int dt = 0; dt < 4; ++dt)
#pragma unroll
    for (int g = 0; g < 4; ++g) {
      const int d = 32 * dt + 8 * g + 4 * h;
      uint2 gv = *(const uint2*)(yrow + d);
      float g0 = bf2f(gv.x & 0xffffu), g1 = bf2f(gv.x >> 16), g2 = bf2f(gv.y & 0xffffu), g3 = bf2f(gv.y >> 16);
      uint2 ov;
      ov.x = pack2(o[dt][4 * g] * inv * silu(g0), o[dt][4 * g + 1] * inv * silu(g1));
      ov.y = pack2(o[dt][4 * g + 2] * inv * silu(g2), o[dt][4 * g + 3] * inv * silu(g3));
      *(uint2*)(yrow + d) = ov;
    }
}

DI void memattn_item(const Params& p, int L, int c, int item, char* smem, bool dry) {
  const bool rw = L & 1;
  const int ldu = rw ? LDU_R : LDU_M, oq = rw ? R_QM : M_QM, og = rw ? R_GATE : M_GATE;
  const int tile = item >> 2, xh = item & 3;
  const int b = gtok(rw, c, tile * 128) >> 13;
  u16* U = (u16*)(p.ws + OFF_U);
  const u16* MK = (const u16*)(p.ws + OFF_MEMK) + (size_t)((L * 4 + b) * 4 + xh) * 256 * 128;
  const u16* MV = (const u16*)(p.ws + OFF_MEMVT) + (size_t)((L * 4 + b) * 4 + xh) * 128 * 256;
  attn_item<128>(U + (size_t)tile * 128 * ldu + oq + xh * 128, ldu, MK, MV, 256, 4, 0, false,
                 0.08838834764831845f * 1.4426950408889634f, U + (size_t)tile * 128 * ldu + og + 1536 + xh * 128, ldu, smem, dry);
}

DI void phase_attn(const Params& p, int L, int c, char* smem, int* s_item, bool dry) {
  int* cnt = (int*)(p.ws + OFF_CNT) + 64 + ((L * 2 + c) * 2 + (dry ? 1 : 0)) * 16;
  u16* U = (u16*)(p.ws + OFF_U);
  const u16* Q = (const u16*)(p.ws + OFF_Q); const u16* Kb = (const u16*)(p.ws + OFF_K); const u16* Vt = (const u16*)(p.ws + OFF_VT);
  const int xcc = (int)(__builtin_amdgcn_s_getreg((3 << 11) | 20) & 7u);
  for (int k = 0; k < 8; ++k) {
    const int x = (xcc + k) & 7;
    for (;;) {
      __syncthreads();
      if (otid() == 0) *s_item = atomicAdd(cnt + x, 1);
      __syncthreads();
      const int item = *s_item;
      if (item >= 192) break;
      const int qt = 63 - (item & 63), bh = 3 * x + (item >> 6);
      const int lb = bh / 12, head = bh - lb * 12;
      const int q0 = qt * 128;
      attn_item_c<192>(Q + ((size_t)(lb * 12 + head) * 8192 + q0) * 192, 192, Kb + (size_t)(lb * 12 + head) * 8192 * 192,
                     Vt + (size_t)(lb * 12 + head) * 128 * 8192, 8192, 2 * (qt + 1), q0,
                     0.07216878364870323f * 1.4426950408889634f,
                     U + (size_t)(lb * 8192 + q0) * LDU_M + M_GATE + head * 128, LDU_M, smem, dry);
    }
  }
  for (;;) {
    __syncthreads();
    if (otid() == 0) *s_item = atomicAdd(cnt + 8, 1);
    __syncthreads();
    const int item = *s_item;
    if (item >= 512) break;
    memattn_item(p, L, c, item, smem, dry);
  }
}

DI void scan_item(const Params& p, int L, int c, int item, char* smem, bool dry) {
  const int tid = otid(), w = tid >> 6, lane = tid & 63, r = lane & 31, h = lane >> 5;
  const int j = L >> 1;
  const int b = item / 48, rem = item - b * 48, head = rem >> 1, half = rem & 1;
  float* PA  = (float*)smem;
  float* Vst = PA + 32 * 5 * 64;
  float* Yst = Vst + 32 * 32;
  float* PRM = Yst + 32 * 32;
  float* BON = PRM + 10 * 64;
  u16* A1  = (u16*)(BON + 32);
  u16* W2t = A1 + 2 * 32 * 72;
  float* LO  = (float*)(W2t + 2 * 64 * 72);
  const u16* U = (const u16*)(p.ws + OFF_U);
  const u16* BND = (const u16*)(p.ws + OFF_BND);
  u16* YR = (u16*)(p.ws + OFF_YR); u16* BV = (u16*)(p.ws + OFF_BV);
  float* ST = (float*)(p.ws + OFF_ST); float* BS = (float*)(p.ws + OFF_BS);
  float* STATE = (float*)(p.ws + OFF_STATE);
  __syncthreads();
  if (tid < 64) {
    const float* mu = p.mu + j * SHIFTW;
    const int hc = head * 64 + tid;
    PRM[0 * 64 + tid] = mu[R_R + hc]; PRM[1 * 64 + tid] = mu[R_K + hc]; PRM[2 * 64 + tid] = mu[R_WD + tid]; PRM[3 * 64 + tid] = mu[R_AD + tid];
    PRM[4 * 64 + tid] = p.w0[j * 1536 + hc]; PRM[5 * 64 + tid] = p.a0[j * 1536 + hc]; PRM[6 * 64 + tid] = p.k_k[j * 1536 + hc];
    PRM[7 * 64 + tid] = p.k_a[j * 1536 + hc]; PRM[8 * 64 + tid] = p.r_k[j * 1536 + hc];
    PRM[9 * 64 + tid] = (tid < 32) ? mu[R_V + head * 64 + 32 * half + tid] : 0.f;
  }
  for (int e = tid; e < 8192; e += 256) {
    int arr = e >> 12, jj = (e >> 6) & 63, cc = e & 63;
    const float* src = (arr ? p.a2 : p.w2) + (size_t)j * 64 * 1536;
    W2t[(arr * 64 + cc) * 72 + jj] = f2bf(src[jj * 1536 + head * 64 + cc]);
  }
  const int rowl = lane >> 3, ks = lane & 7, row32 = 8 * w + rowl;
  float S[8];
  {
    float* sp = STATE + ((size_t)((b * 24 + head) * 64 + 32 * half + row32)) * 64 + 8 * ks;
#pragma unroll
    for (int i = 0; i < 8; ++i) S[i] = (c == 0) ? 0.f : sp[i];
  }
  const int tt = tid >> 3, cs = tid & 7;
  uint4 Rr_c, Rr_p, Rk_c, Rk_p, Rw_c, Rw_p, Ra_c, Ra_p, Rv_c, Rv_p;
  const uint4 zero4 = {0u, 0u, 0u, 0u};
  auto load_raw = [&](int tc) {
    const int lr = b * 4096 + tc * 32 + tt;
    const int s = c * 4096 + tc * 32 + tt;
    const u16* cur = U + (size_t)lr * LDU_R;
    const u16* prv = (s == 4096 && c == 1) ? (BND + (size_t)b * SHIFTW) : (cur - LDU_R);
    const bool hp = (s != 0);
    Rr_c = *(const uint4*)(cur + R_R + head * 64 + cs * 8);  Rr_p = hp ? *(const uint4*)(prv + R_R + head * 64 + cs * 8) : zero4;
    Rk_c = *(const uint4*)(cur + R_K + head * 64 + cs * 8);  Rk_p = hp ? *(const uint4*)(prv + R_K + head * 64 + cs * 8) : zero4;
    Rw_c = *(const uint4*)(cur + R_WD + cs * 8);             Rw_p = hp ? *(const uint4*)(prv + R_WD + cs * 8) : zero4;
    Ra_c = *(const uint4*)(cur + R_AD + cs * 8);             Ra_p = hp ? *(const uint4*)(prv + R_AD + cs * 8) : zero4;
    const int vo = R_V + head * 64 + 32 * half + (cs & 3) * 8;
    Rv_c = *(const uint4*)(cur + vo);                        Rv_p = hp ? *(const uint4*)(prv + vo) : zero4;
  };
  load_raw(0);
  __syncthreads();
  for (int tc = 0; tc < 128; ++tc) {
    const int lr = b * 4096 + tc * 32 + tt;
    float rm[8], km[8];
    {
      float cu[8], pv[8], t8[8];
      unpack8(Rr_c, cu); unpack8(Rr_p, pv);
#pragma unroll
      for (int e = 0; e < 8; ++e) rm[e] = cu[e] + (pv[e] - cu[e]) * PRM[0 * 64 + cs * 8 + e];
      unpack8(Rk_c, cu); unpack8(Rk_p, pv);
#pragma unroll
      for (int e = 0; e < 8; ++e) km[e] = cu[e] + (pv[e] - cu[e]) * PRM[1 * 64 + cs * 8 + e];
      unpack8(Rw_c, cu); unpack8(Rw_p, pv);
#pragma unroll
      for (int e = 0; e < 8; ++e) {
        float xw = cu[e] + (pv[e] - cu[e]) * PRM[2 * 64 + cs * 8 + e];
        float ee = ex2(xw * 2.8853900817779268f);
        t8[e] = 1.f - 2.f * frcp(ee + 1.f);
      }
      *(uint4*)(A1 + (0 * 32 + tt) * 72 + cs * 8) = pack8(t8);
      unpack8(Ra_c, cu); unpack8(Ra_p, pv);
#pragma unroll
      for (int e = 0; e < 8; ++e) t8[e] = cu[e] + (pv[e] - cu[e]) * PRM[3 * 64 + cs * 8 + e];
      *(uint4*)(A1 + (1 * 32 + tt) * 72 + cs * 8) = pack8(t8);
      unpack8(Rv_c, cu); unpack8(Rv_p, pv);
      if (cs < 4) {
#pragma unroll
        for (int e = 0; e < 8; ++e) Vst[tt * 32 + cs * 8 + e] = cu[e] + (pv[e] - cu[e]) * PRM[9 * 64 + cs * 8 + e];
      }
    }
    __syncthreads();
    {
      const int arr = w >> 1, nt = w & 1;
      f32x16 acc;
#pragma unroll
      for (int e = 0; e < 16; ++e) acc[e] = 0.f;
#pragma unroll
      for (int k4 = 0; k4 < 4; ++k4) {
        bf16x8 a = *(const bf16x8*)(A1 + (arr * 32 + r) * 72 + 16 * k4 + 8 * h);
        bf16x8 bw = *(const bf16x8*)(W2t + (arr * 64 + 32 * nt + r) * 72 + 16 * k4 + 8 * h);
        acc = MFMA32(a, bw, acc);
      }
#pragma unroll
      for (int e = 0; e < 16; ++e) LO[(arr * 32 + crow(e, h)) * 64 + 32 * nt + r] = acc[e];
    }
    __syncthreads();
    float lw[8], la[8];
    {
      float4 t0 = *(const float4*)(LO + (0 * 32 + tt) * 64 + cs * 8), t1 = *(const float4*)(LO + (0 * 32 + tt) * 64 + cs * 8 + 4);
      lw[0] = t0.x; lw[1] = t0.y; lw[2] = t0.z; lw[3] = t0.w; lw[4] = t1.x; lw[5] = t1.y; lw[6] = t1.z; lw[7] = t1.w;
      t0 = *(const float4*)(LO + (1 * 32 + tt) * 64 + cs * 8); t1 = *(const float4*)(LO + (1 * 32 + tt) * 64 + cs * 8 + 4);
      la[0] = t0.x; la[1] = t0.y; la[2] = t0.z; la[3] = t0.w; la[4] = t1.x; la[5] = t1.y; la[6] = t1.z; la[7] = t1.w;
    }
    {
      float dec[8], kk[8], av[8], kp[8];
      float ssq = 0.f, bon = 0.f;
#pragma unroll
      for (int e = 0; e < 8; ++e) {
        const int ch = cs * 8 + e;
        const float sg = frcp(1.f + fexp(-(lw[e] + PRM[4 * 64 + ch])));
        dec[e] = ex2(-0.8750340f * sg);
        float a = frcp(1.f + fexp(-(la[e] + PRM[5 * 64 + ch])));
        av[e] = a;
        kk[e] = km[e] * PRM[6 * 64 + ch];
        ssq += kk[e] * kk[e];
        kp[e] = km[e] * (1.f + (a - 1.f) * PRM[7 * 64 + ch]);
        bon += rm[e] * kp[e] * PRM[8 * 64 + ch];
      }
      ssq = red8(ssq); bon = red8(bon);
      const float inv = 1.f / fmaxf(sqrtf(ssq), 1e-12f);
      float nk[8], bb[8];
#pragma unroll
      for (int e = 0; e < 8; ++e) { float kn = kk[e] * inv; nk[e] = -kn; bb[e] = kn * av[e]; }
      float* pa = PA + tt * 320 + cs * 8;
      *(float4*)(pa) = make_float4(dec[0], dec[1], dec[2], dec[3]); *(float4*)(pa + 4) = make_float4(dec[4], dec[5], dec[6], dec[7]);
      *(float4*)(pa + 64) = make_float4(nk[0], nk[1], nk[2], nk[3]); *(float4*)(pa + 68) = make_float4(nk[4], nk[5], nk[6], nk[7]);
      *(float4*)(pa + 128) = make_float4(bb[0], bb[1], bb[2], bb[3]); *(float4*)(pa + 132) = make_float4(bb[4], bb[5], bb[6], bb[7]);
      *(float4*)(pa + 192) = make_float4(kp[0], kp[1], kp[2], kp[3]); *(float4*)(pa + 196) = make_float4(kp[4], kp[5], kp[6], kp[7]);
      *(float4*)(pa + 256) = make_float4(rm[0], rm[1], rm[2], rm[3]); *(float4*)(pa + 260) = make_float4(rm[4], rm[5], rm[6], rm[7]);
      if (cs == 0) BON[tt] = bon;
    }
    __syncthreads();
    if (tc + 1 < 128) load_raw(tc + 1);
    {
      const float* pa0 = PA + ks * 8;
      const float* vs0 = Vst + row32;
      float4 d0 = *(const float4*)(pa0), d1 = *(const float4*)(pa0 + 4);
      float4 n0 = *(const float4*)(pa0 + 64), n1 = *(const float4*)(pa0 + 68);
      float4 b0 = *(const float4*)(pa0 + 128), b1 = *(const float4*)(pa0 + 132);
      float4 k0 = *(const float4*)(pa0 + 192), k1 = *(const float4*)(pa0 + 196);
      float4 r0 = *(const float4*)(pa0 + 256), r1 = *(const float4*)(pa0 + 260);
      float vv = vs0[0];
#pragma unroll 2
      for (int t = 0; t < 32; ++t) {
        const float* pa = pa0 + (t + 1) * 320;
        const float4 xd0 = *(const float4*)(pa), xd1 = *(const float4*)(pa + 4);
        const float4 xn0 = *(const float4*)(pa + 64), xn1 = *(const float4*)(pa + 68);
        const float4 xb0 = *(const float4*)(pa + 128), xb1 = *(const float4*)(pa + 132);
        const float4 xk0 = *(const float4*)(pa + 192), xk1 = *(const float4*)(pa + 196);
        const float4 xr0 = *(const float4*)(pa + 256), xr1 = *(const float4*)(pa + 260);
        const float xvv = vs0[(t + 1) * 32];
        __builtin_amdgcn_sched_barrier(0);
        float sa0 = S[0] * n0.x, sa1 = S[1] * n0.y;
        sa0 = fmaf(S[2], n0.z, sa0); sa1 = fmaf(S[3], n0.w, sa1);
        sa0 = fmaf(S[4], n1.x, sa0); sa1 = fmaf(S[5], n1.y, sa1);
        sa0 = fmaf(S[6], n1.z, sa0); sa1 = fmaf(S[7], n1.w, sa1);
        float sa = red8(sa0 + sa1);
        S[0] = fmaf(sa, b0.x, fmaf(S[0], d0.x, vv * k0.x)); S[1] = fmaf(sa, b0.y, fmaf(S[1], d0.y, vv * k0.y));
        S[2] = fmaf(sa, b0.z, fmaf(S[2], d0.z, vv * k0.z)); S[3] = fmaf(sa, b0.w, fmaf(S[3], d0.w, vv * k0.w));
        S[4] = fmaf(sa, b1.x, fmaf(S[4], d1.x, vv * k1.x)); S[5] = fmaf(sa, b1.y, fmaf(S[5], d1.y, vv * k1.y));
        S[6] = fmaf(sa, b1.z, fmaf(S[6], d1.z, vv * k1.z)); S[7] = fmaf(sa, b1.w, fmaf(S[7], d1.w, vv * k1.w));
        float y0 = S[0] * r0.x, y1 = S[1] * r0.y;
        y0 = fmaf(S[2], r0.z, y0); y1 = fmaf(S[3], r0.w, y1);
        y0 = fmaf(S[4], r1.x, y0); y1 = fmaf(S[5], r1.y, y1);
        y0 = fmaf(S[6], r1.z, y0); y1 = fmaf(S[7], r1.w, y1);
        float y = red8(y0 + y1);
        if (ks == 0) Yst[t * 32 + row32] = y;
        __builtin_amdgcn_sched_barrier(0);
        d0 = xd0; d1 = xd1; n0 = xn0; n1 = xn1; b0 = xb0; b1 = xb1; k0 = xk0; k1 = xk1; r0 = xr0; r1 = xr1; vv = xvv;
      }
    }
    __syncthreads();
    {
      const int c4 = cs & 3;
      float y8[8], v8[8];
      float4 t0 = *(const float4*)(Yst + tt * 32 + c4 * 8), t1 = *(const float4*)(Yst + tt * 32 + c4 * 8 + 4);
      y8[0] = t0.x; y8[1] = t0.y; y8[2] = t0.z; y8[3] = t0.w; y8[4] = t1.x; y8[5] = t1.y; y8[6] = t1.z; y8[7] = t1.w;
      float sm = 0.f, sq = 0.f;
#pragma unroll
      for (int e = 0; e < 8; ++e) { sm += y8[e]; sq += y8[e] * y8[e]; }
      sm = red4(sm); sq = red4(sq);
      const float bon = BON[tt];
      t0 = *(const float4*)(Vst + tt * 32 + c4 * 8); t1 = *(const float4*)(Vst + tt * 32 + c4 * 8 + 4);
      v8[0] = t0.x * bon; v8[1] = t0.y * bon; v8[2] = t0.z * bon; v8[3] = t0.w * bon; v8[4] = t1.x * bon; v8[5] = t1.y * bon; v8[6] = t1.z * bon; v8[7] = t1.w * bon;
      if (cs < 4 && !dry) {
        const size_t o = (size_t)lr * 1536 + head * 64 + 32 * half + cs * 8;
        *(uint4*)(YR + o) = pack8(y8);
        *(uint4*)(BV + o) = pack8(v8);
        if (cs == 0) {
          float* stp = ST + ((size_t)(lr * 24 + head) * 2 + half) * 2;
          stp[0] = sm; stp[1] = sq;
        }
      }
    }
  }
  if (c == 0 && !dry) {
    float* sp = STATE + ((size_t)((b * 24 + head) * 64 + 32 * half + row32)) * 64 + 8 * ks;
#pragma unroll
    for (int i = 0; i < 8; ++i) sp[i] = S[i];
  }
}

DI void phase_scan(const Params& p, int L, int c, char* smem, int* s_item, bool dry) {
  for (int item = blockIdx.x; item < 192; item += gridDim.x) scan_item(p, L, c, item, smem, dry);
  int* cnt = (int*)(p.ws + OFF_CNT) + 64 + ((L * 2 + c) * 2 + (dry ? 1 : 0)) * 16 + 8;
  for (;;) {
    __syncthreads();
    if (otid() == 0) *s_item = atomicAdd(cnt, 1);
    __syncthreads();
    const int item = *s_item;
    if (item >= 512) break;
    memattn_item(p, L, c, item, smem, dry);
  }
}

DI void phase_finalize(const Params& p, int L, int c, bool dry) {
  const int j = L >> 1;
  u16* U = (u16*)(p.ws + OFF_U);
  const u16* YR = (const u16*)(p.ws + OFF_YR); const u16* BV = (const u16*)(p.ws + OFF_BV);
  const float* ST = (const float*)(p.ws + OFF_ST);
  const int G = gridDim.x;
  for (int idx = blockIdx.x * 256 + otid(); idx < TC * 192; idx += G * 256) {
    const int lr = idx / 192, c8 = idx - lr * 192, ch0 = c8 * 8, head = ch0 >> 6;
    const float4 st = *(const float4*)(ST + (size_t)(lr * 24 + head) * 4);
    const float mean = (st.x + st.z) * (1.f / 64.f);
    const float var = (st.y + st.w) * (1.f / 64.f) - mean * mean;
    const float rstd = rsqrtf(fmaxf(var, 0.f) + 64e-5f);
    float y[8], bv[8], g[8], o[8];
    unpack8(*(const uint4*)(YR + (size_t)lr * 1536 + ch0), y);
    unpack8(*(const uint4*)(BV + (size_t)lr * 1536 + ch0), bv);
    u16* gp = U + (size_t)lr * LDU_R + R_GATE + ch0;
    unpack8(*(const uint4*)gp, g);
    const float* gw = p.gn_w + j * 1536 + ch0; const float* gb = p.gn_b + j * 1536 + ch0;
#pragma unroll
    for (int e = 0; e < 8; ++e) o[e] = ((y[e] - mean) * rstd * gw[e] + gb[e] + bv[e]) * silu(g[e]);
    if (!dry) *(uint4*)gp = pack8(o);
  }
  if (c == 0) {
    u16* BND = (u16*)(p.ws + OFF_BND);
    for (int idx = blockIdx.x * 256 + otid(); idx < 4 * (SHIFTW / 8); idx += G * 256) {
      const int b = idx / (SHIFTW / 8), cc = idx - b * (SHIFTW / 8);
      *(uint4*)(BND + (size_t)b * SHIFTW + cc * 8) = *(const uint4*)(U + (size_t)(b * 4096 + 4095) * LDU_R + cc * 8);
    }
  }
}

enum { PH_PREP = 0, PH_NORM, PH_GEMM_IN, PH_KVPREP, PH_GEMM_UP, PH_ATTN, PH_SCAN, PH_FINALIZE, PH_GEMM_OUT, PH_FINAL };
constexpr int NSTEPS = 46;

DI void decode_step(int step, int& ph, int& L, int& c) {
  if (step == 0) { ph = PH_PREP; L = 0; c = 0; return; }
  if (step == NSTEPS - 1) { ph = PH_FINAL; L = 0; c = 0; return; }
  int s = step - 1;
  int pr = s / 22, rem = s - pr * 22;
  if (rem < 12) {
    L = 2 * pr; c = rem / 6; int k = rem - c * 6;
    ph = (k == 0) ? PH_NORM : (k == 1) ? PH_GEMM_IN : (k == 2) ? PH_KVPREP : (k == 3) ? PH_GEMM_UP : (k == 4) ? PH_ATTN : PH_GEMM_OUT;
  } else {
    rem -= 12; L = 2 * pr + 1; c = rem / 5; int k = rem - c * 5;
    ph = (k == 0) ? PH_NORM : (k == 1) ? PH_GEMM_IN : (k == 2) ? PH_SCAN : (k == 3) ? PH_FINALIZE : PH_GEMM_OUT;
  }
}

DI void run_step(const Params& p, int ph, int L, int c, char* smem, int* s_item, bool dry_in, int vt) {
  const bool dry = dry_in && !(HYP5 && (ph == PH_GEMM_IN || ph == PH_GEMM_UP));
  char* ws = p.ws;
  const bool rw = L & 1;
  const int j = L >> 1;
  switch (ph) {
    case PH_PREP: phase_prep(p, smem); break;
    case PH_NORM:
      phase_norm(p, L, c);
      if (L == 0 && c == 0) {
        EpiMemKV epi{(u16*)(ws + OFF_MEMK), (u16*)(ws + OFF_MEMVT), false};
        gemm_phase<2, false, 16>((const u16*)(ws + OFF_MEMH), 1024ull * 1024, 1024, (const u16*)(ws + OFF_WT_MEMKV), 1024ull * 1024, 1024, 4, 4, 8, 4, 1024, smem, epi, vt);
      }
      break;
    case PH_GEMM_IN:
      if (!rw) {
        EpiStoreBf16 epi{(u16*)(ws + OFF_U), LDU_M, LDU_M, dry};
        gemm_phase<2, true, 16>((const u16*)(ws + OFF_H), 0, 1024, (const u16*)(ws + OFF_WT_INMLA) + (size_t)j * 3328 * 1024, 0, 1024, 1, 64, 26, 4, 1024, smem, epi, vt);
      } else {
        EpiStoreBf16 epi{(u16*)(ws + OFF_U), LDU_R, LDU_R, dry};
        gemm_phase<2, true, 16>((const u16*)(ws + OFF_H), 0, 1024, (const u16*)(ws + OFF_WT_INRW) + (size_t)j * 7296 * 1024, 0, 1024, 1, 64, 57, 4, 1024, smem, epi, vt);
      }
      break;
    case PH_KVPREP: phase_kvprep(p, L, c, dry); break;
    case PH_GEMM_UP: {
      EpiUQ e1{(u16*)(ws + OFF_Q), (const float*)(ws + OFF_COS), (const float*)(ws + OFF_SIN), c, dry};
      gemm_phase<2, true, 6>((const u16*)(ws + OFF_U) + M_CQ, 0, LDU_M, (const u16*)(ws + OFF_WT_UQ) + (size_t)j * 2304 * 384, 0, 384, 1, 64, 18, 4, 384, smem, e1, vt);
      EpiUK e2{(u16*)(ws + OFF_K), dry};
      gemm_phase<2, true, 4>((const u16*)(ws + OFF_U) + M_CKV, 0, LDU_M, (const u16*)(ws + OFF_WT_UKV) + (size_t)j * 3072 * 256, 0, 256, 1, 64, 12, 4, 256, smem, e2, vt);
      EpiUV e3{(u16*)(ws + OFF_VT), dry};
      gemm_phase<2, false, 4>((const u16*)(ws + OFF_U) + M_CKV, 0, LDU_M, (const u16*)(ws + OFF_WT_UKV) + (size_t)j * 3072 * 256 + 1536ull * 256, 0, 256, 1, 64, 12, 4, 256, smem, e3, vt);
    } break;
    case PH_ATTN: phase_attn(p, L, c, smem, s_item, dry); break;
    case PH_SCAN: phase_scan(p, L, c, smem, s_item, dry); break;
    case PH_FINALIZE: phase_finalize(p, L, c, dry); break;
    case PH_GEMM_OUT: {
      EpiResid epi{(L == 0) ? p.x : (const float*)p.out, p.out, rw, c, dry};
      gemm_phase<2, true, 32>((const u16*)(ws + OFF_U) + (rw ? R_GATE : M_GATE), 0, rw ? LDU_R : LDU_M, (const u16*)(ws + OFF_WT_OUT) + (size_t)L * 1024 * 2048, 0, 2048,
                 1, 64, 8, 4, 2048, smem, epi, vt);
    } break;
    case PH_FINAL: phase_final_norm(p, dry); break;
  }
}

DI void grid_barrier(unsigned* bar, unsigned& epoch) {
  __syncthreads();
  ++epoch;
  if (threadIdx.x == 0) {
    __builtin_amdgcn_fence(__ATOMIC_RELEASE, "agent");
    asm volatile("s_waitcnt vmcnt(0)" ::: "memory");
    const unsigned target = epoch * gridDim.x;
    __hip_atomic_fetch_add(bar, 1u, __ATOMIC_RELAXED, __HIP_MEMORY_SCOPE_AGENT);
    unsigned spins = 0;
    while (__hip_atomic_load(bar, __ATOMIC_RELAXED, __HIP_MEMORY_SCOPE_AGENT) < target) {
      __builtin_amdgcn_s_sleep(2);
      if (++spins > (1u << 22)) break;
    }
    __builtin_amdgcn_fence(__ATOMIC_ACQUIRE, "agent");
    asm volatile("s_waitcnt vmcnt(0)" ::: "memory");
  }
  __syncthreads();
}

__global__ void __launch_bounds__(256, 1) hybrid_megakernel(Params p, int s_lo, int s_hi, int coop, int probe_mask) {
  __shared__ __attribute__((aligned(16))) char smem[SMEM_BYTES];
  __shared__ int s_item;
  unsigned* bar = (unsigned*)(p.ws + OFF_BAR);
  unsigned epoch = 0;
  if (coop == 2) cg::this_grid().sync();
  __shared__ int s_vt;
  int myx = 0, myrank = 0;
  if (coop && threadIdx.x == 0) {
    myx = (int)(__builtin_amdgcn_s_getreg((3 << 11) | 20) & 7u);
    myrank = (int)__hip_atomic_fetch_add(bar + 16 + myx, 1u, __ATOMIC_RELAXED, __HIP_MEMORY_SCOPE_AGENT);
  }
  int vt = blockIdx.x;
  {
    const int G = gridDim.x, t = blockIdx.x;
    vt = ((G & 7) == 0) ? ((t & 7) * (G >> 3) + (t >> 3)) : t;
  }
  for (int st = s_lo; st < s_hi; ++st) {
    int ph, L, c;
    decode_step(st, ph, L, c);
    for (int rep = ((probe_mask >> ph) & 1) ? 0 : 1; rep < 2; ++rep) {
      run_step(p, ph, L, c, smem, &s_item, rep == 0, vt);
      if (coop && (rep == 0 || st + 1 < s_hi)) grid_barrier(bar, epoch);
      if (coop) for (int xs = 0; xs < EXTRA_SYNCS; ++xs) grid_barrier(bar, epoch);
    }
    if (coop && st == s_lo) {
      if (threadIdx.x == 0) {
        const int G = gridDim.x;
        bool ok = (G & 7) == 0;
        for (int x = 0; x < 8; ++x) ok = ok && ((int)__hip_atomic_load(bar + 16 + x, __ATOMIC_RELAXED, __HIP_MEMORY_SCOPE_AGENT) == (G >> 3));
        s_vt = ok ? (myx * (G >> 3) + myrank) : vt;
      }
      __syncthreads();
      vt = s_vt;
    }
  }
}

extern "C" void kernel_launch(void* const* d_in, const int* in_sizes, int n_in, void* d_out, int out_size, void* d_ws, size_t ws_size,
                              hipStream_t stream) {
  if (ws_size < WS_NEED) { fprintf(stderr, "workspace too small: %zu < %zu\n", ws_size, (size_t)WS_NEED); return; }
  Params p;
  memset(&p, 0, sizeof(p));
  p.x = (const float*)d_in[0]; p.mem = (const float*)d_in[1]; p.pos = (const int*)d_in[2];
  p.norm_g = (const float*)d_in[3]; p.mem_norm_g = (const float*)d_in[4]; p.w_mem_kv = (const float*)d_in[5];
  p.w_in_mla = (const float*)d_in[6]; p.q_norm_g = (const float*)d_in[7]; p.kv_norm_g = (const float*)d_in[8];
  p.w_uq = (const float*)d_in[9]; p.w_ukv = (const float*)d_in[10]; p.w_in_rwkv = (const float*)d_in[11];
  p.mu = (const float*)d_in[12]; p.w0 = (const float*)d_in[13]; p.w2 = (const float*)d_in[14]; p.a0 = (const float*)d_in[15];
  p.a2 = (const float*)d_in[16]; p.k_k = (const float*)d_in[17]; p.k_a = (const float*)d_in[18]; p.r_k = (const float*)d_in[19];
  p.gn_w = (const float*)d_in[20]; p.gn_b = (const float*)d_in[21]; p.w_out = (const float*)d_in[22]; p.final_g = (const float*)d_in[23];
  p.out = (float*)d_out; p.ws = (char*)d_ws;
  static int grid_blocks = 0;
  if (!grid_blocks) {
    int dev = 0, cus = 0, per_cu = 0;
    hipGetDevice(&dev);
    hipDeviceGetAttribute(&cus, hipDeviceAttributeMultiprocessorCount, dev);
    hipOccupancyMaxActiveBlocksPerMultiprocessor(&per_cu, hybrid_megakernel, 256, 0);
    if (per_cu > 2) per_cu = 2;
    if (per_cu < 1) per_cu = 1;
    grid_blocks = cus * per_cu;
  }
#if MULTI_LAUNCH
  for (int s = 0; s < NSTEPS; ++s) hipLaunchKernelGGL(hybrid_megakernel, dim3(grid_blocks), dim3(256), 0, stream, p, s, s + 1, 0, 0);
#else
  int s_lo = 0, s_hi = NSTEPS, coop = 1, probe_mask = PROBE_MASK;
  void* args[] = {&p, &s_lo, &s_hi, &coop, &probe_mask};
  hipMemsetAsync((char*)d_ws + OFF_BAR, 0, 256, stream);
  hipError_t e = hipLaunchCooperativeKernel((void*)hybrid_megakernel, dim3(grid_blocks), dim3(256), args, 0, stream);
  if (e != hipSuccess) fprintf(stderr, "cooperative launch failed: %s (grid %d)\n", hipGetErrorString(e), grid_blocks);
#endif
}
```

```cpp
#include <hip/hip_runtime.h>
#include <hip/hip_cooperative_groups.h>
#include <cstdio>
#include <cstring>
namespace cg = cooperative_groups;

#define PROBE_MASK 0
#define EXTRA_SYNCS 0
#define HYP1 0
#define HYP2 0
#define HYP3 0
#define HYP4 0
#define HYP5 0
#define HYP6 0
#ifndef MULTI_LAUNCH
#define MULTI_LAUNCH 0
#endif

#define DI __device__ __forceinline__
typedef unsigned short u16;
typedef __attribute__((ext_vector_type(8))) short bf16x8;
typedef __attribute__((ext_vector_type(16))) float f32x16;
typedef __attribute__((ext_vector_type(2))) __bf16 bf2_t;
typedef __attribute__((ext_vector_type(2))) float f2_t;
typedef __attribute__((ext_vector_type(4))) unsigned u32x4;
typedef __attribute__((ext_vector_type(2))) unsigned u32x2;
#define MFMA32(a, b, c) __builtin_amdgcn_mfma_f32_32x32x16_bf16((a), (b), (c), 0, 0, 0)

constexpr int SEQ = 8192, TC = 16384;
constexpr int LDU_M = 3264, LDU_R = 7296;
constexpr int M_CQ = 0, M_CKV = 384, M_KR = 640, M_QM = 704, M_GATE = 1216;
constexpr int R_R = 0, R_K = 1536, R_V = 3072, R_WD = 4608, R_AD = 4672, R_QM = 4736, R_GATE = 5248;
constexpr int SHIFTW = 4736;

constexpr size_t OFF_WT_MEMKV = 0;
constexpr size_t OFF_WT_INMLA = OFF_WT_MEMKV + 4ull * 1024 * 1024 * 2;
constexpr size_t OFF_WT_UQ    = OFF_WT_INMLA + 2ull * 3328 * 1024 * 2;
constexpr size_t OFF_WT_UKV   = OFF_WT_UQ + 2ull * 2304 * 384 * 2;
constexpr size_t OFF_WT_INRW  = OFF_WT_UKV + 2ull * 3072 * 256 * 2;
constexpr size_t OFF_WT_OUT   = OFF_WT_INRW + 2ull * 7296 * 1024 * 2;
constexpr size_t OFF_MEMH     = OFF_WT_OUT + 4ull * 1024 * 2048 * 2;
constexpr size_t OFF_MEMK     = OFF_MEMH + 4ull * 1024 * 1024 * 2;
constexpr size_t OFF_MEMVT    = OFF_MEMK + 4ull * 4 * 4 * 256 * 128 * 2;
constexpr size_t OFF_COS      = OFF_MEMVT + 4ull * 4 * 4 * 256 * 128 * 2;
constexpr size_t OFF_SIN      = OFF_COS + 32768ull * 32 * 4;
constexpr size_t OFF_CNT      = OFF_SIN + 32768ull * 32 * 4;
constexpr size_t OFF_BAR      = OFF_CNT + 4096;
constexpr size_t OFF_STATE    = OFF_BAR + 256;
constexpr size_t OFF_BND      = OFF_STATE + 96ull * 4096 * 4;
constexpr size_t OFF_H        = OFF_BND + 5ull * 4736 * 2 + 128;
constexpr size_t OFF_R        = OFF_H + 16384ull * 1024 * 2;
constexpr size_t OFF_U        = OFF_R;
constexpr size_t OFF_Q        = OFF_R + 16384ull * 3264 * 2;
constexpr size_t OFF_K        = OFF_Q + 2ull * 12 * 8192 * 192 * 2;
constexpr size_t OFF_VT       = OFF_K + 2ull * 12 * 8192 * 192 * 2;
constexpr size_t OFF_YR       = OFF_R + 16384ull * 7296 * 2;
constexpr size_t OFF_BV       = OFF_YR + 16384ull * 1536 * 2;
constexpr size_t OFF_ST       = OFF_BV + 16384ull * 1536 * 2;
constexpr size_t OFF_BS       = OFF_ST + 16384ull * 24 * 4 * 4;
constexpr size_t WS_NEED      = OFF_BS + 16384ull * 24 * 4;

constexpr int SMEM_BYTES = 110592;

struct Params {
  const float *x, *mem; const int* pos;
  const float *norm_g, *mem_norm_g, *w_mem_kv, *w_in_mla, *q_norm_g, *kv_norm_g, *w_uq, *w_ukv, *w_in_rwkv;
  const float *mu, *w0, *w2, *a0, *a2, *k_k, *k_a, *r_k, *gn_w, *gn_b, *w_out, *final_g;
  float* out; char* ws;
};

DI int otid() { int t = threadIdx.x; asm volatile("" : "+v"(t)); return t; }
DI float bf2f(unsigned v) { return __uint_as_float(v << 16); }
DI unsigned pack2(float a, float b) { f2_t v = {a, b}; bf2_t r = __builtin_convertvector(v, bf2_t); return __builtin_bit_cast(unsigned, r); }
DI u16 f2bf(float a) { return (u16)(pack2(a, 0.f) & 0xffffu); }
DI float ex2(float x) { return __builtin_amdgcn_exp2f(x); }
DI float fexp(float x) { return __builtin_amdgcn_exp2f(x * 1.4426950408889634f); }
DI float frcp(float x) { return __builtin_amdgcn_rcpf(x); }
DI float silu(float g) { return g * frcp(1.f + fexp(-g)); }
DI float wave_sum(float v) { for (int o = 32; o > 0; o >>= 1) v += __shfl_xor(v, o); return v; }
DI int crow(int reg, int h) { return (reg & 3) + 8 * (reg >> 2) + 4 * h; }
DI float dppf(float x, const int ctrl_sel) {
  int xi;
  if (ctrl_sel == 0) xi = __builtin_amdgcn_update_dpp(0, __float_as_int(x), 0xB1, 0xf, 0xf, true);
  else if (ctrl_sel == 1) xi = __builtin_amdgcn_update_dpp(0, __float_as_int(x), 0x4E, 0xf, 0xf, true);
  else xi = __builtin_amdgcn_update_dpp(0, __float_as_int(x), 0x141, 0xf, 0xf, true);
  return __int_as_float(xi);
}
DI float red4(float x) { x += dppf(x, 0); x += dppf(x, 1); return x; }
DI float red8(float x) { x += dppf(x, 0); x += dppf(x, 1); x += dppf(x, 2); return x; }
DI int gtok(bool rw, int c, int lr) { return rw ? ((lr >> 12) * 8192 + c * 4096 + (lr & 4095)) : (c * 16384 + lr); }
DI void unpack8(const uint4& v, float* f) {
  f[0] = bf2f(v.x & 0xffffu); f[1] = bf2f(v.x >> 16); f[2] = bf2f(v.y & 0xffffu); f[3] = bf2f(v.y >> 16);
  f[4] = bf2f(v.z & 0xffffu); f[5] = bf2f(v.z >> 16); f[6] = bf2f(v.w & 0xffffu); f[7] = bf2f(v.w >> 16);
}
DI uint4 pack8(const float* f) { uint4 v; v.x = pack2(f[0], f[1]); v.y = pack2(f[2], f[3]); v.z = pack2(f[4], f[5]); v.w = pack2(f[6], f[7]); return v; }

DI void transpose_tile(const float* __restrict__ src, u16* __restrict__ dst, int K, int N, int tk, int tn, int drow, float* tile) {
  const int tid = otid();
  __syncthreads();
#pragma unroll
  for (int i = 0; i < 4; ++i) {
    int kr = (tid >> 4) + 16 * i, nc = (tid & 15) * 4;
    float4 v = *(const float4*)(src + (size_t)(tk * 64 + kr) * N + tn * 64 + nc);
    tile[kr * 65 + nc] = v.x; tile[kr * 65 + nc + 1] = v.y; tile[kr * 65 + nc + 2] = v.z; tile[kr * 65 + nc + 3] = v.w;
  }
  __syncthreads();
#pragma unroll
  for (int i = 0; i < 2; ++i) {
    int n = (tid >> 3) + 32 * i, kc = (tid & 7) * 8;
    float f[8];
#pragma unroll
    for (int e = 0; e < 8; ++e) f[e] = tile[(kc + e) * 65 + n];
    *(uint4*)(dst + (size_t)(drow + n) * K + tk * 64 + kc) = pack8(f);
  }
}

DI void rms_row_bf16(const float* __restrict__ src, const float* __restrict__ g, u16* __restrict__ dst, int lane) {
  float4 v[4]; float ss = 0.f;
#pragma unroll
  for (int i = 0; i < 4; ++i) { v[i] = *(const float4*)(src + i * 256 + lane * 4); ss += v[i].x * v[i].x + v[i].y * v[i].y + v[i].z * v[i].z + v[i].w * v[i].w; }
  ss = wave_sum(ss);
  float rs = rsqrtf(ss * (1.f / 1024.f) + 1e-6f);
#pragma unroll
  for (int i = 0; i < 4; ++i) {
    float4 gg = *(const float4*)(g + i * 256 + lane * 4);
    uint2 o; o.x = pack2(v[i].x * rs * gg.x, v[i].y * rs * gg.y); o.y = pack2(v[i].z * rs * gg.z, v[i].w * rs * gg.w);
    *(uint2*)(dst + i * 256 + lane * 4) = o;
  }
}

DI void phase_prep(const Params& p, char* smem) {
  const int tid = otid(), G = gridDim.x, bid = blockIdx.x;
  char* ws = p.ws;
  if (bid == 0) for (int i = tid; i < 1024; i += 256) ((int*)(ws + OFF_CNT))[i] = 0;
  float* tile = (float*)smem;
  for (int g0 = bid; g0 < 9168; g0 += G) {
    int g = g0;
    const float* src = nullptr; u16* dst = nullptr; int K = 0, N = 0; size_t dstr = 0; bool ukv = false;
    if (g < 1024) { src = p.w_mem_kv; dst = (u16*)(ws + OFF_WT_MEMKV); K = 1024; N = 1024; dstr = 1024ull * 1024; }
    else if ((g -= 1024) < 1632) { src = p.w_in_mla; dst = (u16*)(ws + OFF_WT_INMLA); K = 1024; N = 3264; dstr = 3328ull * 1024; }
    else if ((g -= 1632) < 432) { src = p.w_uq; dst = (u16*)(ws + OFF_WT_UQ); K = 384; N = 2304; dstr = 2304ull * 384; }
    else if ((g -= 432) < 384) { src = p.w_ukv; dst = (u16*)(ws + OFF_WT_UKV); K = 256; N = 3072; dstr = 3072ull * 256; ukv = true; }
    else if ((g -= 384) < 3648) { src = p.w_in_rwkv; dst = (u16*)(ws + OFF_WT_INRW); K = 1024; N = 7296; dstr = 7296ull * 1024; }
    else { g -= 3648; src = p.w_out; dst = (u16*)(ws + OFF_WT_OUT); K = 2048; N = 1024; dstr = 1024ull * 2048; }
    int ntn = N >> 6, per = (K >> 6) * ntn;
    int m = g / per, t = g - m * per;
    int tk = t / ntn, tn = t - tk * ntn;
    int drow = tn * 64;
    if (ukv) { const int hd = drow >> 8, dd = drow & 255; drow = (dd < 128) ? (hd * 128 + dd) : (1536 + hd * 128 + dd - 128); }
    transpose_tile(src + (size_t)m * K * N, dst + (size_t)m * dstr, K, N, tk, tn, drow, tile);
  }
  for (int i = bid * 256 + tid; i < 2 * 64 * 1024 / 8; i += G * 256) {
    int m = i / (64 * 1024 / 8), r = i - m * (64 * 1024 / 8);
    uint4 z; z.x = z.y = z.z = z.w = 0u;
    *(uint4*)((u16*)(ws + OFF_WT_INMLA) + (size_t)m * 3328 * 1024 + 3264ull * 1024 + (size_t)r * 8) = z;
  }
  for (int i = bid * 256 + tid; i < SHIFTW / 8; i += G * 256) { uint4 z; z.x = z.y = z.z = z.w = 0u; *(uint4*)((u16*)(ws + OFF_BND) + 4 * SHIFTW + i * 8) = z; }
  float* cs = (float*)(ws + OFF_COS); float* sn = (float*)(ws + OFF_SIN);
  for (int i = bid * 256 + tid; i < 32768 * 32; i += G * 256) {
    int tk = i >> 5, pi = i & 31;
    float inv_freq = (float)exp2(-(double)(2 * pi) / 64.0 * 13.287712379549449);
    float ang = (float)p.pos[tk] * inv_freq;
    double rev = (double)ang * 0.15915494309189535;
    float fr = (float)(rev - rint(rev));
    cs[i] = __builtin_amdgcn_cosf(fr); sn[i] = __builtin_amdgcn_sinf(fr);
  }
  const int w = tid >> 6, lane = tid & 63;
  for (int row = bid * 4 + w; row < 4096; row += G * 4) {
    int L = row >> 10, m = row & 1023;
    rms_row_bf16(p.mem + (size_t)m * 1024, p.mem_norm_g + L * 1024, (u16*)(ws + OFF_MEMH) + (size_t)row * 1024, lane);
  }
}

DI void phase_norm(const Params& p, int L, int c) {
  const int tid = otid(), w = tid >> 6, lane = tid & 63;
  const bool rw = L & 1;
  const float* xs = (L == 0) ? p.x : p.out;
  u16* H = (u16*)(p.ws + OFF_H);
  for (int lr = blockIdx.x * 4 + w; lr < TC; lr += gridDim.x * 4) {
    int gt = gtok(rw, c, lr);
    rms_row_bf16(xs + (size_t)gt * 1024, p.norm_g + L * 1024, H + (size_t)lr * 1024, lane);
  }
}

DI void phase_final_norm(const Params& p, bool dry) {
  const int tid = otid(), w = tid >> 6, lane = tid & 63;
  for (int row = blockIdx.x * 4 + w; row < 32768; row += gridDim.x * 4) {
    float* xr = p.out + (size_t)row * 1024;
    float4 v[4]; float ss = 0.f;
#pragma unroll
    for (int i = 0; i < 4; ++i) { v[i] = *(const float4*)(xr + i * 256 + lane * 4); ss += v[i].x * v[i].x + v[i].y * v[i].y + v[i].z * v[i].z + v[i].w * v[i].w; }
    ss = wave_sum(ss);
    float rs = rsqrtf(ss * (1.f / 1024.f) + 1e-6f);
#pragma unroll
    for (int i = 0; i < 4; ++i) {
      float4 gg = *(const float4*)(p.final_g + i * 256 + lane * 4);
      float4 o; o.x = v[i].x * rs * gg.x; o.y = v[i].y * rs * gg.y; o.z = v[i].z * rs * gg.z; o.w = v[i].w * rs * gg.w;
      if (!dry) *(float4*)(xr + i * 256 + lane * 4) = o;
    }
  }
}

template <int TJ, bool SWAP, int NK, class Epi>
DI void gemm_phase(const u16* __restrict__ A, size_t strideAz, int lda, const u16* __restrict__ Bt, size_t strideBz, int ldb,
                   int Z, int Mt, int Nt, int GM, int K, char* smem, const Epi& epi, int vt) {
  constexpr int BN = 64 * TJ;
  constexpr int NB = BN / 32;
  const int tid = otid(), w = tid >> 6, lane = tid & 63, r = lane & 31, h = lane >> 5;
  const int wm = w >> 1, wn = w & 1;
  u16* As = (u16*)smem;
  u16* Bs = As + 2 * 256 * 72;
  const int G = gridDim.x, per = Mt * Nt, total = Z * per;
  const int lrow = tid >> 3, lcc = (tid & 7) * 8;
  unsigned aoff[8], boff[NB];
#pragma unroll
  for (int i = 0; i < 8; ++i) aoff[i] = (unsigned)((lrow + 32 * i) * lda + lcc);
#pragma unroll
  for (int i = 0; i < NB; ++i) boff[i] = (unsigned)((lrow + 32 * i) * ldb + lcc);
  const int lds_st = lrow * 72 + lcc;
  for (int base = 0; base < total; base += G) {
    const int q = base + vt;
    if (q >= total) continue;
    const int z = q / per, qq = q - z * per;
    const int grp = qq / (GM * Nt), within = qq - grp * GM * Nt;
    const int mt = grp * GM + (within % GM), nt = within / GM;
    const u16* Ag = A + z * strideAz + (size_t)(mt * 256) * lda;
    const u16* Bg = Bt + z * strideBz + (size_t)(nt * BN) * ldb;
    u32x4 ra[2][8], rb[2][NB];
    f32x16 acc[4][TJ];
#pragma unroll
    for (int i = 0; i < 4; ++i)
#pragma unroll
      for (int j = 0; j < TJ; ++j)
#pragma unroll
        for (int e = 0; e < 16; ++e) acc[i][j][e] = 0.f;
    __syncthreads();
#pragma unroll
    for (int i = 0; i < 8; ++i) ra[0][i] = *(const u32x4*)(Ag + aoff[i]);
#pragma unroll
    for (int i = 0; i < NB; ++i) rb[0][i] = *(const u32x4*)(Bg + boff[i]);
#pragma unroll
    for (int i = 0; i < 8; ++i) ra[1][i] = *(const u32x4*)(Ag + 64 + aoff[i]);
#pragma unroll
    for (int i = 0; i < NB; ++i) rb[1][i] = *(const u32x4*)(Bg + 64 + boff[i]);
#pragma unroll
    for (int i = 0; i < 8; ++i) *(u32x4*)(As + lds_st + (32 * i) * 72) = ra[0][i];
#pragma unroll
    for (int i = 0; i < NB; ++i) *(u32x4*)(Bs + lds_st + (32 * i) * 72) = rb[0][i];
    __syncthreads();
#pragma unroll
    for (int kt = 0; kt < NK; ++kt) {
      constexpr int dummy = 0; (void)dummy;
      const int u = kt & 1;
      if (kt + 2 < NK) {
        const u16* ag = Ag + (kt + 2) * 64; const u16* bg = Bg + (kt + 2) * 64;
#pragma unroll
        for (int i = 0; i < 8; ++i) ra[u][i] = *(const u32x4*)(ag + aoff[i]);
#pragma unroll
        for (int i = 0; i < NB; ++i) rb[u][i] = *(const u32x4*)(bg + boff[i]);
      }
      const u16* as = As + u * 256 * 72 + (128 * wm + r) * 72 + 8 * h;
      const u16* bs = Bs + u * BN * 72 + (32 * TJ * wn + r) * 72 + 8 * h;
      bf16x8 af[2][4], bfr[2][TJ];
#pragma unroll
      for (int i = 0; i < 4; ++i) af[0][i] = *(const bf16x8*)(as + (32 * i) * 72);
#pragma unroll
      for (int j = 0; j < TJ; ++j) bfr[0][j] = *(const bf16x8*)(bs + (32 * j) * 72);
#pragma unroll
      for (int ks = 0; ks < 4; ++ks) {
        if (ks < 3) {
#pragma unroll
          for (int i = 0; i < 4; ++i) af[(ks + 1) & 1][i] = *(const bf16x8*)(as + (32 * i) * 72 + 16 * (ks + 1));
#pragma unroll
          for (int j = 0; j < TJ; ++j) bfr[(ks + 1) & 1][j] = *(const bf16x8*)(bs + (32 * j) * 72 + 16 * (ks + 1));
        }
        __builtin_amdgcn_sched_barrier(0);
#pragma unroll
        for (int i = 0; i < 4; ++i)
#pragma unroll
          for (int j = 0; j < TJ; ++j)
            acc[i][j] = SWAP ? MFMA32(bfr[ks & 1][j], af[ks & 1][i], acc[i][j]) : MFMA32(af[ks & 1][i], bfr[ks & 1][j], acc[i][j]);
        if (ks == 0 && kt + 1 < NK) {
          u16* ad = As + (u ^ 1) * 256 * 72 + lds_st; u16* bd = Bs + (u ^ 1) * BN * 72 + lds_st;
#pragma unroll
          for (int i = 0; i < 8; ++i) *(u32x4*)(ad + (32 * i) * 72) = ra[u ^ 1][i];
#pragma unroll
          for (int i = 0; i < NB; ++i) *(u32x4*)(bd + (32 * i) * 72) = rb[u ^ 1][i];
#pragma unroll
          for (int i = 0; i < 6; ++i) { __builtin_amdgcn_sched_group_barrier(0x008, 1, 0); __builtin_amdgcn_sched_group_barrier(0x200, 2, 0); }
        }
        __builtin_amdgcn_sched_barrier(0);
      }
      __syncthreads();
    }
#pragma unroll
    for (int i = 0; i < 4; ++i)
#pragma unroll
      for (int j = 0; j < TJ; ++j) {
        if (SWAP) epi(z, mt * 256 + 128 * wm + 32 * i + r, nt * BN + 32 * TJ * wn + 32 * j, h, acc[i][j]);
        else epi(z, mt * 256 + 128 * wm + 32 * i, nt * BN + 32 * TJ * wn + 32 * j + r, h, acc[i][j]);
      }
  }
}

struct EpiStoreBf16 {
  u16* C; int ldc; int ncols; bool dry;
  DI void operator()(int z, int row, int colbase, int h, const f32x16& a) const {
    if (dry) return;
#pragma unroll
    for (int g = 0; g < 4; ++g) {
      const int col = colbase + 8 * g + 4 * h;
      if (col < ncols) {
        u32x2 pk = {pack2(a[4 * g], a[4 * g + 1]), pack2(a[4 * g + 2], a[4 * g + 3])};
        *(u32x2*)(C + (size_t)row * ldc + col) = pk;
      }
    }
  }
};
struct EpiResid {
  const float* xin; float* xout; bool rw; int c; bool dry;
  DI void operator()(int z, int row, int colbase, int h, const f32x16& a) const {
    if (dry) return;
    const size_t o = (size_t)gtok(rw, c, row) * 1024 + colbase + 4 * h;
#pragma unroll
    for (int g = 0; g < 4; ++g) {
      float4 v = *(const float4*)(xin + o + 8 * g);
      v.x += a[4 * g]; v.y += a[4 * g + 1]; v.z += a[4 * g + 2]; v.w += a[4 * g + 3];
      *(float4*)(xout + o + 8 * g) = v;
    }
  }
};
struct EpiUQ {
  u16* Q; const float* cs; const float* sn; int c; bool dry;
  DI void operator()(int z, int row, int colbase, int h, const f32x16& a) const {
    if (dry) return;
    const int head = colbase / 192, db = colbase - head * 192;
    const int lb = row >> 13, s = row & 8191;
    u16* qp = Q + ((size_t)(lb * 12 + head) * 8192 + s) * 192 + db + 4 * h;
    const size_t ti = (size_t)(c * 16384 + row) * 32;
#pragma unroll
    for (int g = 0; g < 4; ++g) {
      float v0 = a[4 * g], v1 = a[4 * g + 1], v2 = a[4 * g + 2], v3 = a[4 * g + 3];
      if (db >= 128) {
        const int pi = (db - 128 + 8 * g + 4 * h) >> 1;
        const float2 cc = *(const float2*)(cs + ti + pi), ss = *(const float2*)(sn + ti + pi);
        const float o0 = v0 * cc.x - v1 * ss.x, o1 = v0 * ss.x + v1 * cc.x;
        const float o2 = v2 * cc.y - v3 * ss.y, o3 = v2 * ss.y + v3 * cc.y;
        v0 = o0; v1 = o1; v2 = o2; v3 = o3;
      }
      u32x2 pk = {pack2(v0, v1), pack2(v2, v3)};
      *(u32x2*)(qp + 8 * g) = pk;
    }
  }
};
struct EpiUK {
  u16* Kb; bool dry;
  DI void operator()(int z, int row, int colbase, int h, const f32x16& a) const {
    if (dry) return;
    const int head = colbase >> 7, db = colbase & 127;
    const int lb = row >> 13, s = row & 8191;
    u16* kp = Kb + ((size_t)(lb * 12 + head) * 8192 + s) * 192 + db + 4 * h;
#pragma unroll
    for (int g = 0; g < 4; ++g) {
      u32x2 pk = {pack2(a[4 * g], a[4 * g + 1]), pack2(a[4 * g + 2], a[4 * g + 3])};
      *(u32x2*)(kp + 8 * g) = pk;
    }
  }
};
struct EpiUV {
  u16* Vt; bool dry;
  DI void operator()(int z, int rowbase, int col, int h, const f32x16& a) const {
    if (dry) return;
    const int head = col >> 7, d = col & 127;
#pragma unroll
    for (int g = 0; g < 4; ++g) {
      int lr = rowbase + 8 * g + 4 * h; int lb = lr >> 13, s = lr & 8191;
      u32x2 pk = {pack2(a[4 * g], a[4 * g + 1]), pack2(a[4 * g + 2], a[4 * g + 3])};
      *(u32x2*)(Vt + (((size_t)(lb * 12 + head) * 128 + (s >> 6)) * 128 + d) * 64 + (s & 63)) = pk;
    }
  }
};
struct EpiMemKV {
  u16* MK; u16* MVt; bool dry;
  DI void operator()(int z, int rowbase, int col, int h, const f32x16& a) const {
    if (col < 512) {
      const int xh = col >> 7, d = col & 127;
#pragma unroll
      for (int e = 0; e < 16; ++e) {
        int m = rowbase + crow(e, h); int b = m >> 8, mi = m & 255;
        MK[((size_t)((z * 4 + b) * 4 + xh) * 256 + mi) * 128 + d] = f2bf(a[e]);
      }
    } else {
      const int n = col - 512, xh = n >> 7, d = n & 127;
#pragma unroll
      for (int g = 0; g < 4; ++g) {
        int m = rowbase + 8 * g + 4 * h; int b = m >> 8, mi = m & 255;
        uint2 pk; pk.x = pack2(a[4 * g], a[4 * g + 1]); pk.y = pack2(a[4 * g + 2], a[4 * g + 3]);
        *(uint2*)(MVt + (((size_t)((z * 4 + b) * 4 + xh) * 4 + (mi >> 6)) * 128 + d) * 64 + (mi & 63)) = pk;
      }
    }
  }
};

DI void phase_kvprep(const Params& p, int L, int c, bool dry) {
  const int tid = otid(), w = tid >> 6, lane = tid & 63;
  const int j = L >> 1;
  u16* U = (u16*)(p.ws + OFF_U); u16* Kb = (u16*)(p.ws + OFF_K);
  const float* cs = (const float*)(p.ws + OFF_COS); const float* sn = (const float*)(p.ws + OFF_SIN);
  for (int lr = blockIdx.x * 4 + w; lr < TC; lr += gridDim.x * 4) {
    u16* row = U + (size_t)lr * LDU_M;
    float fq[8], fk[8]; float sq = 0.f, sk = 0.f;
    if (lane < 48) { uint4 v = *(const uint4*)(row + M_CQ + lane * 8); unpack8(v, fq);
#pragma unroll
      for (int e = 0; e < 8; ++e) sq += fq[e] * fq[e]; }
    if (lane < 32) { uint4 v = *(const uint4*)(row + M_CKV + lane * 8); unpack8(v, fk);
#pragma unroll
      for (int e = 0; e < 8; ++e) sk += fk[e] * fk[e]; }
    sq = wave_sum(sq); sk = wave_sum(sk);
    float rq = rsqrtf(sq * (1.f / 384.f) + 1e-6f), rk = rsqrtf(sk * (1.f / 256.f) + 1e-6f);
    if (dry) continue;
    if (lane < 48) {
      const float* g = p.q_norm_g + j * 384 + lane * 8;
#pragma unroll
      for (int e = 0; e < 8; ++e) fq[e] = fq[e] * rq * g[e];
      *(uint4*)(row + M_CQ + lane * 8) = pack8(fq);
    }
    if (lane < 32) {
      const float* g = p.kv_norm_g + j * 256 + lane * 8;
#pragma unroll
      for (int e = 0; e < 8; ++e) fk[e] = fk[e] * rk * g[e];
      *(uint4*)(row + M_CKV + lane * 8) = pack8(fk);
    }
    if (lane < 8) {
      float f[8], o[8]; uint4 v = *(const uint4*)(row + M_KR + lane * 8); unpack8(v, f);
      int gt = c * 16384 + lr;
#pragma unroll
      for (int i = 0; i < 4; ++i) {
        float cc = cs[gt * 32 + lane * 4 + i], ss = sn[gt * 32 + lane * 4 + i];
        o[2 * i] = f[2 * i] * cc - f[2 * i + 1] * ss; o[2 * i + 1] = f[2 * i] * ss + f[2 * i + 1] * cc;
      }
      uint4 pk = pack8(o);
      int lb = lr >> 13, s = lr & 8191;
#pragma unroll
      for (int hd = 0; hd < 12; ++hd) *(uint4*)(Kb + ((size_t)(lb * 12 + hd) * 8192 + s) * 192 + 128 + lane * 8) = pk;
    }
  }
}

template <int DQK>
DI void attn_item(const u16* __restrict__ Qp, int ldq, const u16* __restrict__ Kp, const u16* __restrict__ Vtp, int ldv,
                  int nkt, int q0, bool causal, float c, u16* Yp, int ldy, char* smem, bool dry) {
  constexpr int KLD = DQK + 8;
  constexpr int NKC = DQK * 64 / 8 / 256;
  constexpr int NKS = DQK / 16;
  constexpr int CPR = DQK / 8;
  constexpr int BUFE = 64 * KLD + 128 * 72;
  u16* L0 = (u16*)smem;
  const int tid = otid(), w = tid >> 6, lane = tid & 63, r = lane & 31, h = lane >> 5;
  bf16x8 qf[NKS];
  {
    const u16* qrow = Qp + (size_t)(32 * w + r) * ldq + 8 * h;
#pragma unroll
    for (int ks = 0; ks < NKS; ++ks) qf[ks] = *(const bf16x8*)(qrow + 16 * ks);
  }
  f32x16 o[4];
#pragma unroll
  for (int dt = 0; dt < 4; ++dt)
#pragma unroll
    for (int e = 0; e < 16; ++e) o[dt][e] = 0.f;
  float m = -INFINITY, l = 0.f;
  u32x4 kst[NKC], vst[4];
  const int vd = tid >> 3, vc8 = tid & 7;
  int kso[NKC];
#pragma unroll
  for (int i = 0; i < NKC; ++i) { int id = tid + 256 * i; int row = id / CPR, cc = id - row * CPR; kso[i] = row * KLD + cc * 8; }
  const int vso = 64 * KLD + vd * 72 + 16 * (vc8 >> 1) + 4 * (vc8 & 1);
  __syncthreads();
#pragma unroll
  for (int i = 0; i < NKC; ++i) kst[i] = *(const u32x4*)(Kp + (size_t)(tid + 256 * i) * 8);
#pragma unroll
  for (int i = 0; i < 4; ++i) vst[i] = *(const u32x4*)(Vtp + (size_t)(tid + 256 * i) * 8);
#pragma unroll
  for (int i = 0; i < NKC; ++i) *(u32x4*)(L0 + kso[i]) = kst[i];
#pragma unroll
  for (int i = 0; i < 4; ++i) {
    u16* dst = L0 + vso + (32 * i) * 72;
    u32x2 lo = {vst[i].x, vst[i].y}, hi = {vst[i].z, vst[i].w};
    *(u32x2*)dst = lo; *(u32x2*)(dst + 8) = hi;
  }
  if (nkt > 1) {
    const u16* kg = Kp + (size_t)64 * DQK;
#pragma unroll
    for (int i = 0; i < NKC; ++i) kst[i] = *(const u32x4*)(kg + (size_t)(tid + 256 * i) * 8);
#pragma unroll
    for (int i = 0; i < 4; ++i) vst[i] = *(const u32x4*)(Vtp + 8192 + (size_t)(tid + 256 * i) * 8);
  }
  __syncthreads();
  const int qmin = q0 + 32 * w;
  for (int kt = 0; kt < nkt; ++kt) {
    const u16* Ks = L0 + (kt & 1) * BUFE;
    const u16* Vs = Ks + 64 * KLD;
    u16* Ln = L0 + ((kt + 1) & 1) * BUFE;
    const bool active = !(causal && kt * 64 > qmin + 31);
    f32x16 s0, s1;
#pragma unroll
    for (int e = 0; e < 16; ++e) { s0[e] = 0.f; s1[e] = 0.f; }
    const u16* k0 = Ks + r * KLD + 8 * h;
    bf16x8 ka[2][2];
    if (active) {
      ka[0][0] = *(const bf16x8*)(k0); ka[0][1] = *(const bf16x8*)(k0 + 32 * KLD);
      ka[1][0] = *(const bf16x8*)(k0 + 16); ka[1][1] = *(const bf16x8*)(k0 + 32 * KLD + 16);
      __builtin_amdgcn_sched_barrier(0);
      s0 = MFMA32(ka[0][0], qf[0], s0); s1 = MFMA32(ka[0][1], qf[0], s1);
    }
    if (kt + 1 < nkt) {
#pragma unroll
      for (int i = 0; i < NKC; ++i) *(u32x4*)(Ln + kso[i]) = kst[i];
#pragma unroll
      for (int i = 0; i < 4; ++i) {
        u16* dst = Ln + vso + (32 * i) * 72;
        u32x2 lo = {vst[i].x, vst[i].y}, hi = {vst[i].z, vst[i].w};
        *(u32x2*)dst = lo; *(u32x2*)(dst + 8) = hi;
      }
    }
    if (kt + 2 < nkt) {
      const u16* kg = Kp + (size_t)(kt + 2) * 64 * DQK;
#pragma unroll
      for (int i = 0; i < NKC; ++i) kst[i] = *(const u32x4*)(kg + (size_t)(tid + 256 * i) * 8);
#pragma unroll
      for (int i = 0; i < 4; ++i) vst[i] = *(const u32x4*)(Vtp + (size_t)(kt + 2) * 8192 + (size_t)(tid + 256 * i) * 8);
    }
    if (active) {
      __builtin_amdgcn_sched_barrier(0);
#pragma unroll
      for (int ks = 1; ks < NKS; ++ks) {
        if (ks + 1 < NKS) {
          ka[(ks + 1) & 1][0] = *(const bf16x8*)(k0 + 16 * (ks + 1));
          ka[(ks + 1) & 1][1] = *(const bf16x8*)(k0 + 32 * KLD + 16 * (ks + 1));
        }
        __builtin_amdgcn_sched_barrier(0);
        s0 = MFMA32(ka[ks & 1][0], qf[ks], s0); s1 = MFMA32(ka[ks & 1][1], qf[ks], s1);
        __builtin_amdgcn_sched_barrier(0);
      }
      const u16* v0 = Vs + r * 72 + 8 * h;
      bf16x8 va[2][4];
#pragma unroll
      for (int dt = 0; dt < 4; ++dt) va[0][dt] = *(const bf16x8*)(v0 + (32 * dt) * 72);
      if (causal && kt * 64 + 63 > qmin) {
        const int qi = qmin + r;
#pragma unroll
        for (int e = 0; e < 16; ++e) {
          int key = kt * 64 + crow(e, h);
          if (key > qi) s0[e] = -INFINITY;
          if (key + 32 > qi) s1[e] = -INFINITY;
        }
      }
      float mx = fmaxf(s0[0], s1[0]);
#pragma unroll
      for (int e = 1; e < 16; ++e) mx = fmaxf(mx, fmaxf(s0[e], s1[e]));
      mx = fmaxf(mx, __shfl_xor(mx, 32));
      if (__builtin_amdgcn_ballot_w64((mx - m) * c > 8.f) != 0ull) {
        const float mn = fmaxf(m, mx);
        const float alpha = ex2((m - mn) * c);
        m = mn;
        l *= alpha;
#pragma unroll
        for (int dt = 0; dt < 4; ++dt)
#pragma unroll
          for (int e = 0; e < 16; ++e) o[dt][e] *= alpha;
      }
      const float mc = m * c;
      float ps = 0.f;
#pragma unroll
      for (int e = 0; e < 16; ++e) { s0[e] = ex2(fmaf(s0[e], c, -mc)); s1[e] = ex2(fmaf(s1[e], c, -mc)); ps += s0[e] + s1[e]; }
      l += ps;
      bf16x8 pf[4];
      {
        u32x4 t;
        t.x = pack2(s0[0], s0[1]); t.y = pack2(s0[2], s0[3]); t.z = pack2(s0[4], s0[5]); t.w = pack2(s0[6], s0[7]); pf[0] = __builtin_bit_cast(bf16x8, t);
        t.x = pack2(s0[8], s0[9]); t.y = pack2(s0[10], s0[11]); t.z = pack2(s0[12], s0[13]); t.w = pack2(s0[14], s0[15]); pf[1] = __builtin_bit_cast(bf16x8, t);
        t.x = pack2(s1[0], s1[1]); t.y = pack2(s1[2], s1[3]); t.z = pack2(s1[4], s1[5]); t.w = pack2(s1[6], s1[7]); pf[2] = __builtin_bit_cast(bf16x8, t);
        t.x = pack2(s1[8], s1[9]); t.y = pack2(s1[10], s1[11]); t.z = pack2(s1[12], s1[13]); t.w = pack2(s1[14], s1[15]); pf[3] = __builtin_bit_cast(bf16x8, t);
      }
#pragma unroll
      for (int kk = 0; kk < 4; ++kk) {
        if (kk < 3) {
#pragma unroll
          for (int dt = 0; dt < 4; ++dt) va[(kk + 1) & 1][dt] = *(const bf16x8*)(v0 + (32 * dt) * 72 + 16 * (kk + 1));
        }
        __builtin_amdgcn_sched_barrier(0);
#pragma unroll
        for (int dt = 0; dt < 4; ++dt) o[dt] = MFMA32(va[kk & 1][dt], pf[kk], o[dt]);
        __builtin_amdgcn_sched_barrier(0);
      }
    }
    __syncthreads();
  }
  const float lt = l + __shfl_xor(l, 32);
  const float inv = 1.f / lt;
  if (dry) return;
  u16* yrow = Yp + (size_t)(32 * w + r) * ldy;
#pragma unroll
  for (int dt = 0; dt < 4; ++dt)
#pragma unroll
    for (int g = 0; g < 4; ++g) {
      const int d = 32 * dt + 8 * g + 4 * h;
      uint2 gv = *(const uint2*)(yrow + d);
      float g0 = bf2f(gv.x & 0xffffu), g1 = bf2f(gv.x >> 16), g2 = bf2f(gv.y & 0xffffu), g3 = bf2f(gv.y >> 16);
      uint2 ov;
      ov.x = pack2(o[dt][4 * g] * inv * silu(g0), o[dt][4 * g + 1] * inv * silu(g1));
      ov.y = pack2(o[dt][4 * g + 2] * inv * silu(g2), o[dt][4 * g + 3] * inv * silu(g3));
      *(uint2*)(yrow + d) = ov;
    }
}

template <int DQK>
DI void attn_item_c(const u16* __restrict__ Qp, int ldq, const u16* __restrict__ Kp, const u16* __restrict__ Vtp, int ldv,
                    int nkt, int q0, float c, u16* Yp, int ldy, char* smem, bool dry) {
  constexpr int KLD = DQK + 8;
  constexpr int NKC = DQK * 64 / 8 / 256;
  constexpr int NKS = DQK / 16;
  constexpr int CPR = DQK / 8;
  constexpr int BUFE = 64 * KLD + 128 * 72;
  u16* L0 = (u16*)smem;
  const int tid = otid(), w = tid >> 6, lane = tid & 63, r = lane & 31, h = lane >> 5;
  bf16x8 qf[NKS];
  {
    const u16* qrow = Qp + (size_t)(32 * w + r) * ldq + 8 * h;
#pragma unroll
    for (int ks = 0; ks < NKS; ++ks) qf[ks] = *(const bf16x8*)(qrow + 16 * ks);
  }
  f32x16 o[4];
#pragma unroll
  for (int dt = 0; dt < 4; ++dt)
#pragma unroll
    for (int e = 0; e < 16; ++e) o[dt][e] = 0.f;
  float m = -INFINITY, l = 0.f;
  u32x4 kstA[NKC], vstA[4], kstB[NKC], vstB[4];
  const int vd = tid >> 3, vc8 = tid & 7;
  int kso[NKC];
#pragma unroll
  for (int i = 0; i < NKC; ++i) { int id = tid + 256 * i; int row = id / CPR, cc = id - row * CPR; kso[i] = row * KLD + cc * 8; }
  const int vso = 64 * KLD + vd * 72 + 16 * (vc8 >> 1) + 4 * (vc8 & 1);
  const int nktp = (nkt + 3) & ~3;
  auto gload = [&](u32x4* ks_, u32x4* vs_, int j) {
    const u16* kg = Kp + (size_t)(j + 1) * 64 * DQK;
#pragma unroll
    for (int i = 0; i < NKC; ++i) ks_[i] = *(const u32x4*)(kg + (size_t)(tid + 256 * i) * 8);
#pragma unroll
    for (int i = 0; i < 4; ++i) vs_[i] = *(const u32x4*)(Vtp + (size_t)j * 8192 + (size_t)(tid + 256 * i) * 8);
  };
  auto lstore = [&](const u32x4* ks_, const u32x4* vs_, u16* Lb) {
#pragma unroll
    for (int i = 0; i < NKC; ++i) *(u32x4*)(Lb + kso[i]) = ks_[i];
#pragma unroll
    for (int i = 0; i < 4; ++i) {
      u16* dst = Lb + vso + (32 * i) * 72;
      u32x2 lo = {vs_[i].x, vs_[i].y}, hi = {vs_[i].z, vs_[i].w};
      *(u32x2*)dst = lo; *(u32x2*)(dst + 8) = hi;
    }
  };
  __syncthreads();
  gload(kstA, vstA, 0);
  gload(kstB, vstB, 1);
  f32x16 sa0, sa1, sb0, sb1;
#pragma unroll
  for (int e = 0; e < 16; ++e) { sa0[e] = 0.f; sa1[e] = 0.f; }
  {
    const u16* kr = Kp + (size_t)r * DQK + 8 * h;
#pragma unroll
    for (int ks = 0; ks < NKS; ++ks) {
      bf16x8 a0 = *(const bf16x8*)(kr + 16 * ks), a1 = *(const bf16x8*)(kr + 32 * DQK + 16 * ks);
      sa0 = MFMA32(a0, qf[ks], sa0); sa1 = MFMA32(a1, qf[ks], sa1);
    }
  }
  lstore(kstA, vstA, L0);
  gload(kstA, vstA, 2);
  __syncthreads();
  const int qmin = q0 + 32 * w;
  const int qi = qmin + r;
  auto body = [&](int kt, u32x4* wk, u32x4* wv, f32x16& s0, f32x16& s1, f32x16& n0, f32x16& n1) {
    const u16* Ks = L0 + (kt & 1) * BUFE;
    const u16* Vs = Ks + 64 * KLD;
    u16* Ln = L0 + ((kt + 1) & 1) * BUFE;
    const bool active = !(kt * 64 > qmin + 31);
    if (kt * 64 + 63 > qmin) {
#pragma unroll
      for (int e = 0; e < 16; ++e) {
        int key = kt * 64 + crow(e, h);
        if (key > qi) s0[e] = -INFINITY;
        if (key + 32 > qi) s1[e] = -INFINITY;
      }
    }
    float mx = fmaxf(s0[0], s1[0]);
#pragma unroll
    for (int e = 1; e < 16; ++e) mx = fmaxf(mx, fmaxf(s0[e], s1[e]));
    mx = fmaxf(mx, __shfl_xor(mx, 32));
    if (__builtin_amdgcn_ballot_w64((mx - m) * c > 8.f) != 0ull) {
      const float mn = fmaxf(m, mx);
      const float alpha = ex2((m - mn) * c);
      m = mn;
      l *= alpha;
#pragma unroll
      for (int dt = 0; dt < 4; ++dt)
#pragma unroll
        for (int e = 0; e < 16; ++e) o[dt][e] *= alpha;
    }
    const float mc = m * c;
#pragma unroll
    for (int e = 0; e < 16; ++e) { n0[e] = 0.f; n1[e] = 0.f; }
    const u16* k0 = Ks + r * KLD + 8 * h;
    bf16x8 ka[2][2];
    ka[0][0] = *(const bf16x8*)(k0); ka[0][1] = *(const bf16x8*)(k0 + 32 * KLD);
    bf16x8 pf[4];
    u32x4 pk[4];
    float ps = 0.f;
#pragma unroll
    for (int ks = 0; ks < NKS; ++ks) {
      if (ks + 1 < NKS) {
        ka[(ks + 1) & 1][0] = *(const bf16x8*)(k0 + 16 * (ks + 1));
        ka[(ks + 1) & 1][1] = *(const bf16x8*)(k0 + 32 * KLD + 16 * (ks + 1));
      }
      __builtin_amdgcn_sched_barrier(0);
      n0 = MFMA32(ka[ks & 1][0], qf[ks], n0); n1 = MFMA32(ka[ks & 1][1], qf[ks], n1);
      if (ks < 8) {
#pragma unroll
        for (int e4 = 0; e4 < 4; ++e4) {
          const int e = (4 * ks + e4) & 15;
          if (ks < 4) { s0[e] = ex2(fmaf(s0[e], c, -mc)); ps += s0[e]; }
          else        { s1[e] = ex2(fmaf(s1[e], c, -mc)); ps += s1[e]; }
        }
      }
      if (ks == 1) {
        lstore(wk, wv, Ln);
        gload(wk, wv, kt + 3);
      }
      if (ks == 4)  { pk[0].x = pack2(s0[0], s0[1]);  pk[0].y = pack2(s0[2], s0[3]);   pk[0].z = pack2(s0[4], s0[5]);   pk[0].w = pack2(s0[6], s0[7]); }
      if (ks == 5)  { pk[1].x = pack2(s0[8], s0[9]);  pk[1].y = pack2(s0[10], s0[11]); pk[1].z = pack2(s0[12], s0[13]); pk[1].w = pack2(s0[14], s0[15]); }
      if (ks == 8)  { pk[2].x = pack2(s1[0], s1[1]);  pk[2].y = pack2(s1[2], s1[3]);   pk[2].z = pack2(s1[4], s1[5]);   pk[2].w = pack2(s1[6], s1[7]); }
      if (ks == 9)  { pk[3].x = pack2(s1[8], s1[9]);  pk[3].y = pack2(s1[10], s1[11]); pk[3].z = pack2(s1[12], s1[13]); pk[3].w = pack2(s1[14], s1[15]); }
      __builtin_amdgcn_sched_barrier(0);
    }
    l += ps;
#pragma unroll
    for (int i = 0; i < 4; ++i) pf[i] = __builtin_bit_cast(bf16x8, pk[i]);
    if (active) {
      const u16* v0 = Vs + r * 72 + 8 * h;
      bf16x8 va[2][4];
#pragma unroll
      for (int dt = 0; dt < 4; ++dt) va[0][dt] = *(const bf16x8*)(v0 + (32 * dt) * 72);
#pragma unroll
      for (int kk = 0; kk < 4; ++kk) {
        if (kk < 3) {
#pragma unroll
          for (int dt = 0; dt < 4; ++dt) va[(kk + 1) & 1][dt] = *(const bf16x8*)(v0 + (32 * dt) * 72 + 16 * (kk + 1));
        }
        __builtin_amdgcn_sched_barrier(0);
#pragma unroll
        for (int dt = 0; dt < 4; ++dt) o[dt] = MFMA32(va[kk & 1][dt], pf[kk], o[dt]);
        __builtin_amdgcn_sched_barrier(0);
      }
    }
    __syncthreads();
  };
  for (int kt4 = 0; kt4 < nktp; kt4 += 4) {
    body(kt4 + 0, kstB, vstB, sa0, sa1, sb0, sb1); body(kt4 + 1, kstA, vstA, sb0, sb1, sa0, sa1);
    body(kt4 + 2, kstB, vstB, sa0, sa1, sb0, sb1); body(kt4 + 3, kstA, vstA, sb0, sb1, sa0, sa1);
  }
  const float lt = l + __shfl_xor(l, 32);
  const float inv = 1.f / lt;
  if (dry) return;
  u16* yrow = Yp + (size_t)(32 * w + r) * ldy;
#pragma unroll
  for (int dt = 0; dt < 4; ++dt)
#pragma unroll
    for (int g = 0; g < 4; ++g) {
      const int d = 32 * dt + 8 * g + 4 * h;
      uint2 gv = *(const uint2*)(yrow + d);
      float g0 = bf2f(gv.x & 0xffffu), g1 = bf2f(gv.x >> 16), g2 = bf2f(gv.y & 0xffffu), g3 = bf2f(gv.y >> 16);
      uint2 ov;
      ov.x = pack2(o[dt][4 * g] * inv * silu(g0), o[dt][4 * g + 1] * inv * silu(g1));
      ov.y = pack2(o[dt][4 * g + 2] * inv * silu(g2), o[dt][4 * g + 3] * inv * silu(g3));
      *(uint2*)(yrow + d) = ov;
    }
}

DI void memattn_item(const Params& p, int L, int c, int item, char* smem, bool dry) {
  const bool rw = L & 1;
  const int ldu = rw ? LDU_R : LDU_M, oq = rw ? R_QM : M_QM, og = rw ? R_GATE : M_GATE;
  const int tile = item >> 2, xh = item & 3;
  const int b = gtok(rw, c, tile * 128) >> 13;
  u16* U = (u16*)(p.ws + OFF_U);
  const u16* MK = (const u16*)(p.ws + OFF_MEMK) + (size_t)((L * 4 + b) * 4 + xh) * 256 * 128;
  const u16* MV = (const u16*)(p.ws + OFF_MEMVT) + (size_t)((L * 4 + b) * 4 + xh) * 128 * 256;
  attn_item<128>(U + (size_t)tile * 128 * ldu + oq + xh * 128, ldu, MK, MV, 256, 4, 0, false,
                 0.08838834764831845f * 1.4426950408889634f, U + (size_t)tile * 128 * ldu + og + 1536 + xh * 128, ldu, smem, dry);
}

DI void phase_attn(const Params& p, int L, int c, char* smem, int* s_item, bool dry) {
  int* cnt = (int*)(p.ws + OFF_CNT) + 64 + ((L * 2 + c) * 2 + (dry ? 1 : 0)) * 16;
  u16* U = (u16*)(p.ws + OFF_U);
  const u16* Q = (const u16*)(p.ws + OFF_Q); const u16* Kb = (const u16*)(p.ws + OFF_K); const u16* Vt = (const u16*)(p.ws + OFF_VT);
  const int xcc = (int)(__builtin_amdgcn_s_getreg((3 << 11) | 20) & 7u);
  for (int k = 0; k < 8; ++k) {
    const int x = (xcc + k) & 7;
    for (;;) {
      __syncthreads();
      if (otid() == 0) *s_item = atomicAdd(cnt + x, 1);
      __syncthreads();
      const int item = *s_item;
      if (item >= 192) break;
      const int qt = 63 - (item & 63), bh = 3 * x + (item >> 6);
      const int lb = bh / 12, head = bh - lb * 12;
      const int q0 = qt * 128;
      attn_item_c<192>(Q + ((size_t)(lb * 12 + head) * 8192 + q0) * 192, 192, Kb + (size_t)(lb * 12 + head) * 8192 * 192,
                     Vt + (size_t)(lb * 12 + head) * 128 * 8192, 8192, 2 * (qt + 1), q0,
                     0.07216878364870323f * 1.4426950408889634f,
                     U + (size_t)(lb * 8192 + q0) * LDU_M + M_GATE + head * 128, LDU_M, smem, dry);
    }
  }
  for (;;) {
    __syncthreads();
    if (otid() == 0) *s_item = atomicAdd(cnt + 8, 1);
    __syncthreads();
    const int item = *s_item;
    if (item >= 512) break;
    memattn_item(p, L, c, item, smem, dry);
  }
}

DI void scan_item(const Params& p, int L, int c, int item, char* smem, bool dry) {
  const int tid = otid(), w = tid >> 6, lane = tid & 63, r = lane & 31, h = lane >> 5;
  const int j = L >> 1;
  const int b = item / 48, rem = item - b * 48, head = rem >> 1, half = rem & 1;
  float* PA  = (float*)smem;
  float* Vst = PA + 32 * 5 * 64;
  float* Yst = Vst + 32 * 32;
  float* PRM = Yst + 32 * 32;
  float* BON = PRM + 10 * 64;
  u16* A1  = (u16*)(BON + 32);
  u16* W2t = A1 + 2 * 32 * 72;
  float* LO  = (float*)(W2t + 2 * 64 * 72);
  const u16* U = (const u16*)(p.ws + OFF_U);
  const u16* BND = (const u16*)(p.ws + OFF_BND);
  u16* YR = (u16*)(p.ws + OFF_YR); u16* BV = (u16*)(p.ws + OFF_BV);
  float* ST = (float*)(p.ws + OFF_ST); float* BS = (float*)(p.ws + OFF_BS);
  float* STATE = (float*)(p.ws + OFF_STATE);
  __syncthreads();
  if (tid < 64) {
    const float* mu = p.mu + j * SHIFTW;
    const int hc = head * 64 + tid;
    PRM[0 * 64 + tid] = mu[R_R + hc]; PRM[1 * 64 + tid] = mu[R_K + hc]; PRM[2 * 64 + tid] = mu[R_WD + tid]; PRM[3 * 64 + tid] = mu[R_AD + tid];
    PRM[4 * 64 + tid] = p.w0[j * 1536 + hc]; PRM[5 * 64 + tid] = p.a0[j * 1536 + hc]; PRM[6 * 64 + tid] = p.k_k[j * 1536 + hc];
    PRM[7 * 64 + tid] = p.k_a[j * 1536 + hc]; PRM[8 * 64 + tid] = p.r_k[j * 1536 + hc];
    PRM[9 * 64 + tid] = (tid < 32) ? mu[R_V + head * 64 + 32 * half + tid] : 0.f;
  }
  for (int e = tid; e < 8192; e += 256) {
    int arr = e >> 12, jj = (e >> 6) & 63, cc = e & 63;
    const float* src = (arr ? p.a2 : p.w2) + (size_t)j * 64 * 1536;
    W2t[(arr * 64 + cc) * 72 + jj] = f2bf(src[jj * 1536 + head * 64 + cc]);
  }
  const int rowl = lane >> 3, ks = lane & 7, row32 = 8 * w + rowl;
  float S[8];
  {
    float* sp = STATE + ((size_t)((b * 24 + head) * 64 + 32 * half + row32)) * 64 + 8 * ks;
#pragma unroll
    for (int i = 0; i < 8; ++i) S[i] = (c == 0) ? 0.f : sp[i];
  }
  const int tt = tid >> 3, cs = tid & 7;
  uint4 Rr_c, Rr_p, Rk_c, Rk_p, Rw_c, Rw_p, Ra_c, Ra_p, Rv_c, Rv_p;
  const uint4 zero4 = {0u, 0u, 0u, 0u};
  auto load_raw = [&](int tc) {
    const int lr = b * 4096 + tc * 32 + tt;
    const int s = c * 4096 + tc * 32 + tt;
    const u16* cur = U + (size_t)lr * LDU_R;
    const u16* prv = (s == 0) ? (BND + (size_t)4 * SHIFTW) : ((s == 4096 && c == 1) ? (BND + (size_t)b * SHIFTW) : (cur - LDU_R));
    Rr_c = *(const uint4*)(cur + R_R + head * 64 + cs * 8);  Rr_p = *(const uint4*)(prv + R_R + head * 64 + cs * 8);
    Rk_c = *(const uint4*)(cur + R_K + head * 64 + cs * 8);  Rk_p = *(const uint4*)(prv + R_K + head * 64 + cs * 8);
    Rw_c = *(const uint4*)(cur + R_WD + cs * 8);             Rw_p = *(const uint4*)(prv + R_WD + cs * 8);
    Ra_c = *(const uint4*)(cur + R_AD + cs * 8);             Ra_p = *(const uint4*)(prv + R_AD + cs * 8);
    const int vo = R_V + head * 64 + 32 * half + (cs & 3) * 8;
    Rv_c = *(const uint4*)(cur + vo);                        Rv_p = *(const uint4*)(prv + vo);
  };
  load_raw(0);
  __syncthreads();
  for (int tc = 0; tc < 128; ++tc) {
    const int lr = b * 4096 + tc * 32 + tt;
    float rm[8], km[8];
    {
      float cu[8], pv[8], t8[8];
      unpack8(Rr_c, cu); unpack8(Rr_p, pv);
#pragma unroll
      for (int e = 0; e < 8; ++e) rm[e] = cu[e] + (pv[e] - cu[e]) * PRM[0 * 64 + cs * 8 + e];
      unpack8(Rk_c, cu); unpack8(Rk_p, pv);
#pragma unroll
      for (int e = 0; e < 8; ++e) km[e] = cu[e] + (pv[e] - cu[e]) * PRM[1 * 64 + cs * 8 + e];
      unpack8(Rw_c, cu); unpack8(Rw_p, pv);
#pragma unroll
      for (int e = 0; e < 8; ++e) {
        float xw = cu[e] + (pv[e] - cu[e]) * PRM[2 * 64 + cs * 8 + e];
        float ee = ex2(xw * 2.8853900817779268f);
        t8[e] = 1.f - 2.f * frcp(ee + 1.f);
      }
      *(uint4*)(A1 + (0 * 32 + tt) * 72 + cs * 8) = pack8(t8);
      unpack8(Ra_c, cu); unpack8(Ra_p, pv);
#pragma unroll
      for (int e = 0; e < 8; ++e) t8[e] = cu[e] + (pv[e] - cu[e]) * PRM[3 * 64 + cs * 8 + e];
      *(uint4*)(A1 + (1 * 32 + tt) * 72 + cs * 8) = pack8(t8);
      unpack8(Rv_c, cu); unpack8(Rv_p, pv);
      if (cs < 4) {
#pragma unroll
        for (int e = 0; e < 8; ++e) Vst[tt * 32 + cs * 8 + e] = cu[e] + (pv[e] - cu[e]) * PRM[9 * 64 + cs * 8 + e];
      }
    }
    __syncthreads();
    {
      const int arr = w >> 1, nt = w & 1;
      f32x16 acc;
#pragma unroll
      for (int e = 0; e < 16; ++e) acc[e] = 0.f;
#pragma unroll
      for (int k4 = 0; k4 < 4; ++k4) {
        bf16x8 a = *(const bf16x8*)(A1 + (arr * 32 + r) * 72 + 16 * k4 + 8 * h);
        bf16x8 bw = *(const bf16x8*)(W2t + (arr * 64 + 32 * nt + r) * 72 + 16 * k4 + 8 * h);
        acc = MFMA32(a, bw, acc);
      }
#pragma unroll
      for (int e = 0; e < 16; ++e) LO[(arr * 32 + crow(e, h)) * 64 + 32 * nt + r] = acc[e];
    }
    __syncthreads();
    float lw[8], la[8];
    {
      float4 t0 = *(const float4*)(LO + (0 * 32 + tt) * 64 + cs * 8), t1 = *(const float4*)(LO + (0 * 32 + tt) * 64 + cs * 8 + 4);
      lw[0] = t0.x; lw[1] = t0.y; lw[2] = t0.z; lw[3] = t0.w; lw[4] = t1.x; lw[5] = t1.y; lw[6] = t1.z; lw[7] = t1.w;
      t0 = *(const float4*)(LO + (1 * 32 + tt) * 64 + cs * 8); t1 = *(const float4*)(LO + (1 * 32 + tt) * 64 + cs * 8 + 4);
      la[0] = t0.x; la[1] = t0.y; la[2] = t0.z; la[3] = t0.w; la[4] = t1.x; la[5] = t1.y; la[6] = t1.z; la[7] = t1.w;
    }
    {
      float dec[8], kk[8], av[8], kp[8];
      float ssq = 0.f, bon = 0.f;
#pragma unroll
      for (int e = 0; e < 8; ++e) {
        const int ch = cs * 8 + e;
        const float sg = frcp(1.f + fexp(-(lw[e] + PRM[4 * 64 + ch])));
        dec[e] = ex2(-0.8750340f * sg);
        float a = frcp(1.f + fexp(-(la[e] + PRM[5 * 64 + ch])));
        av[e] = a;
        kk[e] = km[e] * PRM[6 * 64 + ch];
        ssq += kk[e] * kk[e];
        kp[e] = km[e] * (1.f + (a - 1.f) * PRM[7 * 64 + ch]);
        bon += rm[e] * kp[e] * PRM[8 * 64 + ch];
      }
      ssq = red8(ssq); bon = red8(bon);
      const float inv = 1.f / fmaxf(sqrtf(ssq), 1e-12f);
      float nk[8], bb[8];
#pragma unroll
      for (int e = 0; e < 8; ++e) { float kn = kk[e] * inv; nk[e] = -kn; bb[e] = kn * av[e]; }
      float* pa = PA + tt * 320 + cs * 8;
      *(float4*)(pa) = make_float4(dec[0], dec[1], dec[2], dec[3]); *(float4*)(pa + 4) = make_float4(dec[4], dec[5], dec[6], dec[7]);
      *(float4*)(pa + 64) = make_float4(nk[0], nk[1], nk[2], nk[3]); *(float4*)(pa + 68) = make_float4(nk[4], nk[5], nk[6], nk[7]);
      *(float4*)(pa + 128) = make_float4(bb[0], bb[1], bb[2], bb[3]); *(float4*)(pa + 132) = make_float4(bb[4], bb[5], bb[6], bb[7]);
      *(float4*)(pa + 192) = make_float4(kp[0], kp[1], kp[2], kp[3]); *(float4*)(pa + 196) = make_float4(kp[4], kp[5], kp[6], kp[7]);
      *(float4*)(pa + 256) = make_float4(rm[0], rm[1], rm[2], rm[3]); *(float4*)(pa + 260) = make_float4(rm[4], rm[5], rm[6], rm[7]);
      if (cs == 0) BON[tt] = bon;
    }
    __syncthreads();
    if (tc + 1 < 128) load_raw(tc + 1);
    {
      const float* pa0 = PA + ks * 8;
      const float* vs0 = Vst + row32;
      float4 d0 = *(const float4*)(pa0), d1 = *(const float4*)(pa0 + 4);
      float4 n0 = *(const float4*)(pa0 + 64), n1 = *(const float4*)(pa0 + 68);
      float4 b0 = *(const float4*)(pa0 + 128), b1 = *(const float4*)(pa0 + 132);
      float4 k0 = *(const float4*)(pa0 + 192), k1 = *(const float4*)(pa0 + 196);
      float4 r0 = *(const float4*)(pa0 + 256), r1 = *(const float4*)(pa0 + 260);
      float vv = vs0[0];
#pragma unroll 4
      for (int t = 0; t < 32; ++t) {
        const float* pa = pa0 + (t + 1) * 320;
        const float4 xd0 = *(const float4*)(pa), xd1 = *(const float4*)(pa + 4);
        const float4 xn0 = *(const float4*)(pa + 64), xn1 = *(const float4*)(pa + 68);
        const float4 xb0 = *(const float4*)(pa + 128), xb1 = *(const float4*)(pa + 132);
        const float4 xk0 = *(const float4*)(pa + 192), xk1 = *(const float4*)(pa + 196);
        const float4 xr0 = *(const float4*)(pa + 256), xr1 = *(const float4*)(pa + 260);
        const float xvv = vs0[(t + 1) * 32];
        __builtin_amdgcn_sched_barrier(0);
        float sa0 = S[0] * n0.x, sa1 = S[1] * n0.y;
        sa0 = fmaf(S[2], n0.z, sa0); sa1 = fmaf(S[3], n0.w, sa1);
        sa0 = fmaf(S[4], n1.x, sa0); sa1 = fmaf(S[5], n1.y, sa1);
        sa0 = fmaf(S[6], n1.z, sa0); sa1 = fmaf(S[7], n1.w, sa1);
        float sa = red8(sa0 + sa1);
        S[0] = fmaf(sa, b0.x, fmaf(S[0], d0.x, vv * k0.x)); S[1] = fmaf(sa, b0.y, fmaf(S[1], d0.y, vv * k0.y));
        S[2] = fmaf(sa, b0.z, fmaf(S[2], d0.z, vv * k0.z)); S[3] = fmaf(sa, b0.w, fmaf(S[3], d0.w, vv * k0.w));
        S[4] = fmaf(sa, b1.x, fmaf(S[4], d1.x, vv * k1.x)); S[5] = fmaf(sa, b1.y, fmaf(S[5], d1.y, vv * k1.y));
        S[6] = fmaf(sa, b1.z, fmaf(S[6], d1.z, vv * k1.z)); S[7] = fmaf(sa, b1.w, fmaf(S[7], d1.w, vv * k1.w));
        float y0 = S[0] * r0.x, y1 = S[1] * r0.y;
        y0 = fmaf(S[2], r0.z, y0); y1 = fmaf(S[3], r0.w, y1);
        y0 = fmaf(S[4], r1.x, y0); y1 = fmaf(S[5], r1.y, y1);
        y0 = fmaf(S[6], r1.z, y0); y1 = fmaf(S[7], r1.w, y1);
        float y = red8(y0 + y1);
        if (ks == 0) Yst[t * 32 + row32] = y;

        d0 = xd0; d1 = xd1; n0 = xn0; n1 = xn1; b0 = xb0; b1 = xb1; k0 = xk0; k1 = xk1; r0 = xr0; r1 = xr1; vv = xvv;
      }
    }
    __syncthreads();
    {
      const int c4 = cs & 3;
      float y8[8], v8[8];
      float4 t0 = *(const float4*)(Yst + tt * 32 + c4 * 8), t1 = *(const float4*)(Yst + tt * 32 + c4 * 8 + 4);
      y8[0] = t0.x; y8[1] = t0.y; y8[2] = t0.z; y8[3] = t0.w; y8[4] = t1.x; y8[5] = t1.y; y8[6] = t1.z; y8[7] = t1.w;
      float sm = 0.f, sq = 0.f;
#pragma unroll
      for (int e = 0; e < 8; ++e) { sm += y8[e]; sq += y8[e] * y8[e]; }
      sm = red4(sm); sq = red4(sq);
      const float bon = BON[tt];
      t0 = *(const float4*)(Vst + tt * 32 + c4 * 8); t1 = *(const float4*)(Vst + tt * 32 + c4 * 8 + 4);
      v8[0] = t0.x * bon; v8[1] = t0.y * bon; v8[2] = t0.z * bon; v8[3] = t0.w * bon; v8[4] = t1.x * bon; v8[5] = t1.y * bon; v8[6] = t1.z * bon; v8[7] = t1.w * bon;
      if (cs < 4 && !dry) {
        const size_t o = (size_t)lr * 1536 + head * 64 + 32 * half + cs * 8;
        *(uint4*)(YR + o) = pack8(y8);
        *(uint4*)(BV + o) = pack8(v8);
        if (cs == 0) {
          float* stp = ST + ((size_t)(lr * 24 + head) * 2 + half) * 2;
          stp[0] = sm; stp[1] = sq;
        }
      }
    }
  }
  if (c == 0 && !dry) {
    float* sp = STATE + ((size_t)((b * 24 + head) * 64 + 32 * half + row32)) * 64 + 8 * ks;
#pragma unroll
    for (int i = 0; i < 8; ++i) sp[i] = S[i];
  }
}

DI void phase_scan(const Params& p, int L, int c, char* smem, int* s_item, bool dry) {
  for (int item = blockIdx.x; item < 192; item += gridDim.x) scan_item(p, L, c, item, smem, dry);
  int* cnt = (int*)(p.ws + OFF_CNT) + 64 + ((L * 2 + c) * 2 + (dry ? 1 : 0)) * 16 + 8;
  for (;;) {
    __syncthreads();
    if (otid() == 0) *s_item = atomicAdd(cnt, 1);
    __syncthreads();
    const int item = *s_item;
    if (item >= 512) break;
    memattn_item(p, L, c, item, smem, dry);
  }
}

DI void phase_finalize(const Params& p, int L, int c, bool dry) {
  const int j = L >> 1;
  u16* U = (u16*)(p.ws + OFF_U);
  const u16* YR = (const u16*)(p.ws + OFF_YR); const u16* BV = (const u16*)(p.ws + OFF_BV);
  const float* ST = (const float*)(p.ws + OFF_ST);
  const int G = gridDim.x;
  for (int idx = blockIdx.x * 256 + otid(); idx < TC * 192; idx += G * 256) {
    const int lr = idx / 192, c8 = idx - lr * 192, ch0 = c8 * 8, head = ch0 >> 6;
    const float4 st = *(const float4*)(ST + (size_t)(lr * 24 + head) * 4);
    const float mean = (st.x + st.z) * (1.f / 64.f);
    const float var = (st.y + st.w) * (1.f / 64.f) - mean * mean;
    const float rstd = rsqrtf(fmaxf(var, 0.f) + 64e-5f);
    float y[8], bv[8], g[8], o[8];
    unpack8(*(const uint4*)(YR + (size_t)lr * 1536 + ch0), y);
    unpack8(*(const uint4*)(BV + (size_t)lr * 1536 + ch0), bv);
    u16* gp = U + (size_t)lr * LDU_R + R_GATE + ch0;
    unpack8(*(const uint4*)gp, g);
    const float* gw = p.gn_w + j * 1536 + ch0; const float* gb = p.gn_b + j * 1536 + ch0;
#pragma unroll
    for (int e = 0; e < 8; ++e) o[e] = ((y[e] - mean) * rstd * gw[e] + gb[e] + bv[e]) * silu(g[e]);
    if (!dry) *(uint4*)gp = pack8(o);
  }
  if (c == 0) {
    u16* BND = (u16*)(p.ws + OFF_BND);
    for (int idx = blockIdx.x * 256 + otid(); idx < 4 * (SHIFTW / 8); idx += G * 256) {
      const int b = idx / (SHIFTW / 8), cc = idx - b * (SHIFTW / 8);
      *(uint4*)(BND + (size_t)b * SHIFTW + cc * 8) = *(const uint4*)(U + (size_t)(b * 4096 + 4095) * LDU_R + cc * 8);
    }
  }
}

enum { PH_PREP = 0, PH_NORM, PH_GEMM_IN, PH_KVPREP, PH_GEMM_UP, PH_ATTN, PH_SCAN, PH_FINALIZE, PH_GEMM_OUT, PH_FINAL };
constexpr int NSTEPS = 46;

DI void decode_step(int step, int& ph, int& L, int& c) {
  if (step == 0) { ph = PH_PREP; L = 0; c = 0; return; }
  if (step == NSTEPS - 1) { ph = PH_FINAL; L = 0; c = 0; return; }
  int s = step - 1;
  int pr = s / 22, rem = s - pr * 22;
  if (rem < 12) {
    L = 2 * pr; c = rem / 6; int k = rem - c * 6;
    ph = (k == 0) ? PH_NORM : (k == 1) ? PH_GEMM_IN : (k == 2) ? PH_KVPREP : (k == 3) ? PH_GEMM_UP : (k == 4) ? PH_ATTN : PH_GEMM_OUT;
  } else {
    rem -= 12; L = 2 * pr + 1; c = rem / 5; int k = rem - c * 5;
    ph = (k == 0) ? PH_NORM : (k == 1) ? PH_GEMM_IN : (k == 2) ? PH_SCAN : (k == 3) ? PH_FINALIZE : PH_GEMM_OUT;
  }
}

DI void run_step(const Params& p, int ph, int L, int c, char* smem, int* s_item, bool dry_in, int vt) {
  const bool dry = dry_in && !(HYP5 && (ph == PH_GEMM_IN || ph == PH_GEMM_UP));
  char* ws = p.ws;
  const bool rw = L & 1;
  const int j = L >> 1;
  switch (ph) {
    case PH_PREP: phase_prep(p, smem); break;
    case PH_NORM:
      phase_norm(p, L, c);
      if (L == 0 && c == 0) {
        EpiMemKV epi{(u16*)(ws + OFF_MEMK), (u16*)(ws + OFF_MEMVT), false};
        gemm_phase<2, false, 16>((const u16*)(ws + OFF_MEMH), 1024ull * 1024, 1024, (const u16*)(ws + OFF_WT_MEMKV), 1024ull * 1024, 1024, 4, 4, 8, 4, 1024, smem, epi, vt);
      }
      break;
    case PH_GEMM_IN:
      if (!rw) {
        EpiStoreBf16 epi{(u16*)(ws + OFF_U), LDU_M, LDU_M, dry};
        gemm_phase<2, true, 16>((const u16*)(ws + OFF_H), 0, 1024, (const u16*)(ws + OFF_WT_INMLA) + (size_t)j * 3328 * 1024, 0, 1024, 1, 64, 26, 4, 1024, smem, epi, vt);
      } else {
        EpiStoreBf16 epi{(u16*)(ws + OFF_U), LDU_R, LDU_R, dry};
        gemm_phase<2, true, 16>((const u16*)(ws + OFF_H), 0, 1024, (const u16*)(ws + OFF_WT_INRW) + (size_t)j * 7296 * 1024, 0, 1024, 1, 64, 57, 4, 1024, smem, epi, vt);
      }
      break;
    case PH_KVPREP: phase_kvprep(p, L, c, dry); break;
    case PH_GEMM_UP: {
      EpiUQ e1{(u16*)(ws + OFF_Q), (const float*)(ws + OFF_COS), (const float*)(ws + OFF_SIN), c, dry};
      gemm_phase<2, true, 6>((const u16*)(ws + OFF_U) + M_CQ, 0, LDU_M, (const u16*)(ws + OFF_WT_UQ) + (size_t)j * 2304 * 384, 0, 384, 1, 64, 18, 4, 384, smem, e1, vt);
      EpiUK e2{(u16*)(ws + OFF_K), dry};
      gemm_phase<2, true, 4>((const u16*)(ws + OFF_U) + M_CKV, 0, LDU_M, (const u16*)(ws + OFF_WT_UKV) + (size_t)j * 3072 * 256, 0, 256, 1, 64, 12, 4, 256, smem, e2, vt);
      EpiUV e3{(u16*)(ws + OFF_VT), dry};
      gemm_phase<2, false, 4>((const u16*)(ws + OFF_U) + M_CKV, 0, LDU_M, (const u16*)(ws + OFF_WT_UKV) + (size_t)j * 3072 * 256 + 1536ull * 256, 0, 256, 1, 64, 12, 4, 256, smem, e3, vt);
    } break;
    case PH_ATTN: phase_attn(p, L, c, smem, s_item, dry); break;
    case PH_SCAN: phase_scan(p, L, c, smem, s_item, dry); break;
    case PH_FINALIZE: phase_finalize(p, L, c, dry); break;
    case PH_GEMM_OUT: {
      EpiResid epi{(L == 0) ? p.x : (const float*)p.out, p.out, rw, c, dry};
      gemm_phase<2, true, 32>((const u16*)(ws + OFF_U) + (rw ? R_GATE : M_GATE), 0, rw ? LDU_R : LDU_M, (const u16*)(ws + OFF_WT_OUT) + (size_t)L * 1024 * 2048, 0, 2048,
                 1, 64, 8, 4, 2048, smem, epi, vt);
    } break;
    case PH_FINAL: phase_final_norm(p, dry); break;
  }
}

DI void grid_barrier(unsigned* bar, unsigned& epoch) {
  __syncthreads();
  ++epoch;
  if (threadIdx.x == 0) {
    __builtin_amdgcn_fence(__ATOMIC_RELEASE, "agent");
    asm volatile("s_waitcnt vmcnt(0)" ::: "memory");
    const unsigned target = epoch * gridDim.x;
    __hip_atomic_fetch_add(bar, 1u, __ATOMIC_RELAXED, __HIP_MEMORY_SCOPE_AGENT);
    unsigned spins = 0;
    while (__hip_atomic_load(bar, __ATOMIC_RELAXED, __HIP_MEMORY_SCOPE_AGENT) < target) {
      __builtin_amdgcn_s_sleep(2);
      if (++spins > (1u << 22)) break;
    }
    __builtin_amdgcn_fence(__ATOMIC_ACQUIRE, "agent");
    asm volatile("s_waitcnt vmcnt(0)" ::: "memory");
  }
  __syncthreads();
}

__global__ void __launch_bounds__(256, 1) hybrid_megakernel(Params p, int s_lo, int s_hi, int coop, int probe_mask) {
  __shared__ __attribute__((aligned(16))) char smem[SMEM_BYTES];
  __shared__ int s_item;
  unsigned* bar = (unsigned*)(p.ws + OFF_BAR);
  unsigned epoch = 0;
  if (coop == 2) cg::this_grid().sync();
  __shared__ int s_vt;
  int myx = 0, myrank = 0;
  if (coop && threadIdx.x == 0) {
    myx = (int)(__builtin_amdgcn_s_getreg((3 << 11) | 20) & 7u);
    myrank = (int)__hip_atomic_fetch_add(bar + 16 + myx, 1u, __ATOMIC_RELAXED, __HIP_MEMORY_SCOPE_AGENT);
  }
  int vt = blockIdx.x;
  {
    const int G = gridDim.x, t = blockIdx.x;
    vt = ((G & 7) == 0) ? ((t & 7) * (G >> 3) + (t >> 3)) : t;
  }
  for (int st = s_lo; st < s_hi; ++st) {
    int ph, L, c;
    decode_step(st, ph, L, c);
    for (int rep = ((probe_mask >> ph) & 1) ? 0 : 1; rep < 2; ++rep) {
      run_step(p, ph, L, c, smem, &s_item, rep == 0, vt);
      if (coop && (rep == 0 || st + 1 < s_hi)) grid_barrier(bar, epoch);
      if (coop) for (int xs = 0; xs < EXTRA_SYNCS; ++xs) grid_barrier(bar, epoch);
    }
    if (coop && st == s_lo) {
      if (threadIdx.x == 0) {
        const int G = gridDim.x;
        bool ok = (G & 7) == 0;
        for (int x = 0; x < 8; ++x) ok = ok && ((int)__hip_atomic_load(bar + 16 + x, __ATOMIC_RELAXED, __HIP_MEMORY_SCOPE_AGENT) == (G >> 3));
        s_vt = ok ? (myx * (G >> 3) + myrank) : vt;
      }
      __syncthreads();
      vt = s_vt;
    }
  }
}

extern "C" void kernel_launch(void* const* d_in, const int* in_sizes, int n_in, void* d_out, int out_size, void* d_ws, size_t ws_size,
                              hipStream_t stream) {
  if (ws_size < WS_NEED) { fprintf(stderr, "workspace too small: %zu < %zu\n", ws_size, (size_t)WS_NEED); return; }
  Params p;
  memset(&p, 0, sizeof(p));
  p.x = (const float*)d_in[0]; p.mem = (const float*)d_in[1]; p.pos = (const int*)d_in[2];
  p.norm_g = (const float*)d_in[3]; p.mem_norm_g = (const float*)d_in[4]; p.w_mem_kv = (const float*)d_in[5];
  p.w_in_mla = (const float*)d_in[6]; p.q_norm_g = (const float*)d_in[7]; p.kv_norm_g = (const float*)d_in[8];
  p.w_uq = (const float*)d_in[9]; p.w_ukv = (const float*)d_in[10]; p.w_in_rwkv = (const float*)d_in[11];
  p.mu = (const float*)d_in[12]; p.w0 = (const float*)d_in[13]; p.w2 = (const float*)d_in[14]; p.a0 = (const float*)d_in[15];
  p.a2 = (const float*)d_in[16]; p.k_k = (const float*)d_in[17]; p.k_a = (const float*)d_in[18]; p.r_k = (const float*)d_in[19];
  p.gn_w = (const float*)d_in[20]; p.gn_b = (const float*)d_in[21]; p.w_out = (const float*)d_in[22]; p.final_g = (const float*)d_in[23];
  p.out = (float*)d_out; p.ws = (char*)d_ws;
  static int grid_blocks = 0;
  if (!grid_blocks) {
    int dev = 0, cus = 0, per_cu = 0;
    hipGetDevice(&dev);
    hipDeviceGetAttribute(&cus, hipDeviceAttributeMultiprocessorCount, dev);
    hipOccupancyMaxActiveBlocksPerMultiprocessor(&per_cu, hybrid_megakernel, 256, 0);
    if (per_cu > 2) per_cu = 2;
    if (per_cu < 1) per_cu = 1;
    grid_blocks = cus * per_cu;
  }
#if MULTI_LAUNCH
  for (int s = 0; s < NSTEPS; ++s) hipLaunchKernelGGL(hybrid_megakernel, dim3(grid_blocks), dim3(256), 0, stream, p, s, s + 1, 0, 0);
#else
  int s_lo = 0, s_hi = NSTEPS, coop = 1, probe_mask = PROBE_MASK;
  void* args[] = {&p, &s_lo, &s_hi, &coop, &probe_mask};
  hipMemsetAsync((char*)d_ws + OFF_BAR, 0, 256, stream);
  hipError_t e = hipLaunchCooperativeKernel((void*)hybrid_megakernel, dim3(grid_blocks), dim3(256), args, 0, stream);
  if (e != hipSuccess) fprintf(stderr, "cooperative launch failed: %s (grid %d)\n", hipGetErrorString(e), grid_blocks);
#endif
}
```

```cpp
#include <hip/hip_runtime.h>
#include <hip/hip_cooperative_groups.h>
#include <cstdio>
#include <cstring>
namespace cg = cooperative_groups;

#define PROBE_MASK 0
#define EXTRA_SYNCS 0
#define HYP1 0
#define HYP2 0
#define HYP3 0
#define HYP4 0
#define HYP5 0
#define HYP6 0
#ifndef MULTI_LAUNCH
#define MULTI_LAUNCH 0
#endif

#define DI __device__ __forceinline__
typedef unsigned short u16;
typedef __attribute__((ext_vector_type(8))) short bf16x8;
typedef __attribute__((ext_vector_type(16))) float f32x16;
typedef __attribute__((ext_vector_type(2))) __bf16 bf2_t;
typedef __attribute__((ext_vector_type(2))) float f2_t;
typedef __attribute__((ext_vector_type(4))) unsigned u32x4;
typedef __attribute__((ext_vector_type(2))) unsigned u32x2;
#define MFMA32(a, b, c) __builtin_amdgcn_mfma_f32_32x32x16_bf16((a), (b), (c), 0, 0, 0)

constexpr int SEQ = 8192, TC = 16384;
constexpr int LDU_M = 3264, LDU_R = 7296;
constexpr int M_CQ = 0, M_CKV = 384, M_KR = 640, M_QM = 704, M_GATE = 1216;
constexpr int R_R = 0, R_K = 1536, R_V = 3072, R_WD = 4608, R_AD = 4672, R_QM = 4736, R_GATE = 5248;
constexpr int SHIFTW = 4736;

constexpr size_t OFF_WT_MEMKV = 0;
constexpr size_t OFF_WT_INMLA = OFF_WT_MEMKV + 4ull * 1024 * 1024 * 2;
constexpr size_t OFF_WT_UQ    = OFF_WT_INMLA + 2ull * 3328 * 1024 * 2;
constexpr size_t OFF_WT_UKV   = OFF_WT_UQ + 2ull * 2304 * 384 * 2;
constexpr size_t OFF_WT_INRW  = OFF_WT_UKV + 2ull * 3072 * 256 * 2;
constexpr size_t OFF_WT_OUT   = OFF_WT_INRW + 2ull * 7296 * 1024 * 2;
constexpr size_t OFF_MEMH     = OFF_WT_OUT + 4ull * 1024 * 2048 * 2;
constexpr size_t OFF_MEMK     = OFF_MEMH + 4ull * 1024 * 1024 * 2;
constexpr size_t OFF_MEMVT    = OFF_MEMK + 4ull * 4 * 4 * 256 * 128 * 2;
constexpr size_t OFF_COS      = OFF_MEMVT + 4ull * 4 * 4 * 256 * 128 * 2;
constexpr size_t OFF_SIN      = OFF_COS + 32768ull * 32 * 4;
constexpr size_t OFF_CNT      = OFF_SIN + 32768ull * 32 * 4;
constexpr size_t OFF_BAR      = OFF_CNT + 4096;
constexpr size_t OFF_STATE    = OFF_BAR + 256;
constexpr size_t OFF_BND      = OFF_STATE + 96ull * 4096 * 4;
constexpr size_t OFF_H        = OFF_BND + 5ull * 4736 * 2 + 128;
constexpr size_t OFF_R        = OFF_H + 16384ull * 1024 * 2;
constexpr size_t OFF_U        = OFF_R;
constexpr size_t OFF_Q        = OFF_R + 16384ull * 3264 * 2;
constexpr size_t OFF_K        = OFF_Q + 2ull * 12 * 8192 * 192 * 2;
constexpr size_t OFF_VT       = OFF_K + 2ull * 12 * 8192 * 192 * 2;
constexpr size_t OFF_YR       = OFF_R + 16384ull * 7296 * 2;
constexpr size_t OFF_BV       = OFF_YR + 16384ull * 1536 * 2;
constexpr size_t OFF_ST       = OFF_BV + 16384ull * 1536 * 2;
constexpr size_t OFF_BS       = OFF_ST + 16384ull * 24 * 4 * 4;
constexpr size_t WS_NEED      = OFF_BS + 16384ull * 24 * 4;

constexpr int SMEM_BYTES = 110592;

struct Params {
  const float *x, *mem; const int* pos;
  const float *norm_g, *mem_norm_g, *w_mem_kv, *w_in_mla, *q_norm_g, *kv_norm_g, *w_uq, *w_ukv, *w_in_rwkv;
  const float *mu, *w0, *w2, *a0, *a2, *k_k, *k_a, *r_k, *gn_w, *gn_b, *w_out, *final_g;
  float* out; char* ws;
};

DI int otid() { int t = threadIdx.x; asm volatile("" : "+v"(t)); return t; }
DI float bf2f(unsigned v) { return __uint_as_float(v << 16); }
DI unsigned pack2(float a, float b) { f2_t v = {a, b}; bf2_t r = __builtin_convertvector(v, bf2_t); return __builtin_bit_cast(unsigned, r); }
DI u16 f2bf(float a) { return (u16)(pack2(a, 0.f) & 0xffffu); }
DI float ex2(float x) { return __builtin_amdgcn_exp2f(x); }
DI float fexp(float x) { return __builtin_amdgcn_exp2f(x * 1.4426950408889634f); }
DI float frcp(float x) { return __builtin_amdgcn_rcpf(x); }
DI float silu(float g) { return g * frcp(1.f + fexp(-g)); }
DI float wave_sum(float v) { for (int o = 32; o > 0; o >>= 1) v += __shfl_xor(v, o); return v; }
DI int crow(int reg, int h) { return (reg & 3) + 8 * (reg >> 2) + 4 * h; }
DI float dppf(float x, const int ctrl_sel) {
  int xi;
  if (ctrl_sel == 0) xi = __builtin_amdgcn_update_dpp(0, __float_as_int(x), 0xB1, 0xf, 0xf, true);
  else if (ctrl_sel == 1) xi = __builtin_amdgcn_update_dpp(0, __float_as_int(x), 0x4E, 0xf, 0xf, true);
  else xi = __builtin_amdgcn_update_dpp(0, __float_as_int(x), 0x141, 0xf, 0xf, true);
  return __int_as_float(xi);
}
DI float red4(float x) { x += dppf(x, 0); x += dppf(x, 1); return x; }
DI float red8(float x) { x += dppf(x, 0); x += dppf(x, 1); x += dppf(x, 2); return x; }
DI int gtok(bool rw, int c, int lr) { return rw ? ((lr >> 12) * 8192 + c * 4096 + (lr & 4095)) : (c * 16384 + lr); }
DI void unpack8(const uint4& v, float* f) {
  f[0] = bf2f(v.x & 0xffffu); f[1] = bf2f(v.x >> 16); f[2] = bf2f(v.y & 0xffffu); f[3] = bf2f(v.y >> 16);
  f[4] = bf2f(v.z & 0xffffu); f[5] = bf2f(v.z >> 16); f[6] = bf2f(v.w & 0xffffu); f[7] = bf2f(v.w >> 16);
}
DI uint4 pack8(const float* f) { uint4 v; v.x = pack2(f[0], f[1]); v.y = pack2(f[2], f[3]); v.z = pack2(f[4], f[5]); v.w = pack2(f[6], f[7]); return v; }

DI void transpose_tile(const float* __restrict__ src, u16* __restrict__ dst, int K, int N, int tk, int tn, int drow, float* tile) {
  const int tid = otid();
  __syncthreads();
#pragma unroll
  for (int i = 0; i < 4; ++i) {
    int kr = (tid >> 4) + 16 * i, nc = (tid & 15) * 4;
    float4 v = *(const float4*)(src + (size_t)(tk * 64 + kr) * N + tn * 64 + nc);
    tile[kr * 65 + nc] = v.x; tile[kr * 65 + nc + 1] = v.y; tile[kr * 65 + nc + 2] = v.z; tile[kr * 65 + nc + 3] = v.w;
  }
  __syncthreads();
#pragma unroll
  for (int i = 0; i < 2; ++i) {
    int n = (tid >> 3) + 32 * i, kc = (tid & 7) * 8;
    float f[8];
#pragma unroll
    for (int e = 0; e < 8; ++e) f[e] = tile[(kc + e) * 65 + n];
    *(uint4*)(dst + (size_t)(drow + n) * K + tk * 64 + kc) = pack8(f);
  }
}

DI void rms_row_bf16(const float* __restrict__ src, const float* __restrict__ g, u16* __restrict__ dst, int lane) {
  float4 v[4]; float ss = 0.f;
#pragma unroll
  for (int i = 0; i < 4; ++i) { v[i] = *(const float4*)(src + i * 256 + lane * 4); ss += v[i].x * v[i].x + v[i].y * v[i].y + v[i].z * v[i].z + v[i].w * v[i].w; }
  ss = wave_sum(ss);
  float rs = rsqrtf(ss * (1.f / 1024.f) + 1e-6f);
#pragma unroll
  for (int i = 0; i < 4; ++i) {
    float4 gg = *(const float4*)(g + i * 256 + lane * 4);
    uint2 o; o.x = pack2(v[i].x * rs * gg.x, v[i].y * rs * gg.y); o.y = pack2(v[i].z * rs * gg.z, v[i].w * rs * gg.w);
    *(uint2*)(dst + i * 256 + lane * 4) = o;
  }
}

DI void phase_prep(const Params& p, char* smem) {
  const int tid = otid(), G = gridDim.x, bid = blockIdx.x;
  char* ws = p.ws;
  if (bid == 0) for (int i = tid; i < 1024; i += 256) ((int*)(ws + OFF_CNT))[i] = 0;
  float* tile = (float*)smem;
  for (int g0 = bid; g0 < 9168; g0 += G) {
    int g = g0;
    const float* src = nullptr; u16* dst = nullptr; int K = 0, N = 0; size_t dstr = 0; bool ukv = false;
    if (g < 1024) { src = p.w_mem_kv; dst = (u16*)(ws + OFF_WT_MEMKV); K = 1024; N = 1024; dstr = 1024ull * 1024; }
    else if ((g -= 1024) < 1632) { src = p.w_in_mla; dst = (u16*)(ws + OFF_WT_INMLA); K = 1024; N = 3264; dstr = 3328ull * 1024; }
    else if ((g -= 1632) < 432) { src = p.w_uq; dst = (u16*)(ws + OFF_WT_UQ); K = 384; N = 2304; dstr = 2304ull * 384; }
    else if ((g -= 432) < 384) { src = p.w_ukv; dst = (u16*)(ws + OFF_WT_UKV); K = 256; N = 3072; dstr = 3072ull * 256; ukv = true; }
    else if ((g -= 384) < 3648) { src = p.w_in_rwkv; dst = (u16*)(ws + OFF_WT_INRW); K = 1024; N = 7296; dstr = 7296ull * 1024; }
    else { g -= 3648; src = p.w_out; dst = (u16*)(ws + OFF_WT_OUT); K = 2048; N = 1024; dstr = 1024ull * 2048; }
    int ntn = N >> 6, per = (K >> 6) * ntn;
    int m = g / per, t = g - m * per;
    int tk = t / ntn, tn = t - tk * ntn;
    int drow = tn * 64;
    if (ukv) { const int hd = drow >> 8, dd = drow & 255; drow = (dd < 128) ? (hd * 128 + dd) : (1536 + hd * 128 + dd - 128); }
    transpose_tile(src + (size_t)m * K * N, dst + (size_t)m * dstr, K, N, tk, tn, drow, tile);
  }
  for (int i = bid * 256 + tid; i < 2 * 64 * 1024 / 8; i += G * 256) {
    int m = i / (64 * 1024 / 8), r = i - m * (64 * 1024 / 8);
    uint4 z; z.x = z.y = z.z = z.w = 0u;
    *(uint4*)((u16*)(ws + OFF_WT_INMLA) + (size_t)m * 3328 * 1024 + 3264ull * 1024 + (size_t)r * 8) = z;
  }
  for (int i = bid * 256 + tid; i < SHIFTW / 8; i += G * 256) { uint4 z; z.x = z.y = z.z = z.w = 0u; *(uint4*)((u16*)(ws + OFF_BND) + 4 * SHIFTW + i * 8) = z; }
  float* cs = (float*)(ws + OFF_COS); float* sn = (float*)(ws + OFF_SIN);
  for (int i = bid * 256 + tid; i < 32768 * 32; i += G * 256) {
    int tk = i >> 5, pi = i & 31;
    float inv_freq = (float)exp2(-(double)(2 * pi) / 64.0 * 13.287712379549449);
    float ang = (float)p.pos[tk] * inv_freq;
    double rev = (double)ang * 0.15915494309189535;
    float fr = (float)(rev - rint(rev));
    cs[i] = __builtin_amdgcn_cosf(fr); sn[i] = __builtin_amdgcn_sinf(fr);
  }
  const int w = tid >> 6, lane = tid & 63;
  for (int row = bid * 4 + w; row < 4096; row += G * 4) {
    int L = row >> 10, m = row & 1023;
    rms_row_bf16(p.mem + (size_t)m * 1024, p.mem_norm_g + L * 1024, (u16*)(ws + OFF_MEMH) + (size_t)row * 1024, lane);
  }
}

DI void phase_norm(const Params& p, int L, int c) {
  const int tid = otid(), w = tid >> 6, lane = tid & 63;
  const bool rw = L & 1;
  const float* xs = (L == 0) ? p.x : p.out;
  u16* H = (u16*)(p.ws + OFF_H);
  for (int lr = blockIdx.x * 4 + w; lr < TC; lr += gridDim.x * 4) {
    int gt = gtok(rw, c, lr);
    rms_row_bf16(xs + (size_t)gt * 1024, p.norm_g + L * 1024, H + (size_t)lr * 1024, lane);
  }
}

DI void phase_final_norm(const Params& p, bool dry) {
  const int tid = otid(), w = tid >> 6, lane = tid & 63;
  for (int row = blockIdx.x * 4 + w; row < 32768; row += gridDim.x * 4) {
    float* xr = p.out + (size_t)row * 1024;
    float4 v[4]; float ss = 0.f;
#pragma unroll
    for (int i = 0; i < 4; ++i) { v[i] = *(const float4*)(xr + i * 256 + lane * 4); ss += v[i].x * v[i].x + v[i].y * v[i].y + v[i].z * v[i].z + v[i].w * v[i].w; }
    ss = wave_sum(ss);
    float rs = rsqrtf(ss * (1.f / 1024.f) + 1e-6f);
#pragma unroll
    for (int i = 0; i < 4; ++i) {
      float4 gg = *(const float4*)(p.final_g + i * 256 + lane * 4);
      float4 o; o.x = v[i].x * rs * gg.x; o.y = v[i].y * rs * gg.y; o.z = v[i].z * rs * gg.z; o.w = v[i].w * rs * gg.w;
      if (!dry) *(float4*)(xr + i * 256 + lane * 4) = o;
    }
  }
}

template <int TJ, bool SWAP, int NK, class Epi>
DI void gemm_phase(const u16* __restrict__ A, size_t strideAz, int lda, const u16* __restrict__ Bt, size_t strideBz, int ldb,
                   int Z, int Mt, int Nt, int GM, int K, char* smem, const Epi& epi, int vt) {
  constexpr int BN = 64 * TJ;
  constexpr int NB = BN / 32;
  const int tid = otid(), w = tid >> 6, lane = tid & 63, r = lane & 31, h = lane >> 5;
  const int wm = w >> 1, wn = w & 1;
  u16* As = (u16*)smem;
  u16* Bs = As + 2 * 256 * 72;
  const int G = gridDim.x, per = Mt * Nt, total = Z * per;
  const int lrow = tid >> 3, lcc = (tid & 7) * 8;
  unsigned aoff[8], boff[NB];
#pragma unroll
  for (int i = 0; i < 8; ++i) aoff[i] = (unsigned)((lrow + 32 * i) * lda + lcc);
#pragma unroll
  for (int i = 0; i < NB; ++i) boff[i] = (unsigned)((lrow + 32 * i) * ldb + lcc);
  const int lds_st = lrow * 72 + lcc;
  for (int base = 0; base < total; base += G) {
    const int q = base + vt;
    if (q >= total) continue;
    const int z = q / per, qq = q - z * per;
    const int grp = qq / (GM * Nt), within = qq - grp * GM * Nt;
    const int mt = grp * GM + (within % GM), nt = within / GM;
    const u16* Ag = A + z * strideAz + (size_t)(mt * 256) * lda;
    const u16* Bg = Bt + z * strideBz + (size_t)(nt * BN) * ldb;
    u32x4 ra[2][8], rb[2][NB];
    f32x16 acc[4][TJ];
#pragma unroll
    for (int i = 0; i < 4; ++i)
#pragma unroll
      for (int j = 0; j < TJ; ++j)
#pragma unroll
        for (int e = 0; e < 16; ++e) acc[i][j][e] = 0.f;
    __syncthreads();
#pragma unroll
    for (int i = 0; i < 8; ++i) ra[0][i] = *(const u32x4*)(Ag + aoff[i]);
#pragma unroll
    for (int i = 0; i < NB; ++i) rb[0][i] = *(const u32x4*)(Bg + boff[i]);
#pragma unroll
    for (int i = 0; i < 8; ++i) ra[1][i] = *(const u32x4*)(Ag + 64 + aoff[i]);
#pragma unroll
    for (int i = 0; i < NB; ++i) rb[1][i] = *(const u32x4*)(Bg + 64 + boff[i]);
#pragma unroll
    for (int i = 0; i < 8; ++i) *(u32x4*)(As + lds_st + (32 * i) * 72) = ra[0][i];
#pragma unroll
    for (int i = 0; i < NB; ++i) *(u32x4*)(Bs + lds_st + (32 * i) * 72) = rb[0][i];
    __syncthreads();
#pragma unroll
    for (int kt = 0; kt < NK; ++kt) {
      constexpr int dummy = 0; (void)dummy;
      const int u = kt & 1;
      if (kt + 2 < NK) {
        const u16* ag = Ag + (kt + 2) * 64; const u16* bg = Bg + (kt + 2) * 64;
#pragma unroll
        for (int i = 0; i < 8; ++i) ra[u][i] = *(const u32x4*)(ag + aoff[i]);
#pragma unroll
        for (int i = 0; i < NB; ++i) rb[u][i] = *(const u32x4*)(bg + boff[i]);
      }
      const u16* as = As + u * 256 * 72 + (128 * wm + r) * 72 + 8 * h;
      const u16* bs = Bs + u * BN * 72 + (32 * TJ * wn + r) * 72 + 8 * h;
      bf16x8 af[2][4], bfr[2][TJ];
#pragma unroll
      for (int i = 0; i < 4; ++i) af[0][i] = *(const bf16x8*)(as + (32 * i) * 72);
#pragma unroll
      for (int j = 0; j < TJ; ++j) bfr[0][j] = *(const bf16x8*)(bs + (32 * j) * 72);
#pragma unroll
      for (int ks = 0; ks < 4; ++ks) {
        if (ks < 3) {
#pragma unroll
          for (int i = 0; i < 4; ++i) af[(ks + 1) & 1][i] = *(const bf16x8*)(as + (32 * i) * 72 + 16 * (ks + 1));
#pragma unroll
          for (int j = 0; j < TJ; ++j) bfr[(ks + 1) & 1][j] = *(const bf16x8*)(bs + (32 * j) * 72 + 16 * (ks + 1));
        }
        __builtin_amdgcn_sched_barrier(0);
#pragma unroll
        for (int i = 0; i < 4; ++i)
#pragma unroll
          for (int j = 0; j < TJ; ++j)
            acc[i][j] = SWAP ? MFMA32(bfr[ks & 1][j], af[ks & 1][i], acc[i][j]) : MFMA32(af[ks & 1][i], bfr[ks & 1][j], acc[i][j]);
        if (ks == 0 && kt + 1 < NK) {
          u16* ad = As + (u ^ 1) * 256 * 72 + lds_st; u16* bd = Bs + (u ^ 1) * BN * 72 + lds_st;
#pragma unroll
          for (int i = 0; i < 8; ++i) *(u32x4*)(ad + (32 * i) * 72) = ra[u ^ 1][i];
#pragma unroll
          for (int i = 0; i < NB; ++i) *(u32x4*)(bd + (32 * i) * 72) = rb[u ^ 1][i];
#pragma unroll
          for (int i = 0; i < 6; ++i) { __builtin_amdgcn_sched_group_barrier(0x008, 1, 0); __builtin_amdgcn_sched_group_barrier(0x200, 2, 0); }
        }
        __builtin_amdgcn_sched_barrier(0);
      }
      __syncthreads();
    }
#pragma unroll
    for (int i = 0; i < 4; ++i)
#pragma unroll
      for (int j = 0; j < TJ; ++j) {
        if (SWAP) epi(z, mt * 256 + 128 * wm + 32 * i + r, nt * BN + 32 * TJ * wn + 32 * j, h, acc[i][j]);
        else epi(z, mt * 256 + 128 * wm + 32 * i, nt * BN + 32 * TJ * wn + 32 * j + r, h, acc[i][j]);
      }
  }
}

struct EpiStoreBf16 {
  u16* C; int ldc; int ncols; bool dry;
  DI void operator()(int z, int row, int colbase, int h, const f32x16& a) const {
    if (dry) return;
#pragma unroll
    for (int g = 0; g < 4; ++g) {
      const int col = colbase + 8 * g + 4 * h;
      if (col < ncols) {
        u32x2 pk = {pack2(a[4 * g], a[4 * g + 1]), pack2(a[4 * g + 2], a[4 * g + 3])};
        *(u32x2*)(C + (size_t)row * ldc + col) = pk;
      }
    }
  }
};
struct EpiResid {
  const float* xin; float* xout; bool rw; int c; bool dry;
  DI void operator()(int z, int row, int colbase, int h, const f32x16& a) const {
    if (dry) return;
    const size_t o = (size_t)gtok(rw, c, row) * 1024 + colbase + 4 * h;
#pragma unroll
    for (int g = 0; g < 4; ++g) {
      float4 v = *(const float4*)(xin + o + 8 * g);
      v.x += a[4 * g]; v.y += a[4 * g + 1]; v.z += a[4 * g + 2]; v.w += a[4 * g + 3];
      *(float4*)(xout + o + 8 * g) = v;
    }
  }
};
struct EpiUQ {
  u16* Q; const float* cs; const float* sn; int c; bool dry;
  DI void operator()(int z, int row, int colbase, int h, const f32x16& a) const {
    if (dry) return;
    const int head = colbase / 192, db = colbase - head * 192;
    const int lb = row >> 13, s = row & 8191;
    u16* qp = Q + ((size_t)(lb * 12 + head) * 8192 + s) * 192 + db + 4 * h;
    const size_t ti = (size_t)(c * 16384 + row) * 32;
#pragma unroll
    for (int g = 0; g < 4; ++g) {
      float v0 = a[4 * g], v1 = a[4 * g + 1], v2 = a[4 * g + 2], v3 = a[4 * g + 3];
      if (db >= 128) {
        const int pi = (db - 128 + 8 * g + 4 * h) >> 1;
        const float2 cc = *(const float2*)(cs + ti + pi), ss = *(const float2*)(sn + ti + pi);
        const float o0 = v0 * cc.x - v1 * ss.x, o1 = v0 * ss.x + v1 * cc.x;
        const float o2 = v2 * cc.y - v3 * ss.y, o3 = v2 * ss.y + v3 * cc.y;
        v0 = o0; v1 = o1; v2 = o2; v3 = o3;
      }
      u32x2 pk = {pack2(v0, v1), pack2(v2, v3)};
      *(u32x2*)(qp + 8 * g) = pk;
    }
  }
};
struct EpiUK {
  u16* Kb; bool dry;
  DI void operator()(int z, int row, int colbase, int h, const f32x16& a) const {
    if (dry) return;
    const int head = colbase >> 7, db = colbase & 127;
    const int lb = row >> 13, s = row & 8191;
    u16* kp = Kb + ((size_t)(lb * 12 + head) * 8192 + s) * 192 + db + 4 * h;
#pragma unroll
    for (int g = 0; g < 4; ++g) {
      u32x2 pk = {pack2(a[4 * g], a[4 * g + 1]), pack2(a[4 * g + 2], a[4 * g + 3])};
      *(u32x2*)(kp + 8 * g) = pk;
    }
  }
};
struct EpiUV {
  u16* Vt; bool dry;
  DI void operator()(int z, int rowbase, int col, int h, const f32x16& a) const {
    if (dry) return;
    const int head = col >> 7, d = col & 127;
#pragma unroll
    for (int g = 0; g < 4; ++g) {
      int lr = rowbase + 8 * g + 4 * h; int lb = lr >> 13, s = lr & 8191;
      u32x2 pk = {pack2(a[4 * g], a[4 * g + 1]), pack2(a[4 * g + 2], a[4 * g + 3])};
      *(u32x2*)(Vt + (((size_t)(lb * 12 + head) * 128 + (s >> 6)) * 128 + d) * 64 + (s & 63)) = pk;
    }
  }
};
struct EpiMemKV {
  u16* MK; u16* MVt; bool dry;
  DI void operator()(int z, int rowbase, int col, int h, const f32x16& a) const {
    if (col < 512) {
      const int xh = col >> 7, d = col & 127;
#pragma unroll
      for (int e = 0; e < 16; ++e) {
        int m = rowbase + crow(e, h); int b = m >> 8, mi = m & 255;
        MK[((size_t)((z * 4 + b) * 4 + xh) * 256 + mi) * 128 + d] = f2bf(a[e]);
      }
    } else {
      const int n = col - 512, xh = n >> 7, d = n & 127;
#pragma unroll
      for (int g = 0; g < 4; ++g) {
        int m = rowbase + 8 * g + 4 * h; int b = m >> 8, mi = m & 255;
        uint2 pk; pk.x = pack2(a[4 * g], a[4 * g + 1]); pk.y = pack2(a[4 * g + 2], a[4 * g + 3]);
        *(uint2*)(MVt + (((size_t)((z * 4 + b) * 4 + xh) * 4 + (mi >> 6)) * 128 + d) * 64 + (mi & 63)) = pk;
      }
    }
  }
};

DI void phase_kvprep(const Params& p, int L, int c, bool dry) {
  const int tid = otid(), w = tid >> 6, lane = tid & 63;
  const int j = L >> 1;
  u16* U = (u16*)(p.ws + OFF_U); u16* Kb = (u16*)(p.ws + OFF_K);
  const float* cs = (const float*)(p.ws + OFF_COS); const float* sn = (const float*)(p.ws + OFF_SIN);
  for (int lr = blockIdx.x * 4 + w; lr < TC; lr += gridDim.x * 4) {
    u16* row = U + (size_t)lr * LDU_M;
    float fq[8], fk[8]; float sq = 0.f, sk = 0.f;
    if (lane < 48) { uint4 v = *(const uint4*)(row + M_CQ + lane * 8); unpack8(v, fq);
#pragma unroll
      for (int e = 0; e < 8; ++e) sq += fq[e] * fq[e]; }
    if (lane < 32) { uint4 v = *(const uint4*)(row + M_CKV + lane * 8); unpack8(v, fk);
#pragma unroll
      for (int e = 0; e < 8; ++e) sk += fk[e] * fk[e]; }
    sq = wave_sum(sq); sk = wave_sum(sk);
    float rq = rsqrtf(sq * (1.f / 384.f) + 1e-6f), rk = rsqrtf(sk * (1.f / 256.f) + 1e-6f);
    if (dry) continue;
    if (lane < 48) {
      const float* g = p.q_norm_g + j * 384 + lane * 8;
#pragma unroll
      for (int e = 0; e < 8; ++e) fq[e] = fq[e] * rq * g[e];
      *(uint4*)(row + M_CQ + lane * 8) = pack8(fq);
    }
    if (lane < 32) {
      const float* g = p.kv_norm_g + j * 256 + lane * 8;
#pragma unroll
      for (int e = 0; e < 8; ++e) fk[e] = fk[e] * rk * g[e];
      *(uint4*)(row + M_CKV + lane * 8) = pack8(fk);
    }
    if (lane < 8) {
      float f[8], o[8]; uint4 v = *(const uint4*)(row + M_KR + lane * 8); unpack8(v, f);
      int gt = c * 16384 + lr;
#pragma unroll
      for (int i = 0; i < 4; ++i) {
        float cc = cs[gt * 32 + lane * 4 + i], ss = sn[gt * 32 + lane * 4 + i];
        o[2 * i] = f[2 * i] * cc - f[2 * i + 1] * ss; o[2 * i + 1] = f[2 * i] * ss + f[2 * i + 1] * cc;
      }
      uint4 pk = pack8(o);
      int lb = lr >> 13, s = lr & 8191;
#pragma unroll
      for (int hd = 0; hd < 12; ++hd) *(uint4*)(Kb + ((size_t)(lb * 12 + hd) * 8192 + s) * 192 + 128 + lane * 8) = pk;
    }
  }
}

template <int DQK>
DI void attn_item(const u16* __restrict__ Qp, int ldq, const u16* __restrict__ Kp, const u16* __restrict__ Vtp, int ldv,
                  int nkt, int q0, bool causal, float c, u16* Yp, int ldy, char* smem, bool dry) {
  constexpr int KLD = DQK + 8;
  constexpr int NKC = DQK * 64 / 8 / 256;
  constexpr int NKS = DQK / 16;
  constexpr int CPR = DQK / 8;
  constexpr int BUFE = 64 * KLD + 128 * 72;
  u16* L0 = (u16*)smem;
  const int tid = otid(), w = tid >> 6, lane = tid & 63, r = lane & 31, h = lane >> 5;
  bf16x8 qf[NKS];
  {
    const u16* qrow = Qp + (size_t)(32 * w + r) * ldq + 8 * h;
#pragma unroll
    for (int ks = 0; ks < NKS; ++ks) qf[ks] = *(const bf16x8*)(qrow + 16 * ks);
  }
  f32x16 o[4];
#pragma unroll
  for (int dt = 0; dt < 4; ++dt)
#pragma unroll
    for (int e = 0; e < 16; ++e) o[dt][e] = 0.f;
  float m = -INFINITY, l = 0.f;
  u32x4 kst[NKC], vst[4];
  const int vd = tid >> 3, vc8 = tid & 7;
  int kso[NKC];
#pragma unroll
  for (int i = 0; i < NKC; ++i) { int id = tid + 256 * i; int row = id / CPR, cc = id - row * CPR; kso[i] = row * KLD + cc * 8; }
  const int vso = 64 * KLD + vd * 72 + 16 * (vc8 >> 1) + 4 * (vc8 & 1);
  __syncthreads();
#pragma unroll
  for (int i = 0; i < NKC; ++i) kst[i] = *(const u32x4*)(Kp + (size_t)(tid + 256 * i) * 8);
#pragma unroll
  for (int i = 0; i < 4; ++i) vst[i] = *(const u32x4*)(Vtp + (size_t)(tid + 256 * i) * 8);
#pragma unroll
  for (int i = 0; i < NKC; ++i) *(u32x4*)(L0 + kso[i]) = kst[i];
#pragma unroll
  for (int i = 0; i < 4; ++i) {
    u16* dst = L0 + vso + (32 * i) * 72;
    u32x2 lo = {vst[i].x, vst[i].y}, hi = {vst[i].z, vst[i].w};
    *(u32x2*)dst = lo; *(u32x2*)(dst + 8) = hi;
  }
  if (nkt > 1) {
    const u16* kg = Kp + (size_t)64 * DQK;
#pragma unroll
    for (int i = 0; i < NKC; ++i) kst[i] = *(const u32x4*)(kg + (size_t)(tid + 256 * i) * 8);
#pragma unroll
    for (int i = 0; i < 4; ++i) vst[i] = *(const u32x4*)(Vtp + 8192 + (size_t)(tid + 256 * i) * 8);
  }
  __syncthreads();
  const int qmin = q0 + 32 * w;
  for (int kt = 0; kt < nkt; ++kt) {
    const u16* Ks = L0 + (kt & 1) * BUFE;
    const u16* Vs = Ks + 64 * KLD;
    u16* Ln = L0 + ((kt + 1) & 1) * BUFE;
    const bool active = !(causal && kt * 64 > qmin + 31);
    f32x16 s0, s1;
#pragma unroll
    for (int e = 0; e < 16; ++e) { s0[e] = 0.f; s1[e] = 0.f; }
    const u16* k0 = Ks + r * KLD + 8 * h;
    bf16x8 ka[2][2];
    if (active) {
      ka[0][0] = *(const bf16x8*)(k0); ka[0][1] = *(const bf16x8*)(k0 + 32 * KLD);
      ka[1][0] = *(const bf16x8*)(k0 + 16); ka[1][1] = *(const bf16x8*)(k0 + 32 * KLD + 16);
      __builtin_amdgcn_sched_barrier(0);
      s0 = MFMA32(ka[0][0], qf[0], s0); s1 = MFMA32(ka[0][1], qf[0], s1);
    }
    if (kt + 1 < nkt) {
#pragma unroll
      for (int i = 0; i < NKC; ++i) *(u32x4*)(Ln + kso[i]) = kst[i];
#pragma unroll
      for (int i = 0; i < 4; ++i) {
        u16* dst = Ln + vso + (32 * i) * 72;
        u32x2 lo = {vst[i].x, vst[i].y}, hi = {vst[i].z, vst[i].w};
        *(u32x2*)dst = lo; *(u32x2*)(dst + 8) = hi;
      }
    }
    if (kt + 2 < nkt) {
      const u16* kg = Kp + (size_t)(kt + 2) * 64 * DQK;
#pragma unroll
      for (int i = 0; i < NKC; ++i) kst[i] = *(const u32x4*)(kg + (size_t)(tid + 256 * i) * 8);
#pragma unroll
      for (int i = 0; i < 4; ++i) vst[i] = *(const u32x4*)(Vtp + (size_t)(kt + 2) * 8192 + (size_t)(tid + 256 * i) * 8);
    }
    if (active) {
      __builtin_amdgcn_sched_barrier(0);
#pragma unroll
      for (int ks = 1; ks < NKS; ++ks) {
        if (ks + 1 < NKS) {
          ka[(ks + 1) & 1][0] = *(const bf16x8*)(k0 + 16 * (ks + 1));
          ka[(ks + 1) & 1][1] = *(const bf16x8*)(k0 + 32 * KLD + 16 * (ks + 1));
        }
        __builtin_amdgcn_sched_barrier(0);
        s0 = MFMA32(ka[ks & 1][0], qf[ks], s0); s1 = MFMA32(ka[ks & 1][1], qf[ks], s1);
        __builtin_amdgcn_sched_barrier(0);
      }
      const u16* v0 = Vs + r * 72 + 8 * h;
      bf16x8 va[2][4];
#pragma unroll
      for (int dt = 0; dt < 4; ++dt) va[0][dt] = *(const bf16x8*)(v0 + (32 * dt) * 72);
      if (causal && kt * 64 + 63 > qmin) {
        const int qi = qmin + r;
#pragma unroll
        for (int e = 0; e < 16; ++e) {
          int key = kt * 64 + crow(e, h);
          if (key > qi) s0[e] = -INFINITY;
          if (key + 32 > qi) s1[e] = -INFINITY;
        }
      }
      float mx = fmaxf(s0[0], s1[0]);
#pragma unroll
      for (int e = 1; e < 16; ++e) mx = fmaxf(mx, fmaxf(s0[e], s1[e]));
      mx = fmaxf(mx, __shfl_xor(mx, 32));
      if (__builtin_amdgcn_ballot_w64((mx - m) * c > 8.f) != 0ull) {
        const float mn = fmaxf(m, mx);
        const float alpha = ex2((m - mn) * c);
        m = mn;
        l *= alpha;
#pragma unroll
        for (int dt = 0; dt < 4; ++dt)
#pragma unroll
          for (int e = 0; e < 16; ++e) o[dt][e] *= alpha;
      }
      const float mc = m * c;
      float ps = 0.f;
#pragma unroll
      for (int e = 0; e < 16; ++e) { s0[e] = ex2(fmaf(s0[e], c, -mc)); s1[e] = ex2(fmaf(s1[e], c, -mc)); ps += s0[e] + s1[e]; }
      l += ps;
      bf16x8 pf[4];
      {
        u32x4 t;
        t.x = pack2(s0[0], s0[1]); t.y = pack2(s0[2], s0[3]); t.z = pack2(s0[4], s0[5]); t.w = pack2(s0[6], s0[7]); pf[0] = __builtin_bit_cast(bf16x8, t);
        t.x = pack2(s0[8], s0[9]); t.y = pack2(s0[10], s0[11]); t.z = pack2(s0[12], s0[13]); t.w = pack2(s0[14], s0[15]); pf[1] = __builtin_bit_cast(bf16x8, t);
        t.x = pack2(s1[0], s1[1]); t.y = pack2(s1[2], s1[3]); t.z = pack2(s1[4], s1[5]); t.w = pack2(s1[6], s1[7]); pf[2] = __builtin_bit_cast(bf16x8, t);
        t.x = pack2(s1[8], s1[9]); t.y = pack2(s1[10], s1[11]); t.z = pack2(s1[12], s1[13]); t.w = pack2(s1[14], s1[15]); pf[3] = __builtin_bit_cast(bf16x8, t);
      }
#pragma unroll
      for (int kk = 0; kk < 4; ++kk) {
        if (kk < 3) {
#pragma unroll
          for (int dt = 0; dt < 4; ++dt) va[(kk + 1) & 1][dt] = *(const bf16x8*)(v0 + (32 * dt) * 72 + 16 * (kk + 1));
        }
        __builtin_amdgcn_sched_barrier(0);
#pragma unroll
        for (int dt = 0; dt < 4; ++dt) o[dt] = MFMA32(va[kk & 1][dt], pf[kk], o[dt]);
        __builtin_amdgcn_sched_barrier(0);
      }
    }
    __syncthreads();
  }
  const float lt = l + __shfl_xor(l, 32);
  const float inv = 1.f / lt;
  if (dry) return;
  u16* yrow = Yp + (size_t)(32 * w + r) * ldy;
#pragma unroll
  for (int dt = 0; dt < 4; ++dt)
#pragma unroll
    for (int g = 0; g < 4; ++g) {
      const int d = 32 * dt + 8 * g + 4 * h;
      uint2 gv = *(const uint2*)(yrow + d);
      float g0 = bf2f(gv.x & 0xffffu), g1 = bf2f(gv.x >> 16), g2 = bf2f(gv.y & 0xffffu), g3 = bf2f(gv.y >> 16);
      uint2 ov;
      ov.x = pack2(o[dt][4 * g] * inv * silu(g0), o[dt][4 * g + 1] * inv * silu(g1));
      ov.y = pack2(o[dt][4 * g + 2] * inv * silu(g2), o[dt][4 * g + 3] * inv * silu(g3));
      *(uint2*)(yrow + d) = ov;
    }
}

template <int DQK>
DI void attn_item_c(const u16* __restrict__ Qp, int ldq, const u16* __restrict__ Kp, const u16* __restrict__ Vtp, int ldv,
                    int nkt, int q0, float c, u16* Yp, int ldy, char* smem, bool dry) {
  constexpr int KLD = DQK + 8;
  constexpr int NKC = DQK * 64 / 8 / 256;
  constexpr int NKS = DQK / 16;
  constexpr int CPR = DQK / 8;
  constexpr int BUFE = 64 * KLD + 128 * 72;
  u16* L0 = (u16*)smem;
  const int tid = otid(), w = tid >> 6, lane = tid & 63, r = lane & 31, h = lane >> 5;
  bf16x8 qf[NKS];
  {
    const u16* qrow = Qp + (size_t)(32 * w + r) * ldq + 8 * h;
#pragma unroll
    for (int ks = 0; ks < NKS; ++ks) qf[ks] = *(const bf16x8*)(qrow + 16 * ks);
  }
  f32x16 o[4];
#pragma unroll
  for (int dt = 0; dt < 4; ++dt)
#pragma unroll
    for (int e = 0; e < 16; ++e) o[dt][e] = 0.f;
  float m = -INFINITY, l = 0.f;
  u32x4 kstA[NKC], vstA[4], kstB[NKC], vstB[4];
  const int vd = tid >> 3, vc8 = tid & 7;
  int kso[NKC];
#pragma unroll
  for (int i = 0; i < NKC; ++i) { int id = tid + 256 * i; int row = id / CPR, cc = id - row * CPR; kso[i] = row * KLD + cc * 8; }
  const int vso = 64 * KLD + vd * 72 + 16 * (vc8 >> 1) + 4 * (vc8 & 1);
  const int nktp = (nkt + 3) & ~3;
  auto gload = [&](u32x4* ks_, u32x4* vs_, int j) {
    const u16* kg = Kp + (size_t)(j + 1) * 64 * DQK;
#pragma unroll
    for (int i = 0; i < NKC; ++i) ks_[i] = *(const u32x4*)(kg + (size_t)(tid + 256 * i) * 8);
#pragma unroll
    for (int i = 0; i < 4; ++i) vs_[i] = *(const u32x4*)(Vtp + (size_t)j * 8192 + (size_t)(tid + 256 * i) * 8);
  };
  auto lstore = [&](const u32x4* ks_, const u32x4* vs_, u16* Lb) {
#pragma unroll
    for (int i = 0; i < NKC; ++i) *(u32x4*)(Lb + kso[i]) = ks_[i];
#pragma unroll
    for (int i = 0; i < 4; ++i) {
      u16* dst = Lb + vso + (32 * i) * 72;
      u32x2 lo = {vs_[i].x, vs_[i].y}, hi = {vs_[i].z, vs_[i].w};
      *(u32x2*)dst = lo; *(u32x2*)(dst + 8) = hi;
    }
  };
  __syncthreads();
  gload(kstA, vstA, 0);
  gload(kstB, vstB, 1);
  f32x16 sa0, sa1, sb0, sb1;
#pragma unroll
  for (int e = 0; e < 16; ++e) { sa0[e] = 0.f; sa1[e] = 0.f; }
  {
    const u16* kr = Kp + (size_t)r * DQK + 8 * h;
#pragma unroll
    for (int ks = 0; ks < NKS; ++ks) {
      bf16x8 a0 = *(const bf16x8*)(kr + 16 * ks), a1 = *(const bf16x8*)(kr + 32 * DQK + 16 * ks);
      sa0 = MFMA32(a0, qf[ks], sa0); sa1 = MFMA32(a1, qf[ks], sa1);
    }
  }
  lstore(kstA, vstA, L0);
  gload(kstA, vstA, 2);
  __syncthreads();
  const int qmin = q0 + 32 * w;
  const int qi = qmin + r;
  auto body = [&](int kt, u32x4* wk, u32x4* wv, f32x16& s0, f32x16& s1, f32x16& n0, f32x16& n1) {
    const u16* Ks = L0 + (kt & 1) * BUFE;
    const u16* Vs = Ks + 64 * KLD;
    u16* Ln = L0 + ((kt + 1) & 1) * BUFE;
    const bool active = !(kt * 64 > qmin + 31);
    if (kt * 64 + 63 > qmin) {
#pragma unroll
      for (int e = 0; e < 16; ++e) {
        int key = kt * 64 + crow(e, h);
        if (key > qi) s0[e] = -INFINITY;
        if (key + 32 > qi) s1[e] = -INFINITY;
      }
    }
    float mx = fmaxf(s0[0], s1[0]);
#pragma unroll
    for (int e = 1; e < 16; ++e) mx = fmaxf(mx, fmaxf(s0[e], s1[e]));
    mx = fmaxf(mx, __shfl_xor(mx, 32));
    if (__builtin_amdgcn_ballot_w64((mx - m) * c > 8.f) != 0ull) {
      const float mn = fmaxf(m, mx);
      const float alpha = ex2((m - mn) * c);
      m = mn;
      l *= alpha;
#pragma unroll
      for (int dt = 0; dt < 4; ++dt)
#pragma unroll
        for (int e = 0; e < 16; ++e) o[dt][e] *= alpha;
    }
    const float mc = m * c;
#pragma unroll
    for (int e = 0; e < 16; ++e) { n0[e] = 0.f; n1[e] = 0.f; }
    const u16* k0 = Ks + r * KLD + 8 * h;
    bf16x8 ka[2][2];
    ka[0][0] = *(const bf16x8*)(k0); ka[0][1] = *(const bf16x8*)(k0 + 32 * KLD);
    bf16x8 pf[4];
    u32x4 pk[4];
    float ps = 0.f;
#pragma unroll
    for (int ks = 0; ks < NKS; ++ks) {
      if (ks + 1 < NKS) {
        ka[(ks + 1) & 1][0] = *(const bf16x8*)(k0 + 16 * (ks + 1));
        ka[(ks + 1) & 1][1] = *(const bf16x8*)(k0 + 32 * KLD + 16 * (ks + 1));
      }
      __builtin_amdgcn_sched_barrier(0);
      n0 = MFMA32(ka[ks & 1][0], qf[ks], n0); n1 = MFMA32(ka[ks & 1][1], qf[ks], n1);
      if (ks < 8) {
#pragma unroll
        for (int e4 = 0; e4 < 4; ++e4) {
          const int e = (4 * ks + e4) & 15;
          if (ks < 4) { s0[e] = ex2(fmaf(s0[e], c, -mc)); ps += s0[e]; }
          else        { s1[e] = ex2(fmaf(s1[e], c, -mc)); ps += s1[e]; }
        }
      }
      if (ks == 1) {
        lstore(wk, wv, Ln);
        gload(wk, wv, kt + 3);
      }
      if (ks == 4)  { pk[0].x = pack2(s0[0], s0[1]);  pk[0].y = pack2(s0[2], s0[3]);   pk[0].z = pack2(s0[4], s0[5]);   pk[0].w = pack2(s0[6], s0[7]); }
      if (ks == 5)  { pk[1].x = pack2(s0[8], s0[9]);  pk[1].y = pack2(s0[10], s0[11]); pk[1].z = pack2(s0[12], s0[13]); pk[1].w = pack2(s0[14], s0[15]); }
      if (ks == 8)  { pk[2].x = pack2(s1[0], s1[1]);  pk[2].y = pack2(s1[2], s1[3]);   pk[2].z = pack2(s1[4], s1[5]);   pk[2].w = pack2(s1[6], s1[7]); }
      if (ks == 9)  { pk[3].x = pack2(s1[8], s1[9]);  pk[3].y = pack2(s1[10], s1[11]); pk[3].z = pack2(s1[12], s1[13]); pk[3].w = pack2(s1[14], s1[15]); }
      __builtin_amdgcn_sched_barrier(0);
    }
    l += ps;
#pragma unroll
    for (int i = 0; i < 4; ++i) pf[i] = __builtin_bit_cast(bf16x8, pk[i]);
    if (active) {
      const u16* v0 = Vs + r * 72 + 8 * h;
      bf16x8 va[2][4];
#pragma unroll
      for (int dt = 0; dt < 4; ++dt) va[0][dt] = *(const bf16x8*)(v0 + (32 * dt) * 72);
#pragma unroll
      for (int kk = 0; kk < 4; ++kk) {
        if (kk < 3) {
#pragma unroll
          for (int dt = 0; dt < 4; ++dt) va[(kk + 1) & 1][dt] = *(const bf16x8*)(v0 + (32 * dt) * 72 + 16 * (kk + 1));
        }
        __builtin_amdgcn_sched_barrier(0);
#pragma unroll
        for (int dt = 0; dt < 4; ++dt) o[dt] = MFMA32(va[kk & 1][dt], pf[kk], o[dt]);
        __builtin_amdgcn_sched_barrier(0);
      }
    }
    __syncthreads();
  };
  for (int kt4 = 0; kt4 < nktp; kt4 += 4) {
    body(kt4 + 0, kstB, vstB, sa0, sa1, sb0, sb1); body(kt4 + 1, kstA, vstA, sb0, sb1, sa0, sa1);
    body(kt4 + 2, kstB, vstB, sa0, sa1, sb0, sb1); body(kt4 + 3, kstA, vstA, sb0, sb1, sa0, sa1);
  }
  const float lt = l + __shfl_xor(l, 32);
  const float inv = 1.f / lt;
  if (dry) return;
  u16* yrow = Yp + (size_t)(32 * w + r) * ldy;
#pragma unroll
  for (int dt = 0; dt < 4; ++dt)
#pragma unroll
    for (int g = 0; g < 4; ++g) {
      const int d = 32 * dt + 8 * g + 4 * h;
      uint2 gv = *(const uint2*)(yrow + d);
      float g0 = bf2f(gv.x & 0xffffu), g1 = bf2f(gv.x >> 16), g2 = bf2f(gv.y & 0xffffu), g3 = bf2f(gv.y >> 16);
      uint2 ov;
      ov.x = pack2(o[dt][4 * g] * inv * silu(g0), o[dt][4 * g + 1] * inv * silu(g1));
      ov.y = pack2(o[dt][4 * g + 2] * inv * silu(g2), o[dt][4 * g + 3] * inv * silu(g3));
      *(uint2*)(yrow + d) = ov;
    }
}

DI void memattn_item(const Params& p, int L, int c, int item, char* smem, bool dry) {
  const bool rw = L & 1;
  const int ldu = rw ? LDU_R : LDU_M, oq = rw ? R_QM : M_QM, og = rw ? R_GATE : M_GATE;
  const int tile = item >> 2, xh = item & 3;
  const int b = gtok(rw, c, tile * 128) >> 13;
  u16* U = (u16*)(p.ws + OFF_U);
  const u16* MK = (const u16*)(p.ws + OFF_MEMK) + (size_t)((L * 4 + b) * 4 + xh) * 256 * 128;
  const u16* MV = (const u16*)(p.ws + OFF_MEMVT) + (size_t)((L * 4 + b) * 4 + xh) * 128 * 256;
  attn_item<128>(U + (size_t)tile * 128 * ldu + oq + xh * 128, ldu, MK, MV, 256, 4, 0, false,
                 0.08838834764831845f * 1.4426950408889634f, U + (size_t)tile * 128 * ldu + og + 1536 + xh * 128, ldu, smem, dry);
}

DI void phase_attn(const Params& p, int L, int c, char* smem, int* s_item, bool dry) {
  int* cnt = (int*)(p.ws + OFF_CNT) + 64 + ((L * 2 + c) * 2 + (dry ? 1 : 0)) * 16;
  u16* U = (u16*)(p.ws + OFF_U);
  const u16* Q = (const u16*)(p.ws + OFF_Q); const u16* Kb = (const u16*)(p.ws + OFF_K); const u16* Vt = (const u16*)(p.ws + OFF_VT);
  const int xcc = (int)(__builtin_amdgcn_s_getreg((3 << 11) | 20) & 7u);
  for (int k = 0; k < 8; ++k) {
    const int x = (xcc + k) & 7;
    for (;;) {
      __syncthreads();
      if (otid() == 0) *s_item = atomicAdd(cnt + x, 1);
      __syncthreads();
      const int item = *s_item;
      if (item >= 192) break;
      const int qt = 63 - (item & 63), bh = 3 * x + (item >> 6);
      const int lb = bh / 12, head = bh - lb * 12;
      const int q0 = qt * 128;
      attn_item_c<192>(Q + ((size_t)(lb * 12 + head) * 8192 + q0) * 192, 192, Kb + (size_t)(lb * 12 + head) * 8192 * 192,
                     Vt + (size_t)(lb * 12 + head) * 128 * 8192, 8192, 2 * (qt + 1), q0,
                     0.07216878364870323f * 1.4426950408889634f,
                     U + (size_t)(lb * 8192 + q0) * LDU_M + M_GATE + head * 128, LDU_M, smem, dry);
    }
  }
  for (;;) {
    __syncthreads();
    if (otid() == 0) *s_item = atomicAdd(cnt + 8, 1);
    __syncthreads();
    const int item = *s_item;
    if (item >= 512) break;
    memattn_item(p, L, c, item, smem, dry);
  }
}

DI void scan_item(const Params& p, int L, int c, int item, char* smem, bool dry) {
  const int tid = otid(), w = tid >> 6, lane = tid & 63, r = lane & 31, h = lane >> 5;
  const int j = L >> 1;
  const int b = item / 48, rem = item - b * 48, head = rem >> 1, half = rem & 1;
  float* PA  = (float*)smem;
  float* Vst = PA + 32 * 5 * 64;
  float* Yst = Vst + 32 * 32;
  float* PRM = Yst + 32 * 32;
  float* BON = PRM + 10 * 64;
  u16* A1  = (u16*)(BON + 32);
  u16* W2t = A1 + 2 * 32 * 72;
  float* LO  = (float*)(W2t + 2 * 64 * 72);
  const u16* U = (const u16*)(p.ws + OFF_U);
  const u16* BND = (const u16*)(p.ws + OFF_BND);
  u16* YR = (u16*)(p.ws + OFF_YR); u16* BV = (u16*)(p.ws + OFF_BV);
  float* ST = (float*)(p.ws + OFF_ST); float* BS = (float*)(p.ws + OFF_BS);
  float* STATE = (float*)(p.ws + OFF_STATE);
  __syncthreads();
  if (tid < 64) {
    const float* mu = p.mu + j * SHIFTW;
    const int hc = head * 64 + tid;
    PRM[0 * 64 + tid] = mu[R_R + hc]; PRM[1 * 64 + tid] = mu[R_K + hc]; PRM[2 * 64 + tid] = mu[R_WD + tid]; PRM[3 * 64 + tid] = mu[R_AD + tid];
    PRM[4 * 64 + tid] = p.w0[j * 1536 + hc]; PRM[5 * 64 + tid] = p.a0[j * 1536 + hc]; PRM[6 * 64 + tid] = p.k_k[j * 1536 + hc];
    PRM[7 * 64 + tid] = p.k_a[j * 1536 + hc]; PRM[8 * 64 + tid] = p.r_k[j * 1536 + hc];
    PRM[9 * 64 + tid] = (tid < 32) ? mu[R_V + head * 64 + 32 * half + tid] : 0.f;
  }
  for (int e = tid; e < 8192; e += 256) {
    int arr = e >> 12, jj = (e >> 6) & 63, cc = e & 63;
    const float* src = (arr ? p.a2 : p.w2) + (size_t)j * 64 * 1536;
    W2t[(arr * 64 + cc) * 72 + jj] = f2bf(src[jj * 1536 + head * 64 + cc]);
  }
  const int rowl = lane >> 3, ks = lane & 7, row32 = 8 * w + rowl;
  float S[8];
  {
    float* sp = STATE + ((size_t)((b * 24 + head) * 64 + 32 * half + row32)) * 64 + 8 * ks;
#pragma unroll
    for (int i = 0; i < 8; ++i) S[i] = (c == 0) ? 0.f : sp[i];
  }
  const int tt = tid >> 3, cs = tid & 7;
  uint4 Rr_c, Rr_p, Rk_c, Rk_p, Rw_c, Rw_p, Ra_c, Ra_p, Rv_c, Rv_p;
  const uint4 zero4 = {0u, 0u, 0u, 0u};
  auto load_raw = [&](int tc) {
    const int lr = b * 4096 + tc * 32 + tt;
    const int s = c * 4096 + tc * 32 + tt;
    const u16* cur = U + (size_t)lr * LDU_R;
    const u16* prv = (s == 0) ? (BND + (size_t)4 * SHIFTW) : ((s == 4096 && c == 1) ? (BND + (size_t)b * SHIFTW) : (cur - LDU_R));
    Rr_c = *(const uint4*)(cur + R_R + head * 64 + cs * 8);  Rr_p = *(const uint4*)(prv + R_R + head * 64 + cs * 8);
    Rk_c = *(const uint4*)(cur + R_K + head * 64 + cs * 8);  Rk_p = *(const uint4*)(prv + R_K + head * 64 + cs * 8);
    Rw_c = *(const uint4*)(cur + R_WD + cs * 8);             Rw_p = *(const uint4*)(prv + R_WD + cs * 8);
    Ra_c = *(const uint4*)(cur + R_AD + cs * 8);             Ra_p = *(const uint4*)(prv + R_AD + cs * 8);
    const int vo = R_V + head * 64 + 32 * half + (cs & 3) * 8;
    Rv_c = *(const uint4*)(cur + vo);                        Rv_p = *(const uint4*)(prv + vo);
  };
  uint4 d_y = zero4, d_v = zero4; float d_sm = 0.f, d_sq = 0.f; int d_lr = -1;
  auto flush_out = [&]() {
    if (cs < 4 && !dry && d_lr >= 0) {
      const size_t o = (size_t)d_lr * 1536 + head * 64 + 32 * half + cs * 8;
      *(uint4*)(YR + o) = d_y;
      *(uint4*)(BV + o) = d_v;
      if (cs == 0) {
        float* stp = ST + ((size_t)(d_lr * 24 + head) * 2 + half) * 2;
        stp[0] = d_sm; stp[1] = d_sq;
      }
    }
  };
  load_raw(0);
  __syncthreads();
  for (int tc = 0; tc < 128; ++tc) {
    const int lr = b * 4096 + tc * 32 + tt;
    float rm[8], km[8];
    {
      float cu[8], pv[8], t8[8];
      unpack8(Rr_c, cu); unpack8(Rr_p, pv);
#pragma unroll
      for (int e = 0; e < 8; ++e) rm[e] = cu[e] + (pv[e] - cu[e]) * PRM[0 * 64 + cs * 8 + e];
      unpack8(Rk_c, cu); unpack8(Rk_p, pv);
#pragma unroll
      for (int e = 0; e < 8; ++e) km[e] = cu[e] + (pv[e] - cu[e]) * PRM[1 * 64 + cs * 8 + e];
      unpack8(Rw_c, cu); unpack8(Rw_p, pv);
#pragma unroll
      for (int e = 0; e < 8; ++e) {
        float xw = cu[e] + (pv[e] - cu[e]) * PRM[2 * 64 + cs * 8 + e];
        float ee = ex2(xw * 2.8853900817779268f);
        t8[e] = 1.f - 2.f * frcp(ee + 1.f);
      }
      *(uint4*)(A1 + (0 * 32 + tt) * 72 + cs * 8) = pack8(t8);
      unpack8(Ra_c, cu); unpack8(Ra_p, pv);
#pragma unroll
      for (int e = 0; e < 8; ++e) t8[e] = cu[e] + (pv[e] - cu[e]) * PRM[3 * 64 + cs * 8 + e];
      *(uint4*)(A1 + (1 * 32 + tt) * 72 + cs * 8) = pack8(t8);
      unpack8(Rv_c, cu); unpack8(Rv_p, pv);
      if (cs < 4) {
#pragma unroll
        for (int e = 0; e < 8; ++e) Vst[tt * 32 + cs * 8 + e] = cu[e] + (pv[e] - cu[e]) * PRM[9 * 64 + cs * 8 + e];
      }
    }
    __syncthreads();
    {
      const int arr = w >> 1, nt = w & 1;
      f32x16 acc;
#pragma unroll
      for (int e = 0; e < 16; ++e) acc[e] = 0.f;
#pragma unroll
      for (int k4 = 0; k4 < 4; ++k4) {
        bf16x8 a = *(const bf16x8*)(A1 + (arr * 32 + r) * 72 + 16 * k4 + 8 * h);
        bf16x8 bw = *(const bf16x8*)(W2t + (arr * 64 + 32 * nt + r) * 72 + 16 * k4 + 8 * h);
        acc = MFMA32(a, bw, acc);
      }
#pragma unroll
      for (int e = 0; e < 16; ++e) LO[(arr * 32 + crow(e, h)) * 64 + 32 * nt + r] = acc[e];
    }
    __syncthreads();
    float lw[8], la[8];
    {
      float4 t0 = *(const float4*)(LO + (0 * 32 + tt) * 64 + cs * 8), t1 = *(const float4*)(LO + (0 * 32 + tt) * 64 + cs * 8 + 4);
      lw[0] = t0.x; lw[1] = t0.y; lw[2] = t0.z; lw[3] = t0.w; lw[4] = t1.x; lw[5] = t1.y; lw[6] = t1.z; lw[7] = t1.w;
      t0 = *(const float4*)(LO + (1 * 32 + tt) * 64 + cs * 8); t1 = *(const float4*)(LO + (1 * 32 + tt) * 64 + cs * 8 + 4);
      la[0] = t0.x; la[1] = t0.y; la[2] = t0.z; la[3] = t0.w; la[4] = t1.x; la[5] = t1.y; la[6] = t1.z; la[7] = t1.w;
    }
    {
      float dec[8], kk[8], av[8], kp[8];
      float ssq = 0.f, bon = 0.f;
#pragma unroll
      for (int e = 0; e < 8; ++e) {
        const int ch = cs * 8 + e;
        const float sg = frcp(1.f + fexp(-(lw[e] + PRM[4 * 64 + ch])));
        dec[e] = ex2(-0.8750340f * sg);
        float a = frcp(1.f + fexp(-(la[e] + PRM[5 * 64 + ch])));
        av[e] = a;
        kk[e] = km[e] * PRM[6 * 64 + ch];
        ssq += kk[e] * kk[e];
        kp[e] = km[e] * (1.f + (a - 1.f) * PRM[7 * 64 + ch]);
        bon += rm[e] * kp[e] * PRM[8 * 64 + ch];
      }
      ssq = red8(ssq); bon = red8(bon);
      const float inv = 1.f / fmaxf(sqrtf(ssq), 1e-12f);
      float nk[8], bb[8];
#pragma unroll
      for (int e = 0; e < 8; ++e) { float kn = kk[e] * inv; nk[e] = -kn; bb[e] = kn * av[e]; }
      float* pa = PA + tt * 320 + cs * 8;
      *(float4*)(pa) = make_float4(dec[0], dec[1], dec[2], dec[3]); *(float4*)(pa + 4) = make_float4(dec[4], dec[5], dec[6], dec[7]);
      *(float4*)(pa + 64) = make_float4(nk[0], nk[1], nk[2], nk[3]); *(float4*)(pa + 68) = make_float4(nk[4], nk[5], nk[6], nk[7]);
      *(float4*)(pa + 128) = make_float4(bb[0], bb[1], bb[2], bb[3]); *(float4*)(pa + 132) = make_float4(bb[4], bb[5], bb[6], bb[7]);
      *(float4*)(pa + 192) = make_float4(kp[0], kp[1], kp[2], kp[3]); *(float4*)(pa + 196) = make_float4(kp[4], kp[5], kp[6], kp[7]);
      *(float4*)(pa + 256) = make_float4(rm[0], rm[1], rm[2], rm[3]); *(float4*)(pa + 260) = make_float4(rm[4], rm[5], rm[6], rm[7]);
      if (cs == 0) BON[tt] = bon;
    }
    __syncthreads();
    if (tc + 1 < 128) load_raw(tc + 1);
    flush_out();
    {
      const float* pa0 = PA + ks * 8;
      const float* vs0 = Vst + row32;
      float4 d0 = *(const float4*)(pa0), d1 = *(const float4*)(pa0 + 4);
      float4 n0 = *(const float4*)(pa0 + 64), n1 = *(const float4*)(pa0 + 68);
      float4 b0 = *(const float4*)(pa0 + 128), b1 = *(const float4*)(pa0 + 132);
      float4 k0 = *(const float4*)(pa0 + 192), k1 = *(const float4*)(pa0 + 196);
      float4 r0 = *(const float4*)(pa0 + 256), r1 = *(const float4*)(pa0 + 260);
      float vv = vs0[0];
#pragma unroll 4
      for (int t = 0; t < 32; ++t) {
        const float* pa = pa0 + (t + 1) * 320;
        const float4 xd0 = *(const float4*)(pa), xd1 = *(const float4*)(pa + 4);
        const float4 xn0 = *(const float4*)(pa + 64), xn1 = *(const float4*)(pa + 68);
        const float4 xb0 = *(const float4*)(pa + 128), xb1 = *(const float4*)(pa + 132);
        const float4 xk0 = *(const float4*)(pa + 192), xk1 = *(const float4*)(pa + 196);
        const float4 xr0 = *(const float4*)(pa + 256), xr1 = *(const float4*)(pa + 260);
        const float xvv = vs0[(t + 1) * 32];
        __builtin_amdgcn_sched_barrier(0);
        float sa0 = S[0] * n0.x, sa1 = S[1] * n0.y;
        sa0 = fmaf(S[2], n0.z, sa0); sa1 = fmaf(S[3], n0.w, sa1);
        sa0 = fmaf(S[4], n1.x, sa0); sa1 = fmaf(S[5], n1.y, sa1);
        sa0 = fmaf(S[6], n1.z, sa0); sa1 = fmaf(S[7], n1.w, sa1);
        float sa = red8(sa0 + sa1);
        S[0] = fmaf(sa, b0.x, fmaf(S[0], d0.x, vv * k0.x)); S[1] = fmaf(sa, b0.y, fmaf(S[1], d0.y, vv * k0.y));
        S[2] = fmaf(sa, b0.z, fmaf(S[2], d0.z, vv * k0.z)); S[3] = fmaf(sa, b0.w, fmaf(S[3], d0.w, vv * k0.w));
        S[4] = fmaf(sa, b1.x, fmaf(S[4], d1.x, vv * k1.x)); S[5] = fmaf(sa, b1.y, fmaf(S[5], d1.y, vv * k1.y));
        S[6] = fmaf(sa, b1.z, fmaf(S[6], d1.z, vv * k1.z)); S[7] = fmaf(sa, b1.w, fmaf(S[7], d1.w, vv * k1.w));
        float y0 = S[0] * r0.x, y1 = S[1] * r0.y;
        y0 = fmaf(S[2], r0.z, y0); y1 = fmaf(S[3], r0.w, y1);
        y0 = fmaf(S[4], r1.x, y0); y1 = fmaf(S[5], r1.y, y1);
        y0 = fmaf(S[6], r1.z, y0); y1 = fmaf(S[7], r1.w, y1);
        float y = red8(y0 + y1);
        if (ks == 0) Yst[t * 32 + row32] = y;

        d0 = xd0; d1 = xd1; n0 = xn0; n1 = xn1; b0 = xb0; b1 = xb1; k0 = xk0; k1 = xk1; r0 = xr0; r1 = xr1; vv = xvv;
      }
    }
    __syncthreads();
    {
      const int c4 = cs & 3;
      float y8[8], v8[8];
      float4 t0 = *(const float4*)(Yst + tt * 32 + c4 * 8), t1 = *(const float4*)(Yst + tt * 32 + c4 * 8 + 4);
      y8[0] = t0.x; y8[1] = t0.y; y8[2] = t0.z; y8[3] = t0.w; y8[4] = t1.x; y8[5] = t1.y; y8[6] = t1.z; y8[7] = t1.w;
      float sm = 0.f, sq = 0.f;
#pragma unroll
      for (int e = 0; e < 8; ++e) { sm += y8[e]; sq += y8[e] * y8[e]; }
      sm = red4(sm); sq = red4(sq);
      const float bon = BON[tt];
      t0 = *(const float4*)(Vst + tt * 32 + c4 * 8); t1 = *(const float4*)(Vst + tt * 32 + c4 * 8 + 4);
      v8[0] = t0.x * bon; v8[1] = t0.y * bon; v8[2] = t0.z * bon; v8[3] = t0.w * bon; v8[4] = t1.x * bon; v8[5] = t1.y * bon; v8[6] = t1.z * bon; v8[7] = t1.w * bon;
      d_y = pack8(y8); d_v = pack8(v8); d_sm = sm; d_sq = sq; d_lr = lr;
    }
  }
  flush_out();
  if (c == 0 && !dry) {
    float* sp = STATE + ((size_t)((b * 24 + head) * 64 + 32 * half + row32)) * 64 + 8 * ks;
#pragma unroll
    for (int i = 0; i < 8; ++i) sp[i] = S[i];
  }
}

DI void phase_scan(const Params& p, int L, int c, char* smem, int* s_item, bool dry) {
  for (int item = blockIdx.x; item < 192; item += gridDim.x) scan_item(p, L, c, item, smem, dry);
  int* cnt = (int*)(p.ws + OFF_CNT) + 64 + ((L * 2 + c) * 2 + (dry ? 1 : 0)) * 16 + 8;
  for (;;) {
    __syncthreads();
    if (otid() == 0) *s_item = atomicAdd(cnt, 1);
    __syncthreads();
    const int item = *s_item;
    if (item >= 512) break;
    memattn_item(p, L, c, item, smem, dry);
  }
}

DI void phase_finalize(const Params& p, int L, int c, bool dry) {
  const int j = L >> 1;
  u16* U = (u16*)(p.ws + OFF_U);
  const u16* YR = (const u16*)(p.ws + OFF_YR); const u16* BV = (const u16*)(p.ws + OFF_BV);
  const float* ST = (const float*)(p.ws + OFF_ST);
  const int G = gridDim.x;
  for (int idx = blockIdx.x * 256 + otid(); idx < TC * 192; idx += G * 256) {
    const int lr = idx / 192, c8 = idx - lr * 192, ch0 = c8 * 8, head = ch0 >> 6;
    const float4 st = *(const float4*)(ST + (size_t)(lr * 24 + head) * 4);
    const float mean = (st.x + st.z) * (1.f / 64.f);
    const float var = (st.y + st.w) * (1.f / 64.f) - mean * mean;
    const float rstd = rsqrtf(fmaxf(var, 0.f) + 64e-5f);
    float y[8], bv[8], g[8], o[8];
    unpack8(*(const uint4*)(YR + (size_t)lr * 1536 + ch0), y);
    unpack8(*(const uint4*)(BV + (size_t)lr * 1536 + ch0), bv);
    u16* gp = U + (size_t)lr * LDU_R + R_GATE + ch0;
    unpack8(*(const uint4*)gp, g);
    const float* gw = p.gn_w + j * 1536 + ch0; const float* gb = p.gn_b + j * 1536 + ch0;
#pragma unroll
    for (int e = 0; e < 8; ++e) o[e] = ((y[e] - mean) * rstd * gw[e] + gb[e] + bv[e]) * silu(g[e]);
    if (!dry) *(uint4*)gp = pack8(o);
  }
  if (c == 0) {
    u16* BND = (u16*)(p.ws + OFF_BND);
    for (int idx = blockIdx.x * 256 + otid(); idx < 4 * (SHIFTW / 8); idx += G * 256) {
      const int b = idx / (SHIFTW / 8), cc = idx - b * (SHIFTW / 8);
      *(uint4*)(BND + (size_t)b * SHIFTW + cc * 8) = *(const uint4*)(U + (size_t)(b * 4096 + 4095) * LDU_R + cc * 8);
    }
  }
}

enum { PH_PREP = 0, PH_NORM, PH_GEMM_IN, PH_KVPREP, PH_GEMM_UP, PH_ATTN, PH_SCAN, PH_FINALIZE, PH_GEMM_OUT, PH_FINAL };
constexpr int NSTEPS = 42;

DI void decode_step(int step, int& ph, int& L, int& c) {
  if (step == 0) { ph = PH_PREP; L = 0; c = 0; return; }
  if (step == NSTEPS - 1) { ph = PH_FINAL; L = 0; c = 0; return; }
  int s = step - 1;
  int pr = s / 20, rem = s - pr * 20;
  if (rem < 11) {
    L = 2 * pr;
    int k;
    if (rem < 6) { c = 0; k = rem; } else { c = 1; k = rem - 5; }
    ph = (k == 0) ? PH_NORM : (k == 1) ? PH_GEMM_IN : (k == 2) ? PH_KVPREP : (k == 3) ? PH_GEMM_UP : (k == 4) ? PH_ATTN : PH_GEMM_OUT;
  } else {
    rem -= 11; L = 2 * pr + 1;
    int k;
    if (rem < 5) { c = 0; k = rem; } else { c = 1; k = rem - 4; }
    ph = (k == 0) ? PH_NORM : (k == 1) ? PH_GEMM_IN : (k == 2) ? PH_SCAN : (k == 3) ? PH_FINALIZE : PH_GEMM_OUT;
  }
}

DI void run_step(const Params& p, int ph, int L, int c, char* smem, int* s_item, bool dry_in, int vt) {
  const bool dry = dry_in && !(HYP5 && (ph == PH_GEMM_IN || ph == PH_GEMM_UP));
  char* ws = p.ws;
  const bool rw = L & 1;
  const int j = L >> 1;
  switch (ph) {
    case PH_PREP: phase_prep(p, smem); break;
    case PH_NORM:
      phase_norm(p, L, c);
      if (L == 0 && c == 0) {
        EpiMemKV epi{(u16*)(ws + OFF_MEMK), (u16*)(ws + OFF_MEMVT), false};
        gemm_phase<2, false, 16>((const u16*)(ws + OFF_MEMH), 1024ull * 1024, 1024, (const u16*)(ws + OFF_WT_MEMKV), 1024ull * 1024, 1024, 4, 4, 8, 4, 1024, smem, epi, vt);
      }
      break;
    case PH_GEMM_IN:
      if (!rw) {
        EpiStoreBf16 epi{(u16*)(ws + OFF_U), LDU_M, LDU_M, dry};
        gemm_phase<2, true, 16>((const u16*)(ws + OFF_H), 0, 1024, (const u16*)(ws + OFF_WT_INMLA) + (size_t)j * 3328 * 1024, 0, 1024, 1, 64, 26, 4, 1024, smem, epi, vt);
      } else {
        EpiStoreBf16 epi{(u16*)(ws + OFF_U), LDU_R, LDU_R, dry};
        gemm_phase<2, true, 16>((const u16*)(ws + OFF_H), 0, 1024, (const u16*)(ws + OFF_WT_INRW) + (size_t)j * 7296 * 1024, 0, 1024, 1, 64, 57, 4, 1024, smem, epi, vt);
      }
      break;
    case PH_KVPREP: phase_kvprep(p, L, c, dry); break;
    case PH_GEMM_UP: {
      EpiUQ e1{(u16*)(ws + OFF_Q), (const float*)(ws + OFF_COS), (const float*)(ws + OFF_SIN), c, dry};
      gemm_phase<2, true, 6>((const u16*)(ws + OFF_U) + M_CQ, 0, LDU_M, (const u16*)(ws + OFF_WT_UQ) + (size_t)j * 2304 * 384, 0, 384, 1, 64, 18, 4, 384, smem, e1, vt);
      EpiUK e2{(u16*)(ws + OFF_K), dry};
      gemm_phase<2, true, 4>((const u16*)(ws + OFF_U) + M_CKV, 0, LDU_M, (const u16*)(ws + OFF_WT_UKV) + (size_t)j * 3072 * 256, 0, 256, 1, 64, 12, 4, 256, smem, e2, vt);
      EpiUV e3{(u16*)(ws + OFF_VT), dry};
      gemm_phase<2, false, 4>((const u16*)(ws + OFF_U) + M_CKV, 0, LDU_M, (const u16*)(ws + OFF_WT_UKV) + (size_t)j * 3072 * 256 + 1536ull * 256, 0, 256, 1, 64, 12, 4, 256, smem, e3, vt);
    } break;
    case PH_ATTN: phase_attn(p, L, c, smem, s_item, dry); break;
    case PH_SCAN: phase_scan(p, L, c, smem, s_item, dry); break;
    case PH_FINALIZE: phase_finalize(p, L, c, dry); break;
    case PH_GEMM_OUT: {
      EpiResid epi{(L == 0) ? p.x : (const float*)p.out, p.out, rw, c, dry};
      gemm_phase<2, true, 32>((const u16*)(ws + OFF_U) + (rw ? R_GATE : M_GATE), 0, rw ? LDU_R : LDU_M, (const u16*)(ws + OFF_WT_OUT) + (size_t)L * 1024 * 2048, 0, 2048,
                 1, 64, 8, 4, 2048, smem, epi, vt);
      if (c == 0 && !dry) phase_norm(p, L, 1);
    } break;
    case PH_FINAL: phase_final_norm(p, dry); break;
  }
}

DI void grid_barrier(unsigned* bar, unsigned& epoch) {
  __syncthreads();
  ++epoch;
  if (threadIdx.x == 0) {
    __builtin_amdgcn_fence(__ATOMIC_RELEASE, "agent");
    asm volatile("s_waitcnt vmcnt(0)" ::: "memory");
    const unsigned target = epoch * gridDim.x;
    __hip_atomic_fetch_add(bar, 1u, __ATOMIC_RELAXED, __HIP_MEMORY_SCOPE_AGENT);
    unsigned spins = 0;
    while (__hip_atomic_load(bar, __ATOMIC_RELAXED, __HIP_MEMORY_SCOPE_AGENT) < target) {
      __builtin_amdgcn_s_sleep(2);
      if (++spins > (1u << 22)) break;
    }
    __builtin_amdgcn_fence(__ATOMIC_ACQUIRE, "agent");
    asm volatile("s_waitcnt vmcnt(0)" ::: "memory");
  }
  __syncthreads();
}

__global__ void __launch_bounds__(256, 1) hybrid_megakernel(Params p, int s_lo, int s_hi, int coop, int probe_mask) {
  __shared__ __attribute__((aligned(16))) char smem[SMEM_BYTES];
  __shared__ int s_item;
  unsigned* bar = (unsigned*)(p.ws + OFF_BAR);
  unsigned epoch = 0;
  if (coop == 2) cg::this_grid().sync();
  __shared__ int s_vt;
  int myx = 0, myrank = 0;
  if (coop && threadIdx.x == 0) {
    myx = (int)(__builtin_amdgcn_s_getreg((3 << 11) | 20) & 7u);
    myrank = (int)__hip_atomic_fetch_add(bar + 16 + myx, 1u, __ATOMIC_RELAXED, __HIP_MEMORY_SCOPE_AGENT);
  }
  int vt = blockIdx.x;
  {
    const int G = gridDim.x, t = blockIdx.x;
    vt = ((G & 7) == 0) ? ((t & 7) * (G >> 3) + (t >> 3)) : t;
  }
  for (int st = s_lo; st < s_hi; ++st) {
    int ph, L, c;
    decode_step(st, ph, L, c);
    for (int rep = ((probe_mask >> ph) & 1) ? 0 : 1; rep < 2; ++rep) {
      run_step(p, ph, L, c, smem, &s_item, rep == 0, vt);
      if (coop && (rep == 0 || st + 1 < s_hi)) grid_barrier(bar, epoch);
      if (coop) for (int xs = 0; xs < EXTRA_SYNCS; ++xs) grid_barrier(bar, epoch);
    }
    if (coop && st == s_lo) {
      if (threadIdx.x == 0) {
        const int G = gridDim.x;
        bool ok = (G & 7) == 0;
        for (int x = 0; x < 8; ++x) ok = ok && ((int)__hip_atomic_load(bar + 16 + x, __ATOMIC_RELAXED, __HIP_MEMORY_SCOPE_AGENT) == (G >> 3));
        s_vt = ok ? (myx * (G >> 3) + myrank) : vt;
      }
      __syncthreads();
      vt = s_vt;
    }
  }
}

extern "C" void kernel_launch(void* const* d_in, const int* in_sizes, int n_in, void* d_out, int out_size, void* d_ws, size_t ws_size,
                              hipStream_t stream) {
  if (ws_size < WS_NEED) { fprintf(stderr, "workspace too small: %zu < %zu\n", ws_size, (size_t)WS_NEED); return; }
  Params p;
  memset(&p, 0, sizeof(p));
  p.x = (const float*)d_in[0]; p.mem = (const float*)d_in[1]; p.pos = (const int*)d_in[2];
  p.norm_g = (const float*)d_in[3]; p.mem_norm_g = (const float*)d_in[4]; p.w_mem_kv = (const float*)d_in[5];
  p.w_in_mla = (const float*)d_in[6]; p.q_norm_g = (const float*)d_in[7]; p.kv_norm_g = (const float*)d_in[8];
  p.w_uq = (const float*)d_in[9]; p.w_ukv = (const float*)d_in[10]; p.w_in_rwkv = (const float*)d_in[11];
  p.mu = (const float*)d_in[12]; p.w0 = (const float*)d_in[13]; p.w2 = (const float*)d_in[14]; p.a0 = (const float*)d_in[15];
  p.a2 = (const float*)d_in[16]; p.k_k = (const float*)d_in[17]; p.k_a = (const float*)d_in[18]; p.r_k = (const float*)d_in[19];
  p.gn_w = (const float*)d_in[20]; p.gn_b = (const float*)d_in[21]; p.w_out = (const float*)d_in[22]; p.final_g = (const float*)d_in[23];
  p.out = (float*)d_out; p.ws = (char*)d_ws;
  static int grid_blocks = 0;
  if (!grid_blocks) {
    int dev = 0, cus = 0, per_cu = 0;
    hipGetDevice(&dev);
    hipDeviceGetAttribute(&cus, hipDeviceAttributeMultiprocessorCount, dev);
    hipOccupancyMaxActiveBlocksPerMultiprocessor(&per_cu, hybrid_megakernel, 256, 0);
    if (per_cu > 2) per_cu = 2;
    if (per_cu < 1) per_cu = 1;
    grid_blocks = cus * per_cu;
  }
#if MULTI_LAUNCH
  for (int s = 0; s < NSTEPS; ++s) hipLaunchKernelGGL(hybrid_megakernel, dim3(grid_blocks), dim3(256), 0, stream, p, s, s + 1, 0, 0);
#else
  int s_lo = 0, s_hi = NSTEPS, coop = 1, probe_mask = PROBE_MASK;
  void* args[] = {&p, &s_lo, &s_hi, &coop, &probe_mask};
  hipMemsetAsync((char*)d_ws + OFF_BAR, 0, 256, stream);
  hipError_t e = hipLaunchCooperativeKernel((void*)hybrid_megakernel, dim3(grid_blocks), dim3(256), args, 0, stream);
  if (e != hipSuccess) fprintf(stderr, "cooperative launch failed: %s (grid %d)\n", hipGetErrorString(e), grid_blocks);
#endif
}
```

```cpp
#include <hip/hip_runtime.h>
#include <hip/hip_cooperative_groups.h>
#include <cstdio>
#include <cstring>
namespace cg = cooperative_groups;

#define PROBE_MASK 0
#define EXTRA_SYNCS 0
#define HYP1 0
#define HYP2 0
#define HYP3 0
#define HYP4 0
#define HYP5 0
#define HYP6 0
#ifndef MULTI_LAUNCH
#define MULTI_LAUNCH 0
#endif

#define DI __device__ __forceinline__
typedef unsigned short u16;
typedef __attribute__((ext_vector_type(8))) short bf16x8;
typedef __attribute__((ext_vector_type(16))) float f32x16;
typedef __attribute__((ext_vector_type(2))) __bf16 bf2_t;
typedef __attribute__((ext_vector_type(2))) float f2_t;
typedef __attribute__((ext_vector_type(4))) unsigned u32x4;
typedef __attribute__((ext_vector_type(2))) unsigned u32x2;
#define MFMA32(a, b, c) __builtin_amdgcn_mfma_f32_32x32x16_bf16((a), (b), (c), 0, 0, 0)

constexpr int SEQ = 8192, TC = 16384;
constexpr int LDU_M = 3264, LDU_R = 7296;
constexpr int M_CQ = 0, M_CKV = 384, M_KR = 640, M_QM = 704, M_GATE = 1216;
constexpr int R_R = 0, R_K = 1536, R_V = 3072, R_WD = 4608, R_AD = 4672, R_QM = 4736, R_GATE = 5248;
constexpr int SHIFTW = 4736;

constexpr size_t OFF_WT_MEMKV = 0;
constexpr size_t OFF_WT_INMLA = OFF_WT_MEMKV + 4ull * 1024 * 1024 * 2;
constexpr size_t OFF_WT_UQ    = OFF_WT_INMLA + 2ull * 3328 * 1024 * 2;
constexpr size_t OFF_WT_UKV   = OFF_WT_UQ + 2ull * 2304 * 384 * 2;
constexpr size_t OFF_WT_INRW  = OFF_WT_UKV + 2ull * 3072 * 256 * 2;
constexpr size_t OFF_WT_OUT   = OFF_WT_INRW + 2ull * 7296 * 1024 * 2;
constexpr size_t OFF_MEMH     = OFF_WT_OUT + 4ull * 1024 * 2048 * 2;
constexpr size_t OFF_MEMK     = OFF_MEMH + 4ull * 1024 * 1024 * 2;
constexpr size_t OFF_MEMVT    = OFF_MEMK + 4ull * 4 * 4 * 256 * 128 * 2;
constexpr size_t OFF_COS      = OFF_MEMVT + 4ull * 4 * 4 * 256 * 128 * 2;
constexpr size_t OFF_SIN      = OFF_COS + 32768ull * 32 * 4;
constexpr size_t OFF_CNT      = OFF_SIN + 32768ull * 32 * 4;
constexpr size_t OFF_BAR      = OFF_CNT + 4096;
constexpr size_t OFF_STATE    = OFF_BAR + 256;
constexpr size_t OFF_BND      = OFF_STATE + 96ull * 4096 * 4;
constexpr size_t OFF_H        = OFF_BND + 5ull * 4736 * 2 + 128;
constexpr size_t OFF_R        = OFF_H + 16384ull * 1024 * 2;
constexpr size_t OFF_U        = OFF_R;
constexpr size_t OFF_Q        = OFF_R + 16384ull * 3264 * 2;
constexpr size_t OFF_K        = OFF_Q + 2ull * 12 * 8192 * 192 * 2;
constexpr size_t OFF_VT       = OFF_K + 2ull * 12 * 8192 * 192 * 2;
constexpr size_t OFF_YR       = OFF_R + 16384ull * 7296 * 2;
constexpr size_t OFF_BV       = OFF_YR + 16384ull * 1536 * 2;
constexpr size_t OFF_ST       = OFF_BV + 16384ull * 1536 * 2;
constexpr size_t OFF_BS       = OFF_ST + 16384ull * 24 * 4 * 4;
constexpr size_t WS_NEED      = OFF_BS + 16384ull * 24 * 4;

constexpr int SMEM_BYTES = 149504;

struct Params {
  const float *x, *mem; const int* pos;
  const float *norm_g, *mem_norm_g, *w_mem_kv, *w_in_mla, *q_norm_g, *kv_norm_g, *w_uq, *w_ukv, *w_in_rwkv;
  const float *mu, *w0, *w2, *a0, *a2, *k_k, *k_a, *r_k, *gn_w, *gn_b, *w_out, *final_g;
  float* out; char* ws;
};

DI int otid() { int t = threadIdx.x; asm volatile("" : "+v"(t)); return t; }
DI float bf2f(unsigned v) { return __uint_as_float(v << 16); }
DI unsigned pack2(float a, float b) { f2_t v = {a, b}; bf2_t r = __builtin_convertvector(v, bf2_t); return __builtin_bit_cast(unsigned, r); }
DI u16 f2bf(float a) { return (u16)(pack2(a, 0.f) & 0xffffu); }
DI float ex2(float x) { return __builtin_amdgcn_exp2f(x); }
DI float fexp(float x) { return __builtin_amdgcn_exp2f(x * 1.4426950408889634f); }
DI float frcp(float x) { return __builtin_amdgcn_rcpf(x); }
DI float silu(float g) { return g * frcp(1.f + fexp(-g)); }
DI float wave_sum(float v) { for (int o = 32; o > 0; o >>= 1) v += __shfl_xor(v, o); return v; }
DI int crow(int reg, int h) { return (reg & 3) + 8 * (reg >> 2) + 4 * h; }
DI float dppf(float x, const int ctrl_sel) {
  int xi;
  if (ctrl_sel == 0) xi = __builtin_amdgcn_update_dpp(0, __float_as_int(x), 0xB1, 0xf, 0xf, true);
  else if (ctrl_sel == 1) xi = __builtin_amdgcn_update_dpp(0, __float_as_int(x), 0x4E, 0xf, 0xf, true);
  else xi = __builtin_amdgcn_update_dpp(0, __float_as_int(x), 0x141, 0xf, 0xf, true);
  return __int_as_float(xi);
}
DI float red4(float x) { x += dppf(x, 0); x += dppf(x, 1); return x; }
DI float red8(float x) { x += dppf(x, 0); x += dppf(x, 1); x += dppf(x, 2); return x; }
DI int gtok(bool rw, int c, int lr) { return rw ? ((lr >> 12) * 8192 + c * 4096 + (lr & 4095)) : (c * 16384 + lr); }
DI void unpack8(const uint4& v, float* f) {
  f[0] = bf2f(v.x & 0xffffu); f[1] = bf2f(v.x >> 16); f[2] = bf2f(v.y & 0xffffu); f[3] = bf2f(v.y >> 16);
  f[4] = bf2f(v.z & 0xffffu); f[5] = bf2f(v.z >> 16); f[6] = bf2f(v.w & 0xffffu); f[7] = bf2f(v.w >> 16);
}
DI uint4 pack8(const float* f) { uint4 v; v.x = pack2(f[0], f[1]); v.y = pack2(f[2], f[3]); v.z = pack2(f[4], f[5]); v.w = pack2(f[6], f[7]); return v; }

DI void transpose_tile(const float* __restrict__ src, u16* __restrict__ dst, int K, int N, int tk, int tn, int drow, float* tile) {
  const int tid = otid();
  __syncthreads();
#pragma unroll
  for (int i = 0; i < 4; ++i) {
    int kr = (tid >> 4) + 16 * i, nc = (tid & 15) * 4;
    float4 v = *(const float4*)(src + (size_t)(tk * 64 + kr) * N + tn * 64 + nc);
    tile[kr * 65 + nc] = v.x; tile[kr * 65 + nc + 1] = v.y; tile[kr * 65 + nc + 2] = v.z; tile[kr * 65 + nc + 3] = v.w;
  }
  __syncthreads();
#pragma unroll
  for (int i = 0; i < 2; ++i) {
    int n = (tid >> 3) + 32 * i, kc = (tid & 7) * 8;
    float f[8];
#pragma unroll
    for (int e = 0; e < 8; ++e) f[e] = tile[(kc + e) * 65 + n];
    *(uint4*)(dst + (size_t)(drow + n) * K + tk * 64 + kc) = pack8(f);
  }
}

DI void rms_row_bf16(const float* __restrict__ src, const float* __restrict__ g, u16* __restrict__ dst, int lane) {
  float4 v[4]; float ss = 0.f;
#pragma unroll
  for (int i = 0; i < 4; ++i) { v[i] = *(const float4*)(src + i * 256 + lane * 4); ss += v[i].x * v[i].x + v[i].y * v[i].y + v[i].z * v[i].z + v[i].w * v[i].w; }
  ss = wave_sum(ss);
  float rs = rsqrtf(ss * (1.f / 1024.f) + 1e-6f);
#pragma unroll
  for (int i = 0; i < 4; ++i) {
    float4 gg = *(const float4*)(g + i * 256 + lane * 4);
    uint2 o; o.x = pack2(v[i].x * rs * gg.x, v[i].y * rs * gg.y); o.y = pack2(v[i].z * rs * gg.z, v[i].w * rs * gg.w);
    *(uint2*)(dst + i * 256 + lane * 4) = o;
  }
}

DI void phase_prep(const Params& p, char* smem) {
  const int tid = otid(), G = gridDim.x, bid = blockIdx.x;
  char* ws = p.ws;
  if (bid == 0) for (int i = tid; i < 1024; i += 256) ((int*)(ws + OFF_CNT))[i] = 0;
  float* tile = (float*)smem;
  for (int g0 = bid; g0 < 9168; g0 += G) {
    int g = g0;
    const float* src = nullptr; u16* dst = nullptr; int K = 0, N = 0; size_t dstr = 0; bool ukv = false;
    if (g < 1024) { src = p.w_mem_kv; dst = (u16*)(ws + OFF_WT_MEMKV); K = 1024; N = 1024; dstr = 1024ull * 1024; }
    else if ((g -= 1024) < 1632) { src = p.w_in_mla; dst = (u16*)(ws + OFF_WT_INMLA); K = 1024; N = 3264; dstr = 3328ull * 1024; }
    else if ((g -= 1632) < 432) { src = p.w_uq; dst = (u16*)(ws + OFF_WT_UQ); K = 384; N = 2304; dstr = 2304ull * 384; }
    else if ((g -= 432) < 384) { src = p.w_ukv; dst = (u16*)(ws + OFF_WT_UKV); K = 256; N = 3072; dstr = 3072ull * 256; ukv = true; }
    else if ((g -= 384) < 3648) { src = p.w_in_rwkv; dst = (u16*)(ws + OFF_WT_INRW); K = 1024; N = 7296; dstr = 7296ull * 1024; }
    else { g -= 3648; src = p.w_out; dst = (u16*)(ws + OFF_WT_OUT); K = 2048; N = 1024; dstr = 1024ull * 2048; }
    int ntn = N >> 6, per = (K >> 6) * ntn;
    int m = g / per, t = g - m * per;
    int tk = t / ntn, tn = t - tk * ntn;
    int drow = tn * 64;
    if (ukv) { const int hd = drow >> 8, dd = drow & 255; drow = (dd < 128) ? (hd * 128 + dd) : (1536 + hd * 128 + dd - 128); }
    transpose_tile(src + (size_t)m * K * N, dst + (size_t)m * dstr, K, N, tk, tn, drow, tile);
  }
  for (int i = bid * 256 + tid; i < 2 * 64 * 1024 / 8; i += G * 256) {
    int m = i / (64 * 1024 / 8), r = i - m * (64 * 1024 / 8);
    uint4 z; z.x = z.y = z.z = z.w = 0u;
    *(uint4*)((u16*)(ws + OFF_WT_INMLA) + (size_t)m * 3328 * 1024 + 3264ull * 1024 + (size_t)r * 8) = z;
  }
  for (int i = bid * 256 + tid; i < SHIFTW / 8; i += G * 256) { uint4 z; z.x = z.y = z.z = z.w = 0u; *(uint4*)((u16*)(ws + OFF_BND) + 4 * SHIFTW + i * 8) = z; }
  float* cs = (float*)(ws + OFF_COS); float* sn = (float*)(ws + OFF_SIN);
  for (int i = bid * 256 + tid; i < 32768 * 32; i += G * 256) {
    int tk = i >> 5, pi = i & 31;
    float inv_freq = (float)exp2(-(double)(2 * pi) / 64.0 * 13.287712379549449);
    float ang = (float)p.pos[tk] * inv_freq;
    double rev = (double)ang * 0.15915494309189535;
    float fr = (float)(rev - rint(rev));
    cs[i] = __builtin_amdgcn_cosf(fr); sn[i] = __builtin_amdgcn_sinf(fr);
  }
  const int w = tid >> 6, lane = tid & 63;
  for (int row = bid * 4 + w; row < 4096; row += G * 4) {
    int L = row >> 10, m = row & 1023;
    rms_row_bf16(p.mem + (size_t)m * 1024, p.mem_norm_g + L * 1024, (u16*)(ws + OFF_MEMH) + (size_t)row * 1024, lane);
  }
}

DI void phase_norm(const Params& p, int L, int c) {
  const int tid = otid(), w = tid >> 6, lane = tid & 63;
  const bool rw = L & 1;
  const float* xs = (L == 0) ? p.x : p.out;
  u16* H = (u16*)(p.ws + OFF_H);
  for (int lr = blockIdx.x * 4 + w; lr < TC; lr += gridDim.x * 4) {
    int gt = gtok(rw, c, lr);
    rms_row_bf16(xs + (size_t)gt * 1024, p.norm_g + L * 1024, H + (size_t)lr * 1024, lane);
  }
}

DI void phase_final_norm(const Params& p, bool dry) {
  const int tid = otid(), w = tid >> 6, lane = tid & 63;
  for (int row = blockIdx.x * 4 + w; row < 32768; row += gridDim.x * 4) {
    float* xr = p.out + (size_t)row * 1024;
    float4 v[4]; float ss = 0.f;
#pragma unroll
    for (int i = 0; i < 4; ++i) { v[i] = *(const float4*)(xr + i * 256 + lane * 4); ss += v[i].x * v[i].x + v[i].y * v[i].y + v[i].z * v[i].z + v[i].w * v[i].w; }
    ss = wave_sum(ss);
    float rs = rsqrtf(ss * (1.f / 1024.f) + 1e-6f);
#pragma unroll
    for (int i = 0; i < 4; ++i) {
      float4 gg = *(const float4*)(p.final_g + i * 256 + lane * 4);
      float4 o; o.x = v[i].x * rs * gg.x; o.y = v[i].y * rs * gg.y; o.z = v[i].z * rs * gg.z; o.w = v[i].w * rs * gg.w;
      if (!dry) *(float4*)(xr + i * 256 + lane * 4) = o;
    }
  }
}

template <int TJ, bool SWAP, int NK, class Epi>
DI void gemm_phase(const u16* __restrict__ A, size_t strideAz, int lda, const u16* __restrict__ Bt, size_t strideBz, int ldb,
                   int Z, int Mt, int Nt, int GM, int K, char* smem, const Epi& epi, int vt) {
  constexpr int BN = 64 * TJ;
  constexpr int NB = BN / 32;
  const int tid = otid(), w = tid >> 6, lane = tid & 63, r = lane & 31, h = lane >> 5;
  const int wm = w >> 1, wn = w & 1;
  u16* As = (u16*)smem;
  u16* Bs = As + 2 * 256 * 72;
  const int G = gridDim.x, per = Mt * Nt, total = Z * per;
  const int lrow = tid >> 3, lcc = (tid & 7) * 8;
  unsigned aoff[8], boff[NB];
#pragma unroll
  for (int i = 0; i < 8; ++i) aoff[i] = (unsigned)((lrow + 32 * i) * lda + lcc);
#pragma unroll
  for (int i = 0; i < NB; ++i) boff[i] = (unsigned)((lrow + 32 * i) * ldb + lcc);
  const int lds_st = lrow * 72 + lcc;
  for (int base = 0; base < total; base += G) {
    const int q = base + vt;
    if (q >= total) continue;
    const int z = q / per, qq = q - z * per;
    const int grp = qq / (GM * Nt), within = qq - grp * GM * Nt;
    const int mt = grp * GM + (within % GM), nt = within / GM;
    const u16* Ag = A + z * strideAz + (size_t)(mt * 256) * lda;
    const u16* Bg = Bt + z * strideBz + (size_t)(nt * BN) * ldb;
    u32x4 ra[2][8], rb[2][NB];
    f32x16 acc[4][TJ];
#pragma unroll
    for (int i = 0; i < 4; ++i)
#pragma unroll
      for (int j = 0; j < TJ; ++j)
#pragma unroll
        for (int e = 0; e < 16; ++e) acc[i][j][e] = 0.f;
    __syncthreads();
#pragma unroll
    for (int i = 0; i < 8; ++i) ra[0][i] = *(const u32x4*)(Ag + aoff[i]);
#pragma unroll
    for (int i = 0; i < NB; ++i) rb[0][i] = *(const u32x4*)(Bg + boff[i]);
#pragma unroll
    for (int i = 0; i < 8; ++i) ra[1][i] = *(const u32x4*)(Ag + 64 + aoff[i]);
#pragma unroll
    for (int i = 0; i < NB; ++i) rb[1][i] = *(const u32x4*)(Bg + 64 + boff[i]);
#pragma unroll
    for (int i = 0; i < 8; ++i) *(u32x4*)(As + lds_st + (32 * i) * 72) = ra[0][i];
#pragma unroll
    for (int i = 0; i < NB; ++i) *(u32x4*)(Bs + lds_st + (32 * i) * 72) = rb[0][i];
    __syncthreads();
#pragma unroll
    for (int kt = 0; kt < NK; ++kt) {
      constexpr int dummy = 0; (void)dummy;
      const int u = kt & 1;
      if (kt + 2 < NK) {
        const u16* ag = Ag + (kt + 2) * 64; const u16* bg = Bg + (kt + 2) * 64;
#pragma unroll
        for (int i = 0; i < 8; ++i) ra[u][i] = *(const u32x4*)(ag + aoff[i]);
#pragma unroll
        for (int i = 0; i < NB; ++i) rb[u][i] = *(const u32x4*)(bg + boff[i]);
      }
      const u16* as = As + u * 256 * 72 + (128 * wm + r) * 72 + 8 * h;
      const u16* bs = Bs + u * BN * 72 + (32 * TJ * wn + r) * 72 + 8 * h;
      bf16x8 af[2][4], bfr[2][TJ];
#pragma unroll
      for (int i = 0; i < 4; ++i) af[0][i] = *(const bf16x8*)(as + (32 * i) * 72);
#pragma unroll
      for (int j = 0; j < TJ; ++j) bfr[0][j] = *(const bf16x8*)(bs + (32 * j) * 72);
#pragma unroll
      for (int ks = 0; ks < 4; ++ks) {
        if (ks < 3) {
#pragma unroll
          for (int i = 0; i < 4; ++i) af[(ks + 1) & 1][i] = *(const bf16x8*)(as + (32 * i) * 72 + 16 * (ks + 1));
#pragma unroll
          for (int j = 0; j < TJ; ++j) bfr[(ks + 1) & 1][j] = *(const bf16x8*)(bs + (32 * j) * 72 + 16 * (ks + 1));
        }
        __builtin_amdgcn_sched_barrier(0);
#pragma unroll
        for (int i = 0; i < 4; ++i)
#pragma unroll
          for (int j = 0; j < TJ; ++j)
            acc[i][j] = SWAP ? MFMA32(bfr[ks & 1][j], af[ks & 1][i], acc[i][j]) : MFMA32(af[ks & 1][i], bfr[ks & 1][j], acc[i][j]);
        if (ks == 0 && kt + 1 < NK) {
          u16* ad = As + (u ^ 1) * 256 * 72 + lds_st; u16* bd = Bs + (u ^ 1) * BN * 72 + lds_st;
#pragma unroll
          for (int i = 0; i < 8; ++i) *(u32x4*)(ad + (32 * i) * 72) = ra[u ^ 1][i];
#pragma unroll
          for (int i = 0; i < NB; ++i) *(u32x4*)(bd + (32 * i) * 72) = rb[u ^ 1][i];
#pragma unroll
          for (int i = 0; i < 6; ++i) { __builtin_amdgcn_sched_group_barrier(0x008, 1, 0); __builtin_amdgcn_sched_group_barrier(0x200, 2, 0); }
        }
        __builtin_amdgcn_sched_barrier(0);
      }
      __syncthreads();
    }
#pragma unroll
    for (int i = 0; i < 4; ++i)
#pragma unroll
      for (int j = 0; j < TJ; ++j) {
        if (SWAP) epi(z, mt * 256 + 128 * wm + 32 * i + r, nt * BN + 32 * TJ * wn + 32 * j, h, acc[i][j]);
        else epi(z, mt * 256 + 128 * wm + 32 * i, nt * BN + 32 * TJ * wn + 32 * j + r, h, acc[i][j]);
      }
  }
}

struct EpiStoreBf16 {
  u16* C; int ldc; int ncols; bool dry;
  DI void operator()(int z, int row, int colbase, int h, const f32x16& a) const {
    if (dry) return;
#pragma unroll
    for (int g = 0; g < 4; ++g) {
      const int col = colbase + 8 * g + 4 * h;
      if (col < ncols) {
        u32x2 pk = {pack2(a[4 * g], a[4 * g + 1]), pack2(a[4 * g + 2], a[4 * g + 3])};
        *(u32x2*)(C + (size_t)row * ldc + col) = pk;
      }
    }
  }
};
struct EpiResid {
  const float* xin; float* xout; bool rw; int c; bool dry;
  DI void operator()(int z, int row, int colbase, int h, const f32x16& a) const {
    if (dry) return;
    const size_t o = (size_t)gtok(rw, c, row) * 1024 + colbase + 4 * h;
#pragma unroll
    for (int g = 0; g < 4; ++g) {
      float4 v = *(const float4*)(xin + o + 8 * g);
      v.x += a[4 * g]; v.y += a[4 * g + 1]; v.z += a[4 * g + 2]; v.w += a[4 * g + 3];
      *(float4*)(xout + o + 8 * g) = v;
    }
  }
};
struct EpiUQ {
  u16* Q; const float* cs; const float* sn; int c; bool dry;
  DI void operator()(int z, int row, int colbase, int h, const f32x16& a) const {
    if (dry) return;
    const int head = colbase / 192, db = colbase - head * 192;
    const int lb = row >> 13, s = row & 8191;
    u16* qp = Q + ((size_t)(lb * 12 + head) * 8192 + s) * 192 + db + 4 * h;
    const size_t ti = (size_t)(c * 16384 + row) * 32;
#pragma unroll
    for (int g = 0; g < 4; ++g) {
      float v0 = a[4 * g], v1 = a[4 * g + 1], v2 = a[4 * g + 2], v3 = a[4 * g + 3];
      if (db >= 128) {
        const int pi = (db - 128 + 8 * g + 4 * h) >> 1;
        const float2 cc = *(const float2*)(cs + ti + pi), ss = *(const float2*)(sn + ti + pi);
        const float o0 = v0 * cc.x - v1 * ss.x, o1 = v0 * ss.x + v1 * cc.x;
        const float o2 = v2 * cc.y - v3 * ss.y, o3 = v2 * ss.y + v3 * cc.y;
        v0 = o0; v1 = o1; v2 = o2; v3 = o3;
      }
      u32x2 pk = {pack2(v0, v1), pack2(v2, v3)};
      *(u32x2*)(qp + 8 * g) = pk;
    }
  }
};
struct EpiUK {
  u16* Kb; bool dry;
  DI void operator()(int z, int row, int colbase, int h, const f32x16& a) const {
    if (dry) return;
    const int head = colbase >> 7, db = colbase & 127;
    const int lb = row >> 13, s = row & 8191;
    u16* kp = Kb + ((size_t)(lb * 12 + head) * 8192 + s) * 192 + db + 4 * h;
#pragma unroll
    for (int g = 0; g < 4; ++g) {
      u32x2 pk = {pack2(a[4 * g], a[4 * g + 1]), pack2(a[4 * g + 2], a[4 * g + 3])};
      *(u32x2*)(kp + 8 * g) = pk;
    }
  }
};
struct EpiUV {
  u16* Vt; bool dry;
  DI void operator()(int z, int rowbase, int col, int h, const f32x16& a) const {
    if (dry) return;
    const int head = col >> 7, d = col & 127;
#pragma unroll
    for (int g = 0; g < 4; ++g) {
      int lr = rowbase + 8 * g + 4 * h; int lb = lr >> 13, s = lr & 8191;
      u32x2 pk = {pack2(a[4 * g], a[4 * g + 1]), pack2(a[4 * g + 2], a[4 * g + 3])};
      *(u32x2*)(Vt + (((size_t)(lb * 12 + head) * 128 + (s >> 6)) * 128 + d) * 64 + (s & 63)) = pk;
    }
  }
};
struct EpiMemKV {
  u16* MK; u16* MVt; bool dry;
  DI void operator()(int z, int rowbase, int col, int h, const f32x16& a) const {
    if (col < 512) {
      const int xh = col >> 7, d = col & 127;
#pragma unroll
      for (int e = 0; e < 16; ++e) {
        int m = rowbase + crow(e, h); int b = m >> 8, mi = m & 255;
        MK[((size_t)((z * 4 + b) * 4 + xh) * 256 + mi) * 128 + d] = f2bf(a[e]);
      }
    } else {
      const int n = col - 512, xh = n >> 7, d = n & 127;
#pragma unroll
      for (int g = 0; g < 4; ++g) {
        int m = rowbase + 8 * g + 4 * h; int b = m >> 8, mi = m & 255;
        uint2 pk; pk.x = pack2(a[4 * g], a[4 * g + 1]); pk.y = pack2(a[4 * g + 2], a[4 * g + 3]);
        *(uint2*)(MVt + (((size_t)((z * 4 + b) * 4 + xh) * 4 + (mi >> 6)) * 128 + d) * 64 + (mi & 63)) = pk;
      }
    }
  }
};

DI void phase_kvprep(const Params& p, int L, int c, bool dry) {
  const int tid = otid(), w = tid >> 6, lane = tid & 63;
  const int j = L >> 1;
  u16* U = (u16*)(p.ws + OFF_U); u16* Kb = (u16*)(p.ws + OFF_K);
  const float* cs = (const float*)(p.ws + OFF_COS); const float* sn = (const float*)(p.ws + OFF_SIN);
  for (int lr = blockIdx.x * 4 + w; lr < TC; lr += gridDim.x * 4) {
    u16* row = U + (size_t)lr * LDU_M;
    float fq[8], fk[8]; float sq = 0.f, sk = 0.f;
    if (lane < 48) { uint4 v = *(const uint4*)(row + M_CQ + lane * 8); unpack8(v, fq);
#pragma unroll
      for (int e = 0; e < 8; ++e) sq += fq[e] * fq[e]; }
    if (lane < 32) { uint4 v = *(const uint4*)(row + M_CKV + lane * 8); unpack8(v, fk);
#pragma unroll
      for (int e = 0; e < 8; ++e) sk += fk[e] * fk[e]; }
    sq = wave_sum(sq); sk = wave_sum(sk);
    float rq = rsqrtf(sq * (1.f / 384.f) + 1e-6f), rk = rsqrtf(sk * (1.f / 256.f) + 1e-6f);
    if (dry) continue;
    if (lane < 48) {
      const float* g = p.q_norm_g + j * 384 + lane * 8;
#pragma unroll
      for (int e = 0; e < 8; ++e) fq[e] = fq[e] * rq * g[e];
      *(uint4*)(row + M_CQ + lane * 8) = pack8(fq);
    }
    if (lane < 32) {
      const float* g = p.kv_norm_g + j * 256 + lane * 8;
#pragma unroll
      for (int e = 0; e < 8; ++e) fk[e] = fk[e] * rk * g[e];
      *(uint4*)(row + M_CKV + lane * 8) = pack8(fk);
    }
    if (lane < 8) {
      float f[8], o[8]; uint4 v = *(const uint4*)(row + M_KR + lane * 8); unpack8(v, f);
      int gt = c * 16384 + lr;
#pragma unroll
      for (int i = 0; i < 4; ++i) {
        float cc = cs[gt * 32 + lane * 4 + i], ss = sn[gt * 32 + lane * 4 + i];
        o[2 * i] = f[2 * i] * cc - f[2 * i + 1] * ss; o[2 * i + 1] = f[2 * i] * ss + f[2 * i + 1] * cc;
      }
      uint4 pk = pack8(o);
      int lb = lr >> 13, s = lr & 8191;
#pragma unroll
      for (int hd = 0; hd < 12; ++hd) *(uint4*)(Kb + ((size_t)(lb * 12 + hd) * 8192 + s) * 192 + 128 + lane * 8) = pk;
    }
  }
}

template <int DQK>
DI void attn_item(const u16* __restrict__ Qp, int ldq, const u16* __restrict__ Kp, const u16* __restrict__ Vtp, int ldv,
                  int nkt, int q0, bool causal, float c, u16* Yp, int ldy, char* smem, bool dry) {
  constexpr int KLD = DQK + 8;
  constexpr int NKC = DQK * 64 / 8 / 256;
  constexpr int NKS = DQK / 16;
  constexpr int CPR = DQK / 8;
  constexpr int BUFE = 64 * KLD + 128 * 72;
  u16* L0 = (u16*)smem;
  const int tid = otid(), w = tid >> 6, lane = tid & 63, r = lane & 31, h = lane >> 5;
  bf16x8 qf[NKS];
  {
    const u16* qrow = Qp + (size_t)(32 * w + r) * ldq + 8 * h;
#pragma unroll
    for (int ks = 0; ks < NKS; ++ks) qf[ks] = *(const bf16x8*)(qrow + 16 * ks);
  }
  f32x16 o[4];
#pragma unroll
  for (int dt = 0; dt < 4; ++dt)
#pragma unroll
    for (int e = 0; e < 16; ++e) o[dt][e] = 0.f;
  float m = -INFINITY, l = 0.f;
  u32x4 kst[NKC], vst[4];
  const int vd = tid >> 3, vc8 = tid & 7;
  int kso[NKC];
#pragma unroll
  for (int i = 0; i < NKC; ++i) { int id = tid + 256 * i; int row = id / CPR, cc = id - row * CPR; kso[i] = row * KLD + cc * 8; }
  const int vso = 64 * KLD + vd * 72 + 16 * (vc8 >> 1) + 4 * (vc8 & 1);
  __syncthreads();
#pragma unroll
  for (int i = 0; i < NKC; ++i) kst[i] = *(const u32x4*)(Kp + (size_t)(tid + 256 * i) * 8);
#pragma unroll
  for (int i = 0; i < 4; ++i) vst[i] = *(const u32x4*)(Vtp + (size_t)(tid + 256 * i) * 8);
#pragma unroll
  for (int i = 0; i < NKC; ++i) *(u32x4*)(L0 + kso[i]) = kst[i];
#pragma unroll
  for (int i = 0; i < 4; ++i) {
    u16* dst = L0 + vso + (32 * i) * 72;
    u32x2 lo = {vst[i].x, vst[i].y}, hi = {vst[i].z, vst[i].w};
    *(u32x2*)dst = lo; *(u32x2*)(dst + 8) = hi;
  }
  if (nkt > 1) {
    const u16* kg = Kp + (size_t)64 * DQK;
#pragma unroll
    for (int i = 0; i < NKC; ++i) kst[i] = *(const u32x4*)(kg + (size_t)(tid + 256 * i) * 8);
#pragma unroll
    for (int i = 0; i < 4; ++i) vst[i] = *(const u32x4*)(Vtp + 8192 + (size_t)(tid + 256 * i) * 8);
  }
  __syncthreads();
  const int qmin = q0 + 32 * w;
  for (int kt = 0; kt < nkt; ++kt) {
    const u16* Ks = L0 + (kt & 1) * BUFE;
    const u16* Vs = Ks + 64 * KLD;
    u16* Ln = L0 + ((kt + 1) & 1) * BUFE;
    const bool active = !(causal && kt * 64 > qmin + 31);
    f32x16 s0, s1;
#pragma unroll
    for (int e = 0; e < 16; ++e) { s0[e] = 0.f; s1[e] = 0.f; }
    const u16* k0 = Ks + r * KLD + 8 * h;
    bf16x8 ka[2][2];
    if (active) {
      ka[0][0] = *(const bf16x8*)(k0); ka[0][1] = *(const bf16x8*)(k0 + 32 * KLD);
      ka[1][0] = *(const bf16x8*)(k0 + 16); ka[1][1] = *(const bf16x8*)(k0 + 32 * KLD + 16);
      __builtin_amdgcn_sched_barrier(0);
      s0 = MFMA32(ka[0][0], qf[0], s0); s1 = MFMA32(ka[0][1], qf[0], s1);
    }
    if (kt + 1 < nkt) {
#pragma unroll
      for (int i = 0; i < NKC; ++i) *(u32x4*)(Ln + kso[i]) = kst[i];
#pragma unroll
      for (int i = 0; i < 4; ++i) {
        u16* dst = Ln + vso + (32 * i) * 72;
        u32x2 lo = {vst[i].x, vst[i].y}, hi = {vst[i].z, vst[i].w};
        *(u32x2*)dst = lo; *(u32x2*)(dst + 8) = hi;
      }
    }
    if (kt + 2 < nkt) {
      const u16* kg = Kp + (size_t)(kt + 2) * 64 * DQK;
#pragma unroll
      for (int i = 0; i < NKC; ++i) kst[i] = *(const u32x4*)(kg + (size_t)(tid + 256 * i) * 8);
#pragma unroll
      for (int i = 0; i < 4; ++i) vst[i] = *(const u32x4*)(Vtp + (size_t)(kt + 2) * 8192 + (size_t)(tid + 256 * i) * 8);
    }
    if (active) {
      __builtin_amdgcn_sched_barrier(0);
#pragma unroll
      for (int ks = 1; ks < NKS; ++ks) {
        if (ks + 1 < NKS) {
          ka[(ks + 1) & 1][0] = *(const bf16x8*)(k0 + 16 * (ks + 1));
          ka[(ks + 1) & 1][1] = *(const bf16x8*)(k0 + 32 * KLD + 16 * (ks + 1));
        }
        __builtin_amdgcn_sched_barrier(0);
        s0 = MFMA32(ka[ks & 1][0], qf[ks], s0); s1 = MFMA32(ka[ks & 1][1], qf[ks], s1);
        __builtin_amdgcn_sched_barrier(0);
      }
      const u16* v0 = Vs + r * 72 + 8 * h;
      bf16x8 va[2][4];
#pragma unroll
      for (int dt = 0; dt < 4; ++dt) va[0][dt] = *(const bf16x8*)(v0 + (32 * dt) * 72);
      if (causal && kt * 64 + 63 > qmin) {
        const int qi = qmin + r;
#pragma unroll
        for (int e = 0; e < 16; ++e) {
          int key = kt * 64 + crow(e, h);
          if (key > qi) s0[e] = -INFINITY;
          if (key + 32 > qi) s1[e] = -INFINITY;
        }
      }
      float mx = fmaxf(s0[0], s1[0]);
#pragma unroll
      for (int e = 1; e < 16; ++e) mx = fmaxf(mx, fmaxf(s0[e], s1[e]));
      mx = fmaxf(mx, __shfl_xor(mx, 32));
      if (__builtin_amdgcn_ballot_w64((mx - m) * c > 8.f) != 0ull) {
        const float mn = fmaxf(m, mx);
        const float alpha = ex2((m - mn) * c);
        m = mn;
        l *= alpha;
#pragma unroll
        for (int dt = 0; dt < 4; ++dt)
#pragma unroll
          for (int e = 0; e < 16; ++e) o[dt][e] *= alpha;
      }
      const float mc = m * c;
      float ps = 0.f;
#pragma unroll
      for (int e = 0; e < 16; ++e) { s0[e] = ex2(fmaf(s0[e], c, -mc)); s1[e] = ex2(fmaf(s1[e], c, -mc)); ps += s0[e] + s1[e]; }
      l += ps;
      bf16x8 pf[4];
      {
        u32x4 t;
        t.x = pack2(s0[0], s0[1]); t.y = pack2(s0[2], s0[3]); t.z = pack2(s0[4], s0[5]); t.w = pack2(s0[6], s0[7]); pf[0] = __builtin_bit_cast(bf16x8, t);
        t.x = pack2(s0[8], s0[9]); t.y = pack2(s0[10], s0[11]); t.z = pack2(s0[12], s0[13]); t.w = pack2(s0[14], s0[15]); pf[1] = __builtin_bit_cast(bf16x8, t);
        t.x = pack2(s1[0], s1[1]); t.y = pack2(s1[2], s1[3]); t.z = pack2(s1[4], s1[5]); t.w = pack2(s1[6], s1[7]); pf[2] = __builtin_bit_cast(bf16x8, t);
        t.x = pack2(s1[8], s1[9]); t.y = pack2(s1[10], s1[11]); t.z = pack2(s1[12], s1[13]); t.w = pack2(s1[14], s1[15]); pf[3] = __builtin_bit_cast(bf16x8, t);
      }
#pragma unroll
      for (int kk = 0; kk < 4; ++kk) {
        if (kk < 3) {
#pragma unroll
          for (int dt = 0; dt < 4; ++dt) va[(kk + 1) & 1][dt] = *(const bf16x8*)(v0 + (32 * dt) * 72 + 16 * (kk + 1));
        }
        __builtin_amdgcn_sched_barrier(0);
#pragma unroll
        for (int dt = 0; dt < 4; ++dt) o[dt] = MFMA32(va[kk & 1][dt], pf[kk], o[dt]);
        __builtin_amdgcn_sched_barrier(0);
      }
    }
    __syncthreads();
  }
  const float lt = l + __shfl_xor(l, 32);
  const float inv = 1.f / lt;
  if (dry) return;
  u16* yrow = Yp + (size_t)(32 * w + r) * ldy;
#pragma unroll
  for (int dt = 0; dt < 4; ++dt)
#pragma unroll
    for (int g = 0; g < 4; ++g) {
      const int d = 32 * dt + 8 * g + 4 * h;
      uint2 gv = *(const uint2*)(yrow + d);
      float g0 = bf2f(gv.x & 0xffffu), g1 = bf2f(gv.x >> 16), g2 = bf2f(gv.y & 0xffffu), g3 = bf2f(gv.y >> 16);
      uint2 ov;
      ov.x = pack2(o[dt][4 * g] * inv * silu(g0), o[dt][4 * g + 1] * inv * silu(g1));
      ov.y = pack2(o[dt][4 * g + 2] * inv * silu(g2), o[dt][4 * g + 3] * inv * silu(g3));
      *(uint2*)(yrow + d) = ov;
    }
}

template <int DQK>
DI void attn_item_c(const u16* __restrict__ Qp, int ldq, const u16* __restrict__ Kp, const u16* __restrict__ Vtp, int ldv,
                    int nkt, int q0, float c, u16* Yp, int ldy, char* smem, bool dry) {
  constexpr int KLD = DQK + 8;
  constexpr int NKC = DQK * 64 / 8 / 256;
  constexpr int NKS = DQK / 16;
  constexpr int CPR = DQK / 8;
  constexpr int BUFE = 64 * KLD + 128 * 72;
  u16* L0 = (u16*)smem;
  const int tid = otid(), w = tid >> 6, lane = tid & 63, r = lane & 31, h = lane >> 5;
  bf16x8 qf[NKS];
  {
    const u16* qrow = Qp + (size_t)(32 * w + r) * ldq + 8 * h;
#pragma unroll
    for (int ks = 0; ks < NKS; ++ks) qf[ks] = *(const bf16x8*)(qrow + 16 * ks);
  }
  f32x16 o[4];
#pragma unroll
  for (int dt = 0; dt < 4; ++dt)
#pragma unroll
    for (int e = 0; e < 16; ++e) o[dt][e] = 0.f;
  float m = -INFINITY, l = 0.f;
  u32x4 kstA[NKC], vstA[4], kstB[NKC], vstB[4];
  const int vd = tid >> 3, vc8 = tid & 7;
  int kso[NKC];
#pragma unroll
  for (int i = 0; i < NKC; ++i) { int id = tid + 256 * i; int row = id / CPR, cc = id - row * CPR; kso[i] = row * KLD + cc * 8; }
  const int vso = 64 * KLD + vd * 72 + 16 * (vc8 >> 1) + 4 * (vc8 & 1);
  const int nktp = (nkt + 3) & ~3;
  auto gload = [&](u32x4* ks_, u32x4* vs_, int j) {
    const u16* kg = Kp + (size_t)(j + 1) * 64 * DQK;
#pragma unroll
    for (int i = 0; i < NKC; ++i) ks_[i] = *(const u32x4*)(kg + (size_t)(tid + 256 * i) * 8);
#pragma unroll
    for (int i = 0; i < 4; ++i) vs_[i] = *(const u32x4*)(Vtp + (size_t)j * 8192 + (size_t)(tid + 256 * i) * 8);
  };
  auto lstore = [&](const u32x4* ks_, const u32x4* vs_, u16* Lb) {
#pragma unroll
    for (int i = 0; i < NKC; ++i) *(u32x4*)(Lb + kso[i]) = ks_[i];
#pragma unroll
    for (int i = 0; i < 4; ++i) {
      u16* dst = Lb + vso + (32 * i) * 72;
      u32x2 lo = {vs_[i].x, vs_[i].y}, hi = {vs_[i].z, vs_[i].w};
      *(u32x2*)dst = lo; *(u32x2*)(dst + 8) = hi;
    }
  };
  __syncthreads();
  gload(kstA, vstA, 0);
  gload(kstB, vstB, 1);
  f32x16 sa0, sa1, sb0, sb1;
#pragma unroll
  for (int e = 0; e < 16; ++e) { sa0[e] = 0.f; sa1[e] = 0.f; }
  {
    const u16* kr = Kp + (size_t)r * DQK + 8 * h;
#pragma unroll
    for (int ks = 0; ks < NKS; ++ks) {
      bf16x8 a0 = *(const bf16x8*)(kr + 16 * ks), a1 = *(const bf16x8*)(kr + 32 * DQK + 16 * ks);
      sa0 = MFMA32(a0, qf[ks], sa0); sa1 = MFMA32(a1, qf[ks], sa1);
    }
  }
  lstore(kstA, vstA, L0);
  gload(kstA, vstA, 2);
  __syncthreads();
  const int qmin = q0 + 32 * w;
  const int qi = qmin + r;
  auto body = [&](int kt, u32x4* wk, u32x4* wv, f32x16& s0, f32x16& s1, f32x16& n0, f32x16& n1) {
    const u16* Ks = L0 + (kt & 1) * BUFE;
    const u16* Vs = Ks + 64 * KLD;
    u16* Ln = L0 + ((kt + 1) & 1) * BUFE;
    const bool active = !(kt * 64 > qmin + 31);
    if (kt * 64 + 63 > qmin) {
#pragma unroll
      for (int e = 0; e < 16; ++e) {
        int key = kt * 64 + crow(e, h);
        if (key > qi) s0[e] = -INFINITY;
        if (key + 32 > qi) s1[e] = -INFINITY;
      }
    }
    float mx = fmaxf(s0[0], s1[0]);
#pragma unroll
    for (int e = 1; e < 16; ++e) mx = fmaxf(mx, fmaxf(s0[e], s1[e]));
    mx = fmaxf(mx, __shfl_xor(mx, 32));
    if (__builtin_amdgcn_ballot_w64((mx - m) * c > 8.f) != 0ull) {
      const float mn = fmaxf(m, mx);
      const float alpha = ex2((m - mn) * c);
      m = mn;
      l *= alpha;
#pragma unroll
      for (int dt = 0; dt < 4; ++dt)
#pragma unroll
        for (int e = 0; e < 16; ++e) o[dt][e] *= alpha;
    }
    const float mc = m * c;
#pragma unroll
    for (int e = 0; e < 16; ++e) { n0[e] = 0.f; n1[e] = 0.f; }
    const u16* k0 = Ks + r * KLD + 8 * h;
    bf16x8 ka[2][2];
    ka[0][0] = *(const bf16x8*)(k0); ka[0][1] = *(const bf16x8*)(k0 + 32 * KLD);
    bf16x8 pf[4];
    u32x4 pk[4];
    float ps = 0.f;
#pragma unroll
    for (int ks = 0; ks < NKS; ++ks) {
      if (ks + 1 < NKS) {
        ka[(ks + 1) & 1][0] = *(const bf16x8*)(k0 + 16 * (ks + 1));
        ka[(ks + 1) & 1][1] = *(const bf16x8*)(k0 + 32 * KLD + 16 * (ks + 1));
      }
      __builtin_amdgcn_sched_barrier(0);
      n0 = MFMA32(ka[ks & 1][0], qf[ks], n0); n1 = MFMA32(ka[ks & 1][1], qf[ks], n1);
      if (ks < 8) {
#pragma unroll
        for (int e4 = 0; e4 < 4; ++e4) {
          const int e = (4 * ks + e4) & 15;
          if (ks < 4) { s0[e] = ex2(fmaf(s0[e], c, -mc)); ps += s0[e]; }
          else        { s1[e] = ex2(fmaf(s1[e], c, -mc)); ps += s1[e]; }
        }
      }
      if (ks == 1) {
        lstore(wk, wv, Ln);
        gload(wk, wv, kt + 3);
      }
      if (ks == 4)  { pk[0].x = pack2(s0[0], s0[1]);  pk[0].y = pack2(s0[2], s0[3]);   pk[0].z = pack2(s0[4], s0[5]);   pk[0].w = pack2(s0[6], s0[7]); }
      if (ks == 5)  { pk[1].x = pack2(s0[8], s0[9]);  pk[1].y = pack2(s0[10], s0[11]); pk[1].z = pack2(s0[12], s0[13]); pk[1].w = pack2(s0[14], s0[15]); }
      if (ks == 8)  { pk[2].x = pack2(s1[0], s1[1]);  pk[2].y = pack2(s1[2], s1[3]);   pk[2].z = pack2(s1[4], s1[5]);   pk[2].w = pack2(s1[6], s1[7]); }
      if (ks == 9)  { pk[3].x = pack2(s1[8], s1[9]);  pk[3].y = pack2(s1[10], s1[11]); pk[3].z = pack2(s1[12], s1[13]); pk[3].w = pack2(s1[14], s1[15]); }
      __builtin_amdgcn_sched_barrier(0);
    }
    l += ps;
#pragma unroll
    for (int i = 0; i < 4; ++i) pf[i] = __builtin_bit_cast(bf16x8, pk[i]);
    if (active) {
      const u16* v0 = Vs + r * 72 + 8 * h;
      bf16x8 va[2][4];
#pragma unroll
      for (int dt = 0; dt < 4; ++dt) va[0][dt] = *(const bf16x8*)(v0 + (32 * dt) * 72);
#pragma unroll
      for (int kk = 0; kk < 4; ++kk) {
        if (kk < 3) {
#pragma unroll
          for (int dt = 0; dt < 4; ++dt) va[(kk + 1) & 1][dt] = *(const bf16x8*)(v0 + (32 * dt) * 72 + 16 * (kk + 1));
        }
        __builtin_amdgcn_sched_barrier(0);
#pragma unroll
        for (int dt = 0; dt < 4; ++dt) o[dt] = MFMA32(va[kk & 1][dt], pf[kk], o[dt]);
        __builtin_amdgcn_sched_barrier(0);
      }
    }
    __syncthreads();
  };
  for (int kt4 = 0; kt4 < nktp; kt4 += 4) {
    body(kt4 + 0, kstB, vstB, sa0, sa1, sb0, sb1); body(kt4 + 1, kstA, vstA, sb0, sb1, sa0, sa1);
    body(kt4 + 2, kstB, vstB, sa0, sa1, sb0, sb1); body(kt4 + 3, kstA, vstA, sb0, sb1, sa0, sa1);
  }
  const float lt = l + __shfl_xor(l, 32);
  const float inv = 1.f / lt;
  if (dry) return;
  u16* yrow = Yp + (size_t)(32 * w + r) * ldy;
#pragma unroll
  for (int dt = 0; dt < 4; ++dt)
#pragma unroll
    for (int g = 0; g < 4; ++g) {
      const int d = 32 * dt + 8 * g + 4 * h;
      uint2 gv = *(const uint2*)(yrow + d);
      float g0 = bf2f(gv.x & 0xffffu), g1 = bf2f(gv.x >> 16), g2 = bf2f(gv.y & 0xffffu), g3 = bf2f(gv.y >> 16);
      uint2 ov;
      ov.x = pack2(o[dt][4 * g] * inv * silu(g0), o[dt][4 * g + 1] * inv * silu(g1));
      ov.y = pack2(o[dt][4 * g + 2] * inv * silu(g2), o[dt][4 * g + 3] * inv * silu(g3));
      *(uint2*)(yrow + d) = ov;
    }
}

DI void memattn_item(const Params& p, int L, int c, int item, char* smem, bool dry) {
  const bool rw = L & 1;
  const int ldu = rw ? LDU_R : LDU_M, oq = rw ? R_QM : M_QM, og = rw ? R_GATE : M_GATE;
  const int tile = item >> 2, xh = item & 3;
  const int b = gtok(rw, c, tile * 128) >> 13;
  u16* U = (u16*)(p.ws + OFF_U);
  const u16* MK = (const u16*)(p.ws + OFF_MEMK) + (size_t)((L * 4 + b) * 4 + xh) * 256 * 128;
  const u16* MV = (const u16*)(p.ws + OFF_MEMVT) + (size_t)((L * 4 + b) * 4 + xh) * 128 * 256;
  attn_item<128>(U + (size_t)tile * 128 * ldu + oq + xh * 128, ldu, MK, MV, 256, 4, 0, false,
                 0.08838834764831845f * 1.4426950408889634f, U + (size_t)tile * 128 * ldu + og + 1536 + xh * 128, ldu, smem, dry);
}

DI void phase_attn(const Params& p, int L, int c, char* smem, int* s_item, bool dry) {
  int* cnt = (int*)(p.ws + OFF_CNT) + 64 + ((L * 2 + c) * 2 + (dry ? 1 : 0)) * 16;
  u16* U = (u16*)(p.ws + OFF_U);
  const u16* Q = (const u16*)(p.ws + OFF_Q); const u16* Kb = (const u16*)(p.ws + OFF_K); const u16* Vt = (const u16*)(p.ws + OFF_VT);
  const int xcc = (int)(__builtin_amdgcn_s_getreg((3 << 11) | 20) & 7u);
  for (int k = 0; k < 8; ++k) {
    const int x = (xcc + k) & 7;
    for (;;) {
      __syncthreads();
      if (otid() == 0) *s_item = atomicAdd(cnt + x, 1);
      __syncthreads();
      const int item = *s_item;
      if (item >= 192) break;
      const int qt = 63 - (item & 63), bh = 3 * x + (item >> 6);
      const int lb = bh / 12, head = bh - lb * 12;
      const int q0 = qt * 128;
      attn_item_c<192>(Q + ((size_t)(lb * 12 + head) * 8192 + q0) * 192, 192, Kb + (size_t)(lb * 12 + head) * 8192 * 192,
                     Vt + (size_t)(lb * 12 + head) * 128 * 8192, 8192, 2 * (qt + 1), q0,
                     0.07216878364870323f * 1.4426950408889634f,
                     U + (size_t)(lb * 8192 + q0) * LDU_M + M_GATE + head * 128, LDU_M, smem, dry);
    }
  }
  for (;;) {
    __syncthreads();
    if (otid() == 0) *s_item = atomicAdd(cnt + 8, 1);
    __syncthreads();
    const int item = *s_item;
    if (item >= 512) break;
    memattn_item(p, L, c, item, smem, dry);
  }
}

DI void scan_item(const Params& p, int L, int c, int item, char* smem, bool dry) {
  const int tid = otid(), w = tid >> 6, lane = tid & 63, r = lane & 31, h = lane >> 5;
  const int j = L >> 1;
  const int b = item / 48, rem = item - b * 48, head = rem >> 1, half = rem & 1;
  float* PAb  = (float*)smem;
  float* Vstb = PAb + 2 * 10240;
  float* Ystb = Vstb + 3 * 1024;
  float* PRM  = Ystb + 2 * 1024;
  float* BONb = PRM + 10 * 64;
  u16* A1  = (u16*)(BONb + 96);
  u16* W2t = A1 + 2 * 32 * 72;
  float* LO  = (float*)(W2t + 2 * 64 * 72);
  const u16* U = (const u16*)(p.ws + OFF_U);
  const u16* BND = (const u16*)(p.ws + OFF_BND);
  u16* YR = (u16*)(p.ws + OFF_YR); u16* BV = (u16*)(p.ws + OFF_BV);
  float* ST = (float*)(p.ws + OFF_ST);
  float* STATE = (float*)(p.ws + OFF_STATE);
  __syncthreads();
  if (tid < 64) {
    const float* mu = p.mu + j * SHIFTW;
    const int hc = head * 64 + tid;
    PRM[0 * 64 + tid] = mu[R_R + hc]; PRM[1 * 64 + tid] = mu[R_K + hc]; PRM[2 * 64 + tid] = mu[R_WD + tid]; PRM[3 * 64 + tid] = mu[R_AD + tid];
    PRM[4 * 64 + tid] = p.w0[j * 1536 + hc]; PRM[5 * 64 + tid] = p.a0[j * 1536 + hc]; PRM[6 * 64 + tid] = p.k_k[j * 1536 + hc];
    PRM[7 * 64 + tid] = p.k_a[j * 1536 + hc]; PRM[8 * 64 + tid] = p.r_k[j * 1536 + hc];
    PRM[9 * 64 + tid] = (tid < 32) ? mu[R_V + head * 64 + 32 * half + tid] : 0.f;
  }
  for (int e = tid; e < 8192; e += 256) {
    int arr = e >> 12, jj = (e >> 6) & 63, cc = e & 63;
    const float* src = (arr ? p.a2 : p.w2) + (size_t)j * 64 * 1536;
    W2t[(arr * 64 + cc) * 72 + jj] = f2bf(src[jj * 1536 + head * 64 + cc]);
  }
  const int rowl = lane >> 3, ks = lane & 7, row32 = 8 * w + rowl;
  float S[8];
  {
    float* sp = STATE + ((size_t)((b * 24 + head) * 64 + 32 * half + row32)) * 64 + 8 * ks;
#pragma unroll
    for (int i = 0; i < 8; ++i) S[i] = (c == 0) ? 0.f : sp[i];
  }
  const int tt = tid >> 3, cs = tid & 7, c4 = cs & 3;
  uint4 Rr_c, Rr_p, Rk_c, Rk_p, Rw_c, Rw_p, Ra_c, Ra_p, Rv_c, Rv_p;
  const uint4 zero4 = {0u, 0u, 0u, 0u};
  auto load_raw = [&](int tc) {
    const int lr = b * 4096 + tc * 32 + tt;
    const int s = c * 4096 + tc * 32 + tt;
    const u16* cur = U + (size_t)lr * LDU_R;
    const u16* prv = (s == 0) ? (BND + (size_t)4 * SHIFTW) : ((s == 4096 && c == 1) ? (BND + (size_t)b * SHIFTW) : (cur - LDU_R));
    Rr_c = *(const uint4*)(cur + R_R + head * 64 + cs * 8);  Rr_p = *(const uint4*)(prv + R_R + head * 64 + cs * 8);
    Rk_c = *(const uint4*)(cur + R_K + head * 64 + cs * 8);  Rk_p = *(const uint4*)(prv + R_K + head * 64 + cs * 8);
    Rw_c = *(const uint4*)(cur + R_WD + cs * 8);             Rw_p = *(const uint4*)(prv + R_WD + cs * 8);
    Ra_c = *(const uint4*)(cur + R_AD + cs * 8);             Ra_p = *(const uint4*)(prv + R_AD + cs * 8);
    const int vo = R_V + head * 64 + 32 * half + c4 * 8;
    Rv_c = *(const uint4*)(cur + vo);                        Rv_p = *(const uint4*)(prv + vo);
  };
  uint4 d_y = zero4, d_v = zero4; float d_sm = 0.f, d_sq = 0.f; int d_lr = -1;
  auto flush_out = [&]() {
    if (cs < 4 && !dry && d_lr >= 0) {
      const size_t o = (size_t)d_lr * 1536 + head * 64 + 32 * half + cs * 8;
      *(uint4*)(YR + o) = d_y;
      *(uint4*)(BV + o) = d_v;
      if (cs == 0) {
        float* stp = ST + ((size_t)(d_lr * 24 + head) * 2 + half) * 2;
        stp[0] = d_sm; stp[1] = d_sq;
      }
    }
  };
  float rm[8], km[8];
  auto prep1 = [&](float* Vst) {
    float cu[8], pv[8], t8[8];
    unpack8(Rr_c, cu); unpack8(Rr_p, pv);
#pragma unroll
    for (int e = 0; e < 8; ++e) rm[e] = cu[e] + (pv[e] - cu[e]) * PRM[0 * 64 + cs * 8 + e];
    unpack8(Rk_c, cu); unpack8(Rk_p, pv);
#pragma unroll
    for (int e = 0; e < 8; ++e) km[e] = cu[e] + (pv[e] - cu[e]) * PRM[1 * 64 + cs * 8 + e];
    unpack8(Rw_c, cu); unpack8(Rw_p, pv);
#pragma unroll
    for (int e = 0; e < 8; ++e) {
      float xw = cu[e] + (pv[e] - cu[e]) * PRM[2 * 64 + cs * 8 + e];
      float ee = ex2(xw * 2.8853900817779268f);
      t8[e] = 1.f - 2.f * frcp(ee + 1.f);
    }
    *(uint4*)(A1 + (0 * 32 + tt) * 72 + cs * 8) = pack8(t8);
    unpack8(Ra_c, cu); unpack8(Ra_p, pv);
#pragma unroll
    for (int e = 0; e < 8; ++e) t8[e] = cu[e] + (pv[e] - cu[e]) * PRM[3 * 64 + cs * 8 + e];
    *(uint4*)(A1 + (1 * 32 + tt) * 72 + cs * 8) = pack8(t8);
    unpack8(Rv_c, cu); unpack8(Rv_p, pv);
    float v8[8];
#pragma unroll
    for (int e = 0; e < 8; ++e) v8[e] = cu[e] + (pv[e] - cu[e]) * PRM[9 * 64 + c4 * 8 + e];
    *(float4*)(Vst + tt * 32 + c4 * 8) = make_float4(v8[0], v8[1], v8[2], v8[3]);
    *(float4*)(Vst + tt * 32 + c4 * 8 + 4) = make_float4(v8[4], v8[5], v8[6], v8[7]);
  };
  auto prep3 = [&]() {
    const int arr = w >> 1, nt = w & 1;
    f32x16 acc;
#pragma unroll
    for (int e = 0; e < 16; ++e) acc[e] = 0.f;
#pragma unroll
    for (int k4 = 0; k4 < 4; ++k4) {
      bf16x8 a = *(const bf16x8*)(A1 + (arr * 32 + r) * 72 + 16 * k4 + 8 * h);
      bf16x8 bw = *(const bf16x8*)(W2t + (arr * 64 + 32 * nt + r) * 72 + 16 * k4 + 8 * h);
      acc = MFMA32(a, bw, acc);
    }
#pragma unroll
    for (int e = 0; e < 16; ++e) LO[(arr * 32 + crow(e, h)) * 64 + 32 * nt + r] = acc[e];
  };
  auto prep4 = [&](float* PA, float* BON) {
    float lw[8], la[8];
    {
      float4 t0 = *(const float4*)(LO + (0 * 32 + tt) * 64 + cs * 8), t1 = *(const float4*)(LO + (0 * 32 + tt) * 64 + cs * 8 + 4);
      lw[0] = t0.x; lw[1] = t0.y; lw[2] = t0.z; lw[3] = t0.w; lw[4] = t1.x; lw[5] = t1.y; lw[6] = t1.z; lw[7] = t1.w;
      t0 = *(const float4*)(LO + (1 * 32 + tt) * 64 + cs * 8); t1 = *(const float4*)(LO + (1 * 32 + tt) * 64 + cs * 8 + 4);
      la[0] = t0.x; la[1] = t0.y; la[2] = t0.z; la[3] = t0.w; la[4] = t1.x; la[5] = t1.y; la[6] = t1.z; la[7] = t1.w;
    }
    float dec[8], kk[8], av[8], kp[8];
    float ssq = 0.f, bon = 0.f;
#pragma unroll
    for (int e = 0; e < 8; ++e) {
      const int ch = cs * 8 + e;
      const float sg = frcp(1.f + fexp(-(lw[e] + PRM[4 * 64 + ch])));
      dec[e] = ex2(-0.8750340f * sg);
      float a = frcp(1.f + fexp(-(la[e] + PRM[5 * 64 + ch])));
      av[e] = a;
      kk[e] = km[e] * PRM[6 * 64 + ch];
      ssq += kk[e] * kk[e];
      kp[e] = km[e] * (1.f + (a - 1.f) * PRM[7 * 64 + ch]);
      bon += rm[e] * kp[e] * PRM[8 * 64 + ch];
    }
    ssq = red8(ssq); bon = red8(bon);
    const float inv = 1.f / fmaxf(sqrtf(ssq), 1e-12f);
    float nk[8], bb[8];
#pragma unroll
    for (int e = 0; e < 8; ++e) { float kn = kk[e] * inv; nk[e] = -kn; bb[e] = kn * av[e]; }
    float* pa = PA + tt * 320 + cs * 8;
    *(float4*)(pa) = make_float4(dec[0], dec[1], dec[2], dec[3]); *(float4*)(pa + 4) = make_float4(dec[4], dec[5], dec[6], dec[7]);
    *(float4*)(pa + 64) = make_float4(nk[0], nk[1], nk[2], nk[3]); *(float4*)(pa + 68) = make_float4(nk[4], nk[5], nk[6], nk[7]);
    *(float4*)(pa + 128) = make_float4(bb[0], bb[1], bb[2], bb[3]); *(float4*)(pa + 132) = make_float4(bb[4], bb[5], bb[6], bb[7]);
    *(float4*)(pa + 192) = make_float4(kp[0], kp[1], kp[2], kp[3]); *(float4*)(pa + 196) = make_float4(kp[4], kp[5], kp[6], kp[7]);
    *(float4*)(pa + 256) = make_float4(rm[0], rm[1], rm[2], rm[3]); *(float4*)(pa + 260) = make_float4(rm[4], rm[5], rm[6], rm[7]);
    BON[tt] = bon;
  };
  float4 d0, d1, n0, n1, b0, b1, k0, k1, r0, r1; float vv;
  auto step_load = [&](const float* PA, const float* Vst, int t) {
    const float* pa = PA + t * 320 + ks * 8;
    d0 = *(const float4*)(pa); d1 = *(const float4*)(pa + 4);
    n0 = *(const float4*)(pa + 64); n1 = *(const float4*)(pa + 68);
    b0 = *(const float4*)(pa + 128); b1 = *(const float4*)(pa + 132);
    k0 = *(const float4*)(pa + 192); k1 = *(const float4*)(pa + 196);
    r0 = *(const float4*)(pa + 256); r1 = *(const float4*)(pa + 260);
    vv = Vst[t * 32 + row32];
  };
  auto steps8 = [&](const float* PA, const float* Vst, float* Yst, int t0) {
#pragma unroll
    for (int t8 = 0; t8 < 8; ++t8) {
      const int t = t0 + t8;
      const float* pa = PA + (t + 1) * 320 + ks * 8;
      const float4 xd0 = *(const float4*)(pa), xd1 = *(const float4*)(pa + 4);
      const float4 xn0 = *(const float4*)(pa + 64), xn1 = *(const float4*)(pa + 68);
      const float4 xb0 = *(const float4*)(pa + 128), xb1 = *(const float4*)(pa + 132);
      const float4 xk0 = *(const float4*)(pa + 192), xk1 = *(const float4*)(pa + 196);
      const float4 xr0 = *(const float4*)(pa + 256), xr1 = *(const float4*)(pa + 260);
      const float xvv = Vst[(t + 1) * 32 + row32];
      float sa0 = S[0] * n0.x, sa1 = S[1] * n0.y;
      sa0 = fmaf(S[2], n0.z, sa0); sa1 = fmaf(S[3], n0.w, sa1);
      sa0 = fmaf(S[4], n1.x, sa0); sa1 = fmaf(S[5], n1.y, sa1);
      sa0 = fmaf(S[6], n1.z, sa0); sa1 = fmaf(S[7], n1.w, sa1);
      float sa = red8(sa0 + sa1);
      S[0] = fmaf(sa, b0.x, fmaf(S[0], d0.x, vv * k0.x)); S[1] = fmaf(sa, b0.y, fmaf(S[1], d0.y, vv * k0.y));
      S[2] = fmaf(sa, b0.z, fmaf(S[2], d0.z, vv * k0.z)); S[3] = fmaf(sa, b0.w, fmaf(S[3], d0.w, vv * k0.w));
      S[4] = fmaf(sa, b1.x, fmaf(S[4], d1.x, vv * k1.x)); S[5] = fmaf(sa, b1.y, fmaf(S[5], d1.y, vv * k1.y));
      S[6] = fmaf(sa, b1.z, fmaf(S[6], d1.z, vv * k1.z)); S[7] = fmaf(sa, b1.w, fmaf(S[7], d1.w, vv * k1.w));
      float y0 = S[0] * r0.x, y1 = S[1] * r0.y;
      y0 = fmaf(S[2], r0.z, y0); y1 = fmaf(S[3], r0.w, y1);
      y0 = fmaf(S[4], r1.x, y0); y1 = fmaf(S[5], r1.y, y1);
      y0 = fmaf(S[6], r1.z, y0); y1 = fmaf(S[7], r1.w, y1);
      float y = red8(y0 + y1);
      Yst[t * 32 + row32] = y;
      d0 = xd0; d1 = xd1; n0 = xn0; n1 = xn1; b0 = xb0; b1 = xb1; k0 = xk0; k1 = xk1; r0 = xr0; r1 = xr1; vv = xvv;
    }
  };
  load_raw(0);
  prep1(Vstb);
  __syncthreads();
  prep3();
  load_raw(1);
  __syncthreads();
  prep4(PAb, BONb);
  __syncthreads();
  int v3 = 0;
  for (int tc = 0; tc < 128; ++tc) {
    const int lr = b * 4096 + tc * 32 + tt;
    const int v3n = (v3 == 2) ? 0 : v3 + 1;
    float* PAc = PAb + (tc & 1) * 10240;        float* PAn = PAb + ((tc + 1) & 1) * 10240;
    float* Vc = Vstb + v3 * 1024;               float* Vn = Vstb + v3n * 1024;
    float* Bc = BONb + v3 * 32;                 float* Bn = BONb + v3n * 32;
    float* Yc = Ystb + (tc & 1) * 1024;
    step_load(PAc, Vc, 0);
    prep1(Vn);
    steps8(PAc, Vc, Yc, 0);
    __syncthreads();
    prep3();
    steps8(PAc, Vc, Yc, 8);
    __syncthreads();
    prep4(PAn, Bn);
    steps8(PAc, Vc, Yc, 16);
    load_raw(tc + 2);
    flush_out();
    steps8(PAc, Vc, Yc, 24);
    __syncthreads();
    {
      float y8[8], v8[8];
      float4 t0 = *(const float4*)(Yc + tt * 32 + c4 * 8), t1 = *(const float4*)(Yc + tt * 32 + c4 * 8 + 4);
      y8[0] = t0.x; y8[1] = t0.y; y8[2] = t0.z; y8[3] = t0.w; y8[4] = t1.x; y8[5] = t1.y; y8[6] = t1.z; y8[7] = t1.w;
      float sm = 0.f, sq = 0.f;
#pragma unroll
      for (int e = 0; e < 8; ++e) { sm += y8[e]; sq += y8[e] * y8[e]; }
      sm = red4(sm); sq = red4(sq);
      const float bon = Bc[tt];
      t0 = *(const float4*)(Vc + tt * 32 + c4 * 8); t1 = *(const float4*)(Vc + tt * 32 + c4 * 8 + 4);
      v8[0] = t0.x * bon; v8[1] = t0.y * bon; v8[2] = t0.z * bon; v8[3] = t0.w * bon; v8[4] = t1.x * bon; v8[5] = t1.y * bon; v8[6] = t1.z * bon; v8[7] = t1.w * bon;
      d_y = pack8(y8); d_v = pack8(v8); d_sm = sm; d_sq = sq; d_lr = lr;
    }
    v3 = v3n;
  }
  flush_out();
  if (c == 0 && !dry) {
    float* sp = STATE + ((size_t)((b * 24 + head) * 64 + 32 * half + row32)) * 64 + 8 * ks;
#pragma unroll
    for (int i = 0; i < 8; ++i) sp[i] = S[i];
  }
}

DI void phase_scan(const Params& p, int L, int c, char* smem, int* s_item, bool dry) {
  for (int item = blockIdx.x; item < 192; item += gridDim.x) scan_item(p, L, c, item, smem, dry);
  int* cnt = (int*)(p.ws + OFF_CNT) + 64 + ((L * 2 + c) * 2 + (dry ? 1 : 0)) * 16 + 8;
  for (;;) {
    __syncthreads();
    if (otid() == 0) *s_item = atomicAdd(cnt, 1);
    __syncthreads();
    const int item = *s_item;
    if (item >= 512) break;
    memattn_item(p, L, c, item, smem, dry);
  }
}

DI void phase_finalize(const Params& p, int L, int c, bool dry) {
  const int j = L >> 1;
  u16* U = (u16*)(p.ws + OFF_U);
  const u16* YR = (const u16*)(p.ws + OFF_YR); const u16* BV = (const u16*)(p.ws + OFF_BV);
  const float* ST = (const float*)(p.ws + OFF_ST);
  const int G = gridDim.x;
  for (int idx = blockIdx.x * 256 + otid(); idx < TC * 192; idx += G * 256) {
    const int lr = idx / 192, c8 = idx - lr * 192, ch0 = c8 * 8, head = ch0 >> 6;
    const float4 st = *(const float4*)(ST + (size_t)(lr * 24 + head) * 4);
    const float mean = (st.x + st.z) * (1.f / 64.f);
    const float var = (st.y + st.w) * (1.f / 64.f) - mean * mean;
    const float rstd = rsqrtf(fmaxf(var, 0.f) + 64e-5f);
    float y[8], bv[8], g[8], o[8];
    unpack8(*(const uint4*)(YR + (size_t)lr * 1536 + ch0), y);
    unpack8(*(const uint4*)(BV + (size_t)lr * 1536 + ch0), bv);
    u16* gp = U + (size_t)lr * LDU_R + R_GATE + ch0;
    unpack8(*(const uint4*)gp, g);
    const float* gw = p.gn_w + j * 1536 + ch0; const float* gb = p.gn_b + j * 1536 + ch0;
#pragma unroll
    for (int e = 0; e < 8; ++e) o[e] = ((y[e] - mean) * rstd * gw[e] + gb[e] + bv[e]) * silu(g[e]);
    if (!dry) *(uint4*)gp = pack8(o);
  }
  if (c == 0) {
    u16* BND = (u16*)(p.ws + OFF_BND);
    for (int idx = blockIdx.x * 256 + otid(); idx < 4 * (SHIFTW / 8); idx += G * 256) {
      const int b = idx / (SHIFTW / 8), cc = idx - b * (SHIFTW / 8);
      *(uint4*)(BND + (size_t)b * SHIFTW + cc * 8) = *(const uint4*)(U + (size_t)(b * 4096 + 4095) * LDU_R + cc * 8);
    }
  }
}

enum { PH_PREP = 0, PH_NORM, PH_GEMM_IN, PH_KVPREP, PH_GEMM_UP, PH_ATTN, PH_SCAN, PH_FINALIZE, PH_GEMM_OUT, PH_FINAL };
constexpr int NSTEPS = 42;

DI void decode_step(int step, int& ph, int& L, int& c) {
  if (step == 0) { ph = PH_PREP; L = 0; c = 0; return; }
  if (step == NSTEPS - 1) { ph = PH_FINAL; L = 0; c = 0; return; }
  int s = step - 1;
  int pr = s / 20, rem = s - pr * 20;
  if (rem < 11) {
    L = 2 * pr;
    int k;
    if (rem < 6) { c = 0; k = rem; } else { c = 1; k = rem - 5; }
    ph = (k == 0) ? PH_NORM : (k == 1) ? PH_GEMM_IN : (k == 2) ? PH_KVPREP : (k == 3) ? PH_GEMM_UP : (k == 4) ? PH_ATTN : PH_GEMM_OUT;
  } else {
    rem -= 11; L = 2 * pr + 1;
    int k;
    if (rem < 5) { c = 0; k = rem; } else { c = 1; k = rem - 4; }
    ph = (k == 0) ? PH_NORM : (k == 1) ? PH_GEMM_IN : (k == 2) ? PH_SCAN : (k == 3) ? PH_FINALIZE : PH_GEMM_OUT;
  }
}

DI void run_step(const Params& p, int ph, int L, int c, char* smem, int* s_item, bool dry_in, int vt) {
  const bool dry = dry_in && !(HYP5 && (ph == PH_GEMM_IN || ph == PH_GEMM_UP));
  char* ws = p.ws;
  const bool rw = L & 1;
  const int j = L >> 1;
  switch (ph) {
    case PH_PREP: phase_prep(p, smem); break;
    case PH_NORM:
      phase_norm(p, L, c);
      if (L == 0 && c == 0) {
        EpiMemKV epi{(u16*)(ws + OFF_MEMK), (u16*)(ws + OFF_MEMVT), false};
        gemm_phase<2, false, 16>((const u16*)(ws + OFF_MEMH), 1024ull * 1024, 1024, (const u16*)(ws + OFF_WT_MEMKV), 1024ull * 1024, 1024, 4, 4, 8, 4, 1024, smem, epi, vt);
      }
      break;
    case PH_GEMM_IN:
      if (!rw) {
        EpiStoreBf16 epi{(u16*)(ws + OFF_U), LDU_M, LDU_M, dry};
        gemm_phase<2, true, 16>((const u16*)(ws + OFF_H), 0, 1024, (const u16*)(ws + OFF_WT_INMLA) + (size_t)j * 3328 * 1024, 0, 1024, 1, 64, 26, 4, 1024, smem, epi, vt);
      } else {
        EpiStoreBf16 epi{(u16*)(ws + OFF_U), LDU_R, LDU_R, dry};
        gemm_phase<2, true, 16>((const u16*)(ws + OFF_H), 0, 1024, (const u16*)(ws + OFF_WT_INRW) + (size_t)j * 7296 * 1024, 0, 1024, 1, 64, 57, 4, 1024, smem, epi, vt);
      }
      break;
    case PH_KVPREP: phase_kvprep(p, L, c, dry); break;
    case PH_GEMM_UP: {
      EpiUQ e1{(u16*)(ws + OFF_Q), (const float*)(ws + OFF_COS), (const float*)(ws + OFF_SIN), c, dry};
      gemm_phase<2, true, 6>((const u16*)(ws + OFF_U) + M_CQ, 0, LDU_M, (const u16*)(ws + OFF_WT_UQ) + (size_t)j * 2304 * 384, 0, 384, 1, 64, 18, 4, 384, smem, e1, vt);
      EpiUK e2{(u16*)(ws + OFF_K), dry};
      gemm_phase<2, true, 4>((const u16*)(ws + OFF_U) + M_CKV, 0, LDU_M, (const u16*)(ws + OFF_WT_UKV) + (size_t)j * 3072 * 256, 0, 256, 1, 64, 12, 4, 256, smem, e2, vt);
      EpiUV e3{(u16*)(ws + OFF_VT), dry};
      gemm_phase<2, false, 4>((const u16*)(ws + OFF_U) + M_CKV, 0, LDU_M, (const u16*)(ws + OFF_WT_UKV) + (size_t)j * 3072 * 256 + 1536ull * 256, 0, 256, 1, 64, 12, 4, 256, smem, e3, vt);
    } break;
    case PH_ATTN: phase_attn(p, L, c, smem, s_item, dry); break;
    case PH_SCAN: phase_scan(p, L, c, smem, s_item, dry); break;
    case PH_FINALIZE: phase_finalize(p, L, c, dry); break;
    case PH_GEMM_OUT: {
      EpiResid epi{(L == 0) ? p.x : (const float*)p.out, p.out, rw, c, dry};
      gemm_phase<2, true, 32>((const u16*)(ws + OFF_U) + (rw ? R_GATE : M_GATE), 0, rw ? LDU_R : LDU_M, (const u16*)(ws + OFF_WT_OUT) + (size_t)L * 1024 * 2048, 0, 2048,
                 1, 64, 8, 4, 2048, smem, epi, vt);
      if (c == 0 && !dry) phase_norm(p, L, 1);
    } break;
    case PH_FINAL: phase_final_norm(p, dry); break;
  }
}

DI void grid_barrier(unsigned* bar, unsigned& epoch) {
  __syncthreads();
  ++epoch;
  if (threadIdx.x == 0) {
    __builtin_amdgcn_fence(__ATOMIC_RELEASE, "agent");
    asm volatile("s_waitcnt vmcnt(0)" ::: "memory");
    const unsigned target = epoch * gridDim.x;
    __hip_atomic_fetch_add(bar, 1u, __ATOMIC_RELAXED, __HIP_MEMORY_SCOPE_AGENT);
    unsigned spins = 0;
    while (__hip_atomic_load(bar, __ATOMIC_RELAXED, __HIP_MEMORY_SCOPE_AGENT) < target) {
      __builtin_amdgcn_s_sleep(2);
      if (++spins > (1u << 22)) break;
    }
    __builtin_amdgcn_fence(__ATOMIC_ACQUIRE, "agent");
    asm volatile("s_waitcnt vmcnt(0)" ::: "memory");
  }
  __syncthreads();
}

__global__ void __launch_bounds__(256, 1) hybrid_megakernel(Params p, int s_lo, int s_hi, int coop, int probe_mask) {
  __shared__ __attribute__((aligned(16))) char smem[SMEM_BYTES];
  __shared__ int s_item;
  unsigned* bar = (unsigned*)(p.ws + OFF_BAR);
  unsigned epoch = 0;
  if (coop == 2) cg::this_grid().sync();
  __shared__ int s_vt;
  int myx = 0, myrank = 0;
  if (coop && threadIdx.x == 0) {
    myx = (int)(__builtin_amdgcn_s_getreg((3 << 11) | 20) & 7u);
    myrank = (int)__hip_atomic_fetch_add(bar + 16 + myx, 1u, __ATOMIC_RELAXED, __HIP_MEMORY_SCOPE_AGENT);
  }
  int vt = blockIdx.x;
  {
    const int G = gridDim.x, t = blockIdx.x;
    vt = ((G & 7) == 0) ? ((t & 7) * (G >> 3) + (t >> 3)) : t;
  }
  for (int st = s_lo; st < s_hi; ++st) {
    int ph, L, c;
    decode_step(st, ph, L, c);
    for (int rep = ((probe_mask >> ph) & 1) ? 0 : 1; rep < 2; ++rep) {
      run_step(p, ph, L, c, smem, &s_item, rep == 0, vt);
      if (coop && (rep == 0 || st + 1 < s_hi)) grid_barrier(bar, epoch);
      if (coop) for (int xs = 0; xs < EXTRA_SYNCS; ++xs) grid_barrier(bar, epoch);
    }
    if (coop && st == s_lo) {
      if (threadIdx.x == 0) {
        const int G = gridDim.x;
        bool ok = (G & 7) == 0;
        for (int x = 0; x < 8; ++x) ok = ok && ((int)__hip_atomic_load(bar + 16 + x, __ATOMIC_RELAXED, __HIP_MEMORY_SCOPE_AGENT) == (G >> 3));
        s_vt = ok ? (myx * (G >> 3) + myrank) : vt;
      }
      __syncthreads();
      vt = s_vt;
    }
  }
}

extern "C" void kernel_launch(void* const* d_in, const int* in_sizes, int n_in, void* d_out, int out_size, void* d_ws, size_t ws_size,
                              hipStream_t stream) {
  if (ws_size < WS_NEED) { fprintf(stderr, "workspace too small: %zu < %zu\n", ws_size, (size_t)WS_NEED); return; }
  Params p;
  memset(&p, 0, sizeof(p));
  p.x = (const float*)d_in[0]; p.mem = (const float*)d_in[1]; p.pos = (const int*)d_in[2];
  p.norm_g = (const float*)d_in[3]; p.mem_norm_g = (const float*)d_in[4]; p.w_mem_kv = (const float*)d_in[5];
  p.w_in_mla = (const float*)d_in[6]; p.q_norm_g = (const float*)d_in[7]; p.kv_norm_g = (const float*)d_in[8];
  p.w_uq = (const float*)d_in[9]; p.w_ukv = (const float*)d_in[10]; p.w_in_rwkv = (const float*)d_in[11];
  p.mu = (const float*)d_in[12]; p.w0 = (const float*)d_in[13]; p.w2 = (const float*)d_in[14]; p.a0 = (const float*)d_in[15];
  p.a2 = (const float*)d_in[16]; p.k_k = (const float*)d_in[17]; p.k_a = (const float*)d_in[18]; p.r_k = (const float*)d_in[19];
  p.gn_w = (const float*)d_in[20]; p.gn_b = (const float*)d_in[21]; p.w_out = (const float*)d_in[22]; p.final_g = (const float*)d_in[23];
  p.out = (float*)d_out; p.ws = (char*)d_ws;
  static int grid_blocks = 0;
  if (!grid_blocks) {
    int dev = 0, cus = 0, per_cu = 0;
    hipGetDevice(&dev);
    hipDeviceGetAttribute(&cus, hipDeviceAttributeMultiprocessorCount, dev);
    hipOccupancyMaxActiveBlocksPerMultiprocessor(&per_cu, hybrid_megakernel, 256, 0);
    if (per_cu > 2) per_cu = 2;
    if (per_cu < 1) per_cu = 1;
    grid_blocks = cus * per_cu;
  }
#if MULTI_LAUNCH
  for (int s = 0; s < NSTEPS; ++s) hipLaunchKernelGGL(hybrid_megakernel, dim3(grid_blocks), dim3(256), 0, stream, p, s, s + 1, 0, 0);
#else
  int s_lo = 0, s_hi = NSTEPS, coop = 1, probe_mask = PROBE_MASK;
  void* args[] = {&p, &s_lo, &s_hi, &coop, &probe_mask};
  hipMemsetAsync((char*)d_ws + OFF_BAR, 0, 256, stream);
  hipError_t e = hipLaunchCooperativeKernel((void*)hybrid_megakernel, dim3(grid_blocks), dim3(256), args, 0, stream);
  if (e != hipSuccess) fprintf(stderr, "cooperative launch failed: %s (grid %d)\n", hipGetErrorString(e), grid_blocks);
#endif
}
```

```cpp
#include <hip/hip_runtime.h>
#include <hip/hip_cooperative_groups.h>
#include <cstdio>
#include <cstring>
namespace cg = cooperative_groups;

#define PROBE_MASK 0
#define EXTRA_SYNCS 0
#define HYP1 0
#define HYP2 0
#define HYP3 0
#define HYP4 0
#define HYP5 0
#define HYP6 0
#ifndef MULTI_LAUNCH
#define MULTI_LAUNCH 0
#endif

#define DI __device__ __forceinline__
typedef unsigned short u16;
typedef __attribute__((ext_vector_type(8))) short bf16x8;
typedef __attribute__((ext_vector_type(16))) float f32x16;
typedef __attribute__((ext_vector_type(2))) __bf16 bf2_t;
typedef __attribute__((ext_vector_type(2))) float f2_t;
typedef __attribute__((ext_vector_type(4))) unsigned u32x4;
typedef __attribute__((ext_vector_type(2))) unsigned u32x2;
#define MFMA32(a, b, c) __builtin_amdgcn_mfma_f32_32x32x16_bf16((a), (b), (c), 0, 0, 0)

constexpr int SEQ = 8192, TC = 16384;
constexpr int LDU_M = 3264, LDU_R = 7296;
constexpr int M_CQ = 0, M_CKV = 384, M_KR = 640, M_QM = 704, M_GATE = 1216;
constexpr int R_R = 0, R_K = 1536, R_V = 3072, R_WD = 4608, R_AD = 4672, R_QM = 4736, R_GATE = 5248;
constexpr int SHIFTW = 4736;

constexpr size_t OFF_WT_MEMKV = 0;
constexpr size_t OFF_WT_INMLA = OFF_WT_MEMKV + 4ull * 1024 * 1024 * 2;
constexpr size_t OFF_WT_UQ    = OFF_WT_INMLA + 2ull * 3328 * 1024 * 2;
constexpr size_t OFF_WT_UKV   = OFF_WT_UQ + 2ull * 2304 * 384 * 2;
constexpr size_t OFF_WT_INRW  = OFF_WT_UKV + 2ull * 3072 * 256 * 2;
constexpr size_t OFF_WT_OUT   = OFF_WT_INRW + 2ull * 7296 * 1024 * 2;
constexpr size_t OFF_MEMH     = OFF_WT_OUT + 4ull * 1024 * 2048 * 2;
constexpr size_t OFF_MEMK     = OFF_MEMH + 4ull * 1024 * 1024 * 2;
constexpr size_t OFF_MEMVT    = OFF_MEMK + 4ull * 4 * 4 * 256 * 128 * 2;
constexpr size_t OFF_COS      = OFF_MEMVT + 4ull * 4 * 4 * 256 * 128 * 2;
constexpr size_t OFF_SIN      = OFF_COS + 32768ull * 32 * 4;
constexpr size_t OFF_CNT      = OFF_SIN + 32768ull * 32 * 4;
constexpr size_t OFF_BAR      = OFF_CNT + 4096;
constexpr size_t OFF_STATE    = OFF_BAR + 256;
constexpr size_t OFF_BND      = OFF_STATE + 96ull * 4096 * 4;
constexpr size_t OFF_H        = OFF_BND + 5ull * 4736 * 2 + 128;
constexpr size_t OFF_R        = OFF_H + 16384ull * 1024 * 2;
constexpr size_t OFF_U        = OFF_R;
constexpr size_t OFF_Q        = OFF_R + 16384ull * 3264 * 2;
constexpr size_t OFF_K        = OFF_Q + 2ull * 12 * 8192 * 192 * 2;
constexpr size_t OFF_VT       = OFF_K + 2ull * 12 * 8192 * 192 * 2;
constexpr size_t OFF_YR       = OFF_R + 16384ull * 7296 * 2;
constexpr size_t OFF_BV       = OFF_YR + 16384ull * 1536 * 2;
constexpr size_t OFF_ST       = OFF_BV + 16384ull * 1536 * 2;
constexpr size_t OFF_BS       = OFF_ST + 16384ull * 24 * 4 * 4;
constexpr size_t WS_NEED      = OFF_BS + 16384ull * 24 * 4;

constexpr int SMEM_BYTES = 149504;

struct Params {
  const float *x, *mem; const int* pos;
  const float *norm_g, *mem_norm_g, *w_mem_kv, *w_in_mla, *q_norm_g, *kv_norm_g, *w_uq, *w_ukv, *w_in_rwkv;
  const float *mu, *w0, *w2, *a0, *a2, *k_k, *k_a, *r_k, *gn_w, *gn_b, *w_out, *final_g;
  float* out; char* ws;
};

DI int otid() { int t = threadIdx.x; asm volatile("" : "+v"(t)); return t; }
DI float bf2f(unsigned v) { return __uint_as_float(v << 16); }
DI unsigned pack2(float a, float b) { f2_t v = {a, b}; bf2_t r = __builtin_convertvector(v, bf2_t); return __builtin_bit_cast(unsigned, r); }
DI u16 f2bf(float a) { return (u16)(pack2(a, 0.f) & 0xffffu); }
DI float ex2(float x) { return __builtin_amdgcn_exp2f(x); }
DI float fexp(float x) { return __builtin_amdgcn_exp2f(x * 1.4426950408889634f); }
DI float frcp(float x) { return __builtin_amdgcn_rcpf(x); }
DI float silu(float g) { return g * frcp(1.f + fexp(-g)); }
DI float wave_sum(float v) { for (int o = 32; o > 0; o >>= 1) v += __shfl_xor(v, o); return v; }
DI int crow(int reg, int h) { return (reg & 3) + 8 * (reg >> 2) + 4 * h; }
DI float dppf(float x, const int ctrl_sel) {
  int xi;
  if (ctrl_sel == 0) xi = __builtin_amdgcn_update_dpp(0, __float_as_int(x), 0xB1, 0xf, 0xf, true);
  else if (ctrl_sel == 1) xi = __builtin_amdgcn_update_dpp(0, __float_as_int(x), 0x4E, 0xf, 0xf, true);
  else xi = __builtin_amdgcn_update_dpp(0, __float_as_int(x), 0x141, 0xf, 0xf, true);
  return __int_as_float(xi);
}
DI float red4(float x) { x += dppf(x, 0); x += dppf(x, 1); return x; }
DI float red8(float x) { x += dppf(x, 0); x += dppf(x, 1); x += dppf(x, 2); return x; }
DI int gtok(bool rw, int c, int lr) { return rw ? ((lr >> 12) * 8192 + c * 4096 + (lr & 4095)) : (c * 16384 + lr); }
DI void unpack8(const uint4& v, float* f) {
  f[0] = bf2f(v.x & 0xffffu); f[1] = bf2f(v.x >> 16); f[2] = bf2f(v.y & 0xffffu); f[3] = bf2f(v.y >> 16);
  f[4] = bf2f(v.z & 0xffffu); f[5] = bf2f(v.z >> 16); f[6] = bf2f(v.w & 0xffffu); f[7] = bf2f(v.w >> 16);
}
DI uint4 pack8(const float* f) { uint4 v; v.x = pack2(f[0], f[1]); v.y = pack2(f[2], f[3]); v.z = pack2(f[4], f[5]); v.w = pack2(f[6], f[7]); return v; }

DI void transpose_tile(const float* __restrict__ src, u16* __restrict__ dst, int K, int N, int tk, int tn, int drow, float* tile) {
  const int tid = otid();
  __syncthreads();
#pragma unroll
  for (int i = 0; i < 4; ++i) {
    int kr = (tid >> 4) + 16 * i, nc = (tid & 15) * 4;
    float4 v = *(const float4*)(src + (size_t)(tk * 64 + kr) * N + tn * 64 + nc);
    tile[kr * 65 + nc] = v.x; tile[kr * 65 + nc + 1] = v.y; tile[kr * 65 + nc + 2] = v.z; tile[kr * 65 + nc + 3] = v.w;
  }
  __syncthreads();
#pragma unroll
  for (int i = 0; i < 2; ++i) {
    int n = (tid >> 3) + 32 * i, kc = (tid & 7) * 8;
    float f[8];
#pragma unroll
    for (int e = 0; e < 8; ++e) f[e] = tile[(kc + e) * 65 + n];
    *(uint4*)(dst + (size_t)(drow + n) * K + tk * 64 + kc) = pack8(f);
  }
}

DI void rms_row_bf16(const float* __restrict__ src, const float* __restrict__ g, u16* __restrict__ dst, int lane) {
  float4 v[4]; float ss = 0.f;
#pragma unroll
  for (int i = 0; i < 4; ++i) { v[i] = *(const float4*)(src + i * 256 + lane * 4); ss += v[i].x * v[i].x + v[i].y * v[i].y + v[i].z * v[i].z + v[i].w * v[i].w; }
  ss = wave_sum(ss);
  float rs = rsqrtf(ss * (1.f / 1024.f) + 1e-6f);
#pragma unroll
  for (int i = 0; i < 4; ++i) {
    float4 gg = *(const float4*)(g + i * 256 + lane * 4);
    uint2 o; o.x = pack2(v[i].x * rs * gg.x, v[i].y * rs * gg.y); o.y = pack2(v[i].z * rs * gg.z, v[i].w * rs * gg.w);
    *(uint2*)(dst + i * 256 + lane * 4) = o;
  }
}

DI void phase_prep(const Params& p, char* smem) {
  const int tid = otid(), G = gridDim.x, bid = blockIdx.x;
  char* ws = p.ws;
  if (bid == 0) for (int i = tid; i < 1024; i += 256) ((int*)(ws + OFF_CNT))[i] = 0;
  float* tile = (float*)smem;
  for (int g0 = bid; g0 < 9168; g0 += G) {
    int g = g0;
    const float* src = nullptr; u16* dst = nullptr; int K = 0, N = 0; size_t dstr = 0; bool ukv = false;
    if (g < 1024) { src = p.w_mem_kv; dst = (u16*)(ws + OFF_WT_MEMKV); K = 1024; N = 1024; dstr = 1024ull * 1024; }
    else if ((g -= 1024) < 1632) { src = p.w_in_mla; dst = (u16*)(ws + OFF_WT_INMLA); K = 1024; N = 3264; dstr = 3328ull * 1024; }
    else if ((g -= 1632) < 432) { src = p.w_uq; dst = (u16*)(ws + OFF_WT_UQ); K = 384; N = 2304; dstr = 2304ull * 384; }
    else if ((g -= 432) < 384) { src = p.w_ukv; dst = (u16*)(ws + OFF_WT_UKV); K = 256; N = 3072; dstr = 3072ull * 256; ukv = true; }
    else if ((g -= 384) < 3648) { src = p.w_in_rwkv; dst = (u16*)(ws + OFF_WT_INRW); K = 1024; N = 7296; dstr = 7296ull * 1024; }
    else { g -= 3648; src = p.w_out; dst = (u16*)(ws + OFF_WT_OUT); K = 2048; N = 1024; dstr = 1024ull * 2048; }
    int ntn = N >> 6, per = (K >> 6) * ntn;
    int m = g / per, t = g - m * per;
    int tk = t / ntn, tn = t - tk * ntn;
    int drow = tn * 64;
    if (ukv) { const int hd = drow >> 8, dd = drow & 255; drow = (dd < 128) ? (hd * 128 + dd) : (1536 + hd * 128 + dd - 128); }
    transpose_tile(src + (size_t)m * K * N, dst + (size_t)m * dstr, K, N, tk, tn, drow, tile);
  }
  for (int i = bid * 256 + tid; i < 2 * 64 * 1024 / 8; i += G * 256) {
    int m = i / (64 * 1024 / 8), r = i - m * (64 * 1024 / 8);
    uint4 z; z.x = z.y = z.z = z.w = 0u;
    *(uint4*)((u16*)(ws + OFF_WT_INMLA) + (size_t)m * 3328 * 1024 + 3264ull * 1024 + (size_t)r * 8) = z;
  }
  for (int i = bid * 256 + tid; i < SHIFTW / 8; i += G * 256) { uint4 z; z.x = z.y = z.z = z.w = 0u; *(uint4*)((u16*)(ws + OFF_BND) + 4 * SHIFTW + i * 8) = z; }
  float* cs = (float*)(ws + OFF_COS); float* sn = (float*)(ws + OFF_SIN);
  for (int i = bid * 256 + tid; i < 32768 * 32; i += G * 256) {
    int tk = i >> 5, pi = i & 31;
    float inv_freq = (float)exp2(-(double)(2 * pi) / 64.0 * 13.287712379549449);
    float ang = (float)p.pos[tk] * inv_freq;
    double rev = (double)ang * 0.15915494309189535;
    float fr = (float)(rev - rint(rev));
    cs[i] = __builtin_amdgcn_cosf(fr); sn[i] = __builtin_amdgcn_sinf(fr);
  }
  const int w = tid >> 6, lane = tid & 63;
  for (int row = bid * 4 + w; row < 4096; row += G * 4) {
    int L = row >> 10, m = row & 1023;
    rms_row_bf16(p.mem + (size_t)m * 1024, p.mem_norm_g + L * 1024, (u16*)(ws + OFF_MEMH) + (size_t)row * 1024, lane);
  }
}

DI void phase_norm(const Params& p, int L, int c) {
  const int tid = otid(), w = tid >> 6, lane = tid & 63;
  const bool rw = L & 1;
  const float* xs = (L == 0) ? p.x : p.out;
  u16* H = (u16*)(p.ws + OFF_H);
  for (int lr = blockIdx.x * 4 + w; lr < TC; lr += gridDim.x * 4) {
    int gt = gtok(rw, c, lr);
    rms_row_bf16(xs + (size_t)gt * 1024, p.norm_g + L * 1024, H + (size_t)lr * 1024, lane);
  }
}

DI void phase_final_norm(const Params& p, bool dry) {
  const int tid = otid(), w = tid >> 6, lane = tid & 63;
  for (int row = blockIdx.x * 4 + w; row < 32768; row += gridDim.x * 4) {
    float* xr = p.out + (size_t)row * 1024;
    float4 v[4]; float ss = 0.f;
#pragma unroll
    for (int i = 0; i < 4; ++i) { v[i] = *(const float4*)(xr + i * 256 + lane * 4); ss += v[i].x * v[i].x + v[i].y * v[i].y + v[i].z * v[i].z + v[i].w * v[i].w; }
    ss = wave_sum(ss);
    float rs = rsqrtf(ss * (1.f / 1024.f) + 1e-6f);
#pragma unroll
    for (int i = 0; i < 4; ++i) {
      float4 gg = *(const float4*)(p.final_g + i * 256 + lane * 4);
      float4 o; o.x = v[i].x * rs * gg.x; o.y = v[i].y * rs * gg.y; o.z = v[i].z * rs * gg.z; o.w = v[i].w * rs * gg.w;
      if (!dry) *(float4*)(xr + i * 256 + lane * 4) = o;
    }
  }
}

template <int TJ, bool SWAP, int NK, class Epi>
DI void gemm_phase(const u16* __restrict__ A, size_t strideAz, int lda, const u16* __restrict__ Bt, size_t strideBz, int ldb,
                   int Z, int Mt, int Nt, int GM, int K, char* smem, const Epi& epi, int vt) {
  constexpr int BN = 64 * TJ;
  constexpr int NB = BN / 32;
  const int tid = otid(), w = tid >> 6, lane = tid & 63, r = lane & 31, h = lane >> 5;
  const int wm = w >> 1, wn = w & 1;
  u16* As = (u16*)smem;
  u16* Bs = As + 2 * 256 * 72;
  const int G = gridDim.x, per = Mt * Nt, total = Z * per;
  const int lrow = tid >> 3, lcc = (tid & 7) * 8;
  unsigned aoff[8], boff[NB];
#pragma unroll
  for (int i = 0; i < 8; ++i) aoff[i] = (unsigned)((lrow + 32 * i) * lda + lcc);
#pragma unroll
  for (int i = 0; i < NB; ++i) boff[i] = (unsigned)((lrow + 32 * i) * ldb + lcc);
  const int lds_st = lrow * 72 + lcc;
  for (int base = 0; base < total; base += G) {
    const int q = base + vt;
    if (q >= total) continue;
    const int z = q / per, qq = q - z * per;
    const int grp = qq / (GM * Nt), within = qq - grp * GM * Nt;
    const int mt = grp * GM + (within % GM), nt = within / GM;
    const u16* Ag = A + z * strideAz + (size_t)(mt * 256) * lda;
    const u16* Bg = Bt + z * strideBz + (size_t)(nt * BN) * ldb;
    u32x4 ra[2][8], rb[2][NB];
    f32x16 acc[4][TJ];
#pragma unroll
    for (int i = 0; i < 4; ++i)
#pragma unroll
      for (int j = 0; j < TJ; ++j)
#pragma unroll
        for (int e = 0; e < 16; ++e) acc[i][j][e] = 0.f;
    __syncthreads();
#pragma unroll
    for (int i = 0; i < 8; ++i) ra[0][i] = *(const u32x4*)(Ag + aoff[i]);
#pragma unroll
    for (int i = 0; i < NB; ++i) rb[0][i] = *(const u32x4*)(Bg + boff[i]);
#pragma unroll
    for (int i = 0; i < 8; ++i) ra[1][i] = *(const u32x4*)(Ag + 64 + aoff[i]);
#pragma unroll
    for (int i = 0; i < NB; ++i) rb[1][i] = *(const u32x4*)(Bg + 64 + boff[i]);
#pragma unroll
    for (int i = 0; i < 8; ++i) *(u32x4*)(As + lds_st + (32 * i) * 72) = ra[0][i];
#pragma unroll
    for (int i = 0; i < NB; ++i) *(u32x4*)(Bs + lds_st + (32 * i) * 72) = rb[0][i];
    __syncthreads();
#pragma unroll
    for (int kt = 0; kt < NK; ++kt) {
      constexpr int dummy = 0; (void)dummy;
      const int u = kt & 1;
      if (kt + 2 < NK) {
        const u16* ag = Ag + (kt + 2) * 64; const u16* bg = Bg + (kt + 2) * 64;
#pragma unroll
        for (int i = 0; i < 8; ++i) ra[u][i] = *(const u32x4*)(ag + aoff[i]);
#pragma unroll
        for (int i = 0; i < NB; ++i) rb[u][i] = *(const u32x4*)(bg + boff[i]);
      }
      const u16* as = As + u * 256 * 72 + (128 * wm + r) * 72 + 8 * h;
      const u16* bs = Bs + u * BN * 72 + (32 * TJ * wn + r) * 72 + 8 * h;
      bf16x8 af[2][4], bfr[2][TJ];
#pragma unroll
      for (int i = 0; i < 4; ++i) af[0][i] = *(const bf16x8*)(as + (32 * i) * 72);
#pragma unroll
      for (int j = 0; j < TJ; ++j) bfr[0][j] = *(const bf16x8*)(bs + (32 * j) * 72);
#pragma unroll
      for (int ks = 0; ks < 4; ++ks) {
        if (ks < 3) {
#pragma unroll
          for (int i = 0; i < 4; ++i) af[(ks + 1) & 1][i] = *(const bf16x8*)(as + (32 * i) * 72 + 16 * (ks + 1));
#pragma unroll
          for (int j = 0; j < TJ; ++j) bfr[(ks + 1) & 1][j] = *(const bf16x8*)(bs + (32 * j) * 72 + 16 * (ks + 1));
        }
        __builtin_amdgcn_sched_barrier(0);
#pragma unroll
        for (int i = 0; i < 4; ++i)
#pragma unroll
          for (int j = 0; j < TJ; ++j)
            acc[i][j] = SWAP ? MFMA32(bfr[ks & 1][j], af[ks & 1][i], acc[i][j]) : MFMA32(af[ks & 1][i], bfr[ks & 1][j], acc[i][j]);
        if (ks == 0 && kt + 1 < NK) {
          u16* ad = As + (u ^ 1) * 256 * 72 + lds_st; u16* bd = Bs + (u ^ 1) * BN * 72 + lds_st;
#pragma unroll
          for (int i = 0; i < 8; ++i) *(u32x4*)(ad + (32 * i) * 72) = ra[u ^ 1][i];
#pragma unroll
          for (int i = 0; i < NB; ++i) *(u32x4*)(bd + (32 * i) * 72) = rb[u ^ 1][i];
#pragma unroll
          for (int i = 0; i < 6; ++i) { __builtin_amdgcn_sched_group_barrier(0x008, 1, 0); __builtin_amdgcn_sched_group_barrier(0x200, 2, 0); }
        }
        __builtin_amdgcn_sched_barrier(0);
      }
      __syncthreads();
    }
#pragma unroll
    for (int i = 0; i < 4; ++i)
#pragma unroll
      for (int j = 0; j < TJ; ++j) {
        if (SWAP) epi(z, mt * 256 + 128 * wm + 32 * i + r, nt * BN + 32 * TJ * wn + 32 * j, h, acc[i][j]);
        else epi(z, mt * 256 + 128 * wm + 32 * i, nt * BN + 32 * TJ * wn + 32 * j + r, h, acc[i][j]);
      }
  }
}

struct EpiStoreBf16 {
  u16* C; int ldc; int ncols; bool dry;
  DI void operator()(int z, int row, int colbase, int h, const f32x16& a) const {
    if (dry) return;
#pragma unroll
    for (int g = 0; g < 4; ++g) {
      const int col = colbase + 8 * g + 4 * h;
      if (col < ncols) {
        u32x2 pk = {pack2(a[4 * g], a[4 * g + 1]), pack2(a[4 * g + 2], a[4 * g + 3])};
        *(u32x2*)(C + (size_t)row * ldc + col) = pk;
      }
    }
  }
};
struct EpiResid {
  const float* xin; float* xout; bool rw; int c; bool dry;
  DI void operator()(int z, int row, int colbase, int h, const f32x16& a) const {
    if (dry) return;
    const size_t o = (size_t)gtok(rw, c, row) * 1024 + colbase + 4 * h;
#pragma unroll
    for (int g = 0; g < 4; ++g) {
      float4 v = *(const float4*)(xin + o + 8 * g);
      v.x += a[4 * g]; v.y += a[4 * g + 1]; v.z += a[4 * g + 2]; v.w += a[4 * g + 3];
      *(float4*)(xout + o + 8 * g) = v;
    }
  }
};
struct EpiUQ {
  u16* Q; const float* cs; const float* sn; int c; bool dry;
  DI void operator()(int z, int row, int colbase, int h, const f32x16& a) const {
    if (dry) return;
    const int head = colbase / 192, db = colbase - head * 192;
    const int lb = row >> 13, s = row & 8191;
    u16* qp = Q + ((size_t)(lb * 12 + head) * 8192 + s) * 192 + db + 4 * h;
    const size_t ti = (size_t)(c * 16384 + row) * 32;
#pragma unroll
    for (int g = 0; g < 4; ++g) {
      float v0 = a[4 * g], v1 = a[4 * g + 1], v2 = a[4 * g + 2], v3 = a[4 * g + 3];
      if (db >= 128) {
        const int pi = (db - 128 + 8 * g + 4 * h) >> 1;
        const float2 cc = *(const float2*)(cs + ti + pi), ss = *(const float2*)(sn + ti + pi);
        const float o0 = v0 * cc.x - v1 * ss.x, o1 = v0 * ss.x + v1 * cc.x;
        const float o2 = v2 * cc.y - v3 * ss.y, o3 = v2 * ss.y + v3 * cc.y;
        v0 = o0; v1 = o1; v2 = o2; v3 = o3;
      }
      u32x2 pk = {pack2(v0, v1), pack2(v2, v3)};
      *(u32x2*)(qp + 8 * g) = pk;
    }
  }
};
struct EpiUK {
  u16* Kb; bool dry;
  DI void operator()(int z, int row, int colbase, int h, const f32x16& a) const {
    if (dry) return;
    const int head = colbase >> 7, db = colbase & 127;
    const int lb = row >> 13, s = row & 8191;
    u16* kp = Kb + ((size_t)(lb * 12 + head) * 8192 + s) * 192 + db + 4 * h;
#pragma unroll
    for (int g = 0; g < 4; ++g) {
      u32x2 pk = {pack2(a[4 * g], a[4 * g + 1]), pack2(a[4 * g + 2], a[4 * g + 3])};
      *(u32x2*)(kp + 8 * g) = pk;
    }
  }
};
struct EpiUV {
  u16* Vt; bool dry;
  DI void operator()(int z, int rowbase, int col, int h, const f32x16& a) const {
    if (dry) return;
    const int head = col >> 7, d = col & 127;
#pragma unroll
    for (int g = 0; g < 4; ++g) {
      int lr = rowbase + 8 * g + 4 * h; int lb = lr >> 13, s = lr & 8191;
      u32x2 pk = {pack2(a[4 * g], a[4 * g + 1]), pack2(a[4 * g + 2], a[4 * g + 3])};
      *(u32x2*)(Vt + (((size_t)(lb * 12 + head) * 128 + (s >> 6)) * 128 + d) * 64 + (s & 63)) = pk;
    }
  }
};
struct EpiMemKV {
  u16* MK; u16* MVt; bool dry;
  DI void operator()(int z, int rowbase, int col, int h, const f32x16& a) const {
    if (col < 512) {
      const int xh = col >> 7, d = col & 127;
#pragma unroll
      for (int e = 0; e < 16; ++e) {
        int m = rowbase + crow(e, h); int b = m >> 8, mi = m & 255;
        MK[((size_t)((z * 4 + b) * 4 + xh) * 256 + mi) * 128 + d] = f2bf(a[e]);
      }
    } else {
      const int n = col - 512, xh = n >> 7, d = n & 127;
#pragma unroll
      for (int g = 0; g < 4; ++g) {
        int m = rowbase + 8 * g + 4 * h; int b = m >> 8, mi = m & 255;
        uint2 pk; pk.x = pack2(a[4 * g], a[4 * g + 1]); pk.y = pack2(a[4 * g + 2], a[4 * g + 3]);
        *(uint2*)(MVt + (((size_t)((z * 4 + b) * 4 + xh) * 4 + (mi >> 6)) * 128 + d) * 64 + (mi & 63)) = pk;
      }
    }
  }
};

DI void phase_kvprep(const Params& p, int L, int c, bool dry) {
  const int tid = otid(), w = tid >> 6, lane = tid & 63;
  const int j = L >> 1;
  u16* U = (u16*)(p.ws + OFF_U); u16* Kb = (u16*)(p.ws + OFF_K);
  const float* cs = (const float*)(p.ws + OFF_COS); const float* sn = (const float*)(p.ws + OFF_SIN);
  for (int lr = blockIdx.x * 4 + w; lr < TC; lr += gridDim.x * 4) {
    u16* row = U + (size_t)lr * LDU_M;
    float fq[8], fk[8]; float sq = 0.f, sk = 0.f;
    if (lane < 48) { uint4 v = *(const uint4*)(row + M_CQ + lane * 8); unpack8(v, fq);
#pragma unroll
      for (int e = 0; e < 8; ++e) sq += fq[e] * fq[e]; }
    if (lane < 32) { uint4 v = *(const uint4*)(row + M_CKV + lane * 8); unpack8(v, fk);
#pragma unroll
      for (int e = 0; e < 8; ++e) sk += fk[e] * fk[e]; }
    sq = wave_sum(sq); sk = wave_sum(sk);
    float rq = rsqrtf(sq * (1.f / 384.f) + 1e-6f), rk = rsqrtf(sk * (1.f / 256.f) + 1e-6f);
    if (dry) continue;
    if (lane < 48) {
      const float* g = p.q_norm_g + j * 384 + lane * 8;
#pragma unroll
      for (int e = 0; e < 8; ++e) fq[e] = fq[e] * rq * g[e];
      *(uint4*)(row + M_CQ + lane * 8) = pack8(fq);
    }
    if (lane < 32) {
      const float* g = p.kv_norm_g + j * 256 + lane * 8;
#pragma unroll
      for (int e = 0; e < 8; ++e) fk[e] = fk[e] * rk * g[e];
      *(uint4*)(row + M_CKV + lane * 8) = pack8(fk);
    }
    if (lane < 8) {
      float f[8], o[8]; uint4 v = *(const uint4*)(row + M_KR + lane * 8); unpack8(v, f);
      int gt = c * 16384 + lr;
#pragma unroll
      for (int i = 0; i < 4; ++i) {
        float cc = cs[gt * 32 + lane * 4 + i], ss = sn[gt * 32 + lane * 4 + i];
        o[2 * i] = f[2 * i] * cc - f[2 * i + 1] * ss; o[2 * i + 1] = f[2 * i] * ss + f[2 * i + 1] * cc;
      }
      uint4 pk = pack8(o);
      int lb = lr >> 13, s = lr & 8191;
#pragma unroll
      for (int hd = 0; hd < 12; ++hd) *(uint4*)(Kb + ((size_t)(lb * 12 + hd) * 8192 + s) * 192 + 128 + lane * 8) = pk;
    }
  }
}

template <int DQK>
DI void attn_item(const u16* __restrict__ Qp, int ldq, const u16* __restrict__ Kp, const u16* __restrict__ Vtp, int ldv,
                  int nkt, int q0, bool causal, float c, u16* Yp, int ldy, char* smem, bool dry) {
  constexpr int KLD = DQK + 8;
  constexpr int NKC = DQK * 64 / 8 / 256;
  constexpr int NKS = DQK / 16;
  constexpr int CPR = DQK / 8;
  constexpr int BUFE = 64 * KLD + 128 * 72;
  u16* L0 = (u16*)smem;
  const int tid = otid(), w = tid >> 6, lane = tid & 63, r = lane & 31, h = lane >> 5;
  bf16x8 qf[NKS];
  {
    const u16* qrow = Qp + (size_t)(32 * w + r) * ldq + 8 * h;
#pragma unroll
    for (int ks = 0; ks < NKS; ++ks) qf[ks] = *(const bf16x8*)(qrow + 16 * ks);
  }
  f32x16 o[4];
#pragma unroll
  for (int dt = 0; dt < 4; ++dt)
#pragma unroll
    for (int e = 0; e < 16; ++e) o[dt][e] = 0.f;
  float m = -INFINITY, l = 0.f;
  u32x4 kst[NKC], vst[4];
  const int vd = tid >> 3, vc8 = tid & 7;
  int kso[NKC];
#pragma unroll
  for (int i = 0; i < NKC; ++i) { int id = tid + 256 * i; int row = id / CPR, cc = id - row * CPR; kso[i] = row * KLD + cc * 8; }
  const int vso = 64 * KLD + vd * 72 + 16 * (vc8 >> 1) + 4 * (vc8 & 1);
  __syncthreads();
#pragma unroll
  for (int i = 0; i < NKC; ++i) kst[i] = *(const u32x4*)(Kp + (size_t)(tid + 256 * i) * 8);
#pragma unroll
  for (int i = 0; i < 4; ++i) vst[i] = *(const u32x4*)(Vtp + (size_t)(tid + 256 * i) * 8);
#pragma unroll
  for (int i = 0; i < NKC; ++i) *(u32x4*)(L0 + kso[i]) = kst[i];
#pragma unroll
  for (int i = 0; i < 4; ++i) {
    u16* dst = L0 + vso + (32 * i) * 72;
    u32x2 lo = {vst[i].x, vst[i].y}, hi = {vst[i].z, vst[i].w};
    *(u32x2*)dst = lo; *(u32x2*)(dst + 8) = hi;
  }
  if (nkt > 1) {
    const u16* kg = Kp + (size_t)64 * DQK;
#pragma unroll
    for (int i = 0; i < NKC; ++i) kst[i] = *(const u32x4*)(kg + (size_t)(tid + 256 * i) * 8);
#pragma unroll
    for (int i = 0; i < 4; ++i) vst[i] = *(const u32x4*)(Vtp + 8192 + (size_t)(tid + 256 * i) * 8);
  }
  __syncthreads();
  const int qmin = q0 + 32 * w;
  for (int kt = 0; kt < nkt; ++kt) {
    const u16* Ks = L0 + (kt & 1) * BUFE;
    const u16* Vs = Ks + 64 * KLD;
    u16* Ln = L0 + ((kt + 1) & 1) * BUFE;
    const bool active = !(causal && kt * 64 > qmin + 31);
    f32x16 s0, s1;
#pragma unroll
    for (int e = 0; e < 16; ++e) { s0[e] = 0.f; s1[e] = 0.f; }
    const u16* k0 = Ks + r * KLD + 8 * h;
    bf16x8 ka[2][2];
    if (active) {
      ka[0][0] = *(const bf16x8*)(k0); ka[0][1] = *(const bf16x8*)(k0 + 32 * KLD);
      ka[1][0] = *(const bf16x8*)(k0 + 16); ka[1][1] = *(const bf16x8*)(k0 + 32 * KLD + 16);
      __builtin_amdgcn_sched_barrier(0);
      s0 = MFMA32(ka[0][0], qf[0], s0); s1 = MFMA32(ka[0][1], qf[0], s1);
    }
    if (kt + 1 < nkt) {
#pragma unroll
      for (int i = 0; i < NKC; ++i) *(u32x4*)(Ln + kso[i]) = kst[i];
#pragma unroll
      for (int i = 0; i < 4; ++i) {
        u16* dst = Ln + vso + (32 * i) * 72;
        u32x2 lo = {vst[i].x, vst[i].y}, hi = {vst[i].z, vst[i].w};
        *(u32x2*)dst = lo; *(u32x2*)(dst + 8) = hi;
      }
    }
    if (kt + 2 < nkt) {
      const u16* kg = Kp + (size_t)(kt + 2) * 64 * DQK;
#pragma unroll
      for (int i = 0; i < NKC; ++i) kst[i] = *(const u32x4*)(kg + (size_t)(tid + 256 * i) * 8);
#pragma unroll
      for (int i = 0; i < 4; ++i) vst[i] = *(const u32x4*)(Vtp + (size_t)(kt + 2) * 8192 + (size_t)(tid + 256 * i) * 8);
    }
    if (active) {
      __builtin_amdgcn_sched_barrier(0);
#pragma unroll
      for (int ks = 1; ks < NKS; ++ks) {
        if (ks + 1 < NKS) {
          ka[(ks + 1) & 1][0] = *(const bf16x8*)(k0 + 16 * (ks + 1));
          ka[(ks + 1) & 1][1] = *(const bf16x8*)(k0 + 32 * KLD + 16 * (ks + 1));
        }
        __builtin_amdgcn_sched_barrier(0);
        s0 = MFMA32(ka[ks & 1][0], qf[ks], s0); s1 = MFMA32(ka[ks & 1][1], qf[ks], s1);
        __builtin_amdgcn_sched_barrier(0);
      }
      const u16* v0 = Vs + r * 72 + 8 * h;
      bf16x8 va[2][4];
#pragma unroll
      for (int dt = 0; dt < 4; ++dt) va[0][dt] = *(const bf16x8*)(v0 + (32 * dt) * 72);
      if (causal && kt * 64 + 63 > qmin) {
        const int qi = qmin + r;
#pragma unroll
        for (int e = 0; e < 16; ++e) {
          int key = kt * 64 + crow(e, h);
          if (key > qi) s0[e] = -INFINITY;
          if (key + 32 > qi) s1[e] = -INFINITY;
        }
      }
      float mx = fmaxf(s0[0], s1[0]);
#pragma unroll
      for (int e = 1; e < 16; ++e) mx = fmaxf(mx, fmaxf(s0[e], s1[e]));
      mx = fmaxf(mx, __shfl_xor(mx, 32));
      if (__builtin_amdgcn_ballot_w64((mx - m) * c > 8.f) != 0ull) {
        const float mn = fmaxf(m, mx);
        const float alpha = ex2((m - mn) * c);
        m = mn;
        l *= alpha;
#pragma unroll
        for (int dt = 0; dt < 4; ++dt)
#pragma unroll
          for (int e = 0; e < 16; ++e) o[dt][e] *= alpha;
      }
      const float mc = m * c;
      float ps = 0.f;
#pragma unroll
      for (int e = 0; e < 16; ++e) { s0[e] = ex2(fmaf(s0[e], c, -mc)); s1[e] = ex2(fmaf(s1[e], c, -mc)); ps += s0[e] + s1[e]; }
      l += ps;
      bf16x8 pf[4];
      {
        u32x4 t;
        t.x = pack2(s0[0], s0[1]); t.y = pack2(s0[2], s0[3]); t.z = pack2(s0[4], s0[5]); t.w = pack2(s0[6], s0[7]); pf[0] = __builtin_bit_cast(bf16x8, t);
        t.x = pack2(s0[8], s0[9]); t.y = pack2(s0[10], s0[11]); t.z = pack2(s0[12], s0[13]); t.w = pack2(s0[14], s0[15]); pf[1] = __builtin_bit_cast(bf16x8, t);
        t.x = pack2(s1[0], s1[1]); t.y = pack2(s1[2], s1[3]); t.z = pack2(s1[4], s1[5]); t.w = pack2(s1[6], s1[7]); pf[2] = __builtin_bit_cast(bf16x8, t);
        t.x = pack2(s1[8], s1[9]); t.y = pack2(s1[10], s1[11]); t.z = pack2(s1[12], s1[13]); t.w = pack2(s1[14], s1[15]); pf[3] = __builtin_bit_cast(bf16x8, t);
      }
#pragma unroll
      for (int kk = 0; kk < 4; ++kk) {
        if (kk < 3) {
#pragma unroll
          for (int dt = 0; dt < 4; ++dt) va[(kk + 1) & 1][dt] = *(const bf16x8*)(v0 + (32 * dt) * 72 + 16 * (kk + 1));
        }
        __builtin_amdgcn_sched_barrier(0);
#pragma unroll
        for (int dt = 0; dt < 4; ++dt) o[dt] = MFMA32(va[kk & 1][dt], pf[kk], o[dt]);
        __builtin_amdgcn_sched_barrier(0);
      }
    }
    __syncthreads();
  }
  const float lt = l + __shfl_xor(l, 32);
  const float inv = 1.f / lt;
  if (dry) return;
  u16* yrow = Yp + (size_t)(32 * w + r) * ldy;
#pragma unroll
  for (int dt = 0; dt < 4; ++dt)
#pragma unroll
    for (int g = 0; g < 4; ++g) {
      const int d = 32 * dt + 8 * g + 4 * h;
      uint2 gv = *(const uint2*)(yrow + d);
      float g0 = bf2f(gv.x & 0xffffu), g1 = bf2f(gv.x >> 16), g2 = bf2f(gv.y & 0xffffu), g3 = bf2f(gv.y >> 16);
      uint2 ov;
      ov.x = pack2(o[dt][4 * g] * inv * silu(g0), o[dt][4 * g + 1] * inv * silu(g1));
      ov.y = pack2(o[dt][4 * g + 2] * inv * silu(g2), o[dt][4 * g + 3] * inv * silu(g3));
      *(uint2*)(yrow + d) = ov;
    }
}

template <int DQK>
DI void attn_item_c(const u16* __restrict__ Qp, int ldq, const u16* __restrict__ Kp, const u16* __restrict__ Vtp, int ldv,
                    int nkt, int q0, float c, u16* Yp, int ldy, char* smem, bool dry) {
  constexpr int KLD = DQK + 8;
  constexpr int NKC = DQK * 64 / 8 / 256;
  constexpr int NKS = DQK / 16;
  constexpr int CPR = DQK / 8;
  constexpr int BUFE = 64 * KLD + 128 * 72;
  u16* L0 = (u16*)smem;
  const int tid = otid(), w = tid >> 6, lane = tid & 63, r = lane & 31, h = lane >> 5;
  bf16x8 qf[NKS];
  {
    const u16* qrow = Qp + (size_t)(32 * w + r) * ldq + 8 * h;
#pragma unroll
    for (int ks = 0; ks < NKS; ++ks) qf[ks] = *(const bf16x8*)(qrow + 16 * ks);
  }
  f32x16 o[4];
#pragma unroll
  for (int dt = 0; dt < 4; ++dt)
#pragma unroll
    for (int e = 0; e < 16; ++e) o[dt][e] = 0.f;
  float m = -INFINITY, l = 0.f;
  u32x4 kstA[NKC], vstA[4], kstB[NKC], vstB[4];
  const int vd = tid >> 3, vc8 = tid & 7;
  int kso[NKC];
#pragma unroll
  for (int i = 0; i < NKC; ++i) { int id = tid + 256 * i; int row = id / CPR, cc = id - row * CPR; kso[i] = row * KLD + cc * 8; }
  const int vso = 64 * KLD + vd * 72 + 16 * (vc8 >> 1) + 4 * (vc8 & 1);
  const int nktp = (nkt + 3) & ~3;
  auto gload = [&](u32x4* ks_, u32x4* vs_, int j) {
    const u16* kg = Kp + (size_t)(j + 1) * 64 * DQK;
#pragma unroll
    for (int i = 0; i < NKC; ++i) ks_[i] = *(const u32x4*)(kg + (size_t)(tid + 256 * i) * 8);
#pragma unroll
    for (int i = 0; i < 4; ++i) vs_[i] = *(const u32x4*)(Vtp + (size_t)j * 8192 + (size_t)(tid + 256 * i) * 8);
  };
  auto lstore = [&](const u32x4* ks_, const u32x4* vs_, u16* Lb) {
#pragma unroll
    for (int i = 0; i < NKC; ++i) *(u32x4*)(Lb + kso[i]) = ks_[i];
#pragma unroll
    for (int i = 0; i < 4; ++i) {
      u16* dst = Lb + vso + (32 * i) * 72;
      u32x2 lo = {vs_[i].x, vs_[i].y}, hi = {vs_[i].z, vs_[i].w};
      *(u32x2*)dst = lo; *(u32x2*)(dst + 8) = hi;
    }
  };
  __syncthreads();
  gload(kstA, vstA, 0);
  gload(kstB, vstB, 1);
  f32x16 sa0, sa1, sb0, sb1;
#pragma unroll
  for (int e = 0; e < 16; ++e) { sa0[e] = 0.f; sa1[e] = 0.f; }
  {
    const u16* kr = Kp + (size_t)r * DQK + 8 * h;
#pragma unroll
    for (int ks = 0; ks < NKS; ++ks) {
      bf16x8 a0 = *(const bf16x8*)(kr + 16 * ks), a1 = *(const bf16x8*)(kr + 32 * DQK + 16 * ks);
      sa0 = MFMA32(a0, qf[ks], sa0); sa1 = MFMA32(a1, qf[ks], sa1);
    }
  }
  lstore(kstA, vstA, L0);
  gload(kstA, vstA, 2);
  __syncthreads();
  const int qmin = q0 + 32 * w;
  const int qi = qmin + r;
  auto body = [&](int kt, u32x4* wk, u32x4* wv, f32x16& s0, f32x16& s1, f32x16& n0, f32x16& n1) {
    const u16* Ks = L0 + (kt & 1) * BUFE;
    const u16* Vs = Ks + 64 * KLD;
    u16* Ln = L0 + ((kt + 1) & 1) * BUFE;
    const bool active = !(kt * 64 > qmin + 31);
    if (kt * 64 + 63 > qmin) {
#pragma unroll
      for (int e = 0; e < 16; ++e) {
        int key = kt * 64 + crow(e, h);
        if (key > qi) s0[e] = -INFINITY;
        if (key + 32 > qi) s1[e] = -INFINITY;
      }
    }
    float mx = fmaxf(s0[0], s1[0]);
#pragma unroll
    for (int e = 1; e < 16; ++e) mx = fmaxf(fmaxf(mx, s0[e]), s1[e]);
    mx = fmaxf(mx, __shfl_xor(mx, 32));
    if (__builtin_amdgcn_ballot_w64((mx - m) * c > 8.f) != 0ull) {
      const float mn = fmaxf(m, mx);
      const float alpha = ex2((m - mn) * c);
      m = mn;
      l *= alpha;
#pragma unroll
      for (int dt = 0; dt < 4; ++dt)
#pragma unroll
        for (int e = 0; e < 16; ++e) o[dt][e] *= alpha;
    }
    const float mc = m * c;
#pragma unroll
    for (int e = 0; e < 16; ++e) { n0[e] = 0.f; n1[e] = 0.f; }
    const u16* k0 = Ks + r * KLD + 8 * h;
    bf16x8 ka[2][2];
    ka[0][0] = *(const bf16x8*)(k0); ka[0][1] = *(const bf16x8*)(k0 + 32 * KLD);
    bf16x8 pf[4];
    u32x4 pk[4];
    float __attribute__((ext_vector_type(2))) ps2 = {0.f, 0.f};
#pragma unroll
    for (int ks = 0; ks < NKS; ++ks) {
      if (ks + 1 < NKS) {
        ka[(ks + 1) & 1][0] = *(const bf16x8*)(k0 + 16 * (ks + 1));
        ka[(ks + 1) & 1][1] = *(const bf16x8*)(k0 + 32 * KLD + 16 * (ks + 1));
      }
      __builtin_amdgcn_sched_barrier(0);
      n0 = MFMA32(ka[ks & 1][0], qf[ks], n0); n1 = MFMA32(ka[ks & 1][1], qf[ks], n1);
      if (ks < 8) {
        typedef float f2v __attribute__((ext_vector_type(2)));
        const f2v c2 = {c, c}, nmc2 = {-mc, -mc};
#pragma unroll
        for (int e2 = 0; e2 < 2; ++e2) {
          const int e = (4 * ks + 2 * e2) & 15;
          if (ks < 4) {
            f2v t = {s0[e], s0[e + 1]}; t = __builtin_elementwise_fma(t, c2, nmc2);
            t.x = ex2(t.x); t.y = ex2(t.y); s0[e] = t.x; s0[e + 1] = t.y; ps2 += t;
          } else {
            f2v t = {s1[e], s1[e + 1]}; t = __builtin_elementwise_fma(t, c2, nmc2);
            t.x = ex2(t.x); t.y = ex2(t.y); s1[e] = t.x; s1[e + 1] = t.y; ps2 += t;
          }
        }
      }
      if (ks == 4)  { pk[0].x = pack2(s0[0], s0[1]);  pk[0].y = pack2(s0[2], s0[3]);   pk[0].z = pack2(s0[4], s0[5]);   pk[0].w = pack2(s0[6], s0[7]); }
      if (ks == 5)  { pk[1].x = pack2(s0[8], s0[9]);  pk[1].y = pack2(s0[10], s0[11]); pk[1].z = pack2(s0[12], s0[13]); pk[1].w = pack2(s0[14], s0[15]); }
      if (ks == 8)  { pk[2].x = pack2(s1[0], s1[1]);  pk[2].y = pack2(s1[2], s1[3]);   pk[2].z = pack2(s1[4], s1[5]);   pk[2].w = pack2(s1[6], s1[7]); }
      if (ks == 9)  { pk[3].x = pack2(s1[8], s1[9]);  pk[3].y = pack2(s1[10], s1[11]); pk[3].z = pack2(s1[12], s1[13]); pk[3].w = pack2(s1[14], s1[15]); }
      __builtin_amdgcn_sched_barrier(0);
    }
    l += ps2.x + ps2.y;
#pragma unroll
    for (int i = 0; i < 4; ++i) pf[i] = __builtin_bit_cast(bf16x8, pk[i]);
    if (active) {
      const u16* v0 = Vs + r * 72 + 8 * h;
      bf16x8 va[2][4];
#pragma unroll
      for (int dt = 0; dt < 4; ++dt) va[0][dt] = *(const bf16x8*)(v0 + (32 * dt) * 72);
#pragma unroll
      for (int kk = 0; kk < 4; ++kk) {
        if (kk < 3) {
#pragma unroll
          for (int dt = 0; dt < 4; ++dt) va[(kk + 1) & 1][dt] = *(const bf16x8*)(v0 + (32 * dt) * 72 + 16 * (kk + 1));
        }
        __builtin_amdgcn_sched_barrier(0);
#pragma unroll
        for (int dt = 0; dt < 4; ++dt) o[dt] = MFMA32(va[kk & 1][dt], pf[kk], o[dt]);
        if (kk == 0) lstore(wk, wv, Ln);
        if (kk == 1) gload(wk, wv, kt + 3);
        __builtin_amdgcn_sched_barrier(0);
      }
    } else {
      lstore(wk, wv, Ln);
      gload(wk, wv, kt + 3);
    }
    __syncthreads();
  };
  for (int kt4 = 0; kt4 < nktp; kt4 += 4) {
    body(kt4 + 0, kstB, vstB, sa0, sa1, sb0, sb1); body(kt4 + 1, kstA, vstA, sb0, sb1, sa0, sa1);
    body(kt4 + 2, kstB, vstB, sa0, sa1, sb0, sb1); body(kt4 + 3, kstA, vstA, sb0, sb1, sa0, sa1);
  }
  const float lt = l + __shfl_xor(l, 32);
  const float inv = 1.f / lt;
  if (dry) return;
  u16* yrow = Yp + (size_t)(32 * w + r) * ldy;
#pragma unroll
  for (int dt = 0; dt < 4; ++dt)
#pragma unroll
    for (int g = 0; g < 4; ++g) {
      const int d = 32 * dt + 8 * g + 4 * h;
      uint2 gv = *(const uint2*)(yrow + d);
      float g0 = bf2f(gv.x & 0xffffu), g1 = bf2f(gv.x >> 16), g2 = bf2f(gv.y & 0xffffu), g3 = bf2f(gv.y >> 16);
      uint2 ov;
      ov.x = pack2(o[dt][4 * g] * inv * silu(g0), o[dt][4 * g + 1] * inv * silu(g1));
      ov.y = pack2(o[dt][4 * g + 2] * inv * silu(g2), o[dt][4 * g + 3] * inv * silu(g3));
      *(uint2*)(yrow + d) = ov;
    }
}

DI void memattn_item(const Params& p, int L, int c, int item, char* smem, bool dry) {
  const bool rw = L & 1;
  const int ldu = rw ? LDU_R : LDU_M, oq = rw ? R_QM : M_QM, og = rw ? R_GATE : M_GATE;
  const int tile = item >> 2, xh = item & 3;
  const int b = gtok(rw, c, tile * 128) >> 13;
  u16* U = (u16*)(p.ws + OFF_U);
  const u16* MK = (const u16*)(p.ws + OFF_MEMK) + (size_t)((L * 4 + b) * 4 + xh) * 256 * 128;
  const u16* MV = (const u16*)(p.ws + OFF_MEMVT) + (size_t)((L * 4 + b) * 4 + xh) * 128 * 256;
  attn_item<128>(U + (size_t)tile * 128 * ldu + oq + xh * 128, ldu, MK, MV, 256, 4, 0, false,
                 0.08838834764831845f * 1.4426950408889634f, U + (size_t)tile * 128 * ldu + og + 1536 + xh * 128, ldu, smem, dry);
}

DI void phase_attn(const Params& p, int L, int c, char* smem, int* s_item, bool dry) {
  int* cnt = (int*)(p.ws + OFF_CNT) + 64 + ((L * 2 + c) * 2 + (dry ? 1 : 0)) * 16;
  u16* U = (u16*)(p.ws + OFF_U);
  const u16* Q = (const u16*)(p.ws + OFF_Q); const u16* Kb = (const u16*)(p.ws + OFF_K); const u16* Vt = (const u16*)(p.ws + OFF_VT);
  const int xcc = (int)(__builtin_amdgcn_s_getreg((3 << 11) | 20) & 7u);
  for (int k = 0; k < 8; ++k) {
    const int x = (xcc + k) & 7;
    for (;;) {
      __syncthreads();
      if (otid() == 0) *s_item = atomicAdd(cnt + x, 1);
      __syncthreads();
      const int item = *s_item;
      if (item >= 192) break;
      const int qt = 63 - (item & 63), bh = 3 * x + (item >> 6);
      const int lb = bh / 12, head = bh - lb * 12;
      const int q0 = qt * 128;
      attn_item_c<192>(Q + ((size_t)(lb * 12 + head) * 8192 + q0) * 192, 192, Kb + (size_t)(lb * 12 + head) * 8192 * 192,
                     Vt + (size_t)(lb * 12 + head) * 128 * 8192, 8192, 2 * (qt + 1), q0,
                     0.07216878364870323f * 1.4426950408889634f,
                     U + (size_t)(lb * 8192 + q0) * LDU_M + M_GATE + head * 128, LDU_M, smem, dry);
    }
  }
  for (;;) {
    __syncthreads();
    if (otid() == 0) *s_item = atomicAdd(cnt + 8, 1);
    __syncthreads();
    const int item = *s_item;
    if (item >= 512) break;
    memattn_item(p, L, c, item, smem, dry);
  }
}

DI void scan_item(const Params& p, int L, int c, int item, char* smem, bool dry) {
  const int tid = otid(), w = tid >> 6, lane = tid & 63, r = lane & 31, h = lane >> 5;
  const int j = L >> 1;
  const int b = item / 48, rem = item - b * 48, head = rem >> 1, half = rem & 1;
  float* PAb  = (float*)smem;
  float* Vstb = PAb + 2 * 10240;
  float* Ystb = Vstb + 3 * 1024;
  float* PRM  = Ystb + 2 * 1024;
  float* BONb = PRM + 10 * 64;
  u16* A1  = (u16*)(BONb + 96);
  u16* W2t = A1 + 2 * 32 * 72;
  float* LO  = (float*)(W2t + 2 * 64 * 72);
  const u16* U = (const u16*)(p.ws + OFF_U);
  const u16* BND = (const u16*)(p.ws + OFF_BND);
  u16* YR = (u16*)(p.ws + OFF_YR); u16* BV = (u16*)(p.ws + OFF_BV);
  float* ST = (float*)(p.ws + OFF_ST);
  float* STATE = (float*)(p.ws + OFF_STATE);
  __syncthreads();
  if (tid < 64) {
    const float* mu = p.mu + j * SHIFTW;
    const int hc = head * 64 + tid;
    PRM[0 * 64 + tid] = mu[R_R + hc]; PRM[1 * 64 + tid] = mu[R_K + hc]; PRM[2 * 64 + tid] = mu[R_WD + tid]; PRM[3 * 64 + tid] = mu[R_AD + tid];
    PRM[4 * 64 + tid] = p.w0[j * 1536 + hc]; PRM[5 * 64 + tid] = p.a0[j * 1536 + hc]; PRM[6 * 64 + tid] = p.k_k[j * 1536 + hc];
    PRM[7 * 64 + tid] = p.k_a[j * 1536 + hc]; PRM[8 * 64 + tid] = p.r_k[j * 1536 + hc];
    PRM[9 * 64 + tid] = (tid < 32) ? mu[R_V + head * 64 + 32 * half + tid] : 0.f;
  }
  for (int e = tid; e < 8192; e += 256) {
    int arr = e >> 12, jj = (e >> 6) & 63, cc = e & 63;
    const float* src = (arr ? p.a2 : p.w2) + (size_t)j * 64 * 1536;
    W2t[(arr * 64 + cc) * 72 + jj] = f2bf(src[jj * 1536 + head * 64 + cc]);
  }
  const int rowl = lane >> 3, ks = lane & 7, row32 = 8 * w + rowl;
  float S[8];
  {
    float* sp = STATE + ((size_t)((b * 24 + head) * 64 + 32 * half + row32)) * 64 + 8 * ks;
#pragma unroll
    for (int i = 0; i < 8; ++i) S[i] = (c == 0) ? 0.f : sp[i];
  }
  const int tt = tid >> 3, cs = tid & 7, c4 = cs & 3;
  uint4 Rr_c, Rr_p, Rk_c, Rk_p, Rw_c, Rw_p, Ra_c, Ra_p, Rv_c, Rv_p;
  const uint4 zero4 = {0u, 0u, 0u, 0u};
  auto load_raw = [&](int tc) {
    const int lr = b * 4096 + tc * 32 + tt;
    const int s = c * 4096 + tc * 32 + tt;
    const u16* cur = U + (size_t)lr * LDU_R;
    const u16* prv = (s == 0) ? (BND + (size_t)4 * SHIFTW) : ((s == 4096 && c == 1) ? (BND + (size_t)b * SHIFTW) : (cur - LDU_R));
    Rr_c = *(const uint4*)(cur + R_R + head * 64 + cs * 8);  Rr_p = *(const uint4*)(prv + R_R + head * 64 + cs * 8);
    Rk_c = *(const uint4*)(cur + R_K + head * 64 + cs * 8);  Rk_p = *(const uint4*)(prv + R_K + head * 64 + cs * 8);
    Rw_c = *(const uint4*)(cur + R_WD + cs * 8);             Rw_p = *(const uint4*)(prv + R_WD + cs * 8);
    Ra_c = *(const uint4*)(cur + R_AD + cs * 8);             Ra_p = *(const uint4*)(prv + R_AD + cs * 8);
    const int vo = R_V + head * 64 + 32 * half + c4 * 8;
    Rv_c = *(const uint4*)(cur + vo);                        Rv_p = *(const uint4*)(prv + vo);
  };
  uint4 d_y = zero4, d_v = zero4; float d_sm = 0.f, d_sq = 0.f; int d_lr = -1;
  auto flush_out = [&]() {
    if (cs < 4 && !dry && d_lr >= 0) {
      const size_t o = (size_t)d_lr * 1536 + head * 64 + 32 * half + cs * 8;
      *(uint4*)(YR + o) = d_y;
      *(uint4*)(BV + o) = d_v;
      if (cs == 0) {
        float* stp = ST + ((size_t)(d_lr * 24 + head) * 2 + half) * 2;
        stp[0] = d_sm; stp[1] = d_sq;
      }
    }
  };
  float rm[8], km[8];
  auto prep1 = [&](float* Vst) {
    float cu[8], pv[8], t8[8];
    unpack8(Rr_c, cu); unpack8(Rr_p, pv);
#pragma unroll
    for (int e = 0; e < 8; ++e) rm[e] = cu[e] + (pv[e] - cu[e]) * PRM[0 * 64 + cs * 8 + e];
    unpack8(Rk_c, cu); unpack8(Rk_p, pv);
#pragma unroll
    for (int e = 0; e < 8; ++e) km[e] = cu[e] + (pv[e] - cu[e]) * PRM[1 * 64 + cs * 8 + e];
    unpack8(Rw_c, cu); unpack8(Rw_p, pv);
#pragma unroll
    for (int e = 0; e < 8; ++e) {
      float xw = cu[e] + (pv[e] - cu[e]) * PRM[2 * 64 + cs * 8 + e];
      float ee = ex2(xw * 2.8853900817779268f);
      t8[e] = 1.f - 2.f * frcp(ee + 1.f);
    }
    *(uint4*)(A1 + (0 * 32 + tt) * 72 + cs * 8) = pack8(t8);
    unpack8(Ra_c, cu); unpack8(Ra_p, pv);
#pragma unroll
    for (int e = 0; e < 8; ++e) t8[e] = cu[e] + (pv[e] - cu[e]) * PRM[3 * 64 + cs * 8 + e];
    *(uint4*)(A1 + (1 * 32 + tt) * 72 + cs * 8) = pack8(t8);
    unpack8(Rv_c, cu); unpack8(Rv_p, pv);
    float v8[8];
#pragma unroll
    for (int e = 0; e < 8; ++e) v8[e] = cu[e] + (pv[e] - cu[e]) * PRM[9 * 64 + c4 * 8 + e];
    *(float4*)(Vst + tt * 32 + c4 * 8) = make_float4(v8[0], v8[1], v8[2], v8[3]);
    *(float4*)(Vst + tt * 32 + c4 * 8 + 4) = make_float4(v8[4], v8[5], v8[6], v8[7]);
  };
  auto prep3 = [&]() {
    const int arr = w >> 1, nt = w & 1;
    f32x16 acc;
#pragma unroll
    for (int e = 0; e < 16; ++e) acc[e] = 0.f;
#pragma unroll
    for (int k4 = 0; k4 < 4; ++k4) {
      bf16x8 a = *(const bf16x8*)(A1 + (arr * 32 + r) * 72 + 16 * k4 + 8 * h);
      bf16x8 bw = *(const bf16x8*)(W2t + (arr * 64 + 32 * nt + r) * 72 + 16 * k4 + 8 * h);
      acc = MFMA32(a, bw, acc);
    }
#pragma unroll
    for (int e = 0; e < 16; ++e) LO[(arr * 32 + crow(e, h)) * 64 + 32 * nt + r] = acc[e];
  };
  auto prep4 = [&](float* PA, float* BON) {
    float lw[8], la[8];
    {
      float4 t0 = *(const float4*)(LO + (0 * 32 + tt) * 64 + cs * 8), t1 = *(const float4*)(LO + (0 * 32 + tt) * 64 + cs * 8 + 4);
      lw[0] = t0.x; lw[1] = t0.y; lw[2] = t0.z; lw[3] = t0.w; lw[4] = t1.x; lw[5] = t1.y; lw[6] = t1.z; lw[7] = t1.w;
      t0 = *(const float4*)(LO + (1 * 32 + tt) * 64 + cs * 8); t1 = *(const float4*)(LO + (1 * 32 + tt) * 64 + cs * 8 + 4);
      la[0] = t0.x; la[1] = t0.y; la[2] = t0.z; la[3] = t0.w; la[4] = t1.x; la[5] = t1.y; la[6] = t1.z; la[7] = t1.w;
    }
    float dec[8], kk[8], av[8], kp[8];
    float ssq = 0.f, bon = 0.f;
#pragma unroll
    for (int e = 0; e < 8; ++e) {
      const int ch = cs * 8 + e;
      const float sg = frcp(1.f + fexp(-(lw[e] + PRM[4 * 64 + ch])));
      dec[e] = ex2(-0.8750340f * sg);
      float a = frcp(1.f + fexp(-(la[e] + PRM[5 * 64 + ch])));
      av[e] = a;
      kk[e] = km[e] * PRM[6 * 64 + ch];
      ssq += kk[e] * kk[e];
      kp[e] = km[e] * (1.f + (a - 1.f) * PRM[7 * 64 + ch]);
      bon += rm[e] * kp[e] * PRM[8 * 64 + ch];
    }
    ssq = red8(ssq); bon = red8(bon);
    const float inv = 1.f / fmaxf(sqrtf(ssq), 1e-12f);
    float nk[8], bb[8];
#pragma unroll
    for (int e = 0; e < 8; ++e) { float kn = kk[e] * inv; nk[e] = -kn; bb[e] = kn * av[e]; }
    float* pa = PA + tt * 320 + cs * 8;
    *(float4*)(pa) = make_float4(dec[0], dec[1], dec[2], dec[3]); *(float4*)(pa + 4) = make_float4(dec[4], dec[5], dec[6], dec[7]);
    *(float4*)(pa + 64) = make_float4(nk[0], nk[1], nk[2], nk[3]); *(float4*)(pa + 68) = make_float4(nk[4], nk[5], nk[6], nk[7]);
    *(float4*)(pa + 128) = make_float4(bb[0], bb[1], bb[2], bb[3]); *(float4*)(pa + 132) = make_float4(bb[4], bb[5], bb[6], bb[7]);
    *(float4*)(pa + 192) = make_float4(kp[0], kp[1], kp[2], kp[3]); *(float4*)(pa + 196) = make_float4(kp[4], kp[5], kp[6], kp[7]);
    *(float4*)(pa + 256) = make_float4(rm[0], rm[1], rm[2], rm[3]); *(float4*)(pa + 260) = make_float4(rm[4], rm[5], rm[6], rm[7]);
    BON[tt] = bon;
  };
  float4 d0, d1, n0, n1, b0, b1, k0, k1, r0, r1; float vv;
  auto step_load = [&](const float* PA, const float* Vst, int t) {
    const float* pa = PA + t * 320 + ks * 8;
    d0 = *(const float4*)(pa); d1 = *(const float4*)(pa + 4);
    n0 = *(const float4*)(pa + 64); n1 = *(const float4*)(pa + 68);
    b0 = *(const float4*)(pa + 128); b1 = *(const float4*)(pa + 132);
    k0 = *(const float4*)(pa + 192); k1 = *(const float4*)(pa + 196);
    r0 = *(const float4*)(pa + 256); r1 = *(const float4*)(pa + 260);
    vv = Vst[t * 32 + row32];
  };
  auto steps8 = [&](const float* PA, const float* Vst, float* Yst, int t0) {
#pragma unroll
    for (int t8 = 0; t8 < 8; ++t8) {
      const int t = t0 + t8;
      const float* pa = PA + (t + 1) * 320 + ks * 8;
      const float4 xd0 = *(const float4*)(pa), xd1 = *(const float4*)(pa + 4);
      const float4 xn0 = *(const float4*)(pa + 64), xn1 = *(const float4*)(pa + 68);
      const float4 xb0 = *(const float4*)(pa + 128), xb1 = *(const float4*)(pa + 132);
      const float4 xk0 = *(const float4*)(pa + 192), xk1 = *(const float4*)(pa + 196);
      const float4 xr0 = *(const float4*)(pa + 256), xr1 = *(const float4*)(pa + 260);
      const float xvv = Vst[(t + 1) * 32 + row32];
      float sa0 = S[0] * n0.x, sa1 = S[1] * n0.y;
      sa0 = fmaf(S[2], n0.z, sa0); sa1 = fmaf(S[3], n0.w, sa1);
      sa0 = fmaf(S[4], n1.x, sa0); sa1 = fmaf(S[5], n1.y, sa1);
      sa0 = fmaf(S[6], n1.z, sa0); sa1 = fmaf(S[7], n1.w, sa1);
      float sa = red8(sa0 + sa1);
      S[0] = fmaf(sa, b0.x, fmaf(S[0], d0.x, vv * k0.x)); S[1] = fmaf(sa, b0.y, fmaf(S[1], d0.y, vv * k0.y));
      S[2] = fmaf(sa, b0.z, fmaf(S[2], d0.z, vv * k0.z)); S[3] = fmaf(sa, b0.w, fmaf(S[3], d0.w, vv * k0.w));
      S[4] = fmaf(sa, b1.x, fmaf(S[4], d1.x, vv * k1.x)); S[5] = fmaf(sa, b1.y, fmaf(S[5], d1.y, vv * k1.y));
      S[6] = fmaf(sa, b1.z, fmaf(S[6], d1.z, vv * k1.z)); S[7] = fmaf(sa, b1.w, fmaf(S[7], d1.w, vv * k1.w));
      float y0 = S[0] * r0.x, y1 = S[1] * r0.y;
      y0 = fmaf(S[2], r0.z, y0); y1 = fmaf(S[3], r0.w, y1);
      y0 = fmaf(S[4], r1.x, y0); y1 = fmaf(S[5], r1.y, y1);
      y0 = fmaf(S[6], r1.z, y0); y1 = fmaf(S[7], r1.w, y1);
      float y = red8(y0 + y1);
      Yst[t * 32 + row32] = y;
      d0 = xd0; d1 = xd1; n0 = xn0; n1 = xn1; b0 = xb0; b1 = xb1; k0 = xk0; k1 = xk1; r0 = xr0; r1 = xr1; vv = xvv;
    }
  };
  load_raw(0);
  prep1(Vstb);
  __syncthreads();
  prep3();
  load_raw(1);
  __syncthreads();
  prep4(PAb, BONb);
  __syncthreads();
  int v3 = 0;
  for (int tc = 0; tc < 128; ++tc) {
    const int lr = b * 4096 + tc * 32 + tt;
    const int v3n = (v3 == 2) ? 0 : v3 + 1;
    float* PAc = PAb + (tc & 1) * 10240;        float* PAn = PAb + ((tc + 1) & 1) * 10240;
    float* Vc = Vstb + v3 * 1024;               float* Vn = Vstb + v3n * 1024;
    float* Bc = BONb + v3 * 32;                 float* Bn = BONb + v3n * 32;
    float* Yc = Ystb + (tc & 1) * 1024;
    step_load(PAc, Vc, 0);
    prep1(Vn);
    steps8(PAc, Vc, Yc, 0);
    __syncthreads();
    prep3();
    steps8(PAc, Vc, Yc, 8);
    __syncthreads();
    prep4(PAn, Bn);
    steps8(PAc, Vc, Yc, 16);
    load_raw(tc + 2);
    flush_out();
    steps8(PAc, Vc, Yc, 24);
    __syncthreads();
    {
      float y8[8], v8[8];
      float4 t0 = *(const float4*)(Yc + tt * 32 + c4 * 8), t1 = *(const float4*)(Yc + tt * 32 + c4 * 8 + 4);
      y8[0] = t0.x; y8[1] = t0.y; y8[2] = t0.z; y8[3] = t0.w; y8[4] = t1.x; y8[5] = t1.y; y8[6] = t1.z; y8[7] = t1.w;
      float sm = 0.f, sq = 0.f;
#pragma unroll
      for (int e = 0; e < 8; ++e) { sm += y8[e]; sq += y8[e] * y8[e]; }
      sm = red4(sm); sq = red4(sq);
      const float bon = Bc[tt];
      t0 = *(const float4*)(Vc + tt * 32 + c4 * 8); t1 = *(const float4*)(Vc + tt * 32 + c4 * 8 + 4);
      v8[0] = t0.x * bon; v8[1] = t0.y * bon; v8[2] = t0.z * bon; v8[3] = t0.w * bon; v8[4] = t1.x * bon; v8[5] = t1.y * bon; v8[6] = t1.z * bon; v8[7] = t1.w * bon;
      d_y = pack8(y8); d_v = pack8(v8); d_sm = sm; d_sq = sq; d_lr = lr;
    }
    v3 = v3n;
  }
  flush_out();
  if (c == 0 && !dry) {
    float* sp = STATE + ((size_t)((b * 24 + head) * 64 + 32 * half + row32)) * 64 + 8 * ks;
#pragma unroll
    for (int i = 0; i < 8; ++i) sp[i] = S[i];
  }
}

DI void phase_scan(const Params& p, int L, int c, char* smem, int* s_item, bool dry) {
  for (int item = blockIdx.x; item < 192; item += gridDim.x) scan_item(p, L, c, item, smem, dry);
  int* cnt = (int*)(p.ws + OFF_CNT) + 64 + ((L * 2 + c) * 2 + (dry ? 1 : 0)) * 16 + 8;
  for (;;) {
    __syncthreads();
    if (otid() == 0) *s_item = atomicAdd(cnt, 1);
    __syncthreads();
    const int item = *s_item;
    if (item >= 512) break;
    memattn_item(p, L, c, item, smem, dry);
  }
}

DI void phase_finalize(const Params& p, int L, int c, bool dry) {
  const int j = L >> 1;
  u16* U = (u16*)(p.ws + OFF_U);
  const u16* YR = (const u16*)(p.ws + OFF_YR); const u16* BV = (const u16*)(p.ws + OFF_BV);
  const float* ST = (const float*)(p.ws + OFF_ST);
  const int G = gridDim.x;
  for (int idx = blockIdx.x * 256 + otid(); idx < TC * 192; idx += G * 256) {
    const int lr = idx / 192, c8 = idx - lr * 192, ch0 = c8 * 8, head = ch0 >> 6;
    const float4 st = *(const float4*)(ST + (size_t)(lr * 24 + head) * 4);
    const float mean = (st.x + st.z) * (1.f / 64.f);
    const float var = (st.y + st.w) * (1.f / 64.f) - mean * mean;
    const float rstd = rsqrtf(fmaxf(var, 0.f) + 64e-5f);
    float y[8], bv[8], g[8], o[8];
    unpack8(*(const uint4*)(YR + (size_t)lr * 1536 + ch0), y);
    unpack8(*(const uint4*)(BV + (size_t)lr * 1536 + ch0), bv);
    u16* gp = U + (size_t)lr * LDU_R + R_GATE + ch0;
    unpack8(*(const uint4*)gp, g);
    const float* gw = p.gn_w + j * 1536 + ch0; const float* gb = p.gn_b + j * 1536 + ch0;
#pragma unroll
    for (int e = 0; e < 8; ++e) o[e] = ((y[e] - mean) * rstd * gw[e] + gb[e] + bv[e]) * silu(g[e]);
    if (!dry) *(uint4*)gp = pack8(o);
  }
  if (c == 0) {
    u16* BND = (u16*)(p.ws + OFF_BND);
    for (int idx = blockIdx.x * 256 + otid(); idx < 4 * (SHIFTW / 8); idx += G * 256) {
      const int b = idx / (SHIFTW / 8), cc = idx - b * (SHIFTW / 8);
      *(uint4*)(BND + (size_t)b * SHIFTW + cc * 8) = *(const uint4*)(U + (size_t)(b * 4096 + 4095) * LDU_R + cc * 8);
    }
  }
}

enum { PH_PREP = 0, PH_NORM, PH_GEMM_IN, PH_KVPREP, PH_GEMM_UP, PH_ATTN, PH_SCAN, PH_FINALIZE, PH_GEMM_OUT, PH_FINAL };
constexpr int NSTEPS = 42;

DI void decode_step(int step, int& ph, int& L, int& c) {
  if (step == 0) { ph = PH_PREP; L = 0; c = 0; return; }
  if (step == NSTEPS - 1) { ph = PH_FINAL; L = 0; c = 0; return; }
  int s = step - 1;
  int pr = s / 20, rem = s - pr * 20;
  if (rem < 11) {
    L = 2 * pr;
    int k;
    if (rem < 6) { c = 0; k = rem; } else { c = 1; k = rem - 5; }
    ph = (k == 0) ? PH_NORM : (k == 1) ? PH_GEMM_IN : (k == 2) ? PH_KVPREP : (k == 3) ? PH_GEMM_UP : (k == 4) ? PH_ATTN : PH_GEMM_OUT;
  } else {
    rem -= 11; L = 2 * pr + 1;
    int k;
    if (rem < 5) { c = 0; k = rem; } else { c = 1; k = rem - 4; }
    ph = (k == 0) ? PH_NORM : (k == 1) ? PH_GEMM_IN : (k == 2) ? PH_SCAN : (k == 3) ? PH_FINALIZE : PH_GEMM_OUT;
  }
}

DI void run_step(const Params& p, int ph, int L, int c, char* smem, int* s_item, bool dry_in, int vt) {
  const bool dry = dry_in && !(HYP5 && (ph == PH_GEMM_IN || ph == PH_GEMM_UP));
  char* ws = p.ws;
  const bool rw = L & 1;
  const int j = L >> 1;
  switch (ph) {
    case PH_PREP: phase_prep(p, smem); break;
    case PH_NORM:
      phase_norm(p, L, c);
      if (L == 0 && c == 0) {
        EpiMemKV epi{(u16*)(ws + OFF_MEMK), (u16*)(ws + OFF_MEMVT), false};
        gemm_phase<2, false, 16>((const u16*)(ws + OFF_MEMH), 1024ull * 1024, 1024, (const u16*)(ws + OFF_WT_MEMKV), 1024ull * 1024, 1024, 4, 4, 8, 4, 1024, smem, epi, vt);
      }
      break;
    case PH_GEMM_IN:
      if (!rw) {
        EpiStoreBf16 epi{(u16*)(ws + OFF_U), LDU_M, LDU_M, dry};
        gemm_phase<2, true, 16>((const u16*)(ws + OFF_H), 0, 1024, (const u16*)(ws + OFF_WT_INMLA) + (size_t)j * 3328 * 1024, 0, 1024, 1, 64, 26, 4, 1024, smem, epi, vt);
      } else {
        EpiStoreBf16 epi{(u16*)(ws + OFF_U), LDU_R, LDU_R, dry};
        gemm_phase<2, true, 16>((const u16*)(ws + OFF_H), 0, 1024, (const u16*)(ws + OFF_WT_INRW) + (size_t)j * 7296 * 1024, 0, 1024, 1, 64, 57, 4, 1024, smem, epi, vt);
      }
      break;
    case PH_KVPREP: phase_kvprep(p, L, c, dry); break;
    case PH_GEMM_UP: {
      EpiUQ e1{(u16*)(ws + OFF_Q), (const float*)(ws + OFF_COS), (const float*)(ws + OFF_SIN), c, dry};
      gemm_phase<2, true, 6>((const u16*)(ws + OFF_U) + M_CQ, 0, LDU_M, (const u16*)(ws + OFF_WT_UQ) + (size_t)j * 2304 * 384, 0, 384, 1, 64, 18, 4, 384, smem, e1, vt);
      EpiUK e2{(u16*)(ws + OFF_K), dry};
      gemm_phase<2, true, 4>((const u16*)(ws + OFF_U) + M_CKV, 0, LDU_M, (const u16*)(ws + OFF_WT_UKV) + (size_t)j * 3072 * 256, 0, 256, 1, 64, 12, 4, 256, smem, e2, vt);
      EpiUV e3{(u16*)(ws + OFF_VT), dry};
      gemm_phase<2, false, 4>((const u16*)(ws + OFF_U) + M_CKV, 0, LDU_M, (const u16*)(ws + OFF_WT_UKV) + (size_t)j * 3072 * 256 + 1536ull * 256, 0, 256, 1, 64, 12, 4, 256, smem, e3, vt);
    } break;
    case PH_ATTN: phase_attn(p, L, c, smem, s_item, dry); break;
    case PH_SCAN: phase_scan(p, L, c, smem, s_item, dry); break;
    case PH_FINALIZE: phase_finalize(p, L, c, dry); break;
    case PH_GEMM_OUT: {
      EpiResid epi{(L == 0) ? p.x : (const float*)p.out, p.out, rw, c, dry};
      gemm_phase<2, true, 32>((const u16*)(ws + OFF_U) + (rw ? R_GATE : M_GATE), 0, rw ? LDU_R : LDU_M, (const u16*)(ws + OFF_WT_OUT) + (size_t)L * 1024 * 2048, 0, 2048,
                 1, 64, 8, 4, 2048, smem, epi, vt);
      if (c == 0 && !dry) phase_norm(p, L, 1);
    } break;
    case PH_FINAL: phase_final_norm(p, dry); break;
  }
}

DI void grid_barrier(unsigned* bar, unsigned& epoch) {
  __syncthreads();
  ++epoch;
  if (threadIdx.x == 0) {
    __builtin_amdgcn_fence(__ATOMIC_RELEASE, "agent");
    asm volatile("s_waitcnt vmcnt(0)" ::: "memory");
    const unsigned target = epoch * gridDim.x;
    __hip_atomic_fetch_add(bar, 1u, __ATOMIC_RELAXED, __HIP_MEMORY_SCOPE_AGENT);
    unsigned spins = 0;
    while (__hip_atomic_load(bar, __ATOMIC_RELAXED, __HIP_MEMORY_SCOPE_AGENT) < target) {
      __builtin_amdgcn_s_sleep(2);
      if (++spins > (1u << 22)) break;
    }
    __builtin_amdgcn_fence(__ATOMIC_ACQUIRE, "agent");
    asm volatile("s_waitcnt vmcnt(0)" ::: "memory");
  }
  __syncthreads();
}

__global__ void __launch_bounds__(256, 1) hybrid_megakernel(Params p, int s_lo, int s_hi, int coop, int probe_mask) {
  __shared__ __attribute__((aligned(16))) char smem[SMEM_BYTES];
  __shared__ int s_item;
  unsigned* bar = (unsigned*)(p.ws + OFF_BAR);
  unsigned epoch = 0;
  if (coop == 2) cg::this_grid().sync();
  __shared__ int s_vt;
  int myx = 0, myrank = 0;
  if (coop && threadIdx.x == 0) {
    myx = (int)(__builtin_amdgcn_s_getreg((3 << 11) | 20) & 7u);
    myrank = (int)__hip_atomic_fetch_add(bar + 16 + myx, 1u, __ATOMIC_RELAXED, __HIP_MEMORY_SCOPE_AGENT);
  }
  int vt = blockIdx.x;
  {
    const int G = gridDim.x, t = blockIdx.x;
    vt = ((G & 7) == 0) ? ((t & 7) * (G >> 3) + (t >> 3)) : t;
  }
  for (int st = s_lo; st < s_hi; ++st) {
    int ph, L, c;
    decode_step(st, ph, L, c);
    for (int rep = ((probe_mask >> ph) & 1) ? 0 : 1; rep < 2; ++rep) {
      run_step(p, ph, L, c, smem, &s_item, rep == 0, vt);
      if (coop && (rep == 0 || st + 1 < s_hi)) grid_barrier(bar, epoch);
      if (coop) for (int xs = 0; xs < EXTRA_SYNCS; ++xs) grid_barrier(bar, epoch);
    }
    if (coop && st == s_lo) {
      if (threadIdx.x == 0) {
        const int G = gridDim.x;
        bool ok = (G & 7) == 0;
        for (int x = 0; x < 8; ++x) ok = ok && ((int)__hip_atomic_load(bar + 16 + x, __ATOMIC_RELAXED, __HIP_MEMORY_SCOPE_AGENT) == (G >> 3));
        s_vt = ok ? (myx * (G >> 3) + myrank) : vt;
      }
      __syncthreads();
      vt = s_vt;
    }
  }
}

extern "C" void kernel_launch(void* const* d_in, const int* in_sizes, int n_in, void* d_out, int out_size, void* d_ws, size_t ws_size,
                              hipStream_t stream) {
  if (ws_size < WS_NEED) { fprintf(stderr, "workspace too small: %zu < %zu\n", ws_size, (size_t)WS_NEED); return; }
  Params p;
  memset(&p, 0, sizeof(p));
  p.x = (const float*)d_in[0]; p.mem = (const float*)d_in[1]; p.pos = (const int*)d_in[2];
  p.norm_g = (const float*)d_in[3]; p.mem_norm_g = (const float*)d_in[4]; p.w_mem_kv = (const float*)d_in[5];
  p.w_in_mla = (const float*)d_in[6]; p.q_norm_g = (const float*)d_in[7]; p.kv_norm_g = (const float*)d_in[8];
  p.w_uq = (const float*)d_in[9]; p.w_ukv = (const float*)d_in[10]; p.w_in_rwkv = (const float*)d_in[11];
  p.mu = (const float*)d_in[12]; p.w0 = (const float*)d_in[13]; p.w2 = (const float*)d_in[14]; p.a0 = (const float*)d_in[15];
  p.a2 = (const float*)d_in[16]; p.k_k = (const float*)d_in[17]; p.k_a = (const float*)d_in[18]; p.r_k = (const float*)d_in[19];
  p.gn_w = (const float*)d_in[20]; p.gn_b = (const float*)d_in[21]; p.w_out = (const float*)d_in[22]; p.final_g = (const float*)d_in[23];
  p.out = (float*)d_out; p.ws = (char*)d_ws;
  static int grid_blocks = 0;
  if (!grid_blocks) {
    int dev = 0, cus = 0, per_cu = 0;
    hipGetDevice(&dev);
    hipDeviceGetAttribute(&cus, hipDeviceAttributeMultiprocessorCount, dev);
    hipOccupancyMaxActiveBlocksPerMultiprocessor(&per_cu, hybrid_megakernel, 256, 0);
    if (per_cu > 2) per_cu = 2;
    if (per_cu < 1) per_cu = 1;
    grid_blocks = cus * per_cu;
  }
#if MULTI_LAUNCH
  for (int s = 0; s < NSTEPS; ++s) hipLaunchKernelGGL(hybrid_megakernel, dim3(grid_blocks), dim3(256), 0, stream, p, s, s + 1, 0, 0);
#else
  int s_lo = 0, s_hi = NSTEPS, coop = 1, probe_mask = PROBE_MASK;
  void* args[] = {&p, &s_lo, &s_hi, &coop, &probe_mask};
  hipMemsetAsync((char*)d_ws + OFF_BAR, 0, 256, stream);
  hipError_t e = hipLaunchCooperativeKernel((void*)hybrid_megakernel, dim3(grid_blocks), dim3(256), args, 0, stream);
  if (e != hipSuccess) fprintf(stderr, "cooperative launch failed: %s (grid %d)\n", hipGetErrorString(e), grid_blocks);
#endif
}
```

```cpp
#include <hip/hip_runtime.h>
#include <hip/hip_cooperative_groups.h>
#include <cstdio>
#include <cstring>
namespace cg = cooperative_groups;

#define PROBE_MASK 0
#define EXTRA_SYNCS 0
#define HYP1 0
#define HYP2 0
#define HYP3 0
#define HYP4 0
#define HYP5 0
#define HYP6 0
#ifndef MULTI_LAUNCH
#define MULTI_LAUNCH 0
#endif

#define DI __device__ __forceinline__
typedef unsigned short u16;
typedef __attribute__((ext_vector_type(8))) short bf16x8;
typedef __attribute__((ext_vector_type(16))) float f32x16;
typedef __attribute__((ext_vector_type(2))) __bf16 bf2_t;
typedef __attribute__((ext_vector_type(2))) float f2_t;
typedef __attribute__((ext_vector_type(4))) unsigned u32x4;
typedef __attribute__((ext_vector_type(2))) unsigned u32x2;
#define MFMA32(a, b, c) __builtin_amdgcn_mfma_f32_32x32x16_bf16((a), (b), (c), 0, 0, 0)

constexpr int SEQ = 8192, TC = 16384;
constexpr int LDU_M = 3264, LDU_R = 7296;
constexpr int M_CQ = 0, M_CKV = 384, M_KR = 640, M_QM = 704, M_GATE = 1216;
constexpr int R_R = 0, R_K = 1536, R_V = 3072, R_WD = 4608, R_AD = 4672, R_QM = 4736, R_GATE = 5248;
constexpr int SHIFTW = 4736;

constexpr size_t OFF_WT_MEMKV = 0;
constexpr size_t OFF_WT_INMLA = OFF_WT_MEMKV + 4ull * 1024 * 1024 * 2;
constexpr size_t OFF_WT_UQ    = OFF_WT_INMLA + 2ull * 3328 * 1024 * 2;
constexpr size_t OFF_WT_UKV   = OFF_WT_UQ + 2ull * 2304 * 384 * 2;
constexpr size_t OFF_WT_INRW  = OFF_WT_UKV + 2ull * 3072 * 256 * 2;
constexpr size_t OFF_WT_OUT   = OFF_WT_INRW + 2ull * 7296 * 1024 * 2;
constexpr size_t OFF_MEMH     = OFF_WT_OUT + 4ull * 1024 * 2048 * 2;
constexpr size_t OFF_MEMK     = OFF_MEMH + 4ull * 1024 * 1024 * 2;
constexpr size_t OFF_MEMVT    = OFF_MEMK + 4ull * 4 * 4 * 256 * 128 * 2;
constexpr size_t OFF_COS      = OFF_MEMVT + 4ull * 4 * 4 * 256 * 128 * 2;
constexpr size_t OFF_SIN      = OFF_COS + 32768ull * 32 * 4;
constexpr size_t OFF_CNT      = OFF_SIN + 32768ull * 32 * 4;
constexpr size_t OFF_BAR      = OFF_CNT + 4096;
constexpr size_t OFF_STATE    = OFF_BAR + 256;
constexpr size_t OFF_BND      = OFF_STATE + 96ull * 4096 * 4;
constexpr size_t OFF_H        = OFF_BND + 5ull * 4736 * 2 + 128;
constexpr size_t OFF_R        = OFF_H + 16384ull * 1024 * 2;
constexpr size_t OFF_U        = OFF_R;
constexpr size_t OFF_Q        = OFF_R + 16384ull * 3264 * 2;
constexpr size_t OFF_K        = OFF_Q + 2ull * 12 * 8192 * 192 * 2;
constexpr size_t OFF_VT       = OFF_K + 2ull * 12 * 8192 * 192 * 2;
constexpr size_t OFF_YR       = OFF_R + 16384ull * 7296 * 2;
constexpr size_t OFF_BV       = OFF_YR + 16384ull * 1536 * 2;
constexpr size_t OFF_ST       = OFF_BV + 16384ull * 1536 * 2;
constexpr size_t OFF_BS       = OFF_ST + 16384ull * 24 * 4 * 4;
constexpr size_t WS_NEED      = OFF_BS + 16384ull * 24 * 4;

constexpr int SMEM_BYTES = 149504;

struct Params {
  const float *x, *mem; const int* pos;
  const float *norm_g, *mem_norm_g, *w_mem_kv, *w_in_mla, *q_norm_g, *kv_norm_g, *w_uq, *w_ukv, *w_in_rwkv;
  const float *mu, *w0, *w2, *a0, *a2, *k_k, *k_a, *r_k, *gn_w, *gn_b, *w_out, *final_g;
  float* out; char* ws;
};

DI int otid() { int t = threadIdx.x; asm volatile("" : "+v"(t)); return t; }
DI float bf2f(unsigned v) { return __uint_as_float(v << 16); }
DI unsigned pack2(float a, float b) { f2_t v = {a, b}; bf2_t r = __builtin_convertvector(v, bf2_t); return __builtin_bit_cast(unsigned, r); }
DI u16 f2bf(float a) { return (u16)(pack2(a, 0.f) & 0xffffu); }
DI float ex2(float x) { return __builtin_amdgcn_exp2f(x); }
DI float fexp(float x) { return __builtin_amdgcn_exp2f(x * 1.4426950408889634f); }
DI float frcp(float x) { return __builtin_amdgcn_rcpf(x); }
DI float silu(float g) { return g * frcp(1.f + fexp(-g)); }
DI float wave_sum(float v) { for (int o = 32; o > 0; o >>= 1) v += __shfl_xor(v, o); return v; }
DI int crow(int reg, int h) { return (reg & 3) + 8 * (reg >> 2) + 4 * h; }
DI float dppf(float x, const int ctrl_sel) {
  int xi;
  if (ctrl_sel == 0) xi = __builtin_amdgcn_update_dpp(0, __float_as_int(x), 0xB1, 0xf, 0xf, true);
  else if (ctrl_sel == 1) xi = __builtin_amdgcn_update_dpp(0, __float_as_int(x), 0x4E, 0xf, 0xf, true);
  else xi = __builtin_amdgcn_update_dpp(0, __float_as_int(x), 0x141, 0xf, 0xf, true);
  return __int_as_float(xi);
}
DI float red4(float x) { x += dppf(x, 0); x += dppf(x, 1); return x; }
DI float red8(float x) { x += dppf(x, 0); x += dppf(x, 1); x += dppf(x, 2); return x; }
DI int gtok(bool rw, int c, int lr) { return rw ? ((lr >> 12) * 8192 + c * 4096 + (lr & 4095)) : (c * 16384 + lr); }
DI void unpack8(const uint4& v, float* f) {
  f[0] = bf2f(v.x & 0xffffu); f[1] = bf2f(v.x >> 16); f[2] = bf2f(v.y & 0xffffu); f[3] = bf2f(v.y >> 16);
  f[4] = bf2f(v.z & 0xffffu); f[5] = bf2f(v.z >> 16); f[6] = bf2f(v.w & 0xffffu); f[7] = bf2f(v.w >> 16);
}
DI uint4 pack8(const float* f) { uint4 v; v.x = pack2(f[0], f[1]); v.y = pack2(f[2], f[3]); v.z = pack2(f[4], f[5]); v.w = pack2(f[6], f[7]); return v; }

DI void transpose_tile(const float* __restrict__ src, u16* __restrict__ dst, int K, int N, int tk, int tn, int drow, float* tile) {
  const int tid = otid();
  __syncthreads();
#pragma unroll
  for (int i = 0; i < 4; ++i) {
    int kr = (tid >> 4) + 16 * i, nc = (tid & 15) * 4;
    float4 v = *(const float4*)(src + (size_t)(tk * 64 + kr) * N + tn * 64 + nc);
    tile[kr * 65 + nc] = v.x; tile[kr * 65 + nc + 1] = v.y; tile[kr * 65 + nc + 2] = v.z; tile[kr * 65 + nc + 3] = v.w;
  }
  __syncthreads();
#pragma unroll
  for (int i = 0; i < 2; ++i) {
    int n = (tid >> 3) + 32 * i, kc = (tid & 7) * 8;
    float f[8];
#pragma unroll
    for (int e = 0; e < 8; ++e) f[e] = tile[(kc + e) * 65 + n];
    *(uint4*)(dst + (size_t)(drow + n) * K + tk * 64 + kc) = pack8(f);
  }
}

DI void rms_row_bf16(const float* __restrict__ src, const float* __restrict__ g, u16* __restrict__ dst, int lane) {
  float4 v[4]; float ss = 0.f;
#pragma unroll
  for (int i = 0; i < 4; ++i) { v[i] = *(const float4*)(src + i * 256 + lane * 4); ss += v[i].x * v[i].x + v[i].y * v[i].y + v[i].z * v[i].z + v[i].w * v[i].w; }
  ss = wave_sum(ss);
  float rs = rsqrtf(ss * (1.f / 1024.f) + 1e-6f);
#pragma unroll
  for (int i = 0; i < 4; ++i) {
    float4 gg = *(const float4*)(g + i * 256 + lane * 4);
    uint2 o; o.x = pack2(v[i].x * rs * gg.x, v[i].y * rs * gg.y); o.y = pack2(v[i].z * rs * gg.z, v[i].w * rs * gg.w);
    *(uint2*)(dst + i * 256 + lane * 4) = o;
  }
}

DI void phase_prep(const Params& p, char* smem) {
  const int tid = otid(), G = gridDim.x, bid = blockIdx.x;
  char* ws = p.ws;
  if (bid == 0) for (int i = tid; i < 1024; i += 256) ((int*)(ws + OFF_CNT))[i] = 0;
  float* tile = (float*)smem;
  for (int g0 = bid; g0 < 9168; g0 += G) {
    int g = g0;
    const float* src = nullptr; u16* dst = nullptr; int K = 0, N = 0; size_t dstr = 0; bool ukv = false;
    if (g < 1024) { src = p.w_mem_kv; dst = (u16*)(ws + OFF_WT_MEMKV); K = 1024; N = 1024; dstr = 1024ull * 1024; }
    else if ((g -= 1024) < 1632) { src = p.w_in_mla; dst = (u16*)(ws + OFF_WT_INMLA); K = 1024; N = 3264; dstr = 3328ull * 1024; }
    else if ((g -= 1632) < 432) { src = p.w_uq; dst = (u16*)(ws + OFF_WT_UQ); K = 384; N = 2304; dstr = 2304ull * 384; }
    else if ((g -= 432) < 384) { src = p.w_ukv; dst = (u16*)(ws + OFF_WT_UKV); K = 256; N = 3072; dstr = 3072ull * 256; ukv = true; }
    else if ((g -= 384) < 3648) { src = p.w_in_rwkv; dst = (u16*)(ws + OFF_WT_INRW); K = 1024; N = 7296; dstr = 7296ull * 1024; }
    else { g -= 3648; src = p.w_out; dst = (u16*)(ws + OFF_WT_OUT); K = 2048; N = 1024; dstr = 1024ull * 2048; }
    int ntn = N >> 6, per = (K >> 6) * ntn;
    int m = g / per, t = g - m * per;
    int tk = t / ntn, tn = t - tk * ntn;
    int drow = tn * 64;
    if (ukv) { const int hd = drow >> 8, dd = drow & 255; drow = (dd < 128) ? (hd * 128 + dd) : (1536 + hd * 128 + dd - 128); }
    transpose_tile(src + (size_t)m * K * N, dst + (size_t)m * dstr, K, N, tk, tn, drow, tile);
  }
  for (int i = bid * 256 + tid; i < 2 * 64 * 1024 / 8; i += G * 256) {
    int m = i / (64 * 1024 / 8), r = i - m * (64 * 1024 / 8);
    uint4 z; z.x = z.y = z.z = z.w = 0u;
    *(uint4*)((u16*)(ws + OFF_WT_INMLA) + (size_t)m * 3328 * 1024 + 3264ull * 1024 + (size_t)r * 8) = z;
  }
  for (int i = bid * 256 + tid; i < SHIFTW / 8; i += G * 256) { uint4 z; z.x = z.y = z.z = z.w = 0u; *(uint4*)((u16*)(ws + OFF_BND) + 4 * SHIFTW + i * 8) = z; }
  float* cs = (float*)(ws + OFF_COS); float* sn = (float*)(ws + OFF_SIN);
  for (int i = bid * 256 + tid; i < 32768 * 32; i += G * 256) {
    int tk = i >> 5, pi = i & 31;
    float inv_freq = (float)exp2(-(double)(2 * pi) / 64.0 * 13.287712379549449);
    float ang = (float)p.pos[tk] * inv_freq;
    double rev = (double)ang * 0.15915494309189535;
    float fr = (float)(rev - rint(rev));
    cs[i] = __builtin_amdgcn_cosf(fr); sn[i] = __builtin_amdgcn_sinf(fr);
  }
  const int w = tid >> 6, lane = tid & 63;
  for (int row = bid * 4 + w; row < 4096; row += G * 4) {
    int L = row >> 10, m = row & 1023;
    rms_row_bf16(p.mem + (size_t)m * 1024, p.mem_norm_g + L * 1024, (u16*)(ws + OFF_MEMH) + (size_t)row * 1024, lane);
  }
}

DI void phase_norm(const Params& p, int L, int c) {
  const int tid = otid(), w = tid >> 6, lane = tid & 63;
  const bool rw = L & 1;
  const float* xs = (L == 0) ? p.x : p.out;
  u16* H = (u16*)(p.ws + OFF_H);
  for (int lr = blockIdx.x * 4 + w; lr < TC; lr += gridDim.x * 4) {
    int gt = gtok(rw, c, lr);
    rms_row_bf16(xs + (size_t)gt * 1024, p.norm_g + L * 1024, H + (size_t)lr * 1024, lane);
  }
}

DI void phase_final_norm(const Params& p, bool dry) {
  const int tid = otid(), w = tid >> 6, lane = tid & 63;
  for (int row = blockIdx.x * 4 + w; row < 32768; row += gridDim.x * 4) {
    float* xr = p.out + (size_t)row * 1024;
    float4 v[4]; float ss = 0.f;
#pragma unroll
    for (int i = 0; i < 4; ++i) { v[i] = *(const float4*)(xr + i * 256 + lane * 4); ss += v[i].x * v[i].x + v[i].y * v[i].y + v[i].z * v[i].z + v[i].w * v[i].w; }
    ss = wave_sum(ss);
    float rs = rsqrtf(ss * (1.f / 1024.f) + 1e-6f);
#pragma unroll
    for (int i = 0; i < 4; ++i) {
      float4 gg = *(const float4*)(p.final_g + i * 256 + lane * 4);
      float4 o; o.x = v[i].x * rs * gg.x; o.y = v[i].y * rs * gg.y; o.z = v[i].z * rs * gg.z; o.w = v[i].w * rs * gg.w;
      if (!dry) *(float4*)(xr + i * 256 + lane * 4) = o;
    }
  }
}

template <int TJ, bool SWAP, int NK, class Epi>
DI void gemm_phase(const u16* __restrict__ A, size_t strideAz, int lda, const u16* __restrict__ Bt, size_t strideBz, int ldb,
                   int Z, int Mt, int Nt, int GM, int K, char* smem, const Epi& epi, int vt) {
  constexpr int BN = 64 * TJ;
  constexpr int NB = BN / 32;
  const int tid = otid(), w = tid >> 6, lane = tid & 63, r = lane & 31, h = lane >> 5;
  const int wm = w >> 1, wn = w & 1;
  u16* As = (u16*)smem;
  u16* Bs = As + 2 * 256 * 72;
  const int G = gridDim.x, per = Mt * Nt, total = Z * per;
  const int lrow = tid >> 3, lcc = (tid & 7) * 8;
  unsigned aoff[8], boff[NB];
#pragma unroll
  for (int i = 0; i < 8; ++i) aoff[i] = (unsigned)((lrow + 32 * i) * lda + lcc);
#pragma unroll
  for (int i = 0; i < NB; ++i) boff[i] = (unsigned)((lrow + 32 * i) * ldb + lcc);
  const int lds_st = lrow * 72 + lcc;
  for (int base = 0; base < total; base += G) {
    const int q = base + vt;
    if (q >= total) continue;
    const int z = q / per, qq = q - z * per;
    const int grp = qq / (GM * Nt), within = qq - grp * GM * Nt;
    const int mt = grp * GM + (within % GM), nt = within / GM;
    const u16* Ag = A + z * strideAz + (size_t)(mt * 256) * lda;
    const u16* Bg = Bt + z * strideBz + (size_t)(nt * BN) * ldb;
    u32x4 ra[2][8], rb[2][NB];
    f32x16 acc[4][TJ];
#pragma unroll
    for (int i = 0; i < 4; ++i)
#pragma unroll
      for (int j = 0; j < TJ; ++j)
#pragma unroll
        for (int e = 0; e < 16; ++e) acc[i][j][e] = 0.f;
    __syncthreads();
#pragma unroll
    for (int i = 0; i < 8; ++i) ra[0][i] = *(const u32x4*)(Ag + aoff[i]);
#pragma unroll
    for (int i = 0; i < NB; ++i) rb[0][i] = *(const u32x4*)(Bg + boff[i]);
#pragma unroll
    for (int i = 0; i < 8; ++i) ra[1][i] = *(const u32x4*)(Ag + 64 + aoff[i]);
#pragma unroll
    for (int i = 0; i < NB; ++i) rb[1][i] = *(const u32x4*)(Bg + 64 + boff[i]);
#pragma unroll
    for (int i = 0; i < 8; ++i) *(u32x4*)(As + lds_st + (32 * i) * 72) = ra[0][i];
#pragma unroll
    for (int i = 0; i < NB; ++i) *(u32x4*)(Bs + lds_st + (32 * i) * 72) = rb[0][i];
    __syncthreads();
    bf16x8 af[2][4], bfr[2][TJ];
#pragma unroll
    for (int kt = 0; kt < NK; ++kt) {
      constexpr int dummy = 0; (void)dummy;
      const int u = kt & 1;
      const u16* as = As + u * 256 * 72 + (128 * wm + r) * 72 + 8 * h;
      const u16* bs = Bs + u * BN * 72 + (32 * TJ * wn + r) * 72 + 8 * h;
      if (kt == 0) {
#pragma unroll
        for (int i = 0; i < 4; ++i) af[0][i] = *(const bf16x8*)(as + (32 * i) * 72);
#pragma unroll
        for (int j = 0; j < TJ; ++j) bfr[0][j] = *(const bf16x8*)(bs + (32 * j) * 72);
      }
#pragma unroll
      for (int ks = 0; ks < 4; ++ks) {
        if (ks < 3) {
#pragma unroll
          for (int i = 0; i < 4; ++i) af[(ks + 1) & 1][i] = *(const bf16x8*)(as + (32 * i) * 72 + 16 * (ks + 1));
#pragma unroll
          for (int j = 0; j < TJ; ++j) bfr[(ks + 1) & 1][j] = *(const bf16x8*)(bs + (32 * j) * 72 + 16 * (ks + 1));
        } else if (kt + 1 < NK) {
          const u16* asn = As + (u ^ 1) * 256 * 72 + (128 * wm + r) * 72 + 8 * h;
          const u16* bsn = Bs + (u ^ 1) * BN * 72 + (32 * TJ * wn + r) * 72 + 8 * h;
#pragma unroll
          for (int i = 0; i < 4; ++i) af[0][i] = *(const bf16x8*)(asn + (32 * i) * 72);
#pragma unroll
          for (int j = 0; j < TJ; ++j) bfr[0][j] = *(const bf16x8*)(bsn + (32 * j) * 72);
        }
        __builtin_amdgcn_sched_barrier(0);
#pragma unroll
        for (int i = 0; i < 4; ++i)
#pragma unroll
          for (int j = 0; j < TJ; ++j)
            acc[i][j] = SWAP ? MFMA32(bfr[ks & 1][j], af[ks & 1][i], acc[i][j]) : MFMA32(af[ks & 1][i], bfr[ks & 1][j], acc[i][j]);
        if (ks == 0 && kt + 2 < NK) {
          const u16* ag = Ag + (kt + 2) * 64; const u16* bg = Bg + (kt + 2) * 64;
#pragma unroll
          for (int i = 0; i < 8; ++i) ra[u][i] = *(const u32x4*)(ag + aoff[i]);
#pragma unroll
          for (int i = 0; i < NB; ++i) rb[u][i] = *(const u32x4*)(bg + boff[i]);
#pragma unroll
          for (int i = 0; i < 6; ++i) { __builtin_amdgcn_sched_group_barrier(0x008, 1, 0); __builtin_amdgcn_sched_group_barrier(0x020, 2, 0); }
        }
        if (ks == 1 && kt + 1 < NK) {
          u16* ad = As + (u ^ 1) * 256 * 72 + lds_st; u16* bd = Bs + (u ^ 1) * BN * 72 + lds_st;
#pragma unroll
          for (int i = 0; i < 8; ++i) *(u32x4*)(ad + (32 * i) * 72) = ra[u ^ 1][i];
#pragma unroll
          for (int i = 0; i < NB; ++i) *(u32x4*)(bd + (32 * i) * 72) = rb[u ^ 1][i];
#pragma unroll
          for (int i = 0; i < 6; ++i) { __builtin_amdgcn_sched_group_barrier(0x008, 1, 0); __builtin_amdgcn_sched_group_barrier(0x200, 2, 0); }
        }
        __builtin_amdgcn_sched_barrier(0);
        if (ks == 2) __syncthreads();
      }
    }
#pragma unroll
    for (int i = 0; i < 4; ++i)
#pragma unroll
      for (int j = 0; j < TJ; ++j) {
        if (SWAP) epi(z, mt * 256 + 128 * wm + 32 * i + r, nt * BN + 32 * TJ * wn + 32 * j, h, acc[i][j]);
        else epi(z, mt * 256 + 128 * wm + 32 * i, nt * BN + 32 * TJ * wn + 32 * j + r, h, acc[i][j]);
      }
  }
}

struct EpiStoreBf16 {
  u16* C; int ldc; int ncols; bool dry;
  DI void operator()(int z, int row, int colbase, int h, const f32x16& a) const {
    if (dry) return;
#pragma unroll
    for (int g = 0; g < 4; ++g) {
      const int col = colbase + 8 * g + 4 * h;
      if (col < ncols) {
        u32x2 pk = {pack2(a[4 * g], a[4 * g + 1]), pack2(a[4 * g + 2], a[4 * g + 3])};
        *(u32x2*)(C + (size_t)row * ldc + col) = pk;
      }
    }
  }
};
struct EpiResid {
  const float* xin; float* xout; bool rw; int c; bool dry;
  DI void operator()(int z, int row, int colbase, int h, const f32x16& a) const {
    if (dry) return;
    const size_t o = (size_t)gtok(rw, c, row) * 1024 + colbase + 4 * h;
#pragma unroll
    for (int g = 0; g < 4; ++g) {
      float4 v = *(const float4*)(xin + o + 8 * g);
      v.x += a[4 * g]; v.y += a[4 * g + 1]; v.z += a[4 * g + 2]; v.w += a[4 * g + 3];
      *(float4*)(xout + o + 8 * g) = v;
    }
  }
};
struct EpiUQ {
  u16* Q; const float* cs; const float* sn; int c; bool dry;
  DI void operator()(int z, int row, int colbase, int h, const f32x16& a) const {
    if (dry) return;
    const int head = colbase / 192, db = colbase - head * 192;
    const int lb = row >> 13, s = row & 8191;
    u16* qp = Q + ((size_t)(lb * 12 + head) * 8192 + s) * 192 + db + 4 * h;
    const size_t ti = (size_t)(c * 16384 + row) * 32;
#pragma unroll
    for (int g = 0; g < 4; ++g) {
      float v0 = a[4 * g], v1 = a[4 * g + 1], v2 = a[4 * g + 2], v3 = a[4 * g + 3];
      if (db >= 128) {
        const int pi = (db - 128 + 8 * g + 4 * h) >> 1;
        const float2 cc = *(const float2*)(cs + ti + pi), ss = *(const float2*)(sn + ti + pi);
        const float o0 = v0 * cc.x - v1 * ss.x, o1 = v0 * ss.x + v1 * cc.x;
        const float o2 = v2 * cc.y - v3 * ss.y, o3 = v2 * ss.y + v3 * cc.y;
        v0 = o0; v1 = o1; v2 = o2; v3 = o3;
      }
      u32x2 pk = {pack2(v0, v1), pack2(v2, v3)};
      *(u32x2*)(qp + 8 * g) = pk;
    }
  }
};
struct EpiUK {
  u16* Kb; bool dry;
  DI void operator()(int z, int row, int colbase, int h, const f32x16& a) const {
    if (dry) return;
    const int head = colbase >> 7, db = colbase & 127;
    const int lb = row >> 13, s = row & 8191;
    u16* kp = Kb + ((size_t)(lb * 12 + head) * 8192 + s) * 192 + db + 4 * h;
#pragma unroll
    for (int g = 0; g < 4; ++g) {
      u32x2 pk = {pack2(a[4 * g], a[4 * g + 1]), pack2(a[4 * g + 2], a[4 * g + 3])};
      *(u32x2*)(kp + 8 * g) = pk;
    }
  }
};
struct EpiUV {
  u16* Vt; bool dry;
  DI void operator()(int z, int rowbase, int col, int h, const f32x16& a) const {
    if (dry) return;
    const int head = col >> 7, d = col & 127;
#pragma unroll
    for (int g = 0; g < 4; ++g) {
      int lr = rowbase + 8 * g + 4 * h; int lb = lr >> 13, s = lr & 8191;
      u32x2 pk = {pack2(a[4 * g], a[4 * g + 1]), pack2(a[4 * g + 2], a[4 * g + 3])};
      *(u32x2*)(Vt + (((size_t)(lb * 12 + head) * 128 + (s >> 6)) * 128 + d) * 64 + (s & 63)) = pk;
    }
  }
};
struct EpiMemKV {
  u16* MK; u16* MVt; bool dry;
  DI void operator()(int z, int rowbase, int col, int h, const f32x16& a) const {
    if (col < 512) {
      const int xh = col >> 7, d = col & 127;
#pragma unroll
      for (int e = 0; e < 16; ++e) {
        int m = rowbase + crow(e, h); int b = m >> 8, mi = m & 255;
        MK[((size_t)((z * 4 + b) * 4 + xh) * 256 + mi) * 128 + d] = f2bf(a[e]);
      }
    } else {
      const int n = col - 512, xh = n >> 7, d = n & 127;
#pragma unroll
      for (int g = 0; g < 4; ++g) {
        int m = rowbase + 8 * g + 4 * h; int b = m >> 8, mi = m & 255;
        uint2 pk; pk.x = pack2(a[4 * g], a[4 * g + 1]); pk.y = pack2(a[4 * g + 2], a[4 * g + 3]);
        *(uint2*)(MVt + (((size_t)((z * 4 + b) * 4 + xh) * 4 + (mi >> 6)) * 128 + d) * 64 + (mi & 63)) = pk;
      }
    }
  }
};

DI void phase_kvprep(const Params& p, int L, int c, bool dry) {
  const int tid = otid(), w = tid >> 6, lane = tid & 63;
  const int j = L >> 1;
  u16* U = (u16*)(p.ws + OFF_U); u16* Kb = (u16*)(p.ws + OFF_K);
  const float* cs = (const float*)(p.ws + OFF_COS); const float* sn = (const float*)(p.ws + OFF_SIN);
  for (int lr = blockIdx.x * 4 + w; lr < TC; lr += gridDim.x * 4) {
    u16* row = U + (size_t)lr * LDU_M;
    float fq[8], fk[8]; float sq = 0.f, sk = 0.f;
    if (lane < 48) { uint4 v = *(const uint4*)(row + M_CQ + lane * 8); unpack8(v, fq);
#pragma unroll
      for (int e = 0; e < 8; ++e) sq += fq[e] * fq[e]; }
    if (lane < 32) { uint4 v = *(const uint4*)(row + M_CKV + lane * 8); unpack8(v, fk);
#pragma unroll
      for (int e = 0; e < 8; ++e) sk += fk[e] * fk[e]; }
    sq = wave_sum(sq); sk = wave_sum(sk);
    float rq = rsqrtf(sq * (1.f / 384.f) + 1e-6f), rk = rsqrtf(sk * (1.f / 256.f) + 1e-6f);
    if (dry) continue;
    if (lane < 48) {
      const float* g = p.q_norm_g + j * 384 + lane * 8;
#pragma unroll
      for (int e = 0; e < 8; ++e) fq[e] = fq[e] * rq * g[e];
      *(uint4*)(row + M_CQ + lane * 8) = pack8(fq);
    }
    if (lane < 32) {
      const float* g = p.kv_norm_g + j * 256 + lane * 8;
#pragma unroll
      for (int e = 0; e < 8; ++e) fk[e] = fk[e] * rk * g[e];
      *(uint4*)(row + M_CKV + lane * 8) = pack8(fk);
    }
    if (lane < 8) {
      float f[8], o[8]; uint4 v = *(const uint4*)(row + M_KR + lane * 8); unpack8(v, f);
      int gt = c * 16384 + lr;
#pragma unroll
      for (int i = 0; i < 4; ++i) {
        float cc = cs[gt * 32 + lane * 4 + i], ss = sn[gt * 32 + lane * 4 + i];
        o[2 * i] = f[2 * i] * cc - f[2 * i + 1] * ss; o[2 * i + 1] = f[2 * i] * ss + f[2 * i + 1] * cc;
      }
      uint4 pk = pack8(o);
      int lb = lr >> 13, s = lr & 8191;
#pragma unroll
      for (int hd = 0; hd < 12; ++hd) *(uint4*)(Kb + ((size_t)(lb * 12 + hd) * 8192 + s) * 192 + 128 + lane * 8) = pk;
    }
  }
}

template <int DQK>
DI void attn_item(const u16* __restrict__ Qp, int ldq, const u16* __restrict__ Kp, const u16* __restrict__ Vtp, int ldv,
                  int nkt, int q0, bool causal, float c, u16* Yp, int ldy, char* smem, bool dry) {
  constexpr int KLD = DQK + 8;
  constexpr int NKC = DQK * 64 / 8 / 256;
  constexpr int NKS = DQK / 16;
  constexpr int CPR = DQK / 8;
  constexpr int BUFE = 64 * KLD + 128 * 72;
  u16* L0 = (u16*)smem;
  const int tid = otid(), w = tid >> 6, lane = tid & 63, r = lane & 31, h = lane >> 5;
  bf16x8 qf[NKS];
  {
    const u16* qrow = Qp + (size_t)(32 * w + r) * ldq + 8 * h;
#pragma unroll
    for (int ks = 0; ks < NKS; ++ks) qf[ks] = *(const bf16x8*)(qrow + 16 * ks);
  }
  f32x16 o[4];
#pragma unroll
  for (int dt = 0; dt < 4; ++dt)
#pragma unroll
    for (int e = 0; e < 16; ++e) o[dt][e] = 0.f;
  float m = -INFINITY, l = 0.f;
  u32x4 kst[NKC], vst[4];
  const int vd = tid >> 3, vc8 = tid & 7;
  int kso[NKC];
#pragma unroll
  for (int i = 0; i < NKC; ++i) { int id = tid + 256 * i; int row = id / CPR, cc = id - row * CPR; kso[i] = row * KLD + cc * 8; }
  const int vso = 64 * KLD + vd * 72 + 16 * (vc8 >> 1) + 4 * (vc8 & 1);
  __syncthreads();
#pragma unroll
  for (int i = 0; i < NKC; ++i) kst[i] = *(const u32x4*)(Kp + (size_t)(tid + 256 * i) * 8);
#pragma unroll
  for (int i = 0; i < 4; ++i) vst[i] = *(const u32x4*)(Vtp + (size_t)(tid + 256 * i) * 8);
#pragma unroll
  for (int i = 0; i < NKC; ++i) *(u32x4*)(L0 + kso[i]) = kst[i];
#pragma unroll
  for (int i = 0; i < 4; ++i) {
    u16* dst = L0 + vso + (32 * i) * 72;
    u32x2 lo = {vst[i].x, vst[i].y}, hi = {vst[i].z, vst[i].w};
    *(u32x2*)dst = lo; *(u32x2*)(dst + 8) = hi;
  }
  if (nkt > 1) {
    const u16* kg = Kp + (size_t)64 * DQK;
#pragma unroll
    for (int i = 0; i < NKC; ++i) kst[i] = *(const u32x4*)(kg + (size_t)(tid + 256 * i) * 8);
#pragma unroll
    for (int i = 0; i < 4; ++i) vst[i] = *(const u32x4*)(Vtp + 8192 + (size_t)(tid + 256 * i) * 8);
  }
  __syncthreads();
  const int qmin = q0 + 32 * w;
  for (int kt = 0; kt < nkt; ++kt) {
    const u16* Ks = L0 + (kt & 1) * BUFE;
    const u16* Vs = Ks + 64 * KLD;
    u16* Ln = L0 + ((kt + 1) & 1) * BUFE;
    const bool active = !(causal && kt * 64 > qmin + 31);
    f32x16 s0, s1;
#pragma unroll
    for (int e = 0; e < 16; ++e) { s0[e] = 0.f; s1[e] = 0.f; }
    const u16* k0 = Ks + r * KLD + 8 * h;
    bf16x8 ka[2][2];
    if (active) {
      ka[0][0] = *(const bf16x8*)(k0); ka[0][1] = *(const bf16x8*)(k0 + 32 * KLD);
      ka[1][0] = *(const bf16x8*)(k0 + 16); ka[1][1] = *(const bf16x8*)(k0 + 32 * KLD + 16);
      __builtin_amdgcn_sched_barrier(0);
      s0 = MFMA32(ka[0][0], qf[0], s0); s1 = MFMA32(ka[0][1], qf[0], s1);
    }
    if (kt + 1 < nkt) {
#pragma unroll
      for (int i = 0; i < NKC; ++i) *(u32x4*)(Ln + kso[i]) = kst[i];
#pragma unroll
      for (int i = 0; i < 4; ++i) {
        u16* dst = Ln + vso + (32 * i) * 72;
        u32x2 lo = {vst[i].x, vst[i].y}, hi = {vst[i].z, vst[i].w};
        *(u32x2*)dst = lo; *(u32x2*)(dst + 8) = hi;
      }
    }
    if (kt + 2 < nkt) {
      const u16* kg = Kp + (size_t)(kt + 2) * 64 * DQK;
#pragma unroll
      for (int i = 0; i < NKC; ++i) kst[i] = *(const u32x4*)(kg + (size_t)(tid + 256 * i) * 8);
#pragma unroll
      for (int i = 0; i < 4; ++i) vst[i] = *(const u32x4*)(Vtp + (size_t)(kt + 2) * 8192 + (size_t)(tid + 256 * i) * 8);
    }
    if (active) {
      __builtin_amdgcn_sched_barrier(0);
#pragma unroll
      for (int ks = 1; ks < NKS; ++ks) {
        if (ks + 1 < NKS) {
          ka[(ks + 1) & 1][0] = *(const bf16x8*)(k0 + 16 * (ks + 1));
          ka[(ks + 1) & 1][1] = *(const bf16x8*)(k0 + 32 * KLD + 16 * (ks + 1));
        }
        __builtin_amdgcn_sched_barrier(0);
        s0 = MFMA32(ka[ks & 1][0], qf[ks], s0); s1 = MFMA32(ka[ks & 1][1], qf[ks], s1);
        __builtin_amdgcn_sched_barrier(0);
      }
      const u16* v0 = Vs + r * 72 + 8 * h;
      bf16x8 va[2][4];
#pragma unroll
      for (int dt = 0; dt < 4; ++dt) va[0][dt] = *(const bf16x8*)(v0 + (32 * dt) * 72);
      if (causal && kt * 64 + 63 > qmin) {
        const int qi = qmin + r;
#pragma unroll
        for (int e = 0; e < 16; ++e) {
          int key = kt * 64 + crow(e, h);
          if (key > qi) s0[e] = -INFINITY;
          if (key + 32 > qi) s1[e] = -INFINITY;
        }
      }
      float mx = fmaxf(s0[0], s1[0]);
#pragma unroll
      for (int e = 1; e < 16; ++e) mx = fmaxf(mx, fmaxf(s0[e], s1[e]));
      mx = fmaxf(mx, __shfl_xor(mx, 32));
      if (__builtin_amdgcn_ballot_w64((mx - m) * c > 8.f) != 0ull) {
        const float mn = fmaxf(m, mx);
        const float alpha = ex2((m - mn) * c);
        m = mn;
        l *= alpha;
#pragma unroll
        for (int dt = 0; dt < 4; ++dt)
#pragma unroll
          for (int e = 0; e < 16; ++e) o[dt][e] *= alpha;
      }
      const float mc = m * c;
      float ps = 0.f;
#pragma unroll
      for (int e = 0; e < 16; ++e) { s0[e] = ex2(fmaf(s0[e], c, -mc)); s1[e] = ex2(fmaf(s1[e], c, -mc)); ps += s0[e] + s1[e]; }
      l += ps;
      bf16x8 pf[4];
      {
        u32x4 t;
        t.x = pack2(s0[0], s0[1]); t.y = pack2(s0[2], s0[3]); t.z = pack2(s0[4], s0[5]); t.w = pack2(s0[6], s0[7]); pf[0] = __builtin_bit_cast(bf16x8, t);
        t.x = pack2(s0[8], s0[9]); t.y = pack2(s0[10], s0[11]); t.z = pack2(s0[12], s0[13]); t.w = pack2(s0[14], s0[15]); pf[1] = __builtin_bit_cast(bf16x8, t);
        t.x = pack2(s1[0], s1[1]); t.y = pack2(s1[2], s1[3]); t.z = pack2(s1[4], s1[5]); t.w = pack2(s1[6], s1[7]); pf[2] = __builtin_bit_cast(bf16x8, t);
        t.x = pack2(s1[8], s1[9]); t.y = pack2(s1[10], s1[11]); t.z = pack2(s1[12], s1[13]); t.w = pack2(s1[14], s1[15]); pf[3] = __builtin_bit_cast(bf16x8, t);
      }
#pragma unroll
      for (int kk = 0; kk < 4; ++kk) {
        if (kk < 3) {
#pragma unroll
          for (int dt = 0; dt < 4; ++dt) va[(kk + 1) & 1][dt] = *(const bf16x8*)(v0 + (32 * dt) * 72 + 16 * (kk + 1));
        }
        __builtin_amdgcn_sched_barrier(0);
#pragma unroll
        for (int dt = 0; dt < 4; ++dt) o[dt] = MFMA32(va[kk & 1][dt], pf[kk], o[dt]);
        __builtin_amdgcn_sched_barrier(0);
      }
    }
    __syncthreads();
  }
  const float lt = l + __shfl_xor(l, 32);
  const float inv = 1.f / lt;
  if (dry) return;
  u16* yrow = Yp + (size_t)(32 * w + r) * ldy;
#pragma unroll
  for (int dt = 0; dt < 4; ++dt)
#pragma unroll
    for (int g = 0; g < 4; ++g) {
      const int d = 32 * dt + 8 * g + 4 * h;
      uint2 gv = *(const uint2*)(yrow + d);
      float g0 = bf2f(gv.x & 0xffffu), g1 = bf2f(gv.x >> 16), g2 = bf2f(gv.y & 0xffffu), g3 = bf2f(gv.y >> 16);
      uint2 ov;
      ov.x = pack2(o[dt][4 * g] * inv * silu(g0), o[dt][4 * g + 1] * inv * silu(g1));
      ov.y = pack2(o[dt][4 * g + 2] * inv * silu(g2), o[dt][4 * g + 3] * inv * silu(g3));
      *(uint2*)(yrow + d) = ov;
    }
}

template <int DQK>
DI void attn_item_c(const u16* __restrict__ Qp, int ldq, const u16* __restrict__ Kp, const u16* __restrict__ Vtp, int ldv,
                    int nkt, int q0, float c, u16* Yp, int ldy, char* smem, bool dry) {
  constexpr int KLD = DQK + 8;
  constexpr int NKC = DQK * 64 / 8 / 256;
  constexpr int NKS = DQK / 16;
  constexpr int CPR = DQK / 8;
  constexpr int BUFE = 64 * KLD + 128 * 72;
  u16* L0 = (u16*)smem;
  const int tid = otid(), w = tid >> 6, lane = tid & 63, r = lane & 31, h = lane >> 5;
  bf16x8 qf[NKS];
  {
    const u16* qrow = Qp + (size_t)(32 * w + r) * ldq + 8 * h;
#pragma unroll
    for (int ks = 0; ks < NKS; ++ks) qf[ks] = *(const bf16x8*)(qrow + 16 * ks);
  }
  f32x16 o[4];
#pragma unroll
  for (int dt = 0; dt < 4; ++dt)
#pragma unroll
    for (int e = 0; e < 16; ++e) o[dt][e] = 0.f;
  float m = -INFINITY, l = 0.f;
  u32x4 kstA[NKC], vstA[4], kstB[NKC], vstB[4];
  const int vd = tid >> 3, vc8 = tid & 7;
  int kso[NKC];
#pragma unroll
  for (int i = 0; i < NKC; ++i) { int id = tid + 256 * i; int row = id / CPR, cc = id - row * CPR; kso[i] = row * KLD + cc * 8; }
  const int vso = 64 * KLD + vd * 72 + 16 * (vc8 >> 1) + 4 * (vc8 & 1);
  const int nktp = (nkt + 3) & ~3;
  auto gload = [&](u32x4* ks_, u32x4* vs_, int j) {
    const u16* kg = Kp + (size_t)(j + 1) * 64 * DQK;
#pragma unroll
    for (int i = 0; i < NKC; ++i) ks_[i] = *(const u32x4*)(kg + (size_t)(tid + 256 * i) * 8);
#pragma unroll
    for (int i = 0; i < 4; ++i) vs_[i] = *(const u32x4*)(Vtp + (size_t)j * 8192 + (size_t)(tid + 256 * i) * 8);
  };
  auto lstore = [&](const u32x4* ks_, const u32x4* vs_, u16* Lb) {
#pragma unroll
    for (int i = 0; i < NKC; ++i) *(u32x4*)(Lb + kso[i]) = ks_[i];
#pragma unroll
    for (int i = 0; i < 4; ++i) {
      u16* dst = Lb + vso + (32 * i) * 72;
      u32x2 lo = {vs_[i].x, vs_[i].y}, hi = {vs_[i].z, vs_[i].w};
      *(u32x2*)dst = lo; *(u32x2*)(dst + 8) = hi;
    }
  };
  __syncthreads();
  gload(kstA, vstA, 0);
  gload(kstB, vstB, 1);
  f32x16 sa0, sa1, sb0, sb1;
#pragma unroll
  for (int e = 0; e < 16; ++e) { sa0[e] = 0.f; sa1[e] = 0.f; }
  {
    const u16* kr = Kp + (size_t)r * DQK + 8 * h;
#pragma unroll
    for (int ks = 0; ks < NKS; ++ks) {
      bf16x8 a0 = *(const bf16x8*)(kr + 16 * ks), a1 = *(const bf16x8*)(kr + 32 * DQK + 16 * ks);
      sa0 = MFMA32(a0, qf[ks], sa0); sa1 = MFMA32(a1, qf[ks], sa1);
    }
  }
  lstore(kstA, vstA, L0);
  gload(kstA, vstA, 2);
  __syncthreads();
  const int qmin = q0 + 32 * w;
  const int qi = qmin + r;
  auto body = [&](int kt, u32x4* wk, u32x4* wv, f32x16& s0, f32x16& s1, f32x16& n0, f32x16& n1) {
    const u16* Ks = L0 + (kt & 1) * BUFE;
    const u16* Vs = Ks + 64 * KLD;
    u16* Ln = L0 + ((kt + 1) & 1) * BUFE;
    const bool active = !(kt * 64 > qmin + 31);
    if (kt * 64 + 63 > qmin) {
#pragma unroll
      for (int e = 0; e < 16; ++e) {
        int key = kt * 64 + crow(e, h);
        if (key > qi) s0[e] = -INFINITY;
        if (key + 32 > qi) s1[e] = -INFINITY;
      }
    }
    float mx = fmaxf(s0[0], s1[0]);
#pragma unroll
    for (int e = 1; e < 16; ++e) mx = fmaxf(fmaxf(mx, s0[e]), s1[e]);
    mx = fmaxf(mx, __shfl_xor(mx, 32));
    if (__builtin_amdgcn_ballot_w64((mx - m) * c > 8.f) != 0ull) {
      const float mn = fmaxf(m, mx);
      const float alpha = ex2((m - mn) * c);
      m = mn;
      l *= alpha;
#pragma unroll
      for (int dt = 0; dt < 4; ++dt)
#pragma unroll
        for (int e = 0; e < 16; ++e) o[dt][e] *= alpha;
    }
    const float mc = m * c;
#pragma unroll
    for (int e = 0; e < 16; ++e) { n0[e] = 0.f; n1[e] = 0.f; }
    const u16* k0 = Ks + r * KLD + 8 * h;
    bf16x8 ka[2][2];
    ka[0][0] = *(const bf16x8*)(k0); ka[0][1] = *(const bf16x8*)(k0 + 32 * KLD);
    bf16x8 pf[4];
    u32x4 pk[4];
    float ps = 0.f;
#pragma unroll
    for (int ks = 0; ks < NKS; ++ks) {
      if (ks + 1 < NKS) {
        ka[(ks + 1) & 1][0] = *(const bf16x8*)(k0 + 16 * (ks + 1));
        ka[(ks + 1) & 1][1] = *(const bf16x8*)(k0 + 32 * KLD + 16 * (ks + 1));
      }
      __builtin_amdgcn_sched_barrier(0);
      n0 = MFMA32(ka[ks & 1][0], qf[ks], n0); n1 = MFMA32(ka[ks & 1][1], qf[ks], n1);
      {
        constexpr int dummy0 = 0; (void)dummy0;
        const int e_lo = (32 * ks) / NKS, e_hi = (32 * (ks + 1)) / NKS;
#pragma unroll
        for (int q = 0; q < 3; ++q) {
          const int e = e_lo + q;
          if (e < e_hi) {
            if (e < 16) { s0[e & 15] = ex2(fmaf(s0[e & 15], c, -mc)); ps += s0[e & 15]; }
            else        { s1[e & 15] = ex2(fmaf(s1[e & 15], c, -mc)); ps += s1[e & 15]; }
          }
        }
      }
      if (ks == 3)  { pk[0].x = pack2(s0[0], s0[1]);  pk[0].y = pack2(s0[2], s0[3]);   pk[0].z = pack2(s0[4], s0[5]);   pk[0].w = pack2(s0[6], s0[7]); }
      if (ks == 6)  { pk[1].x = pack2(s0[8], s0[9]);  pk[1].y = pack2(s0[10], s0[11]); pk[1].z = pack2(s0[12], s0[13]); pk[1].w = pack2(s0[14], s0[15]); }
      if (ks == 9)  { pk[2].x = pack2(s1[0], s1[1]);  pk[2].y = pack2(s1[2], s1[3]);   pk[2].z = pack2(s1[4], s1[5]);   pk[2].w = pack2(s1[6], s1[7]); }
      if (ks == NKS - 1) { pk[3].x = pack2(s1[8], s1[9]);  pk[3].y = pack2(s1[10], s1[11]); pk[3].z = pack2(s1[12], s1[13]); pk[3].w = pack2(s1[14], s1[15]); }
      __builtin_amdgcn_sched_barrier(0);
    }
    l += ps;
#pragma unroll
    for (int i = 0; i < 4; ++i) pf[i] = __builtin_bit_cast(bf16x8, pk[i]);
    if (active) {
      const u16* v0 = Vs + r * 72 + 8 * h;
      bf16x8 va[2][4];
#pragma unroll
      for (int dt = 0; dt < 4; ++dt) va[0][dt] = *(const bf16x8*)(v0 + (32 * dt) * 72);
#pragma unroll
      for (int kk = 0; kk < 4; ++kk) {
        if (kk < 3) {
#pragma unroll
          for (int dt = 0; dt < 4; ++dt) va[(kk + 1) & 1][dt] = *(const bf16x8*)(v0 + (32 * dt) * 72 + 16 * (kk + 1));
        }
        __builtin_amdgcn_sched_barrier(0);
#pragma unroll
        for (int dt = 0; dt < 4; ++dt) o[dt] = MFMA32(va[kk & 1][dt], pf[kk], o[dt]);
        if (kk == 0) lstore(wk, wv, Ln);
        if (kk == 1) gload(wk, wv, kt + 3);
        __builtin_amdgcn_sched_barrier(0);
      }
    } else {
      lstore(wk, wv, Ln);
      gload(wk, wv, kt + 3);
    }
    __syncthreads();
  };
  for (int kt4 = 0; kt4 < nktp; kt4 += 4) {
    body(kt4 + 0, kstB, vstB, sa0, sa1, sb0, sb1); body(kt4 + 1, kstA, vstA, sb0, sb1, sa0, sa1);
    body(kt4 + 2, kstB, vstB, sa0, sa1, sb0, sb1); body(kt4 + 3, kstA, vstA, sb0, sb1, sa0, sa1);
  }
  const float lt = l + __shfl_xor(l, 32);
  const float inv = 1.f / lt;
  if (dry) return;
  u16* yrow = Yp + (size_t)(32 * w + r) * ldy;
#pragma unroll
  for (int dt = 0; dt < 4; ++dt)
#pragma unroll
    for (int g = 0; g < 4; ++g) {
      const int d = 32 * dt + 8 * g + 4 * h;
      uint2 gv = *(const uint2*)(yrow + d);
      float g0 = bf2f(gv.x & 0xffffu), g1 = bf2f(gv.x >> 16), g2 = bf2f(gv.y & 0xffffu), g3 = bf2f(gv.y >> 16);
      uint2 ov;
      ov.x = pack2(o[dt][4 * g] * inv * silu(g0), o[dt][4 * g + 1] * inv * silu(g1));
      ov.y = pack2(o[dt][4 * g + 2] * inv * silu(g2), o[dt][4 * g + 3] * inv * silu(g3));
      *(uint2*)(yrow + d) = ov;
    }
}

DI void memattn_item(const Params& p, int L, int c, int item, char* smem, bool dry) {
  const bool rw = L & 1;
  const int ldu = rw ? LDU_R : LDU_M, oq = rw ? R_QM : M_QM, og = rw ? R_GATE : M_GATE;
  const int tile = item >> 2, xh = item & 3;
  const int b = gtok(rw, c, tile * 128) >> 13;
  u16* U = (u16*)(p.ws + OFF_U);
  const u16* MK = (const u16*)(p.ws + OFF_MEMK) + (size_t)((L * 4 + b) * 4 + xh) * 256 * 128;
  const u16* MV = (const u16*)(p.ws + OFF_MEMVT) + (size_t)((L * 4 + b) * 4 + xh) * 128 * 256;
  attn_item<128>(U + (size_t)tile * 128 * ldu + oq + xh * 128, ldu, MK, MV, 256, 4, 0, false,
                 0.08838834764831845f * 1.4426950408889634f, U + (size_t)tile * 128 * ldu + og + 1536 + xh * 128, ldu, smem, dry);
}

DI void phase_attn(const Params& p, int L, int c, char* smem, int* s_item, bool dry) {
  int* cnt = (int*)(p.ws + OFF_CNT) + 64 + ((L * 2 + c) * 2 + (dry ? 1 : 0)) * 16;
  u16* U = (u16*)(p.ws + OFF_U);
  const u16* Q = (const u16*)(p.ws + OFF_Q); const u16* Kb = (const u16*)(p.ws + OFF_K); const u16* Vt = (const u16*)(p.ws + OFF_VT);
  const int xcc = (int)(__builtin_amdgcn_s_getreg((3 << 11) | 20) & 7u);
  for (int k = 0; k < 8; ++k) {
    const int x = (xcc + k) & 7;
    for (;;) {
      __syncthreads();
      if (otid() == 0) *s_item = atomicAdd(cnt + x, 1);
      __syncthreads();
      const int item = *s_item;
      if (item >= 192) break;
      const int qt = 63 - (item & 63), bh = 3 * x + (item >> 6);
      const int lb = bh / 12, head = bh - lb * 12;
      const int q0 = qt * 128;
      attn_item_c<192>(Q + ((size_t)(lb * 12 + head) * 8192 + q0) * 192, 192, Kb + (size_t)(lb * 12 + head) * 8192 * 192,
                     Vt + (size_t)(lb * 12 + head) * 128 * 8192, 8192, 2 * (qt + 1), q0,
                     0.07216878364870323f * 1.4426950408889634f,
                     U + (size_t)(lb * 8192 + q0) * LDU_M + M_GATE + head * 128, LDU_M, smem, dry);
    }
  }
  for (;;) {
    __syncthreads();
    if (otid() == 0) *s_item = atomicAdd(cnt + 8, 1);
    __syncthreads();
    const int item = *s_item;
    if (item >= 512) break;
    memattn_item(p, L, c, item, smem, dry);
  }
}

DI void scan_item(const Params& p, int L, int c, int item, char* smem, bool dry) {
  const int tid = otid(), w = tid >> 6, lane = tid & 63, r = lane & 31, h = lane >> 5;
  const int j = L >> 1;
  const int b = item / 48, rem = item - b * 48, head = rem >> 1, half = rem & 1;
  float* PAb  = (float*)smem;
  float* Vstb = PAb + 2 * 10240;
  float* Ystb = Vstb + 3 * 1024;
  float* PRM  = Ystb + 2 * 1024;
  float* BONb = PRM + 10 * 64;
  u16* A1  = (u16*)(BONb + 96);
  u16* W2t = A1 + 2 * 32 * 72;
  float* LO  = (float*)(W2t + 2 * 64 * 72);
  const u16* U = (const u16*)(p.ws + OFF_U);
  const u16* BND = (const u16*)(p.ws + OFF_BND);
  u16* YR = (u16*)(p.ws + OFF_YR); u16* BV = (u16*)(p.ws + OFF_BV);
  float* ST = (float*)(p.ws + OFF_ST);
  float* STATE = (float*)(p.ws + OFF_STATE);
  __syncthreads();
  if (tid < 64) {
    const float* mu = p.mu + j * SHIFTW;
    const int hc = head * 64 + tid;
    PRM[0 * 64 + tid] = mu[R_R + hc]; PRM[1 * 64 + tid] = mu[R_K + hc]; PRM[2 * 64 + tid] = mu[R_WD + tid]; PRM[3 * 64 + tid] = mu[R_AD + tid];
    PRM[4 * 64 + tid] = p.w0[j * 1536 + hc]; PRM[5 * 64 + tid] = p.a0[j * 1536 + hc]; PRM[6 * 64 + tid] = p.k_k[j * 1536 + hc];
    PRM[7 * 64 + tid] = p.k_a[j * 1536 + hc]; PRM[8 * 64 + tid] = p.r_k[j * 1536 + hc];
    PRM[9 * 64 + tid] = (tid < 32) ? mu[R_V + head * 64 + 32 * half + tid] : 0.f;
  }
  for (int e = tid; e < 8192; e += 256) {
    int arr = e >> 12, jj = (e >> 6) & 63, cc = e & 63;
    const float* src = (arr ? p.a2 : p.w2) + (size_t)j * 64 * 1536;
    W2t[(arr * 64 + cc) * 72 + jj] = f2bf(src[jj * 1536 + head * 64 + cc]);
  }
  const int rowl = lane >> 3, ks = lane & 7, row32 = 8 * w + rowl;
  float S[8];
  {
    float* sp = STATE + ((size_t)((b * 24 + head) * 64 + 32 * half + row32)) * 64 + 8 * ks;
#pragma unroll
    for (int i = 0; i < 8; ++i) S[i] = (c == 0) ? 0.f : sp[i];
  }
  const int tt = tid >> 3, cs = tid & 7, c4 = cs & 3;
  uint4 Rr_c, Rr_p, Rk_c, Rk_p, Rw_c, Rw_p, Ra_c, Ra_p, Rv_c, Rv_p;
  const uint4 zero4 = {0u, 0u, 0u, 0u};
  auto load_raw = [&](int tc) {
    const int lr = b * 4096 + tc * 32 + tt;
    const int s = c * 4096 + tc * 32 + tt;
    const u16* cur = U + (size_t)lr * LDU_R;
    const u16* prv = (s == 0) ? (BND + (size_t)4 * SHIFTW) : ((s == 4096 && c == 1) ? (BND + (size_t)b * SHIFTW) : (cur - LDU_R));
    Rr_c = *(const uint4*)(cur + R_R + head * 64 + cs * 8);  Rr_p = *(const uint4*)(prv + R_R + head * 64 + cs * 8);
    Rk_c = *(const uint4*)(cur + R_K + head * 64 + cs * 8);  Rk_p = *(const uint4*)(prv + R_K + head * 64 + cs * 8);
    Rw_c = *(const uint4*)(cur + R_WD + cs * 8);             Rw_p = *(const uint4*)(prv + R_WD + cs * 8);
    Ra_c = *(const uint4*)(cur + R_AD + cs * 8);             Ra_p = *(const uint4*)(prv + R_AD + cs * 8);
    const int vo = R_V + head * 64 + 32 * half + c4 * 8;
    Rv_c = *(const uint4*)(cur + vo);                        Rv_p = *(const uint4*)(prv + vo);
  };
  uint4 d_y = zero4, d_v = zero4; float d_sm = 0.f, d_sq = 0.f; int d_lr = -1;
  auto flush_out = [&]() {
    if (cs < 4 && !dry && d_lr >= 0) {
      const size_t o = (size_t)d_lr * 1536 + head * 64 + 32 * half + cs * 8;
      *(uint4*)(YR + o) = d_y;
      *(uint4*)(BV + o) = d_v;
      if (cs == 0) {
        float* stp = ST + ((size_t)(d_lr * 24 + head) * 2 + half) * 2;
        stp[0] = d_sm; stp[1] = d_sq;
      }
    }
  };
  float rm[8], km[8];
  auto prep1 = [&](float* Vst) {
    float cu[8], pv[8], t8[8];
    unpack8(Rr_c, cu); unpack8(Rr_p, pv);
#pragma unroll
    for (int e = 0; e < 8; ++e) rm[e] = cu[e] + (pv[e] - cu[e]) * PRM[0 * 64 + cs * 8 + e];
    unpack8(Rk_c, cu); unpack8(Rk_p, pv);
#pragma unroll
    for (int e = 0; e < 8; ++e) km[e] = cu[e] + (pv[e] - cu[e]) * PRM[1 * 64 + cs * 8 + e];
    unpack8(Rw_c, cu); unpack8(Rw_p, pv);
#pragma unroll
    for (int e = 0; e < 8; ++e) {
      float xw = cu[e] + (pv[e] - cu[e]) * PRM[2 * 64 + cs * 8 + e];
      float ee = ex2(xw * 2.8853900817779268f);
      t8[e] = 1.f - 2.f * frcp(ee + 1.f);
    }
    *(uint4*)(A1 + (0 * 32 + tt) * 72 + cs * 8) = pack8(t8);
    unpack8(Ra_c, cu); unpack8(Ra_p, pv);
#pragma unroll
    for (int e = 0; e < 8; ++e) t8[e] = cu[e] + (pv[e] - cu[e]) * PRM[3 * 64 + cs * 8 + e];
    *(uint4*)(A1 + (1 * 32 + tt) * 72 + cs * 8) = pack8(t8);
    unpack8(Rv_c, cu); unpack8(Rv_p, pv);
    float v8[8];
#pragma unroll
    for (int e = 0; e < 8; ++e) v8[e] = cu[e] + (pv[e] - cu[e]) * PRM[9 * 64 + c4 * 8 + e];
    *(float4*)(Vst + tt * 32 + c4 * 8) = make_float4(v8[0], v8[1], v8[2], v8[3]);
    *(float4*)(Vst + tt * 32 + c4 * 8 + 4) = make_float4(v8[4], v8[5], v8[6], v8[7]);
  };
  auto prep3 = [&]() {
    const int arr = w >> 1, nt = w & 1;
    f32x16 acc;
#pragma unroll
    for (int e = 0; e < 16; ++e) acc[e] = 0.f;
#pragma unroll
    for (int k4 = 0; k4 < 4; ++k4) {
      bf16x8 a = *(const bf16x8*)(A1 + (arr * 32 + r) * 72 + 16 * k4 + 8 * h);
      bf16x8 bw = *(const bf16x8*)(W2t + (arr * 64 + 32 * nt + r) * 72 + 16 * k4 + 8 * h);
      acc = MFMA32(a, bw, acc);
    }
#pragma unroll
    for (int e = 0; e < 16; ++e) LO[(arr * 32 + crow(e, h)) * 64 + 32 * nt + r] = acc[e];
  };
  auto prep4 = [&](float* PA, float* BON) {
    float lw[8], la[8];
    {
      float4 t0 = *(const float4*)(LO + (0 * 32 + tt) * 64 + cs * 8), t1 = *(const float4*)(LO + (0 * 32 + tt) * 64 + cs * 8 + 4);
      lw[0] = t0.x; lw[1] = t0.y; lw[2] = t0.z; lw[3] = t0.w; lw[4] = t1.x; lw[5] = t1.y; lw[6] = t1.z; lw[7] = t1.w;
      t0 = *(const float4*)(LO + (1 * 32 + tt) * 64 + cs * 8); t1 = *(const float4*)(LO + (1 * 32 + tt) * 64 + cs * 8 + 4);
      la[0] = t0.x; la[1] = t0.y; la[2] = t0.z; la[3] = t0.w; la[4] = t1.x; la[5] = t1.y; la[6] = t1.z; la[7] = t1.w;
    }
    float dec[8], kk[8], av[8], kp[8];
    float ssq = 0.f, bon = 0.f;
#pragma unroll
    for (int e = 0; e < 8; ++e) {
      const int ch = cs * 8 + e;
      const float sg = frcp(1.f + fexp(-(lw[e] + PRM[4 * 64 + ch])));
      dec[e] = ex2(-0.8750340f * sg);
      float a = frcp(1.f + fexp(-(la[e] + PRM[5 * 64 + ch])));
      av[e] = a;
      kk[e] = km[e] * PRM[6 * 64 + ch];
      ssq += kk[e] * kk[e];
      kp[e] = km[e] * (1.f + (a - 1.f) * PRM[7 * 64 + ch]);
      bon += rm[e] * kp[e] * PRM[8 * 64 + ch];
    }
    ssq = red8(ssq); bon = red8(bon);
    const float inv = 1.f / fmaxf(sqrtf(ssq), 1e-12f);
    float nk[8], bb[8];
#pragma unroll
    for (int e = 0; e < 8; ++e) { float kn = kk[e] * inv; nk[e] = -kn; bb[e] = kn * av[e]; }
    float* pa = PA + tt * 320 + cs * 8;
    *(float4*)(pa) = make_float4(dec[0], dec[1], dec[2], dec[3]); *(float4*)(pa + 4) = make_float4(dec[4], dec[5], dec[6], dec[7]);
    *(float4*)(pa + 64) = make_float4(nk[0], nk[1], nk[2], nk[3]); *(float4*)(pa + 68) = make_float4(nk[4], nk[5], nk[6], nk[7]);
    *(float4*)(pa + 128) = make_float4(bb[0], bb[1], bb[2], bb[3]); *(float4*)(pa + 132) = make_float4(bb[4], bb[5], bb[6], bb[7]);
    *(float4*)(pa + 192) = make_float4(kp[0], kp[1], kp[2], kp[3]); *(float4*)(pa + 196) = make_float4(kp[4], kp[5], kp[6], kp[7]);
    *(float4*)(pa + 256) = make_float4(rm[0], rm[1], rm[2], rm[3]); *(float4*)(pa + 260) = make_float4(rm[4], rm[5], rm[6], rm[7]);
    BON[tt] = bon;
  };
  float4 d0, d1, n0, n1, b0, b1, k0, k1, r0, r1; float vv;
  auto step_load = [&](const float* PA, const float* Vst, int t) {
    const float* pa = PA + t * 320 + ks * 8;
    d0 = *(const float4*)(pa); d1 = *(const float4*)(pa + 4);
    n0 = *(const float4*)(pa + 64); n1 = *(const float4*)(pa + 68);
    b0 = *(const float4*)(pa + 128); b1 = *(const float4*)(pa + 132);
    k0 = *(const float4*)(pa + 192); k1 = *(const float4*)(pa + 196);
    r0 = *(const float4*)(pa + 256); r1 = *(const float4*)(pa + 260);
    vv = Vst[t * 32 + row32];
  };
  auto steps8 = [&](const float* PA, const float* Vst, float* Yst, int t0) {
#pragma unroll
    for (int t8 = 0; t8 < 8; ++t8) {
      const int t = t0 + t8;
      const float* pa = PA + (t + 1) * 320 + ks * 8;
      const float4 xd0 = *(const float4*)(pa), xd1 = *(const float4*)(pa + 4);
      const float4 xn0 = *(const float4*)(pa + 64), xn1 = *(const float4*)(pa + 68);
      const float4 xb0 = *(const float4*)(pa + 128), xb1 = *(const float4*)(pa + 132);
      const float4 xk0 = *(const float4*)(pa + 192), xk1 = *(const float4*)(pa + 196);
      const float4 xr0 = *(const float4*)(pa + 256), xr1 = *(const float4*)(pa + 260);
      const float xvv = Vst[(t + 1) * 32 + row32];
      float sa0 = S[0] * n0.x, sa1 = S[1] * n0.y;
      sa0 = fmaf(S[2], n0.z, sa0); sa1 = fmaf(S[3], n0.w, sa1);
      sa0 = fmaf(S[4], n1.x, sa0); sa1 = fmaf(S[5], n1.y, sa1);
      sa0 = fmaf(S[6], n1.z, sa0); sa1 = fmaf(S[7], n1.w, sa1);
      float sa = red8(sa0 + sa1);
      S[0] = fmaf(sa, b0.x, fmaf(S[0], d0.x, vv * k0.x)); S[1] = fmaf(sa, b0.y, fmaf(S[1], d0.y, vv * k0.y));
      S[2] = fmaf(sa, b0.z, fmaf(S[2], d0.z, vv * k0.z)); S[3] = fmaf(sa, b0.w, fmaf(S[3], d0.w, vv * k0.w));
      S[4] = fmaf(sa, b1.x, fmaf(S[4], d1.x, vv * k1.x)); S[5] = fmaf(sa, b1.y, fmaf(S[5], d1.y, vv * k1.y));
      S[6] = fmaf(sa, b1.z, fmaf(S[6], d1.z, vv * k1.z)); S[7] = fmaf(sa, b1.w, fmaf(S[7], d1.w, vv * k1.w));
      float y0 = S[0] * r0.x, y1 = S[1] * r0.y;
      y0 = fmaf(S[2], r0.z, y0); y1 = fmaf(S[3], r0.w, y1);
      y0 = fmaf(S[4], r1.x, y0); y1 = fmaf(S[5], r1.y, y1);
      y0 = fmaf(S[6], r1.z, y0); y1 = fmaf(S[7], r1.w, y1);
      float y = red8(y0 + y1);
      Yst[t * 32 + row32] = y;
      d0 = xd0; d1 = xd1; n0 = xn0; n1 = xn1; b0 = xb0; b1 = xb1; k0 = xk0; k1 = xk1; r0 = xr0; r1 = xr1; vv = xvv;
    }
  };
  load_raw(0);
  prep1(Vstb);
  __syncthreads();
  prep3();
  load_raw(1);
  __syncthreads();
  prep4(PAb, BONb);
  __syncthreads();
  int v3 = 0;
  for (int tc = 0; tc < 128; ++tc) {
    const int lr = b * 4096 + tc * 32 + tt;
    const int v3n = (v3 == 2) ? 0 : v3 + 1;
    float* PAc = PAb + (tc & 1) * 10240;        float* PAn = PAb + ((tc + 1) & 1) * 10240;
    float* Vc = Vstb + v3 * 1024;               float* Vn = Vstb + v3n * 1024;
    float* Bc = BONb + v3 * 32;                 float* Bn = BONb + v3n * 32;
    float* Yc = Ystb + (tc & 1) * 1024;
    step_load(PAc, Vc, 0);
    prep1(Vn);
    steps8(PAc, Vc, Yc, 0);
    __syncthreads();
    prep3();
    steps8(PAc, Vc, Yc, 8);
    __syncthreads();
    prep4(PAn, Bn);
    steps8(PAc, Vc, Yc, 16);
    load_raw(tc + 2);
    flush_out();
    steps8(PAc, Vc, Yc, 24);
    __syncthreads();
    {
      float y8[8], v8[8];
      float4 t0 = *(const float4*)(Yc + tt * 32 + c4 * 8), t1 = *(const float4*)(Yc + tt * 32 + c4 * 8 + 4);
      y8[0] = t0.x; y8[1] = t0.y; y8[2] = t0.z; y8[3] = t0.w; y8[4] = t1.x; y8[5] = t1.y; y8[6] = t1.z; y8[7] = t1.w;
      float sm = 0.f, sq = 0.f;
#pragma unroll
      for (int e = 0; e < 8; ++e) { sm += y8[e]; sq += y8[e] * y8[e]; }
      sm = red4(sm); sq = red4(sq);
      const float bon = Bc[tt];
      t0 = *(const float4*)(Vc + tt * 32 + c4 * 8); t1 = *(const float4*)(Vc + tt * 32 + c4 * 8 + 4);
      v8[0] = t0.x * bon; v8[1] = t0.y * bon; v8[2] = t0.z * bon; v8[3] = t0.w * bon; v8[4] = t1.x * bon; v8[5] = t1.y * bon; v8[6] = t1.z * bon; v8[7] = t1.w * bon;
      d_y = pack8(y8); d_v = pack8(v8); d_sm = sm; d_sq = sq; d_lr = lr;
    }
    v3 = v3n;
  }
  flush_out();
  if (c == 0 && !dry) {
    float* sp = STATE + ((size_t)((b * 24 + head) * 64 + 32 * half + row32)) * 64 + 8 * ks;
#pragma unroll
    for (int i = 0; i < 8; ++i) sp[i] = S[i];
  }
}

DI void phase_scan(const Params& p, int L, int c, char* smem, int* s_item, bool dry) {
  for (int item = blockIdx.x; item < 192; item += gridDim.x) scan_item(p, L, c, item, smem, dry);
  int* cnt = (int*)(p.ws + OFF_CNT) + 64 + ((L * 2 + c) * 2 + (dry ? 1 : 0)) * 16 + 8;
  for (;;) {
    __syncthreads();
    if (otid() == 0) *s_item = atomicAdd(cnt, 1);
    __syncthreads();
    const int item = *s_item;
    if (item >= 512) break;
    memattn_item(p, L, c, item, smem, dry);
  }
}

DI void phase_finalize(const Params& p, int L, int c, bool dry) {
  const int j = L >> 1;
  u16* U = (u16*)(p.ws + OFF_U);
  const u16* YR = (const u16*)(p.ws + OFF_YR); const u16* BV = (const u16*)(p.ws + OFF_BV);
  const float* ST = (const float*)(p.ws + OFF_ST);
  const int G = gridDim.x;
  for (int idx = blockIdx.x * 256 + otid(); idx < TC * 192; idx += G * 256) {
    const int lr = idx / 192, c8 = idx - lr * 192, ch0 = c8 * 8, head = ch0 >> 6;
    const float4 st = *(const float4*)(ST + (size_t)(lr * 24 + head) * 4);
    const float mean = (st.x + st.z) * (1.f / 64.f);
    const float var = (st.y + st.w) * (1.f / 64.f) - mean * mean;
    const float rstd = rsqrtf(fmaxf(var, 0.f) + 64e-5f);
    float y[8], bv[8], g[8], o[8];
    unpack8(*(const uint4*)(YR + (size_t)lr * 1536 + ch0), y);
    unpack8(*(const uint4*)(BV + (size_t)lr * 1536 + ch0), bv);
    u16* gp = U + (size_t)lr * LDU_R + R_GATE + ch0;
    unpack8(*(const uint4*)gp, g);
    const float* gw = p.gn_w + j * 1536 + ch0; const float* gb = p.gn_b + j * 1536 + ch0;
#pragma unroll
    for (int e = 0; e < 8; ++e) o[e] = ((y[e] - mean) * rstd * gw[e] + gb[e] + bv[e]) * silu(g[e]);
    if (!dry) *(uint4*)gp = pack8(o);
  }
  if (c == 0) {
    u16* BND = (u16*)(p.ws + OFF_BND);
    for (int idx = blockIdx.x * 256 + otid(); idx < 4 * (SHIFTW / 8); idx += G * 256) {
      const int b = idx / (SHIFTW / 8), cc = idx - b * (SHIFTW / 8);
      *(uint4*)(BND + (size_t)b * SHIFTW + cc * 8) = *(const uint4*)(U + (size_t)(b * 4096 + 4095) * LDU_R + cc * 8);
    }
  }
}

enum { PH_PREP = 0, PH_NORM, PH_GEMM_IN, PH_KVPREP, PH_GEMM_UP, PH_ATTN, PH_SCAN, PH_FINALIZE, PH_GEMM_OUT, PH_FINAL };
constexpr int NSTEPS = 42;

DI void decode_step(int step, int& ph, int& L, int& c) {
  if (step == 0) { ph = PH_PREP; L = 0; c = 0; return; }
  if (step == NSTEPS - 1) { ph = PH_FINAL; L = 0; c = 0; return; }
  int s = step - 1;
  int pr = s / 20, rem = s - pr * 20;
  if (rem < 11) {
    L = 2 * pr;
    int k;
    if (rem < 6) { c = 0; k = rem; } else { c = 1; k = rem - 5; }
    ph = (k == 0) ? PH_NORM : (k == 1) ? PH_GEMM_IN : (k == 2) ? PH_KVPREP : (k == 3) ? PH_GEMM_UP : (k == 4) ? PH_ATTN : PH_GEMM_OUT;
  } else {
    rem -= 11; L = 2 * pr + 1;
    int k;
    if (rem < 5) { c = 0; k = rem; } else { c = 1; k = rem - 4; }
    ph = (k == 0) ? PH_NORM : (k == 1) ? PH_GEMM_IN : (k == 2) ? PH_SCAN : (k == 3) ? PH_FINALIZE : PH_GEMM_OUT;
  }
}

DI void run_step(const Params& p, int ph, int L, int c, char* smem, int* s_item, bool dry_in, int vt) {
  const bool dry = dry_in && !(HYP5 && (ph == PH_GEMM_IN || ph == PH_GEMM_UP));
  char* ws = p.ws;
  const bool rw = L & 1;
  const int j = L >> 1;
  switch (ph) {
    case PH_PREP: phase_prep(p, smem); break;
    case PH_NORM:
      phase_norm(p, L, c);
      if (L == 0 && c == 0) {
        EpiMemKV epi{(u16*)(ws + OFF_MEMK), (u16*)(ws + OFF_MEMVT), false};
        gemm_phase<2, false, 16>((const u16*)(ws + OFF_MEMH), 1024ull * 1024, 1024, (const u16*)(ws + OFF_WT_MEMKV), 1024ull * 1024, 1024, 4, 4, 8, 4, 1024, smem, epi, vt);
      }
      break;
    case PH_GEMM_IN:
      if (!rw) {
        EpiStoreBf16 epi{(u16*)(ws + OFF_U), LDU_M, LDU_M, dry};
        gemm_phase<2, true, 16>((const u16*)(ws + OFF_H), 0, 1024, (const u16*)(ws + OFF_WT_INMLA) + (size_t)j * 3328 * 1024, 0, 1024, 1, 64, 26, 4, 1024, smem, epi, vt);
      } else {
        EpiStoreBf16 epi{(u16*)(ws + OFF_U), LDU_R, LDU_R, dry};
        gemm_phase<2, true, 16>((const u16*)(ws + OFF_H), 0, 1024, (const u16*)(ws + OFF_WT_INRW) + (size_t)j * 7296 * 1024, 0, 1024, 1, 64, 57, 4, 1024, smem, epi, vt);
      }
      break;
    case PH_KVPREP: phase_kvprep(p, L, c, dry); break;
    case PH_GEMM_UP: {
      EpiUQ e1{(u16*)(ws + OFF_Q), (const float*)(ws + OFF_COS), (const float*)(ws + OFF_SIN), c, dry};
      gemm_phase<2, true, 6>((const u16*)(ws + OFF_U) + M_CQ, 0, LDU_M, (const u16*)(ws + OFF_WT_UQ) + (size_t)j * 2304 * 384, 0, 384, 1, 64, 18, 4, 384, smem, e1, vt);
      EpiUK e2{(u16*)(ws + OFF_K), dry};
      gemm_phase<2, true, 4>((const u16*)(ws + OFF_U) + M_CKV, 0, LDU_M, (const u16*)(ws + OFF_WT_UKV) + (size_t)j * 3072 * 256, 0, 256, 1, 64, 12, 4, 256, smem, e2, vt);
      EpiUV e3{(u16*)(ws + OFF_VT), dry};
      gemm_phase<2, false, 4>((const u16*)(ws + OFF_U) + M_CKV, 0, LDU_M, (const u16*)(ws + OFF_WT_UKV) + (size_t)j * 3072 * 256 + 1536ull * 256, 0, 256, 1, 64, 12, 4, 256, smem, e3, vt);
    } break;
    case PH_ATTN: phase_attn(p, L, c, smem, s_item, dry); break;
    case PH_SCAN: phase_scan(p, L, c, smem, s_item, dry); break;
    case PH_FINALIZE: phase_finalize(p, L, c, dry); break;
    case PH_GEMM_OUT: {
      EpiResid epi{(L == 0) ? p.x : (const float*)p.out, p.out, rw, c, dry};
      gemm_phase<2, true, 32>((const u16*)(ws + OFF_U) + (rw ? R_GATE : M_GATE), 0, rw ? LDU_R : LDU_M, (const u16*)(ws + OFF_WT_OUT) + (size_t)L * 1024 * 2048, 0, 2048,
                 1, 64, 8, 4, 2048, smem, epi, vt);
      if (c == 0 && !dry) phase_norm(p, L, 1);
    } break;
    case PH_FINAL: phase_final_norm(p, dry); break;
  }
}

DI void grid_barrier(unsigned* bar, unsigned& epoch) {
  __syncthreads();
  ++epoch;
  if (threadIdx.x == 0) {
    __builtin_amdgcn_fence(__ATOMIC_RELEASE, "agent");
    asm volatile("s_waitcnt vmcnt(0)" ::: "memory");
    const unsigned target = epoch * gridDim.x;
    __hip_atomic_fetch_add(bar, 1u, __ATOMIC_RELAXED, __HIP_MEMORY_SCOPE_AGENT);
    unsigned spins = 0;
    while (__hip_atomic_load(bar, __ATOMIC_RELAXED, __HIP_MEMORY_SCOPE_AGENT) < target) {
      __builtin_amdgcn_s_sleep(2);
      if (++spins > (1u << 22)) break;
    }
    __builtin_amdgcn_fence(__ATOMIC_ACQUIRE, "agent");
    asm volatile("s_waitcnt vmcnt(0)" ::: "memory");
  }
  __syncthreads();
}

__global__ void __launch_bounds__(256, 1) hybrid_megakernel(Params p, int s_lo, int s_hi, int coop, int probe_mask) {
  __shared__ __attribute__((aligned(16))) char smem[SMEM_BYTES];
  __shared__ int s_item;
  unsigned* bar = (unsigned*)(p.ws + OFF_BAR);
  unsigned epoch = 0;
  if (coop == 2) cg::this_grid().sync();
  __shared__ int s_vt;
  int myx = 0, myrank = 0;
  if (coop && threadIdx.x == 0) {
    myx = (int)(__builtin_amdgcn_s_getreg((3 << 11) | 20) & 7u);
    myrank = (int)__hip_atomic_fetch_add(bar + 16 + myx, 1u, __ATOMIC_RELAXED, __HIP_MEMORY_SCOPE_AGENT);
  }
  int vt = blockIdx.x;
  {
    const int G = gridDim.x, t = blockIdx.x;
    vt = ((G & 7) == 0) ? ((t & 7) * (G >> 3) + (t >> 3)) : t;
  }
  for (int st = s_lo; st < s_hi; ++st) {
    int ph, L, c;
    decode_step(st, ph, L, c);
    for (int rep = ((probe_mask >> ph) & 1) ? 0 : 1; rep < 2; ++rep) {
      run_step(p, ph, L, c, smem, &s_item, rep == 0, vt);
      if (coop && (rep == 0 || st + 1 < s_hi)) grid_barrier(bar, epoch);
      if (coop) for (int xs = 0; xs < EXTRA_SYNCS; ++xs) grid_barrier(bar, epoch);
    }
    if (coop && st == s_lo) {
      if (threadIdx.x == 0) {
        const int G = gridDim.x;
        bool ok = (G & 7) == 0;
        for (int x = 0; x < 8; ++x) ok = ok && ((int)__hip_atomic_load(bar + 16 + x, __ATOMIC_RELAXED, __HIP_MEMORY_SCOPE_AGENT) == (G >> 3));
        s_vt = ok ? (myx * (G >> 3) + myrank) : vt;
      }
      __syncthreads();
      vt = s_vt;
    }
  }
}

extern "C" void kernel_launch(void* const* d_in, const int* in_sizes, int n_in, void* d_out, int out_size, void* d_ws, size_t ws_size,
                              hipStream_t stream) {
  if (ws_size < WS_NEED) { fprintf(stderr, "workspace too small: %zu < %zu\n", ws_size, (size_t)WS_NEED); return; }
  Params p;
  memset(&p, 0, sizeof(p));
  p.x = (const float*)d_in[0]; p.mem = (const float*)d_in[1]; p.pos = (const int*)d_in[2];
  p.norm_g = (const float*)d_in[3]; p.mem_norm_g = (const float*)d_in[4]; p.w_mem_kv = (const float*)d_in[5];
  p.w_in_mla = (const float*)d_in[6]; p.q_norm_g = (const float*)d_in[7]; p.kv_norm_g = (const float*)d_in[8];
  p.w_uq = (const float*)d_in[9]; p.w_ukv = (const float*)d_in[10]; p.w_in_rwkv = (const float*)d_in[11];
  p.mu = (const float*)d_in[12]; p.w0 = (const float*)d_in[13]; p.w2 = (const float*)d_in[14]; p.a0 = (const float*)d_in[15];
  p.a2 = (const float*)d_in[16]; p.k_k = (const float*)d_in[17]; p.k_a = (const float*)d_in[18]; p.r_k = (const float*)d_in[19];
  p.gn_w = (const float*)d_in[20]; p.gn_b = (const float*)d_in[21]; p.w_out = (const float*)d_in[22]; p.final_g = (const float*)d_in[23];
  p.out = (float*)d_out; p.ws = (char*)d_ws;
  static int grid_blocks = 0;
  if (!grid_blocks) {
    int dev = 0, cus = 0, per_cu = 0;
    hipGetDevice(&dev);
    hipDeviceGetAttribute(&cus, hipDeviceAttributeMultiprocessorCount, dev);
    hipOccupancyMaxActiveBlocksPerMultiprocessor(&per_cu, hybrid_megakernel, 256, 0);
    if (per_cu > 2) per_cu = 2;
    if (per_cu < 1) per_cu = 1;
    grid_blocks = cus * per_cu;
  }
#if MULTI_LAUNCH
  for (int s = 0; s < NSTEPS; ++s) hipLaunchKernelGGL(hybrid_megakernel, dim3(grid_blocks), dim3(256), 0, stream, p, s, s + 1, 0, 0);
#else
  int s_lo = 0, s_hi = NSTEPS, coop = 1, probe_mask = PROBE_MASK;
  void* args[] = {&p, &s_lo, &s_hi, &coop, &probe_mask};
  hipMemsetAsync((char*)d_ws + OFF_BAR, 0, 256, stream);
  hipError_t e = hipLaunchCooperativeKernel((void*)hybrid_megakernel, dim3(grid_blocks), dim3(256), args, 0, stream);
  if (e != hipSuccess) fprintf(stderr, "cooperative launch failed: %s (grid %d)\n", hipGetErrorString(e), grid_blocks);
#endif
}
```

```cpp
#include <hip/hip_runtime.h>
#include <hip/hip_cooperative_groups.h>
#include <cstdio>
#include <cstring>
namespace cg = cooperative_groups;

#define PROBE_MASK 0
#define EXTRA_SYNCS 0
#define HYP1 0
#define HYP2 0
#define HYP3 0
#define HYP4 0
#define HYP5 0
#define HYP6 0
#ifndef MULTI_LAUNCH
#define MULTI_LAUNCH 0
#endif

#define DI __device__ __forceinline__
typedef unsigned short u16;
typedef __attribute__((ext_vector_type(8))) short bf16x8;
typedef __attribute__((ext_vector_type(16))) float f32x16;
typedef __attribute__((ext_vector_type(2))) __bf16 bf2_t;
typedef __attribute__((ext_vector_type(2))) float f2_t;
typedef __attribute__((ext_vector_type(4))) unsigned u32x4;
typedef __attribute__((ext_vector_type(2))) unsigned u32x2;
#define MFMA32(a, b, c) __builtin_amdgcn_mfma_f32_32x32x16_bf16((a), (b), (c), 0, 0, 0)

constexpr int SEQ = 8192, TC = 16384;
constexpr int LDU_M = 3264, LDU_R = 7296;
constexpr int M_CQ = 0, M_CKV = 384, M_KR = 640, M_QM = 704, M_GATE = 1216;
constexpr int R_R = 0, R_K = 1536, R_V = 3072, R_WD = 4608, R_AD = 4672, R_QM = 4736, R_GATE = 5248;
constexpr int SHIFTW = 4736;

constexpr size_t OFF_WT_MEMKV = 0;
constexpr size_t OFF_WT_INMLA = OFF_WT_MEMKV + 4ull * 1024 * 1024 * 2;
constexpr size_t OFF_WT_UQ    = OFF_WT_INMLA + 2ull * 3328 * 1024 * 2;
constexpr size_t OFF_WT_UKV   = OFF_WT_UQ + 2ull * 2304 * 384 * 2;
constexpr size_t OFF_WT_INRW  = OFF_WT_UKV + 2ull * 3072 * 256 * 2;
constexpr size_t OFF_WT_OUT   = OFF_WT_INRW + 2ull * 7296 * 1024 * 2;
constexpr size_t OFF_MEMH     = OFF_WT_OUT + 4ull * 1024 * 2048 * 2;
constexpr size_t OFF_MEMK     = OFF_MEMH + 4ull * 1024 * 1024 * 2;
constexpr size_t OFF_MEMVT    = OFF_MEMK + 4ull * 4 * 4 * 256 * 128 * 2;
constexpr size_t OFF_COS      = OFF_MEMVT + 4ull * 4 * 4 * 256 * 128 * 2;
constexpr size_t OFF_SIN      = OFF_COS + 32768ull * 32 * 4;
constexpr size_t OFF_CNT      = OFF_SIN + 32768ull * 32 * 4;
constexpr size_t OFF_BAR      = OFF_CNT + 4096;
constexpr size_t OFF_STATE    = OFF_BAR + 256;
constexpr size_t OFF_BND      = OFF_STATE + 96ull * 4096 * 4;
constexpr size_t OFF_H        = OFF_BND + 5ull * 4736 * 2 + 128;
constexpr size_t OFF_R        = OFF_H + 16384ull * 1024 * 2;
constexpr size_t OFF_U        = OFF_R;
constexpr size_t OFF_Q        = OFF_R + 16384ull * 3264 * 2;
constexpr size_t OFF_K        = OFF_Q + 2ull * 12 * 8192 * 192 * 2;
constexpr size_t OFF_VT       = OFF_K + 2ull * 12 * 8192 * 192 * 2;
constexpr size_t OFF_YR       = OFF_R + 16384ull * 7296 * 2;
constexpr size_t OFF_BV       = OFF_YR + 16384ull * 1536 * 2;
constexpr size_t OFF_ST       = OFF_BV + 16384ull * 1536 * 2;
constexpr size_t OFF_BS       = OFF_ST + 16384ull * 24 * 4 * 4;
constexpr size_t WS_NEED      = OFF_BS + 16384ull * 24 * 4;

constexpr int SMEM_BYTES = 149504;

struct Params {
  const float *x, *mem; const int* pos;
  const float *norm_g, *mem_norm_g, *w_mem_kv, *w_in_mla, *q_norm_g, *kv_norm_g, *w_uq, *w_ukv, *w_in_rwkv;
  const float *mu, *w0, *w2, *a0, *a2, *k_k, *k_a, *r_k, *gn_w, *gn_b, *w_out, *final_g;
  float* out; char* ws;
};

DI int otid() { int t = threadIdx.x; asm volatile("" : "+v"(t)); return t; }
DI float bf2f(unsigned v) { return __uint_as_float(v << 16); }
DI unsigned pack2(float a, float b) { f2_t v = {a, b}; bf2_t r = __builtin_convertvector(v, bf2_t); return __builtin_bit_cast(unsigned, r); }
DI u16 f2bf(float a) { return (u16)(pack2(a, 0.f) & 0xffffu); }
DI float ex2(float x) { return __builtin_amdgcn_exp2f(x); }
DI float fexp(float x) { return __builtin_amdgcn_exp2f(x * 1.4426950408889634f); }
DI float frcp(float x) { return __builtin_amdgcn_rcpf(x); }
DI float silu(float g) { return g * frcp(1.f + fexp(-g)); }
DI float wave_sum(float v) { for (int o = 32; o > 0; o >>= 1) v += __shfl_xor(v, o); return v; }
DI int crow(int reg, int h) { return (reg & 3) + 8 * (reg >> 2) + 4 * h; }
DI float dppf(float x, const int ctrl_sel) {
  int xi;
  if (ctrl_sel == 0) xi = __builtin_amdgcn_update_dpp(0, __float_as_int(x), 0xB1, 0xf, 0xf, true);
  else if (ctrl_sel == 1) xi = __builtin_amdgcn_update_dpp(0, __float_as_int(x), 0x4E, 0xf, 0xf, true);
  else xi = __builtin_amdgcn_update_dpp(0, __float_as_int(x), 0x141, 0xf, 0xf, true);
  return __int_as_float(xi);
}
DI float red4(float x) { x += dppf(x, 0); x += dppf(x, 1); return x; }
DI float red8(float x) { x += dppf(x, 0); x += dppf(x, 1); x += dppf(x, 2); return x; }
DI int gtok(bool rw, int c, int lr) { return rw ? ((lr >> 12) * 8192 + c * 4096 + (lr & 4095)) : (c * 16384 + lr); }
DI void unpack8(const uint4& v, float* f) {
  f[0] = bf2f(v.x & 0xffffu); f[1] = bf2f(v.x >> 16); f[2] = bf2f(v.y & 0xffffu); f[3] = bf2f(v.y >> 16);
  f[4] = bf2f(v.z & 0xffffu); f[5] = bf2f(v.z >> 16); f[6] = bf2f(v.w & 0xffffu); f[7] = bf2f(v.w >> 16);
}
DI uint4 pack8(const float* f) { uint4 v; v.x = pack2(f[0], f[1]); v.y = pack2(f[2], f[3]); v.z = pack2(f[4], f[5]); v.w = pack2(f[6], f[7]); return v; }

DI void transpose_tile(const float* __restrict__ src, u16* __restrict__ dst, int K, int N, int tk, int tn, int drow, float* tile) {
  const int tid = otid();
  __syncthreads();
#pragma unroll
  for (int i = 0; i < 4; ++i) {
    int kr = (tid >> 4) + 16 * i, nc = (tid & 15) * 4;
    float4 v = *(const float4*)(src + (size_t)(tk * 64 + kr) * N + tn * 64 + nc);
    tile[kr * 65 + nc] = v.x; tile[kr * 65 + nc + 1] = v.y; tile[kr * 65 + nc + 2] = v.z; tile[kr * 65 + nc + 3] = v.w;
  }
  __syncthreads();
#pragma unroll
  for (int i = 0; i < 2; ++i) {
    int n = (tid >> 3) + 32 * i, kc = (tid & 7) * 8;
    float f[8];
#pragma unroll
    for (int e = 0; e < 8; ++e) f[e] = tile[(kc + e) * 65 + n];
    *(uint4*)(dst + (size_t)(drow + n) * K + tk * 64 + kc) = pack8(f);
  }
}

DI void rms_row_bf16(const float* __restrict__ src, const float* __restrict__ g, u16* __restrict__ dst, int lane) {
  float4 v[4]; float ss = 0.f;
#pragma unroll
  for (int i = 0; i < 4; ++i) { v[i] = *(const float4*)(src + i * 256 + lane * 4); ss += v[i].x * v[i].x + v[i].y * v[i].y + v[i].z * v[i].z + v[i].w * v[i].w; }
  ss = wave_sum(ss);
  float rs = rsqrtf(ss * (1.f / 1024.f) + 1e-6f);
#pragma unroll
  for (int i = 0; i < 4; ++i) {
    float4 gg = *(const float4*)(g + i * 256 + lane * 4);
    uint2 o; o.x = pack2(v[i].x * rs * gg.x, v[i].y * rs * gg.y); o.y = pack2(v[i].z * rs * gg.z, v[i].w * rs * gg.w);
    *(uint2*)(dst + i * 256 + lane * 4) = o;
  }
}

DI void phase_prep(const Params& p, char* smem) {
  const int tid = otid(), G = gridDim.x, bid = blockIdx.x;
  char* ws = p.ws;
  if (bid == 0) for (int i = tid; i < 1024; i += 256) ((int*)(ws + OFF_CNT))[i] = 0;
  float* tile = (float*)smem;
  for (int g0 = bid; g0 < 9168; g0 += G) {
    int g = g0;
    const float* src = nullptr; u16* dst = nullptr; int K = 0, N = 0; size_t dstr = 0; bool ukv = false;
    if (g < 1024) { src = p.w_mem_kv; dst = (u16*)(ws + OFF_WT_MEMKV); K = 1024; N = 1024; dstr = 1024ull * 1024; }
    else if ((g -= 1024) < 1632) { src = p.w_in_mla; dst = (u16*)(ws + OFF_WT_INMLA); K = 1024; N = 3264; dstr = 3328ull * 1024; }
    else if ((g -= 1632) < 432) { src = p.w_uq; dst = (u16*)(ws + OFF_WT_UQ); K = 384; N = 2304; dstr = 2304ull * 384; }
    else if ((g -= 432) < 384) { src = p.w_ukv; dst = (u16*)(ws + OFF_WT_UKV); K = 256; N = 3072; dstr = 3072ull * 256; ukv = true; }
    else if ((g -= 384) < 3648) { src = p.w_in_rwkv; dst = (u16*)(ws + OFF_WT_INRW); K = 1024; N = 7296; dstr = 7296ull * 1024; }
    else { g -= 3648; src = p.w_out; dst = (u16*)(ws + OFF_WT_OUT); K = 2048; N = 1024; dstr = 1024ull * 2048; }
    int ntn = N >> 6, per = (K >> 6) * ntn;
    int m = g / per, t = g - m * per;
    int tk = t / ntn, tn = t - tk * ntn;
    int drow = tn * 64;
    if (ukv) { const int hd = drow >> 8, dd = drow & 255; drow = (dd < 128) ? (hd * 128 + dd) : (1536 + hd * 128 + dd - 128); }
    transpose_tile(src + (size_t)m * K * N, dst + (size_t)m * dstr, K, N, tk, tn, drow, tile);
  }
  for (int i = bid * 256 + tid; i < 2 * 64 * 1024 / 8; i += G * 256) {
    int m = i / (64 * 1024 / 8), r = i - m * (64 * 1024 / 8);
    uint4 z; z.x = z.y = z.z = z.w = 0u;
    *(uint4*)((u16*)(ws + OFF_WT_INMLA) + (size_t)m * 3328 * 1024 + 3264ull * 1024 + (size_t)r * 8) = z;
  }
  for (int i = bid * 256 + tid; i < SHIFTW / 8; i += G * 256) { uint4 z; z.x = z.y = z.z = z.w = 0u; *(uint4*)((u16*)(ws + OFF_BND) + 4 * SHIFTW + i * 8) = z; }
  float* cs = (float*)(ws + OFF_COS); float* sn = (float*)(ws + OFF_SIN);
  for (int i = bid * 256 + tid; i < 32768 * 32; i += G * 256) {
    int tk = i >> 5, pi = i & 31;
    float inv_freq = (float)exp2(-(double)(2 * pi) / 64.0 * 13.287712379549449);
    float ang = (float)p.pos[tk] * inv_freq;
    double rev = (double)ang * 0.15915494309189535;
    float fr = (float)(rev - rint(rev));
    cs[i] = __builtin_amdgcn_cosf(fr); sn[i] = __builtin_amdgcn_sinf(fr);
  }
  const int w = tid >> 6, lane = tid & 63;
  for (int row = bid * 4 + w; row < 4096; row += G * 4) {
    int L = row >> 10, m = row & 1023;
    rms_row_bf16(p.mem + (size_t)m * 1024, p.mem_norm_g + L * 1024, (u16*)(ws + OFF_MEMH) + (size_t)row * 1024, lane);
  }
}

DI void phase_norm(const Params& p, int L, int c) {
  const int tid = otid(), w = tid >> 6, lane = tid & 63;
  const bool rw = L & 1;
  const float* xs = (L == 0) ? p.x : p.out;
  u16* H = (u16*)(p.ws + OFF_H);
  for (int lr = blockIdx.x * 4 + w; lr < TC; lr += gridDim.x * 4) {
    int gt = gtok(rw, c, lr);
    rms_row_bf16(xs + (size_t)gt * 1024, p.norm_g + L * 1024, H + (size_t)lr * 1024, lane);
  }
}

DI void phase_final_norm(const Params& p, bool dry) {
  const int tid = otid(), w = tid >> 6, lane = tid & 63;
  for (int row = blockIdx.x * 4 + w; row < 32768; row += gridDim.x * 4) {
    float* xr = p.out + (size_t)row * 1024;
    float4 v[4]; float ss = 0.f;
#pragma unroll
    for (int i = 0; i < 4; ++i) { v[i] = *(const float4*)(xr + i * 256 + lane * 4); ss += v[i].x * v[i].x + v[i].y * v[i].y + v[i].z * v[i].z + v[i].w * v[i].w; }
    ss = wave_sum(ss);
    float rs = rsqrtf(ss * (1.f / 1024.f) + 1e-6f);
#pragma unroll
    for (int i = 0; i < 4; ++i) {
      float4 gg = *(const float4*)(p.final_g + i * 256 + lane * 4);
      float4 o; o.x = v[i].x * rs * gg.x; o.y = v[i].y * rs * gg.y; o.z = v[i].z * rs * gg.z; o.w = v[i].w * rs * gg.w;
      if (!dry) *(float4*)(xr + i * 256 + lane * 4) = o;
    }
  }
}

template <int TJ, bool SWAP, int NK, class Epi>
DI void gemm_phase(const u16* __restrict__ A, size_t strideAz, int lda, const u16* __restrict__ Bt, size_t strideBz, int ldb,
                   int Z, int Mt, int Nt, int GM, int K, char* smem, const Epi& epi, int vt) {
  constexpr int BN = 64 * TJ;
  constexpr int NB = BN / 32;
  const int tid = otid(), w = tid >> 6, lane = tid & 63, r = lane & 31, h = lane >> 5;
  const int wm = w >> 1, wn = w & 1;
  u16* As = (u16*)smem;
  u16* Bs = As + 2 * 256 * 72;
  const int G = gridDim.x, per = Mt * Nt, total = Z * per;
  const int lrow = tid >> 3, lcc = (tid & 7) * 8;
  unsigned aoff[8], boff[NB];
#pragma unroll
  for (int i = 0; i < 8; ++i) aoff[i] = (unsigned)((lrow + 32 * i) * lda + lcc);
#pragma unroll
  for (int i = 0; i < NB; ++i) boff[i] = (unsigned)((lrow + 32 * i) * ldb + lcc);
  const int lds_st = lrow * 72 + lcc;
  for (int base = 0; base < total; base += G) {
    const int q = base + vt;
    if (q >= total) continue;
    const int z = q / per, qq = q - z * per;
    const int grp = qq / (GM * Nt), within = qq - grp * GM * Nt;
    const int mt = grp * GM + (within % GM), nt = within / GM;
    const u16* Ag = A + z * strideAz + (size_t)(mt * 256) * lda;
    const u16* Bg = Bt + z * strideBz + (size_t)(nt * BN) * ldb;
    u32x4 ra[2][8], rb[2][NB];
    f32x16 acc[4][TJ];
#pragma unroll
    for (int i = 0; i < 4; ++i)
#pragma unroll
      for (int j = 0; j < TJ; ++j)
#pragma unroll
        for (int e = 0; e < 16; ++e) acc[i][j][e] = 0.f;
    __syncthreads();
#pragma unroll
    for (int i = 0; i < 8; ++i) ra[0][i] = *(const u32x4*)(Ag + aoff[i]);
#pragma unroll
    for (int i = 0; i < NB; ++i) rb[0][i] = *(const u32x4*)(Bg + boff[i]);
#pragma unroll
    for (int i = 0; i < 8; ++i) ra[1][i] = *(const u32x4*)(Ag + 64 + aoff[i]);
#pragma unroll
    for (int i = 0; i < NB; ++i) rb[1][i] = *(const u32x4*)(Bg + 64 + boff[i]);
#pragma unroll
    for (int i = 0; i < 8; ++i) *(u32x4*)(As + lds_st + (32 * i) * 72) = ra[0][i];
#pragma unroll
    for (int i = 0; i < NB; ++i) *(u32x4*)(Bs + lds_st + (32 * i) * 72) = rb[0][i];
    __syncthreads();
    bf16x8 af[2][4], bfr[2][TJ];
#pragma unroll
    for (int kt = 0; kt < NK; ++kt) {
      constexpr int dummy = 0; (void)dummy;
      const int u = kt & 1;
      const u16* as = As + u * 256 * 72 + (128 * wm + r) * 72 + 8 * h;
      const u16* bs = Bs + u * BN * 72 + (32 * TJ * wn + r) * 72 + 8 * h;
      if (kt == 0) {
#pragma unroll
        for (int i = 0; i < 4; ++i) af[0][i] = *(const bf16x8*)(as + (32 * i) * 72);
#pragma unroll
        for (int j = 0; j < TJ; ++j) bfr[0][j] = *(const bf16x8*)(bs + (32 * j) * 72);
      }
#pragma unroll
      for (int ks = 0; ks < 4; ++ks) {
        if (ks < 3) {
#pragma unroll
          for (int i = 0; i < 4; ++i) af[(ks + 1) & 1][i] = *(const bf16x8*)(as + (32 * i) * 72 + 16 * (ks + 1));
#pragma unroll
          for (int j = 0; j < TJ; ++j) bfr[(ks + 1) & 1][j] = *(const bf16x8*)(bs + (32 * j) * 72 + 16 * (ks + 1));
        } else if (kt + 1 < NK) {
          const u16* asn = As + (u ^ 1) * 256 * 72 + (128 * wm + r) * 72 + 8 * h;
          const u16* bsn = Bs + (u ^ 1) * BN * 72 + (32 * TJ * wn + r) * 72 + 8 * h;
#pragma unroll
          for (int i = 0; i < 4; ++i) af[0][i] = *(const bf16x8*)(asn + (32 * i) * 72);
#pragma unroll
          for (int j = 0; j < TJ; ++j) bfr[0][j] = *(const bf16x8*)(bsn + (32 * j) * 72);
        }
        __builtin_amdgcn_sched_barrier(0);
#pragma unroll
        for (int i = 0; i < 4; ++i)
#pragma unroll
          for (int j = 0; j < TJ; ++j)
            acc[i][j] = SWAP ? MFMA32(bfr[ks & 1][j], af[ks & 1][i], acc[i][j]) : MFMA32(af[ks & 1][i], bfr[ks & 1][j], acc[i][j]);
        if (ks == 0 && kt + 2 < NK) {
          const u16* ag = Ag + (kt + 2) * 64;
#pragma unroll
          for (int i = 0; i < 8; ++i) ra[u][i] = *(const u32x4*)(ag + aoff[i]);
#pragma unroll
          for (int i = 0; i < 8; ++i) { __builtin_amdgcn_sched_group_barrier(0x008, 1, 0); __builtin_amdgcn_sched_group_barrier(0x020, 1, 0); }
        }
        if (ks == 2 && kt + 2 < NK) {
          const u16* bg = Bg + (kt + 2) * 64;
#pragma unroll
          for (int i = 0; i < NB; ++i) rb[u][i] = *(const u32x4*)(bg + boff[i]);
#pragma unroll
          for (int i = 0; i < NB; ++i) { __builtin_amdgcn_sched_group_barrier(0x008, 1, 0); __builtin_amdgcn_sched_group_barrier(0x020, 1, 0); }
        }
        if (ks == 1 && kt + 1 < NK) {
          u16* ad = As + (u ^ 1) * 256 * 72 + lds_st; u16* bd = Bs + (u ^ 1) * BN * 72 + lds_st;
#pragma unroll
          for (int i = 0; i < 8; ++i) *(u32x4*)(ad + (32 * i) * 72) = ra[u ^ 1][i];
#pragma unroll
          for (int i = 0; i < NB; ++i) *(u32x4*)(bd + (32 * i) * 72) = rb[u ^ 1][i];
#pragma unroll
          for (int i = 0; i < 6; ++i) { __builtin_amdgcn_sched_group_barrier(0x008, 1, 0); __builtin_amdgcn_sched_group_barrier(0x200, 2, 0); }
        }
        __builtin_amdgcn_sched_barrier(0);
        if (ks == 2) __syncthreads();
      }
    }
#pragma unroll
    for (int i = 0; i < 4; ++i)
#pragma unroll
      for (int j = 0; j < TJ; ++j) {
        if (SWAP) epi(z, mt * 256 + 128 * wm + 32 * i + r, nt * BN + 32 * TJ * wn + 32 * j, h, acc[i][j]);
        else epi(z, mt * 256 + 128 * wm + 32 * i, nt * BN + 32 * TJ * wn + 32 * j + r, h, acc[i][j]);
      }
  }
}

struct EpiStoreBf16 {
  u16* C; int ldc; int ncols; bool dry;
  DI void operator()(int z, int row, int colbase, int h, const f32x16& a) const {
    if (dry) return;
#pragma unroll
    for (int g = 0; g < 4; ++g) {
      const int col = colbase + 8 * g + 4 * h;
      if (col < ncols) {
        u32x2 pk = {pack2(a[4 * g], a[4 * g + 1]), pack2(a[4 * g + 2], a[4 * g + 3])};
        *(u32x2*)(C + (size_t)row * ldc + col) = pk;
      }
    }
  }
};
struct EpiResid {
  const float* xin; float* xout; bool rw; int c; bool dry;
  DI void operator()(int z, int row, int colbase, int h, const f32x16& a) const {
    if (dry) return;
    const size_t o = (size_t)gtok(rw, c, row) * 1024 + colbase + 4 * h;
#pragma unroll
    for (int g = 0; g < 4; ++g) {
      float4 v = *(const float4*)(xin + o + 8 * g);
      v.x += a[4 * g]; v.y += a[4 * g + 1]; v.z += a[4 * g + 2]; v.w += a[4 * g + 3];
      *(float4*)(xout + o + 8 * g) = v;
    }
  }
};
struct EpiUQ {
  u16* Q; const float* cs; const float* sn; int c; bool dry;
  DI void operator()(int z, int row, int colbase, int h, const f32x16& a) const {
    if (dry) return;
    const int head = colbase / 192, db = colbase - head * 192;
    const int lb = row >> 13, s = row & 8191;
    u16* qp = Q + ((size_t)(lb * 12 + head) * 8192 + s) * 192 + db + 4 * h;
    const size_t ti = (size_t)(c * 16384 + row) * 32;
#pragma unroll
    for (int g = 0; g < 4; ++g) {
      float v0 = a[4 * g], v1 = a[4 * g + 1], v2 = a[4 * g + 2], v3 = a[4 * g + 3];
      if (db >= 128) {
        const int pi = (db - 128 + 8 * g + 4 * h) >> 1;
        const float2 cc = *(const float2*)(cs + ti + pi), ss = *(const float2*)(sn + ti + pi);
        const float o0 = v0 * cc.x - v1 * ss.x, o1 = v0 * ss.x + v1 * cc.x;
        const float o2 = v2 * cc.y - v3 * ss.y, o3 = v2 * ss.y + v3 * cc.y;
        v0 = o0; v1 = o1; v2 = o2; v3 = o3;
      }
      u32x2 pk = {pack2(v0, v1), pack2(v2, v3)};
      *(u32x2*)(qp + 8 * g) = pk;
    }
  }
};
struct EpiUK {
  u16* Kb; bool dry;
  DI void operator()(int z, int row, int colbase, int h, const f32x16& a) const {
    if (dry) return;
    const int head = colbase >> 7, db = colbase & 127;
    const int lb = row >> 13, s = row & 8191;
    u16* kp = Kb + ((size_t)(lb * 12 + head) * 8192 + s) * 192 + db + 4 * h;
#pragma unroll
    for (int g = 0; g < 4; ++g) {
      u32x2 pk = {pack2(a[4 * g], a[4 * g + 1]), pack2(a[4 * g + 2], a[4 * g + 3])};
      *(u32x2*)(kp + 8 * g) = pk;
    }
  }
};
struct EpiUV {
  u16* Vt; bool dry;
  DI void operator()(int z, int rowbase, int col, int h, const f32x16& a) const {
    if (dry) return;
    const int head = col >> 7, d = col & 127;
#pragma unroll
    for (int g = 0; g < 4; ++g) {
      int lr = rowbase + 8 * g + 4 * h; int lb = lr >> 13, s = lr & 8191;
      u32x2 pk = {pack2(a[4 * g], a[4 * g + 1]), pack2(a[4 * g + 2], a[4 * g + 3])};
      *(u32x2*)(Vt + (((size_t)(lb * 12 + head) * 128 + (s >> 6)) * 128 + d) * 64 + (s & 63)) = pk;
    }
  }
};
struct EpiMemKV {
  u16* MK; u16* MVt; bool dry;
  DI void operator()(int z, int rowbase, int col, int h, const f32x16& a) const {
    if (col < 512) {
      const int xh = col >> 7, d = col & 127;
#pragma unroll
      for (int e = 0; e < 16; ++e) {
        int m = rowbase + crow(e, h); int b = m >> 8, mi = m & 255;
        MK[((size_t)((z * 4 + b) * 4 + xh) * 256 + mi) * 128 + d] = f2bf(a[e]);
      }
    } else {
      const int n = col - 512, xh = n >> 7, d = n & 127;
#pragma unroll
      for (int g = 0; g < 4; ++g) {
        int m = rowbase + 8 * g + 4 * h; int b = m >> 8, mi = m & 255;
        uint2 pk; pk.x = pack2(a[4 * g], a[4 * g + 1]); pk.y = pack2(a[4 * g + 2], a[4 * g + 3]);
        *(uint2*)(MVt + (((size_t)((z * 4 + b) * 4 + xh) * 4 + (mi >> 6)) * 128 + d) * 64 + (mi & 63)) = pk;
      }
    }
  }
};

DI void phase_kvprep(const Params& p, int L, int c, bool dry) {
  const int tid = otid(), w = tid >> 6, lane = tid & 63;
  const int j = L >> 1;
  u16* U = (u16*)(p.ws + OFF_U); u16* Kb = (u16*)(p.ws + OFF_K);
  const float* cs = (const float*)(p.ws + OFF_COS); const float* sn = (const float*)(p.ws + OFF_SIN);
  for (int lr = blockIdx.x * 4 + w; lr < TC; lr += gridDim.x * 4) {
    u16* row = U + (size_t)lr * LDU_M;
    float fq[8], fk[8]; float sq = 0.f, sk = 0.f;
    if (lane < 48) { uint4 v = *(const uint4*)(row + M_CQ + lane * 8); unpack8(v, fq);
#pragma unroll
      for (int e = 0; e < 8; ++e) sq += fq[e] * fq[e]; }
    if (lane < 32) { uint4 v = *(const uint4*)(row + M_CKV + lane * 8); unpack8(v, fk);
#pragma unroll
      for (int e = 0; e < 8; ++e) sk += fk[e] * fk[e]; }
    sq = wave_sum(sq); sk = wave_sum(sk);
    float rq = rsqrtf(sq * (1.f / 384.f) + 1e-6f), rk = rsqrtf(sk * (1.f / 256.f) + 1e-6f);
    if (dry) continue;
    if (lane < 48) {
      const float* g = p.q_norm_g + j * 384 + lane * 8;
#pragma unroll
      for (int e = 0; e < 8; ++e) fq[e] = fq[e] * rq * g[e];
      *(uint4*)(row + M_CQ + lane * 8) = pack8(fq);
    }
    if (lane < 32) {
      const float* g = p.kv_norm_g + j * 256 + lane * 8;
#pragma unroll
      for (int e = 0; e < 8; ++e) fk[e] = fk[e] * rk * g[e];
      *(uint4*)(row + M_CKV + lane * 8) = pack8(fk);
    }
    if (lane < 8) {
      float f[8], o[8]; uint4 v = *(const uint4*)(row + M_KR + lane * 8); unpack8(v, f);
      int gt = c * 16384 + lr;
#pragma unroll
      for (int i = 0; i < 4; ++i) {
        float cc = cs[gt * 32 + lane * 4 + i], ss = sn[gt * 32 + lane * 4 + i];
        o[2 * i] = f[2 * i] * cc - f[2 * i + 1] * ss; o[2 * i + 1] = f[2 * i] * ss + f[2 * i + 1] * cc;
      }
      uint4 pk = pack8(o);
      int lb = lr >> 13, s = lr & 8191;
#pragma unroll
      for (int hd = 0; hd < 12; ++hd) *(uint4*)(Kb + ((size_t)(lb * 12 + hd) * 8192 + s) * 192 + 128 + lane * 8) = pk;
    }
  }
}

template <int DQK>
DI void attn_item(const u16* __restrict__ Qp, int ldq, const u16* __restrict__ Kp, const u16* __restrict__ Vtp, int ldv,
                  int nkt, int q0, bool causal, float c, u16* Yp, int ldy, char* smem, bool dry) {
  constexpr int KLD = DQK + 8;
  constexpr int NKC = DQK * 64 / 8 / 256;
  constexpr int NKS = DQK / 16;
  constexpr int CPR = DQK / 8;
  constexpr int BUFE = 64 * KLD + 128 * 72;
  u16* L0 = (u16*)smem;
  const int tid = otid(), w = tid >> 6, lane = tid & 63, r = lane & 31, h = lane >> 5;
  bf16x8 qf[NKS];
  {
    const u16* qrow = Qp + (size_t)(32 * w + r) * ldq + 8 * h;
#pragma unroll
    for (int ks = 0; ks < NKS; ++ks) qf[ks] = *(const bf16x8*)(qrow + 16 * ks);
  }
  f32x16 o[4];
#pragma unroll
  for (int dt = 0; dt < 4; ++dt)
#pragma unroll
    for (int e = 0; e < 16; ++e) o[dt][e] = 0.f;
  float m = -INFINITY, l = 0.f;
  u32x4 kst[NKC], vst[4];
  const int vd = tid >> 3, vc8 = tid & 7;
  int kso[NKC];
#pragma unroll
  for (int i = 0; i < NKC; ++i) { int id = tid + 256 * i; int row = id / CPR, cc = id - row * CPR; kso[i] = row * KLD + cc * 8; }
  const int vso = 64 * KLD + vd * 72 + 16 * (vc8 >> 1) + 4 * (vc8 & 1);
  __syncthreads();
#pragma unroll
  for (int i = 0; i < NKC; ++i) kst[i] = *(const u32x4*)(Kp + (size_t)(tid + 256 * i) * 8);
#pragma unroll
  for (int i = 0; i < 4; ++i) vst[i] = *(const u32x4*)(Vtp + (size_t)(tid + 256 * i) * 8);
#pragma unroll
  for (int i = 0; i < NKC; ++i) *(u32x4*)(L0 + kso[i]) = kst[i];
#pragma unroll
  for (int i = 0; i < 4; ++i) {
    u16* dst = L0 + vso + (32 * i) * 72;
    u32x2 lo = {vst[i].x, vst[i].y}, hi = {vst[i].z, vst[i].w};
    *(u32x2*)dst = lo; *(u32x2*)(dst + 8) = hi;
  }
  if (nkt > 1) {
    const u16* kg = Kp + (size_t)64 * DQK;
#pragma unroll
    for (int i = 0; i < NKC; ++i) kst[i] = *(const u32x4*)(kg + (size_t)(tid + 256 * i) * 8);
#pragma unroll
    for (int i = 0; i < 4; ++i) vst[i] = *(const u32x4*)(Vtp + 8192 + (size_t)(tid + 256 * i) * 8);
  }
  __syncthreads();
  const int qmin = q0 + 32 * w;
  for (int kt = 0; kt < nkt; ++kt) {
    const u16* Ks = L0 + (kt & 1) * BUFE;
    const u16* Vs = Ks + 64 * KLD;
    u16* Ln = L0 + ((kt + 1) & 1) * BUFE;
    const bool active = !(causal && kt * 64 > qmin + 31);
    f32x16 s0, s1;
#pragma unroll
    for (int e = 0; e < 16; ++e) { s0[e] = 0.f; s1[e] = 0.f; }
    const u16* k0 = Ks + r * KLD + 8 * h;
    bf16x8 ka[2][2];
    if (active) {
      ka[0][0] = *(const bf16x8*)(k0); ka[0][1] = *(const bf16x8*)(k0 + 32 * KLD);
      ka[1][0] = *(const bf16x8*)(k0 + 16); ka[1][1] = *(const bf16x8*)(k0 + 32 * KLD + 16);
      __builtin_amdgcn_sched_barrier(0);
      s0 = MFMA32(ka[0][0], qf[0], s0); s1 = MFMA32(ka[0][1], qf[0], s1);
    }
    if (kt + 1 < nkt) {
#pragma unroll
      for (int i = 0; i < NKC; ++i) *(u32x4*)(Ln + kso[i]) = kst[i];
#pragma unroll
      for (int i = 0; i < 4; ++i) {
        u16* dst = Ln + vso + (32 * i) * 72;
        u32x2 lo = {vst[i].x, vst[i].y}, hi = {vst[i].z, vst[i].w};
        *(u32x2*)dst = lo; *(u32x2*)(dst + 8) = hi;
      }
    }
    if (kt + 2 < nkt) {
      const u16* kg = Kp + (size_t)(kt + 2) * 64 * DQK;
#pragma unroll
      for (int i = 0; i < NKC; ++i) kst[i] = *(const u32x4*)(kg + (size_t)(tid + 256 * i) * 8);
#pragma unroll
      for (int i = 0; i < 4; ++i) vst[i] = *(const u32x4*)(Vtp + (size_t)(kt + 2) * 8192 + (size_t)(tid + 256 * i) * 8);
    }
    if (active) {
      __builtin_amdgcn_sched_barrier(0);
#pragma unroll
      for (int ks = 1; ks < NKS; ++ks) {
        if (ks + 1 < NKS) {
          ka[(ks + 1) & 1][0] = *(const bf16x8*)(k0 + 16 * (ks + 1));
          ka[(ks + 1) & 1][1] = *(const bf16x8*)(k0 + 32 * KLD + 16 * (ks + 1));
        }
        __builtin_amdgcn_sched_barrier(0);
        s0 = MFMA32(ka[ks & 1][0], qf[ks], s0); s1 = MFMA32(ka[ks & 1][1], qf[ks], s1);
        __builtin_amdgcn_sched_barrier(0);
      }
      const u16* v0 = Vs + r * 72 + 8 * h;
      bf16x8 va[2][4];
#pragma unroll
      for (int dt = 0; dt < 4; ++dt) va[0][dt] = *(const bf16x8*)(v0 + (32 * dt) * 72);
      if (causal && kt * 64 + 63 > qmin) {
        const int qi = qmin + r;
#pragma unroll
        for (int e = 0; e < 16; ++e) {
          int key = kt * 64 + crow(e, h);
          if (key > qi) s0[e] = -INFINITY;
          if (key + 32 > qi) s1[e] = -INFINITY;
        }
      }
      float mx = fmaxf(s0[0], s1[0]);
#pragma unroll
      for (int e = 1; e < 16; ++e) mx = fmaxf(mx, fmaxf(s0[e], s1[e]));
      mx = fmaxf(mx, __shfl_xor(mx, 32));
      if (__builtin_amdgcn_ballot_w64((mx - m) * c > 8.f) != 0ull) {
        const float mn = fmaxf(m, mx);
        const float alpha = ex2((m - mn) * c);
        m = mn;
        l *= alpha;
#pragma unroll
        for (int dt = 0; dt < 4; ++dt)
#pragma unroll
          for (int e = 0; e < 16; ++e) o[dt][e] *= alpha;
      }
      const float mc = m * c;
      float ps = 0.f;
#pragma unroll
      for (int e = 0; e < 16; ++e) { s0[e] = ex2(fmaf(s0[e], c, -mc)); s1[e] = ex2(fmaf(s1[e], c, -mc)); ps += s0[e] + s1[e]; }
      l += ps;
      bf16x8 pf[4];
      {
        u32x4 t;
        t.x = pack2(s0[0], s0[1]); t.y = pack2(s0[2], s0[3]); t.z = pack2(s0[4], s0[5]); t.w = pack2(s0[6], s0[7]); pf[0] = __builtin_bit_cast(bf16x8, t);
        t.x = pack2(s0[8], s0[9]); t.y = pack2(s0[10], s0[11]); t.z = pack2(s0[12], s0[13]); t.w = pack2(s0[14], s0[15]); pf[1] = __builtin_bit_cast(bf16x8, t);
        t.x = pack2(s1[0], s1[1]); t.y = pack2(s1[2], s1[3]); t.z = pack2(s1[4], s1[5]); t.w = pack2(s1[6], s1[7]); pf[2] = __builtin_bit_cast(bf16x8, t);
        t.x = pack2(s1[8], s1[9]); t.y = pack2(s1[10], s1[11]); t.z = pack2(s1[12], s1[13]); t.w = pack2(s1[14], s1[15]); pf[3] = __builtin_bit_cast(bf16x8, t);
      }
#pragma unroll
      for (int kk = 0; kk < 4; ++kk) {
        if (kk < 3) {
#pragma unroll
          for (int dt = 0; dt < 4; ++dt) va[(kk + 1) & 1][dt] = *(const bf16x8*)(v0 + (32 * dt) * 72 + 16 * (kk + 1));
        }
        __builtin_amdgcn_sched_barrier(0);
#pragma unroll
        for (int dt = 0; dt < 4; ++dt) o[dt] = MFMA32(va[kk & 1][dt], pf[kk], o[dt]);
        __builtin_amdgcn_sched_barrier(0);
      }
    }
    __syncthreads();
  }
  const float lt = l + __shfl_xor(l, 32);
  const float inv = 1.f / lt;
  if (dry) return;
  u16* yrow = Yp + (size_t)(32 * w + r) * ldy;
#pragma unroll
  for (int dt = 0; dt < 4; ++dt)
#pragma unroll
    for (int g = 0; g < 4; ++g) {
      const int d = 32 * dt + 8 * g + 4 * h;
      uint2 gv = *(const uint2*)(yrow + d);
      float g0 = bf2f(gv.x & 0xffffu), g1 = bf2f(gv.x >> 16), g2 = bf2f(gv.y & 0xffffu), g3 = bf2f(gv.y >> 16);
      uint2 ov;
      ov.x = pack2(o[dt][4 * g] * inv * silu(g0), o[dt][4 * g + 1] * inv * silu(g1));
      ov.y = pack2(o[dt][4 * g + 2] * inv * silu(g2), o[dt][4 * g + 3] * inv * silu(g3));
      *(uint2*)(yrow + d) = ov;
    }
}

template <int DQK>
DI void attn_item_c(const u16* __restrict__ Qp, int ldq, const u16* __restrict__ Kp, const u16* __restrict__ Vtp, int ldv,
                    int nkt, int q0, float c, u16* Yp, int ldy, char* smem, bool dry) {
  constexpr int KLD = DQK + 8;
  constexpr int NKC = DQK * 64 / 8 / 256;
  constexpr int NKS = DQK / 16;
  constexpr int CPR = DQK / 8;
  constexpr int BUFE = 64 * KLD + 128 * 72;
  u16* L0 = (u16*)smem;
  const int tid = otid(), w = tid >> 6, lane = tid & 63, r = lane & 31, h = lane >> 5;
  bf16x8 qf[NKS];
  {
    const u16* qrow = Qp + (size_t)(32 * w + r) * ldq + 8 * h;
#pragma unroll
    for (int ks = 0; ks < NKS; ++ks) qf[ks] = *(const bf16x8*)(qrow + 16 * ks);
  }
  f32x16 o[4];
#pragma unroll
  for (int dt = 0; dt < 4; ++dt)
#pragma unroll
    for (int e = 0; e < 16; ++e) o[dt][e] = 0.f;
  float m = -INFINITY, l = 0.f;
  u32x4 kstA[NKC], vstA[4], kstB[NKC], vstB[4];
  const int vd = tid >> 3, vc8 = tid & 7;
  int kso[NKC];
#pragma unroll
  for (int i = 0; i < NKC; ++i) { int id = tid + 256 * i; int row = id / CPR, cc = id - row * CPR; kso[i] = row * KLD + cc * 8; }
  const int vso = 64 * KLD + vd * 72 + 16 * (vc8 >> 1) + 4 * (vc8 & 1);
  const int nktp = (nkt + 3) & ~3;
  auto gload = [&](u32x4* ks_, u32x4* vs_, int j) {
    const u16* kg = Kp + (size_t)(j + 1) * 64 * DQK;
#pragma unroll
    for (int i = 0; i < NKC; ++i) ks_[i] = *(const u32x4*)(kg + (size_t)(tid + 256 * i) * 8);
#pragma unroll
    for (int i = 0; i < 4; ++i) vs_[i] = *(const u32x4*)(Vtp + (size_t)j * 8192 + (size_t)(tid + 256 * i) * 8);
  };
  auto lstore = [&](const u32x4* ks_, const u32x4* vs_, u16* Lb) {
#pragma unroll
    for (int i = 0; i < NKC; ++i) *(u32x4*)(Lb + kso[i]) = ks_[i];
#pragma unroll
    for (int i = 0; i < 4; ++i) {
      u16* dst = Lb + vso + (32 * i) * 72;
      u32x2 lo = {vs_[i].x, vs_[i].y}, hi = {vs_[i].z, vs_[i].w};
      *(u32x2*)dst = lo; *(u32x2*)(dst + 8) = hi;
    }
  };
  auto gloadK = [&](u32x4* ks_, int j) {
    const u16* kg = Kp + (size_t)(j + 1) * 64 * DQK;
#pragma unroll
    for (int i = 0; i < NKC; ++i) ks_[i] = *(const u32x4*)(kg + (size_t)(tid + 256 * i) * 8);
  };
  auto gloadV = [&](u32x4* vs_, int j) {
#pragma unroll
    for (int i = 0; i < 4; ++i) vs_[i] = *(const u32x4*)(Vtp + (size_t)j * 8192 + (size_t)(tid + 256 * i) * 8);
  };
  auto lstoreK = [&](const u32x4* ks_, u16* Lb) {
#pragma unroll
    for (int i = 0; i < NKC; ++i) *(u32x4*)(Lb + kso[i]) = ks_[i];
  };
  auto lstoreV = [&](const u32x4* vs_, u16* Lb) {
#pragma unroll
    for (int i = 0; i < 4; ++i) {
      u16* dst = Lb + vso + (32 * i) * 72;
      u32x2 lo = {vs_[i].x, vs_[i].y}, hi = {vs_[i].z, vs_[i].w};
      *(u32x2*)dst = lo; *(u32x2*)(dst + 8) = hi;
    }
  };
  __syncthreads();
  gload(kstA, vstA, 0);
  gload(kstB, vstB, 1);
  f32x16 sa0, sa1, sb0, sb1;
#pragma unroll
  for (int e = 0; e < 16; ++e) { sa0[e] = 0.f; sa1[e] = 0.f; }
  {
    const u16* kr = Kp + (size_t)r * DQK + 8 * h;
#pragma unroll
    for (int ks = 0; ks < NKS; ++ks) {
      bf16x8 a0 = *(const bf16x8*)(kr + 16 * ks), a1 = *(const bf16x8*)(kr + 32 * DQK + 16 * ks);
      sa0 = MFMA32(a0, qf[ks], sa0); sa1 = MFMA32(a1, qf[ks], sa1);
    }
  }
  lstore(kstA, vstA, L0);
  gload(kstA, vstA, 2);
  __syncthreads();
  const int qmin = q0 + 32 * w;
  const int qi = qmin + r;
  auto body = [&](int kt, u32x4* wk, u32x4* wv, f32x16& s0, f32x16& s1, f32x16& n0, f32x16& n1) {
    const u16* Ks = L0 + (kt & 1) * BUFE;
    const u16* Vs = Ks + 64 * KLD;
    u16* Ln = L0 + ((kt + 1) & 1) * BUFE;
    const bool active = !(kt * 64 > qmin + 31);
    if (kt * 64 + 63 > qmin) {
#pragma unroll
      for (int e = 0; e < 16; ++e) {
        int key = kt * 64 + crow(e, h);
        if (key > qi) s0[e] = -INFINITY;
        if (key + 32 > qi) s1[e] = -INFINITY;
      }
    }
    float mx = fmaxf(s0[0], s1[0]);
#pragma unroll
    for (int e = 1; e < 16; ++e) mx = fmaxf(fmaxf(mx, s0[e]), s1[e]);
    mx = fmaxf(mx, __shfl_xor(mx, 32));
    if (__builtin_amdgcn_ballot_w64((mx - m) * c > 8.f) != 0ull) {
      const float mn = fmaxf(m, mx);
      const float alpha = ex2((m - mn) * c);
      m = mn;
      l *= alpha;
#pragma unroll
      for (int dt = 0; dt < 4; ++dt)
#pragma unroll
        for (int e = 0; e < 16; ++e) o[dt][e] *= alpha;
    }
    const float mc = m * c;
#pragma unroll
    for (int e = 0; e < 16; ++e) { n0[e] = 0.f; n1[e] = 0.f; }
    const u16* k0 = Ks + r * KLD + 8 * h;
    bf16x8 ka[2][2];
    ka[0][0] = *(const bf16x8*)(k0); ka[0][1] = *(const bf16x8*)(k0 + 32 * KLD);
    bf16x8 pf[4];
    u32x4 pk[4];
    float ps = 0.f;
#pragma unroll
    for (int ks = 0; ks < NKS; ++ks) {
      if (ks + 1 < NKS) {
        ka[(ks + 1) & 1][0] = *(const bf16x8*)(k0 + 16 * (ks + 1));
        ka[(ks + 1) & 1][1] = *(const bf16x8*)(k0 + 32 * KLD + 16 * (ks + 1));
      }
      __builtin_amdgcn_sched_barrier(0);
      n0 = MFMA32(ka[ks & 1][0], qf[ks], n0); n1 = MFMA32(ka[ks & 1][1], qf[ks], n1);
      {
        constexpr int dummy0 = 0; (void)dummy0;
        const int e_lo = (32 * ks) / NKS, e_hi = (32 * (ks + 1)) / NKS;
#pragma unroll
        for (int q = 0; q < 3; ++q) {
          const int e = e_lo + q;
          if (e < e_hi) {
            if (e < 16) { s0[e & 15] = ex2(fmaf(s0[e & 15], c, -mc)); ps += s0[e & 15]; }
            else        { s1[e & 15] = ex2(fmaf(s1[e & 15], c, -mc)); ps += s1[e & 15]; }
          }
        }
      }
      if (ks == 3)  { pk[0].x = pack2(s0[0], s0[1]);  pk[0].y = pack2(s0[2], s0[3]);   pk[0].z = pack2(s0[4], s0[5]);   pk[0].w = pack2(s0[6], s0[7]); }
      if (ks == 6)  { pk[1].x = pack2(s0[8], s0[9]);  pk[1].y = pack2(s0[10], s0[11]); pk[1].z = pack2(s0[12], s0[13]); pk[1].w = pack2(s0[14], s0[15]); }
      if (ks == 9)  { pk[2].x = pack2(s1[0], s1[1]);  pk[2].y = pack2(s1[2], s1[3]);   pk[2].z = pack2(s1[4], s1[5]);   pk[2].w = pack2(s1[6], s1[7]); }
      if (ks == NKS - 1) { pk[3].x = pack2(s1[8], s1[9]);  pk[3].y = pack2(s1[10], s1[11]); pk[3].z = pack2(s1[12], s1[13]); pk[3].w = pack2(s1[14], s1[15]); }
      __builtin_amdgcn_sched_barrier(0);
    }
    l += ps;
#pragma unroll
    for (int i = 0; i < 4; ++i) pf[i] = __builtin_bit_cast(bf16x8, pk[i]);
    if (active) {
      const u16* v0 = Vs + r * 72 + 8 * h;
      bf16x8 va[2][4];
#pragma unroll
      for (int dt = 0; dt < 4; ++dt) va[0][dt] = *(const bf16x8*)(v0 + (32 * dt) * 72);
#pragma unroll
      for (int kk = 0; kk < 4; ++kk) {
        if (kk < 3) {
#pragma unroll
          for (int dt = 0; dt < 4; ++dt) va[(kk + 1) & 1][dt] = *(const bf16x8*)(v0 + (32 * dt) * 72 + 16 * (kk + 1));
        }
        __builtin_amdgcn_sched_barrier(0);
#pragma unroll
        for (int dt = 0; dt < 4; ++dt) o[dt] = MFMA32(va[kk & 1][dt], pf[kk], o[dt]);
        if (kk == 0) lstoreK(wk, Ln);
        if (kk == 1) lstoreV(wv, Ln);
        if (kk == 2) gloadK(wk, kt + 3);
        if (kk == 3) gloadV(wv, kt + 3);
        __builtin_amdgcn_sched_barrier(0);
      }
    } else {
      lstore(wk, wv, Ln);
      gload(wk, wv, kt + 3);
    }
    __syncthreads();
  };
  for (int kt4 = 0; kt4 < nktp; kt4 += 4) {
    body(kt4 + 0, kstB, vstB, sa0, sa1, sb0, sb1); body(kt4 + 1, kstA, vstA, sb0, sb1, sa0, sa1);
    body(kt4 + 2, kstB, vstB, sa0, sa1, sb0, sb1); body(kt4 + 3, kstA, vstA, sb0, sb1, sa0, sa1);
  }
  const float lt = l + __shfl_xor(l, 32);
  const float inv = 1.f / lt;
  if (dry) return;
  u16* yrow = Yp + (size_t)(32 * w + r) * ldy;
#pragma unroll
  for (int dt = 0; dt < 4; ++dt)
#pragma unroll
    for (int g = 0; g < 4; ++g) {
      const int d = 32 * dt + 8 * g + 4 * h;
      uint2 gv = *(const uint2*)(yrow + d);
      float g0 = bf2f(gv.x & 0xffffu), g1 = bf2f(gv.x >> 16), g2 = bf2f(gv.y & 0xffffu), g3 = bf2f(gv.y >> 16);
      uint2 ov;
      ov.x = pack2(o[dt][4 * g] * inv * silu(g0), o[dt][4 * g + 1] * inv * silu(g1));
      ov.y = pack2(o[dt][4 * g + 2] * inv * silu(g2), o[dt][4 * g + 3] * inv * silu(g3));
      *(uint2*)(yrow + d) = ov;
    }
}

DI void memattn_item(const Params& p, int L, int c, int item, char* smem, bool dry) {
  const bool rw = L & 1;
  const int ldu = rw ? LDU_R : LDU_M, oq = rw ? R_QM : M_QM, og = rw ? R_GATE : M_GATE;
  const int tile = item >> 2, xh = item & 3;
  const int b = gtok(rw, c, tile * 128) >> 13;
  u16* U = (u16*)(p.ws + OFF_U);
  const u16* MK = (const u16*)(p.ws + OFF_MEMK) + (size_t)((L * 4 + b) * 4 + xh) * 256 * 128;
  const u16* MV = (const u16*)(p.ws + OFF_MEMVT) + (size_t)((L * 4 + b) * 4 + xh) * 128 * 256;
  attn_item<128>(U + (size_t)tile * 128 * ldu + oq + xh * 128, ldu, MK, MV, 256, 4, 0, false,
                 0.08838834764831845f * 1.4426950408889634f, U + (size_t)tile * 128 * ldu + og + 1536 + xh * 128, ldu, smem, dry);
}

DI void phase_attn(const Params& p, int L, int c, char* smem, int* s_item, bool dry) {
  int* cnt = (int*)(p.ws + OFF_CNT) + 64 + ((L * 2 + c) * 2 + (dry ? 1 : 0)) * 16;
  u16* U = (u16*)(p.ws + OFF_U);
  const u16* Q = (const u16*)(p.ws + OFF_Q); const u16* Kb = (const u16*)(p.ws + OFF_K); const u16* Vt = (const u16*)(p.ws + OFF_VT);
  const int xcc = (int)(__builtin_amdgcn_s_getreg((3 << 11) | 20) & 7u);
  for (int k = 0; k < 8; ++k) {
    const int x = (xcc + k) & 7;
    for (;;) {
      __syncthreads();
      if (otid() == 0) *s_item = atomicAdd(cnt + x, 1);
      __syncthreads();
      const int item = *s_item;
      if (item >= 192) break;
      const int qt = 63 - (item & 63), bh = 3 * x + (item >> 6);
      const int lb = bh / 12, head = bh - lb * 12;
      const int q0 = qt * 128;
      attn_item_c<192>(Q + ((size_t)(lb * 12 + head) * 8192 + q0) * 192, 192, Kb + (size_t)(lb * 12 + head) * 8192 * 192,
                     Vt + (size_t)(lb * 12 + head) * 128 * 8192, 8192, 2 * (qt + 1), q0,
                     0.07216878364870323f * 1.4426950408889634f,
                     U + (size_t)(lb * 8192 + q0) * LDU_M + M_GATE + head * 128, LDU_M, smem, dry);
    }
  }
  for (;;) {
    __syncthreads();
    if (otid() == 0) *s_item = atomicAdd(cnt + 8, 1);
    __syncthreads();
    const int item = *s_item;
    if (item >= 512) break;
    memattn_item(p, L, c, item, smem, dry);
  }
}

DI void scan_item(const Params& p, int L, int c, int item, char* smem, bool dry) {
  const int tid = otid(), w = tid >> 6, lane = tid & 63, r = lane & 31, h = lane >> 5;
  const int j = L >> 1;
  const int b = item / 48, rem = item - b * 48, head = rem >> 1, half = rem & 1;
  float* PAb  = (float*)smem;
  float* Vstb = PAb + 2 * 10240;
  float* Ystb = Vstb + 3 * 1024;
  float* PRM  = Ystb + 2 * 1024;
  float* BONb = PRM + 10 * 64;
  u16* A1  = (u16*)(BONb + 96);
  u16* W2t = A1 + 2 * 32 * 72;
  float* LO  = (float*)(W2t + 2 * 64 * 72);
  const u16* U = (const u16*)(p.ws + OFF_U);
  const u16* BND = (const u16*)(p.ws + OFF_BND);
  u16* YR = (u16*)(p.ws + OFF_YR); u16* BV = (u16*)(p.ws + OFF_BV);
  float* ST = (float*)(p.ws + OFF_ST);
  float* STATE = (float*)(p.ws + OFF_STATE);
  __syncthreads();
  if (tid < 64) {
    const float* mu = p.mu + j * SHIFTW;
    const int hc = head * 64 + tid;
    PRM[0 * 64 + tid] = mu[R_R + hc]; PRM[1 * 64 + tid] = mu[R_K + hc]; PRM[2 * 64 + tid] = mu[R_WD + tid]; PRM[3 * 64 + tid] = mu[R_AD + tid];
    PRM[4 * 64 + tid] = p.w0[j * 1536 + hc]; PRM[5 * 64 + tid] = p.a0[j * 1536 + hc]; PRM[6 * 64 + tid] = p.k_k[j * 1536 + hc];
    PRM[7 * 64 + tid] = p.k_a[j * 1536 + hc]; PRM[8 * 64 + tid] = p.r_k[j * 1536 + hc];
    PRM[9 * 64 + tid] = (tid < 32) ? mu[R_V + head * 64 + 32 * half + tid] : 0.f;
  }
  for (int e = tid; e < 8192; e += 256) {
    int arr = e >> 12, jj = (e >> 6) & 63, cc = e & 63;
    const float* src = (arr ? p.a2 : p.w2) + (size_t)j * 64 * 1536;
    W2t[(arr * 64 + cc) * 72 + jj] = f2bf(src[jj * 1536 + head * 64 + cc]);
  }
  const int rowl = lane >> 3, ks = lane & 7, row32 = 8 * w + rowl;
  float S[8];
  {
    float* sp = STATE + ((size_t)((b * 24 + head) * 64 + 32 * half + row32)) * 64 + 8 * ks;
#pragma unroll
    for (int i = 0; i < 8; ++i) S[i] = (c == 0) ? 0.f : sp[i];
  }
  const int tt = tid >> 3, cs = tid & 7, c4 = cs & 3;
  uint4 Rr_c, Rr_p, Rk_c, Rk_p, Rw_c, Rw_p, Ra_c, Ra_p, Rv_c, Rv_p;
  const uint4 zero4 = {0u, 0u, 0u, 0u};
  auto load_raw = [&](int tc) {
    const int lr = b * 4096 + tc * 32 + tt;
    const int s = c * 4096 + tc * 32 + tt;
    const u16* cur = U + (size_t)lr * LDU_R;
    const u16* prv = (s == 0) ? (BND + (size_t)4 * SHIFTW) : ((s == 4096 && c == 1) ? (BND + (size_t)b * SHIFTW) : (cur - LDU_R));
    Rr_c = *(const uint4*)(cur + R_R + head * 64 + cs * 8);  Rr_p = *(const uint4*)(prv + R_R + head * 64 + cs * 8);
    Rk_c = *(const uint4*)(cur + R_K + head * 64 + cs * 8);  Rk_p = *(const uint4*)(prv + R_K + head * 64 + cs * 8);
    Rw_c = *(const uint4*)(cur + R_WD + cs * 8);             Rw_p = *(const uint4*)(prv + R_WD + cs * 8);
    Ra_c = *(const uint4*)(cur + R_AD + cs * 8);             Ra_p = *(const uint4*)(prv + R_AD + cs * 8);
    const int vo = R_V + head * 64 + 32 * half + c4 * 8;
    Rv_c = *(const uint4*)(cur + vo);                        Rv_p = *(const uint4*)(prv + vo);
  };
  uint4 d_y = zero4, d_v = zero4; float d_sm = 0.f, d_sq = 0.f; int d_lr = -1;
  auto flush_out = [&]() {
    if (cs < 4 && !dry && d_lr >= 0) {
      const size_t o = (size_t)d_lr * 1536 + head * 64 + 32 * half + cs * 8;
      *(uint4*)(YR + o) = d_y;
      *(uint4*)(BV + o) = d_v;
      if (cs == 0) {
        float* stp = ST + ((size_t)(d_lr * 24 + head) * 2 + half) * 2;
        stp[0] = d_sm; stp[1] = d_sq;
      }
    }
  };
  float rm[8], km[8];
  auto prep1 = [&](float* Vst) {
    float cu[8], pv[8], t8[8];
    unpack8(Rr_c, cu); unpack8(Rr_p, pv);
#pragma unroll
    for (int e = 0; e < 8; ++e) rm[e] = cu[e] + (pv[e] - cu[e]) * PRM[0 * 64 + cs * 8 + e];
    unpack8(Rk_c, cu); unpack8(Rk_p, pv);
#pragma unroll
    for (int e = 0; e < 8; ++e) km[e] = cu[e] + (pv[e] - cu[e]) * PRM[1 * 64 + cs * 8 + e];
    unpack8(Rw_c, cu); unpack8(Rw_p, pv);
#pragma unroll
    for (int e = 0; e < 8; ++e) {
      float xw = cu[e] + (pv[e] - cu[e]) * PRM[2 * 64 + cs * 8 + e];
      float ee = ex2(xw * 2.8853900817779268f);
      t8[e] = 1.f - 2.f * frcp(ee + 1.f);
    }
    *(uint4*)(A1 + (0 * 32 + tt) * 72 + cs * 8) = pack8(t8);
    unpack8(Ra_c, cu); unpack8(Ra_p, pv);
#pragma unroll
    for (int e = 0; e < 8; ++e) t8[e] = cu[e] + (pv[e] - cu[e]) * PRM[3 * 64 + cs * 8 + e];
    *(uint4*)(A1 + (1 * 32 + tt) * 72 + cs * 8) = pack8(t8);
    unpack8(Rv_c, cu); unpack8(Rv_p, pv);
    float v8[8];
#pragma unroll
    for (int e = 0; e < 8; ++e) v8[e] = cu[e] + (pv[e] - cu[e]) * PRM[9 * 64 + c4 * 8 + e];
    *(float4*)(Vst + tt * 32 + c4 * 8) = make_float4(v8[0], v8[1], v8[2], v8[3]);
    *(float4*)(Vst + tt * 32 + c4 * 8 + 4) = make_float4(v8[4], v8[5], v8[6], v8[7]);
  };
  auto prep3 = [&]() {
    const int arr = w >> 1, nt = w & 1;
    f32x16 acc;
#pragma unroll
    for (int e = 0; e < 16; ++e) acc[e] = 0.f;
#pragma unroll
    for (int k4 = 0; k4 < 4; ++k4) {
      bf16x8 a = *(const bf16x8*)(A1 + (arr * 32 + r) * 72 + 16 * k4 + 8 * h);
      bf16x8 bw = *(const bf16x8*)(W2t + (arr * 64 + 32 * nt + r) * 72 + 16 * k4 + 8 * h);
      acc = MFMA32(a, bw, acc);
    }
#pragma unroll
    for (int e = 0; e < 16; ++e) LO[(arr * 32 + crow(e, h)) * 64 + 32 * nt + r] = acc[e];
  };
  auto prep4 = [&](float* PA, float* BON) {
    float lw[8], la[8];
    {
      float4 t0 = *(const float4*)(LO + (0 * 32 + tt) * 64 + cs * 8), t1 = *(const float4*)(LO + (0 * 32 + tt) * 64 + cs * 8 + 4);
      lw[0] = t0.x; lw[1] = t0.y; lw[2] = t0.z; lw[3] = t0.w; lw[4] = t1.x; lw[5] = t1.y; lw[6] = t1.z; lw[7] = t1.w;
      t0 = *(const float4*)(LO + (1 * 32 + tt) * 64 + cs * 8); t1 = *(const float4*)(LO + (1 * 32 + tt) * 64 + cs * 8 + 4);
      la[0] = t0.x; la[1] = t0.y; la[2] = t0.z; la[3] = t0.w; la[4] = t1.x; la[5] = t1.y; la[6] = t1.z; la[7] = t1.w;
    }
    float dec[8], kk[8], av[8], kp[8];
    float ssq = 0.f, bon = 0.f;
#pragma unroll
    for (int e = 0; e < 8; ++e) {
      const int ch = cs * 8 + e;
      const float sg = frcp(1.f + fexp(-(lw[e] + PRM[4 * 64 + ch])));
      dec[e] = ex2(-0.8750340f * sg);
      float a = frcp(1.f + fexp(-(la[e] + PRM[5 * 64 + ch])));
      av[e] = a;
      kk[e] = km[e] * PRM[6 * 64 + ch];
      ssq += kk[e] * kk[e];
      kp[e] = km[e] * (1.f + (a - 1.f) * PRM[7 * 64 + ch]);
      bon += rm[e] * kp[e] * PRM[8 * 64 + ch];
    }
    ssq = red8(ssq); bon = red8(bon);
    const float inv = 1.f / fmaxf(sqrtf(ssq), 1e-12f);
    float nk[8], bb[8];
#pragma unroll
    for (int e = 0; e < 8; ++e) { float kn = kk[e] * inv; nk[e] = -kn; bb[e] = kn * av[e]; }
    float* pa = PA + tt * 320 + cs * 8;
    *(float4*)(pa) = make_float4(dec[0], dec[1], dec[2], dec[3]); *(float4*)(pa + 4) = make_float4(dec[4], dec[5], dec[6], dec[7]);
    *(float4*)(pa + 64) = make_float4(nk[0], nk[1], nk[2], nk[3]); *(float4*)(pa + 68) = make_float4(nk[4], nk[5], nk[6], nk[7]);
    *(float4*)(pa + 128) = make_float4(bb[0], bb[1], bb[2], bb[3]); *(float4*)(pa + 132) = make_float4(bb[4], bb[5], bb[6], bb[7]);
    *(float4*)(pa + 192) = make_float4(kp[0], kp[1], kp[2], kp[3]); *(float4*)(pa + 196) = make_float4(kp[4], kp[5], kp[6], kp[7]);
    *(float4*)(pa + 256) = make_float4(rm[0], rm[1], rm[2], rm[3]); *(float4*)(pa + 260) = make_float4(rm[4], rm[5], rm[6], rm[7]);
    BON[tt] = bon;
  };
  float4 d0, d1, n0, n1, b0, b1, k0, k1, r0, r1; float vv;
  auto step_load = [&](const float* PA, const float* Vst, int t) {
    const float* pa = PA + t * 320 + ks * 8;
    d0 = *(const float4*)(pa); d1 = *(const float4*)(pa + 4);
    n0 = *(const float4*)(pa + 64); n1 = *(const float4*)(pa + 68);
    b0 = *(const float4*)(pa + 128); b1 = *(const float4*)(pa + 132);
    k0 = *(const float4*)(pa + 192); k1 = *(const float4*)(pa + 196);
    r0 = *(const float4*)(pa + 256); r1 = *(const float4*)(pa + 260);
    vv = Vst[t * 32 + row32];
  };
  auto steps8 = [&](const float* PA, const float* Vst, float* Yst, int t0) {
#pragma unroll
    for (int t8 = 0; t8 < 8; ++t8) {
      const int t = t0 + t8;
      const float* pa = PA + (t + 1) * 320 + ks * 8;
      const float4 xd0 = *(const float4*)(pa), xd1 = *(const float4*)(pa + 4);
      const float4 xn0 = *(const float4*)(pa + 64), xn1 = *(const float4*)(pa + 68);
      const float4 xb0 = *(const float4*)(pa + 128), xb1 = *(const float4*)(pa + 132);
      const float4 xk0 = *(const float4*)(pa + 192), xk1 = *(const float4*)(pa + 196);
      const float4 xr0 = *(const float4*)(pa + 256), xr1 = *(const float4*)(pa + 260);
      const float xvv = Vst[(t + 1) * 32 + row32];
      float sa0 = S[0] * n0.x, sa1 = S[1] * n0.y;
      sa0 = fmaf(S[2], n0.z, sa0); sa1 = fmaf(S[3], n0.w, sa1);
      sa0 = fmaf(S[4], n1.x, sa0); sa1 = fmaf(S[5], n1.y, sa1);
      sa0 = fmaf(S[6], n1.z, sa0); sa1 = fmaf(S[7], n1.w, sa1);
      float sa = red8(sa0 + sa1);
      S[0] = fmaf(sa, b0.x, fmaf(S[0], d0.x, vv * k0.x)); S[1] = fmaf(sa, b0.y, fmaf(S[1], d0.y, vv * k0.y));
      S[2] = fmaf(sa, b0.z, fmaf(S[2], d0.z, vv * k0.z)); S[3] = fmaf(sa, b0.w, fmaf(S[3], d0.w, vv * k0.w));
      S[4] = fmaf(sa, b1.x, fmaf(S[4], d1.x, vv * k1.x)); S[5] = fmaf(sa, b1.y, fmaf(S[5], d1.y, vv * k1.y));
      S[6] = fmaf(sa, b1.z, fmaf(S[6], d1.z, vv * k1.z)); S[7] = fmaf(sa, b1.w, fmaf(S[7], d1.w, vv * k1.w));
      float y0 = S[0] * r0.x, y1 = S[1] * r0.y;
      y0 = fmaf(S[2], r0.z, y0); y1 = fmaf(S[3], r0.w, y1);
      y0 = fmaf(S[4], r1.x, y0); y1 = fmaf(S[5], r1.y, y1);
      y0 = fmaf(S[6], r1.z, y0); y1 = fmaf(S[7], r1.w, y1);
      float y = red8(y0 + y1);
      Yst[t * 32 + row32] = y;
      d0 = xd0; d1 = xd1; n0 = xn0; n1 = xn1; b0 = xb0; b1 = xb1; k0 = xk0; k1 = xk1; r0 = xr0; r1 = xr1; vv = xvv;
    }
  };
  load_raw(0);
  prep1(Vstb);
  __syncthreads();
  prep3();
  load_raw(1);
  __syncthreads();
  prep4(PAb, BONb);
  __syncthreads();
  int v3 = 0;
  for (int tc = 0; tc < 128; ++tc) {
    const int lr = b * 4096 + tc * 32 + tt;
    const int v3n = (v3 == 2) ? 0 : v3 + 1;
    float* PAc = PAb + (tc & 1) * 10240;        float* PAn = PAb + ((tc + 1) & 1) * 10240;
    float* Vc = Vstb + v3 * 1024;               float* Vn = Vstb + v3n * 1024;
    float* Bc = BONb + v3 * 32;                 float* Bn = BONb + v3n * 32;
    float* Yc = Ystb + (tc & 1) * 1024;
    step_load(PAc, Vc, 0);
    prep1(Vn);
    steps8(PAc, Vc, Yc, 0);
    __syncthreads();
    prep3();
    steps8(PAc, Vc, Yc, 8);
    __syncthreads();
    prep4(PAn, Bn);
    steps8(PAc, Vc, Yc, 16);
    load_raw(tc + 2);
    flush_out();
    steps8(PAc, Vc, Yc, 24);
    __syncthreads();
    {
      float y8[8], v8[8];
      float4 t0 = *(const float4*)(Yc + tt * 32 + c4 * 8), t1 = *(const float4*)(Yc + tt * 32 + c4 * 8 + 4);
      y8[0] = t0.x; y8[1] = t0.y; y8[2] = t0.z; y8[3] = t0.w; y8[4] = t1.x; y8[5] = t1.y; y8[6] = t1.z; y8[7] = t1.w;
      float sm = 0.f, sq = 0.f;
#pragma unroll
      for (int e = 0; e < 8; ++e) { sm += y8[e]; sq += y8[e] * y8[e]; }
      sm = red4(sm); sq = red4(sq);
      const float bon = Bc[tt];
      t0 = *(const float4*)(Vc + tt * 32 + c4 * 8); t1 = *(const float4*)(Vc + tt * 32 + c4 * 8 + 4);
      v8[0] = t0.x * bon; v8[1] = t0.y * bon; v8[2] = t0.z * bon; v8[3] = t0.w * bon; v8[4] = t1.x * bon; v8[5] = t1.y * bon; v8[6] = t1.z * bon; v8[7] = t1.w * bon;
      d_y = pack8(y8); d_v = pack8(v8); d_sm = sm; d_sq = sq; d_lr = lr;
    }
    v3 = v3n;
  }
  flush_out();
  if (c == 0 && !dry) {
    float* sp = STATE + ((size_t)((b * 24 + head) * 64 + 32 * half + row32)) * 64 + 8 * ks;
#pragma unroll
    for (int i = 0; i < 8; ++i) sp[i] = S[i];
  }
}

DI void phase_scan(const Params& p, int L, int c, char* smem, int* s_item, bool dry) {
  for (int item = blockIdx.x; item < 192; item += gridDim.x) scan_item(p, L, c, item, smem, dry);
  int* cnt = (int*)(p.ws + OFF_CNT) + 64 + ((L * 2 + c) * 2 + (dry ? 1 : 0)) * 16 + 8;
  for (;;) {
    __syncthreads();
    if (otid() == 0) *s_item = atomicAdd(cnt, 1);
    __syncthreads();
    const int item = *s_item;
    if (item >= 512) break;
    memattn_item(p, L, c, item, smem, dry);
  }
}

DI void phase_finalize(const Params& p, int L, int c, bool dry) {
  const int j = L >> 1;
  u16* U = (u16*)(p.ws + OFF_U);
  const u16* YR = (const u16*)(p.ws + OFF_YR); const u16* BV = (const u16*)(p.ws + OFF_BV);
  const float* ST = (const float*)(p.ws + OFF_ST);
  const int G = gridDim.x;
  for (int idx = blockIdx.x * 256 + otid(); idx < TC * 192; idx += G * 256) {
    const int lr = idx / 192, c8 = idx - lr * 192, ch0 = c8 * 8, head = ch0 >> 6;
    const float4 st = *(const float4*)(ST + (size_t)(lr * 24 + head) * 4);
    const float mean = (st.x + st.z) * (1.f / 64.f);
    const float var = (st.y + st.w) * (1.f / 64.f) - mean * mean;
    const float rstd = rsqrtf(fmaxf(var, 0.f) + 64e-5f);
    float y[8], bv[8], g[8], o[8];
    unpack8(*(const uint4*)(YR + (size_t)lr * 1536 + ch0), y);
    unpack8(*(const uint4*)(BV + (size_t)lr * 1536 + ch0), bv);
    u16* gp = U + (size_t)lr * LDU_R + R_GATE + ch0;
    unpack8(*(const uint4*)gp, g);
    const float* gw = p.gn_w + j * 1536 + ch0; const float* gb = p.gn_b + j * 1536 + ch0;
#pragma unroll
    for (int e = 0; e < 8; ++e) o[e] = ((y[e] - mean) * rstd * gw[e] + gb[e] + bv[e]) * silu(g[e]);
    if (!dry) *(uint4*)gp = pack8(o);
  }
  if (c == 0) {
    u16* BND = (u16*)(p.ws + OFF_BND);
    for (int idx = blockIdx.x * 256 + otid(); idx < 4 * (SHIFTW / 8); idx += G * 256) {
      const int b = idx / (SHIFTW / 8), cc = idx - b * (SHIFTW / 8);
      *(uint4*)(BND + (size_t)b * SHIFTW + cc * 8) = *(const uint4*)(U + (size_t)(b * 4096 + 4095) * LDU_R + cc * 8);
    }
  }
}

enum { PH_PREP = 0, PH_NORM, PH_GEMM_IN, PH_KVPREP, PH_GEMM_UP, PH_ATTN, PH_SCAN, PH_FINALIZE, PH_GEMM_OUT, PH_FINAL };
constexpr int NSTEPS = 42;

DI void decode_step(int step, int& ph, int& L, int& c) {
  if (step == 0) { ph = PH_PREP; L = 0; c = 0; return; }
  if (step == NSTEPS - 1) { ph = PH_FINAL; L = 0; c = 0; return; }
  int s = step - 1;
  int pr = s / 20, rem = s - pr * 20;
  if (rem < 11) {
    L = 2 * pr;
    int k;
    if (rem < 6) { c = 0; k = rem; } else { c = 1; k = rem - 5; }
    ph = (k == 0) ? PH_NORM : (k == 1) ? PH_GEMM_IN : (k == 2) ? PH_KVPREP : (k == 3) ? PH_GEMM_UP : (k == 4) ? PH_ATTN : PH_GEMM_OUT;
  } else {
    rem -= 11; L = 2 * pr + 1;
    int k;
    if (rem < 5) { c = 0; k = rem; } else { c = 1; k = rem - 4; }
    ph = (k == 0) ? PH_NORM : (k == 1) ? PH_GEMM_IN : (k == 2) ? PH_SCAN : (k == 3) ? PH_FINALIZE : PH_GEMM_OUT;
  }
}

DI void run_step(const Params& p, int ph, int L, int c, char* smem, int* s_item, bool dry_in, int vt) {
  const bool dry = dry_in && !(HYP5 && (ph == PH_GEMM_IN || ph == PH_GEMM_UP));
  char* ws = p.ws;
  const bool rw = L & 1;
  const int j = L >> 1;
  switch (ph) {
    case PH_PREP: phase_prep(p, smem); break;
    case PH_NORM:
      phase_norm(p, L, c);
      if (L == 0 && c == 0) {
        EpiMemKV epi{(u16*)(ws + OFF_MEMK), (u16*)(ws + OFF_MEMVT), false};
        gemm_phase<2, false, 16>((const u16*)(ws + OFF_MEMH), 1024ull * 1024, 1024, (const u16*)(ws + OFF_WT_MEMKV), 1024ull * 1024, 1024, 4, 4, 8, 4, 1024, smem, epi, vt);
      }
      break;
    case PH_GEMM_IN:
      if (!rw) {
        EpiStoreBf16 epi{(u16*)(ws + OFF_U), LDU_M, LDU_M, dry};
        gemm_phase<2, true, 16>((const u16*)(ws + OFF_H), 0, 1024, (const u16*)(ws + OFF_WT_INMLA) + (size_t)j * 3328 * 1024, 0, 1024, 1, 64, 26, 4, 1024, smem, epi, vt);
      } else {
        EpiStoreBf16 epi{(u16*)(ws + OFF_U), LDU_R, LDU_R, dry};
        gemm_phase<2, true, 16>((const u16*)(ws + OFF_H), 0, 1024, (const u16*)(ws + OFF_WT_INRW) + (size_t)j * 7296 * 1024, 0, 1024, 1, 64, 57, 4, 1024, smem, epi, vt);
      }
      break;
    case PH_KVPREP: phase_kvprep(p, L, c, dry); break;
    case PH_GEMM_UP: {
      EpiUQ e1{(u16*)(ws + OFF_Q), (const float*)(ws + OFF_COS), (const float*)(ws + OFF_SIN), c, dry};
      gemm_phase<2, true, 6>((const u16*)(ws + OFF_U) + M_CQ, 0, LDU_M, (const u16*)(ws + OFF_WT_UQ) + (size_t)j * 2304 * 384, 0, 384, 1, 64, 18, 4, 384, smem, e1, vt);
      EpiUK e2{(u16*)(ws + OFF_K), dry};
      gemm_phase<2, true, 4>((const u16*)(ws + OFF_U) + M_CKV, 0, LDU_M, (const u16*)(ws + OFF_WT_UKV) + (size_t)j * 3072 * 256, 0, 256, 1, 64, 12, 4, 256, smem, e2, vt);
      EpiUV e3{(u16*)(ws + OFF_VT), dry};
      gemm_phase<2, false, 4>((const u16*)(ws + OFF_U) + M_CKV, 0, LDU_M, (const u16*)(ws + OFF_WT_UKV) + (size_t)j * 3072 * 256 + 1536ull * 256, 0, 256, 1, 64, 12, 4, 256, smem, e3, vt);
    } break;
    case PH_ATTN: phase_attn(p, L, c, smem, s_item, dry); break;
    case PH_SCAN: phase_scan(p, L, c, smem, s_item, dry); break;
    case PH_FINALIZE: phase_finalize(p, L, c, dry); break;
    case PH_GEMM_OUT: {
      EpiResid epi{(L == 0) ? p.x : (const float*)p.out, p.out, rw, c, dry};
      gemm_phase<2, true, 32>((const u16*)(ws + OFF_U) + (rw ? R_GATE : M_GATE), 0, rw ? LDU_R : LDU_M, (const u16*)(ws + OFF_WT_OUT) + (size_t)L * 1024 * 2048, 0, 2048,
                 1, 64, 8, 4, 2048, smem, epi, vt);
      if (c == 0 && !dry) phase_norm(p, L, 1);
    } break;
    case PH_FINAL: phase_final_norm(p, dry); break;
  }
}

DI void grid_barrier(unsigned* bar, unsigned& epoch) {
  __syncthreads();
  ++epoch;
  if (threadIdx.x == 0) {
    __builtin_amdgcn_fence(__ATOMIC_RELEASE, "agent");
    asm volatile("s_waitcnt vmcnt(0)" ::: "memory");
    const unsigned target = epoch * gridDim.x;
    __hip_atomic_fetch_add(bar, 1u, __ATOMIC_RELAXED, __HIP_MEMORY_SCOPE_AGENT);
    unsigned spins = 0;
    while (__hip_atomic_load(bar, __ATOMIC_RELAXED, __HIP_MEMORY_SCOPE_AGENT) < target) {
      __builtin_amdgcn_s_sleep(2);
      if (++spins > (1u << 22)) break;
    }
    __builtin_amdgcn_fence(__ATOMIC_ACQUIRE, "agent");
    asm volatile("s_waitcnt vmcnt(0)" ::: "memory");
  }
  __syncthreads();
}

__global__ void __launch_bounds__(256, 1) hybrid_megakernel(Params p, int s_lo, int s_hi, int coop, int probe_mask) {
  __shared__ __attribute__((aligned(16))) char smem[SMEM_BYTES];
  __shared__ int s_item;
  unsigned* bar = (unsigned*)(p.ws + OFF_BAR);
  unsigned epoch = 0;
  if (coop == 2) cg::this_grid().sync();
  __shared__ int s_vt;
  int myx = 0, myrank = 0;
  if (coop && threadIdx.x == 0) {
    myx = (int)(__builtin_amdgcn_s_getreg((3 << 11) | 20) & 7u);
    myrank = (int)__hip_atomic_fetch_add(bar + 16 + myx, 1u, __ATOMIC_RELAXED, __HIP_MEMORY_SCOPE_AGENT);
  }
  int vt = blockIdx.x;
  {
    const int G = gridDim.x, t = blockIdx.x;
    vt = ((G & 7) == 0) ? ((t & 7) * (G >> 3) + (t >> 3)) : t;
  }
  for (int st = s_lo; st < s_hi; ++st) {
    int ph, L, c;
    decode_step(st, ph, L, c);
    for (int rep = ((probe_mask >> ph) & 1) ? 0 : 1; rep < 2; ++rep) {
      run_step(p, ph, L, c, smem, &s_item, rep == 0, vt);
      if (coop && (rep == 0 || st + 1 < s_hi)) grid_barrier(bar, epoch);
      if (coop) for (int xs = 0; xs < EXTRA_SYNCS; ++xs) grid_barrier(bar, epoch);
    }
    if (coop && st == s_lo) {
      if (threadIdx.x == 0) {
        const int G = gridDim.x;
        bool ok = (G & 7) == 0;
        for (int x = 0; x < 8; ++x) ok = ok && ((int)__hip_atomic_load(bar + 16 + x, __ATOMIC_RELAXED, __HIP_MEMORY_SCOPE_AGENT) == (G >> 3));
        s_vt = ok ? (myx * (G >> 3) + myrank) : vt;
      }
      __syncthreads();
      vt = s_vt;
    }
  }
}

extern "C" void kernel_launch(void* const* d_in, const int* in_sizes, int n_in, void* d_out, int out_size, void* d_ws, size_t ws_size,
                              hipStream_t stream) {
  if (ws_size < WS_NEED) { fprintf(stderr, "workspace too small: %zu < %zu\n", ws_size, (size_t)WS_NEED); return; }
  Params p;
  memset(&p, 0, sizeof(p));
  p.x = (const float*)d_in[0]; p.mem = (const float*)d_in[1]; p.pos = (const int*)d_in[2];
  p.norm_g = (const float*)d_in[3]; p.mem_norm_g = (const float*)d_in[4]; p.w_mem_kv = (const float*)d_in[5];
  p.w_in_mla = (const float*)d_in[6]; p.q_norm_g = (const float*)d_in[7]; p.kv_norm_g = (const float*)d_in[8];
  p.w_uq = (const float*)d_in[9]; p.w_ukv = (const float*)d_in[10]; p.w_in_rwkv = (const float*)d_in[11];
  p.mu = (const float*)d_in[12]; p.w0 = (const float*)d_in[13]; p.w2 = (const float*)d_in[14]; p.a0 = (const float*)d_in[15];
  p.a2 = (const float*)d_in[16]; p.k_k = (const float*)d_in[17]; p.k_a = (const float*)d_in[18]; p.r_k = (const float*)d_in[19];
  p.gn_w = (const float*)d_in[20]; p.gn_b = (const float*)d_in[21]; p.w_out = (const float*)d_in[22]; p.final_g = (const float*)d_in[23];
  p.out = (float*)d_out; p.ws = (char*)d_ws;
  static int grid_blocks = 0;
  if (!grid_blocks) {
    int dev = 0, cus = 0, per_cu = 0;
    hipGetDevice(&dev);
    hipDeviceGetAttribute(&cus, hipDeviceAttributeMultiprocessorCount, dev);
    hipOccupancyMaxActiveBlocksPerMultiprocessor(&per_cu, hybrid_megakernel, 256, 0);
    if (per_cu > 2) per_cu = 2;
    if (per_cu < 1) per_cu = 1;
    grid_blocks = cus * per_cu;
  }
#if MULTI_LAUNCH
  for (int s = 0; s < NSTEPS; ++s) hipLaunchKernelGGL(hybrid_megakernel, dim3(grid_blocks), dim3(256), 0, stream, p, s, s + 1, 0, 0);
#else
  int s_lo = 0, s_hi = NSTEPS, coop = 1, probe_mask = PROBE_MASK;
  void* args[] = {&p, &s_lo, &s_hi, &coop, &probe_mask};
  hipMemsetAsync((char*)d_ws + OFF_BAR, 0, 256, stream);
  hipError_t e = hipLaunchCooperativeKernel((void*)hybrid_megakernel, dim3(grid_blocks), dim3(256), args, 0, stream);
  if (e != hipSuccess) fprintf(stderr, "cooperative launch failed: %s (grid %d)\n", hipGetErrorString(e), grid_blocks);
#endif
}
```

```cpp
#include <hip/hip_runtime.h>
#include <hip/hip_cooperative_groups.h>
#include <cstdio>
#include <cstring>
namespace cg = cooperative_groups;

#define PROBE_MASK 0
#define EXTRA_SYNCS 0
#define HYP1 0
#define HYP2 0
#define HYP3 0
#define HYP4 0
#define HYP5 0
#define HYP6 0
#ifndef MULTI_LAUNCH
#define MULTI_LAUNCH 0
#endif

#define DI __device__ __forceinline__
typedef unsigned short u16;
typedef __attribute__((ext_vector_type(8))) short bf16x8;
typedef __attribute__((ext_vector_type(16))) float f32x16;
typedef __attribute__((ext_vector_type(2))) __bf16 bf2_t;
typedef __attribute__((ext_vector_type(2))) float f2_t;
typedef __attribute__((ext_vector_type(4))) unsigned u32x4;
typedef __attribute__((ext_vector_type(2))) unsigned u32x2;
#define MFMA32(a, b, c) __builtin_amdgcn_mfma_f32_32x32x16_bf16((a), (b), (c), 0, 0, 0)

constexpr int SEQ = 8192, TC = 16384;
constexpr int LDU_M = 3264, LDU_R = 7296;
constexpr int M_CQ = 0, M_CKV = 384, M_KR = 640, M_QM = 704, M_GATE = 1216;
constexpr int R_R = 0, R_K = 1536, R_V = 3072, R_WD = 4608, R_AD = 4672, R_QM = 4736, R_GATE = 5248;
constexpr int SHIFTW = 4736;

constexpr size_t OFF_WT_MEMKV = 0;
constexpr size_t OFF_WT_INMLA = OFF_WT_MEMKV + 4ull * 1024 * 1024 * 2;
constexpr size_t OFF_WT_UQ    = OFF_WT_INMLA + 2ull * 3328 * 1024 * 2;
constexpr size_t OFF_WT_UKV   = OFF_WT_UQ + 2ull * 2304 * 384 * 2;
constexpr size_t OFF_WT_INRW  = OFF_WT_UKV + 2ull * 3072 * 256 * 2;
constexpr size_t OFF_WT_OUT   = OFF_WT_INRW + 2ull * 7296 * 1024 * 2;
constexpr size_t OFF_MEMH     = OFF_WT_OUT + 4ull * 1024 * 2048 * 2;
constexpr size_t OFF_MEMK     = OFF_MEMH + 4ull * 1024 * 1024 * 2;
constexpr size_t OFF_MEMVT    = OFF_MEMK + 4ull * 4 * 4 * 256 * 128 * 2;
constexpr size_t OFF_COS      = OFF_MEMVT + 4ull * 4 * 4 * 256 * 128 * 2;
constexpr size_t OFF_SIN      = OFF_COS + 32768ull * 32 * 4;
constexpr size_t OFF_CNT      = OFF_SIN + 32768ull * 32 * 4;
constexpr size_t OFF_BAR      = OFF_CNT + 4096;
constexpr size_t OFF_STATE    = OFF_BAR + 256;
constexpr size_t OFF_BND      = OFF_STATE + 96ull * 4096 * 4;
constexpr size_t OFF_H        = OFF_BND + 5ull * 4736 * 2 + 128;
constexpr size_t OFF_R        = OFF_H + 16384ull * 1024 * 2;
constexpr size_t OFF_U        = OFF_R;
constexpr size_t OFF_Q        = OFF_R + 16384ull * 3264 * 2;
constexpr size_t OFF_K        = OFF_Q + 2ull * 12 * 8192 * 192 * 2;
constexpr size_t OFF_VT       = OFF_K + 2ull * 12 * 8192 * 192 * 2;
constexpr size_t OFF_YR       = OFF_R + 16384ull * 7296 * 2;
constexpr size_t OFF_BV       = OFF_YR + 16384ull * 1536 * 2;
constexpr size_t OFF_ST       = OFF_BV + 16384ull * 1536 * 2;
constexpr size_t OFF_BS       = OFF_ST + 16384ull * 24 * 4 * 4;
constexpr size_t WS_NEED      = OFF_BS + 16384ull * 24 * 4;

constexpr int SMEM_BYTES = 149504;

struct Params {
  const float *x, *mem; const int* pos;
  const float *norm_g, *mem_norm_g, *w_mem_kv, *w_in_mla, *q_norm_g, *kv_norm_g, *w_uq, *w_ukv, *w_in_rwkv;
  const float *mu, *w0, *w2, *a0, *a2, *k_k, *k_a, *r_k, *gn_w, *gn_b, *w_out, *final_g;
  float* out; char* ws;
};

DI int otid() { int t = threadIdx.x; asm volatile("" : "+v"(t)); return t; }
DI float bf2f(unsigned v) { return __uint_as_float(v << 16); }
DI unsigned pack2(float a, float b) { f2_t v = {a, b}; bf2_t r = __builtin_convertvector(v, bf2_t); return __builtin_bit_cast(unsigned, r); }
DI u16 f2bf(float a) { return (u16)(pack2(a, 0.f) & 0xffffu); }
DI float ex2(float x) { return __builtin_amdgcn_exp2f(x); }
DI float fexp(float x) { return __builtin_amdgcn_exp2f(x * 1.4426950408889634f); }
DI float frcp(float x) { return __builtin_amdgcn_rcpf(x); }
DI float silu(float g) { return g * frcp(1.f + fexp(-g)); }
DI float wave_sum(float v) { for (int o = 32; o > 0; o >>= 1) v += __shfl_xor(v, o); return v; }
DI int crow(int reg, int h) { return (reg & 3) + 8 * (reg >> 2) + 4 * h; }
DI float dppf(float x, const int ctrl_sel) {
  int xi;
  if (ctrl_sel == 0) xi = __builtin_amdgcn_update_dpp(0, __float_as_int(x), 0xB1, 0xf, 0xf, true);
  else if (ctrl_sel == 1) xi = __builtin_amdgcn_update_dpp(0, __float_as_int(x), 0x4E, 0xf, 0xf, true);
  else xi = __builtin_amdgcn_update_dpp(0, __float_as_int(x), 0x141, 0xf, 0xf, true);
  return __int_as_float(xi);
}
DI float red4(float x) { x += dppf(x, 0); x += dppf(x, 1); return x; }
DI float red8(float x) { x += dppf(x, 0); x += dppf(x, 1); x += dppf(x, 2); return x; }
DI int gtok(bool rw, int c, int lr) { return rw ? ((lr >> 12) * 8192 + c * 4096 + (lr & 4095)) : (c * 16384 + lr); }
DI void unpack8(const uint4& v, float* f) {
  f[0] = bf2f(v.x & 0xffffu); f[1] = bf2f(v.x >> 16); f[2] = bf2f(v.y & 0xffffu); f[3] = bf2f(v.y >> 16);
  f[4] = bf2f(v.z & 0xffffu); f[5] = bf2f(v.z >> 16); f[6] = bf2f(v.w & 0xffffu); f[7] = bf2f(v.w >> 16);
}
DI uint4 pack8(const float* f) { uint4 v; v.x = pack2(f[0], f[1]); v.y = pack2(f[2], f[3]); v.z = pack2(f[4], f[5]); v.w = pack2(f[6], f[7]); return v; }

DI void transpose_tile(const float* __restrict__ src, u16* __restrict__ dst, int K, int N, int tk, int tn, int drow, float* tile) {
  const int tid = otid();
  __syncthreads();
#pragma unroll
  for (int i = 0; i < 4; ++i) {
    int kr = (tid >> 4) + 16 * i, nc = (tid & 15) * 4;
    float4 v = *(const float4*)(src + (size_t)(tk * 64 + kr) * N + tn * 64 + nc);
    tile[kr * 65 + nc] = v.x; tile[kr * 65 + nc + 1] = v.y; tile[kr * 65 + nc + 2] = v.z; tile[kr * 65 + nc + 3] = v.w;
  }
  __syncthreads();
#pragma unroll
  for (int i = 0; i < 2; ++i) {
    int n = (tid >> 3) + 32 * i, kc = (tid & 7) * 8;
    float f[8];
#pragma unroll
    for (int e = 0; e < 8; ++e) f[e] = tile[(kc + e) * 65 + n];
    *(uint4*)(dst + (size_t)(drow + n) * K + tk * 64 + kc) = pack8(f);
  }
}

DI void rms_row_bf16(const float* __restrict__ src, const float* __restrict__ g, u16* __restrict__ dst, int lane) {
  float4 v[4]; float ss = 0.f;
#pragma unroll
  for (int i = 0; i < 4; ++i) { v[i] = *(const float4*)(src + i * 256 + lane * 4); ss += v[i].x * v[i].x + v[i].y * v[i].y + v[i].z * v[i].z + v[i].w * v[i].w; }
  ss = wave_sum(ss);
  float rs = rsqrtf(ss * (1.f / 1024.f) + 1e-6f);
#pragma unroll
  for (int i = 0; i < 4; ++i) {
    float4 gg = *(const float4*)(g + i * 256 + lane * 4);
    uint2 o; o.x = pack2(v[i].x * rs * gg.x, v[i].y * rs * gg.y); o.y = pack2(v[i].z * rs * gg.z, v[i].w * rs * gg.w);
    *(uint2*)(dst + i * 256 + lane * 4) = o;
  }
}

DI void phase_prep(const Params& p, char* smem) {
  const int tid = otid(), G = gridDim.x, bid = blockIdx.x;
  char* ws = p.ws;
  if (bid == 0) for (int i = tid; i < 1024; i += 256) ((int*)(ws + OFF_CNT))[i] = 0;
  float* tile = (float*)smem;
  for (int g0 = bid; g0 < 9168; g0 += G) {
    int g = g0;
    const float* src = nullptr; u16* dst = nullptr; int K = 0, N = 0; size_t dstr = 0; bool ukv = false;
    if (g < 1024) { src = p.w_mem_kv; dst = (u16*)(ws + OFF_WT_MEMKV); K = 1024; N = 1024; dstr = 1024ull * 1024; }
    else if ((g -= 1024) < 1632) { src = p.w_in_mla; dst = (u16*)(ws + OFF_WT_INMLA); K = 1024; N = 3264; dstr = 3328ull * 1024; }
    else if ((g -= 1632) < 432) { src = p.w_uq; dst = (u16*)(ws + OFF_WT_UQ); K = 384; N = 2304; dstr = 2304ull * 384; }
    else if ((g -= 432) < 384) { src = p.w_ukv; dst = (u16*)(ws + OFF_WT_UKV); K = 256; N = 3072; dstr = 3072ull * 256; ukv = true; }
    else if ((g -= 384) < 3648) { src = p.w_in_rwkv; dst = (u16*)(ws + OFF_WT_INRW); K = 1024; N = 7296; dstr = 7296ull * 1024; }
    else { g -= 3648; src = p.w_out; dst = (u16*)(ws + OFF_WT_OUT); K = 2048; N = 1024; dstr = 1024ull * 2048; }
    int ntn = N >> 6, per = (K >> 6) * ntn;
    int m = g / per, t = g - m * per;
    int tk = t / ntn, tn = t - tk * ntn;
    int drow = tn * 64;
    if (ukv) { const int hd = drow >> 8, dd = drow & 255; drow = (dd < 128) ? (hd * 128 + dd) : (1536 + hd * 128 + dd - 128); }
    transpose_tile(src + (size_t)m * K * N, dst + (size_t)m * dstr, K, N, tk, tn, drow, tile);
  }
  for (int i = bid * 256 + tid; i < 2 * 64 * 1024 / 8; i += G * 256) {
    int m = i / (64 * 1024 / 8), r = i - m * (64 * 1024 / 8);
    uint4 z; z.x = z.y = z.z = z.w = 0u;
    *(uint4*)((u16*)(ws + OFF_WT_INMLA) + (size_t)m * 3328 * 1024 + 3264ull * 1024 + (size_t)r * 8) = z;
  }
  for (int i = bid * 256 + tid; i < SHIFTW / 8; i += G * 256) { uint4 z; z.x = z.y = z.z = z.w = 0u; *(uint4*)((u16*)(ws + OFF_BND) + 4 * SHIFTW + i * 8) = z; }
  float* cs = (float*)(ws + OFF_COS); float* sn = (float*)(ws + OFF_SIN);
  for (int i = bid * 256 + tid; i < 32768 * 32; i += G * 256) {
    int tk = i >> 5, pi = i & 31;
    float inv_freq = (float)exp2(-(double)(2 * pi) / 64.0 * 13.287712379549449);
    float ang = (float)p.pos[tk] * inv_freq;
    double rev = (double)ang * 0.15915494309189535;
    float fr = (float)(rev - rint(rev));
    cs[i] = __builtin_amdgcn_cosf(fr); sn[i] = __builtin_amdgcn_sinf(fr);
  }
  const int w = tid >> 6, lane = tid & 63;
  for (int row = bid * 4 + w; row < 4096; row += G * 4) {
    int L = row >> 10, m = row & 1023;
    rms_row_bf16(p.mem + (size_t)m * 1024, p.mem_norm_g + L * 1024, (u16*)(ws + OFF_MEMH) + (size_t)row * 1024, lane);
  }
}

DI void phase_norm(const Params& p, int L, int c) {
  const int tid = otid(), w = tid >> 6, lane = tid & 63;
  const bool rw = L & 1;
  const float* xs = (L == 0) ? p.x : p.out;
  u16* H = (u16*)(p.ws + OFF_H);
  for (int lr = blockIdx.x * 4 + w; lr < TC; lr += gridDim.x * 4) {
    int gt = gtok(rw, c, lr);
    rms_row_bf16(xs + (size_t)gt * 1024, p.norm_g + L * 1024, H + (size_t)lr * 1024, lane);
  }
}

DI void phase_final_norm(const Params& p, bool dry) {
  const int tid = otid(), w = tid >> 6, lane = tid & 63;
  for (int row = blockIdx.x * 4 + w; row < 32768; row += gridDim.x * 4) {
    float* xr = p.out + (size_t)row * 1024;
    float4 v[4]; float ss = 0.f;
#pragma unroll
    for (int i = 0; i < 4; ++i) { v[i] = *(const float4*)(xr + i * 256 + lane * 4); ss += v[i].x * v[i].x + v[i].y * v[i].y + v[i].z * v[i].z + v[i].w * v[i].w; }
    ss = wave_sum(ss);
    float rs = rsqrtf(ss * (1.f / 1024.f) + 1e-6f);
#pragma unroll
    for (int i = 0; i < 4; ++i) {
      float4 gg = *(const float4*)(p.final_g + i * 256 + lane * 4);
      float4 o; o.x = v[i].x * rs * gg.x; o.y = v[i].y * rs * gg.y; o.z = v[i].z * rs * gg.z; o.w = v[i].w * rs * gg.w;
      if (!dry) *(float4*)(xr + i * 256 + lane * 4) = o;
    }
  }
}

template <int TJ, bool SWAP, int NK, class Epi>
DI void gemm_phase(const u16* __restrict__ A, size_t strideAz, int lda, const u16* __restrict__ Bt, size_t strideBz, int ldb,
                   int Z, int Mt, int Nt, int GM, int K, char* smem, const Epi& epi, int vt) {
  constexpr int BN = 64 * TJ;
  constexpr int NB = BN / 32;
  const int tid = otid(), w = tid >> 6, lane = tid & 63, r = lane & 31, h = lane >> 5;
  const int wm = w >> 1, wn = w & 1;
  u16* As = (u16*)smem;
  u16* Bs = As + 2 * 256 * 72;
  const int G = gridDim.x, per = Mt * Nt, total = Z * per;
  const int lrow = tid >> 3, lcc = (tid & 7) * 8;
  unsigned aoff[8], boff[NB];
#pragma unroll
  for (int i = 0; i < 8; ++i) aoff[i] = (unsigned)((lrow + 32 * i) * lda + lcc);
#pragma unroll
  for (int i = 0; i < NB; ++i) boff[i] = (unsigned)((lrow + 32 * i) * ldb + lcc);
  const int lds_st = lrow * 72 + lcc;
  for (int base = 0; base < total; base += G) {
    const int q = base + vt;
    if (q >= total) continue;
    const int z = q / per, qq = q - z * per;
    const int grp = qq / (GM * Nt), within = qq - grp * GM * Nt;
    const int mt = grp * GM + (within % GM), nt = within / GM;
    const u16* Ag = A + z * strideAz + (size_t)(mt * 256) * lda;
    const u16* Bg = Bt + z * strideBz + (size_t)(nt * BN) * ldb;
    u32x4 ra[2][8], rb[2][NB];
    f32x16 acc[4][TJ];
#pragma unroll
    for (int i = 0; i < 4; ++i)
#pragma unroll
      for (int j = 0; j < TJ; ++j)
#pragma unroll
        for (int e = 0; e < 16; ++e) acc[i][j][e] = 0.f;
    __syncthreads();
#pragma unroll
    for (int i = 0; i < 8; ++i) ra[0][i] = *(const u32x4*)(Ag + aoff[i]);
#pragma unroll
    for (int i = 0; i < NB; ++i) rb[0][i] = *(const u32x4*)(Bg + boff[i]);
#pragma unroll
    for (int i = 0; i < 8; ++i) ra[1][i] = *(const u32x4*)(Ag + 64 + aoff[i]);
#pragma unroll
    for (int i = 0; i < NB; ++i) rb[1][i] = *(const u32x4*)(Bg + 64 + boff[i]);
#pragma unroll
    for (int i = 0; i < 8; ++i) *(u32x4*)(As + lds_st + (32 * i) * 72) = ra[0][i];
#pragma unroll
    for (int i = 0; i < NB; ++i) *(u32x4*)(Bs + lds_st + (32 * i) * 72) = rb[0][i];
    __syncthreads();
    bf16x8 af[2][4], bfr[2][TJ];
#pragma unroll
    for (int kt = 0; kt < NK; ++kt) {
      constexpr int dummy = 0; (void)dummy;
      const int u = kt & 1;
      const u16* as = As + u * 256 * 72 + (128 * wm + r) * 72 + 8 * h;
      const u16* bs = Bs + u * BN * 72 + (32 * TJ * wn + r) * 72 + 8 * h;
      if (kt == 0) {
#pragma unroll
        for (int i = 0; i < 4; ++i) af[0][i] = *(const bf16x8*)(as + (32 * i) * 72);
#pragma unroll
        for (int j = 0; j < TJ; ++j) bfr[0][j] = *(const bf16x8*)(bs + (32 * j) * 72);
      }
#pragma unroll
      for (int ks = 0; ks < 4; ++ks) {
        if (ks < 3) {
#pragma unroll
          for (int i = 0; i < 4; ++i) af[(ks + 1) & 1][i] = *(const bf16x8*)(as + (32 * i) * 72 + 16 * (ks + 1));
#pragma unroll
          for (int j = 0; j < TJ; ++j) bfr[(ks + 1) & 1][j] = *(const bf16x8*)(bs + (32 * j) * 72 + 16 * (ks + 1));
        } else if (kt + 1 < NK) {
          const u16* asn = As + (u ^ 1) * 256 * 72 + (128 * wm + r) * 72 + 8 * h;
          const u16* bsn = Bs + (u ^ 1) * BN * 72 + (32 * TJ * wn + r) * 72 + 8 * h;
#pragma unroll
          for (int i = 0; i < 4; ++i) af[0][i] = *(const bf16x8*)(asn + (32 * i) * 72);
#pragma unroll
          for (int j = 0; j < TJ; ++j) bfr[0][j] = *(const bf16x8*)(bsn + (32 * j) * 72);
        }
        __builtin_amdgcn_sched_barrier(0);
#pragma unroll
        for (int i = 0; i < 4; ++i)
#pragma unroll
          for (int j = 0; j < TJ; ++j)
            acc[i][j] = SWAP ? MFMA32(bfr[ks & 1][j], af[ks & 1][i], acc[i][j]) : MFMA32(af[ks & 1][i], bfr[ks & 1][j], acc[i][j]);
        if (ks == 0 && kt + 2 < NK) {
          const u16* ag = Ag + (kt + 2) * 64;
#pragma unroll
          for (int i = 0; i < 8; ++i) ra[u][i] = *(const u32x4*)(ag + aoff[i]);
#pragma unroll
          for (int i = 0; i < 8; ++i) { __builtin_amdgcn_sched_group_barrier(0x008, 1, 0); __builtin_amdgcn_sched_group_barrier(0x020, 1, 0); }
        }
        if (ks == 2 && kt + 2 < NK) {
          const u16* bg = Bg + (kt + 2) * 64;
#pragma unroll
          for (int i = 0; i < NB; ++i) rb[u][i] = *(const u32x4*)(bg + boff[i]);
#pragma unroll
          for (int i = 0; i < NB; ++i) { __builtin_amdgcn_sched_group_barrier(0x008, 1, 0); __builtin_amdgcn_sched_group_barrier(0x020, 1, 0); }
        }
        if (ks == 1 && kt + 1 < NK) {
          u16* ad = As + (u ^ 1) * 256 * 72 + lds_st; u16* bd = Bs + (u ^ 1) * BN * 72 + lds_st;
#pragma unroll
          for (int i = 0; i < 8; ++i) *(u32x4*)(ad + (32 * i) * 72) = ra[u ^ 1][i];
#pragma unroll
          for (int i = 0; i < NB; ++i) *(u32x4*)(bd + (32 * i) * 72) = rb[u ^ 1][i];
#pragma unroll
          for (int i = 0; i < 6; ++i) { __builtin_amdgcn_sched_group_barrier(0x008, 1, 0); __builtin_amdgcn_sched_group_barrier(0x200, 2, 0); }
        }
        __builtin_amdgcn_sched_barrier(0);
        if (ks == 2) __syncthreads();
      }
    }
#pragma unroll
    for (int i = 0; i < 4; ++i)
#pragma unroll
      for (int j = 0; j < TJ; ++j) {
        if (SWAP) epi(z, mt * 256 + 128 * wm + 32 * i + r, nt * BN + 32 * TJ * wn + 32 * j, h, acc[i][j]);
        else epi(z, mt * 256 + 128 * wm + 32 * i, nt * BN + 32 * TJ * wn + 32 * j + r, h, acc[i][j]);
      }
  }
}

struct EpiStoreBf16 {
  u16* C; int ldc; int ncols; bool dry;
  DI void operator()(int z, int row, int colbase, int h, const f32x16& a) const {
    if (dry) return;
#pragma unroll
    for (int g = 0; g < 4; ++g) {
      const int col = colbase + 8 * g + 4 * h;
      if (col < ncols) {
        u32x2 pk = {pack2(a[4 * g], a[4 * g + 1]), pack2(a[4 * g + 2], a[4 * g + 3])};
        *(u32x2*)(C + (size_t)row * ldc + col) = pk;
      }
    }
  }
};
struct EpiResid {
  const float* xin; float* xout; bool rw; int c; bool dry;
  DI void operator()(int z, int row, int colbase, int h, const f32x16& a) const {
    if (dry) return;
    const size_t o = (size_t)gtok(rw, c, row) * 1024 + colbase + 4 * h;
#pragma unroll
    for (int g = 0; g < 4; ++g) {
      float4 v = *(const float4*)(xin + o + 8 * g);
      v.x += a[4 * g]; v.y += a[4 * g + 1]; v.z += a[4 * g + 2]; v.w += a[4 * g + 3];
      *(float4*)(xout + o + 8 * g) = v;
    }
  }
};
struct EpiUQ {
  u16* Q; const float* cs; const float* sn; int c; bool dry;
  DI void operator()(int z, int row, int colbase, int h, const f32x16& a) const {
    if (dry) return;
    const int head = colbase / 192, db = colbase - head * 192;
    const int lb = row >> 13, s = row & 8191;
    u16* qp = Q + ((size_t)(lb * 12 + head) * 8192 + s) * 192 + db + 4 * h;
    const size_t ti = (size_t)(c * 16384 + row) * 32;
#pragma unroll
    for (int g = 0; g < 4; ++g) {
      float v0 = a[4 * g], v1 = a[4 * g + 1], v2 = a[4 * g + 2], v3 = a[4 * g + 3];
      if (db >= 128) {
        const int pi = (db - 128 + 8 * g + 4 * h) >> 1;
        const float2 cc = *(const float2*)(cs + ti + pi), ss = *(const float2*)(sn + ti + pi);
        const float o0 = v0 * cc.x - v1 * ss.x, o1 = v0 * ss.x + v1 * cc.x;
        const float o2 = v2 * cc.y - v3 * ss.y, o3 = v2 * ss.y + v3 * cc.y;
        v0 = o0; v1 = o1; v2 = o2; v3 = o3;
      }
      u32x2 pk = {pack2(v0, v1), pack2(v2, v3)};
      *(u32x2*)(qp + 8 * g) = pk;
    }
  }
};
struct EpiUK {
  u16* Kb; bool dry;
  DI void operator()(int z, int row, int colbase, int h, const f32x16& a) const {
    if (dry) return;
    const int head = colbase >> 7, db = colbase & 127;
    const int lb = row >> 13, s = row & 8191;
    u16* kp = Kb + ((size_t)(lb * 12 + head) * 8192 + s) * 192 + db + 4 * h;
#pragma unroll
    for (int g = 0; g < 4; ++g) {
      u32x2 pk = {pack2(a[4 * g], a[4 * g + 1]), pack2(a[4 * g + 2], a[4 * g + 3])};
      *(u32x2*)(kp + 8 * g) = pk;
    }
  }
};
struct EpiUV {
  u16* Vt; bool dry;
  DI void operator()(int z, int rowbase, int col, int h, const f32x16& a) const {
    if (dry) return;
    const int head = col >> 7, d = col & 127;
#pragma unroll
    for (int g = 0; g < 4; ++g) {
      int lr = rowbase + 8 * g + 4 * h; int lb = lr >> 13, s = lr & 8191;
      u32x2 pk = {pack2(a[4 * g], a[4 * g + 1]), pack2(a[4 * g + 2], a[4 * g + 3])};
      *(u32x2*)(Vt + (((size_t)(lb * 12 + head) * 128 + (s >> 6)) * 128 + d) * 64 + (s & 63)) = pk;
    }
  }
};
struct EpiMemKV {
  u16* MK; u16* MVt; bool dry;
  DI void operator()(int z, int rowbase, int col, int h, const f32x16& a) const {
    if (col < 512) {
      const int xh = col >> 7, d = col & 127;
#pragma unroll
      for (int e = 0; e < 16; ++e) {
        int m = rowbase + crow(e, h); int b = m >> 8, mi = m & 255;
        MK[((size_t)((z * 4 + b) * 4 + xh) * 256 + mi) * 128 + d] = f2bf(a[e]);
      }
    } else {
      const int n = col - 512, xh = n >> 7, d = n & 127;
#pragma unroll
      for (int g = 0; g < 4; ++g) {
        int m = rowbase + 8 * g + 4 * h; int b = m >> 8, mi = m & 255;
        uint2 pk; pk.x = pack2(a[4 * g], a[4 * g + 1]); pk.y = pack2(a[4 * g + 2], a[4 * g + 3]);
        *(uint2*)(MVt + (((size_t)((z * 4 + b) * 4 + xh) * 4 + (mi >> 6)) * 128 + d) * 64 + (mi & 63)) = pk;
      }
    }
  }
};

DI void phase_kvprep(const Params& p, int L, int c, bool dry) {
  const int tid = otid(), w = tid >> 6, lane = tid & 63;
  const int j = L >> 1;
  u16* U = (u16*)(p.ws + OFF_U); u16* Kb = (u16*)(p.ws + OFF_K);
  const float* cs = (const float*)(p.ws + OFF_COS); const float* sn = (const float*)(p.ws + OFF_SIN);
  for (int lr = blockIdx.x * 4 + w; lr < TC; lr += gridDim.x * 4) {
    u16* row = U + (size_t)lr * LDU_M;
    float fq[8], fk[8]; float sq = 0.f, sk = 0.f;
    if (lane < 48) { uint4 v = *(const uint4*)(row + M_CQ + lane * 8); unpack8(v, fq);
#pragma unroll
      for (int e = 0; e < 8; ++e) sq += fq[e] * fq[e]; }
    if (lane < 32) { uint4 v = *(const uint4*)(row + M_CKV + lane * 8); unpack8(v, fk);
#pragma unroll
      for (int e = 0; e < 8; ++e) sk += fk[e] * fk[e]; }
    sq = wave_sum(sq); sk = wave_sum(sk);
    float rq = rsqrtf(sq * (1.f / 384.f) + 1e-6f), rk = rsqrtf(sk * (1.f / 256.f) + 1e-6f);
    if (dry) continue;
    if (lane < 48) {
      const float* g = p.q_norm_g + j * 384 + lane * 8;
#pragma unroll
      for (int e = 0; e < 8; ++e) fq[e] = fq[e] * rq * g[e];
      *(uint4*)(row + M_CQ + lane * 8) = pack8(fq);
    }
    if (lane < 32) {
      const float* g = p.kv_norm_g + j * 256 + lane * 8;
#pragma unroll
      for (int e = 0; e < 8; ++e) fk[e] = fk[e] * rk * g[e];
      *(uint4*)(row + M_CKV + lane * 8) = pack8(fk);
    }
    if (lane < 8) {
      float f[8], o[8]; uint4 v = *(const uint4*)(row + M_KR + lane * 8); unpack8(v, f);
      int gt = c * 16384 + lr;
#pragma unroll
      for (int i = 0; i < 4; ++i) {
        float cc = cs[gt * 32 + lane * 4 + i], ss = sn[gt * 32 + lane * 4 + i];
        o[2 * i] = f[2 * i] * cc - f[2 * i + 1] * ss; o[2 * i + 1] = f[2 * i] * ss + f[2 * i + 1] * cc;
      }
      uint4 pk = pack8(o);
      int lb = lr >> 13, s = lr & 8191;
#pragma unroll
      for (int hd = 0; hd < 12; ++hd) *(uint4*)(Kb + ((size_t)(lb * 12 + hd) * 8192 + s) * 192 + 128 + lane * 8) = pk;
    }
  }
}

template <int DQK>
DI void attn_item(const u16* __restrict__ Qp, int ldq, const u16* __restrict__ Kp, const u16* __restrict__ Vtp, int ldv,
                  int nkt, int q0, bool causal, float c, u16* Yp, int ldy, char* smem, bool dry) {
  constexpr int KLD = DQK + 8;
  constexpr int NKC = DQK * 64 / 8 / 256;
  constexpr int NKS = DQK / 16;
  constexpr int CPR = DQK / 8;
  constexpr int BUFE = 64 * KLD + 128 * 72;
  u16* L0 = (u16*)smem;
  const int tid = otid(), w = tid >> 6, lane = tid & 63, r = lane & 31, h = lane >> 5;
  bf16x8 qf[NKS];
  {
    const u16* qrow = Qp + (size_t)(32 * w + r) * ldq + 8 * h;
#pragma unroll
    for (int ks = 0; ks < NKS; ++ks) qf[ks] = *(const bf16x8*)(qrow + 16 * ks);
  }
  f32x16 o[4];
#pragma unroll
  for (int dt = 0; dt < 4; ++dt)
#pragma unroll
    for (int e = 0; e < 16; ++e) o[dt][e] = 0.f;
  float m = -INFINITY, l = 0.f;
  u32x4 kst[NKC], vst[4];
  const int vd = tid >> 3, vc8 = tid & 7;
  int kso[NKC];
#pragma unroll
  for (int i = 0; i < NKC; ++i) { int id = tid + 256 * i; int row = id / CPR, cc = id - row * CPR; kso[i] = row * KLD + cc * 8; }
  const int vso = 64 * KLD + vd * 72 + 16 * (vc8 >> 1) + 4 * (vc8 & 1);
  __syncthreads();
#pragma unroll
  for (int i = 0; i < NKC; ++i) kst[i] = *(const u32x4*)(Kp + (size_t)(tid + 256 * i) * 8);
#pragma unroll
  for (int i = 0; i < 4; ++i) vst[i] = *(const u32x4*)(Vtp + (size_t)(tid + 256 * i) * 8);
#pragma unroll
  for (int i = 0; i < NKC; ++i) *(u32x4*)(L0 + kso[i]) = kst[i];
#pragma unroll
  for (int i = 0; i < 4; ++i) {
    u16* dst = L0 + vso + (32 * i) * 72;
    u32x2 lo = {vst[i].x, vst[i].y}, hi = {vst[i].z, vst[i].w};
    *(u32x2*)dst = lo; *(u32x2*)(dst + 8) = hi;
  }
  if (nkt > 1) {
    const u16* kg = Kp + (size_t)64 * DQK;
#pragma unroll
    for (int i = 0; i < NKC; ++i) kst[i] = *(const u32x4*)(kg + (size_t)(tid + 256 * i) * 8);
#pragma unroll
    for (int i = 0; i < 4; ++i) vst[i] = *(const u32x4*)(Vtp + 8192 + (size_t)(tid + 256 * i) * 8);
  }
  __syncthreads();
  const int qmin = q0 + 32 * w;
  for (int kt = 0; kt < nkt; ++kt) {
    const u16* Ks = L0 + (kt & 1) * BUFE;
    const u16* Vs = Ks + 64 * KLD;
    u16* Ln = L0 + ((kt + 1) & 1) * BUFE;
    const bool active = !(causal && kt * 64 > qmin + 31);
    f32x16 s0, s1;
#pragma unroll
    for (int e = 0; e < 16; ++e) { s0[e] = 0.f; s1[e] = 0.f; }
    const u16* k0 = Ks + r * KLD + 8 * h;
    bf16x8 ka[2][2];
    if (active) {
      ka[0][0] = *(const bf16x8*)(k0); ka[0][1] = *(const bf16x8*)(k0 + 32 * KLD);
      ka[1][0] = *(const bf16x8*)(k0 + 16); ka[1][1] = *(const bf16x8*)(k0 + 32 * KLD + 16);
      __builtin_amdgcn_sched_barrier(0);
      s0 = MFMA32(ka[0][0], qf[0], s0); s1 = MFMA32(ka[0][1], qf[0], s1);
    }
    if (kt + 1 < nkt) {
#pragma unroll
      for (int i = 0; i < NKC; ++i) *(u32x4*)(Ln + kso[i]) = kst[i];
#pragma unroll
      for (int i = 0; i < 4; ++i) {
        u16* dst = Ln + vso + (32 * i) * 72;
        u32x2 lo = {vst[i].x, vst[i].y}, hi = {vst[i].z, vst[i].w};
        *(u32x2*)dst = lo; *(u32x2*)(dst + 8) = hi;
      }
    }
    if (kt + 2 < nkt) {
      const u16* kg = Kp + (size_t)(kt + 2) * 64 * DQK;
#pragma unroll
      for (int i = 0; i < NKC; ++i) kst[i] = *(const u32x4*)(kg + (size_t)(tid + 256 * i) * 8);
#pragma unroll
      for (int i = 0; i < 4; ++i) vst[i] = *(const u32x4*)(Vtp + (size_t)(kt + 2) * 8192 + (size_t)(tid + 256 * i) * 8);
    }
    if (active) {
      __builtin_amdgcn_sched_barrier(0);
#pragma unroll
      for (int ks = 1; ks < NKS; ++ks) {
        if (ks + 1 < NKS) {
          ka[(ks + 1) & 1][0] = *(const bf16x8*)(k0 + 16 * (ks + 1));
          ka[(ks + 1) & 1][1] = *(const bf16x8*)(k0 + 32 * KLD + 16 * (ks + 1));
        }
        __builtin_amdgcn_sched_barrier(0);
        s0 = MFMA32(ka[ks & 1][0], qf[ks], s0); s1 = MFMA32(ka[ks & 1][1], qf[ks], s1);
        __builtin_amdgcn_sched_barrier(0);
      }
      const u16* v0 = Vs + r * 72 + 8 * h;
      bf16x8 va[2][4];
#pragma unroll
      for (int dt = 0; dt < 4; ++dt) va[0][dt] = *(const bf16x8*)(v0 + (32 * dt) * 72);
      if (causal && kt * 64 + 63 > qmin) {
        const int qi = qmin + r;
#pragma unroll
        for (int e = 0; e < 16; ++e) {
          int key = kt * 64 + crow(e, h);
          if (key > qi) s0[e] = -INFINITY;
          if (key + 32 > qi) s1[e] = -INFINITY;
        }
      }
      float mx = fmaxf(s0[0], s1[0]);
#pragma unroll
      for (int e = 1; e < 16; ++e) mx = fmaxf(mx, fmaxf(s0[e], s1[e]));
      mx = fmaxf(mx, __shfl_xor(mx, 32));
      if (__builtin_amdgcn_ballot_w64((mx - m) * c > 8.f) != 0ull) {
        const float mn = fmaxf(m, mx);
        const float alpha = ex2((m - mn) * c);
        m = mn;
        l *= alpha;
#pragma unroll
        for (int dt = 0; dt < 4; ++dt)
#pragma unroll
          for (int e = 0; e < 16; ++e) o[dt][e] *= alpha;
      }
      const float mc = m * c;
      float ps = 0.f;
#pragma unroll
      for (int e = 0; e < 16; ++e) { s0[e] = ex2(fmaf(s0[e], c, -mc)); s1[e] = ex2(fmaf(s1[e], c, -mc)); ps += s0[e] + s1[e]; }
      l += ps;
      bf16x8 pf[4];
      {
        u32x4 t;
        t.x = pack2(s0[0], s0[1]); t.y = pack2(s0[2], s0[3]); t.z = pack2(s0[4], s0[5]); t.w = pack2(s0[6], s0[7]); pf[0] = __builtin_bit_cast(bf16x8, t);
        t.x = pack2(s0[8], s0[9]); t.y = pack2(s0[10], s0[11]); t.z = pack2(s0[12], s0[13]); t.w = pack2(s0[14], s0[15]); pf[1] = __builtin_bit_cast(bf16x8, t);
        t.x = pack2(s1[0], s1[1]); t.y = pack2(s1[2], s1[3]); t.z = pack2(s1[4], s1[5]); t.w = pack2(s1[6], s1[7]); pf[2] = __builtin_bit_cast(bf16x8, t);
        t.x = pack2(s1[8], s1[9]); t.y = pack2(s1[10], s1[11]); t.z = pack2(s1[12], s1[13]); t.w = pack2(s1[14], s1[15]); pf[3] = __builtin_bit_cast(bf16x8, t);
      }
#pragma unroll
      for (int kk = 0; kk < 4; ++kk) {
        if (kk < 3) {
#pragma unroll
          for (int dt = 0; dt < 4; ++dt) va[(kk + 1) & 1][dt] = *(const bf16x8*)(v0 + (32 * dt) * 72 + 16 * (kk + 1));
        }
        __builtin_amdgcn_sched_barrier(0);
#pragma unroll
        for (int dt = 0; dt < 4; ++dt) o[dt] = MFMA32(va[kk & 1][dt], pf[kk], o[dt]);
        __builtin_amdgcn_sched_barrier(0);
      }
    }
    __syncthreads();
  }
  const float lt = l + __shfl_xor(l, 32);
  const float inv = 1.f / lt;
  if (dry) return;
  u16* yrow = Yp + (size_t)(32 * w + r) * ldy;
#pragma unroll
  for (int dt = 0; dt < 4; ++dt)
#pragma unroll
    for (int g = 0; g < 4; ++g) {
      const int d = 32 * dt + 8 * g + 4 * h;
      uint2 gv = *(const uint2*)(yrow + d);
      float g0 = bf2f(gv.x & 0xffffu), g1 = bf2f(gv.x >> 16), g2 = bf2f(gv.y & 0xffffu), g3 = bf2f(gv.y >> 16);
      uint2 ov;
      ov.x = pack2(o[dt][4 * g] * inv * silu(g0), o[dt][4 * g + 1] * inv * silu(g1));
      ov.y = pack2(o[dt][4 * g + 2] * inv * silu(g2), o[dt][4 * g + 3] * inv * silu(g3));
      *(uint2*)(yrow + d) = ov;
    }
}

template <int DQK>
DI void attn_item_c(const u16* __restrict__ Qp, int ldq, const u16* __restrict__ Kp, const u16* __restrict__ Vtp, int ldv,
                    int nkt, int q0, float c, u16* Yp, int ldy, char* smem, bool dry) {
  constexpr int KLD = DQK + 8;
  constexpr int NKC = DQK * 64 / 8 / 256;
  constexpr int NKS = DQK / 16;
  constexpr int CPR = DQK / 8;
  constexpr int BUFE = 64 * KLD + 128 * 72;
  u16* L0 = (u16*)smem;
  const int tid = otid(), w = tid >> 6, lane = tid & 63, r = lane & 31, h = lane >> 5;
  bf16x8 qf[NKS];
  {
    const u16* qrow = Qp + (size_t)(32 * w + r) * ldq + 8 * h;
#pragma unroll
    for (int ks = 0; ks < NKS; ++ks) qf[ks] = *(const bf16x8*)(qrow + 16 * ks);
  }
  f32x16 o[4];
#pragma unroll
  for (int dt = 0; dt < 4; ++dt)
#pragma unroll
    for (int e = 0; e < 16; ++e) o[dt][e] = 0.f;
  float m = -INFINITY, l = 0.f;
  u32x4 kstA[NKC], vstA[4], kstB[NKC], vstB[4];
  const int vd = tid >> 3, vc8 = tid & 7;
  int kso[NKC];
#pragma unroll
  for (int i = 0; i < NKC; ++i) { int id = tid + 256 * i; int row = id / CPR, cc = id - row * CPR; kso[i] = row * KLD + cc * 8; }
  const int vso = 64 * KLD + vd * 72 + 16 * (vc8 >> 1) + 4 * (vc8 & 1);
  const int nktp = (nkt + 3) & ~3;
  auto gload = [&](u32x4* ks_, u32x4* vs_, int j) {
    const u16* kg = Kp + (size_t)(j + 1) * 64 * DQK;
#pragma unroll
    for (int i = 0; i < NKC; ++i) ks_[i] = *(const u32x4*)(kg + (size_t)(tid + 256 * i) * 8);
#pragma unroll
    for (int i = 0; i < 4; ++i) vs_[i] = *(const u32x4*)(Vtp + (size_t)j * 8192 + (size_t)(tid + 256 * i) * 8);
  };
  auto lstore = [&](const u32x4* ks_, const u32x4* vs_, u16* Lb) {
#pragma unroll
    for (int i = 0; i < NKC; ++i) *(u32x4*)(Lb + kso[i]) = ks_[i];
#pragma unroll
    for (int i = 0; i < 4; ++i) {
      u16* dst = Lb + vso + (32 * i) * 72;
      u32x2 lo = {vs_[i].x, vs_[i].y}, hi = {vs_[i].z, vs_[i].w};
      *(u32x2*)dst = lo; *(u32x2*)(dst + 8) = hi;
    }
  };
  auto gloadK = [&](u32x4* ks_, int j) {
    const u16* kg = Kp + (size_t)(j + 1) * 64 * DQK;
#pragma unroll
    for (int i = 0; i < NKC; ++i) ks_[i] = *(const u32x4*)(kg + (size_t)(tid + 256 * i) * 8);
  };
  auto gloadV = [&](u32x4* vs_, int j) {
#pragma unroll
    for (int i = 0; i < 4; ++i) vs_[i] = *(const u32x4*)(Vtp + (size_t)j * 8192 + (size_t)(tid + 256 * i) * 8);
  };
  auto lstoreK = [&](const u32x4* ks_, u16* Lb) {
#pragma unroll
    for (int i = 0; i < NKC; ++i) *(u32x4*)(Lb + kso[i]) = ks_[i];
  };
  auto lstoreV = [&](const u32x4* vs_, u16* Lb) {
#pragma unroll
    for (int i = 0; i < 4; ++i) {
      u16* dst = Lb + vso + (32 * i) * 72;
      u32x2 lo = {vs_[i].x, vs_[i].y}, hi = {vs_[i].z, vs_[i].w};
      *(u32x2*)dst = lo; *(u32x2*)(dst + 8) = hi;
    }
  };
  __syncthreads();
  gload(kstA, vstA, 0);
  gload(kstB, vstB, 1);
  f32x16 sa0, sa1, sb0, sb1;
#pragma unroll
  for (int e = 0; e < 16; ++e) { sa0[e] = 0.f; sa1[e] = 0.f; }
  {
    const u16* kr = Kp + (size_t)r * DQK + 8 * h;
#pragma unroll
    for (int ks = 0; ks < NKS; ++ks) {
      bf16x8 a0 = *(const bf16x8*)(kr + 16 * ks), a1 = *(const bf16x8*)(kr + 32 * DQK + 16 * ks);
      sa0 = MFMA32(a0, qf[ks], sa0); sa1 = MFMA32(a1, qf[ks], sa1);
    }
  }
  lstore(kstA, vstA, L0);
  gload(kstA, vstA, 2);
  __syncthreads();
  const int qmin = q0 + 32 * w;
  const int qi = qmin + r;
  auto body = [&](int kt, u32x4* wk, u32x4* wv, f32x16& s0, f32x16& s1, f32x16& n0, f32x16& n1) {
    const u16* Ks = L0 + (kt & 1) * BUFE;
    const u16* Vs = Ks + 64 * KLD;
    u16* Ln = L0 + ((kt + 1) & 1) * BUFE;
    const bool active = !(kt * 64 > qmin + 31);
    if (kt * 64 + 63 > qmin) {
#pragma unroll
      for (int e = 0; e < 16; ++e) {
        int key = kt * 64 + crow(e, h);
        if (key > qi) s0[e] = -INFINITY;
        if (key + 32 > qi) s1[e] = -INFINITY;
      }
    }
    float mx = fmaxf(s0[0], s1[0]);
#pragma unroll
    for (int e = 1; e < 16; ++e) mx = fmaxf(fmaxf(mx, s0[e]), s1[e]);
    mx = fmaxf(mx, __shfl_xor(mx, 32));
    if (__builtin_amdgcn_ballot_w64((mx - m) * c > 8.f) != 0ull) {
      const float mn = fmaxf(m, mx);
      const float alpha = ex2((m - mn) * c);
      m = mn;
      l *= alpha;
#pragma unroll
      for (int dt = 0; dt < 4; ++dt)
#pragma unroll
        for (int e = 0; e < 16; ++e) o[dt][e] *= alpha;
    }
    const float mc = m * c;
#pragma unroll
    for (int e = 0; e < 16; ++e) { n0[e] = 0.f; n1[e] = 0.f; }
    const u16* k0 = Ks + r * KLD + 8 * h;
    bf16x8 ka[3][2];
    ka[0][0] = *(const bf16x8*)(k0); ka[0][1] = *(const bf16x8*)(k0 + 32 * KLD);
    ka[1][0] = *(const bf16x8*)(k0 + 16); ka[1][1] = *(const bf16x8*)(k0 + 32 * KLD + 16);
    bf16x8 pf[4];
    u32x4 pk[4];
    float ps = 0.f;
#pragma unroll
    for (int ks = 0; ks < NKS; ++ks) {
      if (ks + 2 < NKS) {
        ka[(ks + 2) % 3][0] = *(const bf16x8*)(k0 + 16 * (ks + 2));
        ka[(ks + 2) % 3][1] = *(const bf16x8*)(k0 + 32 * KLD + 16 * (ks + 2));
      }
      __builtin_amdgcn_sched_barrier(0);
      n0 = MFMA32(ka[ks % 3][0], qf[ks], n0); n1 = MFMA32(ka[ks % 3][1], qf[ks], n1);
      {
        constexpr int dummy0 = 0; (void)dummy0;
        const int e_lo = (32 * ks) / NKS, e_hi = (32 * (ks + 1)) / NKS;
#pragma unroll
        for (int q = 0; q < 3; ++q) {
          const int e = e_lo + q;
          if (e < e_hi) {
            if (e < 16) { s0[e & 15] = ex2(fmaf(s0[e & 15], c, -mc)); ps += s0[e & 15]; }
            else        { s1[e & 15] = ex2(fmaf(s1[e & 15], c, -mc)); ps += s1[e & 15]; }
          }
        }
      }
      if (ks == 3)  { pk[0].x = pack2(s0[0], s0[1]);  pk[0].y = pack2(s0[2], s0[3]);   pk[0].z = pack2(s0[4], s0[5]);   pk[0].w = pack2(s0[6], s0[7]); }
      if (ks == 6)  { pk[1].x = pack2(s0[8], s0[9]);  pk[1].y = pack2(s0[10], s0[11]); pk[1].z = pack2(s0[12], s0[13]); pk[1].w = pack2(s0[14], s0[15]); }
      if (ks == 9)  { pk[2].x = pack2(s1[0], s1[1]);  pk[2].y = pack2(s1[2], s1[3]);   pk[2].z = pack2(s1[4], s1[5]);   pk[2].w = pack2(s1[6], s1[7]); }
      if (ks == NKS - 1) { pk[3].x = pack2(s1[8], s1[9]);  pk[3].y = pack2(s1[10], s1[11]); pk[3].z = pack2(s1[12], s1[13]); pk[3].w = pack2(s1[14], s1[15]); }
      __builtin_amdgcn_sched_barrier(0);
    }
    l += ps;
#pragma unroll
    for (int i = 0; i < 4; ++i) pf[i] = __builtin_bit_cast(bf16x8, pk[i]);
    if (active) {
      const u16* v0 = Vs + r * 72 + 8 * h;
      bf16x8 va[2][4];
#pragma unroll
      for (int dt = 0; dt < 4; ++dt) va[0][dt] = *(const bf16x8*)(v0 + (32 * dt) * 72);
#pragma unroll
      for (int kk = 0; kk < 4; ++kk) {
        if (kk < 3) {
#pragma unroll
          for (int dt = 0; dt < 4; ++dt) va[(kk + 1) & 1][dt] = *(const bf16x8*)(v0 + (32 * dt) * 72 + 16 * (kk + 1));
        }
        __builtin_amdgcn_sched_barrier(0);
#pragma unroll
        for (int dt = 0; dt < 4; ++dt) o[dt] = MFMA32(va[kk & 1][dt], pf[kk], o[dt]);
        if (kk == 0) lstoreK(wk, Ln);
        if (kk == 1) lstoreV(wv, Ln);
        if (kk == 2) gloadK(wk, kt + 3);
        if (kk == 3) gloadV(wv, kt + 3);
        __builtin_amdgcn_sched_barrier(0);
      }
    } else {
      lstore(wk, wv, Ln);
      gload(wk, wv, kt + 3);
    }
    __syncthreads();
  };
  for (int kt4 = 0; kt4 < nktp; kt4 += 4) {
    body(kt4 + 0, kstB, vstB, sa0, sa1, sb0, sb1); body(kt4 + 1, kstA, vstA, sb0, sb1, sa0, sa1);
    body(kt4 + 2, kstB, vstB, sa0, sa1, sb0, sb1); body(kt4 + 3, kstA, vstA, sb0, sb1, sa0, sa1);
  }
  const float lt = l + __shfl_xor(l, 32);
  const float inv = 1.f / lt;
  if (dry) return;
  u16* yrow = Yp + (size_t)(32 * w + r) * ldy;
#pragma unroll
  for (int dt = 0; dt < 4; ++dt)
#pragma unroll
    for (int g = 0; g < 4; ++g) {
      const int d = 32 * dt + 8 * g + 4 * h;
      uint2 gv = *(const uint2*)(yrow + d);
      float g0 = bf2f(gv.x & 0xffffu), g1 = bf2f(gv.x >> 16), g2 = bf2f(gv.y & 0xffffu), g3 = bf2f(gv.y >> 16);
      uint2 ov;
      ov.x = pack2(o[dt][4 * g] * inv * silu(g0), o[dt][4 * g + 1] * inv * silu(g1));
      ov.y = pack2(o[dt][4 * g + 2] * inv * silu(g2), o[dt][4 * g + 3] * inv * silu(g3));
      *(uint2*)(yrow + d) = ov;
    }
}

DI void memattn_item(const Params& p, int L, int c, int item, char* smem, bool dry) {
  const bool rw = L & 1;
  const int ldu = rw ? LDU_R : LDU_M, oq = rw ? R_QM : M_QM, og = rw ? R_GATE : M_GATE;
  const int tile = item >> 2, xh = item & 3;
  const int b = gtok(rw, c, tile * 128) >> 13;
  u16* U = (u16*)(p.ws + OFF_U);
  const u16* MK = (const u16*)(p.ws + OFF_MEMK) + (size_t)((L * 4 + b) * 4 + xh) * 256 * 128;
  const u16* MV = (const u16*)(p.ws + OFF_MEMVT) + (size_t)((L * 4 + b) * 4 + xh) * 128 * 256;
  attn_item<128>(U + (size_t)tile * 128 * ldu + oq + xh * 128, ldu, MK, MV, 256, 4, 0, false,
                 0.08838834764831845f * 1.4426950408889634f, U + (size_t)tile * 128 * ldu + og + 1536 + xh * 128, ldu, smem, dry);
}

DI void phase_attn(const Params& p, int L, int c, char* smem, int* s_item, bool dry) {
  int* cnt = (int*)(p.ws + OFF_CNT) + 64 + ((L * 2 + c) * 2 + (dry ? 1 : 0)) * 16;
  u16* U = (u16*)(p.ws + OFF_U);
  const u16* Q = (const u16*)(p.ws + OFF_Q); const u16* Kb = (const u16*)(p.ws + OFF_K); const u16* Vt = (const u16*)(p.ws + OFF_VT);
  const int xcc = (int)(__builtin_amdgcn_s_getreg((3 << 11) | 20) & 7u);
  for (int k = 0; k < 8; ++k) {
    const int x = (xcc + k) & 7;
    for (;;) {
      __syncthreads();
      if (otid() == 0) *s_item = atomicAdd(cnt + x, 1);
      __syncthreads();
      const int item = *s_item;
      if (item >= 192) break;
      const int qt = 63 - (item & 63), bh = 3 * x + (item >> 6);
      const int lb = bh / 12, head = bh - lb * 12;
      const int q0 = qt * 128;
      attn_item_c<192>(Q + ((size_t)(lb * 12 + head) * 8192 + q0) * 192, 192, Kb + (size_t)(lb * 12 + head) * 8192 * 192,
                     Vt + (size_t)(lb * 12 + head) * 128 * 8192, 8192, 2 * (qt + 1), q0,
                     0.07216878364870323f * 1.4426950408889634f,
                     U + (size_t)(lb * 8192 + q0) * LDU_M + M_GATE + head * 128, LDU_M, smem, dry);
    }
  }
  for (;;) {
    __syncthreads();
    if (otid() == 0) *s_item = atomicAdd(cnt + 8, 1);
    __syncthreads();
    const int item = *s_item;
    if (item >= 512) break;
    memattn_item(p, L, c, item, smem, dry);
  }
}

DI void scan_item(const Params& p, int L, int c, int item, char* smem, bool dry) {
  const int tid = otid(), w = tid >> 6, lane = tid & 63, r = lane & 31, h = lane >> 5;
  const int j = L >> 1;
  const int b = item / 48, rem = item - b * 48, head = rem >> 1, half = rem & 1;
  float* PAb  = (float*)smem;
  float* Vstb = PAb + 2 * 10240;
  float* Ystb = Vstb + 3 * 1024;
  float* PRM  = Ystb + 2 * 1024;
  float* BONb = PRM + 10 * 64;
  u16* A1  = (u16*)(BONb + 96);
  u16* W2t = A1 + 2 * 32 * 72;
  float* LO  = (float*)(W2t + 2 * 64 * 72);
  const u16* U = (const u16*)(p.ws + OFF_U);
  const u16* BND = (const u16*)(p.ws + OFF_BND);
  u16* YR = (u16*)(p.ws + OFF_YR); u16* BV = (u16*)(p.ws + OFF_BV);
  float* ST = (float*)(p.ws + OFF_ST);
  float* STATE = (float*)(p.ws + OFF_STATE);
  __syncthreads();
  if (tid < 64) {
    const float* mu = p.mu + j * SHIFTW;
    const int hc = head * 64 + tid;
    PRM[0 * 64 + tid] = mu[R_R + hc]; PRM[1 * 64 + tid] = mu[R_K + hc]; PRM[2 * 64 + tid] = mu[R_WD + tid]; PRM[3 * 64 + tid] = mu[R_AD + tid];
    PRM[4 * 64 + tid] = p.w0[j * 1536 + hc]; PRM[5 * 64 + tid] = p.a0[j * 1536 + hc]; PRM[6 * 64 + tid] = p.k_k[j * 1536 + hc];
    PRM[7 * 64 + tid] = p.k_a[j * 1536 + hc]; PRM[8 * 64 + tid] = p.r_k[j * 1536 + hc];
    PRM[9 * 64 + tid] = (tid < 32) ? mu[R_V + head * 64 + 32 * half + tid] : 0.f;
  }
  for (int e = tid; e < 8192; e += 256) {
    int arr = e >> 12, jj = (e >> 6) & 63, cc = e & 63;
    const float* src = (arr ? p.a2 : p.w2) + (size_t)j * 64 * 1536;
    W2t[(arr * 64 + cc) * 72 + jj] = f2bf(src[jj * 1536 + head * 64 + cc]);
  }
  const int rowl = lane >> 3, ks = lane & 7, row32 = 8 * w + rowl;
  float S[8];
  {
    float* sp = STATE + ((size_t)((b * 24 + head) * 64 + 32 * half + row32)) * 64 + 8 * ks;
#pragma unroll
    for (int i = 0; i < 8; ++i) S[i] = (c == 0) ? 0.f : sp[i];
  }
  const int tt = tid >> 3, cs = tid & 7, c4 = cs & 3;
  uint4 Rr_c, Rr_p, Rk_c, Rk_p, Rw_c, Rw_p, Ra_c, Ra_p, Rv_c, Rv_p;
  const uint4 zero4 = {0u, 0u, 0u, 0u};
  auto load_raw = [&](int tc) {
    const int lr = b * 4096 + tc * 32 + tt;
    const int s = c * 4096 + tc * 32 + tt;
    const u16* cur = U + (size_t)lr * LDU_R;
    const u16* prv = (s == 0) ? (BND + (size_t)4 * SHIFTW) : ((s == 4096 && c == 1) ? (BND + (size_t)b * SHIFTW) : (cur - LDU_R));
    Rr_c = *(const uint4*)(cur + R_R + head * 64 + cs * 8);  Rr_p = *(const uint4*)(prv + R_R + head * 64 + cs * 8);
    Rk_c = *(const uint4*)(cur + R_K + head * 64 + cs * 8);  Rk_p = *(const uint4*)(prv + R_K + head * 64 + cs * 8);
    Rw_c = *(const uint4*)(cur + R_WD + cs * 8);             Rw_p = *(const uint4*)(prv + R_WD + cs * 8);
    Ra_c = *(const uint4*)(cur + R_AD + cs * 8);             Ra_p = *(const uint4*)(prv + R_AD + cs * 8);
    const int vo = R_V + head * 64 + 32 * half + c4 * 8;
    Rv_c = *(const uint4*)(cur + vo);                        Rv_p = *(const uint4*)(prv + vo);
  };
  uint4 d_y = zero4, d_v = zero4; float d_sm = 0.f, d_sq = 0.f; int d_lr = -1;
  auto flush_out = [&]() {
    if (cs < 4 && !dry && d_lr >= 0) {
      const size_t o = (size_t)d_lr * 1536 + head * 64 + 32 * half + cs * 8;
      *(uint4*)(YR + o) = d_y;
      *(uint4*)(BV + o) = d_v;
      if (cs == 0) {
        float* stp = ST + ((size_t)(d_lr * 24 + head) * 2 + half) * 2;
        stp[0] = d_sm; stp[1] = d_sq;
      }
    }
  };
  float rm[8], km[8];
  auto prep1 = [&](float* Vst) {
    float cu[8], pv[8], t8[8];
    unpack8(Rr_c, cu); unpack8(Rr_p, pv);
#pragma unroll
    for (int e = 0; e < 8; ++e) rm[e] = cu[e] + (pv[e] - cu[e]) * PRM[0 * 64 + cs * 8 + e];
    unpack8(Rk_c, cu); unpack8(Rk_p, pv);
#pragma unroll
    for (int e = 0; e < 8; ++e) km[e] = cu[e] + (pv[e] - cu[e]) * PRM[1 * 64 + cs * 8 + e];
    unpack8(Rw_c, cu); unpack8(Rw_p, pv);
#pragma unroll
    for (int e = 0; e < 8; ++e) {
      float xw = cu[e] + (pv[e] - cu[e]) * PRM[2 * 64 + cs * 8 + e];
      float ee = ex2(xw * 2.8853900817779268f);
      t8[e] = 1.f - 2.f * frcp(ee + 1.f);
    }
    *(uint4*)(A1 + (0 * 32 + tt) * 72 + cs * 8) = pack8(t8);
    unpack8(Ra_c, cu); unpack8(Ra_p, pv);
#pragma unroll
    for (int e = 0; e < 8; ++e) t8[e] = cu[e] + (pv[e] - cu[e]) * PRM[3 * 64 + cs * 8 + e];
    *(uint4*)(A1 + (1 * 32 + tt) * 72 + cs * 8) = pack8(t8);
    unpack8(Rv_c, cu); unpack8(Rv_p, pv);
    float v8[8];
#pragma unroll
    for (int e = 0; e < 8; ++e) v8[e] = cu[e] + (pv[e] - cu[e]) * PRM[9 * 64 + c4 * 8 + e];
    *(float4*)(Vst + tt * 32 + c4 * 8) = make_float4(v8[0], v8[1], v8[2], v8[3]);
    *(float4*)(Vst + tt * 32 + c4 * 8 + 4) = make_float4(v8[4], v8[5], v8[6], v8[7]);
  };
  auto prep3 = [&]() {
    const int arr = w >> 1, nt = w & 1;
    f32x16 acc;
#pragma unroll
    for (int e = 0; e < 16; ++e) acc[e] = 0.f;
#pragma unroll
    for (int k4 = 0; k4 < 4; ++k4) {
      bf16x8 a = *(const bf16x8*)(A1 + (arr * 32 + r) * 72 + 16 * k4 + 8 * h);
      bf16x8 bw = *(const bf16x8*)(W2t + (arr * 64 + 32 * nt + r) * 72 + 16 * k4 + 8 * h);
      acc = MFMA32(a, bw, acc);
    }
#pragma unroll
    for (int e = 0; e < 16; ++e) LO[(arr * 32 + crow(e, h)) * 64 + 32 * nt + r] = acc[e];
  };
  auto prep4 = [&](float* PA, float* BON) {
    float lw[8], la[8];
    {
      float4 t0 = *(const float4*)(LO + (0 * 32 + tt) * 64 + cs * 8), t1 = *(const float4*)(LO + (0 * 32 + tt) * 64 + cs * 8 + 4);
      lw[0] = t0.x; lw[1] = t0.y; lw[2] = t0.z; lw[3] = t0.w; lw[4] = t1.x; lw[5] = t1.y; lw[6] = t1.z; lw[7] = t1.w;
      t0 = *(const float4*)(LO + (1 * 32 + tt) * 64 + cs * 8); t1 = *(const float4*)(LO + (1 * 32 + tt) * 64 + cs * 8 + 4);
      la[0] = t0.x; la[1] = t0.y; la[2] = t0.z; la[3] = t0.w; la[4] = t1.x; la[5] = t1.y; la[6] = t1.z; la[7] = t1.w;
    }
    float dec[8], kk[8], av[8], kp[8];
    float ssq = 0.f, bon = 0.f;
#pragma unroll
    for (int e = 0; e < 8; ++e) {
      const int ch = cs * 8 + e;
      const float sg = frcp(1.f + fexp(-(lw[e] + PRM[4 * 64 + ch])));
      dec[e] = ex2(-0.8750340f * sg);
      float a = frcp(1.f + fexp(-(la[e] + PRM[5 * 64 + ch])));
      av[e] = a;
      kk[e] = km[e] * PRM[6 * 64 + ch];
      ssq += kk[e] * kk[e];
      kp[e] = km[e] * (1.f + (a - 1.f) * PRM[7 * 64 + ch]);
      bon += rm[e] * kp[e] * PRM[8 * 64 + ch];
    }
    ssq = red8(ssq); bon = red8(bon);
    const float inv = 1.f / fmaxf(sqrtf(ssq), 1e-12f);
    float nk[8], bb[8];
#pragma unroll
    for (int e = 0; e < 8; ++e) { float kn = kk[e] * inv; nk[e] = -kn; bb[e] = kn * av[e]; }
    float* pa = PA + tt * 320 + cs * 8;
    *(float4*)(pa) = make_float4(dec[0], dec[1], dec[2], dec[3]); *(float4*)(pa + 4) = make_float4(dec[4], dec[5], dec[6], dec[7]);
    *(float4*)(pa + 64) = make_float4(nk[0], nk[1], nk[2], nk[3]); *(float4*)(pa + 68) = make_float4(nk[4], nk[5], nk[6], nk[7]);
    *(float4*)(pa + 128) = make_float4(bb[0], bb[1], bb[2], bb[3]); *(float4*)(pa + 132) = make_float4(bb[4], bb[5], bb[6], bb[7]);
    *(float4*)(pa + 192) = make_float4(kp[0], kp[1], kp[2], kp[3]); *(float4*)(pa + 196) = make_float4(kp[4], kp[5], kp[6], kp[7]);
    *(float4*)(pa + 256) = make_float4(rm[0], rm[1], rm[2], rm[3]); *(float4*)(pa + 260) = make_float4(rm[4], rm[5], rm[6], rm[7]);
    BON[tt] = bon;
  };
  float4 d0, d1, n0, n1, b0, b1, k0, k1, r0, r1; float vv;
  auto step_load = [&](const float* PA, const float* Vst, int t) {
    const float* pa = PA + t * 320 + ks * 8;
    d0 = *(const float4*)(pa); d1 = *(const float4*)(pa + 4);
    n0 = *(const float4*)(pa + 64); n1 = *(const float4*)(pa + 68);
    b0 = *(const float4*)(pa + 128); b1 = *(const float4*)(pa + 132);
    k0 = *(const float4*)(pa + 192); k1 = *(const float4*)(pa + 196);
    r0 = *(const float4*)(pa + 256); r1 = *(const float4*)(pa + 260);
    vv = Vst[t * 32 + row32];
  };
  auto steps8 = [&](const float* PA, const float* Vst, float* Yst, int t0) {
#pragma unroll
    for (int t8 = 0; t8 < 8; ++t8) {
      const int t = t0 + t8;
      const float* pa = PA + (t + 1) * 320 + ks * 8;
      const float4 xd0 = *(const float4*)(pa), xd1 = *(const float4*)(pa + 4);
      const float4 xn0 = *(const float4*)(pa + 64), xn1 = *(const float4*)(pa + 68);
      const float4 xb0 = *(const float4*)(pa + 128), xb1 = *(const float4*)(pa + 132);
      const float4 xk0 = *(const float4*)(pa + 192), xk1 = *(const float4*)(pa + 196);
      const float4 xr0 = *(const float4*)(pa + 256), xr1 = *(const float4*)(pa + 260);
      const float xvv = Vst[(t + 1) * 32 + row32];
      float sa0 = S[0] * n0.x, sa1 = S[1] * n0.y;
      sa0 = fmaf(S[2], n0.z, sa0); sa1 = fmaf(S[3], n0.w, sa1);
      sa0 = fmaf(S[4], n1.x, sa0); sa1 = fmaf(S[5], n1.y, sa1);
      sa0 = fmaf(S[6], n1.z, sa0); sa1 = fmaf(S[7], n1.w, sa1);
      float sa = red8(sa0 + sa1);
      S[0] = fmaf(sa, b0.x, fmaf(S[0], d0.x, vv * k0.x)); S[1] = fmaf(sa, b0.y, fmaf(S[1], d0.y, vv * k0.y));
      S[2] = fmaf(sa, b0.z, fmaf(S[2], d0.z, vv * k0.z)); S[3] = fmaf(sa, b0.w, fmaf(S[3], d0.w, vv * k0.w));
      S[4] = fmaf(sa, b1.x, fmaf(S[4], d1.x, vv * k1.x)); S[5] = fmaf(sa, b1.y, fmaf(S[5], d1.y, vv * k1.y));
      S[6] = fmaf(sa, b1.z, fmaf(S[6], d1.z, vv * k1.z)); S[7] = fmaf(sa, b1.w, fmaf(S[7], d1.w, vv * k1.w));
      float y0 = S[0] * r0.x, y1 = S[1] * r0.y;
      y0 = fmaf(S[2], r0.z, y0); y1 = fmaf(S[3], r0.w, y1);
      y0 = fmaf(S[4], r1.x, y0); y1 = fmaf(S[5], r1.y, y1);
      y0 = fmaf(S[6], r1.z, y0); y1 = fmaf(S[7], r1.w, y1);
      float y = red8(y0 + y1);
      Yst[t * 32 + row32] = y;
      d0 = xd0; d1 = xd1; n0 = xn0; n1 = xn1; b0 = xb0; b1 = xb1; k0 = xk0; k1 = xk1; r0 = xr0; r1 = xr1; vv = xvv;
    }
  };
  load_raw(0);
  prep1(Vstb);
  __syncthreads();
  prep3();
  load_raw(1);
  __syncthreads();
  prep4(PAb, BONb);
  __syncthreads();
  int v3 = 0;
  for (int tc = 0; tc < 128; ++tc) {
    const int lr = b * 4096 + tc * 32 + tt;
    const int v3n = (v3 == 2) ? 0 : v3 + 1;
    float* PAc = PAb + (tc & 1) * 10240;        float* PAn = PAb + ((tc + 1) & 1) * 10240;
    float* Vc = Vstb + v3 * 1024;               float* Vn = Vstb + v3n * 1024;
    float* Bc = BONb + v3 * 32;                 float* Bn = BONb + v3n * 32;
    float* Yc = Ystb + (tc & 1) * 1024;
    step_load(PAc, Vc, 0);
    prep1(Vn);
    steps8(PAc, Vc, Yc, 0);
    __syncthreads();
    prep3();
    steps8(PAc, Vc, Yc, 8);
    __syncthreads();
    prep4(PAn, Bn);
    steps8(PAc, Vc, Yc, 16);
    load_raw(tc + 2);
    flush_out();
    steps8(PAc, Vc, Yc, 24);
    __syncthreads();
    {
      float y8[8], v8[8];
      float4 t0 = *(const float4*)(Yc + tt * 32 + c4 * 8), t1 = *(const float4*)(Yc + tt * 32 + c4 * 8 + 4);
      y8[0] = t0.x; y8[1] = t0.y; y8[2] = t0.z; y8[3] = t0.w; y8[4] = t1.x; y8[5] = t1.y; y8[6] = t1.z; y8[7] = t1.w;
      float sm = 0.f, sq = 0.f;
#pragma unroll
      for (int e = 0; e < 8; ++e) { sm += y8[e]; sq += y8[e] * y8[e]; }
      sm = red4(sm); sq = red4(sq);
      const float bon = Bc[tt];
      t0 = *(const float4*)(Vc + tt * 32 + c4 * 8); t1 = *(const float4*)(Vc + tt * 32 + c4 * 8 + 4);
      v8[0] = t0.x * bon; v8[1] = t0.y * bon; v8[2] = t0.z * bon; v8[3] = t0.w * bon; v8[4] = t1.x * bon; v8[5] = t1.y * bon; v8[6] = t1.z * bon; v8[7] = t1.w * bon;
      d_y = pack8(y8); d_v = pack8(v8); d_sm = sm; d_sq = sq; d_lr = lr;
    }
    v3 = v3n;
  }
  flush_out();
  if (c == 0 && !dry) {
    float* sp = STATE + ((size_t)((b * 24 + head) * 64 + 32 * half + row32)) * 64 + 8 * ks;
#pragma unroll
    for (int i = 0; i < 8; ++i) sp[i] = S[i];
  }
}

DI void phase_scan(const Params& p, int L, int c, char* smem, int* s_item, bool dry) {
  for (int item = blockIdx.x; item < 192; item += gridDim.x) scan_item(p, L, c, item, smem, dry);
  int* cnt = (int*)(p.ws + OFF_CNT) + 64 + ((L * 2 + c) * 2 + (dry ? 1 : 0)) * 16 + 8;
  for (;;) {
    __syncthreads();
    if (otid() == 0) *s_item = atomicAdd(cnt, 1);
    __syncthreads();
    const int item = *s_item;
    if (item >= 512) break;
    memattn_item(p, L, c, item, smem, dry);
  }
}

DI void phase_finalize(const Params& p, int L, int c, bool dry) {
  const int j = L >> 1;
  u16* U = (u16*)(p.ws + OFF_U);
  const u16* YR = (const u16*)(p.ws + OFF_YR); const u16* BV = (const u16*)(p.ws + OFF_BV);
  const float* ST = (const float*)(p.ws + OFF_ST);
  const int G = gridDim.x;
  for (int idx = blockIdx.x * 256 + otid(); idx < TC * 192; idx += G * 256) {
    const int lr = idx / 192, c8 = idx - lr * 192, ch0 = c8 * 8, head = ch0 >> 6;
    const float4 st = *(const float4*)(ST + (size_t)(lr * 24 + head) * 4);
    const float mean = (st.x + st.z) * (1.f / 64.f);
    const float var = (st.y + st.w) * (1.f / 64.f) - mean * mean;
    const float rstd = rsqrtf(fmaxf(var, 0.f) + 64e-5f);
    float y[8], bv[8], g[8], o[8];
    unpack8(*(const uint4*)(YR + (size_t)lr * 1536 + ch0), y);
    unpack8(*(const uint4*)(BV + (size_t)lr * 1536 + ch0), bv);
    u16* gp = U + (size_t)lr * LDU_R + R_GATE + ch0;
    unpack8(*(const uint4*)gp, g);
    const float* gw = p.gn_w + j * 1536 + ch0; const float* gb = p.gn_b + j * 1536 + ch0;
#pragma unroll
    for (int e = 0; e < 8; ++e) o[e] = ((y[e] - mean) * rstd * gw[e] + gb[e] + bv[e]) * silu(g[e]);
    if (!dry) *(uint4*)gp = pack8(o);
  }
  if (c == 0) {
    u16* BND = (u16*)(p.ws + OFF_BND);
    for (int idx = blockIdx.x * 256 + otid(); idx < 4 * (SHIFTW / 8); idx += G * 256) {
      const int b = idx / (SHIFTW / 8), cc = idx - b * (SHIFTW / 8);
      *(uint4*)(BND + (size_t)b * SHIFTW + cc * 8) = *(const uint4*)(U + (size_t)(b * 4096 + 4095) * LDU_R + cc * 8);
    }
  }
}

enum { PH_PREP = 0, PH_NORM, PH_GEMM_IN, PH_KVPREP, PH_GEMM_UP, PH_ATTN, PH_SCAN, PH_FINALIZE, PH_GEMM_OUT, PH_FINAL };
constexpr int NSTEPS = 42;

DI void decode_step(int step, int& ph, int& L, int& c) {
  if (step == 0) { ph = PH_PREP; L = 0; c = 0; return; }
  if (step == NSTEPS - 1) { ph = PH_FINAL; L = 0; c = 0; return; }
  int s = step - 1;
  int pr = s / 20, rem = s - pr * 20;
  if (rem < 11) {
    L = 2 * pr;
    int k;
    if (rem < 6) { c = 0; k = rem; } else { c = 1; k = rem - 5; }
    ph = (k == 0) ? PH_NORM : (k == 1) ? PH_GEMM_IN : (k == 2) ? PH_KVPREP : (k == 3) ? PH_GEMM_UP : (k == 4) ? PH_ATTN : PH_GEMM_OUT;
  } else {
    rem -= 11; L = 2 * pr + 1;
    int k;
    if (rem < 5) { c = 0; k = rem; } else { c = 1; k = rem - 4; }
    ph = (k == 0) ? PH_NORM : (k == 1) ? PH_GEMM_IN : (k == 2) ? PH_SCAN : (k == 3) ? PH_FINALIZE : PH_GEMM_OUT;
  }
}

DI void run_step(const Params& p, int ph, int L, int c, char* smem, int* s_item, bool dry_in, int vt) {
  const bool dry = dry_in && !(HYP5 && (ph == PH_GEMM_IN || ph == PH_GEMM_UP));
  char* ws = p.ws;
  const bool rw = L & 1;
  const int j = L >> 1;
  switch (ph) {
    case PH_PREP: phase_prep(p, smem); break;
    case PH_NORM:
      phase_norm(p, L, c);
      if (L == 0 && c == 0) {
        EpiMemKV epi{(u16*)(ws + OFF_MEMK), (u16*)(ws + OFF_MEMVT), false};
        gemm_phase<2, false, 16>((const u16*)(ws + OFF_MEMH), 1024ull * 1024, 1024, (const u16*)(ws + OFF_WT_MEMKV), 1024ull * 1024, 1024, 4, 4, 8, 4, 1024, smem, epi, vt);
      }
      break;
    case PH_GEMM_IN:
      if (!rw) {
        EpiStoreBf16 epi{(u16*)(ws + OFF_U), LDU_M, LDU_M, dry};
        gemm_phase<2, true, 16>((const u16*)(ws + OFF_H), 0, 1024, (const u16*)(ws + OFF_WT_INMLA) + (size_t)j * 3328 * 1024, 0, 1024, 1, 64, 26, 4, 1024, smem, epi, vt);
      } else {
        EpiStoreBf16 epi{(u16*)(ws + OFF_U), LDU_R, LDU_R, dry};
        gemm_phase<2, true, 16>((const u16*)(ws + OFF_H), 0, 1024, (const u16*)(ws + OFF_WT_INRW) + (size_t)j * 7296 * 1024, 0, 1024, 1, 64, 57, 4, 1024, smem, epi, vt);
      }
      break;
    case PH_KVPREP: phase_kvprep(p, L, c, dry); break;
    case PH_GEMM_UP: {
      EpiUQ e1{(u16*)(ws + OFF_Q), (const float*)(ws + OFF_COS), (const float*)(ws + OFF_SIN), c, dry};
      gemm_phase<2, true, 6>((const u16*)(ws + OFF_U) + M_CQ, 0, LDU_M, (const u16*)(ws + OFF_WT_UQ) + (size_t)j * 2304 * 384, 0, 384, 1, 64, 18, 4, 384, smem, e1, vt);
      EpiUK e2{(u16*)(ws + OFF_K), dry};
      gemm_phase<2, true, 4>((const u16*)(ws + OFF_U) + M_CKV, 0, LDU_M, (const u16*)(ws + OFF_WT_UKV) + (size_t)j * 3072 * 256, 0, 256, 1, 64, 12, 4, 256, smem, e2, vt);
      EpiUV e3{(u16*)(ws + OFF_VT), dry};
      gemm_phase<2, false, 4>((const u16*)(ws + OFF_U) + M_CKV, 0, LDU_M, (const u16*)(ws + OFF_WT_UKV) + (size_t)j * 3072 * 256 + 1536ull * 256, 0, 256, 1, 64, 12, 4, 256, smem, e3, vt);
    } break;
    case PH_ATTN: phase_attn(p, L, c, smem, s_item, dry); break;
    case PH_SCAN: phase_scan(p, L, c, smem, s_item, dry); break;
    case PH_FINALIZE: phase_finalize(p, L, c, dry); break;
    case PH_GEMM_OUT: {
      EpiResid epi{(L == 0) ? p.x : (const float*)p.out, p.out, rw, c, dry};
      gemm_phase<2, true, 32>((const u16*)(ws + OFF_U) + (rw ? R_GATE : M_GATE), 0, rw ? LDU_R : LDU_M, (const u16*)(ws + OFF_WT_OUT) + (size_t)L * 1024 * 2048, 0, 2048,
                 1, 64, 8, 4, 2048, smem, epi, vt);
      if (c == 0 && !dry) phase_norm(p, L, 1);
    } break;
    case PH_FINAL: phase_final_norm(p, dry); break;
  }
}

DI void grid_barrier(unsigned* bar, unsigned& epoch) {
  __syncthreads();
  ++epoch;
  if (threadIdx.x == 0) {
    __builtin_amdgcn_fence(__ATOMIC_RELEASE, "agent");
    asm volatile("s_waitcnt vmcnt(0)" ::: "memory");
    const unsigned target = epoch * gridDim.x;
    __hip_atomic_fetch_add(bar, 1u, __ATOMIC_RELAXED, __HIP_MEMORY_SCOPE_AGENT);
    unsigned spins = 0;
    while (__hip_atomic_load(bar, __ATOMIC_RELAXED, __HIP_MEMORY_SCOPE_AGENT) < target) {
      __builtin_amdgcn_s_sleep(2);
      if (++spins > (1u << 22)) break;
    }
    __builtin_amdgcn_fence(__ATOMIC_ACQUIRE, "agent");
    asm volatile("s_waitcnt vmcnt(0)" ::: "memory");
  }
  __syncthreads();
}

__global__ void __launch_bounds__(256, 1) hybrid_megakernel(Params p, int s_lo, int s_hi, int coop, int probe_mask) {
  __shared__ __attribute__((aligned(16))) char smem[SMEM_BYTES];
  __shared__ int s_item;
  unsigned* bar = (unsigned*)(p.ws + OFF_BAR);
  unsigned epoch = 0;
  if (coop == 2) cg::this_grid().sync();
  __shared__ int s_vt;
  int myx = 0, myrank = 0;
  if (coop && threadIdx.x == 0) {
    myx = (int)(__builtin_amdgcn_s_getreg((3 << 11) | 20) & 7u);
    myrank = (int)__hip_atomic_fetch_add(bar + 16 + myx, 1u, __ATOMIC_RELAXED, __HIP_MEMORY_SCOPE_AGENT);
  }
  int vt = blockIdx.x;
  {
    const int G = gridDim.x, t = blockIdx.x;
    vt = ((G & 7) == 0) ? ((t & 7) * (G >> 3) + (t >> 3)) : t;
  }
  for (int st = s_lo; st < s_hi; ++st) {
    int ph, L, c;
    decode_step(st, ph, L, c);
    for (int rep = ((probe_mask >> ph) & 1) ? 0 : 1; rep < 2; ++rep) {
      run_step(p, ph, L, c, smem, &s_item, rep == 0, vt);
      if (coop && (rep == 0 || st + 1 < s_hi)) grid_barrier(bar, epoch);
      if (coop) for (int xs = 0; xs < EXTRA_SYNCS; ++xs) grid_barrier(bar, epoch);
    }
    if (coop && st == s_lo) {
      if (threadIdx.x == 0) {
        const int G = gridDim.x;
        bool ok = (G & 7) == 0;
        for (int x = 0; x < 8; ++x) ok = ok && ((int)__hip_atomic_load(bar + 16 + x, __ATOMIC_RELAXED, __HIP_MEMORY_SCOPE_AGENT) == (G >> 3));
        s_vt = ok ? (myx * (G >> 3) + myrank) : vt;
      }
      __syncthreads();
      vt = s_vt;
    }
  }
}

extern "C" void kernel_launch(void* const* d_in, const int* in_sizes, int n_in, void* d_out, int out_size, void* d_ws, size_t ws_size,
                              hipStream_t stream) {
  if (ws_size < WS_NEED) { fprintf(stderr, "workspace too small: %zu < %zu\n", ws_size, (size_t)WS_NEED); return; }
  Params p;
  memset(&p, 0, sizeof(p));
  p.x = (const float*)d_in[0]; p.mem = (const float*)d_in[1]; p.pos = (const int*)d_in[2];
  p.norm_g = (const float*)d_in[3]; p.mem_norm_g = (const float*)d_in[4]; p.w_mem_kv = (const float*)d_in[5];
  p.w_in_mla = (const float*)d_in[6]; p.q_norm_g = (const float*)d_in[7]; p.kv_norm_g = (const float*)d_in[8];
  p.w_uq = (const float*)d_in[9]; p.w_ukv = (const float*)d_in[10]; p.w_in_rwkv = (const float*)d_in[11];
  p.mu = (const float*)d_in[12]; p.w0 = (const float*)d_in[13]; p.w2 = (const float*)d_in[14]; p.a0 = (const float*)d_in[15];
  p.a2 = (const float*)d_in[16]; p.k_k = (const float*)d_in[17]; p.k_a = (const float*)d_in[18]; p.r_k = (const float*)d_in[19];
  p.gn_w = (const float*)d_in[20]; p.gn_b = (const float*)d_in[21]; p.w_out = (const float*)d_in[22]; p.final_g = (const float*)d_in[23];
  p.out = (float*)d_out; p.ws = (char*)d_ws;
  static int grid_blocks = 0;
  if (!grid_blocks) {
    int dev = 0, cus = 0, per_cu = 0;
    hipGetDevice(&dev);
    hipDeviceGetAttribute(&cus, hipDeviceAttributeMultiprocessorCount, dev);
    hipOccupancyMaxActiveBlocksPerMultiprocessor(&per_cu, hybrid_megakernel, 256, 0);
    if (per_cu > 2) per_cu = 2;
    if (per_cu < 1) per_cu = 1;
    grid_blocks = cus * per_cu;
  }
#if MULTI_LAUNCH
  for (int s = 0; s < NSTEPS; ++s) hipLaunchKernelGGL(hybrid_megakernel, dim3(grid_blocks), dim3(256), 0, stream, p, s, s + 1, 0, 0);
#else
  int s_lo = 0, s_hi = NSTEPS, coop = 1, probe_mask = PROBE_MASK;
  void* args[] = {&p, &s_lo, &s_hi, &coop, &probe_mask};
  hipMemsetAsync((char*)d_ws + OFF_BAR, 0, 256, stream);
  hipError_t e = hipLaunchCooperativeKernel((void*)hybrid_megakernel, dim3(grid_blocks), dim3(256), args, 0, stream);
  if (e != hipSuccess) fprintf(stderr, "cooperative launch failed: %s (grid %d)\n", hipGetErrorString(e), grid_blocks);
#endif
}
```

```cpp
#include <hip/hip_runtime.h>
#include <hip/hip_cooperative_groups.h>
#include <cstdio>
#include <cstring>
namespace cg = cooperative_groups;

#define PROBE_MASK 0
#define EXTRA_SYNCS 0
#define HYP1 0
#define HYP2 0
#define HYP3 0
#define HYP4 0
#define HYP5 0
#define HYP6 0
#ifndef MULTI_LAUNCH
#define MULTI_LAUNCH 0
#endif

#define DI __device__ __forceinline__
typedef unsigned short u16;
typedef __attribute__((ext_vector_type(8))) short bf16x8;
typedef __attribute__((ext_vector_type(16))) float f32x16;
typedef __attribute__((ext_vector_type(2))) __bf16 bf2_t;
typedef __attribute__((ext_vector_type(2))) float f2_t;
typedef __attribute__((ext_vector_type(4))) unsigned u32x4;
typedef __attribute__((ext_vector_type(2))) unsigned u32x2;
#define MFMA32(a, b, c) __builtin_amdgcn_mfma_f32_32x32x16_bf16((a), (b), (c), 0, 0, 0)

constexpr int SEQ = 8192, TC = 16384;
constexpr int LDU_M = 3264, LDU_R = 7296;
constexpr int M_CQ = 0, M_CKV = 384, M_KR = 640, M_QM = 704, M_GATE = 1216;
constexpr int R_R = 0, R_K = 1536, R_V = 3072, R_WD = 4608, R_AD = 4672, R_QM = 4736, R_GATE = 5248;
constexpr int SHIFTW = 4736;

constexpr size_t OFF_WT_MEMKV = 0;
constexpr size_t OFF_WT_INMLA = OFF_WT_MEMKV + 4ull * 1024 * 1024 * 2;
constexpr size_t OFF_WT_UQ    = OFF_WT_INMLA + 2ull * 3328 * 1024 * 2;
constexpr size_t OFF_WT_UKV   = OFF_WT_UQ + 2ull * 2304 * 384 * 2;
constexpr size_t OFF_WT_INRW  = OFF_WT_UKV + 2ull * 3072 * 256 * 2;
constexpr size_t OFF_WT_OUT   = OFF_WT_INRW + 2ull * 7296 * 1024 * 2;
constexpr size_t OFF_MEMH     = OFF_WT_OUT + 4ull * 1024 * 2048 * 2;
constexpr size_t OFF_MEMK     = OFF_MEMH + 4ull * 1024 * 1024 * 2;
constexpr size_t OFF_MEMVT    = OFF_MEMK + 4ull * 4 * 4 * 256 * 128 * 2;
constexpr size_t OFF_COS      = OFF_MEMVT + 4ull * 4 * 4 * 256 * 128 * 2;
constexpr size_t OFF_SIN      = OFF_COS + 32768ull * 32 * 4;
constexpr size_t OFF_CNT      = OFF_SIN + 32768ull * 32 * 4;
constexpr size_t OFF_BAR      = OFF_CNT + 4096;
constexpr size_t OFF_STATE    = OFF_BAR + 256;
constexpr size_t OFF_BND      = OFF_STATE + 96ull * 4096 * 4;
constexpr size_t OFF_H        = OFF_BND + 5ull * 4736 * 2 + 128;
constexpr size_t OFF_R        = OFF_H + 16384ull * 1024 * 2;
constexpr size_t OFF_U        = OFF_R;
constexpr size_t OFF_Q        = OFF_R + 16384ull * 3264 * 2;
constexpr size_t OFF_K        = OFF_Q + 2ull * 12 * 8192 * 192 * 2;
constexpr size_t OFF_VT       = OFF_K + 2ull * 12 * 8192 * 192 * 2;
constexpr size_t OFF_YR       = OFF_R + 16384ull * 7296 * 2;
constexpr size_t OFF_BV       = OFF_YR + 16384ull * 1536 * 2;
constexpr size_t OFF_ST       = OFF_BV + 16384ull * 1536 * 2;
constexpr size_t OFF_BS       = OFF_ST + 16384ull * 24 * 4 * 4;
constexpr size_t WS_NEED      = OFF_BS + 16384ull * 24 * 4;

constexpr int SMEM_BYTES = 149504;

struct Params {
  const float *x, *mem; const int* pos;
  const float *norm_g, *mem_norm_g, *w_mem_kv, *w_in_mla, *q_norm_g, *kv_norm_g, *w_uq, *w_ukv, *w_in_rwkv;
  const float *mu, *w0, *w2, *a0, *a2, *k_k, *k_a, *r_k, *gn_w, *gn_b, *w_out, *final_g;
  float* out; char* ws;
};

DI int otid() { int t = threadIdx.x; asm volatile("" : "+v"(t)); return t; }
DI float bf2f(unsigned v) { return __uint_as_float(v << 16); }
DI unsigned pack2(float a, float b) { f2_t v = {a, b}; bf2_t r = __builtin_convertvector(v, bf2_t); return __builtin_bit_cast(unsigned, r); }
DI u16 f2bf(float a) { return (u16)(pack2(a, 0.f) & 0xffffu); }
DI float ex2(float x) { return __builtin_amdgcn_exp2f(x); }
DI float fexp(float x) { return __builtin_amdgcn_exp2f(x * 1.4426950408889634f); }
DI float frcp(float x) { return __builtin_amdgcn_rcpf(x); }
DI float silu(float g) { return g * frcp(1.f + fexp(-g)); }
DI float wave_sum(float v) { for (int o = 32; o > 0; o >>= 1) v += __shfl_xor(v, o); return v; }
DI int crow(int reg, int h) { return (reg & 3) + 8 * (reg >> 2) + 4 * h; }
DI float dppf(float x, const int ctrl_sel) {
  int xi;
  if (ctrl_sel == 0) xi = __builtin_amdgcn_update_dpp(0, __float_as_int(x), 0xB1, 0xf, 0xf, true);
  else if (ctrl_sel == 1) xi = __builtin_amdgcn_update_dpp(0, __float_as_int(x), 0x4E, 0xf, 0xf, true);
  else xi = __builtin_amdgcn_update_dpp(0, __float_as_int(x), 0x141, 0xf, 0xf, true);
  return __int_as_float(xi);
}
DI float red4(float x) { x += dppf(x, 0); x += dppf(x, 1); return x; }
DI float red8(float x) { x += dppf(x, 0); x += dppf(x, 1); x += dppf(x, 2); return x; }
DI int gtok(bool rw, int c, int lr) { return rw ? ((lr >> 12) * 8192 + c * 4096 + (lr & 4095)) : (c * 16384 + lr); }
DI void unpack8(const uint4& v, float* f) {
  f[0] = bf2f(v.x & 0xffffu); f[1] = bf2f(v.x >> 16); f[2] = bf2f(v.y & 0xffffu); f[3] = bf2f(v.y >> 16);
  f[4] = bf2f(v.z & 0xffffu); f[5] = bf2f(v.z >> 16); f[6] = bf2f(v.w & 0xffffu); f[7] = bf2f(v.w >> 16);
}
DI uint4 pack8(const float* f) { uint4 v; v.x = pack2(f[0], f[1]); v.y = pack2(f[2], f[3]); v.z = pack2(f[4], f[5]); v.w = pack2(f[6], f[7]); return v; }

DI void transpose_tile(const float* __restrict__ src, u16* __restrict__ dst, int K, int N, int tk, int tn, int drow, float* tile) {
  const int tid = otid();
  __syncthreads();
#pragma unroll
  for (int i = 0; i < 4; ++i) {
    int kr = (tid >> 4) + 16 * i, nc = (tid & 15) * 4;
    float4 v = *(const float4*)(src + (size_t)(tk * 64 + kr) * N + tn * 64 + nc);
    tile[kr * 65 + nc] = v.x; tile[kr * 65 + nc + 1] = v.y; tile[kr * 65 + nc + 2] = v.z; tile[kr * 65 + nc + 3] = v.w;
  }
  __syncthreads();
#pragma unroll
  for (int i = 0; i < 2; ++i) {
    int n = (tid >> 3) + 32 * i, kc = (tid & 7) * 8;
    float f[8];
#pragma unroll
    for (int e = 0; e < 8; ++e) f[e] = tile[(kc + e) * 65 + n];
    *(uint4*)(dst + (size_t)(drow + n) * K + tk * 64 + kc) = pack8(f);
  }
}

DI void rms_row_bf16(const float* __restrict__ src, const float* __restrict__ g, u16* __restrict__ dst, int lane) {
  float4 v[4]; float ss = 0.f;
#pragma unroll
  for (int i = 0; i < 4; ++i) { v[i] = *(const float4*)(src + i * 256 + lane * 4); ss += v[i].x * v[i].x + v[i].y * v[i].y + v[i].z * v[i].z + v[i].w * v[i].w; }
  ss = wave_sum(ss);
  float rs = rsqrtf(ss * (1.f / 1024.f) + 1e-6f);
#pragma unroll
  for (int i = 0; i < 4; ++i) {
    float4 gg = *(const float4*)(g + i * 256 + lane * 4);
    uint2 o; o.x = pack2(v[i].x * rs * gg.x, v[i].y * rs * gg.y); o.y = pack2(v[i].z * rs * gg.z, v[i].w * rs * gg.w);
    *(uint2*)(dst + i * 256 + lane * 4) = o;
  }
}

DI void phase_prep(const Params& p, char* smem) {
  const int tid = otid(), G = gridDim.x, bid = blockIdx.x;
  char* ws = p.ws;
  if (bid == 0) for (int i = tid; i < 1024; i += 256) ((int*)(ws + OFF_CNT))[i] = 0;
  float* tile = (float*)smem;
  for (int g0 = bid; g0 < 9168; g0 += G) {
    int g = g0;
    const float* src = nullptr; u16* dst = nullptr; int K = 0, N = 0; size_t dstr = 0; bool ukv = false;
    if (g < 1024) { src = p.w_mem_kv; dst = (u16*)(ws + OFF_WT_MEMKV); K = 1024; N = 1024; dstr = 1024ull * 1024; }
    else if ((g -= 1024) < 1632) { src = p.w_in_mla; dst = (u16*)(ws + OFF_WT_INMLA); K = 1024; N = 3264; dstr = 3328ull * 1024; }
    else if ((g -= 1632) < 432) { src = p.w_uq; dst = (u16*)(ws + OFF_WT_UQ); K = 384; N = 2304; dstr = 2304ull * 384; }
    else if ((g -= 432) < 384) { src = p.w_ukv; dst = (u16*)(ws + OFF_WT_UKV); K = 256; N = 3072; dstr = 3072ull * 256; ukv = true; }
    else if ((g -= 384) < 3648) { src = p.w_in_rwkv; dst = (u16*)(ws + OFF_WT_INRW); K = 1024; N = 7296; dstr = 7296ull * 1024; }
    else { g -= 3648; src = p.w_out; dst = (u16*)(ws + OFF_WT_OUT); K = 2048; N = 1024; dstr = 1024ull * 2048; }
    int ntn = N >> 6, per = (K >> 6) * ntn;
    int m = g / per, t = g - m * per;
    int tk = t / ntn, tn = t - tk * ntn;
    int drow = tn * 64;
    if (ukv) { const int hd = drow >> 8, dd = drow & 255; drow = (dd < 128) ? (hd * 128 + dd) : (1536 + hd * 128 + dd - 128); }
    transpose_tile(src + (size_t)m * K * N, dst + (size_t)m * dstr, K, N, tk, tn, drow, tile);
  }
  for (int i = bid * 256 + tid; i < 2 * 64 * 1024 / 8; i += G * 256) {
    int m = i / (64 * 1024 / 8), r = i - m * (64 * 1024 / 8);
    uint4 z; z.x = z.y = z.z = z.w = 0u;
    *(uint4*)((u16*)(ws + OFF_WT_INMLA) + (size_t)m * 3328 * 1024 + 3264ull * 1024 + (size_t)r * 8) = z;
  }
  for (int i = bid * 256 + tid; i < SHIFTW / 8; i += G * 256) { uint4 z; z.x = z.y = z.z = z.w = 0u; *(uint4*)((u16*)(ws + OFF_BND) + 4 * SHIFTW + i * 8) = z; }
  float* cs = (float*)(ws + OFF_COS); float* sn = (float*)(ws + OFF_SIN);
  for (int i = bid * 256 + tid; i < 32768 * 32; i += G * 256) {
    int tk = i >> 5, pi = i & 31;
    float inv_freq = (float)exp2(-(double)(2 * pi) / 64.0 * 13.287712379549449);
    float ang = (float)p.pos[tk] * inv_freq;
    double rev = (double)ang * 0.15915494309189535;
    float fr = (float)(rev - rint(rev));
    cs[i] = __builtin_amdgcn_cosf(fr); sn[i] = __builtin_amdgcn_sinf(fr);
  }
  const int w = tid >> 6, lane = tid & 63;
  for (int row = bid * 4 + w; row < 4096; row += G * 4) {
    int L = row >> 10, m = row & 1023;
    rms_row_bf16(p.mem + (size_t)m * 1024, p.mem_norm_g + L * 1024, (u16*)(ws + OFF_MEMH) + (size_t)row * 1024, lane);
  }
}

DI void phase_norm(const Params& p, int L, int c) {
  const int tid = otid(), w = tid >> 6, lane = tid & 63;
  const bool rw = L & 1;
  const float* xs = (L == 0) ? p.x : p.out;
  u16* H = (u16*)(p.ws + OFF_H);
  for (int lr = blockIdx.x * 4 + w; lr < TC; lr += gridDim.x * 4) {
    int gt = gtok(rw, c, lr);
    rms_row_bf16(xs + (size_t)gt * 1024, p.norm_g + L * 1024, H + (size_t)lr * 1024, lane);
  }
}

DI void phase_final_norm(const Params& p, bool dry) {
  const int tid = otid(), w = tid >> 6, lane = tid & 63;
  for (int row = blockIdx.x * 4 + w; row < 32768; row += gridDim.x * 4) {
    float* xr = p.out + (size_t)row * 1024;
    float4 v[4]; float ss = 0.f;
#pragma unroll
    for (int i = 0; i < 4; ++i) { v[i] = *(const float4*)(xr + i * 256 + lane * 4); ss += v[i].x * v[i].x + v[i].y * v[i].y + v[i].z * v[i].z + v[i].w * v[i].w; }
    ss = wave_sum(ss);
    float rs = rsqrtf(ss * (1.f / 1024.f) + 1e-6f);
#pragma unroll
    for (int i = 0; i < 4; ++i) {
      float4 gg = *(const float4*)(p.final_g + i * 256 + lane * 4);
      float4 o; o.x = v[i].x * rs * gg.x; o.y = v[i].y * rs * gg.y; o.z = v[i].z * rs * gg.z; o.w = v[i].w * rs * gg.w;
      if (!dry) *(float4*)(xr + i * 256 + lane * 4) = o;
    }
  }
}

template <int TJ, bool SWAP, int NK, class Epi>
DI void gemm_phase(const u16* __restrict__ A, size_t strideAz, int lda, const u16* __restrict__ Bt, size_t strideBz, int ldb,
                   int Z, int Mt, int Nt, int GM, int K, char* smem, const Epi& epi, int vt) {
  constexpr int BN = 64 * TJ;
  constexpr int NB = BN / 32;
  const int tid = otid(), w = tid >> 6, lane = tid & 63, r = lane & 31, h = lane >> 5;
  const int wm = w >> 1, wn = w & 1;
  u16* As = (u16*)smem;
  u16* Bs = As + 2 * 256 * 72;
  const int G = gridDim.x, per = Mt * Nt, total = Z * per;
  const int lrow = tid >> 3, lcc = (tid & 7) * 8;
  unsigned aoff[8], boff[NB];
#pragma unroll
  for (int i = 0; i < 8; ++i) aoff[i] = (unsigned)((lrow + 32 * i) * lda + lcc);
#pragma unroll
  for (int i = 0; i < NB; ++i) boff[i] = (unsigned)((lrow + 32 * i) * ldb + lcc);
  const int lds_st = lrow * 72 + lcc;
  for (int base = 0; base < total; base += G) {
    const int q = base + vt;
    if (q >= total) continue;
    const int z = q / per, qq = q - z * per;
    const int grp = qq / (GM * Nt), within = qq - grp * GM * Nt;
    const int mt = grp * GM + (within % GM), nt = within / GM;
    const u16* Ag = A + z * strideAz + (size_t)(mt * 256) * lda;
    const u16* Bg = Bt + z * strideBz + (size_t)(nt * BN) * ldb;
    u32x4 ra[2][8], rb[2][NB];
    f32x16 acc[4][TJ];
#pragma unroll
    for (int i = 0; i < 4; ++i)
#pragma unroll
      for (int j = 0; j < TJ; ++j)
#pragma unroll
        for (int e = 0; e < 16; ++e) acc[i][j][e] = 0.f;
    __syncthreads();
#pragma unroll
    for (int i = 0; i < 8; ++i) ra[0][i] = *(const u32x4*)(Ag + aoff[i]);
#pragma unroll
    for (int i = 0; i < NB; ++i) rb[0][i] = *(const u32x4*)(Bg + boff[i]);
#pragma unroll
    for (int i = 0; i < 8; ++i) ra[1][i] = *(const u32x4*)(Ag + 64 + aoff[i]);
#pragma unroll
    for (int i = 0; i < NB; ++i) rb[1][i] = *(const u32x4*)(Bg + 64 + boff[i]);
#pragma unroll
    for (int i = 0; i < 8; ++i) *(u32x4*)(As + lds_st + (32 * i) * 72) = ra[0][i];
#pragma unroll
    for (int i = 0; i < NB; ++i) *(u32x4*)(Bs + lds_st + (32 * i) * 72) = rb[0][i];
    __syncthreads();
    bf16x8 af[2][4], bfr[2][TJ];
#pragma unroll
    for (int kt = 0; kt < NK; ++kt) {
      constexpr int dummy = 0; (void)dummy;
      const int u = kt & 1;
      const u16* as = As + u * 256 * 72 + (128 * wm + r) * 72 + 8 * h;
      const u16* bs = Bs + u * BN * 72 + (32 * TJ * wn + r) * 72 + 8 * h;
      if (kt == 0) {
#pragma unroll
        for (int i = 0; i < 4; ++i) af[0][i] = *(const bf16x8*)(as + (32 * i) * 72);
#pragma unroll
        for (int j = 0; j < TJ; ++j) bfr[0][j] = *(const bf16x8*)(bs + (32 * j) * 72);
      }
#pragma unroll
      for (int ks = 0; ks < 4; ++ks) {
        if (ks < 3) {
#pragma unroll
          for (int i = 0; i < 4; ++i) af[(ks + 1) & 1][i] = *(const bf16x8*)(as + (32 * i) * 72 + 16 * (ks + 1));
#pragma unroll
          for (int j = 0; j < TJ; ++j) bfr[(ks + 1) & 1][j] = *(const bf16x8*)(bs + (32 * j) * 72 + 16 * (ks + 1));
        } else if (kt + 1 < NK) {
          const u16* asn = As + (u ^ 1) * 256 * 72 + (128 * wm + r) * 72 + 8 * h;
          const u16* bsn = Bs + (u ^ 1) * BN * 72 + (32 * TJ * wn + r) * 72 + 8 * h;
#pragma unroll
          for (int i = 0; i < 4; ++i) af[0][i] = *(const bf16x8*)(asn + (32 * i) * 72);
#pragma unroll
          for (int j = 0; j < TJ; ++j) bfr[0][j] = *(const bf16x8*)(bsn + (32 * j) * 72);
        }
        __builtin_amdgcn_sched_barrier(0);
#pragma unroll
        for (int i = 0; i < 4; ++i)
#pragma unroll
          for (int j = 0; j < TJ; ++j)
            acc[i][j] = SWAP ? MFMA32(bfr[ks & 1][j], af[ks & 1][i], acc[i][j]) : MFMA32(af[ks & 1][i], bfr[ks & 1][j], acc[i][j]);
        if (ks == 0 && kt + 2 < NK) {
          const u16* ag = Ag + (kt + 2) * 64;
#pragma unroll
          for (int i = 0; i < 8; ++i) ra[u][i] = *(const u32x4*)(ag + aoff[i]);
#pragma unroll
          for (int i = 0; i < 8; ++i) { __builtin_amdgcn_sched_group_barrier(0x008, 1, 0); __builtin_amdgcn_sched_group_barrier(0x020, 1, 0); }
        }
        if (ks == 2 && kt + 2 < NK) {
          const u16* bg = Bg + (kt + 2) * 64;
#pragma unroll
          for (int i = 0; i < NB; ++i) rb[u][i] = *(const u32x4*)(bg + boff[i]);
#pragma unroll
          for (int i = 0; i < NB; ++i) { __builtin_amdgcn_sched_group_barrier(0x008, 1, 0); __builtin_amdgcn_sched_group_barrier(0x020, 1, 0); }
        }
        if (ks == 1 && kt + 1 < NK) {
          u16* ad = As + (u ^ 1) * 256 * 72 + lds_st; u16* bd = Bs + (u ^ 1) * BN * 72 + lds_st;
#pragma unroll
          for (int i = 0; i < 8; ++i) *(u32x4*)(ad + (32 * i) * 72) = ra[u ^ 1][i];
#pragma unroll
          for (int i = 0; i < NB; ++i) *(u32x4*)(bd + (32 * i) * 72) = rb[u ^ 1][i];
#pragma unroll
          for (int i = 0; i < 6; ++i) { __builtin_amdgcn_sched_group_barrier(0x008, 1, 0); __builtin_amdgcn_sched_group_barrier(0x200, 2, 0); }
        }
        __builtin_amdgcn_sched_barrier(0);
        if (ks == 2) __syncthreads();
      }
    }
#pragma unroll
    for (int i = 0; i < 4; ++i)
#pragma unroll
      for (int j = 0; j < TJ; ++j) {
        if (SWAP) epi(z, mt * 256 + 128 * wm + 32 * i + r, nt * BN + 32 * TJ * wn + 32 * j, h, acc[i][j]);
        else epi(z, mt * 256 + 128 * wm + 32 * i, nt * BN + 32 * TJ * wn + 32 * j + r, h, acc[i][j]);
      }
  }
}

struct EpiStoreBf16 {
  u16* C; int ldc; int ncols; bool dry;
  DI void operator()(int z, int row, int colbase, int h, const f32x16& a) const {
    if (dry) return;
#pragma unroll
    for (int g = 0; g < 4; ++g) {
      const int col = colbase + 8 * g + 4 * h;
      if (col < ncols) {
        u32x2 pk = {pack2(a[4 * g], a[4 * g + 1]), pack2(a[4 * g + 2], a[4 * g + 3])};
        *(u32x2*)(C + (size_t)row * ldc + col) = pk;
      }
    }
  }
};
struct EpiResid {
  const float* xin; float* xout; bool rw; int c; bool dry;
  DI void operator()(int z, int row, int colbase, int h, const f32x16& a) const {
    if (dry) return;
    const size_t o = (size_t)gtok(rw, c, row) * 1024 + colbase + 4 * h;
#pragma unroll
    for (int g = 0; g < 4; ++g) {
      float4 v = *(const float4*)(xin + o + 8 * g);
      v.x += a[4 * g]; v.y += a[4 * g + 1]; v.z += a[4 * g + 2]; v.w += a[4 * g + 3];
      *(float4*)(xout + o + 8 * g) = v;
    }
  }
};
struct EpiUQ {
  u16* Q; const float* cs; const float* sn; int c; bool dry;
  DI void operator()(int z, int row, int colbase, int h, const f32x16& a) const {
    if (dry) return;
    const int head = colbase / 192, db = colbase - head * 192;
    const int lb = row >> 13, s = row & 8191;
    u16* qp = Q + ((size_t)(lb * 12 + head) * 8192 + s) * 192 + db + 4 * h;
    const size_t ti = (size_t)(c * 16384 + row) * 32;
#pragma unroll
    for (int g = 0; g < 4; ++g) {
      float v0 = a[4 * g], v1 = a[4 * g + 1], v2 = a[4 * g + 2], v3 = a[4 * g + 3];
      if (db >= 128) {
        const int pi = (db - 128 + 8 * g + 4 * h) >> 1;
        const float2 cc = *(const float2*)(cs + ti + pi), ss = *(const float2*)(sn + ti + pi);
        const float o0 = v0 * cc.x - v1 * ss.x, o1 = v0 * ss.x + v1 * cc.x;
        const float o2 = v2 * cc.y - v3 * ss.y, o3 = v2 * ss.y + v3 * cc.y;
        v0 = o0; v1 = o1; v2 = o2; v3 = o3;
      }
      u32x2 pk = {pack2(v0, v1), pack2(v2, v3)};
      *(u32x2*)(qp + 8 * g) = pk;
    }
  }
};
struct EpiUK {
  u16* Kb; bool dry;
  DI void operator()(int z, int row, int colbase, int h, const f32x16& a) const {
    if (dry) return;
    const int head = colbase >> 7, db = colbase & 127;
    const int lb = row >> 13, s = row & 8191;
    u16* kp = Kb + ((size_t)(lb * 12 + head) * 8192 + s) * 192 + db + 4 * h;
#pragma unroll
    for (int g = 0; g < 4; ++g) {
      u32x2 pk = {pack2(a[4 * g], a[4 * g + 1]), pack2(a[4 * g + 2], a[4 * g + 3])};
      *(u32x2*)(kp + 8 * g) = pk;
    }
  }
};
struct EpiUV {
  u16* Vt; bool dry;
  DI void operator()(int z, int rowbase, int col, int h, const f32x16& a) const {
    if (dry) return;
    const int head = col >> 7, d = col & 127;
#pragma unroll
    for (int g = 0; g < 4; ++g) {
      int lr = rowbase + 8 * g + 4 * h; int lb = lr >> 13, s = lr & 8191;
      u32x2 pk = {pack2(a[4 * g], a[4 * g + 1]), pack2(a[4 * g + 2], a[4 * g + 3])};
      *(u32x2*)(Vt + (((size_t)(lb * 12 + head) * 128 + (s >> 6)) * 128 + d) * 64 + (s & 63)) = pk;
    }
  }
};
struct EpiMemKV {
  u16* MK; u16* MVt; bool dry;
  DI void operator()(int z, int rowbase, int col, int h, const f32x16& a) const {
    if (col < 512) {
      const int xh = col >> 7, d = col & 127;
#pragma unroll
      for (int e = 0; e < 16; ++e) {
        int m = rowbase + crow(e, h); int b = m >> 8, mi = m & 255;
        MK[((size_t)((z * 4 + b) * 4 + xh) * 256 + mi) * 128 + d] = f2bf(a[e]);
      }
    } else {
      const int n = col - 512, xh = n >> 7, d = n & 127;
#pragma unroll
      for (int g = 0; g < 4; ++g) {
        int m = rowbase + 8 * g + 4 * h; int b = m >> 8, mi = m & 255;
        uint2 pk; pk.x = pack2(a[4 * g], a[4 * g + 1]); pk.y = pack2(a[4 * g + 2], a[4 * g + 3]);
        *(uint2*)(MVt + (((size_t)((z * 4 + b) * 4 + xh) * 4 + (mi >> 6)) * 128 + d) * 64 + (mi & 63)) = pk;
      }
    }
  }
};

DI void phase_kvprep(const Params& p, int L, int c, bool dry) {
  const int tid = otid(), w = tid >> 6, lane = tid & 63;
  const int j = L >> 1;
  u16* U = (u16*)(p.ws + OFF_U); u16* Kb = (u16*)(p.ws + OFF_K);
  const float* cs = (const float*)(p.ws + OFF_COS); const float* sn = (const float*)(p.ws + OFF_SIN);
  for (int lr = blockIdx.x * 4 + w; lr < TC; lr += gridDim.x * 4) {
    u16* row = U + (size_t)lr * LDU_M;
    float fq[8], fk[8]; float sq = 0.f, sk = 0.f;
    if (lane < 48) { uint4 v = *(const uint4*)(row + M_CQ + lane * 8); unpack8(v, fq);
#pragma unroll
      for (int e = 0; e < 8; ++e) sq += fq[e] * fq[e]; }
    if (lane < 32) { uint4 v = *(const uint4*)(row + M_CKV + lane * 8); unpack8(v, fk);
#pragma unroll
      for (int e = 0; e < 8; ++e) sk += fk[e] * fk[e]; }
    sq = wave_sum(sq); sk = wave_sum(sk);
    float rq = rsqrtf(sq * (1.f / 384.f) + 1e-6f), rk = rsqrtf(sk * (1.f / 256.f) + 1e-6f);
    if (dry) continue;
    if (lane < 48) {
      const float* g = p.q_norm_g + j * 384 + lane * 8;
#pragma unroll
      for (int e = 0; e < 8; ++e) fq[e] = fq[e] * rq * g[e];
      *(uint4*)(row + M_CQ + lane * 8) = pack8(fq);
    }
    if (lane < 32) {
      const float* g = p.kv_norm_g + j * 256 + lane * 8;
#pragma unroll
      for (int e = 0; e < 8; ++e) fk[e] = fk[e] * rk * g[e];
      *(uint4*)(row + M_CKV + lane * 8) = pack8(fk);
    }
    if (lane < 8) {
      float f[8], o[8]; uint4 v = *(const uint4*)(row + M_KR + lane * 8); unpack8(v, f);
      int gt = c * 16384 + lr;
#pragma unroll
      for (int i = 0; i < 4; ++i) {
        float cc = cs[gt * 32 + lane * 4 + i], ss = sn[gt * 32 + lane * 4 + i];
        o[2 * i] = f[2 * i] * cc - f[2 * i + 1] * ss; o[2 * i + 1] = f[2 * i] * ss + f[2 * i + 1] * cc;
      }
      uint4 pk = pack8(o);
      int lb = lr >> 13, s = lr & 8191;
#pragma unroll
      for (int hd = 0; hd < 12; ++hd) *(uint4*)(Kb + ((size_t)(lb * 12 + hd) * 8192 + s) * 192 + 128 + lane * 8) = pk;
    }
  }
}

template <int DQK>
DI void attn_item(const u16* __restrict__ Qp, int ldq, const u16* __restrict__ Kp, const u16* __restrict__ Vtp, int ldv,
                  int nkt, int q0, bool causal, float c, u16* Yp, int ldy, char* smem, bool dry) {
  constexpr int KLD = DQK + 8;
  constexpr int NKC = DQK * 64 / 8 / 256;
  constexpr int NKS = DQK / 16;
  constexpr int CPR = DQK / 8;
  constexpr int BUFE = 64 * KLD + 128 * 72;
  u16* L0 = (u16*)smem;
  const int tid = otid(), w = tid >> 6, lane = tid & 63, r = lane & 31, h = lane >> 5;
  bf16x8 qf[NKS];
  {
    const u16* qrow = Qp + (size_t)(32 * w + r) * ldq + 8 * h;
#pragma unroll
    for (int ks = 0; ks < NKS; ++ks) qf[ks] = *(const bf16x8*)(qrow + 16 * ks);
  }
  f32x16 o[4];
#pragma unroll
  for (int dt = 0; dt < 4; ++dt)
#pragma unroll
    for (int e = 0; e < 16; ++e) o[dt][e] = 0.f;
  float m = -INFINITY, l = 0.f;
  u32x4 kst[NKC], vst[4];
  const int vd = tid >> 3, vc8 = tid & 7;
  int kso[NKC];
#pragma unroll
  for (int i = 0; i < NKC; ++i) { int id = tid + 256 * i; int row = id / CPR, cc = id - row * CPR; kso[i] = row * KLD + cc * 8; }
  const int vso = 64 * KLD + vd * 72 + 16 * (vc8 >> 1) + 4 * (vc8 & 1);
  __syncthreads();
#pragma unroll
  for (int i = 0; i < NKC; ++i) kst[i] = *(const u32x4*)(Kp + (size_t)(tid + 256 * i) * 8);
#pragma unroll
  for (int i = 0; i < 4; ++i) vst[i] = *(const u32x4*)(Vtp + (size_t)(tid + 256 * i) * 8);
#pragma unroll
  for (int i = 0; i < NKC; ++i) *(u32x4*)(L0 + kso[i]) = kst[i];
#pragma unroll
  for (int i = 0; i < 4; ++i) {
    u16* dst = L0 + vso + (32 * i) * 72;
    u32x2 lo = {vst[i].x, vst[i].y}, hi = {vst[i].z, vst[i].w};
    *(u32x2*)dst = lo; *(u32x2*)(dst + 8) = hi;
  }
  if (nkt > 1) {
    const u16* kg = Kp + (size_t)64 * DQK;
#pragma unroll
    for (int i = 0; i < NKC; ++i) kst[i] = *(const u32x4*)(kg + (size_t)(tid + 256 * i) * 8);
#pragma unroll
    for (int i = 0; i < 4; ++i) vst[i] = *(const u32x4*)(Vtp + 8192 + (size_t)(tid + 256 * i) * 8);
  }
  __syncthreads();
  const int qmin = q0 + 32 * w;
  for (int kt = 0; kt < nkt; ++kt) {
    const u16* Ks = L0 + (kt & 1) * BUFE;
    const u16* Vs = Ks + 64 * KLD;
    u16* Ln = L0 + ((kt + 1) & 1) * BUFE;
    const bool active = !(causal && kt * 64 > qmin + 31);
    f32x16 s0, s1;
#pragma unroll
    for (int e = 0; e < 16; ++e) { s0[e] = 0.f; s1[e] = 0.f; }
    const u16* k0 = Ks + r * KLD + 8 * h;
    bf16x8 ka[2][2];
    if (active) {
      ka[0][0] = *(const bf16x8*)(k0); ka[0][1] = *(const bf16x8*)(k0 + 32 * KLD);
      ka[1][0] = *(const bf16x8*)(k0 + 16); ka[1][1] = *(const bf16x8*)(k0 + 32 * KLD + 16);
      __builtin_amdgcn_sched_barrier(0);
      s0 = MFMA32(ka[0][0], qf[0], s0); s1 = MFMA32(ka[0][1], qf[0], s1);
    }
    if (kt + 1 < nkt) {
#pragma unroll
      for (int i = 0; i < NKC; ++i) *(u32x4*)(Ln + kso[i]) = kst[i];
#pragma unroll
      for (int i = 0; i < 4; ++i) {
        u16* dst = Ln + vso + (32 * i) * 72;
        u32x2 lo = {vst[i].x, vst[i].y}, hi = {vst[i].z, vst[i].w};
        *(u32x2*)dst = lo; *(u32x2*)(dst + 8) = hi;
      }
    }
    if (kt + 2 < nkt) {
      const u16* kg = Kp + (size_t)(kt + 2) * 64 * DQK;
#pragma unroll
      for (int i = 0; i < NKC; ++i) kst[i] = *(const u32x4*)(kg + (size_t)(tid + 256 * i) * 8);
#pragma unroll
      for (int i = 0; i < 4; ++i) vst[i] = *(const u32x4*)(Vtp + (size_t)(kt + 2) * 8192 + (size_t)(tid + 256 * i) * 8);
    }
    if (active) {
      __builtin_amdgcn_sched_barrier(0);
#pragma unroll
      for (int ks = 1; ks < NKS; ++ks) {
        if (ks + 1 < NKS) {
          ka[(ks + 1) & 1][0] = *(const bf16x8*)(k0 + 16 * (ks + 1));
          ka[(ks + 1) & 1][1] = *(const bf16x8*)(k0 + 32 * KLD + 16 * (ks + 1));
        }
        __builtin_amdgcn_sched_barrier(0);
        s0 = MFMA32(ka[ks & 1][0], qf[ks], s0); s1 = MFMA32(ka[ks & 1][1], qf[ks], s1);
        __builtin_amdgcn_sched_barrier(0);
      }
      const u16* v0 = Vs + r * 72 + 8 * h;
      bf16x8 va[2][4];
#pragma unroll
      for (int dt = 0; dt < 4; ++dt) va[0][dt] = *(const bf16x8*)(v0 + (32 * dt) * 72);
      if (causal && kt * 64 + 63 > qmin) {
        const int qi = qmin + r;
#pragma unroll
        for (int e = 0; e < 16; ++e) {
          int key = kt * 64 + crow(e, h);
          if (key > qi) s0[e] = -INFINITY;
          if (key + 32 > qi) s1[e] = -INFINITY;
        }
      }
      float mx = fmaxf(s0[0], s1[0]);
#pragma unroll
      for (int e = 1; e < 16; ++e) mx = fmaxf(mx, fmaxf(s0[e], s1[e]));
      mx = fmaxf(mx, __shfl_xor(mx, 32));
      if (__builtin_amdgcn_ballot_w64((mx - m) * c > 8.f) != 0ull) {
        const float mn = fmaxf(m, mx);
        const float alpha = ex2((m - mn) * c);
        m = mn;
        l *= alpha;
#pragma unroll
        for (int dt = 0; dt < 4; ++dt)
#pragma unroll
          for (int e = 0; e < 16; ++e) o[dt][e] *= alpha;
      }
      const float mc = m * c;
      float ps = 0.f;
#pragma unroll
      for (int e = 0; e < 16; ++e) { s0[e] = ex2(fmaf(s0[e], c, -mc)); s1[e] = ex2(fmaf(s1[e], c, -mc)); ps += s0[e] + s1[e]; }
      l += ps;
      bf16x8 pf[4];
      {
        u32x4 t;
        t.x = pack2(s0[0], s0[1]); t.y = pack2(s0[2], s0[3]); t.z = pack2(s0[4], s0[5]); t.w = pack2(s0[6], s0[7]); pf[0] = __builtin_bit_cast(bf16x8, t);
        t.x = pack2(s0[8], s0[9]); t.y = pack2(s0[10], s0[11]); t.z = pack2(s0[12], s0[13]); t.w = pack2(s0[14], s0[15]); pf[1] = __builtin_bit_cast(bf16x8, t);
        t.x = pack2(s1[0], s1[1]); t.y = pack2(s1[2], s1[3]); t.z = pack2(s1[4], s1[5]); t.w = pack2(s1[6], s1[7]); pf[2] = __builtin_bit_cast(bf16x8, t);
        t.x = pack2(s1[8], s1[9]); t.y = pack2(s1[10], s1[11]); t.z = pack2(s1[12], s1[13]); t.w = pack2(s1[14], s1[15]); pf[3] = __builtin_bit_cast(bf16x8, t);
      }
#pragma unroll
      for (int kk = 0; kk < 4; ++kk) {
        if (kk < 3) {
#pragma unroll
          for (int dt = 0; dt < 4; ++dt) va[(kk + 1) & 1][dt] = *(const bf16x8*)(v0 + (32 * dt) * 72 + 16 * (kk + 1));
        }
        __builtin_amdgcn_sched_barrier(0);
#pragma unroll
        for (int dt = 0; dt < 4; ++dt) o[dt] = MFMA32(va[kk & 1][dt], pf[kk], o[dt]);
        __builtin_amdgcn_sched_barrier(0);
      }
    }
    __syncthreads();
  }
  const float lt = l + __shfl_xor(l, 32);
  const float inv = 1.f / lt;
  if (dry) return;
  u16* yrow = Yp + (size_t)(32 * w + r) * ldy;
#pragma unroll
  for (int dt = 0; dt < 4; ++dt)
#pragma unroll
    for (int g = 0; g < 4; ++g) {
      const int d = 32 * dt + 8 * g + 4 * h;
      uint2 gv = *(const uint2*)(yrow + d);
      float g0 = bf2f(gv.x & 0xffffu), g1 = bf2f(gv.x >> 16), g2 = bf2f(gv.y & 0xffffu), g3 = bf2f(gv.y >> 16);
      uint2 ov;
      ov.x = pack2(o[dt][4 * g] * inv * silu(g0), o[dt][4 * g + 1] * inv * silu(g1));
      ov.y = pack2(o[dt][4 * g + 2] * inv * silu(g2), o[dt][4 * g + 3] * inv * silu(g3));
      *(uint2*)(yrow + d) = ov;
    }
}

template <int DQK>
DI void attn_item_c(const u16* __restrict__ Qp, int ldq, const u16* __restrict__ Kp, const u16* __restrict__ Vtp, int ldv,
                    int nkt, int q0, float c, u16* Yp, int ldy, char* smem, bool dry) {
  constexpr int KLD = DQK + 8;
  constexpr int NKC = DQK * 64 / 8 / 256;
  constexpr int NKS = DQK / 16;
  constexpr int CPR = DQK / 8;
  constexpr int BUFE = 64 * KLD + 128 * 72;
  u16* L0 = (u16*)smem;
  const int tid = otid(), w = tid >> 6, lane = tid & 63, r = lane & 31, h = lane >> 5;
  bf16x8 qf[NKS];
  {
    const u16* qrow = Qp + (size_t)(32 * w + r) * ldq + 8 * h;
#pragma unroll
    for (int ks = 0; ks < NKS; ++ks) qf[ks] = *(const bf16x8*)(qrow + 16 * ks);
  }
  f32x16 o[4];
#pragma unroll
  for (int dt = 0; dt < 4; ++dt)
#pragma unroll
    for (int e = 0; e < 16; ++e) o[dt][e] = 0.f;
  float m = -INFINITY, l = 0.f;
  u32x4 kstA[NKC], vstA[4], kstB[NKC], vstB[4];
  const int vd = tid >> 3, vc8 = tid & 7;
  int kso[NKC];
#pragma unroll
  for (int i = 0; i < NKC; ++i) { int id = tid + 256 * i; int row = id / CPR, cc = id - row * CPR; kso[i] = row * KLD + cc * 8; }
  const int vso = 64 * KLD + vd * 72 + 16 * (vc8 >> 1) + 4 * (vc8 & 1);
  const int nktp = (nkt + 3) & ~3;
  auto gload = [&](u32x4* ks_, u32x4* vs_, int j) {
    const u16* kg = Kp + (size_t)(j + 1) * 64 * DQK;
#pragma unroll
    for (int i = 0; i < NKC; ++i) ks_[i] = *(const u32x4*)(kg + (size_t)(tid + 256 * i) * 8);
#pragma unroll
    for (int i = 0; i < 4; ++i) vs_[i] = *(const u32x4*)(Vtp + (size_t)j * 8192 + (size_t)(tid + 256 * i) * 8);
  };
  auto lstore = [&](const u32x4* ks_, const u32x4* vs_, u16* Lb) {
#pragma unroll
    for (int i = 0; i < NKC; ++i) *(u32x4*)(Lb + kso[i]) = ks_[i];
#pragma unroll
    for (int i = 0; i < 4; ++i) {
      u16* dst = Lb + vso + (32 * i) * 72;
      u32x2 lo = {vs_[i].x, vs_[i].y}, hi = {vs_[i].z, vs_[i].w};
      *(u32x2*)dst = lo; *(u32x2*)(dst + 8) = hi;
    }
  };
  auto gloadK = [&](u32x4* ks_, int j) {
    const u16* kg = Kp + (size_t)(j + 1) * 64 * DQK;
#pragma unroll
    for (int i = 0; i < NKC; ++i) ks_[i] = *(const u32x4*)(kg + (size_t)(tid + 256 * i) * 8);
  };
  auto gloadV = [&](u32x4* vs_, int j) {
#pragma unroll
    for (int i = 0; i < 4; ++i) vs_[i] = *(const u32x4*)(Vtp + (size_t)j * 8192 + (size_t)(tid + 256 * i) * 8);
  };
  auto lstoreK = [&](const u32x4* ks_, u16* Lb) {
#pragma unroll
    for (int i = 0; i < NKC; ++i) *(u32x4*)(Lb + kso[i]) = ks_[i];
  };
  auto lstoreV = [&](const u32x4* vs_, u16* Lb) {
#pragma unroll
    for (int i = 0; i < 4; ++i) {
      u16* dst = Lb + vso + (32 * i) * 72;
      u32x2 lo = {vs_[i].x, vs_[i].y}, hi = {vs_[i].z, vs_[i].w};
      *(u32x2*)dst = lo; *(u32x2*)(dst + 8) = hi;
    }
  };
  __syncthreads();
  gload(kstA, vstA, 0);
  gload(kstB, vstB, 1);
  f32x16 sa0, sa1, sb0, sb1;
#pragma unroll
  for (int e = 0; e < 16; ++e) { sa0[e] = 0.f; sa1[e] = 0.f; }
  {
    const u16* kr = Kp + (size_t)r * DQK + 8 * h;
#pragma unroll
    for (int ks = 0; ks < NKS; ++ks) {
      bf16x8 a0 = *(const bf16x8*)(kr + 16 * ks), a1 = *(const bf16x8*)(kr + 32 * DQK + 16 * ks);
      sa0 = MFMA32(a0, qf[ks], sa0); sa1 = MFMA32(a1, qf[ks], sa1);
    }
  }
  lstore(kstA, vstA, L0);
  gload(kstA, vstA, 2);
  __syncthreads();
  const int qmin = q0 + 32 * w;
  const int qi = qmin + r;
  auto body = [&](int kt, u32x4* wk, u32x4* wv, f32x16& s0, f32x16& s1, f32x16& n0, f32x16& n1) {
    const u16* Ks = L0 + (kt & 1) * BUFE;
    const u16* Vs = Ks + 64 * KLD;
    u16* Ln = L0 + ((kt + 1) & 1) * BUFE;
    const bool active = !(kt * 64 > qmin + 31);
    if (kt * 64 + 63 > qmin) {
#pragma unroll
      for (int e = 0; e < 16; ++e) {
        int key = kt * 64 + crow(e, h);
        if (key > qi) s0[e] = -INFINITY;
        if (key + 32 > qi) s1[e] = -INFINITY;
      }
    }
    float mx = fmaxf(s0[0], s1[0]);
#pragma unroll
    for (int e = 1; e < 16; ++e) mx = fmaxf(fmaxf(mx, s0[e]), s1[e]);
    mx = fmaxf(mx, __shfl_xor(mx, 32));
    if (__builtin_amdgcn_ballot_w64((mx - m) * c > 8.f) != 0ull) {
      const float mn = fmaxf(m, mx);
      const float alpha = ex2((m - mn) * c);
      m = mn;
      l *= alpha;
#pragma unroll
      for (int dt = 0; dt < 4; ++dt)
#pragma unroll
        for (int e = 0; e < 16; ++e) o[dt][e] *= alpha;
    }
    const float mc = m * c;
#pragma unroll
    for (int e = 0; e < 16; ++e) { n0[e] = 0.f; n1[e] = 0.f; }
    const u16* k0 = Ks + r * KLD + 8 * h;
    bf16x8 ka[3][2];
    ka[0][0] = *(const bf16x8*)(k0); ka[0][1] = *(const bf16x8*)(k0 + 32 * KLD);
    ka[1][0] = *(const bf16x8*)(k0 + 16); ka[1][1] = *(const bf16x8*)(k0 + 32 * KLD + 16);
    bf16x8 pf[4];
    u32x4 pk[4];
    float ps = 0.f;
#pragma unroll
    for (int ks = 0; ks < NKS; ++ks) {
      if (ks + 2 < NKS) {
        ka[(ks + 2) % 3][0] = *(const bf16x8*)(k0 + 16 * (ks + 2));
        ka[(ks + 2) % 3][1] = *(const bf16x8*)(k0 + 32 * KLD + 16 * (ks + 2));
      }
      __builtin_amdgcn_sched_barrier(0);
      n0 = MFMA32(ka[ks % 3][0], qf[ks], n0); n1 = MFMA32(ka[ks % 3][1], qf[ks], n1);
      {
        constexpr int dummy0 = 0; (void)dummy0;
        const int e_lo = (32 * ks) / NKS, e_hi = (32 * (ks + 1)) / NKS;
#pragma unroll
        for (int q = 0; q < 3; ++q) {
          const int e = e_lo + q;
          if (e < e_hi) {
            if (e < 16) { s0[e & 15] = ex2(fmaf(s0[e & 15], c, -mc)); ps += s0[e & 15]; }
            else        { s1[e & 15] = ex2(fmaf(s1[e & 15], c, -mc)); ps += s1[e & 15]; }
          }
        }
      }
      if (ks == 3)  { pk[0].x = pack2(s0[0], s0[1]);  pk[0].y = pack2(s0[2], s0[3]);   pk[0].z = pack2(s0[4], s0[5]);   pk[0].w = pack2(s0[6], s0[7]); }
      if (ks == 6)  { pk[1].x = pack2(s0[8], s0[9]);  pk[1].y = pack2(s0[10], s0[11]); pk[1].z = pack2(s0[12], s0[13]); pk[1].w = pack2(s0[14], s0[15]); }
      if (ks == 9)  { pk[2].x = pack2(s1[0], s1[1]);  pk[2].y = pack2(s1[2], s1[3]);   pk[2].z = pack2(s1[4], s1[5]);   pk[2].w = pack2(s1[6], s1[7]); }
      if (ks == NKS - 1) { pk[3].x = pack2(s1[8], s1[9]);  pk[3].y = pack2(s1[10], s1[11]); pk[3].z = pack2(s1[12], s1[13]); pk[3].w = pack2(s1[14], s1[15]); }
      __builtin_amdgcn_sched_barrier(0);
    }
    l += ps;
#pragma unroll
    for (int i = 0; i < 4; ++i) pf[i] = __builtin_bit_cast(bf16x8, pk[i]);
    if (active) {
      const u16* v0 = Vs + r * 72 + 8 * h;
      bf16x8 va[2][4];
#pragma unroll
      for (int dt = 0; dt < 4; ++dt) va[0][dt] = *(const bf16x8*)(v0 + (32 * dt) * 72);
#pragma unroll
      for (int kk = 0; kk < 4; ++kk) {
        if (kk < 3) {
#pragma unroll
          for (int dt = 0; dt < 4; ++dt) va[(kk + 1) & 1][dt] = *(const bf16x8*)(v0 + (32 * dt) * 72 + 16 * (kk + 1));
        }
        __builtin_amdgcn_sched_barrier(0);
#pragma unroll
        for (int dt = 0; dt < 4; ++dt) o[dt] = MFMA32(va[kk & 1][dt], pf[kk], o[dt]);
        if (kk == 0) lstoreK(wk, Ln);
        if (kk == 1) lstoreV(wv, Ln);
        if (kk == 2) gloadK(wk, kt + 3);
        if (kk == 3) gloadV(wv, kt + 3);
        __builtin_amdgcn_sched_barrier(0);
      }
    } else {
      lstore(wk, wv, Ln);
      gload(wk, wv, kt + 3);
    }
    __syncthreads();
  };
  for (int kt4 = 0; kt4 < nktp; kt4 += 4) {
    body(kt4 + 0, kstB, vstB, sa0, sa1, sb0, sb1); body(kt4 + 1, kstA, vstA, sb0, sb1, sa0, sa1);
    body(kt4 + 2, kstB, vstB, sa0, sa1, sb0, sb1); body(kt4 + 3, kstA, vstA, sb0, sb1, sa0, sa1);
  }
  const float lt = l + __shfl_xor(l, 32);
  const float inv = 1.f / lt;
  if (dry) return;
  u16* yrow = Yp + (size_t)(32 * w + r) * ldy;
#pragma unroll
  for (int dt = 0; dt < 4; ++dt)
#pragma unroll
    for (int g = 0; g < 4; ++g) {
      const int d = 32 * dt + 8 * g + 4 * h;
      uint2 gv = *(const uint2*)(yrow + d);
      float g0 = bf2f(gv.x & 0xffffu), g1 = bf2f(gv.x >> 16), g2 = bf2f(gv.y & 0xffffu), g3 = bf2f(gv.y >> 16);
      uint2 ov;
      ov.x = pack2(o[dt][4 * g] * inv * silu(g0), o[dt][4 * g + 1] * inv * silu(g1));
      ov.y = pack2(o[dt][4 * g + 2] * inv * silu(g2), o[dt][4 * g + 3] * inv * silu(g3));
      *(uint2*)(yrow + d) = ov;
    }
}

DI void memattn_item(const Params& p, int L, int c, int item, char* smem, bool dry) {
  const bool rw = L & 1;
  const int ldu = rw ? LDU_R : LDU_M, oq = rw ? R_QM : M_QM, og = rw ? R_GATE : M_GATE;
  const int tile = item >> 2, xh = item & 3;
  const int b = gtok(rw, c, tile * 128) >> 13;
  u16* U = (u16*)(p.ws + OFF_U);
  const u16* MK = (const u16*)(p.ws + OFF_MEMK) + (size_t)((L * 4 + b) * 4 + xh) * 256 * 128;
  const u16* MV = (const u16*)(p.ws + OFF_MEMVT) + (size_t)((L * 4 + b) * 4 + xh) * 128 * 256;
  attn_item<128>(U + (size_t)tile * 128 * ldu + oq + xh * 128, ldu, MK, MV, 256, 4, 0, false,
                 0.08838834764831845f * 1.4426950408889634f, U + (size_t)tile * 128 * ldu + og + 1536 + xh * 128, ldu, smem, dry);
}

DI void phase_attn(const Params& p, int L, int c, char* smem, int* s_item, bool dry) {
  int* cnt = (int*)(p.ws + OFF_CNT) + 64 + ((L * 2 + c) * 2 + (dry ? 1 : 0)) * 16;
  u16* U = (u16*)(p.ws + OFF_U);
  const u16* Q = (const u16*)(p.ws + OFF_Q); const u16* Kb = (const u16*)(p.ws + OFF_K); const u16* Vt = (const u16*)(p.ws + OFF_VT);
  const int xcc = (int)(__builtin_amdgcn_s_getreg((3 << 11) | 20) & 7u);
  for (int k = 0; k < 8; ++k) {
    const int x = (xcc + k) & 7;
    for (;;) {
      __syncthreads();
      if (otid() == 0) *s_item = atomicAdd(cnt + x, 1);
      __syncthreads();
      const int item = *s_item;
      if (item >= 192) break;
      const int qt = 63 - (item & 63), bh = 3 * x + (item >> 6);
      const int lb = bh / 12, head = bh - lb * 12;
      const int q0 = qt * 128;
      attn_item_c<192>(Q + ((size_t)(lb * 12 + head) * 8192 + q0) * 192, 192, Kb + (size_t)(lb * 12 + head) * 8192 * 192,
                     Vt + (size_t)(lb * 12 + head) * 128 * 8192, 8192, 2 * (qt + 1), q0,
                     0.07216878364870323f * 1.4426950408889634f,
                     U + (size_t)(lb * 8192 + q0) * LDU_M + M_GATE + head * 128, LDU_M, smem, dry);
    }
  }
  for (;;) {
    __syncthreads();
    if (otid() == 0) *s_item = atomicAdd(cnt + 8, 1);
    __syncthreads();
    const int item = *s_item;
    if (item >= 512) break;
    memattn_item(p, L, c, item, smem, dry);
  }
}

DI void scan_item(const Params& p, int L, int c, int item, char* smem, bool dry) {
  const int tid = otid(), w = tid >> 6, lane = tid & 63, r = lane & 31, h = lane >> 5;
  const int j = L >> 1;
  const int b = item / 48, rem = item - b * 48, head = rem >> 1, half = rem & 1;
  float* PAb  = (float*)smem;
  float* Vstb = PAb + 2 * 10240;
  float* Ystb = Vstb + 3 * 1024;
  float* PRM  = Ystb + 2 * 1024;
  float* BONb = PRM + 10 * 64;
  u16* A1  = (u16*)(BONb + 96);
  u16* W2t = A1 + 2 * 32 * 72;
  float* LO  = (float*)(W2t + 2 * 64 * 72);
  const u16* U = (const u16*)(p.ws + OFF_U);
  const u16* BND = (const u16*)(p.ws + OFF_BND);
  u16* YR = (u16*)(p.ws + OFF_YR); u16* BV = (u16*)(p.ws + OFF_BV);
  float* ST = (float*)(p.ws + OFF_ST);
  float* STATE = (float*)(p.ws + OFF_STATE);
  __syncthreads();
  if (tid < 64) {
    const float* mu = p.mu + j * SHIFTW;
    const int hc = head * 64 + tid;
    PRM[0 * 64 + tid] = mu[R_R + hc]; PRM[1 * 64 + tid] = mu[R_K + hc]; PRM[2 * 64 + tid] = mu[R_WD + tid]; PRM[3 * 64 + tid] = mu[R_AD + tid];
    PRM[4 * 64 + tid] = p.w0[j * 1536 + hc]; PRM[5 * 64 + tid] = p.a0[j * 1536 + hc]; PRM[6 * 64 + tid] = p.k_k[j * 1536 + hc];
    PRM[7 * 64 + tid] = p.k_a[j * 1536 + hc]; PRM[8 * 64 + tid] = p.r_k[j * 1536 + hc];
    PRM[9 * 64 + tid] = (tid < 32) ? mu[R_V + head * 64 + 32 * half + tid] : 0.f;
  }
  for (int e = tid; e < 8192; e += 256) {
    int arr = e >> 12, jj = (e >> 6) & 63, cc = e & 63;
    const float* src = (arr ? p.a2 : p.w2) + (size_t)j * 64 * 1536;
    W2t[(arr * 64 + cc) * 72 + jj] = f2bf(src[jj * 1536 + head * 64 + cc]);
  }
  const int rowl = lane >> 3, ks = lane & 7, row32 = 8 * w + rowl;
  float S[8];
  {
    float* sp = STATE + ((size_t)((b * 24 + head) * 64 + 32 * half + row32)) * 64 + 8 * ks;
#pragma unroll
    for (int i = 0; i < 8; ++i) S[i] = (c == 0) ? 0.f : sp[i];
  }
  const int tt = tid >> 3, cs = tid & 7, c4 = cs & 3;
  uint4 Rr_c, Rr_p, Rk_c, Rk_p, Rw_c, Rw_p, Ra_c, Ra_p, Rv_c, Rv_p;
  const uint4 zero4 = {0u, 0u, 0u, 0u};
  auto load_raw = [&](int tc) {
    const int lr = b * 4096 + tc * 32 + tt;
    const int s = c * 4096 + tc * 32 + tt;
    const u16* cur = U + (size_t)lr * LDU_R;
    const u16* prv = (s == 0) ? (BND + (size_t)4 * SHIFTW) : ((s == 4096 && c == 1) ? (BND + (size_t)b * SHIFTW) : (cur - LDU_R));
    Rr_c = *(const uint4*)(cur + R_R + head * 64 + cs * 8);  Rr_p = *(const uint4*)(prv + R_R + head * 64 + cs * 8);
    Rk_c = *(const uint4*)(cur + R_K + head * 64 + cs * 8);  Rk_p = *(const uint4*)(prv + R_K + head * 64 + cs * 8);
    Rw_c = *(const uint4*)(cur + R_WD + cs * 8);             Rw_p = *(const uint4*)(prv + R_WD + cs * 8);
    Ra_c = *(const uint4*)(cur + R_AD + cs * 8);             Ra_p = *(const uint4*)(prv + R_AD + cs * 8);
    const int vo = R_V + head * 64 + 32 * half + c4 * 8;
    Rv_c = *(const uint4*)(cur + vo);                        Rv_p = *(const uint4*)(prv + vo);
  };
  uint4 d_y = zero4, d_v = zero4; float d_sm = 0.f, d_sq = 0.f; int d_lr = -1;
  auto flush_out = [&]() {
    if (cs < 4 && !dry && d_lr >= 0) {
      const size_t o = (size_t)d_lr * 1536 + head * 64 + 32 * half + cs * 8;
      *(uint4*)(YR + o) = d_y;
      *(uint4*)(BV + o) = d_v;
      if (cs == 0) {
        float* stp = ST + ((size_t)(d_lr * 24 + head) * 2 + half) * 2;
        stp[0] = d_sm; stp[1] = d_sq;
      }
    }
  };
  float rm[8], km[8];
  auto prep1 = [&](float* Vst) {
    float cu[8], pv[8], t8[8];
    unpack8(Rr_c, cu); unpack8(Rr_p, pv);
#pragma unroll
    for (int e = 0; e < 8; ++e) rm[e] = cu[e] + (pv[e] - cu[e]) * PRM[0 * 64 + cs * 8 + e];
    unpack8(Rk_c, cu); unpack8(Rk_p, pv);
#pragma unroll
    for (int e = 0; e < 8; ++e) km[e] = cu[e] + (pv[e] - cu[e]) * PRM[1 * 64 + cs * 8 + e];
    unpack8(Rw_c, cu); unpack8(Rw_p, pv);
#pragma unroll
    for (int e = 0; e < 8; ++e) {
      float xw = cu[e] + (pv[e] - cu[e]) * PRM[2 * 64 + cs * 8 + e];
      float ee = ex2(xw * 2.8853900817779268f);
      t8[e] = 1.f - 2.f * frcp(ee + 1.f);
    }
    *(uint4*)(A1 + (0 * 32 + tt) * 72 + cs * 8) = pack8(t8);
    unpack8(Ra_c, cu); unpack8(Ra_p, pv);
#pragma unroll
    for (int e = 0; e < 8; ++e) t8[e] = cu[e] + (pv[e] - cu[e]) * PRM[3 * 64 + cs * 8 + e];
    *(uint4*)(A1 + (1 * 32 + tt) * 72 + cs * 8) = pack8(t8);
    unpack8(Rv_c, cu); unpack8(Rv_p, pv);
    float v8[8];
#pragma unroll
    for (int e = 0; e < 8; ++e) v8[e] = cu[e] + (pv[e] - cu[e]) * PRM[9 * 64 + c4 * 8 + e];
    *(float4*)(Vst + tt * 32 + c4 * 8) = make_float4(v8[0], v8[1], v8[2], v8[3]);
    *(float4*)(Vst + tt * 32 + c4 * 8 + 4) = make_float4(v8[4], v8[5], v8[6], v8[7]);
  };
  auto prep3 = [&]() {
    const int arr = w >> 1, nt = w & 1;
    f32x16 acc;
#pragma unroll
    for (int e = 0; e < 16; ++e) acc[e] = 0.f;
#pragma unroll
    for (int k4 = 0; k4 < 4; ++k4) {
      bf16x8 a = *(const bf16x8*)(A1 + (arr * 32 + r) * 72 + 16 * k4 + 8 * h);
      bf16x8 bw = *(const bf16x8*)(W2t + (arr * 64 + 32 * nt + r) * 72 + 16 * k4 + 8 * h);
      acc = MFMA32(a, bw, acc);
    }
#pragma unroll
    for (int e = 0; e < 16; ++e) LO[(arr * 32 + crow(e, h)) * 64 + 32 * nt + r] = acc[e];
  };
  auto prep4 = [&](float* PA, float* BON) {
    float lw[8], la[8];
    {
      float4 t0 = *(const float4*)(LO + (0 * 32 + tt) * 64 + cs * 8), t1 = *(const float4*)(LO + (0 * 32 + tt) * 64 + cs * 8 + 4);
      lw[0] = t0.x; lw[1] = t0.y; lw[2] = t0.z; lw[3] = t0.w; lw[4] = t1.x; lw[5] = t1.y; lw[6] = t1.z; lw[7] = t1.w;
      t0 = *(const float4*)(LO + (1 * 32 + tt) * 64 + cs * 8); t1 = *(const float4*)(LO + (1 * 32 + tt) * 64 + cs * 8 + 4);
      la[0] = t0.x; la[1] = t0.y; la[2] = t0.z; la[3] = t0.w; la[4] = t1.x; la[5] = t1.y; la[6] = t1.z; la[7] = t1.w;
    }
    float dec[8], kk[8], av[8], kp[8];
    float ssq = 0.f, bon = 0.f;
#pragma unroll
    for (int e = 0; e < 8; ++e) {
      const int ch = cs * 8 + e;
      const float sg = frcp(1.f + fexp(-(lw[e] + PRM[4 * 64 + ch])));
      dec[e] = ex2(-0.8750340f * sg);
      float a = frcp(1.f + fexp(-(la[e] + PRM[5 * 64 + ch])));
      av[e] = a;
      kk[e] = km[e] * PRM[6 * 64 + ch];
      ssq += kk[e] * kk[e];
      kp[e] = km[e] * (1.f + (a - 1.f) * PRM[7 * 64 + ch]);
      bon += rm[e] * kp[e] * PRM[8 * 64 + ch];
    }
    ssq = red8(ssq); bon = red8(bon);
    const float inv = fminf(__builtin_amdgcn_rsqf(ssq), 1e12f);
    float nk[8], bb[8];
#pragma unroll
    for (int e = 0; e < 8; ++e) { float kn = kk[e] * inv; nk[e] = -kn; bb[e] = kn * av[e]; }
    float* pa = PA + tt * 320 + cs * 8;
    *(float4*)(pa) = make_float4(dec[0], dec[1], dec[2], dec[3]); *(float4*)(pa + 4) = make_float4(dec[4], dec[5], dec[6], dec[7]);
    *(float4*)(pa + 64) = make_float4(nk[0], nk[1], nk[2], nk[3]); *(float4*)(pa + 68) = make_float4(nk[4], nk[5], nk[6], nk[7]);
    *(float4*)(pa + 128) = make_float4(bb[0], bb[1], bb[2], bb[3]); *(float4*)(pa + 132) = make_float4(bb[4], bb[5], bb[6], bb[7]);
    *(float4*)(pa + 192) = make_float4(kp[0], kp[1], kp[2], kp[3]); *(float4*)(pa + 196) = make_float4(kp[4], kp[5], kp[6], kp[7]);
    *(float4*)(pa + 256) = make_float4(rm[0], rm[1], rm[2], rm[3]); *(float4*)(pa + 260) = make_float4(rm[4], rm[5], rm[6], rm[7]);
    BON[tt] = bon;
  };
  float4 d0, d1, n0, n1, b0, b1, k0, k1, r0, r1; float vv;
  auto step_load = [&](const float* PA, const float* Vst, int t) {
    const float* pa = PA + t * 320 + ks * 8;
    d0 = *(const float4*)(pa); d1 = *(const float4*)(pa + 4);
    n0 = *(const float4*)(pa + 64); n1 = *(const float4*)(pa + 68);
    b0 = *(const float4*)(pa + 128); b1 = *(const float4*)(pa + 132);
    k0 = *(const float4*)(pa + 192); k1 = *(const float4*)(pa + 196);
    r0 = *(const float4*)(pa + 256); r1 = *(const float4*)(pa + 260);
    vv = Vst[t * 32 + row32];
  };
  auto steps8 = [&](const float* PA, const float* Vst, float* Yst, int t0) {
#pragma unroll
    for (int t8 = 0; t8 < 8; ++t8) {
      const int t = t0 + t8;
      const float* pa = PA + (t + 1) * 320 + ks * 8;
      const float4 xd0 = *(const float4*)(pa), xd1 = *(const float4*)(pa + 4);
      const float4 xn0 = *(const float4*)(pa + 64), xn1 = *(const float4*)(pa + 68);
      const float4 xb0 = *(const float4*)(pa + 128), xb1 = *(const float4*)(pa + 132);
      const float4 xk0 = *(const float4*)(pa + 192), xk1 = *(const float4*)(pa + 196);
      const float4 xr0 = *(const float4*)(pa + 256), xr1 = *(const float4*)(pa + 260);
      const float xvv = Vst[(t + 1) * 32 + row32];
      float sa0 = S[0] * n0.x, sa1 = S[1] * n0.y;
      sa0 = fmaf(S[2], n0.z, sa0); sa1 = fmaf(S[3], n0.w, sa1);
      sa0 = fmaf(S[4], n1.x, sa0); sa1 = fmaf(S[5], n1.y, sa1);
      sa0 = fmaf(S[6], n1.z, sa0); sa1 = fmaf(S[7], n1.w, sa1);
      float sa = red8(sa0 + sa1);
      S[0] = fmaf(sa, b0.x, fmaf(S[0], d0.x, vv * k0.x)); S[1] = fmaf(sa, b0.y, fmaf(S[1], d0.y, vv * k0.y));
      S[2] = fmaf(sa, b0.z, fmaf(S[2], d0.z, vv * k0.z)); S[3] = fmaf(sa, b0.w, fmaf(S[3], d0.w, vv * k0.w));
      S[4] = fmaf(sa, b1.x, fmaf(S[4], d1.x, vv * k1.x)); S[5] = fmaf(sa, b1.y, fmaf(S[5], d1.y, vv * k1.y));
      S[6] = fmaf(sa, b1.z, fmaf(S[6], d1.z, vv * k1.z)); S[7] = fmaf(sa, b1.w, fmaf(S[7], d1.w, vv * k1.w));
      float y0 = S[0] * r0.x, y1 = S[1] * r0.y;
      y0 = fmaf(S[2], r0.z, y0); y1 = fmaf(S[3], r0.w, y1);
      y0 = fmaf(S[4], r1.x, y0); y1 = fmaf(S[5], r1.y, y1);
      y0 = fmaf(S[6], r1.z, y0); y1 = fmaf(S[7], r1.w, y1);
      float y = red8(y0 + y1);
      Yst[t * 32 + row32] = y;
      d0 = xd0; d1 = xd1; n0 = xn0; n1 = xn1; b0 = xb0; b1 = xb1; k0 = xk0; k1 = xk1; r0 = xr0; r1 = xr1; vv = xvv;
    }
  };
  load_raw(0);
  prep1(Vstb);
  __syncthreads();
  prep3();
  load_raw(1);
  __syncthreads();
  prep4(PAb, BONb);
  __syncthreads();
  int v3 = 0;
  for (int tc = 0; tc < 128; ++tc) {
    const int lr = b * 4096 + tc * 32 + tt;
    const int v3n = (v3 == 2) ? 0 : v3 + 1;
    float* PAc = PAb + (tc & 1) * 10240;        float* PAn = PAb + ((tc + 1) & 1) * 10240;
    float* Vc = Vstb + v3 * 1024;               float* Vn = Vstb + v3n * 1024;
    float* Bc = BONb + v3 * 32;                 float* Bn = BONb + v3n * 32;
    float* Yc = Ystb + (tc & 1) * 1024;
    step_load(PAc, Vc, 0);
    prep1(Vn);
    steps8(PAc, Vc, Yc, 0);
    __syncthreads();
    prep3();
    steps8(PAc, Vc, Yc, 8);
    __syncthreads();
    prep4(PAn, Bn);
    steps8(PAc, Vc, Yc, 16);
    load_raw(tc + 2);
    flush_out();
    steps8(PAc, Vc, Yc, 24);
    __syncthreads();
    {
      float y8[8], v8[8];
      float4 t0 = *(const float4*)(Yc + tt * 32 + c4 * 8), t1 = *(const float4*)(Yc + tt * 32 + c4 * 8 + 4);
      y8[0] = t0.x; y8[1] = t0.y; y8[2] = t0.z; y8[3] = t0.w; y8[4] = t1.x; y8[5] = t1.y; y8[6] = t1.z; y8[7] = t1.w;
      float sm = 0.f, sq = 0.f;
#pragma unroll
      for (int e = 0; e < 8; ++e) { sm += y8[e]; sq += y8[e] * y8[e]; }
      sm = red4(sm); sq = red4(sq);
      const float bon = Bc[tt];
      t0 = *(const float4*)(Vc + tt * 32 + c4 * 8); t1 = *(const float4*)(Vc + tt * 32 + c4 * 8 + 4);
      v8[0] = t0.x * bon; v8[1] = t0.y * bon; v8[2] = t0.z * bon; v8[3] = t0.w * bon; v8[4] = t1.x * bon; v8[5] = t1.y * bon; v8[6] = t1.z * bon; v8[7] = t1.w * bon;
      d_y = pack8(y8); d_v = pack8(v8); d_sm = sm; d_sq = sq; d_lr = lr;
    }
    v3 = v3n;
  }
  flush_out();
  if (c == 0 && !dry) {
    float* sp = STATE + ((size_t)((b * 24 + head) * 64 + 32 * half + row32)) * 64 + 8 * ks;
#pragma unroll
    for (int i = 0; i < 8; ++i) sp[i] = S[i];
  }
}

DI void phase_scan(const Params& p, int L, int c, char* smem, int* s_item, bool dry) {
  for (int item = blockIdx.x; item < 192; item += gridDim.x) scan_item(p, L, c, item, smem, dry);
  int* cnt = (int*)(p.ws + OFF_CNT) + 64 + ((L * 2 + c) * 2 + (dry ? 1 : 0)) * 16 + 8;
  for (;;) {
    __syncthreads();
    if (otid() == 0) *s_item = atomicAdd(cnt, 1);
    __syncthreads();
    const int item = *s_item;
    if (item >= 512) break;
    memattn_item(p, L, c, item, smem, dry);
  }
}

DI void phase_finalize(const Params& p, int L, int c, bool dry) {
  const int j = L >> 1;
  u16* U = (u16*)(p.ws + OFF_U);
  const u16* YR = (const u16*)(p.ws + OFF_YR); const u16* BV = (const u16*)(p.ws + OFF_BV);
  const float* ST = (const float*)(p.ws + OFF_ST);
  const int G = gridDim.x;
  for (int idx = blockIdx.x * 256 + otid(); idx < TC * 192; idx += G * 256) {
    const int lr = idx / 192, c8 = idx - lr * 192, ch0 = c8 * 8, head = ch0 >> 6;
    const float4 st = *(const float4*)(ST + (size_t)(lr * 24 + head) * 4);
    const float mean = (st.x + st.z) * (1.f / 64.f);
    const float var = (st.y + st.w) * (1.f / 64.f) - mean * mean;
    const float rstd = rsqrtf(fmaxf(var, 0.f) + 64e-5f);
    float y[8], bv[8], g[8], o[8];
    unpack8(*(const uint4*)(YR + (size_t)lr * 1536 + ch0), y);
    unpack8(*(const uint4*)(BV + (size_t)lr * 1536 + ch0), bv);
    u16* gp = U + (size_t)lr * LDU_R + R_GATE + ch0;
    unpack8(*(const uint4*)gp, g);
    const float* gw = p.gn_w + j * 1536 + ch0; const float* gb = p.gn_b + j * 1536 + ch0;
#pragma unroll
    for (int e = 0; e < 8; ++e) o[e] = ((y[e] - mean) * rstd * gw[e] + gb[e] + bv[e]) * silu(g[e]);
    if (!dry) *(uint4*)gp = pack8(o);
  }
  if (c == 0) {
    u16* BND = (u16*)(p.ws + OFF_BND);
    for (int idx = blockIdx.x * 256 + otid(); idx < 4 * (SHIFTW / 8); idx += G * 256) {
      const int b = idx / (SHIFTW / 8), cc = idx - b * (SHIFTW / 8);
      *(uint4*)(BND + (size_t)b * SHIFTW + cc * 8) = *(const uint4*)(U + (size_t)(b * 4096 + 4095) * LDU_R + cc * 8);
    }
  }
}

enum { PH_PREP = 0, PH_NORM, PH_GEMM_IN, PH_KVPREP, PH_GEMM_UP, PH_ATTN, PH_SCAN, PH_FINALIZE, PH_GEMM_OUT, PH_FINAL };
constexpr int NSTEPS = 42;

DI void decode_step(int step, int& ph, int& L, int& c) {
  if (step == 0) { ph = PH_PREP; L = 0; c = 0; return; }
  if (step == NSTEPS - 1) { ph = PH_FINAL; L = 0; c = 0; return; }
  int s = step - 1;
  int pr = s / 20, rem = s - pr * 20;
  if (rem < 11) {
    L = 2 * pr;
    int k;
    if (rem < 6) { c = 0; k = rem; } else { c = 1; k = rem - 5; }
    ph = (k == 0) ? PH_NORM : (k == 1) ? PH_GEMM_IN : (k == 2) ? PH_KVPREP : (k == 3) ? PH_GEMM_UP : (k == 4) ? PH_ATTN : PH_GEMM_OUT;
  } else {
    rem -= 11; L = 2 * pr + 1;
    int k;
    if (rem < 5) { c = 0; k = rem; } else { c = 1; k = rem - 4; }
    ph = (k == 0) ? PH_NORM : (k == 1) ? PH_GEMM_IN : (k == 2) ? PH_SCAN : (k == 3) ? PH_FINALIZE : PH_GEMM_OUT;
  }
}

DI void run_step(const Params& p, int ph, int L, int c, char* smem, int* s_item, bool dry_in, int vt) {
  const bool dry = dry_in && !(HYP5 && (ph == PH_GEMM_IN || ph == PH_GEMM_UP));
  char* ws = p.ws;
  const bool rw = L & 1;
  const int j = L >> 1;
  switch (ph) {
    case PH_PREP: phase_prep(p, smem); break;
    case PH_NORM:
      phase_norm(p, L, c);
      if (L == 0 && c == 0) {
        EpiMemKV epi{(u16*)(ws + OFF_MEMK), (u16*)(ws + OFF_MEMVT), false};
        gemm_phase<2, false, 16>((const u16*)(ws + OFF_MEMH), 1024ull * 1024, 1024, (const u16*)(ws + OFF_WT_MEMKV), 1024ull * 1024, 1024, 4, 4, 8, 4, 1024, smem, epi, vt);
      }
      break;
    case PH_GEMM_IN:
      if (!rw) {
        EpiStoreBf16 epi{(u16*)(ws + OFF_U), LDU_M, LDU_M, dry};
        gemm_phase<2, true, 16>((const u16*)(ws + OFF_H), 0, 1024, (const u16*)(ws + OFF_WT_INMLA) + (size_t)j * 3328 * 1024, 0, 1024, 1, 64, 26, 4, 1024, smem, epi, vt);
      } else {
        EpiStoreBf16 epi{(u16*)(ws + OFF_U), LDU_R, LDU_R, dry};
        gemm_phase<2, true, 16>((const u16*)(ws + OFF_H), 0, 1024, (const u16*)(ws + OFF_WT_INRW) + (size_t)j * 7296 * 1024, 0, 1024, 1, 64, 57, 4, 1024, smem, epi, vt);
      }
      break;
    case PH_KVPREP: phase_kvprep(p, L, c, dry); break;
    case PH_GEMM_UP: {
      EpiUQ e1{(u16*)(ws + OFF_Q), (const float*)(ws + OFF_COS), (const float*)(ws + OFF_SIN), c, dry};
      gemm_phase<2, true, 6>((const u16*)(ws + OFF_U) + M_CQ, 0, LDU_M, (const u16*)(ws + OFF_WT_UQ) + (size_t)j * 2304 * 384, 0, 384, 1, 64, 18, 4, 384, smem, e1, vt);
      EpiUK e2{(u16*)(ws + OFF_K), dry};
      gemm_phase<2, true, 4>((const u16*)(ws + OFF_U) + M_CKV, 0, LDU_M, (const u16*)(ws + OFF_WT_UKV) + (size_t)j * 3072 * 256, 0, 256, 1, 64, 12, 4, 256, smem, e2, vt);
      EpiUV e3{(u16*)(ws + OFF_VT), dry};
      gemm_phase<2, false, 4>((const u16*)(ws + OFF_U) + M_CKV, 0, LDU_M, (const u16*)(ws + OFF_WT_UKV) + (size_t)j * 3072 * 256 + 1536ull * 256, 0, 256, 1, 64, 12, 4, 256, smem, e3, vt);
    } break;
    case PH_ATTN: phase_attn(p, L, c, smem, s_item, dry); break;
    case PH_SCAN: phase_scan(p, L, c, smem, s_item, dry); break;
    case PH_FINALIZE: phase_finalize(p, L, c, dry); break;
    case PH_GEMM_OUT: {
      EpiResid epi{(L == 0) ? p.x : (const float*)p.out, p.out, rw, c, dry};
      gemm_phase<2, true, 32>((const u16*)(ws + OFF_U) + (rw ? R_GATE : M_GATE), 0, rw ? LDU_R : LDU_M, (const u16*)(ws + OFF_WT_OUT) + (size_t)L * 1024 * 2048, 0, 2048,
                 1, 64, 8, 4, 2048, smem, epi, vt);
      if (c == 0 && !dry) phase_norm(p, L, 1);
    } break;
    case PH_FINAL: phase_final_norm(p, dry); break;
  }
}

DI void grid_barrier(unsigned* bar, unsigned& epoch) {
  __syncthreads();
  ++epoch;
  if (threadIdx.x == 0) {
    __builtin_amdgcn_fence(__ATOMIC_RELEASE, "agent");
    asm volatile("s_waitcnt vmcnt(0)" ::: "memory");
    const unsigned target = epoch * gridDim.x;
    __hip_atomic_fetch_add(bar, 1u, __ATOMIC_RELAXED, __HIP_MEMORY_SCOPE_AGENT);
    unsigned spins = 0;
    while (__hip_atomic_load(bar, __ATOMIC_RELAXED, __HIP_MEMORY_SCOPE_AGENT) < target) {
      if (spins < 64u) __builtin_amdgcn_s_sleep(2); else __builtin_amdgcn_s_sleep(16);
      if (++spins > (1u << 22)) break;
    }
    __builtin_amdgcn_fence(__ATOMIC_ACQUIRE, "agent");
    asm volatile("s_waitcnt vmcnt(0)" ::: "memory");
  }
  __syncthreads();
}

__global__ void __launch_bounds__(256, 1) hybrid_megakernel(Params p, int s_lo, int s_hi, int coop, int probe_mask) {
  __shared__ __attribute__((aligned(16))) char smem[SMEM_BYTES];
  __shared__ int s_item;
  unsigned* bar = (unsigned*)(p.ws + OFF_BAR);
  unsigned epoch = 0;
  if (coop == 2) cg::this_grid().sync();
  __shared__ int s_vt;
  int myx = 0, myrank = 0;
  if (coop && threadIdx.x == 0) {
    myx = (int)(__builtin_amdgcn_s_getreg((3 << 11) | 20) & 7u);
    myrank = (int)__hip_atomic_fetch_add(bar + 16 + myx, 1u, __ATOMIC_RELAXED, __HIP_MEMORY_SCOPE_AGENT);
  }
  int vt = blockIdx.x;
  {
    const int G = gridDim.x, t = blockIdx.x;
    vt = ((G & 7) == 0) ? ((t & 7) * (G >> 3) + (t >> 3)) : t;
  }
  for (int st = s_lo; st < s_hi; ++st) {
    int ph, L, c;
    decode_step(st, ph, L, c);
    for (int rep = ((probe_mask >> ph) & 1) ? 0 : 1; rep < 2; ++rep) {
      run_step(p, ph, L, c, smem, &s_item, rep == 0, vt);
      if (coop && (rep == 0 || st + 1 < s_hi)) grid_barrier(bar, epoch);
      if (coop) for (int xs = 0; xs < EXTRA_SYNCS; ++xs) grid_barrier(bar, epoch);
    }
    if (coop && st == s_lo) {
      if (threadIdx.x == 0) {
        const int G = gridDim.x;
        bool ok = (G & 7) == 0;
        for (int x = 0; x < 8; ++x) ok = ok && ((int)__hip_atomic_load(bar + 16 + x, __ATOMIC_RELAXED, __HIP_MEMORY_SCOPE_AGENT) == (G >> 3));
        s_vt = ok ? (myx * (G >> 3) + myrank) : vt;
      }
      __syncthreads();
      vt = s_vt;
    }
  }
}

extern "C" void kernel_launch(void* const* d_in, const int* in_sizes, int n_in, void* d_out, int out_size, void* d_ws, size_t ws_size,
                              hipStream_t stream) {
  if (ws_size < WS_NEED) { fprintf(stderr, "workspace too small: %zu < %zu\n", ws_size, (size_t)WS_NEED); return; }
  Params p;
  memset(&p, 0, sizeof(p));
  p.x = (const float*)d_in[0]; p.mem = (const float*)d_in[1]; p.pos = (const int*)d_in[2];
  p.norm_g = (const float*)d_in[3]; p.mem_norm_g = (const float*)d_in[4]; p.w_mem_kv = (const float*)d_in[5];
  p.w_in_mla = (const float*)d_in[6]; p.q_norm_g = (const float*)d_in[7]; p.kv_norm_g = (const float*)d_in[8];
  p.w_uq = (const float*)d_in[9]; p.w_ukv = (const float*)d_in[10]; p.w_in_rwkv = (const float*)d_in[11];
  p.mu = (const float*)d_in[12]; p.w0 = (const float*)d_in[13]; p.w2 = (const float*)d_in[14]; p.a0 = (const float*)d_in[15];
  p.a2 = (const float*)d_in[16]; p.k_k = (const float*)d_in[17]; p.k_a = (const float*)d_in[18]; p.r_k = (const float*)d_in[19];
  p.gn_w = (const float*)d_in[20]; p.gn_b = (const float*)d_in[21]; p.w_out = (const float*)d_in[22]; p.final_g = (const float*)d_in[23];
  p.out = (float*)d_out; p.ws = (char*)d_ws;
  static int grid_blocks = 0;
  if (!grid_blocks) {
    int dev = 0, cus = 0, per_cu = 0;
    hipGetDevice(&dev);
    hipDeviceGetAttribute(&cus, hipDeviceAttributeMultiprocessorCount, dev);
    hipOccupancyMaxActiveBlocksPerMultiprocessor(&per_cu, hybrid_megakernel, 256, 0);
    if (per_cu > 2) per_cu = 2;
    if (per_cu < 1) per_cu = 1;
    grid_blocks = cus * per_cu;
  }
#if MULTI_LAUNCH
  for (int s = 0; s < NSTEPS; ++s) hipLaunchKernelGGL(hybrid_megakernel, dim3(grid_blocks), dim3(256), 0, stream, p, s, s + 1, 0, 0);
#else
  int s_lo = 0, s_hi = NSTEPS, coop = 1, probe_mask = PROBE_MASK;
  void* args[] = {&p, &s_lo, &s_hi, &coop, &probe_mask};
  hipMemsetAsync((char*)d_ws + OFF_BAR, 0, 256, stream);
  hipError_t e = hipLaunchCooperativeKernel((void*)hybrid_megakernel, dim3(grid_blocks), dim3(256), args, 0, stream);
  if (e != hipSuccess) fprintf(stderr, "cooperative launch failed: %s (grid %d)\n", hipGetErrorString(e), grid_blocks);
#endif
}
```
